# Optimizing an MI355X kernel written in HIP

```python
import math
import jax, jax.numpy as jnp
from jax import lax
import numpy as np

D_MODEL = 1024
BATCH = 4
SEQ = 8192
DEPTH = 2

HEAD_DIM = 64
BRANCH_WIDTH = D_MODEL // 2
N_BRANCH = 3
BLOCK = 128
A_HEADS = BRANCH_WIDTH // HEAD_DIM
A_KV_HEADS = 2
WINDOW = 128
B_HEADS = BRANCH_WIDTH // HEAD_DIM
B_KV_HEADS = 2
IDX_HEADS = 4
IDX_DIM = 32
TOPK_MAX = 256
C_HEADS = BRANCH_WIDTH // HEAD_DIM
FORGET_BIAS_INIT = 4.0
N_BUCKETS = 32
MAX_DISTANCE = 512
EPS = 1e-6
ATTN_SCALE = HEAD_DIM ** -0.5

A_SIZES = (A_HEADS * HEAD_DIM, A_KV_HEADS * HEAD_DIM, A_KV_HEADS * HEAD_DIM, BRANCH_WIDTH)
B_SIZES = (B_HEADS * HEAD_DIM, B_KV_HEADS * HEAD_DIM, B_KV_HEADS * HEAD_DIM,
           IDX_HEADS * IDX_DIM, IDX_DIM, IDX_HEADS, BRANCH_WIDTH)
C_SIZES = (C_HEADS * HEAD_DIM, C_HEADS * HEAD_DIM, C_HEADS * HEAD_DIM, C_HEADS, BRANCH_WIDTH)
MERGE_SIZES = (N_BRANCH * D_MODEL,)
IN_SIZES = A_SIZES + B_SIZES + C_SIZES + MERGE_SIZES
IN_COLS = sum(IN_SIZES)

kernel_name = "hybrid_swa_dsa_fox_gated_merge"


def _rms_norm(x, g):
    x32 = x.astype(jnp.float32)
    y = x32 * lax.rsqrt(jnp.mean(x32 * x32, axis=-1, keepdims=True) + EPS)
    return (y * g.astype(jnp.float32)).astype(x.dtype)


def _split(z, sizes):
    outs, start = [], 0
    for s in sizes:
        outs.append(z[..., start:start + s])
        start += s
    return outs


def _t5_bucket(delta):
    n = jnp.maximum(delta, 0)
    max_exact = N_BUCKETS // 2
    nf = jnp.maximum(n, 1).astype(jnp.float32)
    large = max_exact + (jnp.log(nf / max_exact) / math.log(MAX_DISTANCE / max_exact)
                         * (N_BUCKETS - max_exact)).astype(jnp.int32)
    large = jnp.minimum(large, N_BUCKETS - 1)
    return jnp.where(n < max_exact, n, large)


def _to_blocks(a, nb):
    return a.reshape(a.shape[0], nb, BLOCK, *a.shape[2:]).swapaxes(0, 1)


def _sliding_window_attention(q, k, v, sinks, bias_table):
    b_, s_, h_, dh = q.shape
    g_ = h_ // A_KV_HEADS
    nb = s_ // BLOCK
    qb = q.reshape(b_, nb, BLOCK, A_KV_HEADS, g_, dh)
    kb = k.reshape(b_, nb, BLOCK, A_KV_HEADS, dh)
    vb = v.reshape(b_, nb, BLOCK, A_KV_HEADS, dh)
    pad = ((0, 0), (1, 0), (0, 0), (0, 0), (0, 0))
    kk = jnp.concatenate([jnp.pad(kb, pad)[:, :-1], kb], axis=2)
    vv = jnp.concatenate([jnp.pad(vb, pad)[:, :-1], vb], axis=2)
    logits = jnp.einsum('bnqhgd,bnkhd->bnhgqk', qb, kk).astype(jnp.float32) * ATTN_SCALE
    qi = jnp.arange(BLOCK)[:, None]
    ki = jnp.arange(2 * BLOCK)[None, :]
    delta = qi + BLOCK - ki
    band = (delta >= 0) & (delta < WINDOW)
    not_pad = (jnp.arange(nb)[:, None, None] > 0) | (ki >= BLOCK)[None]
    mask = band[None] & not_pad
    bias = bias_table[_t5_bucket(delta)].astype(jnp.float32)
    bias = bias.transpose(2, 0, 1).reshape(A_KV_HEADS, g_, BLOCK, 2 * BLOCK)
    logits = jnp.where(mask[None, :, None, None], logits + bias[None, None], -jnp.inf)
    sink = sinks.astype(jnp.float32).reshape(A_KV_HEADS, g_)[None, None, :, :, None, None]
    sink = jnp.broadcast_to(sink, logits.shape[:-1] + (1,))
    p = jax.nn.softmax(jnp.concatenate([logits, sink], axis=-1), axis=-1)[..., :-1]
    o = jnp.einsum('bnhgqk,bnkhd->bnqhgd', p.astype(v.dtype), vv)
    return o.reshape(b_, s_, h_, dh)


def _dsa_attention(q, k, v, iq, ik, iw, bias_table):
    b_, s_, h_, dh = q.shape
    g_ = h_ // B_KV_HEADS
    nb = s_ // BLOCK
    topk = min(TOPK_MAX, s_ // 4)
    kpos = jnp.arange(s_)

    def one_block(args):
        n, qb, iqb, iwb = args
        tpos = n * BLOCK + jnp.arange(BLOCK)
        causal = kpos[None, :] <= tpos[:, None]
        sc = jnp.einsum('bqhc,bsc->bqhs', iqb, ik).astype(jnp.float32) * (IDX_DIM ** -0.5)
        w = iwb.astype(jnp.float32) * (IDX_HEADS ** -0.5)
        score = jnp.einsum('bqh,bqhs->bqs', w, jax.nn.relu(sc))
        score = jnp.where(causal[None], score, -jnp.inf)
        _, idx = lax.top_k(score, topk)
        ksel = jax.vmap(lambda kb_, ib: kb_[ib])(k, idx)
        vsel = jax.vmap(lambda vb_, ib: vb_[ib])(v, idx)
        qg = qb.reshape(b_, BLOCK, B_KV_HEADS, g_, dh)
        logits = jnp.einsum('bqhgd,bqkhd->bqhgk', qg, ksel).astype(jnp.float32) * ATTN_SCALE
        delta = tpos[None, :, None] - idx
        bias = bias_table[_t5_bucket(delta)].astype(jnp.float32)
        bias = bias.reshape(b_, BLOCK, topk, B_KV_HEADS, g_).transpose(0, 1, 3, 4, 2)
        valid = (delta >= 0)[:, :, None, None, :]
        logits = jnp.where(valid, logits + bias, -jnp.inf)
        p = jax.nn.softmax(logits, axis=-1).astype(v.dtype)
        o = jnp.einsum('bqhgk,bqkhd->bqhgd', p, vsel)
        return o.reshape(b_, BLOCK, h_, dh)

    out = lax.map(one_block, (jnp.arange(nb), _to_blocks(q, nb), _to_blocks(iq, nb), _to_blocks(iw, nb)))
    return out.swapaxes(0, 1).reshape(b_, s_, h_, dh)


def _forgetting_attention(q, k, v, log_f):
    b_, s_, h_, dh = q.shape
    nb = s_ // BLOCK
    c = jnp.cumsum(log_f, axis=1)
    c_keys = c.transpose(0, 2, 1)
    kpos = jnp.arange(s_)

    def one_block(args):
        n, qb, cb = args
        tpos = n * BLOCK + jnp.arange(BLOCK)
        logits = jnp.einsum('bqhd,bshd->bhqs', qb, k).astype(jnp.float32) * ATTN_SCALE
        logits = logits + cb.transpose(0, 2, 1)[..., None] - c_keys[:, :, None, :]
        causal = kpos[None, :] <= tpos[:, None]
        logits = jnp.where(causal[None, None], logits, -jnp.inf)
        p = jax.nn.softmax(logits, axis=-1).astype(v.dtype)
        return jnp.einsum('bhqs,bshd->bqhd', p, v)

    out = lax.map(one_block, (jnp.arange(nb), _to_blocks(q, nb), _to_blocks(c, nb)))
    return out.swapaxes(0, 1).reshape(b_, s_, h_, dh)


def setup_inputs(seed: int = 0) -> dict:
    key = jax.random.key(seed)
    ks = jax.random.split(key, 9)
    x = jax.random.normal(ks[0], (BATCH, SEQ, D_MODEL), jnp.float32)
    norm_gain = 1.0 + 0.02 * jax.random.normal(ks[1], (DEPTH, D_MODEL), jnp.float32)
    w_in = jax.random.normal(ks[2], (DEPTH, D_MODEL, IN_COLS), jnp.float32) * D_MODEL ** -0.5
    b_forget = FORGET_BIAS_INIT + 0.1 * jax.random.normal(ks[3], (DEPTH, C_HEADS), jnp.float32)
    qk_gain = 1.0 + 0.02 * jax.random.normal(ks[4], (DEPTH, N_BRANCH, 2, HEAD_DIM), jnp.float32)
    sinks = 0.5 * jax.random.normal(ks[5], (DEPTH, A_HEADS), jnp.float32)
    w_branch = jax.random.normal(ks[6], (DEPTH, N_BRANCH, BRANCH_WIDTH, D_MODEL), jnp.float32) * BRANCH_WIDTH ** -0.5
    w_out = jax.random.normal(ks[7], (DEPTH, D_MODEL, D_MODEL), jnp.float32) * D_MODEL ** -0.5
    rel_bias = 0.1 * jax.random.normal(ks[8], (N_BUCKETS, A_HEADS + B_HEADS), jnp.float32)
    return {"x": x, "norm_gain": norm_gain, "w_in": w_in, "b_forget": b_forget,
            "qk_gain": qk_gain, "sinks": sinks, "w_branch": w_branch, "w_out": w_out,
            "rel_bias": rel_bias}


def reference(x, norm_gain, w_in, b_forget, qk_gain, sinks, w_branch, w_out, rel_bias):
    b_, s_, _ = x.shape
    bias_a = rel_bias[:, :A_HEADS]
    bias_b = rel_bias[:, A_HEADS:]
    for layer in range(DEPTH):
        h = _rms_norm(x, norm_gain[layer])
        z = jnp.einsum('bsd,dc->bsc', h, w_in[layer])
        (a_q, a_k, a_v, a_gate,
         b_q, b_k, b_v, b_iq, b_ik, b_iw, b_gate,
         c_q, c_k, c_v, c_f, c_gate,
         merge) = _split(z, IN_SIZES)
        g = qk_gain[layer]

        def heads(t, n):
            return t.reshape(b_, s_, n, HEAD_DIM)

        qa = _rms_norm(heads(a_q, A_HEADS), g[0, 0])
        ka = _rms_norm(heads(a_k, A_KV_HEADS), g[0, 1])
        oa = _sliding_window_attention(qa, ka, heads(a_v, A_KV_HEADS), sinks[layer], bias_a)
        qb = _rms_norm(heads(b_q, B_HEADS), g[1, 0])
        kb = _rms_norm(heads(b_k, B_KV_HEADS), g[1, 1])
        ob = _dsa_attention(qb, kb, heads(b_v, B_KV_HEADS),
                            b_iq.reshape(b_, s_, IDX_HEADS, IDX_DIM), b_ik, b_iw, bias_b)
        qc = _rms_norm(heads(c_q, C_HEADS), g[2, 0])
        kc = _rms_norm(heads(c_k, C_HEADS), g[2, 1])
        log_f = jax.nn.log_sigmoid((c_f + b_forget[layer]).astype(jnp.float32))
        oc = _forgetting_attention(qc, kc, heads(c_v, C_HEADS), log_f)

        branches = jnp.stack([oa.reshape(b_, s_, BRANCH_WIDTH) * jax.nn.silu(a_gate),
                              ob.reshape(b_, s_, BRANCH_WIDTH) * jax.nn.silu(b_gate),
                              oc.reshape(b_, s_, BRANCH_WIDTH) * jax.nn.silu(c_gate)], axis=2)
        y = jnp.einsum('bsnc,ncd->bsnd', branches, w_branch[layer])
        gates = jax.nn.sigmoid(merge.reshape(b_, s_, N_BRANCH, D_MODEL))
        merged = jnp.sum(gates * y, axis=2)
        x = x + jnp.einsum('bsd,de->bse', merged, w_out[layer])
    return x
```

```cpp
#include <hip/hip_runtime.h>
#include <cstdio>
#include <cstdint>
#include <cmath>
namespace pg8 {
#define PG8_LAS __attribute__((address_space(3)))
typedef unsigned short bf16_t;
typedef short bf16x8 __attribute__((ext_vector_type(8)));
typedef float f32x4 __attribute__((ext_vector_type(4)));
typedef unsigned u32x4 __attribute__((ext_vector_type(4)));
constexpr int BM = 256, BK = 64, HALF = 128, HTB = HALF * BK * 2  , STAGE_BYTES = 8 * HTB, NXCD = 8, WGM = 8;

__host__ __device__ __forceinline__ int lds_byte(int r, int c) { const int st = (r >> 4) * 2 + (c >> 5), rr = r & 15, cc = c & 31, ob = rr * 64 + cc * 2; return st * 1024 + (ob ^ (((ob >> 9) & 1) << 5)); }
__host__ __device__ __forceinline__ void stage_rc(int b, int& R, int& C) { const int st = b / 1024, sb = b % 1024, swz = sb ^ (((sb >> 9) & 1) << 5); R = (st >> 1) * 16 + swz / 64; C = (st & 1) * 32 + (swz % 64) / 2; }
__host__ __device__ __forceinline__ int perm32(int rho) { const int n = rho >> 4, i = rho & 15; return 8 * (i >> 2) + 4 * n + (i & 3); }

struct Unit { int pm, pn, seg; };
struct Gemm { const bf16_t* A; const bf16_t* Bt; int M, N, K, lda, ldb, segN; };

struct StaticOrder {
    int nM, nN, nwg, G, c;
    __host__ __device__ void init(int M, int N, int G_, int c_) { nM = M / BM; nN = N / BM; nwg = nM * nN; G = G_; c = c_; }
    __host__ __device__ bool next(int i, Unit& u) const {
        const long L = (long)i * G + c; if (L >= nwg) return false;
        int wgid = (int)L; { const int q = nwg / NXCD, r = nwg % NXCD, xcd = wgid % NXCD, off = wgid / NXCD; wgid = (xcd < r ? xcd * (q + 1) : r * (q + 1) + (xcd - r) * q) + off; }
        const int nig = WGM * nN, gid = wgid / nig, fm = gid * WGM, gsz = (nM - fm) < WGM ? (nM - fm) : WGM;
        u.pm = fm + ((wgid % nig) % gsz); u.pn = (wgid % nig) / gsz; u.seg = 0; return true;
    }
    __device__ __forceinline__ void a_ready(const Unit&) const {}
    __device__ __forceinline__ void done(const Unit&) const {}
};

__device__ __forceinline__ unsigned cvt_pk_bf16(float lo, float hi) { unsigned r; asm volatile("v_cvt_pk_bf16_f32 %0, %1, %2" : "=v"(r) : "v"(lo), "v"(hi)); return r; }
constexpr size_t EWS_MiB = 1u << 20, EWS_SSQ = 43 * EWS_MiB, EWS_IW = 47 * EWS_MiB, EWS_CF = 47 * EWS_MiB + 512 * 1024, EWS_IQ = 49 * EWS_MiB, EWS_IK = 57 * EWS_MiB, EWS_G = 188 * EWS_MiB,
    EWS_QA = 284 * EWS_MiB, EWS_QB = 316 * EWS_MiB, EWS_QC = 348 * EWS_MiB, EWS_KC = 380 * EWS_MiB, EWS_VC = 412 * EWS_MiB, EWS_KAB = 444 * EWS_MiB, EWS_VAB = 460 * EWS_MiB;

constexpr float C2Q = 0.125f * 1.4426950408889634f;
__device__ __forceinline__ float fast_sigmoid(float x) { return __builtin_amdgcn_rcpf(1.0f + __expf(-x)); }
__device__ __forceinline__ u32x4 pack8(const f32x4 a, const f32x4 b) { u32x4 w; w.x = cvt_pk_bf16(a[0], a[1]); w.y = cvt_pk_bf16(a[2], a[3]); w.z = cvt_pk_bf16(b[0], b[1]); w.w = cvt_pk_bf16(b[2], b[3]); return w; }
__device__ __forceinline__ void unpack8(const u32x4 w, f32x4& a, f32x4& b) {
    a[0] = __uint_as_float(w.x << 16); a[1] = __uint_as_float(w.x & 0xffff0000u); a[2] = __uint_as_float(w.y << 16); a[3] = __uint_as_float(w.y & 0xffff0000u);
    b[0] = __uint_as_float(w.z << 16); b[1] = __uint_as_float(w.z & 0xffff0000u); b[2] = __uint_as_float(w.w << 16); b[3] = __uint_as_float(w.w & 0xffff0000u); }
#define EPI_PIN() asm volatile("" ::: "memory")
__device__ __forceinline__ void rows_rstd(const float* ssq, int row0, int fq, float (&rs)[2][4]) {
    f32x4 pr[2][4];
#pragma unroll
    for (int ai = 0; ai < 2; ++ai)
#pragma unroll
        for (int m = 0; m < 4; ++m) pr[ai][m] = *(const f32x4*)(ssq + (size_t)(row0 + ai * HALF + m * 16) * 16 + 4 * fq);
    EPI_PIN();
#pragma unroll
    for (int ai = 0; ai < 2; ++ai)
#pragma unroll
        for (int m = 0; m < 4; ++m) { const f32x4 a = pr[ai][m]; float t = (a[0] + a[1]) + (a[2] + a[3]); t += __shfl_xor(t, 16); t += __shfl_xor(t, 32); rs[ai][m] = __builtin_amdgcn_rsqf(t * (1.0f / 1024.0f) + 1e-6f); }
}
struct EpiIn {
    static constexpr bool PERM = true, AFTER_DRAIN = false;
    unsigned char* ws; const float* qkg;
    __device__ __forceinline__ bool keep(const Unit&) const { return false; }
    __device__ __forceinline__ void operator()(f32x4 (&acc)[2][2][4][2], const Unit& u, int wr, int wc, int fr, int fq) const {
        const int row0 = u.pm * BM + wr * 64 + fr, t = u.pn, lc0 = wc * 64 + fq * 8;
        float rs[2][4]; rows_rstd((const float*)(ws + EWS_SSQ), row0, fq, rs);
        if (t == 18) {
            bf16_t* IQ = (bf16_t*)(ws + EWS_IQ); bf16_t* IK = (bf16_t*)(ws + EWS_IK); float* IW = (float*)(ws + EWS_IW); float* CF = (float*)(ws + EWS_CF);
#pragma unroll
            for (int ai = 0; ai < 2; ++ai)
#pragma unroll
                for (int m = 0; m < 4; ++m) { const int row = row0 + ai * HALF + m * 16; const float f = rs[ai][m];
#pragma unroll
                    for (int bj = 0; bj < 2; ++bj) { const int lc = lc0 + 32 * bj; const f32x4 v0 = acc[ai][bj][m][0] * f, v1 = acc[ai][bj][m][1] * f;
                        if (lc < 128) *(u32x4*)(IQ + (size_t)row * 128 + lc) = pack8(v0, v1);
                        else if (lc < 160) *(u32x4*)(IK + (size_t)row * 32 + (lc - 128)) = pack8(v0, v1);
                        else if (lc == 160) { *(f32x4*)(IW + (size_t)row * 4) = v0 * 0.08838834764831845f; *(f32x4*)(CF + (size_t)row * 8) = v1; }
                        else if (lc == 168) *(f32x4*)(CF + (size_t)row * 8 + 4) = v0; } }
            return;
        }
        bf16_t* dst; int ldc, colbase; const float* gp = qkg; float csc = 1.f; bool norm = false, act = false;
        if (t < 6) { const int mx = t >> 1; dst = (bf16_t*)(ws + (mx == 0 ? EWS_QA : (mx == 1 ? EWS_QB : EWS_QC))); ldc = 512; colbase = (t & 1) * 256; norm = true; gp = qkg + (mx * 2 + 0) * 64; csc = (mx == 2) ? C2Q : 1.f; }
        else if (t == 6) { dst = (bf16_t*)(ws + EWS_KAB); ldc = 128; colbase = (wc >> 1) * (32768 * 128 - 128); norm = true;     gp = qkg + ((wc >> 1) * 2 + 1) * 64; }
        else if (t < 9) { dst = (bf16_t*)(ws + EWS_KC); ldc = 512; colbase = (t - 7) * 256; norm = true; gp = qkg + (2 * 2 + 1) * 64; }
        else if (t == 9) { dst = (bf16_t*)(ws + EWS_VAB); ldc = 128; colbase = (wc >> 1) * (32768 * 128 - 128); }
        else if (t < 12) { dst = (bf16_t*)(ws + EWS_VC); ldc = 512; colbase = (t - 10) * 256; }
        else { dst = (bf16_t*)(ws + EWS_G); ldc = 1536; colbase = (t - 12) * 256; act = true; }
        f32x4 gv[2][2];
#pragma unroll
        for (int bj = 0; bj < 2; ++bj)
#pragma unroll
            for (int n = 0; n < 2; ++n) gv[bj][n] = norm ? *(const f32x4*)(gp + 8 * fq + 32 * bj + 4 * n) * csc : (f32x4){1.f, 1.f, 1.f, 1.f};
        EPI_PIN();
#pragma unroll
        for (int ai = 0; ai < 2; ++ai)
#pragma unroll
            for (int m = 0; m < 4; ++m) { const int row = row0 + ai * HALF + m * 16; float f = rs[ai][m];
                if (norm) { float ss = 0.f;
#pragma unroll
                    for (int bj = 0; bj < 2; ++bj)
#pragma unroll
                        for (int n = 0; n < 2; ++n) { const f32x4 x = acc[ai][bj][m][n]; ss += (x[0] * x[0] + x[1] * x[1]) + (x[2] * x[2] + x[3] * x[3]); }
                    ss += __shfl_xor(ss, 16); ss += __shfl_xor(ss, 32);
                    f = f * __builtin_amdgcn_rsqf(f * f * ss * (1.0f / 64.0f) + 1e-6f); }
                bf16_t* rowp = dst + (size_t)row * ldc + colbase + lc0;
#pragma unroll
                for (int bj = 0; bj < 2; ++bj) { f32x4 v0 = acc[ai][bj][m][0] * f * gv[bj][0], v1 = acc[ai][bj][m][1] * f * gv[bj][1];
                    if (act) {
#pragma unroll
                        for (int e = 0; e < 4; ++e) { v0[e] = v0[e] * fast_sigmoid(v0[e]); v1[e] = v1[e] * fast_sigmoid(v1[e]); } }
                    *(u32x4*)(rowp + 32 * bj) = pack8(v0, v1); } }
    }
};
typedef unsigned u32x2e __attribute__((ext_vector_type(2)));
__device__ __forceinline__ unsigned gate_q4(const f32x4 v) { unsigned w = 0u;
    w = __builtin_amdgcn_cvt_pk_u8_f32(fmaxf(255.0f * fast_sigmoid(v[0]), 1.0f), 0, w); w = __builtin_amdgcn_cvt_pk_u8_f32(fmaxf(255.0f * fast_sigmoid(v[1]), 1.0f), 1, w);
    w = __builtin_amdgcn_cvt_pk_u8_f32(fmaxf(255.0f * fast_sigmoid(v[2]), 1.0f), 2, w); w = __builtin_amdgcn_cvt_pk_u8_f32(fmaxf(255.0f * fast_sigmoid(v[3]), 1.0f), 3, w); return w; }
__device__ __forceinline__ f32x4 gate_f4(const unsigned w) { return (f32x4){(float)(w & 0xffu), (float)((w >> 8) & 0xffu), (float)((w >> 16) & 0xffu), (float)(w >> 24)}; }
struct EpiGate {
    static constexpr bool PERM = true, AFTER_DRAIN = false;
    const float* ssq; unsigned char* MG;
    __device__ __forceinline__ bool keep(const Unit&) const { return false; }
    __device__ __forceinline__ void operator()(f32x4 (&acc)[2][2][4][2], const Unit& u, int wr, int wc, int fr, int fq) const {
        const int row0 = u.pm * BM + wr * 64 + fr, lc0 = wc * 64 + fq * 8;
        float rs[2][4]; rows_rstd(ssq, row0, fq, rs);
#pragma unroll
        for (int ai = 0; ai < 2; ++ai)
#pragma unroll
            for (int m = 0; m < 4; ++m) { const int row = row0 + ai * HALF + m * 16; const float f = rs[ai][m];
                unsigned char* rowp = MG + (size_t)row * 3072 + u.pn * BM + lc0;
#pragma unroll
                for (int bj = 0; bj < 2; ++bj) { u32x2e w; w.x = gate_q4(acc[ai][bj][m][0] * f); w.y = gate_q4(acc[ai][bj][m][1] * f); *(u32x2e*)(rowp + 32 * bj) = w; } }
    }
};
struct EpiMerge {
    static constexpr bool PERM = true, AFTER_DRAIN = false;
    const unsigned char* MG; bf16_t* OUT;
    __device__ __forceinline__ bool keep(const Unit& u) const { return u.seg < 2; }
    __device__ __forceinline__ void operator()(f32x4 (&acc)[2][2][4][2], const Unit& u, int wr, int wc, int fr, int fq) const {
        const int row0 = u.pm * BM + wr * 64 + fr, col0 = u.pn * BM + wc * 32 + 8 * fq, seg = u.seg;
#pragma unroll
        for (int ai = 0; ai < 2; ++ai) {
            u32x2e ga[4][2], gb[4][2];
#pragma unroll
            for (int m = 0; m < 4; ++m) { const unsigned char* gp = MG + (size_t)(row0 + ai * HALF + m * 16) * 3072 + seg * 1024 + col0;
#pragma unroll
                for (int bj = 0; bj < 2; ++bj) { ga[m][bj] = *(const u32x2e*)(gp + bj * HALF); gb[m][bj] = seg < 2 ? *(const u32x2e*)(gp + 1024 + bj * HALF) : ga[m][bj]; } }
            EPI_PIN();
#pragma unroll
            for (int m = 0; m < 4; ++m) { const int row = row0 + ai * HALF + m * 16;
#pragma unroll
                for (int bj = 0; bj < 2; ++bj) { f32x4 a0 = gate_f4(ga[m][bj].x), a1 = gate_f4(ga[m][bj].y);
                    if (seg < 2) { const f32x4 b0 = gate_f4(gb[m][bj].x), b1 = gate_f4(gb[m][bj].y);
#pragma unroll
                        for (int e = 0; e < 4; ++e) { a0[e] = a0[e] * __builtin_amdgcn_rcpf(b0[e]); a1[e] = a1[e] * __builtin_amdgcn_rcpf(b1[e]); } }
                    else { a0 = a0 * (1.0f / 255.0f); a1 = a1 * (1.0f / 255.0f); }
                    acc[ai][bj][m][0] = acc[ai][bj][m][0] * a0; acc[ai][bj][m][1] = acc[ai][bj][m][1] * a1;
                    if (seg == 2) *(u32x4*)(OUT + (size_t)row * 1024 + col0 + bj * HALF) = pack8(acc[ai][bj][m][0], acc[ai][bj][m][1]); } }
        }
    }
};
struct EpiOut {
    static constexpr bool PERM = true, AFTER_DRAIN = false;
    const float* resid; float* out; bf16_t* XB; float* ssq; unsigned poison;
    __device__ __forceinline__ bool keep(const Unit&) const { return false; }
    __device__ __forceinline__ void operator()(f32x4 (&acc)[2][2][4][2], const Unit& u, int wr, int wc, int fr, int fq) const {
        const int row0 = u.pm * BM + wr * 64 + fr, col0 = u.pn * BM + wc * 32 + 8 * fq;
#pragma unroll
        for (int ai = 0; ai < 2; ++ai) {
            f32x4 rv[4][2][2];
#pragma unroll
            for (int m = 0; m < 4; ++m)
#pragma unroll
                for (int bj = 0; bj < 2; ++bj) { const size_t o = (size_t)(row0 + ai * HALF + m * 16) * 1024 + col0 + bj * HALF; rv[m][bj][0] = *(const f32x4*)(resid + o); rv[m][bj][1] = *(const f32x4*)(resid + o + 4); }
            EPI_PIN();
#pragma unroll
            for (int m = 0; m < 4; ++m) { const int row = row0 + ai * HALF + m * 16; float ss = 0.f;
#pragma unroll
                for (int bj = 0; bj < 2; ++bj) { const size_t o = (size_t)row * 1024 + col0 + bj * HALF;
                    f32x4 v0 = rv[m][bj][0] + acc[ai][bj][m][0], v1 = rv[m][bj][1] + acc[ai][bj][m][1];
                    if (poison) { const float qn = __builtin_nanf(""); v0 = (f32x4){qn, qn, qn, qn}; v1 = v0; }
                    *(f32x4*)(out + o) = v0; *(f32x4*)(out + o + 4) = v1;
                    if (XB) { *(u32x4*)(XB + o) = pack8(v0, v1); ss += ((v0[0] * v0[0] + v0[1] * v0[1]) + (v0[2] * v0[2] + v0[3] * v0[3])) + ((v1[0] * v1[0] + v1[1] * v1[1]) + (v1[2] * v1[2] + v1[3] * v1[3])); } }
                if (XB) { ss += __shfl_xor(ss, 16); ss += __shfl_xor(ss, 32); if (fq == 0) ssq[(size_t)row * 16 + u.pn * 4 + wc] = ss; } }
            EPI_PIN();
        }
    }
};
struct SegOrder {
    StaticOrder base;
    __device__ __forceinline__ bool next(int i, Unit& u) const { if (!base.next(i / 3, u)) return false; u.seg = i % 3; return true; }
    __device__ __forceinline__ void a_ready(const Unit&) const {}
    __device__ __forceinline__ void done(const Unit&) const {}
};

template <class Epi, class Sched, bool ALIGN_EPI = false, bool SP2 = false>
__device__ __forceinline__ void gemm_phase(PG8_LAS unsigned char* lds, const Gemm g, const Sched& S, const Epi& E, int wave_id) {
    int tid_ = (int)__builtin_amdgcn_mbcnt_hi(~0u, __builtin_amdgcn_mbcnt_lo(~0u, 0u)); asm volatile("" : "+v"(tid_)); tid_ += wave_id * 64;
    const int tid = tid_, wid = __builtin_amdgcn_readfirstlane(tid >> 6), lane = tid & 63, wr = wid >> 2, wc = wid & 3, fr = lane & 15, fq = lane >> 4;
    const int K = g.K, nt = K / BK;
    unsigned voffA[2], voffB[2];
#pragma unroll
    for (int i = 0; i < 2; ++i) { int R, C; stage_rc(tid * 16 + i * 8192, R, C); const int Rb = Epi::PERM ? ((R & ~31) + perm32(R & 31)) : R;
        voffA[i] = (unsigned)(R * g.lda + C) * 2u; voffB[i] = (unsigned)(Rb * g.ldb + C) * 2u; }
    const size_t kstep = (size_t)(BK * 2);
    const size_t hstepA = (size_t)HALF * g.lda * 2, hstepB = (size_t)HALF * g.ldb * 2;
    const size_t tstepA = 2 * hstepA, tstepB = 2 * hstepB, sstepA = (size_t)K * 2;
    const unsigned ldsw = (unsigned)wid * 1024u;
    const int aoff = lds_byte(wr * 64 + fr, fq * 8), boff = lds_byte(wc * 32 + fr, fq * 8);
#define PG8_SA(b, h) (((b) * 2 + (h)) * HTB)
#define PG8_SB(b, h) ((4 + (b) * 2 + (h)) * HTB)
#define PG8_STAGE(bufoff, gbase, voff) do { _Pragma("unroll") for (int _i = 0; _i < 2; ++_i) \
        __builtin_amdgcn_global_load_lds((const unsigned*)((const char*)(gbase) + (voff)[_i]), (PG8_LAS unsigned*)(lds + (bufoff) + ldsw + _i * 8192), 16, 0, 0); } while (0)
#define PG8_LDA(dst, b, h) do { _Pragma("unroll") for (int m = 0; m < 4; ++m) _Pragma("unroll") for (int k = 0; k < 2; ++k) dst[m][k] = *(const PG8_LAS bf16x8*)(lds + PG8_SA(b, h) + aoff + m * 2048 + k * 1024); } while (0)
#define PG8_LDB(dst, b, h) do { _Pragma("unroll") for (int n = 0; n < 2; ++n) _Pragma("unroll") for (int k = 0; k < 2; ++k) dst[n][k] = *(const PG8_LAS bf16x8*)(lds + PG8_SB(b, h) + boff + n * 2048 + k * 1024); } while (0)
#define PG8_MMA(ai, bj, At, Bt) do { __builtin_amdgcn_s_setprio(1); _Pragma("unroll") for (int m = 0; m < 4; ++m) _Pragma("unroll") for (int n = 0; n < 2; ++n) _Pragma("unroll") for (int k = 0; k < 2; ++k) \
        acc[ai][bj][m][n] = __builtin_amdgcn_mfma_f32_16x16x32_bf16(Bt[n][k], At[m][k], acc[ai][bj][m][n], 0, 0, 0); __builtin_amdgcn_s_setprio(0); } while (0)
#define PG8_WAIT_V(n) asm volatile("s_waitcnt vmcnt(" #n ")" ::: "memory")
#define PG8_WAIT_L(n) asm volatile("s_waitcnt lgkmcnt(" #n ")" ::: "memory")
#define PG8_BAR __builtin_amdgcn_s_barrier()
#define PG8_SCHED __builtin_amdgcn_sched_barrier(0)
    Unit cur, nxt; int ui = 0;
    if (!S.next(0, cur)) return;
    f32x4 acc[2][2][4][2];
#pragma unroll
    for (int a = 0; a < 2; ++a)
#pragma unroll
        for (int b = 0; b < 2; ++b)
#pragma unroll
            for (int m = 0; m < 4; ++m)
#pragma unroll
                for (int n = 0; n < 2; ++n) acc[a][b][m][n] = (f32x4){0.f, 0.f, 0.f, 0.f};
    bf16x8 At[4][2], B0[2][2], B1[2][2];
    const char* cA = (const char*)g.A + (size_t)cur.pm * tstepA + (size_t)cur.seg * sstepA; const char* cB = (const char*)g.Bt + (size_t)(cur.seg * g.segN + cur.pn) * tstepB;
    S.a_ready(cur);
    if constexpr (SP2) {
        PG8_STAGE(PG8_SB(0, 0), cB, voffB); PG8_STAGE(PG8_SB(0, 1), cB + hstepB, voffB); PG8_STAGE(PG8_SA(0, 0), cA, voffA); PG8_STAGE(PG8_SA(0, 1), cA + hstepA, voffA);
        if (wr == 1) PG8_BAR;
        PG8_WAIT_V(2); PG8_BAR;
        PG8_STAGE(PG8_SB(1, 0), cB + kstep, voffB); PG8_STAGE(PG8_SA(1, 0), cA + kstep, voffA); PG8_STAGE(PG8_SB(1, 1), cB + hstepB + kstep, voffB);
        PG8_WAIT_V(6); PG8_BAR;
    } else {
        PG8_STAGE(PG8_SB(0, 0), cB, voffB); PG8_STAGE(PG8_SA(0, 0), cA, voffA); PG8_STAGE(PG8_SB(0, 1), cB + hstepB, voffB); PG8_STAGE(PG8_SA(0, 1), cA + hstepA, voffA);
        if (wr == 1) PG8_BAR;
        PG8_WAIT_V(4); PG8_BAR;
        PG8_STAGE(PG8_SB(1, 0), cB + kstep, voffB); PG8_STAGE(PG8_SA(1, 0), cA + kstep, voffA); PG8_STAGE(PG8_SB(1, 1), cB + hstepB + kstep, voffB);
        PG8_WAIT_V(6); PG8_BAR;
    }
    for (;;) {
        const bool has_next = S.next(ui + 1, nxt);
        const char* nA = has_next ? (const char*)g.A + (size_t)nxt.pm * tstepA + (size_t)nxt.seg * sstepA : cA; const char* nB = has_next ? (const char*)g.Bt + (size_t)(nxt.seg * g.segN + nxt.pn) * tstepB : cB;
        for (int t = 0; t < nt; t += 2) {
            const bool last = (t == nt - 2);
            const char* a1 = cA + (size_t)(t + 1) * kstep;
            const char* a2 = last ? nA : cA + (size_t)(t + 2) * kstep; const char* b2 = last ? nB : cB + (size_t)(t + 2) * kstep;
            const char* a3 = a2 + kstep; const char* b3 = b2 + kstep;
            if (last && has_next) S.a_ready(nxt);
            if constexpr (SP2) {
            PG8_LDB(B0, 0, 0); PG8_LDB(B1, 0, 1); PG8_SCHED; PG8_LDA(At, 0, 0); PG8_STAGE(PG8_SA(1, 1), a1 + hstepA, voffA);
            PG8_WAIT_V(8); PG8_WAIT_L(0); PG8_BAR; PG8_MMA(0, 0, At, B0); PG8_MMA(0, 1, At, B1); PG8_BAR; PG8_SCHED;
            PG8_LDA(At, 0, 1); PG8_STAGE(PG8_SB(0, 0), b2, voffB); PG8_STAGE(PG8_SB(0, 1), b2 + hstepB, voffB); PG8_STAGE(PG8_SA(0, 0), a2, voffA);
            PG8_WAIT_V(8); PG8_WAIT_L(0); PG8_BAR; PG8_MMA(1, 0, At, B0); PG8_MMA(1, 1, At, B1); PG8_BAR; PG8_SCHED;
            PG8_LDB(B0, 1, 0); PG8_LDB(B1, 1, 1); PG8_SCHED; PG8_LDA(At, 1, 0); PG8_STAGE(PG8_SA(0, 1), a2 + hstepA, voffA);
            PG8_WAIT_V(8); PG8_WAIT_L(0); PG8_BAR; PG8_MMA(0, 0, At, B0); PG8_MMA(0, 1, At, B1); PG8_BAR; PG8_SCHED;
            PG8_LDA(At, 1, 1); PG8_STAGE(PG8_SB(1, 0), b3, voffB); PG8_STAGE(PG8_SB(1, 1), b3 + hstepB, voffB); PG8_STAGE(PG8_SA(1, 0), a3, voffA);
            PG8_WAIT_V(8); PG8_WAIT_L(0); PG8_BAR; PG8_MMA(1, 0, At, B0); PG8_MMA(1, 1, At, B1); PG8_BAR; PG8_SCHED;
            } else {
            PG8_LDB(B0, 0, 0); PG8_SCHED; PG8_LDA(At, 0, 0); PG8_STAGE(PG8_SA(1, 1), a1 + hstepA, voffA);
            PG8_WAIT_L(8); PG8_BAR; PG8_WAIT_L(0); PG8_MMA(0, 0, At, B0); PG8_BAR; PG8_SCHED;
            PG8_LDB(B1, 0, 1); PG8_STAGE(PG8_SB(0, 0), b2, voffB);
            PG8_BAR; PG8_WAIT_L(0); PG8_MMA(0, 1, At, B1); PG8_BAR;
            PG8_LDA(At, 0, 1); PG8_STAGE(PG8_SA(0, 0), a2, voffA);
            PG8_BAR; PG8_WAIT_L(0); PG8_MMA(1, 0, At, B0); PG8_BAR; PG8_SCHED;
            PG8_STAGE(PG8_SB(0, 1), b2 + hstepB, voffB);
            PG8_WAIT_V(6); PG8_BAR; PG8_MMA(1, 1, At, B1); PG8_BAR;
            PG8_LDB(B0, 1, 0); PG8_SCHED; PG8_LDA(At, 1, 0); PG8_STAGE(PG8_SA(0, 1), a2 + hstepA, voffA);
            PG8_WAIT_L(8); PG8_BAR; PG8_WAIT_L(0); PG8_MMA(0, 0, At, B0); PG8_BAR; PG8_SCHED;
            PG8_LDB(B1, 1, 1); PG8_STAGE(PG8_SB(1, 0), b3, voffB);
            PG8_BAR; PG8_WAIT_L(0); PG8_MMA(0, 1, At, B1); PG8_BAR;
            PG8_LDA(At, 1, 1); PG8_STAGE(PG8_SA(1, 0), a3, voffA);
            PG8_BAR; PG8_WAIT_L(0); PG8_MMA(1, 0, At, B0); PG8_BAR; PG8_SCHED;
            PG8_STAGE(PG8_SB(1, 1), b3 + hstepB, voffB);
            PG8_WAIT_V(6); PG8_BAR; PG8_MMA(1, 1, At, B1); PG8_BAR;
            }
        }
        if constexpr (ALIGN_EPI) { if (wr == 0) PG8_BAR; }
        if constexpr (!Epi::AFTER_DRAIN) { E(acc, cur, wr, wc, fr, fq); S.done(cur); }
        if (!has_next) break;
        if (!E.keep(cur)) {
#pragma unroll
        for (int a = 0; a < 2; ++a)
#pragma unroll
            for (int b = 0; b < 2; ++b)
#pragma unroll
                for (int m = 0; m < 4; ++m)
#pragma unroll
                    for (int n = 0; n < 2; ++n) acc[a][b][m][n] = (f32x4){0.f, 0.f, 0.f, 0.f};
        }
        cur = nxt; cA = nA; cB = nB; ++ui;
        if constexpr (ALIGN_EPI) { if (wr == 1) PG8_BAR; }
    }
    PG8_WAIT_V(0);
    if constexpr (!ALIGN_EPI) { if (wr == 0) PG8_BAR; }
    PG8_BAR;
    if constexpr (Epi::AFTER_DRAIN) { E.fused(acc, cur, wr, wc, fr, fq, lds, wid, lane); S.done(cur); }
#undef PG8_SA
#undef PG8_SB
#undef PG8_STAGE
#undef PG8_LDA
#undef PG8_LDB
#undef PG8_MMA
#undef PG8_WAIT_V
#undef PG8_WAIT_L
#undef PG8_BAR
#undef PG8_SCHED
}
}
#include <hip/hip_bf16.h>
#include <cmath>
namespace attn_body {
using bf16=__hip_bfloat16;
using bf16x8=__attribute__((ext_vector_type(8)))short;
using s16x4=__attribute__((ext_vector_type(4)))short;
using f32x16=__attribute__((ext_vector_type(16)))float;
using u32x4=__attribute__((ext_vector_type(4)))unsigned;
constexpr int BATCH=4,NHEAD=8,SEQ=8192,D=64,DM=NHEAD*D;
constexpr int NW=8,QBLK=32,QB=QBLK*NW,KVBLK=64,NQB=SEQ/QB;
constexpr int ATTN_PITCH=DM, ATTN_UNIT_ROWS=QB, OPITCH=1536, OCOL0=1024;
__device__ __forceinline__ int crow(int r,int hi){return (r&3)+8*(r>>2)+4*hi;}
#define SBAR() __builtin_amdgcn_sched_barrier(0)
__device__ __forceinline__ void cmask(f32x16&p0,f32x16&p1,int jb,int qrel,int hi){
  const float NEG=-INFINITY; int kb=64*jb+4*hi;
  #pragma unroll
  for(int r=0;r<16;++r){int kv=kb+(r&3)+8*(r>>2); if(kv>qrel)p0[r]=NEG; if(kv+32>qrel)p1[r]=NEG;}
}

constexpr int NSLOT=3, SLOTB=8192;
constexpr int LDS_K=0, LDS_V=NSLOT*SLOTB, LDS_WS=2*NSLOT*SLOTB, LDS_OST=LDS_WS+NW*64*4, LDS_BYTES=LDS_OST+NW*4096;
constexpr float C2=0.125f*1.4426950408889634f;
__device__ __forceinline__ void glds16(const void*gsrc,unsigned lds_dst){unsigned keep;
  asm volatile("s_mov_b32 %0, m0\n\ts_mov_b32 m0, %2\n\ts_nop 0\n\tglobal_load_lds_dwordx4 %1, off\n\ts_mov_b32 m0, %0":"=&s"(keep):"v"(gsrc),"s"(lds_dst):"memory");}
__device__ __forceinline__ float max3f(float a,float b,float c){float r;asm("v_max3_f32 %0, %1, %2, %3":"=v"(r):"v"(a),"v"(b),"v"(c));return r;}
__device__ __forceinline__ float max2f(float a,float b){float r;asm("v_max_f32_e32 %0, %1, %2":"=v"(r):"v"(a),"v"(b));return r;}
__device__ __forceinline__ float fadd_s(float a,float b){float r;asm("v_add_f32_e32 %0, %1, %2":"=v"(r):"v"(a),"v"(b));return r;}
__device__ __forceinline__ float fsub_s(float a,float b){float r;asm("v_sub_f32_e32 %0, %1, %2":"=v"(r):"v"(a),"v"(b));return r;}
typedef float f32x2_t __attribute__((ext_vector_type(2))); typedef __bf16 bf16x2_t __attribute__((ext_vector_type(2)));
__device__ __forceinline__ unsigned cvtpk_s(float lo,float hi){f32x2_t v={lo,hi};bf16x2_t b=__builtin_convertvector(v,bf16x2_t);return __builtin_bit_cast(unsigned,b);}
#define WAIT_BAR(N) asm volatile("s_waitcnt vmcnt(" #N ") lgkmcnt(0)\n\ts_barrier":::"memory")

__device__ __forceinline__ void qkt(f32x16&p0,f32x16&p1,const char*Kslot,const bf16x8*qr,int r32,int hi){
  const char*kb=Kslot+hi*1024+r32*16;
  #pragma unroll
  for(int d0=0;d0<4;++d0){
    const bf16x8 b0=*reinterpret_cast<const bf16x8*>(kb+d0*2048);
    const bf16x8 b1=*reinterpret_cast<const bf16x8*>(kb+d0*2048+512);
    p0=__builtin_amdgcn_mfma_f32_32x32x16_bf16(b0,qr[d0],p0,0,0,0);p1=__builtin_amdgcn_mfma_f32_32x32x16_bf16(b1,qr[d0],p1,0,0,0);}
}
typedef __attribute__((address_space(3))) const unsigned* lds_cuptr;
typedef float f32x4_t __attribute__((ext_vector_type(4)));
__device__ __forceinline__ unsigned bfr(float f){ unsigned u=__builtin_bit_cast(unsigned,f); return (u+0x7fffu+((u>>16)&1u))>>16; }
__device__ __forceinline__ void biasmm(f32x16&c0,f32x16&c1,unsigned w0,unsigned w1  ,unsigned qm1,int hi){
  const unsigned one=hi?0u:0x3f803f80u; w0=hi?0u:w0; w1=hi?0u:w1;
  const u32x4 k0={w0,one,0u,0u},k1={w1,one,0u,0u},qv={one,qm1,0u,0u};
  const f32x16 z=f32x16{};
  c0=__builtin_amdgcn_mfma_f32_32x32x16_bf16(__builtin_bit_cast(bf16x8,k0),__builtin_bit_cast(bf16x8,qv),z,0,0,0);
  c1=__builtin_amdgcn_mfma_f32_32x32x16_bf16(__builtin_bit_cast(bf16x8,k1),__builtin_bit_cast(bf16x8,qv),z,0,0,0);
}
typedef __attribute__((address_space(3))) const char* lds_cptr;
typedef short v4i16_t __attribute__((ext_vector_type(4)));
__device__ __forceinline__ void kload8(bf16x8*kf,lds_cptr kp){
  kf[0]=*(const __attribute__((address_space(3))) bf16x8*)(kp);      kf[1]=*(const __attribute__((address_space(3))) bf16x8*)(kp+512);
  kf[2]=*(const __attribute__((address_space(3))) bf16x8*)(kp+2048); kf[3]=*(const __attribute__((address_space(3))) bf16x8*)(kp+2560);
  kf[4]=*(const __attribute__((address_space(3))) bf16x8*)(kp+4096); kf[5]=*(const __attribute__((address_space(3))) bf16x8*)(kp+4608);
  kf[6]=*(const __attribute__((address_space(3))) bf16x8*)(kp+6144); kf[7]=*(const __attribute__((address_space(3))) bf16x8*)(kp+6656);
}
__device__ __forceinline__ void kload2(bf16x8*kf,lds_cptr kp,int j){ kf[2*j]=*(const __attribute__((address_space(3))) bf16x8*)(kp+j*2048); kf[2*j+1]=*(const __attribute__((address_space(3))) bf16x8*)(kp+j*2048+512); }
__device__ __forceinline__ s16x4 vtr(lds_cptr p){ return __builtin_bit_cast(s16x4,__builtin_amdgcn_ds_read_tr16_b64_v4i16((__attribute__((address_space(3))) v4i16_t*)p)); }
__device__ __forceinline__ float rowmax(const f32x16&p0,const f32x16&p1){
  float a=max3f(p0[0],p0[1],p1[0]),b=max3f(p0[2],p0[3],p1[1]);a=max3f(a,p1[2],p1[3]);
  #pragma unroll
  for(int r=4;r<16;r+=4){a=max3f(a,p0[r],p0[r+1]);b=max3f(b,p0[r+2],p0[r+3]);a=max3f(a,p1[r],p1[r+1]);b=max3f(b,p1[r+2],p1[r+3]);}
  const float m=max2f(a,b);
  auto rr=__builtin_amdgcn_permlane32_swap(__float_as_uint(m),__float_as_uint(m),false,false);
  return max2f(__uint_as_float(rr[0]),__uint_as_float(rr[1]));
}
__device__ __forceinline__ void pv(f32x16*o,int vb,bf16x8 pa0,bf16x8 pa1,bf16x8 pa2,bf16x8 pa3){
  #pragma unroll
  for(int d0=0;d0<2;++d0){s16x4 lo[4],hi[4];
    #pragma unroll
    for(int ks=0;ks<4;++ks){
      asm volatile("ds_read_b64_tr_b16 %0,%1 offset:%c2":"=&v"(lo[ks]):"v"(vb),"i"(d0*4096+ks*1024):"memory");
      asm volatile("ds_read_b64_tr_b16 %0,%1 offset:%c2":"=&v"(hi[ks]):"v"(vb),"i"(d0*4096+ks*1024+512):"memory");}
    asm volatile("s_waitcnt lgkmcnt(0)":::"memory");SBAR();
    #define PK(k) (bf16x8){lo[k][0],lo[k][1],lo[k][2],lo[k][3],hi[k][0],hi[k][1],hi[k][2],hi[k][3]}
    o[d0]=__builtin_amdgcn_mfma_f32_32x32x16_bf16(pa0,PK(0),o[d0],0,0,0);
    o[d0]=__builtin_amdgcn_mfma_f32_32x32x16_bf16(pa1,PK(1),o[d0],0,0,0);
    o[d0]=__builtin_amdgcn_mfma_f32_32x32x16_bf16(pa2,PK(2),o[d0],0,0,0);
    o[d0]=__builtin_amdgcn_mfma_f32_32x32x16_bf16(pa3,PK(3),o[d0],0,0,0);
    #undef PK
  }
}

__device__ __forceinline__ u32x4 mul_bf16x8(u32x4 a,u32x4 b){ u32x4 r;
  #pragma unroll
  for(int i=0;i<4;++i){ const float al=__uint_as_float(a[i]<<16),ah=__uint_as_float(a[i]&0xffff0000u),bl=__uint_as_float(b[i]<<16),bh=__uint_as_float(b[i]&0xffff0000u); r[i]=cvtpk_s(al*bl,ah*bh); }
  return r; }
#ifndef ATTN_STORE16
#define ATTN_STORE16(p,v) (*(u32x4*)(p)=(v))
#endif
template<int THRL> __device__ __forceinline__ void attn_unit(int b,int h,int qb,const bf16*Q,const bf16*__restrict__ K,const bf16*__restrict__ V,bf16*O,char*shm,lds_cuptr nb,int tskip,bool dry,int wave_id){
  int tid_=(int)__builtin_amdgcn_mbcnt_hi(~0u,__builtin_amdgcn_mbcnt_lo(~0u,0u)); asm volatile("":"+v"(tid_)); tid_+=wave_id*64; const int tid=tid_,lane=tid&63,r32=lane&31,hi=lane>>5; const int wid=__builtin_amdgcn_readfirstlane(tid>>6);
  const long rowbase=(long)b*SEQ; const int q0=qb*QB;
  const bf16*Qw=Q+(rowbase+q0+wid*QBLK)*DM+h*D;
  const bf16*Kh=K+(rowbase+(long)tskip*KVBLK)*DM+h*D,*Vh=V+(rowbase+(long)tskip*KVBLK)*DM+h*D;
  const unsigned lds0=(unsigned)(uintptr_t)shm;
  float*wsf=(float*)(shm+LDS_WS)+wid*64;
  const bf16*ksrc=Kh+(long)lane*DM+wid*8;
  const bf16*vsrc=Vh+(long)(16*(wid&3)+(lane>>2))*DM+(wid>>2)*32+(lane&3)*8;
  const unsigned kdst=lds0+LDS_K+wid*1024, vdst=lds0+LDS_V+wid*1024;
  #define DMA_K(t,slot) glds16(ksrc+(long)(t)*KVBLK*DM,(unsigned)__builtin_amdgcn_readfirstlane(kdst+(slot)))
  #define DMA_V(t,slot) glds16(vsrc+(long)(t)*KVBLK*DM,(unsigned)__builtin_amdgcn_readfirstlane(vdst+(slot)))
  const int vb0=(int)(lds0+LDS_V)+((lane>>4)&1)*32+(lane&3)*8+(4*hi+((lane&15)>>2))*64;
  const char*Kbase=shm+LDS_K; bf16x8 kf[8];
  const lds_cptr shm3=(lds_cptr)shm; const lds_cptr kp0=shm3+LDS_K+hi*1024+r32*16; const lds_cptr vp0=shm3+LDS_V+((lane>>4)&1)*32+(lane&3)*8+(4*hi+((lane&15)>>2))*64;
  const int NT=(q0+QB)/KVBLK-tskip;
  DMA_K(0,0);DMA_V(0,0);DMA_K(1,SLOTB);
  bf16x8 qr[4];
  #pragma unroll
  for(int d0=0;d0<4;++d0)qr[d0]=*reinterpret_cast<const bf16x8*>(&Qw[(long)r32*DM+d0*16+hi*8]);
  float mhat=0.f,l_reg=0.f;f32x16 o[2];o[0]=f32x16{};o[1]=f32x16{};unsigned qm1=0u;const lds_cuptr nbl=nb+64*tskip+r32;
  #define SETM(NEWM) do{ const float nm_=-(NEWM); const unsigned h_=bfr(nm_); const float hf_=__uint_as_float(h_<<16); const unsigned l_=bfr(nm_-hf_); mhat=-(hf_+__uint_as_float(l_<<16)); qm1=hi?0u:(h_|(l_<<16)); }while(0)
  const int qrel=wid*QBLK+r32;
  #define CMASK(P0,P1,t) do{int jb_=(t)-(NT-4); if(jb_>=0)cmask(P0,P1,jb_,qrel,hi);}while(0)
  bool resc=false;
  #define START(P0,P1) do{ const float rm=rowmax(P0,P1); resc=false; \
    { const float old_=mhat; SETM(old_+rm); const float dl=mhat-old_; \
      _Pragma("unroll") for(int r=0;r<16;++r){P0[r]=fsub_s(P0[r],dl);P1[r]=fsub_s(P1[r],dl);} } \
    _Pragma("unroll") for(int r=0;r<16;++r)P0[r]=__builtin_amdgcn_exp2f(P0[r]); }while(0)
  #define RESC() do{ if(resc){ asm volatile("s_waitcnt lgkmcnt(0)":::"memory"); \
      _Pragma("unroll") for(int d_=0;d_<2;++d_) _Pragma("unroll") for(int r=0;r<16;++r)o[d_][r]*=wsf[crow(r,hi)]; } }while(0)
  f32x16 pA0,pA1,pB0,pB1;
  int sl_prev=0,sl_cur=0,sl_next=SLOTB;
  #define ROT() do{sl_prev=sl_cur;sl_cur=sl_next;sl_next=(sl_next==(NSLOT-1)*SLOTB)?0:sl_next+SLOTB;}while(0)
  DMA_K(2,2*SLOTB);
  WAIT_BAR(3);
  unsigned bw0=nbl[0],bw1=nbl[32]; biasmm(pA0,pA1,bw0,bw1,qm1,hi); bw0=nbl[64]; bw1=nbl[96]; qkt(pA0,pA1,Kbase,qr,r32,hi);    asm volatile("s_nop 15\n\ts_nop 7":"+v"(pA0),"+v"(pA1));CMASK(pA0,pA1,0);
  START(pA0,pA1);
  _Pragma("unroll") for(int r=0;r<16;++r)pA1[r]=__builtin_amdgcn_exp2f(pA1[r]);
  WAIT_BAR(0);
  DMA_K(3,0);DMA_V(1,SLOTB);
  ROT();
  kload8(kf,kp0+sl_cur);
  WAIT_BAR(2);
  s16x4 vlo[8],vhi[8]; u32x4 pw0,pw1,pw2,pw3;
  #define PKW(P,B) cvtpk_s(P[B],P[B+1])
  #define PAF(k) __builtin_bit_cast(bf16x8,pw##k)
  #define VFR(i) (bf16x8){vlo[i][0],vlo[i][1],vlo[i][2],vlo[i][3],vhi[i][0],vhi[i][1],vhi[i][2],vhi[i][3]}
  #define PIN(x) asm volatile("":"+v"(x))
  #define MX3(a,b,c) __builtin_fmaxf(__builtin_fmaxf((a),(b)),(c))
  #define GAPA(MF,A0,A1,A2,A3,W0,W1,PW) do{ MF; sacc+=A0; sacc+=A1; sacc+=A2; sacc+=A3; PIN(sacc); W0; W1; PIN(PW); SBAR(); }while(0)
  #define EX(v) __builtin_amdgcn_exp2f(v)
  #define GAPB(MF,X,B) do{ MF; X[B]=EX(X[B]); X[B+1]=EX(X[B+1]); X[B+2]=EX(X[B+2]); X[B+3]=EX(X[B+3]); PIN(X); SBAR(); }while(0)
  #define VRD(i) do{ vlo[i]=vtr(vp_+(((i)>>2)*4096+((i)&3)*1024)); vhi[i]=vtr(vp_+(((i)>>2)*4096+((i)&3)*1024+512)); }while(0)
  #define KRD(G,j) do{ if(G){ kload2(kf,kp0+sl_next,j); SBAR(); } }while(0)
  #define STEP(C0,C1,P0,P1,t,GK,GV,GL) do{ SBAR(); \
    biasmm(C0,C1,bw0,bw1,qm1,hi); bw0=nbl[64*((t)+1)]; bw1=nbl[64*((t)+1)+32]; SBAR(); \
    const lds_cptr vp_=vp0+sl_prev; \
    VRD(0); SBAR(); float sacc=(P0[0]+P0[1]); \
    GAPA(C0=__builtin_amdgcn_mfma_f32_32x32x16_bf16(kf[0],qr[0],C0,0,0,0), P0[2],P0[3],P0[4],P0[5],     pw0[0]=PKW(P0,0), pw0[1]=PKW(P0,2), pw0); \
    VRD(4); SBAR(); GAPA(C1=__builtin_amdgcn_mfma_f32_32x32x16_bf16(kf[1],qr[0],C1,0,0,0), P0[6],P0[7],P0[8],P0[9],     pw0[2]=PKW(P0,4), pw0[3]=PKW(P0,6), pw0); \
    VRD(1); SBAR(); GAPA(C0=__builtin_amdgcn_mfma_f32_32x32x16_bf16(kf[2],qr[1],C0,0,0,0),   P0[10],P0[11],P0[12],P0[13], pw1[0]=PKW(P0,8), pw1[1]=PKW(P0,10), pw1); \
    VRD(5); SBAR(); GAPA(C1=__builtin_amdgcn_mfma_f32_32x32x16_bf16(kf[3],qr[1],C1,0,0,0),   P0[14],P0[15],P1[0],P1[1],   pw1[2]=PKW(P0,12),pw1[3]=PKW(P0,14), pw1); \
    VRD(2); SBAR(); GAPA(C0=__builtin_amdgcn_mfma_f32_32x32x16_bf16(kf[4],qr[2],C0,0,0,0),   P1[2],P1[3],P1[4],P1[5],     pw2[0]=PKW(P1,0), pw2[1]=PKW(P1,2), pw2); \
    VRD(6); SBAR(); GAPA(C1=__builtin_amdgcn_mfma_f32_32x32x16_bf16(kf[5],qr[2],C1,0,0,0),   P1[6],P1[7],P1[8],P1[9],     pw2[2]=PKW(P1,4), pw2[3]=PKW(P1,6), pw2); \
    VRD(3); SBAR(); GAPA(C0=__builtin_amdgcn_mfma_f32_32x32x16_bf16(kf[6],qr[3],C0,0,0,0),   P1[10],P1[11],P1[12],P1[13], pw3[0]=PKW(P1,8), pw3[1]=PKW(P1,10), pw3); \
    VRD(7); SBAR(); GAPA(C1=__builtin_amdgcn_mfma_f32_32x32x16_bf16(kf[7],qr[3],C1,0,0,0),   P1[14],P1[15],0.f,0.f,       pw3[2]=PKW(P1,12),pw3[3]=PKW(P1,14), pw3); \
    l_reg+=sacc; \
    if(GK){DMA_K((t)+3,sl_cur);} if(GV){DMA_V((t)+1,sl_next);} \
    CMASK(C0,C1,t); \
    { float a=MX3(C0[0],C0[1],C1[0]),b=MX3(C0[2],C0[3],C1[1]); a=MX3(a,C1[2],C1[3]); \
      _Pragma("unroll") for(int r=4;r<16;r+=4){a=MX3(a,C0[r],C0[r+1]);b=MX3(b,C0[r+2],C0[r+3]);a=MX3(a,C1[r],C1[r+1]);b=MX3(b,C1[r+2],C1[r+3]);} \
      float rm=__builtin_fmaxf(a,b); { auto rr=__builtin_amdgcn_permlane32_swap(__float_as_uint(rm),__float_as_uint(rm),false,false); rm=__builtin_fmaxf(__uint_as_float(rr[0]),__uint_as_float(rr[1])); } \
      resc=false; \
      if(__builtin_expect(__any(rm>(float)THRL),0)){ const float old_=mhat; SETM(old_+__builtin_fmaxf(rm,0.f)); const float dl=mhat-old_; \
        _Pragma("unroll") for(int r=0;r<16;++r){C0[r]-=dl;C1[r]-=dl;} \
        const float f=__builtin_amdgcn_exp2f(-dl); l_reg*=f; if(hi==0)wsf[r32]=f; resc=true; } } \
    SBAR(); \
    GAPB(o[0]=__builtin_amdgcn_mfma_f32_32x32x16_bf16(PAF(0),VFR(0),o[0],0,0,0), C0,0); \
    GAPB(o[1]=__builtin_amdgcn_mfma_f32_32x32x16_bf16(PAF(0),VFR(4),o[1],0,0,0), C0,4); \
    KRD(GL,0); GAPB(o[0]=__builtin_amdgcn_mfma_f32_32x32x16_bf16(PAF(1),VFR(1),o[0],0,0,0), C0,8); \
    KRD(GL,1); GAPB(o[1]=__builtin_amdgcn_mfma_f32_32x32x16_bf16(PAF(1),VFR(5),o[1],0,0,0), C0,12); \
    KRD(GL,2); GAPB(o[0]=__builtin_amdgcn_mfma_f32_32x32x16_bf16(PAF(2),VFR(2),o[0],0,0,0), C1,0); \
    KRD(GL,3); GAPB(o[1]=__builtin_amdgcn_mfma_f32_32x32x16_bf16(PAF(2),VFR(6),o[1],0,0,0), C1,4); \
    GAPB(o[0]=__builtin_amdgcn_mfma_f32_32x32x16_bf16(PAF(3),VFR(3),o[0],0,0,0), C1,8); \
    GAPB(o[1]=__builtin_amdgcn_mfma_f32_32x32x16_bf16(PAF(3),VFR(7),o[1],0,0,0), C1,12); \
    }while(0)
  int t=1;
  #undef CMASK
  #define CMASK(P0,P1,t) do{}while(0)
  for(;t+5<NT;t+=2){
    STEP(pB0,pB1,pA0,pA1,t,true,true,true);     WAIT_BAR(2); RESC(); ROT();
    STEP(pA0,pA1,pB0,pB1,t+1,true,true,true);   WAIT_BAR(2); RESC(); ROT();
  }
  #undef CMASK
  #define CMASK(P0,P1,t) do{int jb_=(t)-(NT-4); if(jb_>=0)cmask(P0,P1,jb_,qrel,hi);}while(0)
  #define ENDW(tt) do{ if((tt)+3<NT){WAIT_BAR(2);} else if((tt)+2<NT){WAIT_BAR(1);} else {WAIT_BAR(0);} }while(0)
  for(;t+1<NT;t+=2){
    STEP(pB0,pB1,pA0,pA1,t,(t+3<NT),(t+1<NT),(t+1<NT));       ENDW(t);   RESC(); ROT();
    STEP(pA0,pA1,pB0,pB1,t+1,(t+4<NT),(t+2<NT),(t+2<NT));     ENDW(t+1); RESC(); ROT();
  }
  STEP(pB0,pB1,pA0,pA1,NT-1,false,false,false); RESC();
  { float sacc=pB0[0]+pB0[1]; _Pragma("unroll") for(int r=2;r<16;++r)sacc+=pB0[r]; _Pragma("unroll") for(int r=0;r<16;++r)sacc+=pB1[r]; l_reg+=sacc;
    pw0=(u32x4){PKW(pB0,0),PKW(pB0,2),PKW(pB0,4),PKW(pB0,6)};pw1=(u32x4){PKW(pB0,8),PKW(pB0,10),PKW(pB0,12),PKW(pB0,14)};pw2=(u32x4){PKW(pB1,0),PKW(pB1,2),PKW(pB1,4),PKW(pB1,6)};pw3=(u32x4){PKW(pB1,8),PKW(pB1,10),PKW(pB1,12),PKW(pB1,14)};
    SBAR(); pv(o,vb0+sl_cur,PAF(0),PAF(1),PAF(2),PAF(3)); }
  #undef PKW
  #undef PAF
  #undef VFR
  #undef PIN
  #undef MX3
  #undef GAPA
  #undef GAPB
  #undef EX
  #undef VRD
  #undef KRD
  #undef STEP
  #undef ENDW
  {auto rr=__builtin_amdgcn_permlane32_swap(__float_as_uint(l_reg),__float_as_uint(l_reg),false,false);l_reg=__uint_as_float(rr[0])+__uint_as_float(rr[1]);}
  if(hi==0)wsf[32+r32]=l_reg;asm volatile("s_waitcnt lgkmcnt(0)":::"memory");
  float rli[16];
  #pragma unroll
  for(int r=0;r<16;++r)rli[r]=__builtin_amdgcn_rcpf(wsf[32+crow(r,hi)]);
  bf16*Ow=O+(rowbase+q0+wid*QBLK)*(long)OPITCH+OCOL0+h*D;
  { bf16*stg=(bf16*)(shm+LDS_OST)+wid*2048;
    #pragma unroll
    for(int r=0;r<16;++r){const int orow=crow(r,hi);
      #pragma unroll
      for(int d0=0;d0<2;++d0)stg[orow*64+d0*32+r32]=__float2bfloat16(o[d0][r]*rli[r]);}
    asm volatile("s_waitcnt lgkmcnt(0)":::"memory");
    #pragma unroll
    for(int i=0;i<4;++i){const int row=i*8+(lane>>3),ch=lane&7; const u32x4 v=*(const u32x4*)(stg+row*64+ch*8); bf16*gp=Ow+(long)row*OPITCH+ch*8; const u32x4 gt=*(const u32x4*)gp; if(!dry){ATTN_STORE16(gp,mul_bf16x8(v,gt));}} }
  asm volatile("s_waitcnt lgkmcnt(0)\n\ts_barrier":::"memory");
  #undef DMA_K
  #undef DMA_V
  #undef CMASK
  #undef START
  #undef RESC
  #undef ROT
  #undef SETM
}
constexpr int ATTN_LDS_BYTES=LDS_BYTES;
#undef SBAR
#undef WAIT_BAR
}
constexpr int BATCH = 4, SEQ = 8192, DMODEL = 1024, M = BATCH * SEQ, DEPTH = 2, INC = 7852;
constexpr int NT_A = 19, NT_B = 12, NTILES = NT_A + NT_B;
constexpr int SA_Q = 0, SA_K = 512, SA_V = 640, SA_G = 768, SB_Q = 1280, SB_K = 1792, SB_V = 1920, SB_IQ = 2048, SB_IK = 2176, SB_IW = 2208, SB_G = 2212,
              SC_Q = 2724, SC_K = 3236, SC_V = 3748, SC_F = 4260, SC_G = 4268, S_MG = 4780;
static_assert(S_MG + 3072 == INC, "column partition");
__host__ __device__ __forceinline__ int src_col(int t, int lc) {
    switch (t) {
        case 0: case 1: return SA_Q + t * 256 + lc;
        case 2: case 3: return SB_Q + (t - 2) * 256 + lc;
        case 4: case 5: return SC_Q + (t - 4) * 256 + lc;
        case 6: return lc < 128 ? SA_K + lc : SB_K + lc - 128;
        case 7: case 8: return SC_K + (t - 7) * 256 + lc;
        case 9: return lc < 128 ? SA_V + lc : SB_V + lc - 128;
        case 10: case 11: return SC_V + (t - 10) * 256 + lc;
        case 12: case 13: return SA_G + (t - 12) * 256 + lc;
        case 14: case 15: return SB_G + (t - 14) * 256 + lc;
        case 16: case 17: return SC_G + (t - 16) * 256 + lc;
        case 18: return lc < 128 ? SB_IQ + lc : lc < 160 ? SB_IK + lc - 128 : lc < 164 ? SB_IW + lc - 160 : lc < 172 ? SC_F + lc - 164 : -1;
        default: return S_MG + (t - 19) * 256 + lc;
    }
}
constexpr size_t MiB = 1u << 20;
constexpr size_t WS_CTL = 0, CTL_ZERO_BYTES = 1 * MiB;
constexpr size_t WS_W1T = 2 * MiB;
constexpr size_t WS_WBT = 33 * MiB;
constexpr size_t WS_WOT = 39 * MiB;
constexpr size_t WS_SSQ = 43 * MiB;
constexpr size_t WS_CL = 45 * MiB;
constexpr size_t WS_CT = 46 * MiB;
constexpr size_t WS_IW = 47 * MiB;
constexpr size_t WS_CF = 47 * MiB + 512 * 1024;
constexpr size_t WS_IQ = 49 * MiB;
constexpr size_t WS_IK = 57 * MiB;
constexpr size_t WS_XB = 60 * MiB;
constexpr size_t WS_MERGED = 124 * MiB;
constexpr size_t WS_G = 188 * MiB;
constexpr size_t WS_QA = 284 * MiB, WS_QB = 316 * MiB, WS_QC = 348 * MiB, WS_KC = 380 * MiB, WS_VC = 412 * MiB, WS_KAB = 444 * MiB, WS_VAB = 460 * MiB;
constexpr size_t WS_MG = 284 * MiB;
constexpr size_t WS_END = 476 * MiB;
static_assert(pg8::EWS_SSQ == WS_SSQ && pg8::EWS_IW == WS_IW && pg8::EWS_CF == WS_CF && pg8::EWS_IQ == WS_IQ && pg8::EWS_IK == WS_IK && pg8::EWS_G == WS_G && pg8::EWS_QA == WS_QA && pg8::EWS_QB == WS_QB &&
              pg8::EWS_QC == WS_QC && pg8::EWS_KC == WS_KC && pg8::EWS_VC == WS_VC && pg8::EWS_KAB == WS_KAB && pg8::EWS_VAB == WS_VAB, "epilogue offsets");
constexpr int CW_OVF = 8;
constexpr int CW_TICK = 8192;
constexpr int CW_BAR = 4096;
constexpr int RING_OFF = 0, RING_BYTES = 131072;
constexpr int SEL_OFF = 131072;
constexpr int H2_OFF = SEL_OFF + 8192;
constexpr int BIAS_OFF = H2_OFF + 8192;
constexpr int BKT_OFF = BIAS_OFF + 2048;
constexpr int MISC_OFF = BKT_OFF + 512;
constexpr int LDS_BYTES = 155648;
static_assert(MISC_OFF + 1024 <= LDS_BYTES, "LDS map");
constexpr int NB_OFF = 86016;
static_assert(attn_body::ATTN_LDS_BYTES <= NB_OFF && NB_OFF + 32768 <= RING_BYTES, "LDS map");
constexpr int MW_NSEL = 0, MW_NCAND = 16, MW_BIN = 32, MW_ABOVE = 48, MW_CARRY = 64, MW_BAR = 96, MW_SLOW = 100, MW_TICKET = 101, MW_ZCUT = 112, MW_UC = 128, MW_ELO = 160;

#define GAS __attribute__((address_space(1)))
#define LAS __attribute__((address_space(3)))
typedef unsigned short bf16;
typedef unsigned v4u __attribute__((ext_vector_type(4)));
typedef float f32x4 __attribute__((ext_vector_type(4)));
typedef short bf16x8 __attribute__((ext_vector_type(8)));
typedef GAS unsigned gu32;
#define RLX_AGENT __ATOMIC_RELAXED, __HIP_MEMORY_SCOPE_AGENT
#define LDS_WAIT() asm volatile("s_waitcnt lgkmcnt(0)" ::: "memory")
#define VM_WAIT() asm volatile("s_waitcnt vmcnt(0)" ::: "memory")
__device__ __forceinline__ unsigned f2bf(float f) { unsigned u = __builtin_bit_cast(unsigned, f); return (u + 0x7fffu + ((u >> 16) & 1u)) >> 16; }
__device__ __forceinline__ unsigned pk2(float lo, float hi) { return f2bf(lo) | (f2bf(hi) << 16); }

#define XB_TMO      128
#define XB_XCNT(j)  (256  + 64 * (j))
#define XB_XSUB(j)  (1280 + 64 * (j))
#define XB_XGEN(j)  (2304 + 64 * (j))
#define XB_TOP      3328
#define XB_TOPGEN   3392
#define XCD_BAR_WORDS 3456
#define XB_SPIN_CAP (1u << 18)

__device__ __forceinline__ unsigned xb_ld(unsigned* p)              { return __hip_atomic_load(p, __ATOMIC_RELAXED, __HIP_MEMORY_SCOPE_AGENT); }
__device__ __forceinline__ unsigned xb_add(unsigned* p, unsigned v) { return __hip_atomic_fetch_add(p, v, __ATOMIC_RELAXED, __HIP_MEMORY_SCOPE_AGENT); }
__device__ __forceinline__ unsigned xb_xcc_id() { return (unsigned)__builtin_amdgcn_s_getreg((3 << 11) | 20) & 0xFu; }
#define XB_SPIN(cond, bar) do { unsigned _sp = 0; while (cond) { __builtin_amdgcn_s_sleep(1); \
    if ((++_sp & 255u) == 0u) { if (xb_ld(&(bar)[XB_TMO])) break; if (_sp > XB_SPIN_CAP) { atomicAdd(&(bar)[XB_TMO], 1u); break; } } } } while (0)

struct XcdBarrier {
    unsigned* bar; unsigned x;
    volatile LAS unsigned* st;
};

__device__ __forceinline__ XcdBarrier xcd_barrier_post(unsigned* bar, volatile LAS unsigned* st) {
    XcdBarrier b; b.bar = bar; b.x = xb_xcc_id(); b.st = st;
    if (threadIdx.x == 0) (void)xb_add(&bar[XB_XCNT(b.x)], 1u);
    return b;
}
__device__ __forceinline__ void xcd_barrier_complete(unsigned* bar, unsigned x, unsigned& nloc, unsigned& nx) {
    const unsigned G = gridDim.x * gridDim.y * gridDim.z;
    unsigned sum, cnt, mine, sp = 0u;
    for (;;) {
        sum = 0u; cnt = 0u; mine = 0u;
#pragma unroll
        for (unsigned j = 0; j < 16; ++j) { const unsigned c = xb_ld(&bar[XB_XCNT(j)]); sum += c; cnt += (c > 0u) ? 1u : 0u; mine = (j == x) ? c : mine; }
        if (sum == G) break;
        __builtin_amdgcn_s_sleep(1);
        if ((++sp & 255u) == 0u) { if (xb_ld(&bar[XB_TMO])) break; if (sp > XB_SPIN_CAP) { atomicAdd(&bar[XB_TMO], 1u); break; } }
    }
    nloc = mine > 0u ? mine : 1u; nx = cnt > 0u ? cnt : 1u;
}

__device__ __forceinline__ void xcd_barrier(const XcdBarrier& b) {
    asm volatile("s_waitcnt vmcnt(0)" ::: "memory");
    __syncthreads();
    if (threadIdx.x == 0) {
        unsigned* bar = b.bar;
        __builtin_amdgcn_s_waitcnt(0);
        unsigned nloc = b.st[0], nx = b.st[1];
        if (nloc == 0u) { xcd_barrier_complete(bar, b.x, nloc, nx); b.st[0] = nloc; b.st[1] = nx; }
        const unsigned old = xb_add(&bar[XB_XSUB(b.x)], 1u);
        const unsigned gen = old / nloc;
        if (old + 1u == (gen + 1u) * nloc) {
            __builtin_amdgcn_fence(__ATOMIC_RELEASE, "agent");
            asm volatile("s_waitcnt vmcnt(0)" ::: "memory");
            const unsigned og = xb_add(&bar[XB_TOP], 1u);
            const unsigned tg = og / nx;
            if (og + 1u == (tg + 1u) * nx) xb_add(&bar[XB_TOPGEN], 1u);
            else XB_SPIN(xb_ld(&bar[XB_TOPGEN]) == tg, bar);
            __builtin_amdgcn_fence(__ATOMIC_ACQUIRE, "agent");
            xb_add(&bar[XB_XGEN(b.x)], 1u);
            asm volatile("s_waitcnt vmcnt(0)" ::: "memory");
        } else {
            XB_SPIN(xb_ld(&bar[XB_XGEN(b.x)]) == gen, bar);
            __builtin_amdgcn_fence(__ATOMIC_ACQUIRE, "agent");
            asm volatile("s_waitcnt vmcnt(0)" ::: "memory");
        }
    }
    __syncthreads();
}

struct Frame {
    LAS unsigned char* lds;
    volatile LAS unsigned* MISC;
    gu32* ctl;
    int tid, lane, wave, vcu, G;
};
__device__ __forceinline__ float wave_sum(float v) {
#pragma unroll
    for (int o = 1; o < 64; o <<= 1) v += __shfl_xor(v, o);
    return v;
}
__device__ __forceinline__ float wave_incl_scan(float v, int lane) {
#pragma unroll
    for (int o = 1; o < 64; o <<= 1) { const float t = __shfl_up(v, o); if (lane >= o) v += t; }
    return v;
}
__device__ __forceinline__ int wave_incl_scan_i(int v, int lane) {
#pragma unroll
    for (int o = 1; o < 64; o <<= 1) { const int t = __shfl_up(v, o); if (lane >= o) v += t; }
    return v;
}
__device__ __forceinline__ void transpose_item(const float* W, int N, bf16* WT, int K, int n0, int k0, int scol, const float* kscale, LAS float* scr, int lane) {
#pragma unroll 8
    for (int i = 0; i < 32; ++i) { const int kk = 2 * i + (lane >> 5); float v = 0.f;
        if (scol >= 0) { v = W[(size_t)(k0 + kk) * N + scol]; if (kscale) v *= kscale[k0 + kk]; }
        scr[kk * 33 + (lane & 31)] = v; }
    LDS_WAIT(); asm volatile("" ::: "memory");
    const int c = lane & 7;
#pragma unroll
    for (int j = 0; j < 4; ++j) { const int n = (lane >> 3) + 8 * j; const LAS float* s = scr + (8 * c) * 33 + n;
        v4u o; o.x = pk2(s[0 * 33], s[1 * 33]); o.y = pk2(s[2 * 33], s[3 * 33]); o.z = pk2(s[4 * 33], s[5 * 33]); o.w = pk2(s[6 * 33], s[7 * 33]);
        *(GAS v4u*)(WT + (size_t)(n0 + n) * K + k0 + 8 * c) = o; }
    LDS_WAIT(); asm volatile("" ::: "memory");
}
__device__ __forceinline__ void p0_prologue(Frame& F, const float* x, const float* norm_gain, const float* w_in, const float* w_branch, const float* w_out, unsigned char* ws) {
    LAS float* scr = (LAS float*)(F.lds + RING_OFF + F.wave * 16384);
    const int gw = F.vcu * 8 + F.wave, NGW = F.G * 8, lane = F.lane;
    constexpr int I_W1 = 16 * (NTILES * 256 / 32), I_WB = 8 * 32, I_WO = 16 * 32;
    constexpr int NITEMS = DEPTH * I_W1 + DEPTH * 3 * I_WB + DEPTH * I_WO;
    for (int it = gw; it < NITEMS; it += NGW) {
        int r = it;
        if (r < DEPTH * I_W1) { const int L = r / I_W1; r -= L * I_W1; const int nblk = NTILES * 8, kb = r / nblk, nb = r % nblk, n0 = nb * 32, tile = n0 >> 8, p = (n0 & 255) + (lane & 31);
            const int lc = 64 * ((p >> 5) & 3) + 32 * (p >> 7) + (p & 31);
            transpose_item(w_in + (size_t)L * DMODEL * INC, INC, (bf16*)(ws + WS_W1T) + (size_t)L * NTILES * 256 * 1024, 1024, n0, kb * 64, src_col(tile, lc), norm_gain + L * DMODEL, scr, lane); continue; }
        r -= DEPTH * I_W1;
        if (r < DEPTH * 3 * I_WB) { const int mat = r / I_WB; r -= mat * I_WB; const int kb = r / 32, nb = r % 32;
            transpose_item(w_branch + (size_t)mat * 512 * 1024, 1024, (bf16*)(ws + WS_WBT) + (size_t)mat * 1024 * 512, 512, nb * 32, kb * 64, nb * 32 + (lane & 31), nullptr, scr, lane); continue; }
        r -= DEPTH * 3 * I_WB;
        { const int L = r / I_WO; r -= L * I_WO; const int kb = r / 32, nb = r % 32;
            transpose_item(w_out + (size_t)L * 1024 * 1024, 1024, (bf16*)(ws + WS_WOT) + (size_t)L * 1024 * 1024, 1024, nb * 32, kb * 64, nb * 32 + (lane & 31), nullptr, scr, lane); }
    }
    bf16* XB = (bf16*)(ws + WS_XB); float* SSQ = (float*)(ws + WS_SSQ);
    for (int m = gw; m < M; m += NGW) {
        const GAS f32x4* xr = (const GAS f32x4*)(x + (size_t)m * DMODEL) + lane; f32x4 v[4]; float s = 0.f;
#pragma unroll
        for (int j = 0; j < 4; ++j) { v[j] = xr[64 * j]; s += (v[j].x * v[j].x + v[j].y * v[j].y) + (v[j].z * v[j].z + v[j].w * v[j].w); }
        const float tot = wave_sum(s);
        GAS unsigned long long* o8 = (GAS unsigned long long*)(XB + (size_t)m * DMODEL) + lane;
#pragma unroll
        for (int j = 0; j < 4; ++j) o8[64 * j] = (unsigned long long)pk2(v[j].x, v[j].y) | ((unsigned long long)pk2(v[j].z, v[j].w) << 32);
        if (lane < 16) SSQ[(size_t)m * 16 + lane] = lane == 0 ? tot : 0.f;
    }
}
__device__ __forceinline__ void scan_phase(Frame& F, const float* CF, const float* bforget  , float* CL, float* CT) {
    const int lane = F.lane, h = F.wave;
    for (int u = blockIdx.x; u < 128; u += F.G) { const int b = u >> 5, j = u & 31; const size_t row = (size_t)b * SEQ + 256 * j + 4 * lane; const float bf = bforget[h];
        float s[4]; float run = 0.f;
#pragma unroll
        for (int e = 0; e < 4; ++e) { const float xx = CF[(row + e) * 8 + h] + bf; const float lf = (xx < 0.f ? xx : 0.f) - __logf(1.0f + __expf(-fabsf(xx))); run += lf; s[e] = run; }
        const float incl = wave_incl_scan(run, lane), excl = incl - run;
        *(f32x4*)(CL + (size_t)(b * 8 + h) * SEQ + 256 * j + 4 * lane) = (f32x4){excl + s[0], excl + s[1], excl + s[2], excl + s[3]};
        if (lane == 63) CT[(b * 8 + h) * 32 + j] = incl;
    }
}
#ifndef REP_IDX
#define REP_IDX 1
#endif
#ifndef REP_SPB
#define REP_SPB 1
#endif
#ifndef REP_SPA
#define REP_SPA 1
#endif
typedef unsigned u32x2 __attribute__((ext_vector_type(2)));
constexpr int NBIN = 1024;
__device__ __forceinline__ float pdist(float s, float sc, float inv) { return (s - sc) * inv + 0.0f; }
__device__ __forceinline__ unsigned pbin_d(float d) { const unsigned a = __float_as_uint(d) & 0x7fffffffu;
    int fx = (int)(a >> 19) - 1647; fx = fx < 0 ? 0 : (fx > 511 ? 511 : fx);
    return (__float_as_uint(d) >> 31) ? 511u - (unsigned)fx : 512u + (unsigned)fx; }
__device__ __forceinline__ unsigned pbin(float s, float sc, float inv) { return pbin_d(pdist(s, sc, inv)); }
__device__ __forceinline__ float pedge(int b) {
    if (b >= NBIN) return INFINITY; if (b <= 0) return -INFINITY;
    if (b > 512) return __uint_as_float((unsigned)(b - 512 + 1647) << 19);
    if (b == 512) return 0.0f;
    return -__uint_as_float(((unsigned)(511 - b + 1648) << 19) - 1u);
}
constexpr int CMAX = 1024;
#define LDS_ADD(p, v) __hip_atomic_fetch_add((p), (v), __ATOMIC_RELAXED, __HIP_MEMORY_SCOPE_WORKGROUP)
__device__ __forceinline__ unsigned okey(float s) { const unsigned u = __float_as_uint(s); return (u & 0x80000000u) ? ~u : (u | 0x80000000u); }
struct BAParams { const bf16 *IQ, *IK; const float* IW; const bf16 *QA, *QB, *KAB, *VAB; bf16* G; const float* sinks; };
__device__ __forceinline__ float relu_f(float x) { const int i = __float_as_int(x); return __int_as_float(i > 0 ? i : 0); }

template <int PASS, bool DIAG> __device__ __forceinline__ void idx_tile(const bf16x8 ak, const bf16x8 (&bq)[4], const f32x4 w4, int kt, int g4, int r, int tq, float elo, float ehi,
                                                                       LAS unsigned* hl, unsigned lp, unsigned hinc, LAS u32x2* cand, LAS unsigned short* sel, LAS unsigned* misc, LAS unsigned* zh, int zcut, float sc, float inv) {
    const f32x4 z = {0.f, 0.f, 0.f, 0.f};
    const f32x4 d0 = __builtin_amdgcn_mfma_f32_16x16x32_bf16(ak, bq[0], z, 0, 0, 0), d1 = __builtin_amdgcn_mfma_f32_16x16x32_bf16(ak, bq[1], z, 0, 0, 0),
                d2 = __builtin_amdgcn_mfma_f32_16x16x32_bf16(ak, bq[2], z, 0, 0, 0), d3 = __builtin_amdgcn_mfma_f32_16x16x32_bf16(ak, bq[3], z, 0, 0, 0);
    float sv[4]; bool qs[4], qc[4]; unsigned n1 = 0, n2 = 0;
#pragma unroll
    for (int i = 0; i < 4; ++i) {
        float s = 0.f; s = fmaf(w4[0], relu_f(d0[i]), s); s = fmaf(w4[1], relu_f(d1[i]), s); s = fmaf(w4[2], relu_f(d2[i]), s); s = fmaf(w4[3], relu_f(d3[i]), s);
        const int key = 16 * kt + 4 * g4 + i; sv[i] = s; const bool ok = !DIAG || key <= tq; const float d = pdist(s, sc, inv);
        if (PASS == 1) { if (ok) { const unsigned bin = pbin_d(d); LDS_ADD(hl + (bin * 32u + (lp ^ (bin & 31u))), hinc); if (s == 0.0f) LDS_ADD(zh + (key >> 7), 1u); } }
        else { qs[i] = ok && d >= ehi; qc[i] = ok && !(d >= ehi) && d >= elo && (s != 0.0f || key < zcut)  ;
               n1 += qs[i] ? 1u : 0u; n2 += qc[i] ? 1u : 0u; }
    }
    if (PASS == 2) {
        const unsigned add = n1 | (n2 << 16);
        if (add) { const unsigned pos = LDS_ADD(misc + MW_NSEL + r, add); unsigned p1 = pos & 0xffffu, p2 = pos >> 16;
#pragma unroll
            for (int i = 0; i < 4; ++i) { const int key = 16 * kt + 4 * g4 + i;
                if (qs[i]) { if (p1 < 256u) sel[p1] = (unsigned short)key; ++p1; }
                if (qc[i]) { if (p2 < (unsigned)CMAX) cand[p2] = (u32x2){okey(sv[i]), (unsigned)key}; ++p2; } } }
    }
}
template <int PASS> __device__ __forceinline__ void idx_pass(Frame& F, const bf16* IKb, const bf16x8 (&bq)[4], const f32x4 w4, int tau, int t0) {
    int lane_ = F.lane; asm volatile("" : "+v"(lane_)); const int lane = lane_, r = lane & 15, g4 = lane >> 4, tq = t0 + r;
    LAS unsigned* hl = (LAS unsigned*)(F.lds + RING_OFF); const unsigned lp = (unsigned)lane >> 1, hinc = 1u << ((lane & 1) * 16);
    LAS u32x2* cand = (LAS u32x2*)(F.lds + RING_OFF) + r * CMAX;
    LAS unsigned short* sel = (LAS unsigned short*)(F.lds + SEL_OFF) + r * 256;
    LAS unsigned* misc = (LAS unsigned*)(F.lds + MISC_OFF);
    float elo = 0.f, ehi = 0.f; int zcut = SEQ; if (PASS == 2) { elo = __uint_as_float(misc[MW_ELO + r]); ehi = __uint_as_float(misc[MW_ELO + 16 + r]); zcut = (int)misc[MW_ZCUT + r]; }
    LAS unsigned* zh = (LAS unsigned*)(F.lds + H2_OFF) + r * 64;
    const bf16* kp = IKb + (size_t)r * 32 + 8 * g4;
    float sc, inv; { const bf16x8 at = *(const bf16x8*)kp; const f32x4 z = {0.f, 0.f, 0.f, 0.f};
        const f32x4 d0 = __builtin_amdgcn_mfma_f32_16x16x32_bf16(at, bq[0], z, 0, 0, 0), d1 = __builtin_amdgcn_mfma_f32_16x16x32_bf16(at, bq[1], z, 0, 0, 0),
                    d2 = __builtin_amdgcn_mfma_f32_16x16x32_bf16(at, bq[2], z, 0, 0, 0), d3 = __builtin_amdgcn_mfma_f32_16x16x32_bf16(at, bq[3], z, 0, 0, 0);
        float mx = -INFINITY, ma = 0.f;
#pragma unroll
        for (int i = 0; i < 4; ++i) { float s = 0.f; s = fmaf(w4[0], relu_f(d0[i]), s); s = fmaf(w4[1], relu_f(d1[i]), s); s = fmaf(w4[2], relu_f(d2[i]), s); s = fmaf(w4[3], relu_f(d3[i]), s); mx = fmaxf(mx, s); ma = fmaxf(ma, fabsf(s)); }
        mx = fmaxf(mx, __shfl_xor(mx, 16)); mx = fmaxf(mx, __shfl_xor(mx, 32)); ma = fmaxf(ma, __shfl_xor(ma, 16)); ma = fmaxf(ma, __shfl_xor(ma, 32));
        sc = mx; inv = (ma > 1e-30f && ma < 1e30f) ? 1.0f / ma : 1.0f;
        if (PASS == 1 && F.wave == 0 && g4 == 0) { misc[MW_UC + r] = __float_as_uint(sc); misc[MW_UC + 16 + r] = __float_as_uint(inv); } }
    int kt = F.wave; if (kt > tau) return;
    bf16x8 a0 = *(const bf16x8*)(kp + (size_t)kt * 512);
    bf16x8 a1 = *(const bf16x8*)(kp + (size_t)(kt + 8 <= tau ? kt + 8 : kt) * 512);
    for (; kt <= tau; kt += 8) {
        const int k2 = kt + 16 <= tau ? kt + 16 : kt; const bf16x8 a2 = *(const bf16x8*)(kp + (size_t)k2 * 512);
        if (kt < tau) idx_tile<PASS, false>(a0, bq, w4, kt, g4, r, tq, elo, ehi, hl, lp, hinc, cand, sel, misc, zh, zcut, sc, inv);
        else          idx_tile<PASS, true>(a0, bq, w4, kt, g4, r, tq, elo, ehi, hl, lp, hinc, cand, sel, misc, zh, zcut, sc, inv);
        a0 = a1; a1 = a2;
    }
}
__device__ __forceinline__ void idx_threshold(Frame& F) {
    int lane_ = F.lane; asm volatile("" : "+v"(lane_)); const int lane = lane_; LAS unsigned* misc = (LAS unsigned*)(F.lds + MISC_OFF);
    for (int qq = 0; qq < 2; ++qq) { const int q = 2 * F.wave + qq; const unsigned sh = (q & 1) * 16, qh = (unsigned)q >> 1;
        const LAS unsigned* hb = (const LAS unsigned*)(F.lds + RING_OFF);
        int cnt[16];
#pragma unroll
        for (int k = 0; k < 16; ++k) { const unsigned bin = 64u * k + lane, sw = bin & 31u; const LAS unsigned* p = hb + bin * 32u;
            cnt[k] = (int)(((p[qh ^ sw] >> sh) & 0xffffu) + ((p[(qh + 8u) ^ sw] >> sh) & 0xffffu) + ((p[(qh + 16u) ^ sw] >> sh) & 0xffffu) + ((p[(qh + 24u) ^ sw] >> sh) & 0xffffu)); }
        int a8[8], a4[4], a2[2], a1;
        { const bool h5 = lane & 32, h4 = lane & 16, h3 = lane & 8, h2 = lane & 4;
#pragma unroll
          for (int i = 0; i < 8; ++i) { const int mine = h5 ? cnt[8 + i] : cnt[i], theirs = h5 ? cnt[i] : cnt[8 + i]; a8[i] = mine + __shfl_xor(theirs, 32); }
#pragma unroll
          for (int i = 0; i < 4; ++i) { const int mine = h4 ? a8[4 + i] : a8[i], theirs = h4 ? a8[i] : a8[4 + i]; a4[i] = mine + __shfl_xor(theirs, 16); }
#pragma unroll
          for (int i = 0; i < 2; ++i) { const int mine = h3 ? a4[2 + i] : a4[i], theirs = h3 ? a4[i] : a4[2 + i]; a2[i] = mine + __shfl_xor(theirs, 8); }
          { const int mine = h2 ? a2[1] : a2[0], theirs = h2 ? a2[0] : a2[1]; a1 = mine + __shfl_xor(theirs, 4); }
          a1 += __shfl_xor(a1, 1); a1 += __shfl_xor(a1, 2); }
        int ks = 0, aseg = 0, v = cnt[0]; { int cum = 0; bool found = false;
#pragma unroll
            for (int k = 15; k >= 0; --k) { const int Tk = __builtin_amdgcn_readlane(a1, 4 * k); if (!found && cum + Tk >= 256) { found = true; ks = k; aseg = cum; v = cnt[k]; } cum += Tk; } }
        const int pre = wave_incl_scan_i(v, lane);
        int tot = pre; tot = __shfl(tot, 63);
        const int suf = tot - pre + v;
        const unsigned long long mask = __ballot(aseg + suf >= 256);
        const int Ls = mask ? 63 - (int)__builtin_clzll(mask) : 0;
        if (lane == Ls) { const int bs = 64 * ks + lane; misc[MW_BIN + q] = (unsigned)bs; misc[MW_ABOVE + q] = (unsigned)(aseg + suf - v);
                          misc[MW_ELO + q] = __float_as_uint(pedge(bs)); misc[MW_ELO + 16 + q] = __float_as_uint(pedge(bs + 1)); }
        { const int binstar = __shfl(64 * ks + lane, Ls), needz = 256 - __shfl(aseg + suf - v, Ls);
          const int zc = (int)((const LAS unsigned*)(F.lds + H2_OFF))[q * 64 + lane]; const int zi = wave_incl_scan_i(zc, lane);
          const unsigned long long zm = __ballot(zi >= needz);
          if (lane == 0) misc[MW_ZCUT + q] = (binstar == (int)pbin(0.0f, __uint_as_float(misc[MW_UC + q]), __uint_as_float(misc[MW_UC + 16 + q])) && zm) ? (unsigned)(128 * ((int)__builtin_ctzll(zm) + 1)) : (unsigned)SEQ; }
    }
}
__device__ __forceinline__ unsigned idx_digit(const u32x2 e, int lvl) { const unsigned v = 8191u - e.y;
    return lvl == 0 ? e.x >> 24 : lvl == 1 ? (e.x >> 16) & 255u : lvl == 2 ? (e.x >> 8) & 255u : lvl == 3 ? e.x & 255u : lvl == 4 ? (v >> 5) & 255u : v & 31u; }
__device__ __forceinline__ void idx_resolve(Frame& F) {
    int lane_ = F.lane; asm volatile("" : "+v"(lane_)); const int lane = lane_; LAS unsigned* misc = (LAS unsigned*)(F.lds + MISC_OFF);
    LAS unsigned* h2 = (LAS unsigned*)(F.lds + H2_OFF) + F.wave * 256;
    for (int qq = 0; qq < 2; ++qq) { const int q = 2 * F.wave + qq;
        const unsigned packed = misc[MW_NSEL + q];
        if (lane == 0) misc[MW_NSEL + q] = packed & 0xffffu;
        int c = (int)(packed >> 16); if (c > CMAX) { c = CMAX; if (lane == 0) __hip_atomic_fetch_add(F.ctl + CW_OVF, 1u, RLX_AGENT); }
        int need = 256 - (int)misc[MW_ABOVE + q];
        LAS u32x2* cq = (LAS u32x2*)(F.lds + RING_OFF) + q * CMAX;
        LAS unsigned short* sel = (LAS unsigned short*)(F.lds + SEL_OFF) + q * 256;
        if (c > need && c <= 64) {
            u32x2 e = {0u, 0u}; if (lane < c) e = cq[lane]; int rank = 0;
            for (int j = 0; j < c; ++j) { const unsigned uj = (unsigned)__builtin_amdgcn_readlane((int)e.x, j), ij = (unsigned)__builtin_amdgcn_readlane((int)e.y, j); rank += (uj > e.x || (uj == e.x && ij < e.y)) ? 1 : 0; }
            if (lane < c && rank < need) { const unsigned pos = LDS_ADD(misc + MW_NSEL + q, 1u); if (pos < 256u) sel[pos] = (unsigned short)e.y; }
            c = 0; need = 0;
        }
#pragma unroll 1
        for (int lvl = 0; lvl < 6 && c > need; ++lvl) {
            *(LAS v4u*)(h2 + 4 * lane) = (v4u){0u, 0u, 0u, 0u};
            for (int i = lane; i < c; i += 64) LDS_ADD(h2 + idx_digit(cq[i], lvl), 1u);
            const v4u hw = *(const LAS v4u*)(h2 + 252 - 4 * lane);
            const int total = (int)(hw.x + hw.y + hw.z + hw.w), incl = wave_incl_scan_i(total, lane);
            const unsigned long long mask = __ballot(incl >= need);
            const int Ls = mask ? (int)__builtin_ctzll(mask) : 63;
            int dstar_l = 0, above_l = 0; { int cum = incl - total; bool found = false;
#pragma unroll
                for (int e = 3; e >= 0; --e) { const int cc = (int)hw[e]; if (!found && cum + cc >= need) { found = true; dstar_l = 252 - 4 * lane + e; above_l = cum; } cum += cc; } }
            const unsigned dstar = (unsigned)__shfl(dstar_l, Ls); const int above = __shfl(above_l, Ls);
            int c2 = 0;
            for (int base = 0; base < c; base += 64) { const int i = base + lane; const bool valid = i < c; u32x2 e = {0u, 0u}; if (valid) e = cq[i];
                const unsigned dg = idx_digit(e, lvl); const bool tie = valid && dg == dstar;
                if (valid && dg > dstar) { const unsigned pos = LDS_ADD(misc + MW_NSEL + q, 1u); if (pos < 256u) sel[pos] = (unsigned short)e.y; }
                const unsigned long long tm = __ballot(tie);
                if (tie) cq[c2 + __popcll(tm & ((1ull << lane) - 1ull))] = e;
                c2 += __popcll(tm); }
            c = c2; need -= above;
        }
        for (int i = lane; i < c && i < need; i += 64) { const unsigned pos = LDS_ADD(misc + MW_NSEL + q, 1u); if (pos < 256u) sel[pos] = (unsigned short)cq[i].y; }
    }
}
typedef short s16x4 __attribute__((ext_vector_type(4)));
__device__ __forceinline__ void sp_glds16(const void* gsrc, unsigned lds_dst) { unsigned keep;
    asm volatile("s_mov_b32 %0, m0\n\ts_mov_b32 m0, %2\n\ts_nop 0\n\tglobal_load_lds_dwordx4 %1, off\n\ts_mov_b32 m0, %0" : "=&s"(keep) : "v"(gsrc), "s"(lds_dst) : "memory"); }
__device__ __forceinline__ void sp_glds16s(const void* sbase, unsigned voff, unsigned lds_dst) { unsigned keep;
    asm volatile("s_mov_b32 %0, m0\n\ts_mov_b32 m0, %3\n\ts_nop 0\n\tglobal_load_lds_dwordx4 %1, %2\n\ts_mov_b32 m0, %0" : "=&s"(keep) : "v"(voff), "s"(sbase), "s"(lds_dst) : "memory"); }
template <bool IS_A> __device__ __forceinline__ void sparse_pair(Frame& F, const BAParams& P, int rb, int tA, int qi0, int nv0, int nv1, bool dry) {
    constexpr int NC = IS_A ? 8 : 16, NSLOT = NC * 16, KOFF = IS_A ? 0 : M * 128, HB = IS_A ? 0 : 8, GOFF = IS_A ? 0 : 512;
    int lane_ = F.lane; asm volatile("" : "+v"(lane_)); const int lane = lane_, r = lane & 15, g4 = lane >> 4, my_a = g4 >> 1, my_j = g4 & 1;
    const bf16* Q = IS_A ? P.QA : P.QB;
    const LAS unsigned short* sel = (const LAS unsigned short*)(F.lds + SEL_OFF) + qi0 * 256;
    const LAS float* BIAS = (const LAS float*)(F.lds + BIAS_OFF);
    const LAS unsigned char* BKT = (const LAS unsigned char*)(F.lds + BKT_OFF);
    LAS unsigned short* Pimg = (LAS unsigned short*)(F.lds + RING_OFF + F.wave * 16384);
    bf16x8 q0, q1; const bf16x8 zz = {0, 0, 0, 0, 0, 0, 0, 0};
    { const int a_r = r >> 3, hd = r & 7; const bf16* qp = Q + (size_t)(rb + tA + a_r) * 512 + hd * 64 + 8 * g4; q0 = *(const bf16x8*)qp; q1 = *(const bf16x8*)(qp + 32); }
    const int my_t = tA + my_a, rcb = r >> 2;
    f32x4 x[NC];
#pragma unroll
    for (int c = 0; c < NC; ++c) x[c] = (f32x4){0.f, 0.f, 0.f, 0.f};
    constexpr int KS = NSLOT / 32, NST = 4 * KS;
    const unsigned wk = (unsigned)__builtin_amdgcn_readfirstlane((int)((unsigned)(uintptr_t)(F.lds + RING_OFF) + (unsigned)F.wave * 16384u));
    const int drow = lane >> 3, dpc = lane & 7;
#define SP_KDMA(st, bufi) do { const int cb_ = (st) / KS, ks_ = (st) % KS, a_ = cb_ >> 1, j_ = cb_ & 1; const unsigned dst_ = wk + (unsigned)((bufi) * 4096); \
        _Pragma("unroll") for (int i_ = 0; i_ < 4; ++i_) { const int slot_ = 32 * ks_ + 8 * i_ + drow; int key_; \
            if (IS_A) { key_ = tA + a_ - slot_; key_ = key_ < 0 ? 0 : key_; } else { key_ = sel[a_ * 256 + slot_]; key_ = (slot_ < (a_ ? nv1 : nv0) && key_ < SEQ) ? key_ : 0; } \
            sp_glds16s(P.KAB, (unsigned)(((rb + key_) * 128 + KOFF + j_ * 64 + ((dpc ^ (drow & 7)) * 8)) * 2), (unsigned)__builtin_amdgcn_readfirstlane((int)(dst_ + i_ * 1024))); } } while (0)
    asm volatile("s_waitcnt vmcnt(0)" ::: "memory");
    SP_KDMA(0, 0); SP_KDMA(1, 1); SP_KDMA(2, 2); if (NST > 3) SP_KDMA(3, 3);
    { const LAS unsigned char* kring = F.lds + RING_OFF + F.wave * 16384;
      int kbuf = 0;
#pragma unroll 1
      for (int st = 0; st < NST; ++st) {
        if (st + 3 < NST) asm volatile("s_waitcnt vmcnt(12)" ::: "memory"); else if (st + 2 < NST) asm volatile("s_waitcnt vmcnt(8)" ::: "memory"); else if (st + 1 < NST) asm volatile("s_waitcnt vmcnt(4)" ::: "memory"); else asm volatile("s_waitcnt vmcnt(0)" ::: "memory");
        const int cb = st / KS, ks = st % KS; const bool mine = rcb == cb; const bf16x8 a0 = mine ? q0 : zz, a1 = mine ? q1 : zz;
        const LAS unsigned char* kb = kring + kbuf * 4096;
        bf16x8 f[2][2];
#pragma unroll
        for (int cc = 0; cc < 2; ++cc)
#pragma unroll
            for (int k2 = 0; k2 < 2; ++k2) f[cc][k2] = *(const LAS bf16x8*)(kb + (16 * cc + r) * 128 + (((4 * k2 + g4) ^ (r & 7)) * 16));
        asm volatile("s_waitcnt lgkmcnt(0)" ::: "memory");
#pragma unroll
        for (int k8 = 0; k8 < KS; ++k8) if (k8 == ks) {
#pragma unroll
            for (int cc = 0; cc < 2; ++cc) { x[2 * k8 + cc] = __builtin_amdgcn_mfma_f32_16x16x32_bf16(a0, f[cc][0], x[2 * k8 + cc], 0, 0, 0); x[2 * k8 + cc] = __builtin_amdgcn_mfma_f32_16x16x32_bf16(a1, f[cc][1], x[2 * k8 + cc], 0, 0, 0); } }
        if (st + 4 < NST) SP_KDMA(st + 4, kbuf);
        kbuf = (kbuf + 1) & 3;
      } }
#undef SP_KDMA
#pragma unroll
    for (int c = 0; c < NC; ++c) { const int slot = 16 * c + r; int mk; bool mv;
        if (IS_A) { mk = my_t - slot; mv = mk >= 0; } else { mk = sel[my_a * 256 + slot]; mv = slot < (my_a ? nv1 : nv0); }
        const int delta = my_t - mk; const bool ok = mv && delta >= 0;
        const int bk = (ok && delta < 512) ? (int)BKT[delta] : 31;
        const f32x4 b4 = *(const LAS f32x4*)(BIAS + bk * 16 + HB + 4 * my_j);
#pragma unroll
        for (int i = 0; i < 4; ++i) x[c][i] = ok ? x[c][i] * 0.125f + b4[i] : -INFINITY; }
    f32x4 mx = x[0];
#pragma unroll
    for (int c = 1; c < NC; ++c)
#pragma unroll
        for (int i = 0; i < 4; ++i) mx[i] = fmaxf(mx[i], x[c][i]);
#pragma unroll
    for (int o = 1; o < 16; o <<= 1)
#pragma unroll
        for (int i = 0; i < 4; ++i) mx[i] = fmaxf(mx[i], __shfl_xor(mx[i], o));
    f32x4 sk = {0.f, 0.f, 0.f, 0.f};
    if (IS_A) { sk = *(const f32x4*)(P.sinks + 4 * my_j);
#pragma unroll
        for (int i = 0; i < 4; ++i) mx[i] = fmaxf(mx[i], sk[i]); }
    f32x4 sum = {0.f, 0.f, 0.f, 0.f};
#pragma unroll
    for (int c = 0; c < NC; ++c)
#pragma unroll
        for (int i = 0; i < 4; ++i) { x[c][i] = __expf(x[c][i] - mx[i]); sum[i] += x[c][i]; }
#pragma unroll
    for (int o = 1; o < 16; o <<= 1)
#pragma unroll
        for (int i = 0; i < 4; ++i) sum[i] += __shfl_xor(sum[i], o);
    if (IS_A) {
#pragma unroll
        for (int i = 0; i < 4; ++i) sum[i] += __expf(sk[i] - mx[i]); }
    f32x4 inv;
#pragma unroll
    for (int i = 0; i < 4; ++i) inv[i] = 1.0f / sum[i];
#define SP_PWRITE(qa) do { if (my_a == (qa)) { _Pragma("unroll") for (int c_ = 0; c_ < NC; ++c_) _Pragma("unroll") for (int i_ = 0; i_ < 4; ++i_) \
        Pimg[(4 * my_j + i_) * NSLOT + 16 * c_ + r] = (unsigned short)f2bf(x[c_][i_] * inv[i_]); } } while (0)
    SP_PWRITE(0);
    const unsigned wl = wk + 4096u;
#define SP_VDMA(st, bufi) do { const int cb_ = (st) / KS, ks_ = (st) % KS, a_ = cb_ >> 1, j_ = cb_ & 1; const unsigned dst_ = wl + (unsigned)((bufi) * 4096); \
        _Pragma("unroll") for (int i_ = 0; i_ < 4; ++i_) { const int slot_ = 32 * ks_ + 8 * i_ + drow; int key_; \
            if (IS_A) { key_ = tA + a_ - slot_; key_ = key_ < 0 ? 0 : key_; } else { key_ = sel[a_ * 256 + slot_]; key_ = (slot_ < (a_ ? nv1 : nv0) && key_ < SEQ) ? key_ : 0; } \
            sp_glds16s(P.VAB, (unsigned)(((rb + key_) * 128 + KOFF + j_ * 64 + dpc * 8) * 2), (unsigned)__builtin_amdgcn_readfirstlane((int)(dst_ + i_ * 1024))); } } while (0)
    asm volatile("s_waitcnt vmcnt(0)" ::: "memory");
    SP_VDMA(0, 0); SP_VDMA(1, 1); SP_VDMA(2, 2);
    f32x4 o[4];
#pragma unroll
    for (int db = 0; db < 4; ++db) o[db] = (f32x4){0.f, 0.f, 0.f, 0.f};
    const unsigned trb = (unsigned)((8 * g4 + ((lane & 15) >> 2)) * 128 + (lane & 3) * 8);
    int bufi = 0;
#pragma unroll 1
    for (int st = 0; st < NST; ++st) {
        if (st == NST / 2) { SP_PWRITE(1); }
        if (st + 2 < NST) asm volatile("s_waitcnt vmcnt(8)" ::: "memory"); else if (st + 1 < NST) asm volatile("s_waitcnt vmcnt(4)" ::: "memory"); else asm volatile("s_waitcnt vmcnt(0)" ::: "memory");
        const int cb = st / KS, ks = st % KS; const unsigned vb = wl + (unsigned)(bufi * 4096) + trb;
        s16x4 lo[4], hi[4];
#pragma unroll
        for (int db = 0; db < 4; ++db) {
            asm volatile("ds_read_b64_tr_b16 %0, %1 offset:%c2" : "=&v"(lo[db]) : "v"(vb), "i"(db * 32) : "memory");
            asm volatile("ds_read_b64_tr_b16 %0, %1 offset:%c2" : "=&v"(hi[db]) : "v"(vb), "i"(db * 32 + 512) : "memory"); }
        bf16x8 pb = *(const LAS bf16x8*)(Pimg + (r & 7) * NSLOT + 32 * ks + 8 * g4);
        pb = (rcb == cb) ? pb : zz;
        asm volatile("s_waitcnt lgkmcnt(0)" ::: "memory");
#pragma unroll
        for (int db = 0; db < 4; ++db) { const bf16x8 va = {lo[db][0], lo[db][1], lo[db][2], lo[db][3], hi[db][0], hi[db][1], hi[db][2], hi[db][3]};
            o[db] = __builtin_amdgcn_mfma_f32_16x16x32_bf16(va, pb, o[db], 0, 0, 0); }
        if (st + 3 < NST) SP_VDMA(st + 3, bufi);
        bufi = bufi == 2 ? 0 : bufi + 1;
    }
#undef SP_VDMA
#undef SP_PWRITE
    if (!dry) { bf16* gp = P.G + (size_t)(rb + tA + (r >> 3)) * 1536 + GOFF + (r & 7) * 64 + 4 * g4;
#pragma unroll
        for (int db = 0; db < 4; ++db) { const u32x2 gt = *(const u32x2*)(gp + 16 * db);
            const float g0 = __uint_as_float(gt.x << 16), g1 = __uint_as_float(gt.x & 0xffff0000u), g2 = __uint_as_float(gt.y << 16), g3 = __uint_as_float(gt.y & 0xffff0000u);
            u32x2 w; w.x = pk2(o[db][0] * g0, o[db][1] * g1); w.y = pk2(o[db][2] * g2, o[db][3] * g3);
            *(u32x2*)(gp + 16 * db) = w; } }
}
__device__ __forceinline__ void swa_dense(Frame& F, const BAParams& P, int rb, int t0, bool dry) {
    constexpr int NC = 10, NSLOT = 160, NST = 5;
    int lane_ = F.lane; asm volatile("" : "+v"(lane_)); const int lane = lane_, r = lane & 15, g4 = lane >> 4, j = F.wave >> 2, qg = F.wave & 3, kbase = t0 - 128;
    const LAS float* BIAS = (const LAS float*)(F.lds + BIAS_OFF);
    const LAS unsigned char* BKT = (const LAS unsigned char*)(F.lds + BKT_OFF);
    LAS unsigned short* Pimg = (LAS unsigned short*)(F.lds + RING_OFF + F.wave * 16384);
    bf16x8 qf[2]; { const bf16* qp = P.QA + (size_t)(rb + t0 + 4 * qg + (r >> 2)) * 512 + (4 * j + (r & 3)) * 64 + 8 * g4; qf[0] = *(const bf16x8*)qp; qf[1] = *(const bf16x8*)(qp + 32); }
    bf16x8 kf[NC][2];
#pragma unroll
    for (int c = 0; c < NC; ++c) { int key = kbase + 16 * c + r; key = key < 0 ? 0 : (key > SEQ - 1 ? SEQ - 1 : key);
        const bf16* kp = P.KAB + (size_t)(rb + key) * 128 + j * 64 + 8 * g4; kf[c][0] = *(const bf16x8*)kp; kf[c][1] = *(const bf16x8*)(kp + 32); }
    const int my_t = t0 + 4 * qg + g4;
    f32x4 x[NC];
#pragma unroll
    for (int c = 0; c < NC; ++c) { f32x4 d = {0.f, 0.f, 0.f, 0.f};
        d = __builtin_amdgcn_mfma_f32_16x16x32_bf16(qf[0], kf[c][0], d, 0, 0, 0); d = __builtin_amdgcn_mfma_f32_16x16x32_bf16(qf[1], kf[c][1], d, 0, 0, 0);
        const int key = kbase + 16 * c + r, delta = my_t - key; const bool ok = key >= 0 && delta >= 0 && delta < 128;
        const int bk = (int)BKT[ok ? delta : 0];
        const f32x4 b4 = *(const LAS f32x4*)(BIAS + bk * 16 + 4 * j);
#pragma unroll
        for (int i = 0; i < 4; ++i) x[c][i] = ok ? d[i] * 0.125f + b4[i] : -INFINITY; }
    f32x4 mx = *(const f32x4*)(P.sinks + 4 * j); const f32x4 sk = mx;
#pragma unroll
    for (int c = 0; c < NC; ++c)
#pragma unroll
        for (int i = 0; i < 4; ++i) mx[i] = fmaxf(mx[i], x[c][i]);
#pragma unroll
    for (int o = 1; o < 16; o <<= 1)
#pragma unroll
        for (int i = 0; i < 4; ++i) mx[i] = fmaxf(mx[i], __shfl_xor(mx[i], o));
    f32x4 sum = {0.f, 0.f, 0.f, 0.f};
#pragma unroll
    for (int c = 0; c < NC; ++c)
#pragma unroll
        for (int i = 0; i < 4; ++i) { x[c][i] = __expf(x[c][i] - mx[i]); sum[i] += x[c][i]; }
#pragma unroll
    for (int o = 1; o < 16; o <<= 1)
#pragma unroll
        for (int i = 0; i < 4; ++i) sum[i] += __shfl_xor(sum[i], o);
    f32x4 inv;
#pragma unroll
    for (int i = 0; i < 4; ++i) inv[i] = 1.0f / (sum[i] + __expf(sk[i] - mx[i]));
#pragma unroll
    for (int c = 0; c < NC; ++c)
#pragma unroll
        for (int i = 0; i < 4; ++i) Pimg[(4 * g4 + i) * NSLOT + 16 * c + r] = (unsigned short)f2bf(x[c][i] * inv[i]);
    const unsigned wl = (unsigned)__builtin_amdgcn_readfirstlane((int)((unsigned)(uintptr_t)(F.lds + RING_OFF) + (unsigned)F.wave * 16384u + 8192u));
    const int drow = lane >> 3, dpc = lane & 7;
#define SW_VDMA(st) do { const unsigned dst_ = wl + (unsigned)(((st) & 1) * 4096); \
        _Pragma("unroll") for (int i_ = 0; i_ < 4; ++i_) { int key_ = kbase + 32 * (st) + 8 * i_ + drow; key_ = key_ < 0 ? 0 : (key_ > SEQ - 1 ? SEQ - 1 : key_); \
            sp_glds16s(P.VAB, (unsigned)(((rb + key_) * 128 + j * 64 + dpc * 8) * 2), (unsigned)__builtin_amdgcn_readfirstlane((int)(dst_ + i_ * 1024))); } } while (0)
    asm volatile("s_waitcnt vmcnt(0)" ::: "memory");
    SW_VDMA(0); SW_VDMA(1);
    f32x4 o[4];
#pragma unroll
    for (int db = 0; db < 4; ++db) o[db] = (f32x4){0.f, 0.f, 0.f, 0.f};
    const unsigned trb = (unsigned)((8 * g4 + ((lane & 15) >> 2)) * 128 + (lane & 3) * 8);
#pragma unroll 1
    for (int st = 0; st < NST; ++st) {
        if (st + 1 < NST) asm volatile("s_waitcnt vmcnt(4)" ::: "memory"); else asm volatile("s_waitcnt vmcnt(0)" ::: "memory");
        const unsigned vb = wl + (unsigned)((st & 1) * 4096) + trb;
        s16x4 lo[4], hi[4];
#pragma unroll
        for (int db = 0; db < 4; ++db) {
            asm volatile("ds_read_b64_tr_b16 %0, %1 offset:%c2" : "=&v"(lo[db]) : "v"(vb), "i"(db * 32) : "memory");
            asm volatile("ds_read_b64_tr_b16 %0, %1 offset:%c2" : "=&v"(hi[db]) : "v"(vb), "i"(db * 32 + 512) : "memory"); }
        const bf16x8 pb = *(const LAS bf16x8*)(Pimg + r * NSLOT + 32 * st + 8 * g4);
        asm volatile("s_waitcnt lgkmcnt(0)" ::: "memory");
#pragma unroll
        for (int db = 0; db < 4; ++db) { const bf16x8 va = {lo[db][0], lo[db][1], lo[db][2], lo[db][3], hi[db][0], hi[db][1], hi[db][2], hi[db][3]};
            o[db] = __builtin_amdgcn_mfma_f32_16x16x32_bf16(va, pb, o[db], 0, 0, 0); }
        if (st + 2 < NST) SW_VDMA(st + 2);
    }
#undef SW_VDMA
    if (!dry) { bf16* gp = P.G + (size_t)(rb + t0 + 4 * qg + (r >> 2)) * 1536 + (4 * j + (r & 3)) * 64 + 4 * g4;
#pragma unroll
        for (int db = 0; db < 4; ++db) { const u32x2 gt = *(const u32x2*)(gp + 16 * db);
            const float g0 = __uint_as_float(gt.x << 16), g1 = __uint_as_float(gt.x & 0xffff0000u), g2 = __uint_as_float(gt.y << 16), g3 = __uint_as_float(gt.y & 0xffff0000u);
            u32x2 w; w.x = pk2(o[db][0] * g0, o[db][1] * g1); w.y = pk2(o[db][2] * g2, o[db][3] * g3);
            *(u32x2*)(gp + 16 * db) = w; } }
}
__device__ __forceinline__ void ba_unit(Frame& F, const BAParams& P, int b, int tau, bool dry) {
    { int l_ = (int)__builtin_amdgcn_mbcnt_hi(~0u, __builtin_amdgcn_mbcnt_lo(~0u, 0u)); asm volatile("" : "+v"(l_)); F.lane = l_; F.tid = F.wave * 64 + l_; }
    const int t0 = tau * 16, rb = b * SEQ, lane = F.lane;
    LAS unsigned* misc = (LAS unsigned*)(F.lds + MISC_OFF);
    for (int ri = 0; ri < REP_IDX; ++ri)
    if (tau >= 16) {
        if (ri) __syncthreads();
        { LAS v4u* hz = (LAS v4u*)(F.lds + RING_OFF); for (int i = F.tid; i < RING_BYTES / 16; i += 512) hz[i] = (v4u){0u, 0u, 0u, 0u}; }
        if (F.tid < 32) misc[F.tid] = 0u;
        for (int i = F.tid; i < 16 * 64; i += 512) ((LAS unsigned*)(F.lds + H2_OFF))[i] = 0u;
        __syncthreads();
        bf16x8 bq[4]; const int r = lane & 15, g4 = lane >> 4;
#pragma unroll
        for (int h = 0; h < 4; ++h) bq[h] = *(const bf16x8*)(P.IQ + (size_t)(rb + t0 + r) * 128 + h * 32 + 8 * g4);
        const f32x4 w4 = *(const f32x4*)(P.IW + (size_t)(rb + t0 + r) * 4);
        const bf16* IKb = P.IK + (size_t)rb * 32;
        idx_pass<1>(F, IKb, bq, w4, tau, t0);
        __syncthreads();
        idx_threshold(F);
        __syncthreads();
        idx_pass<2>(F, IKb, bq, w4, tau, t0);
        __syncthreads();
        idx_resolve(F);
    } else {
        LAS unsigned short* sel = (LAS unsigned short*)(F.lds + SEL_OFF);
        for (int i = F.tid; i < 16 * 256; i += 512) sel[i] = (unsigned short)(i & 255);
    }
    __syncthreads();
    const int tA = t0 + 2 * F.wave, nv0 = tA >= 256 ? 256 : tA + 1, nv1 = tA + 1 >= 256 ? 256 : tA + 2;
    for (int rs = 0; rs < REP_SPB; ++rs) sparse_pair<false>(F, P, rb, tA, 2 * F.wave, nv0, nv1, dry || rs + 1 < REP_SPB);
    for (int rs = 0; rs < REP_SPA; ++rs) swa_dense(F, P, rb, t0, dry || rs + 1 < REP_SPA);
}

#ifndef REP_P1A
#define REP_P1A 1
#endif
#ifndef REP_C
#define REP_C 1
#endif
#ifndef REP_BA
#define REP_BA 1
#endif
#ifndef REP_P1B
#define REP_P1B 1
#endif
#ifndef REP_P3
#define REP_P3 1
#endif
#ifndef REP_P0
#define REP_P0 1
#endif
#ifndef FOX_SKIP_LOG2
#define FOX_SKIP_LOG2 (-80.0f)
#endif
#ifndef MK_ONE_LAUNCH
#define MK_ONE_LAUNCH 1
#endif
constexpr int NPHASES = 1 + 6 * DEPTH;
struct Args { const float* in[9]; float* out; unsigned char* ws; int ph_lo, ph_hi; };
static_assert(sizeof(Args) == 9 * 8 + 8 + 8 + 4 + 4, "no padding bytes in the argument struct");

typedef const __attribute__((address_space(4))) Args* ArgP;
__device__ __forceinline__ ArgP argp() { ArgP p = (ArgP)__builtin_amdgcn_kernarg_segment_ptr(); asm volatile("" : "+s"(p)); return p; }
__global__ void __launch_bounds__(512, 2) mk_fwd(Args args) {
    extern __shared__ __attribute__((aligned(16))) unsigned char lds[];
    Frame F;
    F.lds = (LAS unsigned char*)lds;
    F.MISC = (volatile LAS unsigned*)(F.lds + MISC_OFF);
    F.tid = threadIdx.x; F.lane = F.tid & 63; F.wave = __builtin_amdgcn_readfirstlane(F.tid >> 6);
    F.G = gridDim.x; { const int bx = blockIdx.x; F.vcu = (F.G % 8 == 0) ? (bx % 8) * (F.G / 8) + bx / 8 : bx; }
    F.ctl = (gu32*)(argp()->ws + WS_CTL);
    for (int u = F.tid; u < 256; u += 512) ((LAS unsigned*)(F.lds + MISC_OFF))[u] = 0u;
    for (int u = F.tid; u < 512; u += 512) { ((LAS float*)(F.lds + BIAS_OFF))[u] = argp()->in[8][u];
        int bk; if (u < 16) bk = u; else { const float nf = (float)u; int lg = 16 + (int)(logf(nf / 16.0f) / 3.4657359027997265f * 16.0f); bk = lg < 31 ? lg : 31; }
        ((LAS unsigned char*)(F.lds + BKT_OFF))[u] = (unsigned char)bk; }
    __syncthreads();
    XcdBarrier bar; bar.bar = (unsigned*)(F.ctl + CW_BAR); bar.x = 0; bar.st = nullptr;
    if (MK_ONE_LAUNCH) bar = xcd_barrier_post((unsigned*)(F.ctl + CW_BAR), F.MISC + MW_BAR);
    const int lo = argp()->ph_lo, hi = argp()->ph_hi;
#define IN(k) (lo <= (k) && (k) < hi)
#define SEAM(k) do { if (IN(k) && IN((k) + 1)) xcd_barrier(bar); } while (0)
#define PHASE_BEGIN() do { int l_ = (int)__builtin_amdgcn_mbcnt_hi(~0u, __builtin_amdgcn_mbcnt_lo(~0u, 0u)); asm volatile("" : "+v"(l_)); F.lane = l_; F.tid = F.wave * 64 + l_; } while (0)

    if (IN(0)) { PHASE_BEGIN(); ArgP a = argp(); for (int rp = 0; rp < REP_P0; ++rp) p0_prologue(F, a->in[0], a->in[1], a->in[2], a->in[6], a->in[7], a->ws); SEAM(0); }

    for (int L = 0; L < DEPTH; ++L) {
        const int pb = 1 + 6 * L;
        if (IN(pb)) { PHASE_BEGIN();
            unsigned char* ws = argp()->ws; const pg8::bf16_t* W1T = (const pg8::bf16_t*)(ws + WS_W1T) + (size_t)L * NTILES * 256 * 1024;
            pg8::Gemm g{(const pg8::bf16_t*)(ws + WS_XB), W1T, M, NT_A * 256, 1024, 1024, 1024, 0}; pg8::StaticOrder S; S.init(M, NT_A * 256, F.G, (int)blockIdx.x);
            pg8::EpiIn E{ws, argp()->in[4] + L * 384};
            for (int rp = 0; rp < REP_P1A; ++rp) pg8::gemm_phase<pg8::EpiIn, pg8::StaticOrder, true, true>(F.lds + RING_OFF, g, S, E, F.wave);
            SEAM(pb);
        }
        if (IN(pb + 1)) { PHASE_BEGIN(); unsigned char* ws = argp()->ws; scan_phase(F, (const float*)(ws + WS_CF), argp()->in[3] + L * 8, (float*)(ws + WS_CL), (float*)(ws + WS_CT)); SEAM(pb + 1); }
        if (IN(pb + 2)) { PHASE_BEGIN();
            unsigned char* ws = argp()->ws;
            const float* CL = (const float*)(ws + WS_CL); const float* CT = (const float*)(ws + WS_CT);
            LAS float* carry = (LAS float*)(F.lds + MISC_OFF) + MW_CARRY; LAS unsigned* nbw = (LAS unsigned*)(F.lds + RING_OFF + NB_OFF);
            for (int rp = 0; rp < REP_C; ++rp) {
            LAS unsigned* miscw = (LAS unsigned*)(F.lds + MISC_OFF);
            for (int kg = 0; kg < 8; ++kg) { const int xg = ((F.vcu >> 5) + kg) & 7;
            gu32* const tick = F.ctl + CW_TICK + 64 * (8 * (2 * L + rp % 2) + xg);
            if (F.tid == 0) miscw[MW_TICKET] = __hip_atomic_fetch_add(tick, 1u, RLX_AGENT);
            __syncthreads();
            for (;;) {
                PHASE_BEGIN();
                const int ui = (int)miscw[MW_TICKET];
                if (ui >= 128) { __syncthreads(); break; }
                const int qb = 31 - (ui >> 2), bh = 4 * xg + (ui & 3);
                    if (F.wave == 0) { float tv = F.lane < 32 ? CT[bh * 32 + F.lane] : 0.f; const float inc = wave_incl_scan(tv, F.lane); if (F.lane < 32) carry[F.lane] = inc - tv; }
                    __syncthreads();
                    const float cref = carry[qb]; int tskip;
                    { const float* gq = argp()->in[4] + L * 384 + 256; const float g1 = fabsf(gq[F.lane]), g2 = fabsf(gq[64 + F.lane]); float mq = g1, mk = g2;
#pragma unroll
                      for (int o = 1; o < 64; o <<= 1) { mq = fmaxf(mq, __shfl_xor(mq, o)); mk = fmaxf(mk, __shfl_xor(mk, o)); }
                      const float thr = FOX_SKIP_LOG2 - 2.0f * (11.8f * mq * mk + 0.5f);
                      const int NTt = 4 * (qb + 1); const int t_a = F.lane, t_b = 64 + F.lane, k_a = 64 * t_a + 63, k_b = 64 * t_b + 63;
                      const float n_a = t_a < NTt ? (cref - (carry[k_a >> 8] + CL[(size_t)bh * SEQ + k_a])) * 1.4426950408889634f : 0.f, n_b = t_b < NTt ? (cref - (carry[k_b >> 8] + CL[(size_t)bh * SEQ + k_b])) * 1.4426950408889634f : 0.f;
                      const bool s_a = t_a < NTt && n_a < thr, s_b = t_b < NTt && n_b < thr;
                      const unsigned long long f_a = __ballot(!s_a), f_b = __ballot(!s_b);
                      int cnt = f_a ? (int)__builtin_ctzll(f_a) : 64 + (f_b ? (int)__builtin_ctzll(f_b) : 64);
                      cnt &= ~1; tskip = cnt > NTt - 4 ? NTt - 4 : cnt; }
                    { const int nk = 256 * (qb + 1);
                      for (int k = 64 * tskip + F.tid; k < nk; k += 512) { const float xb = (cref - (carry[k >> 8] + CL[(size_t)bh * SEQ + k])) * 1.4426950408889634f;
                          const unsigned h = f2bf(xb), l = f2bf(xb - __uint_as_float(h << 16)); nbw[k] = h | (l << 16); } }
                    __syncthreads();
                    attn_body::attn_unit<8>(bh >> 3, bh & 7, qb, (const attn_body::bf16*)(ws + WS_QC), (const attn_body::bf16*)(ws + WS_KC), (const attn_body::bf16*)(ws + WS_VC), (attn_body::bf16*)(ws + WS_G),
                                            (char*)lds + RING_OFF, (attn_body::lds_cuptr)(F.lds + RING_OFF + NB_OFF), tskip, rp + 1 < REP_C, F.wave);
                if (F.tid == 0) miscw[MW_TICKET] = __hip_atomic_fetch_add(tick, 1u, RLX_AGENT);
                __syncthreads();
            } } }
            __syncthreads(); PHASE_BEGIN();
            const BAParams P{(const bf16*)(ws + WS_IQ), (const bf16*)(ws + WS_IK), (const float*)(ws + WS_IW), (const bf16*)(ws + WS_QA), (const bf16*)(ws + WS_QB), (const bf16*)(ws + WS_KAB), (const bf16*)(ws + WS_VAB),
                             (bf16*)(ws + WS_G), argp()->in[5] + L * 8};
            for (int rp = 0; rp < REP_BA; ++rp) {
            LAS unsigned* miscw = (LAS unsigned*)(F.lds + MISC_OFF);
            for (int kg = 0; kg < 4; ++kg) { const int bq = ((F.vcu >> 6) + kg) & 3;
            gu32* const tick = F.ctl + CW_TICK + 64 * (32 + 4 * (2 * L + rp % 2) + bq);
            if (F.tid == 0) miscw[MW_TICKET] = __hip_atomic_fetch_add(tick, 1u, RLX_AGENT);
            __syncthreads();
            for (;;) {
                PHASE_BEGIN();
                const int ui = (int)miscw[MW_TICKET];
                if (ui >= 512) { __syncthreads(); break; }
                ba_unit(F, P, bq, 511 - ui, rp + 1 < REP_BA);
                if (F.tid == 0) miscw[MW_TICKET] = __hip_atomic_fetch_add(tick, 1u, RLX_AGENT);
                __syncthreads();
            } } }
            SEAM(pb + 2);
        }
        if (IN(pb + 3)) { PHASE_BEGIN();
            unsigned char* ws = argp()->ws; const pg8::bf16_t* W1T = (const pg8::bf16_t*)(ws + WS_W1T) + (size_t)L * NTILES * 256 * 1024;
            pg8::Gemm g{(const pg8::bf16_t*)(ws + WS_XB), W1T + (size_t)NT_A * 256 * 1024, M, NT_B * 256, 1024, 1024, 1024, 0}; pg8::StaticOrder S; S.init(M, NT_B * 256, F.G, (int)blockIdx.x);
            pg8::EpiGate E{(const float*)(ws + WS_SSQ), (unsigned char*)(ws + WS_MG)};
            for (int rp = 0; rp < REP_P1B; ++rp) pg8::gemm_phase<pg8::EpiGate, pg8::StaticOrder, true, true>(F.lds + RING_OFF, g, S, E, F.wave);
            SEAM(pb + 3);
        }
        if (IN(pb + 4)) { PHASE_BEGIN();
            unsigned char* ws = argp()->ws;
            pg8::Gemm g{(const pg8::bf16_t*)(ws + WS_G), (const pg8::bf16_t*)(ws + WS_WBT) + (size_t)L * 3 * 1024 * 512, M, 1024, 512, 1536, 512, 4};
            pg8::SegOrder S; S.base.init(M, 1024, F.G, (int)blockIdx.x);
            pg8::EpiMerge E{(const unsigned char*)(ws + WS_MG), (pg8::bf16_t*)(ws + WS_MERGED)};
            for (int rp = 0; rp < REP_P3; ++rp) pg8::gemm_phase<pg8::EpiMerge, pg8::SegOrder, true, true>(F.lds + RING_OFF, g, S, E, F.wave);
            SEAM(pb + 4);
        }
        if (IN(pb + 5)) { PHASE_BEGIN();
            unsigned char* ws = argp()->ws; float* const outp = argp()->out;
            pg8::Gemm g{(const pg8::bf16_t*)(ws + WS_MERGED), (const pg8::bf16_t*)(ws + WS_WOT) + (size_t)L * 1024 * 1024, M, 1024, 1024, 1024, 1024, 0}; pg8::StaticOrder S; S.init(M, 1024, F.G, (int)blockIdx.x);
            const bool last = (L == DEPTH - 1);
            unsigned poison = 0u;
            if (last) poison = (__hip_atomic_load(F.ctl + CW_OVF, RLX_AGENT) != 0u) | (__hip_atomic_load(F.ctl + CW_BAR + XB_TMO, RLX_AGENT) != 0u);
            pg8::EpiOut E{L == 0 ? argp()->in[0] : (const float*)outp, outp, last ? nullptr : (pg8::bf16_t*)(ws + WS_XB), last ? nullptr : (float*)(ws + WS_SSQ), poison};
            pg8::gemm_phase<pg8::EpiOut, pg8::StaticOrder, true, true>(F.lds + RING_OFF, g, S, E, F.wave);
            if (!last) SEAM(pb + 5);
        }
    }
#undef IN
#undef SEAM
}

extern "C" void kernel_launch(void* const* d_in, const int* in_sizes, int n_in, void* d_out, int out_size, void* d_ws, size_t ws_size, hipStream_t stream) {
    static int grid = 0;
    if (grid == 0) {
        if (n_in != 9 || in_sizes[0] != M * DMODEL || out_size != M * DMODEL || ws_size < WS_END) { fprintf(stderr, "kernel_launch: unexpected shapes / workspace (n_in %d, in0 %d, out %d, ws %zu < %zu); nothing launched\n", n_in, n_in > 0 ? in_sizes[0] : -1, out_size, ws_size, (size_t)WS_END); grid = -1; return; }
        int dev = 0, cus = 0, per_cu = 0;
        if (hipGetDevice(&dev) != hipSuccess || hipDeviceGetAttribute(&cus, hipDeviceAttributeMultiprocessorCount, dev) != hipSuccess) { grid = -1; return; }
        if (hipFuncSetAttribute((const void*)mk_fwd, hipFuncAttributeMaxDynamicSharedMemorySize, LDS_BYTES) != hipSuccess) { fprintf(stderr, "kernel_launch: hipFuncSetAttribute failed\n"); grid = -1; return; }
        if (hipOccupancyMaxActiveBlocksPerMultiprocessor(&per_cu, (const void*)mk_fwd, 512, LDS_BYTES) != hipSuccess || per_cu < 1) fprintf(stderr, "kernel_launch: occupancy query reports %d workgroups per CU\n", per_cu);
        (void)hipGetLastError();
        grid = cus;
    }
    if (grid < 0) return;
    if (hipMemsetAsync((char*)d_ws + WS_CTL, 0, CTL_ZERO_BYTES, stream) != hipSuccess) return;
    Args a{};
    for (int i = 0; i < 9; ++i) a.in[i] = (const float*)d_in[i];
    a.out = (float*)d_out; a.ws = (unsigned char*)d_ws;
#if MK_ONE_LAUNCH
    a.ph_lo = 0; a.ph_hi = NPHASES;
    hipLaunchKernelGGL(mk_fwd, dim3(grid), dim3(512), LDS_BYTES, stream, a);
#else
    for (int p = 0; p < NPHASES; ++p) { a.ph_lo = p; a.ph_hi = p + 1; hipLaunchKernelGGL(mk_fwd, dim3(grid), dim3(512), LDS_BYTES, stream, a); }
#endif
}
```

```cpp
#include <hip/hip_runtime.h>
#include <cstdio>
#include <cstdint>
#include <cmath>
namespace pg8 {
#define PG8_LAS __attribute__((address_space(3)))
typedef unsigned short bf16_t;
typedef short bf16x8 __attribute__((ext_vector_type(8)));
typedef float f32x4 __attribute__((ext_vector_type(4)));
typedef unsigned u32x4 __attribute__((ext_vector_type(4)));
constexpr int BM = 256, BK = 64, HALF = 128, HTB = HALF * BK * 2  , STAGE_BYTES = 8 * HTB, NXCD = 8, WGM = 8;

__host__ __device__ __forceinline__ int lds_byte(int r, int c) { const int st = (r >> 4) * 2 + (c >> 5), rr = r & 15, cc = c & 31, ob = rr * 64 + cc * 2; return st * 1024 + (ob ^ (((ob >> 9) & 1) << 5)); }
__host__ __device__ __forceinline__ void stage_rc(int b, int& R, int& C) { const int st = b / 1024, sb = b % 1024, swz = sb ^ (((sb >> 9) & 1) << 5); R = (st >> 1) * 16 + swz / 64; C = (st & 1) * 32 + (swz % 64) / 2; }
__host__ __device__ __forceinline__ int perm32(int rho) { const int n = rho >> 4, i = rho & 15; return 8 * (i >> 2) + 4 * n + (i & 3); }

struct Unit { int pm, pn, seg; };
struct Gemm { const bf16_t* A; const bf16_t* Bt; int M, N, K, lda, ldb, segN; };

struct StaticOrder {
    int nM, nN, nwg, G, c;
    __host__ __device__ void init(int M, int N, int G_, int c_) { nM = M / BM; nN = N / BM; nwg = nM * nN; G = G_; c = c_; }
    __host__ __device__ bool next(int i, Unit& u) const {
        const long L = (long)i * G + c; if (L >= nwg) return false;
        int wgid = (int)L; { const int q = nwg / NXCD, r = nwg % NXCD, xcd = wgid % NXCD, off = wgid / NXCD; wgid = (xcd < r ? xcd * (q + 1) : r * (q + 1) + (xcd - r) * q) + off; }
        const int nig = WGM * nN, gid = wgid / nig, fm = gid * WGM, gsz = (nM - fm) < WGM ? (nM - fm) : WGM;
        u.pm = fm + ((wgid % nig) % gsz); u.pn = (wgid % nig) / gsz; u.seg = 0; return true;
    }
    __device__ __forceinline__ void a_ready(const Unit&) const {}
    __device__ __forceinline__ void done(const Unit&) const {}
};

__device__ __forceinline__ unsigned cvt_pk_bf16(float lo, float hi) { unsigned r; asm volatile("v_cvt_pk_bf16_f32 %0, %1, %2" : "=v"(r) : "v"(lo), "v"(hi)); return r; }
constexpr size_t EWS_MiB = 1u << 20, EWS_SSQ = 43 * EWS_MiB, EWS_CL = 45 * EWS_MiB, EWS_CT = 46 * EWS_MiB, EWS_IW = 47 * EWS_MiB, EWS_CF = 47 * EWS_MiB + 512 * 1024, EWS_IQ = 49 * EWS_MiB, EWS_IK = 57 * EWS_MiB, EWS_G = 188 * EWS_MiB,
    EWS_QA = 284 * EWS_MiB, EWS_QB = 316 * EWS_MiB, EWS_QC = 348 * EWS_MiB, EWS_KC = 380 * EWS_MiB, EWS_VC = 412 * EWS_MiB, EWS_KAB = 444 * EWS_MiB, EWS_VAB = 460 * EWS_MiB;

constexpr float C2Q = 0.125f * 1.4426950408889634f;
__device__ __forceinline__ float fast_sigmoid(float x) { return __builtin_amdgcn_rcpf(1.0f + __expf(-x)); }
__device__ __forceinline__ u32x4 pack8(const f32x4 a, const f32x4 b) { u32x4 w; w.x = cvt_pk_bf16(a[0], a[1]); w.y = cvt_pk_bf16(a[2], a[3]); w.z = cvt_pk_bf16(b[0], b[1]); w.w = cvt_pk_bf16(b[2], b[3]); return w; }
__device__ __forceinline__ void unpack8(const u32x4 w, f32x4& a, f32x4& b) {
    a[0] = __uint_as_float(w.x << 16); a[1] = __uint_as_float(w.x & 0xffff0000u); a[2] = __uint_as_float(w.y << 16); a[3] = __uint_as_float(w.y & 0xffff0000u);
    b[0] = __uint_as_float(w.z << 16); b[1] = __uint_as_float(w.z & 0xffff0000u); b[2] = __uint_as_float(w.w << 16); b[3] = __uint_as_float(w.w & 0xffff0000u); }
#define EPI_PIN() asm volatile("" ::: "memory")
__device__ __forceinline__ void rows_rstd(const float* ssq, int row0, int fq, float (&rs)[2][4]) {
    f32x4 pr[2][4];
#pragma unroll
    for (int ai = 0; ai < 2; ++ai)
#pragma unroll
        for (int m = 0; m < 4; ++m) pr[ai][m] = *(const f32x4*)(ssq + (size_t)(row0 + ai * HALF + m * 16) * 16 + 4 * fq);
    EPI_PIN();
#pragma unroll
    for (int ai = 0; ai < 2; ++ai)
#pragma unroll
        for (int m = 0; m < 4; ++m) { const f32x4 a = pr[ai][m]; float t = (a[0] + a[1]) + (a[2] + a[3]); t += __shfl_xor(t, 16); t += __shfl_xor(t, 32); rs[ai][m] = __builtin_amdgcn_rsqf(t * (1.0f / 1024.0f) + 1e-6f); }
}
struct EpiIn {
    static constexpr bool PERM = true, AFTER_DRAIN = false;
    unsigned char* ws; const float* qkg; const float* bfg;
    __device__ __forceinline__ bool keep(const Unit&) const { return false; }
    __device__ __forceinline__ void operator()(f32x4 (&acc)[2][2][4][2], const Unit& u, int wr, int wc, int fr, int fq) const {
        const int row0 = u.pm * BM + wr * 64 + fr, t = u.pn, lc0 = wc * 64 + fq * 8;
        float rs[2][4]; rows_rstd((const float*)(ws + EWS_SSQ), row0, fq, rs);
        if (t == 18) {
            bf16_t* IQ = (bf16_t*)(ws + EWS_IQ); bf16_t* IK = (bf16_t*)(ws + EWS_IK); float* IW = (float*)(ws + EWS_IW);
#pragma unroll
            for (int ai = 0; ai < 2; ++ai)
#pragma unroll
                for (int m = 0; m < 4; ++m) { const int row = row0 + ai * HALF + m * 16; const float f = rs[ai][m];
#pragma unroll
                    for (int bj = 0; bj < 2; ++bj) { const int lc = lc0 + 32 * bj; const f32x4 v0 = acc[ai][bj][m][0] * f, v1 = acc[ai][bj][m][1] * f;
                        if (lc < 128) *(u32x4*)(IQ + (size_t)row * 128 + lc) = pack8(v0, v1);
                        else if (lc < 160) *(u32x4*)(IK + (size_t)row * 32 + (lc - 128)) = pack8(v0, v1);
                        else if (lc == 160) *(f32x4*)(IW + (size_t)row * 4) = v0 * 0.08838834764831845f; } }
            int ln_ = (int)__builtin_amdgcn_mbcnt_hi(~0u, __builtin_amdgcn_mbcnt_lo(~0u, 0u)); asm volatile("" : "+v"(ln_));
            if (wc == 2 && (ln_ >> 4) < 2) { const int fql = ln_ >> 4, frl = ln_ & 15;
                float* CL = (float*)(ws + EWS_CL); float* CT = (float*)(ws + EWS_CT); const int hb = 4 * fql; const f32x4 bfv = *(const f32x4*)(bfg + hb);
#pragma unroll
                for (int ai = 0; ai < 2; ++ai) { f32x4 run = {0.f, 0.f, 0.f, 0.f};
#pragma unroll
                    for (int m = 0; m < 4; ++m) { const int row = row0 + ai * HALF + m * 16; const f32x4 z = (fql == 0 ? acc[ai][1][m][1] : acc[ai][1][m][0]) * rs[ai][m] + bfv; f32x4 lf;
#pragma unroll
                        for (int e = 0; e < 4; ++e) lf[e] = (z[e] < 0.f ? z[e] : 0.f) - __logf(1.0f + __expf(-fabsf(z[e])));
#pragma unroll
                        for (int o = 1; o < 16; o <<= 1)
#pragma unroll
                            for (int e = 0; e < 4; ++e) { const float tt = __shfl_up(lf[e], o, 16); if (frl >= o) lf[e] += tt; }
                        const f32x4 cs = lf + run;
                        const int bb = row >> 13, ss = row & 8191;
#pragma unroll
                        for (int e = 0; e < 4; ++e) CL[(size_t)(bb * 8 + hb + e) * 8192 + ss] = cs[e];
#pragma unroll
                        for (int e = 0; e < 4; ++e) run[e] += __shfl(lf[e], 15, 16); }
                    if (frl == 15) { const int row = row0 + ai * HALF, bb = row >> 13, ch = (row & 8191) >> 6;
#pragma unroll
                        for (int e = 0; e < 4; ++e) CT[(bb * 8 + hb + e) * 128 + ch] = run[e]; } } }
            return;
        }
        bf16_t* dst; int ldc, colbase; const float* gp = qkg; float csc = 1.f; bool norm = false, act = false;
        if (t < 6) { const int mx = t >> 1; dst = (bf16_t*)(ws + (mx == 0 ? EWS_QA : (mx == 1 ? EWS_QB : EWS_QC))); ldc = 512; colbase = (t & 1) * 256; norm = true; gp = qkg + (mx * 2 + 0) * 64; csc = (mx == 2) ? C2Q : 1.f; }
        else if (t == 6) { dst = (bf16_t*)(ws + EWS_KAB); ldc = 128; colbase = (wc >> 1) * (32768 * 128 - 128); norm = true;     gp = qkg + ((wc >> 1) * 2 + 1) * 64; }
        else if (t < 9) { dst = (bf16_t*)(ws + EWS_KC); ldc = 512; colbase = (t - 7) * 256; norm = true; gp = qkg + (2 * 2 + 1) * 64; }
        else if (t == 9) { dst = (bf16_t*)(ws + EWS_VAB); ldc = 128; colbase = (wc >> 1) * (32768 * 128 - 128); }
        else if (t < 12) { dst = (bf16_t*)(ws + EWS_VC); ldc = 512; colbase = (t - 10) * 256; }
        else { dst = (bf16_t*)(ws + EWS_G); ldc = 1536; colbase = (t - 12) * 256; act = true; }
        f32x4 gv[2][2];
#pragma unroll
        for (int bj = 0; bj < 2; ++bj)
#pragma unroll
            for (int n = 0; n < 2; ++n) gv[bj][n] = norm ? *(const f32x4*)(gp + 8 * fq + 32 * bj + 4 * n) * csc : (f32x4){1.f, 1.f, 1.f, 1.f};
        EPI_PIN();
#pragma unroll
        for (int ai = 0; ai < 2; ++ai)
#pragma unroll
            for (int m = 0; m < 4; ++m) { const int row = row0 + ai * HALF + m * 16; float f = rs[ai][m];
                if (norm) { float ss = 0.f;
#pragma unroll
                    for (int bj = 0; bj < 2; ++bj)
#pragma unroll
                        for (int n = 0; n < 2; ++n) { const f32x4 x = acc[ai][bj][m][n]; ss += (x[0] * x[0] + x[1] * x[1]) + (x[2] * x[2] + x[3] * x[3]); }
                    ss += __shfl_xor(ss, 16); ss += __shfl_xor(ss, 32);
                    f = f * __builtin_amdgcn_rsqf(f * f * ss * (1.0f / 64.0f) + 1e-6f); }
                bf16_t* rowp = dst + (size_t)row * ldc + colbase + lc0;
#pragma unroll
                for (int bj = 0; bj < 2; ++bj) { f32x4 v0 = acc[ai][bj][m][0] * f * gv[bj][0], v1 = acc[ai][bj][m][1] * f * gv[bj][1];
                    if (act) {
#pragma unroll
                        for (int e = 0; e < 4; ++e) { v0[e] = v0[e] * fast_sigmoid(v0[e]); v1[e] = v1[e] * fast_sigmoid(v1[e]); } }
                    *(u32x4*)(rowp + 32 * bj) = pack8(v0, v1); } }
    }
};
typedef unsigned u32x2e __attribute__((ext_vector_type(2)));
__device__ __forceinline__ unsigned gate_q4(const f32x4 v) { unsigned w = 0u;
    w = __builtin_amdgcn_cvt_pk_u8_f32(fmaxf(255.0f * fast_sigmoid(v[0]), 1.0f), 0, w); w = __builtin_amdgcn_cvt_pk_u8_f32(fmaxf(255.0f * fast_sigmoid(v[1]), 1.0f), 1, w);
    w = __builtin_amdgcn_cvt_pk_u8_f32(fmaxf(255.0f * fast_sigmoid(v[2]), 1.0f), 2, w); w = __builtin_amdgcn_cvt_pk_u8_f32(fmaxf(255.0f * fast_sigmoid(v[3]), 1.0f), 3, w); return w; }
__device__ __forceinline__ f32x4 gate_f4(const unsigned w) { return (f32x4){(float)(w & 0xffu), (float)((w >> 8) & 0xffu), (float)((w >> 16) & 0xffu), (float)(w >> 24)}; }
struct EpiGate {
    static constexpr bool PERM = true, AFTER_DRAIN = false;
    const float* ssq; unsigned char* MG;
    __device__ __forceinline__ bool keep(const Unit&) const { return false; }
    __device__ __forceinline__ void operator()(f32x4 (&acc)[2][2][4][2], const Unit& u, int wr, int wc, int fr, int fq) const {
        const int row0 = u.pm * BM + wr * 64 + fr, lc0 = wc * 64 + fq * 8;
        float rs[2][4]; rows_rstd(ssq, row0, fq, rs);
#pragma unroll
        for (int ai = 0; ai < 2; ++ai)
#pragma unroll
            for (int m = 0; m < 4; ++m) { const int row = row0 + ai * HALF + m * 16; const float f = rs[ai][m];
                unsigned char* rowp = MG + (size_t)row * 3072 + u.pn * BM + lc0;
#pragma unroll
                for (int bj = 0; bj < 2; ++bj) { u32x2e w; w.x = gate_q4(acc[ai][bj][m][0] * f); w.y = gate_q4(acc[ai][bj][m][1] * f); *(u32x2e*)(rowp + 32 * bj) = w; } }
    }
};
struct EpiMerge {
    static constexpr bool PERM = true, AFTER_DRAIN = false;
    const unsigned char* MG; bf16_t* OUT;
    __device__ __forceinline__ bool keep(const Unit& u) const { return u.seg < 2; }
    __device__ __forceinline__ void operator()(f32x4 (&acc)[2][2][4][2], const Unit& u, int wr, int wc, int fr, int fq) const {
        const int row0 = u.pm * BM + wr * 64 + fr, col0 = u.pn * BM + wc * 32 + 8 * fq, seg = u.seg;
#pragma unroll
        for (int ai = 0; ai < 2; ++ai) {
            u32x2e ga[4][2], gb[4][2];
#pragma unroll
            for (int m = 0; m < 4; ++m) { const unsigned char* gp = MG + (size_t)(row0 + ai * HALF + m * 16) * 3072 + seg * 1024 + col0;
#pragma unroll
                for (int bj = 0; bj < 2; ++bj) { ga[m][bj] = *(const u32x2e*)(gp + bj * HALF); gb[m][bj] = seg < 2 ? *(const u32x2e*)(gp + 1024 + bj * HALF) : ga[m][bj]; } }
            EPI_PIN();
#pragma unroll
            for (int m = 0; m < 4; ++m) { const int row = row0 + ai * HALF + m * 16;
#pragma unroll
                for (int bj = 0; bj < 2; ++bj) { f32x4 a0 = gate_f4(ga[m][bj].x), a1 = gate_f4(ga[m][bj].y);
                    if (seg < 2) { const f32x4 b0 = gate_f4(gb[m][bj].x), b1 = gate_f4(gb[m][bj].y);
#pragma unroll
                        for (int e = 0; e < 4; ++e) { a0[e] = a0[e] * __builtin_amdgcn_rcpf(b0[e]); a1[e] = a1[e] * __builtin_amdgcn_rcpf(b1[e]); } }
                    else { a0 = a0 * (1.0f / 255.0f); a1 = a1 * (1.0f / 255.0f); }
                    acc[ai][bj][m][0] = acc[ai][bj][m][0] * a0; acc[ai][bj][m][1] = acc[ai][bj][m][1] * a1;
                    if (seg == 2) *(u32x4*)(OUT + (size_t)row * 1024 + col0 + bj * HALF) = pack8(acc[ai][bj][m][0], acc[ai][bj][m][1]); } }
        }
    }
};
struct EpiOut {
    static constexpr bool PERM = true, AFTER_DRAIN = false;
    const float* resid; float* out; bf16_t* XB; float* ssq; unsigned poison;
    __device__ __forceinline__ bool keep(const Unit&) const { return false; }
    __device__ __forceinline__ void operator()(f32x4 (&acc)[2][2][4][2], const Unit& u, int wr, int wc, int fr, int fq) const {
        const int row0 = u.pm * BM + wr * 64 + fr, col0 = u.pn * BM + wc * 32 + 8 * fq;
#pragma unroll
        for (int ai = 0; ai < 2; ++ai) {
            f32x4 rv[4][2][2];
#pragma unroll
            for (int m = 0; m < 4; ++m)
#pragma unroll
                for (int bj = 0; bj < 2; ++bj) { const size_t o = (size_t)(row0 + ai * HALF + m * 16) * 1024 + col0 + bj * HALF; rv[m][bj][0] = *(const f32x4*)(resid + o); rv[m][bj][1] = *(const f32x4*)(resid + o + 4); }
            EPI_PIN();
#pragma unroll
            for (int m = 0; m < 4; ++m) { const int row = row0 + ai * HALF + m * 16; float ss = 0.f;
#pragma unroll
                for (int bj = 0; bj < 2; ++bj) { const size_t o = (size_t)row * 1024 + col0 + bj * HALF;
                    f32x4 v0 = rv[m][bj][0] + acc[ai][bj][m][0], v1 = rv[m][bj][1] + acc[ai][bj][m][1];
                    if (poison) { const float qn = __builtin_nanf(""); v0 = (f32x4){qn, qn, qn, qn}; v1 = v0; }
                    *(f32x4*)(out + o) = v0; *(f32x4*)(out + o + 4) = v1;
                    if (XB) { *(u32x4*)(XB + o) = pack8(v0, v1); ss += ((v0[0] * v0[0] + v0[1] * v0[1]) + (v0[2] * v0[2] + v0[3] * v0[3])) + ((v1[0] * v1[0] + v1[1] * v1[1]) + (v1[2] * v1[2] + v1[3] * v1[3])); } }
                if (XB) { ss += __shfl_xor(ss, 16); ss += __shfl_xor(ss, 32); if (fq == 0) ssq[(size_t)row * 16 + u.pn * 4 + wc] = ss; } }
            EPI_PIN();
        }
    }
};
struct SegOrder {
    StaticOrder base;
    __device__ __forceinline__ bool next(int i, Unit& u) const { if (!base.next(i / 3, u)) return false; u.seg = i % 3; return true; }
    __device__ __forceinline__ void a_ready(const Unit&) const {}
    __device__ __forceinline__ void done(const Unit&) const {}
};

template <class Epi, class Sched, bool ALIGN_EPI = false, bool SP2 = false>
__device__ __forceinline__ void gemm_phase(PG8_LAS unsigned char* lds, const Gemm g, const Sched& S, const Epi& E, int wave_id) {
    int tid_ = (int)__builtin_amdgcn_mbcnt_hi(~0u, __builtin_amdgcn_mbcnt_lo(~0u, 0u)); asm volatile("" : "+v"(tid_)); tid_ += wave_id * 64;
    const int tid = tid_, wid = __builtin_amdgcn_readfirstlane(tid >> 6), lane = tid & 63, wr = wid >> 2, wc = wid & 3, fr = lane & 15, fq = lane >> 4;
    const int K = g.K, nt = K / BK;
    unsigned voffA[2], voffB[2];
#pragma unroll
    for (int i = 0; i < 2; ++i) { int R, C; stage_rc(tid * 16 + i * 8192, R, C); const int Rb = Epi::PERM ? ((R & ~31) + perm32(R & 31)) : R;
        voffA[i] = (unsigned)(R * g.lda + C) * 2u; voffB[i] = (unsigned)(Rb * g.ldb + C) * 2u; }
    const size_t kstep = (size_t)(BK * 2);
    const size_t hstepA = (size_t)HALF * g.lda * 2, hstepB = (size_t)HALF * g.ldb * 2;
    const size_t tstepA = 2 * hstepA, tstepB = 2 * hstepB, sstepA = (size_t)K * 2;
    const unsigned ldsw = (unsigned)wid * 1024u;
    const int aoff = lds_byte(wr * 64 + fr, fq * 8), boff = lds_byte(wc * 32 + fr, fq * 8);
#define PG8_SA(b, h) (((b) * 2 + (h)) * HTB)
#define PG8_SB(b, h) ((4 + (b) * 2 + (h)) * HTB)
#define PG8_STAGE(bufoff, gbase, voff) do { _Pragma("unroll") for (int _i = 0; _i < 2; ++_i) \
        __builtin_amdgcn_global_load_lds((const unsigned*)((const char*)(gbase) + (voff)[_i]), (PG8_LAS unsigned*)(lds + (bufoff) + ldsw + _i * 8192), 16, 0, 0); } while (0)
#define PG8_LDA(dst, b, h) do { _Pragma("unroll") for (int m = 0; m < 4; ++m) _Pragma("unroll") for (int k = 0; k < 2; ++k) dst[m][k] = *(const PG8_LAS bf16x8*)(lds + PG8_SA(b, h) + aoff + m * 2048 + k * 1024); } while (0)
#define PG8_LDB(dst, b, h) do { _Pragma("unroll") for (int n = 0; n < 2; ++n) _Pragma("unroll") for (int k = 0; k < 2; ++k) dst[n][k] = *(const PG8_LAS bf16x8*)(lds + PG8_SB(b, h) + boff + n * 2048 + k * 1024); } while (0)
#define PG8_MMA(ai, bj, At, Bt) do { __builtin_amdgcn_s_setprio(1); _Pragma("unroll") for (int m = 0; m < 4; ++m) _Pragma("unroll") for (int n = 0; n < 2; ++n) _Pragma("unroll") for (int k = 0; k < 2; ++k) \
        acc[ai][bj][m][n] = __builtin_amdgcn_mfma_f32_16x16x32_bf16(Bt[n][k], At[m][k], acc[ai][bj][m][n], 0, 0, 0); __builtin_amdgcn_s_setprio(0); } while (0)
#define PG8_WAIT_V(n) asm volatile("s_waitcnt vmcnt(" #n ")" ::: "memory")
#define PG8_WAIT_L(n) asm volatile("s_waitcnt lgkmcnt(" #n ")" ::: "memory")
#define PG8_BAR __builtin_amdgcn_s_barrier()
#define PG8_SCHED __builtin_amdgcn_sched_barrier(0)
    Unit cur, nxt; int ui = 0;
    if (!S.next(0, cur)) return;
    f32x4 acc[2][2][4][2];
#pragma unroll
    for (int a = 0; a < 2; ++a)
#pragma unroll
        for (int b = 0; b < 2; ++b)
#pragma unroll
            for (int m = 0; m < 4; ++m)
#pragma unroll
                for (int n = 0; n < 2; ++n) acc[a][b][m][n] = (f32x4){0.f, 0.f, 0.f, 0.f};
    bf16x8 At[4][2], B0[2][2], B1[2][2];
    const char* cA = (const char*)g.A + (size_t)cur.pm * tstepA + (size_t)cur.seg * sstepA; const char* cB = (const char*)g.Bt + (size_t)(cur.seg * g.segN + cur.pn) * tstepB;
    S.a_ready(cur);
    if constexpr (SP2) {
        PG8_STAGE(PG8_SB(0, 0), cB, voffB); PG8_STAGE(PG8_SB(0, 1), cB + hstepB, voffB); PG8_STAGE(PG8_SA(0, 0), cA, voffA); PG8_STAGE(PG8_SA(0, 1), cA + hstepA, voffA);
        if (wr == 1) PG8_BAR;
        PG8_WAIT_V(2); PG8_BAR;
        PG8_STAGE(PG8_SB(1, 0), cB + kstep, voffB); PG8_STAGE(PG8_SA(1, 0), cA + kstep, voffA); PG8_STAGE(PG8_SB(1, 1), cB + hstepB + kstep, voffB);
        PG8_WAIT_V(6); PG8_BAR;
    } else {
        PG8_STAGE(PG8_SB(0, 0), cB, voffB); PG8_STAGE(PG8_SA(0, 0), cA, voffA); PG8_STAGE(PG8_SB(0, 1), cB + hstepB, voffB); PG8_STAGE(PG8_SA(0, 1), cA + hstepA, voffA);
        if (wr == 1) PG8_BAR;
        PG8_WAIT_V(4); PG8_BAR;
        PG8_STAGE(PG8_SB(1, 0), cB + kstep, voffB); PG8_STAGE(PG8_SA(1, 0), cA + kstep, voffA); PG8_STAGE(PG8_SB(1, 1), cB + hstepB + kstep, voffB);
        PG8_WAIT_V(6); PG8_BAR;
    }
    for (;;) {
        const bool has_next = S.next(ui + 1, nxt);
        const char* nA = has_next ? (const char*)g.A + (size_t)nxt.pm * tstepA + (size_t)nxt.seg * sstepA : cA; const char* nB = has_next ? (const char*)g.Bt + (size_t)(nxt.seg * g.segN + nxt.pn) * tstepB : cB;
        for (int t = 0; t < nt; t += 2) {
            const bool last = (t == nt - 2);
            const char* a1 = cA + (size_t)(t + 1) * kstep;
            const char* a2 = last ? nA : cA + (size_t)(t + 2) * kstep; const char* b2 = last ? nB : cB + (size_t)(t + 2) * kstep;
            const char* a3 = a2 + kstep; const char* b3 = b2 + kstep;
            if (last && has_next) S.a_ready(nxt);
            if constexpr (SP2) {
            PG8_LDB(B0, 0, 0); PG8_LDB(B1, 0, 1); PG8_SCHED; PG8_LDA(At, 0, 0); PG8_STAGE(PG8_SA(1, 1), a1 + hstepA, voffA);
            PG8_WAIT_V(8); PG8_WAIT_L(0); PG8_BAR; PG8_MMA(0, 0, At, B0); PG8_MMA(0, 1, At, B1); PG8_BAR; PG8_SCHED;
            PG8_LDA(At, 0, 1); PG8_STAGE(PG8_SB(0, 0), b2, voffB); PG8_STAGE(PG8_SB(0, 1), b2 + hstepB, voffB); PG8_STAGE(PG8_SA(0, 0), a2, voffA);
            PG8_WAIT_V(8); PG8_WAIT_L(0); PG8_BAR; PG8_MMA(1, 0, At, B0); PG8_MMA(1, 1, At, B1); PG8_BAR; PG8_SCHED;
            PG8_LDB(B0, 1, 0); PG8_LDB(B1, 1, 1); PG8_SCHED; PG8_LDA(At, 1, 0); PG8_STAGE(PG8_SA(0, 1), a2 + hstepA, voffA);
            PG8_WAIT_V(8); PG8_WAIT_L(0); PG8_BAR; PG8_MMA(0, 0, At, B0); PG8_MMA(0, 1, At, B1); PG8_BAR; PG8_SCHED;
            PG8_LDA(At, 1, 1); PG8_STAGE(PG8_SB(1, 0), b3, voffB); PG8_STAGE(PG8_SB(1, 1), b3 + hstepB, voffB); PG8_STAGE(PG8_SA(1, 0), a3, voffA);
            PG8_WAIT_V(8); PG8_WAIT_L(0); PG8_BAR; PG8_MMA(1, 0, At, B0); PG8_MMA(1, 1, At, B1); PG8_BAR; PG8_SCHED;
            } else {
            PG8_LDB(B0, 0, 0); PG8_SCHED; PG8_LDA(At, 0, 0); PG8_STAGE(PG8_SA(1, 1), a1 + hstepA, voffA);
            PG8_WAIT_L(8); PG8_BAR; PG8_WAIT_L(0); PG8_MMA(0, 0, At, B0); PG8_BAR; PG8_SCHED;
            PG8_LDB(B1, 0, 1); PG8_STAGE(PG8_SB(0, 0), b2, voffB);
            PG8_BAR; PG8_WAIT_L(0); PG8_MMA(0, 1, At, B1); PG8_BAR;
            PG8_LDA(At, 0, 1); PG8_STAGE(PG8_SA(0, 0), a2, voffA);
            PG8_BAR; PG8_WAIT_L(0); PG8_MMA(1, 0, At, B0); PG8_BAR; PG8_SCHED;
            PG8_STAGE(PG8_SB(0, 1), b2 + hstepB, voffB);
            PG8_WAIT_V(6); PG8_BAR; PG8_MMA(1, 1, At, B1); PG8_BAR;
            PG8_LDB(B0, 1, 0); PG8_SCHED; PG8_LDA(At, 1, 0); PG8_STAGE(PG8_SA(0, 1), a2 + hstepA, voffA);
            PG8_WAIT_L(8); PG8_BAR; PG8_WAIT_L(0); PG8_MMA(0, 0, At, B0); PG8_BAR; PG8_SCHED;
            PG8_LDB(B1, 1, 1); PG8_STAGE(PG8_SB(1, 0), b3, voffB);
            PG8_BAR; PG8_WAIT_L(0); PG8_MMA(0, 1, At, B1); PG8_BAR;
            PG8_LDA(At, 1, 1); PG8_STAGE(PG8_SA(1, 0), a3, voffA);
            PG8_BAR; PG8_WAIT_L(0); PG8_MMA(1, 0, At, B0); PG8_BAR; PG8_SCHED;
            PG8_STAGE(PG8_SB(1, 1), b3 + hstepB, voffB);
            PG8_WAIT_V(6); PG8_BAR; PG8_MMA(1, 1, At, B1); PG8_BAR;
            }
        }
        if constexpr (ALIGN_EPI) { if (wr == 0) PG8_BAR; }
        if constexpr (!Epi::AFTER_DRAIN) { E(acc, cur, wr, wc, fr, fq); S.done(cur); }
        if (!has_next) break;
        if (!E.keep(cur)) {
#pragma unroll
        for (int a = 0; a < 2; ++a)
#pragma unroll
            for (int b = 0; b < 2; ++b)
#pragma unroll
                for (int m = 0; m < 4; ++m)
#pragma unroll
                    for (int n = 0; n < 2; ++n) acc[a][b][m][n] = (f32x4){0.f, 0.f, 0.f, 0.f};
        }
        cur = nxt; cA = nA; cB = nB; ++ui;
        if constexpr (ALIGN_EPI) { if (wr == 1) PG8_BAR; }
    }
    PG8_WAIT_V(0);
    if constexpr (!ALIGN_EPI) { if (wr == 0) PG8_BAR; }
    PG8_BAR;
    if constexpr (Epi::AFTER_DRAIN) { E.fused(acc, cur, wr, wc, fr, fq, lds, wid, lane); S.done(cur); }
#undef PG8_SA
#undef PG8_SB
#undef PG8_STAGE
#undef PG8_LDA
#undef PG8_LDB
#undef PG8_MMA
#undef PG8_WAIT_V
#undef PG8_WAIT_L
#undef PG8_BAR
#undef PG8_SCHED
}
}
#include <hip/hip_bf16.h>
#include <cmath>
namespace attn_body {
using bf16=__hip_bfloat16;
using bf16x8=__attribute__((ext_vector_type(8)))short;
using s16x4=__attribute__((ext_vector_type(4)))short;
using f32x16=__attribute__((ext_vector_type(16)))float;
using u32x4=__attribute__((ext_vector_type(4)))unsigned;
constexpr int BATCH=4,NHEAD=8,SEQ=8192,D=64,DM=NHEAD*D;
constexpr int NW=8,QBLK=32,QB=QBLK*NW,KVBLK=64,NQB=SEQ/QB;
constexpr int ATTN_PITCH=DM, ATTN_UNIT_ROWS=QB, OPITCH=1536, OCOL0=1024;
__device__ __forceinline__ int crow(int r,int hi){return (r&3)+8*(r>>2)+4*hi;}
#define SBAR() __builtin_amdgcn_sched_barrier(0)
__device__ __forceinline__ void cmask(f32x16&p0,f32x16&p1,int jb,int qrel,int hi){
  const float NEG=-INFINITY; int kb=64*jb+4*hi;
  #pragma unroll
  for(int r=0;r<16;++r){int kv=kb+(r&3)+8*(r>>2); if(kv>qrel)p0[r]=NEG; if(kv+32>qrel)p1[r]=NEG;}
}

constexpr int NSLOT=3, SLOTB=8192;
constexpr int LDS_K=0, LDS_V=NSLOT*SLOTB, LDS_WS=2*NSLOT*SLOTB, LDS_OST=LDS_WS+NW*64*4, LDS_BYTES=LDS_OST+NW*4096;
constexpr float C2=0.125f*1.4426950408889634f;
__device__ __forceinline__ void glds16(const void*gsrc,unsigned lds_dst){unsigned keep;
  asm volatile("s_mov_b32 %0, m0\n\ts_mov_b32 m0, %2\n\ts_nop 0\n\tglobal_load_lds_dwordx4 %1, off\n\ts_mov_b32 m0, %0":"=&s"(keep):"v"(gsrc),"s"(lds_dst):"memory");}
__device__ __forceinline__ float max3f(float a,float b,float c){float r;asm("v_max3_f32 %0, %1, %2, %3":"=v"(r):"v"(a),"v"(b),"v"(c));return r;}
__device__ __forceinline__ float max2f(float a,float b){float r;asm("v_max_f32_e32 %0, %1, %2":"=v"(r):"v"(a),"v"(b));return r;}
__device__ __forceinline__ float fadd_s(float a,float b){float r;asm("v_add_f32_e32 %0, %1, %2":"=v"(r):"v"(a),"v"(b));return r;}
__device__ __forceinline__ float fsub_s(float a,float b){float r;asm("v_sub_f32_e32 %0, %1, %2":"=v"(r):"v"(a),"v"(b));return r;}
typedef float f32x2_t __attribute__((ext_vector_type(2))); typedef __bf16 bf16x2_t __attribute__((ext_vector_type(2)));
__device__ __forceinline__ unsigned cvtpk_s(float lo,float hi){f32x2_t v={lo,hi};bf16x2_t b=__builtin_convertvector(v,bf16x2_t);return __builtin_bit_cast(unsigned,b);}
#define WAIT_BAR(N) asm volatile("s_waitcnt vmcnt(" #N ") lgkmcnt(0)\n\ts_barrier":::"memory")

__device__ __forceinline__ void qkt(f32x16&p0,f32x16&p1,const char*Kslot,const bf16x8*qr,int r32,int hi){
  const char*kb=Kslot+hi*1024+r32*16;
  #pragma unroll
  for(int d0=0;d0<4;++d0){
    const bf16x8 b0=*reinterpret_cast<const bf16x8*>(kb+d0*2048);
    const bf16x8 b1=*reinterpret_cast<const bf16x8*>(kb+d0*2048+512);
    p0=__builtin_amdgcn_mfma_f32_32x32x16_bf16(b0,qr[d0],p0,0,0,0);p1=__builtin_amdgcn_mfma_f32_32x32x16_bf16(b1,qr[d0],p1,0,0,0);}
}
typedef __attribute__((address_space(3))) const unsigned* lds_cuptr;
typedef float f32x4_t __attribute__((ext_vector_type(4)));
__device__ __forceinline__ unsigned bfr(float f){ unsigned u=__builtin_bit_cast(unsigned,f); return (u+0x7fffu+((u>>16)&1u))>>16; }
__device__ __forceinline__ void biasmm(f32x16&c0,f32x16&c1,unsigned w0,unsigned w1  ,unsigned qm1,int hi){
  const unsigned one=hi?0u:0x3f803f80u; w0=hi?0u:w0; w1=hi?0u:w1;
  const u32x4 k0={w0,one,0u,0u},k1={w1,one,0u,0u},qv={one,qm1,0u,0u};
  const f32x16 z=f32x16{};
  c0=__builtin_amdgcn_mfma_f32_32x32x16_bf16(__builtin_bit_cast(bf16x8,k0),__builtin_bit_cast(bf16x8,qv),z,0,0,0);
  c1=__builtin_amdgcn_mfma_f32_32x32x16_bf16(__builtin_bit_cast(bf16x8,k1),__builtin_bit_cast(bf16x8,qv),z,0,0,0);
}
typedef __attribute__((address_space(3))) const char* lds_cptr;
typedef short v4i16_t __attribute__((ext_vector_type(4)));
__device__ __forceinline__ void kload8(bf16x8*kf,lds_cptr kp){
  kf[0]=*(const __attribute__((address_space(3))) bf16x8*)(kp);      kf[1]=*(const __attribute__((address_space(3))) bf16x8*)(kp+512);
  kf[2]=*(const __attribute__((address_space(3))) bf16x8*)(kp+2048); kf[3]=*(const __attribute__((address_space(3))) bf16x8*)(kp+2560);
  kf[4]=*(const __attribute__((address_space(3))) bf16x8*)(kp+4096); kf[5]=*(const __attribute__((address_space(3))) bf16x8*)(kp+4608);
  kf[6]=*(const __attribute__((address_space(3))) bf16x8*)(kp+6144); kf[7]=*(const __attribute__((address_space(3))) bf16x8*)(kp+6656);
}
__device__ __forceinline__ void kload2(bf16x8*kf,lds_cptr kp,int j){ kf[2*j]=*(const __attribute__((address_space(3))) bf16x8*)(kp+j*2048); kf[2*j+1]=*(const __attribute__((address_space(3))) bf16x8*)(kp+j*2048+512); }
__device__ __forceinline__ s16x4 vtr(lds_cptr p){ return __builtin_bit_cast(s16x4,__builtin_amdgcn_ds_read_tr16_b64_v4i16((__attribute__((address_space(3))) v4i16_t*)p)); }
__device__ __forceinline__ float rowmax(const f32x16&p0,const f32x16&p1){
  float a=max3f(p0[0],p0[1],p1[0]),b=max3f(p0[2],p0[3],p1[1]);a=max3f(a,p1[2],p1[3]);
  #pragma unroll
  for(int r=4;r<16;r+=4){a=max3f(a,p0[r],p0[r+1]);b=max3f(b,p0[r+2],p0[r+3]);a=max3f(a,p1[r],p1[r+1]);b=max3f(b,p1[r+2],p1[r+3]);}
  const float m=max2f(a,b);
  auto rr=__builtin_amdgcn_permlane32_swap(__float_as_uint(m),__float_as_uint(m),false,false);
  return max2f(__uint_as_float(rr[0]),__uint_as_float(rr[1]));
}
__device__ __forceinline__ void pv(f32x16*o,int vb,bf16x8 pa0,bf16x8 pa1,bf16x8 pa2,bf16x8 pa3){
  #pragma unroll
  for(int d0=0;d0<2;++d0){s16x4 lo[4],hi[4];
    #pragma unroll
    for(int ks=0;ks<4;++ks){
      asm volatile("ds_read_b64_tr_b16 %0,%1 offset:%c2":"=&v"(lo[ks]):"v"(vb),"i"(d0*4096+ks*1024):"memory");
      asm volatile("ds_read_b64_tr_b16 %0,%1 offset:%c2":"=&v"(hi[ks]):"v"(vb),"i"(d0*4096+ks*1024+512):"memory");}
    asm volatile("s_waitcnt lgkmcnt(0)":::"memory");SBAR();
    #define PK(k) (bf16x8){lo[k][0],lo[k][1],lo[k][2],lo[k][3],hi[k][0],hi[k][1],hi[k][2],hi[k][3]}
    o[d0]=__builtin_amdgcn_mfma_f32_32x32x16_bf16(pa0,PK(0),o[d0],0,0,0);
    o[d0]=__builtin_amdgcn_mfma_f32_32x32x16_bf16(pa1,PK(1),o[d0],0,0,0);
    o[d0]=__builtin_amdgcn_mfma_f32_32x32x16_bf16(pa2,PK(2),o[d0],0,0,0);
    o[d0]=__builtin_amdgcn_mfma_f32_32x32x16_bf16(pa3,PK(3),o[d0],0,0,0);
    #undef PK
  }
}

__device__ __forceinline__ u32x4 mul_bf16x8(u32x4 a,u32x4 b){ u32x4 r;
  #pragma unroll
  for(int i=0;i<4;++i){ const float al=__uint_as_float(a[i]<<16),ah=__uint_as_float(a[i]&0xffff0000u),bl=__uint_as_float(b[i]<<16),bh=__uint_as_float(b[i]&0xffff0000u); r[i]=cvtpk_s(al*bl,ah*bh); }
  return r; }
#ifndef ATTN_STORE16
#define ATTN_STORE16(p,v) (*(u32x4*)(p)=(v))
#endif
template<int THRL> __device__ __forceinline__ void attn_unit(int b,int h,int qb,const bf16*Q,const bf16*__restrict__ K,const bf16*__restrict__ V,bf16*O,char*shm,lds_cuptr nb,int tskip,bool dry,int wave_id){
  int tid_=(int)__builtin_amdgcn_mbcnt_hi(~0u,__builtin_amdgcn_mbcnt_lo(~0u,0u)); asm volatile("":"+v"(tid_)); tid_+=wave_id*64; const int tid=tid_,lane=tid&63,r32=lane&31,hi=lane>>5; const int wid=__builtin_amdgcn_readfirstlane(tid>>6);
  const long rowbase=(long)b*SEQ; const int q0=qb*QB;
  const bf16*Qw=Q+(rowbase+q0+wid*QBLK)*DM+h*D;
  const bf16*Kh=K+(rowbase+(long)tskip*KVBLK)*DM+h*D,*Vh=V+(rowbase+(long)tskip*KVBLK)*DM+h*D;
  const unsigned lds0=(unsigned)(uintptr_t)shm;
  float*wsf=(float*)(shm+LDS_WS)+wid*64;
  const bf16*ksrc=Kh+(long)lane*DM+wid*8;
  const bf16*vsrc=Vh+(long)(16*(wid&3)+(lane>>2))*DM+(wid>>2)*32+(lane&3)*8;
  const unsigned kdst=lds0+LDS_K+wid*1024, vdst=lds0+LDS_V+wid*1024;
  #define DMA_K(t,slot) glds16(ksrc+(long)(t)*KVBLK*DM,(unsigned)__builtin_amdgcn_readfirstlane(kdst+(slot)))
  #define DMA_V(t,slot) glds16(vsrc+(long)(t)*KVBLK*DM,(unsigned)__builtin_amdgcn_readfirstlane(vdst+(slot)))
  const int vb0=(int)(lds0+LDS_V)+((lane>>4)&1)*32+(lane&3)*8+(4*hi+((lane&15)>>2))*64;
  const char*Kbase=shm+LDS_K; bf16x8 kf[8];
  const lds_cptr shm3=(lds_cptr)shm; const lds_cptr kp0=shm3+LDS_K+hi*1024+r32*16; const lds_cptr vp0=shm3+LDS_V+((lane>>4)&1)*32+(lane&3)*8+(4*hi+((lane&15)>>2))*64;
  const int NT=(q0+QB)/KVBLK-tskip;
  DMA_K(0,0);DMA_V(0,0);DMA_K(1,SLOTB);
  bf16x8 qr[4];
  #pragma unroll
  for(int d0=0;d0<4;++d0)qr[d0]=*reinterpret_cast<const bf16x8*>(&Qw[(long)r32*DM+d0*16+hi*8]);
  float mhat=0.f,l_reg=0.f;f32x16 o[2];o[0]=f32x16{};o[1]=f32x16{};unsigned qm1=0u;const lds_cuptr nbl=nb+64*tskip+r32;
  #define SETM(NEWM) do{ const float nm_=-(NEWM); const unsigned h_=bfr(nm_); const float hf_=__uint_as_float(h_<<16); const unsigned l_=bfr(nm_-hf_); mhat=-(hf_+__uint_as_float(l_<<16)); qm1=hi?0u:(h_|(l_<<16)); }while(0)
  const int qrel=wid*QBLK+r32;
  #define CMASK(P0,P1,t) do{int jb_=(t)-(NT-4); if(jb_>=0)cmask(P0,P1,jb_,qrel,hi);}while(0)
  bool resc=false;
  #define START(P0,P1) do{ const float rm=rowmax(P0,P1); resc=false; \
    { const float old_=mhat; SETM(old_+rm); const float dl=mhat-old_; \
      _Pragma("unroll") for(int r=0;r<16;++r){P0[r]=fsub_s(P0[r],dl);P1[r]=fsub_s(P1[r],dl);} } \
    _Pragma("unroll") for(int r=0;r<16;++r)P0[r]=__builtin_amdgcn_exp2f(P0[r]); }while(0)
  #define RESC() do{ if(resc){ asm volatile("s_waitcnt lgkmcnt(0)":::"memory"); \
      _Pragma("unroll") for(int d_=0;d_<2;++d_) _Pragma("unroll") for(int r=0;r<16;++r)o[d_][r]*=wsf[crow(r,hi)]; } }while(0)
  f32x16 pA0,pA1,pB0,pB1;
  int sl_prev=0,sl_cur=0,sl_next=SLOTB;
  #define ROT() do{sl_prev=sl_cur;sl_cur=sl_next;sl_next=(sl_next==(NSLOT-1)*SLOTB)?0:sl_next+SLOTB;}while(0)
  DMA_K(2,2*SLOTB);
  WAIT_BAR(3);
  unsigned bw0=nbl[0],bw1=nbl[32]; biasmm(pA0,pA1,bw0,bw1,qm1,hi); bw0=nbl[64]; bw1=nbl[96]; qkt(pA0,pA1,Kbase,qr,r32,hi);    asm volatile("s_nop 15\n\ts_nop 7":"+v"(pA0),"+v"(pA1));CMASK(pA0,pA1,0);
  START(pA0,pA1);
  _Pragma("unroll") for(int r=0;r<16;++r)pA1[r]=__builtin_amdgcn_exp2f(pA1[r]);
  WAIT_BAR(0);
  DMA_K(3,0);DMA_V(1,SLOTB);
  ROT();
  kload8(kf,kp0+sl_cur);
  WAIT_BAR(2);
  s16x4 vlo[8],vhi[8]; u32x4 pw0,pw1,pw2,pw3;
  #define PKW(P,B) cvtpk_s(P[B],P[B+1])
  #define PAF(k) __builtin_bit_cast(bf16x8,pw##k)
  #define VFR(i) (bf16x8){vlo[i][0],vlo[i][1],vlo[i][2],vlo[i][3],vhi[i][0],vhi[i][1],vhi[i][2],vhi[i][3]}
  #define PIN(x) asm volatile("":"+v"(x))
  #define MX3(a,b,c) __builtin_fmaxf(__builtin_fmaxf((a),(b)),(c))
  #define GAPA(MF,A0,A1,A2,A3,W0,W1,PW) do{ MF; sacc+=A0; sacc+=A1; sacc+=A2; sacc+=A3; PIN(sacc); W0; W1; PIN(PW); SBAR(); }while(0)
  #define EX(v) __builtin_amdgcn_exp2f(v)
  #define GAPB(MF,X,B) do{ MF; X[B]=EX(X[B]); X[B+1]=EX(X[B+1]); X[B+2]=EX(X[B+2]); X[B+3]=EX(X[B+3]); PIN(X); SBAR(); }while(0)
  #define VRD(i) do{ vlo[i]=vtr(vp_+(((i)>>2)*4096+((i)&3)*1024)); vhi[i]=vtr(vp_+(((i)>>2)*4096+((i)&3)*1024+512)); }while(0)
  #define KRD(G,j) do{ if(G){ kload2(kf,kp0+sl_next,j); SBAR(); } }while(0)
  #define STEP(C0,C1,P0,P1,t,GK,GV,GL) do{ SBAR(); \
    biasmm(C0,C1,bw0,bw1,qm1,hi); bw0=nbl[64*((t)+1)]; bw1=nbl[64*((t)+1)+32]; SBAR(); \
    const lds_cptr vp_=vp0+sl_prev; \
    VRD(0); SBAR(); float sacc=(P0[0]+P0[1]); \
    GAPA(C0=__builtin_amdgcn_mfma_f32_32x32x16_bf16(kf[0],qr[0],C0,0,0,0), P0[2],P0[3],P0[4],P0[5],     pw0[0]=PKW(P0,0), pw0[1]=PKW(P0,2), pw0); \
    VRD(4); SBAR(); GAPA(C1=__builtin_amdgcn_mfma_f32_32x32x16_bf16(kf[1],qr[0],C1,0,0,0), P0[6],P0[7],P0[8],P0[9],     pw0[2]=PKW(P0,4), pw0[3]=PKW(P0,6), pw0); \
    VRD(1); SBAR(); GAPA(C0=__builtin_amdgcn_mfma_f32_32x32x16_bf16(kf[2],qr[1],C0,0,0,0),   P0[10],P0[11],P0[12],P0[13], pw1[0]=PKW(P0,8), pw1[1]=PKW(P0,10), pw1); \
    VRD(5); SBAR(); GAPA(C1=__builtin_amdgcn_mfma_f32_32x32x16_bf16(kf[3],qr[1],C1,0,0,0),   P0[14],P0[15],P1[0],P1[1],   pw1[2]=PKW(P0,12),pw1[3]=PKW(P0,14), pw1); \
    VRD(2); SBAR(); GAPA(C0=__builtin_amdgcn_mfma_f32_32x32x16_bf16(kf[4],qr[2],C0,0,0,0),   P1[2],P1[3],P1[4],P1[5],     pw2[0]=PKW(P1,0), pw2[1]=PKW(P1,2), pw2); \
    VRD(6); SBAR(); GAPA(C1=__builtin_amdgcn_mfma_f32_32x32x16_bf16(kf[5],qr[2],C1,0,0,0),   P1[6],P1[7],P1[8],P1[9],     pw2[2]=PKW(P1,4), pw2[3]=PKW(P1,6), pw2); \
    VRD(3); SBAR(); GAPA(C0=__builtin_amdgcn_mfma_f32_32x32x16_bf16(kf[6],qr[3],C0,0,0,0),   P1[10],P1[11],P1[12],P1[13], pw3[0]=PKW(P1,8), pw3[1]=PKW(P1,10), pw3); \
    VRD(7); SBAR(); GAPA(C1=__builtin_amdgcn_mfma_f32_32x32x16_bf16(kf[7],qr[3],C1,0,0,0),   P1[14],P1[15],0.f,0.f,       pw3[2]=PKW(P1,12),pw3[3]=PKW(P1,14), pw3); \
    l_reg+=sacc; \
    if(GK){DMA_K((t)+3,sl_cur);} if(GV){DMA_V((t)+1,sl_next);} \
    CMASK(C0,C1,t); \
    { float a=MX3(C0[0],C0[1],C1[0]),b=MX3(C0[2],C0[3],C1[1]); a=MX3(a,C1[2],C1[3]); \
      _Pragma("unroll") for(int r=4;r<16;r+=4){a=MX3(a,C0[r],C0[r+1]);b=MX3(b,C0[r+2],C0[r+3]);a=MX3(a,C1[r],C1[r+1]);b=MX3(b,C1[r+2],C1[r+3]);} \
      float rm=__builtin_fmaxf(a,b); { auto rr=__builtin_amdgcn_permlane32_swap(__float_as_uint(rm),__float_as_uint(rm),false,false); rm=__builtin_fmaxf(__uint_as_float(rr[0]),__uint_as_float(rr[1])); } \
      resc=false; \
      if(__builtin_expect(__any(rm>(float)THRL),0)){ const float old_=mhat; SETM(old_+__builtin_fmaxf(rm,0.f)); const float dl=mhat-old_; \
        _Pragma("unroll") for(int r=0;r<16;++r){C0[r]-=dl;C1[r]-=dl;} \
        const float f=__builtin_amdgcn_exp2f(-dl); l_reg*=f; if(hi==0)wsf[r32]=f; resc=true; } } \
    SBAR(); \
    GAPB(o[0]=__builtin_amdgcn_mfma_f32_32x32x16_bf16(PAF(0),VFR(0),o[0],0,0,0), C0,0); \
    GAPB(o[1]=__builtin_amdgcn_mfma_f32_32x32x16_bf16(PAF(0),VFR(4),o[1],0,0,0), C0,4); \
    KRD(GL,0); GAPB(o[0]=__builtin_amdgcn_mfma_f32_32x32x16_bf16(PAF(1),VFR(1),o[0],0,0,0), C0,8); \
    KRD(GL,1); GAPB(o[1]=__builtin_amdgcn_mfma_f32_32x32x16_bf16(PAF(1),VFR(5),o[1],0,0,0), C0,12); \
    KRD(GL,2); GAPB(o[0]=__builtin_amdgcn_mfma_f32_32x32x16_bf16(PAF(2),VFR(2),o[0],0,0,0), C1,0); \
    KRD(GL,3); GAPB(o[1]=__builtin_amdgcn_mfma_f32_32x32x16_bf16(PAF(2),VFR(6),o[1],0,0,0), C1,4); \
    GAPB(o[0]=__builtin_amdgcn_mfma_f32_32x32x16_bf16(PAF(3),VFR(3),o[0],0,0,0), C1,8); \
    GAPB(o[1]=__builtin_amdgcn_mfma_f32_32x32x16_bf16(PAF(3),VFR(7),o[1],0,0,0), C1,12); \
    }while(0)
  int t=1;
  #undef CMASK
  #define CMASK(P0,P1,t) do{}while(0)
  for(;t+5<NT;t+=2){
    STEP(pB0,pB1,pA0,pA1,t,true,true,true);     WAIT_BAR(2); RESC(); ROT();
    STEP(pA0,pA1,pB0,pB1,t+1,true,true,true);   WAIT_BAR(2); RESC(); ROT();
  }
  #undef CMASK
  #define CMASK(P0,P1,t) do{int jb_=(t)-(NT-4); if(jb_>=0)cmask(P0,P1,jb_,qrel,hi);}while(0)
  #define ENDW(tt) do{ if((tt)+3<NT){WAIT_BAR(2);} else if((tt)+2<NT){WAIT_BAR(1);} else {WAIT_BAR(0);} }while(0)
  for(;t+1<NT;t+=2){
    STEP(pB0,pB1,pA0,pA1,t,(t+3<NT),(t+1<NT),(t+1<NT));       ENDW(t);   RESC(); ROT();
    STEP(pA0,pA1,pB0,pB1,t+1,(t+4<NT),(t+2<NT),(t+2<NT));     ENDW(t+1); RESC(); ROT();
  }
  STEP(pB0,pB1,pA0,pA1,NT-1,false,false,false); RESC();
  { float sacc=pB0[0]+pB0[1]; _Pragma("unroll") for(int r=2;r<16;++r)sacc+=pB0[r]; _Pragma("unroll") for(int r=0;r<16;++r)sacc+=pB1[r]; l_reg+=sacc;
    pw0=(u32x4){PKW(pB0,0),PKW(pB0,2),PKW(pB0,4),PKW(pB0,6)};pw1=(u32x4){PKW(pB0,8),PKW(pB0,10),PKW(pB0,12),PKW(pB0,14)};pw2=(u32x4){PKW(pB1,0),PKW(pB1,2),PKW(pB1,4),PKW(pB1,6)};pw3=(u32x4){PKW(pB1,8),PKW(pB1,10),PKW(pB1,12),PKW(pB1,14)};
    SBAR(); pv(o,vb0+sl_cur,PAF(0),PAF(1),PAF(2),PAF(3)); }
  #undef PKW
  #undef PAF
  #undef VFR
  #undef PIN
  #undef MX3
  #undef GAPA
  #undef GAPB
  #undef EX
  #undef VRD
  #undef KRD
  #undef STEP
  #undef ENDW
  {auto rr=__builtin_amdgcn_permlane32_swap(__float_as_uint(l_reg),__float_as_uint(l_reg),false,false);l_reg=__uint_as_float(rr[0])+__uint_as_float(rr[1]);}
  if(hi==0)wsf[32+r32]=l_reg;asm volatile("s_waitcnt lgkmcnt(0)":::"memory");
  float rli[16];
  #pragma unroll
  for(int r=0;r<16;++r)rli[r]=__builtin_amdgcn_rcpf(wsf[32+crow(r,hi)]);
  bf16*Ow=O+(rowbase+q0+wid*QBLK)*(long)OPITCH+OCOL0+h*D;
  { bf16*stg=(bf16*)(shm+LDS_OST)+wid*2048;
    #pragma unroll
    for(int r=0;r<16;++r){const int orow=crow(r,hi);
      #pragma unroll
      for(int d0=0;d0<2;++d0)stg[orow*64+d0*32+r32]=__float2bfloat16(o[d0][r]*rli[r]);}
    asm volatile("s_waitcnt lgkmcnt(0)":::"memory");
    #pragma unroll
    for(int i=0;i<4;++i){const int row=i*8+(lane>>3),ch=lane&7; const u32x4 v=*(const u32x4*)(stg+row*64+ch*8); bf16*gp=Ow+(long)row*OPITCH+ch*8; const u32x4 gt=*(const u32x4*)gp; if(!dry){ATTN_STORE16(gp,mul_bf16x8(v,gt));}} }
  asm volatile("s_waitcnt lgkmcnt(0)\n\ts_barrier":::"memory");
  #undef DMA_K
  #undef DMA_V
  #undef CMASK
  #undef START
  #undef RESC
  #undef ROT
  #undef SETM
}
constexpr int ATTN_LDS_BYTES=LDS_BYTES;
#undef SBAR
#undef WAIT_BAR
}
constexpr int BATCH = 4, SEQ = 8192, DMODEL = 1024, M = BATCH * SEQ, DEPTH = 2, INC = 7852;
constexpr int NT_A = 19, NT_B = 12, NTILES = NT_A + NT_B;
constexpr int SA_Q = 0, SA_K = 512, SA_V = 640, SA_G = 768, SB_Q = 1280, SB_K = 1792, SB_V = 1920, SB_IQ = 2048, SB_IK = 2176, SB_IW = 2208, SB_G = 2212,
              SC_Q = 2724, SC_K = 3236, SC_V = 3748, SC_F = 4260, SC_G = 4268, S_MG = 4780;
static_assert(S_MG + 3072 == INC, "column partition");
__host__ __device__ __forceinline__ int src_col(int t, int lc) {
    switch (t) {
        case 0: case 1: return SA_Q + t * 256 + lc;
        case 2: case 3: return SB_Q + (t - 2) * 256 + lc;
        case 4: case 5: return SC_Q + (t - 4) * 256 + lc;
        case 6: return lc < 128 ? SA_K + lc : SB_K + lc - 128;
        case 7: case 8: return SC_K + (t - 7) * 256 + lc;
        case 9: return lc < 128 ? SA_V + lc : SB_V + lc - 128;
        case 10: case 11: return SC_V + (t - 10) * 256 + lc;
        case 12: case 13: return SA_G + (t - 12) * 256 + lc;
        case 14: case 15: return SB_G + (t - 14) * 256 + lc;
        case 16: case 17: return SC_G + (t - 16) * 256 + lc;
        case 18: return lc < 128 ? SB_IQ + lc : lc < 160 ? SB_IK + lc - 128 : lc < 164 ? SB_IW + lc - 160 : lc < 172 ? SC_F + lc - 164 : -1;
        default: return S_MG + (t - 19) * 256 + lc;
    }
}
constexpr size_t MiB = 1u << 20;
constexpr size_t WS_CTL = 0, CTL_ZERO_BYTES = 1 * MiB;
constexpr size_t WS_W1T = 2 * MiB;
constexpr size_t WS_WBT = 33 * MiB;
constexpr size_t WS_WOT = 39 * MiB;
constexpr size_t WS_SSQ = 43 * MiB;
constexpr size_t WS_CL = 45 * MiB;
constexpr size_t WS_CT = 46 * MiB;
constexpr size_t WS_IW = 47 * MiB;
constexpr size_t WS_CF = 47 * MiB + 512 * 1024;
constexpr size_t WS_IQ = 49 * MiB;
constexpr size_t WS_IK = 57 * MiB;
constexpr size_t WS_XB = 60 * MiB;
constexpr size_t WS_MERGED = 124 * MiB;
constexpr size_t WS_G = 188 * MiB;
constexpr size_t WS_QA = 284 * MiB, WS_QB = 316 * MiB, WS_QC = 348 * MiB, WS_KC = 380 * MiB, WS_VC = 412 * MiB, WS_KAB = 444 * MiB, WS_VAB = 460 * MiB;
constexpr size_t WS_MG = 284 * MiB;
constexpr size_t WS_END = 476 * MiB;
static_assert(pg8::EWS_CL == WS_CL && pg8::EWS_CT == WS_CT && pg8::EWS_SSQ == WS_SSQ && pg8::EWS_IW == WS_IW && pg8::EWS_CF == WS_CF && pg8::EWS_IQ == WS_IQ && pg8::EWS_IK == WS_IK && pg8::EWS_G == WS_G && pg8::EWS_QA == WS_QA && pg8::EWS_QB == WS_QB &&
              pg8::EWS_QC == WS_QC && pg8::EWS_KC == WS_KC && pg8::EWS_VC == WS_VC && pg8::EWS_KAB == WS_KAB && pg8::EWS_VAB == WS_VAB, "epilogue offsets");
constexpr int CW_OVF = 8;
constexpr int CW_TICK = 8192;
constexpr int CW_BAR = 4096;
constexpr int RING_OFF = 0, RING_BYTES = 131072;
constexpr int SEL_OFF = 131072;
constexpr int H2_OFF = SEL_OFF + 8192;
constexpr int BIAS_OFF = H2_OFF + 8192;
constexpr int BKT_OFF = BIAS_OFF + 2048;
constexpr int MISC_OFF = BKT_OFF + 512;
constexpr int LDS_BYTES = 155648;
static_assert(MISC_OFF + 1024 <= LDS_BYTES, "LDS map");
constexpr int NB_OFF = 86016;
static_assert(attn_body::ATTN_LDS_BYTES <= NB_OFF && NB_OFF + 32768 <= RING_BYTES, "LDS map");
constexpr int MW_NSEL = 0, MW_NCAND = 16, MW_BIN = 32, MW_ABOVE = 48, MW_CARRY = 64, MW_BAR = 96, MW_SLOW = 100, MW_TICKET = 101, MW_ZCUT = 112, MW_UC = 128, MW_ELO = 160;

#define GAS __attribute__((address_space(1)))
#define LAS __attribute__((address_space(3)))
typedef unsigned short bf16;
typedef unsigned v4u __attribute__((ext_vector_type(4)));
typedef float f32x4 __attribute__((ext_vector_type(4)));
typedef short bf16x8 __attribute__((ext_vector_type(8)));
typedef GAS unsigned gu32;
#define RLX_AGENT __ATOMIC_RELAXED, __HIP_MEMORY_SCOPE_AGENT
#define LDS_WAIT() asm volatile("s_waitcnt lgkmcnt(0)" ::: "memory")
#define VM_WAIT() asm volatile("s_waitcnt vmcnt(0)" ::: "memory")
__device__ __forceinline__ unsigned f2bf(float f) { unsigned u = __builtin_bit_cast(unsigned, f); return (u + 0x7fffu + ((u >> 16) & 1u)) >> 16; }
__device__ __forceinline__ unsigned pk2(float lo, float hi) { return f2bf(lo) | (f2bf(hi) << 16); }

#define XB_TMO      128
#define XB_XCNT(j)  (256  + 64 * (j))
#define XB_XSUB(j)  (1280 + 64 * (j))
#define XB_XGEN(j)  (2304 + 64 * (j))
#define XB_TOP      3328
#define XB_TOPGEN   3392
#define XCD_BAR_WORDS 3456
#define XB_SPIN_CAP (1u << 18)

__device__ __forceinline__ unsigned xb_ld(unsigned* p)              { return __hip_atomic_load(p, __ATOMIC_RELAXED, __HIP_MEMORY_SCOPE_AGENT); }
__device__ __forceinline__ unsigned xb_add(unsigned* p, unsigned v) { return __hip_atomic_fetch_add(p, v, __ATOMIC_RELAXED, __HIP_MEMORY_SCOPE_AGENT); }
__device__ __forceinline__ unsigned xb_xcc_id() { return (unsigned)__builtin_amdgcn_s_getreg((3 << 11) | 20) & 0xFu; }
#define XB_SPIN(cond, bar) do { unsigned _sp = 0; while (cond) { __builtin_amdgcn_s_sleep(1); \
    if ((++_sp & 255u) == 0u) { if (xb_ld(&(bar)[XB_TMO])) break; if (_sp > XB_SPIN_CAP) { atomicAdd(&(bar)[XB_TMO], 1u); break; } } } } while (0)

struct XcdBarrier {
    unsigned* bar; unsigned x;
    volatile LAS unsigned* st;
};

__device__ __forceinline__ XcdBarrier xcd_barrier_post(unsigned* bar, volatile LAS unsigned* st) {
    XcdBarrier b; b.bar = bar; b.x = xb_xcc_id(); b.st = st;
    if (threadIdx.x == 0) (void)xb_add(&bar[XB_XCNT(b.x)], 1u);
    return b;
}
__device__ __forceinline__ void xcd_barrier_complete(unsigned* bar, unsigned x, unsigned& nloc, unsigned& nx) {
    const unsigned G = gridDim.x * gridDim.y * gridDim.z;
    unsigned sum, cnt, mine, sp = 0u;
    for (;;) {
        sum = 0u; cnt = 0u; mine = 0u;
#pragma unroll
        for (unsigned j = 0; j < 16; ++j) { const unsigned c = xb_ld(&bar[XB_XCNT(j)]); sum += c; cnt += (c > 0u) ? 1u : 0u; mine = (j == x) ? c : mine; }
        if (sum == G) break;
        __builtin_amdgcn_s_sleep(1);
        if ((++sp & 255u) == 0u) { if (xb_ld(&bar[XB_TMO])) break; if (sp > XB_SPIN_CAP) { atomicAdd(&bar[XB_TMO], 1u); break; } }
    }
    nloc = mine > 0u ? mine : 1u; nx = cnt > 0u ? cnt : 1u;
}

__device__ __forceinline__ void xcd_barrier(const XcdBarrier& b) {
    asm volatile("s_waitcnt vmcnt(0)" ::: "memory");
    __syncthreads();
    if (threadIdx.x == 0) {
        unsigned* bar = b.bar;
        __builtin_amdgcn_s_waitcnt(0);
        unsigned nloc = b.st[0], nx = b.st[1];
        if (nloc == 0u) { xcd_barrier_complete(bar, b.x, nloc, nx); b.st[0] = nloc; b.st[1] = nx; }
        const unsigned old = xb_add(&bar[XB_XSUB(b.x)], 1u);
        const unsigned gen = old / nloc;
        if (old + 1u == (gen + 1u) * nloc) {
            __builtin_amdgcn_fence(__ATOMIC_RELEASE, "agent");
            asm volatile("s_waitcnt vmcnt(0)" ::: "memory");
            const unsigned og = xb_add(&bar[XB_TOP], 1u);
            const unsigned tg = og / nx;
            if (og + 1u == (tg + 1u) * nx) xb_add(&bar[XB_TOPGEN], 1u);
            else XB_SPIN(xb_ld(&bar[XB_TOPGEN]) == tg, bar);
            __builtin_amdgcn_fence(__ATOMIC_ACQUIRE, "agent");
            xb_add(&bar[XB_XGEN(b.x)], 1u);
            asm volatile("s_waitcnt vmcnt(0)" ::: "memory");
        } else {
            XB_SPIN(xb_ld(&bar[XB_XGEN(b.x)]) == gen, bar);
            __builtin_amdgcn_fence(__ATOMIC_ACQUIRE, "agent");
            asm volatile("s_waitcnt vmcnt(0)" ::: "memory");
        }
    }
    __syncthreads();
}

struct Frame {
    LAS unsigned char* lds;
    volatile LAS unsigned* MISC;
    gu32* ctl;
    int tid, lane, wave, vcu, G;
};
__device__ __forceinline__ float wave_sum(float v) {
#pragma unroll
    for (int o = 1; o < 64; o <<= 1) v += __shfl_xor(v, o);
    return v;
}
__device__ __forceinline__ float wave_incl_scan(float v, int lane) {
#pragma unroll
    for (int o = 1; o < 64; o <<= 1) { const float t = __shfl_up(v, o); if (lane >= o) v += t; }
    return v;
}
__device__ __forceinline__ int wave_incl_scan_i(int v, int lane) {
#pragma unroll
    for (int o = 1; o < 64; o <<= 1) { const int t = __shfl_up(v, o); if (lane >= o) v += t; }
    return v;
}
__device__ __forceinline__ void transpose_item(const float* W, int N, bf16* WT, int K, int n0, int k0, int scol, const float* kscale, LAS float* scr, int lane) {
#pragma unroll 8
    for (int i = 0; i < 32; ++i) { const int kk = 2 * i + (lane >> 5); float v = 0.f;
        if (scol >= 0) { v = W[(size_t)(k0 + kk) * N + scol]; if (kscale) v *= kscale[k0 + kk]; }
        scr[kk * 33 + (lane & 31)] = v; }
    LDS_WAIT(); asm volatile("" ::: "memory");
    const int c = lane & 7;
#pragma unroll
    for (int j = 0; j < 4; ++j) { const int n = (lane >> 3) + 8 * j; const LAS float* s = scr + (8 * c) * 33 + n;
        v4u o; o.x = pk2(s[0 * 33], s[1 * 33]); o.y = pk2(s[2 * 33], s[3 * 33]); o.z = pk2(s[4 * 33], s[5 * 33]); o.w = pk2(s[6 * 33], s[7 * 33]);
        *(GAS v4u*)(WT + (size_t)(n0 + n) * K + k0 + 8 * c) = o; }
    LDS_WAIT(); asm volatile("" ::: "memory");
}
__device__ __forceinline__ void p0_prologue(Frame& F, const float* x, const float* norm_gain, const float* w_in, const float* w_branch, const float* w_out, unsigned char* ws) {
    LAS float* scr = (LAS float*)(F.lds + RING_OFF + F.wave * 16384);
    const int gw = F.vcu * 8 + F.wave, NGW = F.G * 8, lane = F.lane;
    constexpr int I_W1 = 16 * (NTILES * 256 / 32), I_WB = 8 * 32, I_WO = 16 * 32;
    constexpr int NITEMS = DEPTH * I_W1 + DEPTH * 3 * I_WB + DEPTH * I_WO;
    for (int it = gw; it < NITEMS; it += NGW) {
        int r = it;
        if (r < DEPTH * I_W1) { const int L = r / I_W1; r -= L * I_W1; const int nblk = NTILES * 8, kb = r / nblk, nb = r % nblk, n0 = nb * 32, tile = n0 >> 8, p = (n0 & 255) + (lane & 31);
            const int lc = 64 * ((p >> 5) & 3) + 32 * (p >> 7) + (p & 31);
            transpose_item(w_in + (size_t)L * DMODEL * INC, INC, (bf16*)(ws + WS_W1T) + (size_t)L * NTILES * 256 * 1024, 1024, n0, kb * 64, src_col(tile, lc), norm_gain + L * DMODEL, scr, lane); continue; }
        r -= DEPTH * I_W1;
        if (r < DEPTH * 3 * I_WB) { const int mat = r / I_WB; r -= mat * I_WB; const int kb = r / 32, nb = r % 32;
            transpose_item(w_branch + (size_t)mat * 512 * 1024, 1024, (bf16*)(ws + WS_WBT) + (size_t)mat * 1024 * 512, 512, nb * 32, kb * 64, nb * 32 + (lane & 31), nullptr, scr, lane); continue; }
        r -= DEPTH * 3 * I_WB;
        { const int L = r / I_WO; r -= L * I_WO; const int kb = r / 32, nb = r % 32;
            transpose_item(w_out + (size_t)L * 1024 * 1024, 1024, (bf16*)(ws + WS_WOT) + (size_t)L * 1024 * 1024, 1024, nb * 32, kb * 64, nb * 32 + (lane & 31), nullptr, scr, lane); }
    }
    bf16* XB = (bf16*)(ws + WS_XB); float* SSQ = (float*)(ws + WS_SSQ);
    for (int m = gw; m < M; m += NGW) {
        const GAS f32x4* xr = (const GAS f32x4*)(x + (size_t)m * DMODEL) + lane; f32x4 v[4]; float s = 0.f;
#pragma unroll
        for (int j = 0; j < 4; ++j) { v[j] = xr[64 * j]; s += (v[j].x * v[j].x + v[j].y * v[j].y) + (v[j].z * v[j].z + v[j].w * v[j].w); }
        const float tot = wave_sum(s);
        GAS unsigned long long* o8 = (GAS unsigned long long*)(XB + (size_t)m * DMODEL) + lane;
#pragma unroll
        for (int j = 0; j < 4; ++j) o8[64 * j] = (unsigned long long)pk2(v[j].x, v[j].y) | ((unsigned long long)pk2(v[j].z, v[j].w) << 32);
        if (lane < 16) SSQ[(size_t)m * 16 + lane] = lane == 0 ? tot : 0.f;
    }
}
__device__ __forceinline__ void scan_phase(Frame& F, const float* CF, const float* bforget  , float* CL, float* CT) {
    const int lane = F.lane, h = F.wave;
    for (int u = blockIdx.x; u < 128; u += F.G) { const int b = u >> 5, j = u & 31; const size_t row = (size_t)b * SEQ + 256 * j + 4 * lane; const float bf = bforget[h];
        float s[4]; float run = 0.f;
#pragma unroll
        for (int e = 0; e < 4; ++e) { const float xx = CF[(row + e) * 8 + h] + bf; const float lf = (xx < 0.f ? xx : 0.f) - __logf(1.0f + __expf(-fabsf(xx))); run += lf; s[e] = run; }
        const float incl = wave_incl_scan(run, lane), excl = incl - run;
        *(f32x4*)(CL + (size_t)(b * 8 + h) * SEQ + 256 * j + 4 * lane) = (f32x4){excl + s[0], excl + s[1], excl + s[2], excl + s[3]};
        if (lane == 63) CT[(b * 8 + h) * 32 + j] = incl;
    }
}
#ifndef REP_IDX
#define REP_IDX 1
#endif
#ifndef REP_SPB
#define REP_SPB 1
#endif
#ifndef REP_SPA
#define REP_SPA 1
#endif
typedef unsigned u32x2 __attribute__((ext_vector_type(2)));
constexpr int NBIN = 1024;
__device__ __forceinline__ float pdist(float s, float sc, float inv) { return (s - sc) * inv + 0.0f; }
__device__ __forceinline__ unsigned pbin_d(float d) { const unsigned a = __float_as_uint(d) & 0x7fffffffu;
    int fx = (int)(a >> 19) - 1647; fx = fx < 0 ? 0 : (fx > 511 ? 511 : fx);
    return (__float_as_uint(d) >> 31) ? 511u - (unsigned)fx : 512u + (unsigned)fx; }
__device__ __forceinline__ unsigned pbin(float s, float sc, float inv) { return pbin_d(pdist(s, sc, inv)); }
__device__ __forceinline__ float pedge(int b) {
    if (b >= NBIN) return INFINITY; if (b <= 0) return -INFINITY;
    if (b > 512) return __uint_as_float((unsigned)(b - 512 + 1647) << 19);
    if (b == 512) return 0.0f;
    return -__uint_as_float(((unsigned)(511 - b + 1648) << 19) - 1u);
}
constexpr int CMAX = 1024;
#define LDS_ADD(p, v) __hip_atomic_fetch_add((p), (v), __ATOMIC_RELAXED, __HIP_MEMORY_SCOPE_WORKGROUP)
__device__ __forceinline__ unsigned okey(float s) { const unsigned u = __float_as_uint(s); return (u & 0x80000000u) ? ~u : (u | 0x80000000u); }
struct BAParams { const bf16 *IQ, *IK; const float* IW; const bf16 *QA, *QB, *KAB, *VAB; bf16* G; const float* sinks; };
__device__ __forceinline__ float relu_f(float x) { const int i = __float_as_int(x); return __int_as_float(i > 0 ? i : 0); }

template <int PASS, bool DIAG> __device__ __forceinline__ void idx_tile(const bf16x8 ak, const bf16x8 (&bq)[4], const f32x4 w4, int kt, int g4, int r, int tq, float elo, float ehi,
                                                                       LAS unsigned* hl, unsigned lp, unsigned hinc, LAS u32x2* cand, LAS unsigned short* sel, LAS unsigned* misc, LAS unsigned* zh, int zcut, float sc, float inv) {
    const f32x4 z = {0.f, 0.f, 0.f, 0.f};
    const f32x4 d0 = __builtin_amdgcn_mfma_f32_16x16x32_bf16(ak, bq[0], z, 0, 0, 0), d1 = __builtin_amdgcn_mfma_f32_16x16x32_bf16(ak, bq[1], z, 0, 0, 0),
                d2 = __builtin_amdgcn_mfma_f32_16x16x32_bf16(ak, bq[2], z, 0, 0, 0), d3 = __builtin_amdgcn_mfma_f32_16x16x32_bf16(ak, bq[3], z, 0, 0, 0);
    float sv[4]; bool qs[4], qc[4]; unsigned n1 = 0, n2 = 0;
#pragma unroll
    for (int i = 0; i < 4; ++i) {
        float s = 0.f; s = fmaf(w4[0], relu_f(d0[i]), s); s = fmaf(w4[1], relu_f(d1[i]), s); s = fmaf(w4[2], relu_f(d2[i]), s); s = fmaf(w4[3], relu_f(d3[i]), s);
        const int key = 16 * kt + 4 * g4 + i; sv[i] = s; const bool ok = !DIAG || key <= tq; const float d = pdist(s, sc, inv);
        if (PASS == 1) { if (ok) { const unsigned bin = pbin_d(d); LDS_ADD(hl + (bin * 32u + (lp ^ (bin & 31u))), hinc); if (s == 0.0f) LDS_ADD(zh + (key >> 7), 1u); } }
        else { qs[i] = ok && d >= ehi; qc[i] = ok && !(d >= ehi) && d >= elo && (s != 0.0f || key < zcut)  ;
               n1 += qs[i] ? 1u : 0u; n2 += qc[i] ? 1u : 0u; }
    }
    if (PASS == 2) {
        const unsigned add = n1 | (n2 << 16);
        if (add) { const unsigned pos = LDS_ADD(misc + MW_NSEL + r, add); unsigned p1 = pos & 0xffffu, p2 = pos >> 16;
#pragma unroll
            for (int i = 0; i < 4; ++i) { const int key = 16 * kt + 4 * g4 + i;
                if (qs[i]) { if (p1 < 256u) sel[p1] = (unsigned short)key; ++p1; }
                if (qc[i]) { if (p2 < (unsigned)CMAX) cand[p2] = (u32x2){okey(sv[i]), (unsigned)key}; ++p2; } } }
    }
}
template <int PASS> __device__ __forceinline__ void idx_pass(Frame& F, const bf16* IKb, const bf16x8 (&bq)[4], const f32x4 w4, int tau, int t0) {
    int lane_ = F.lane; asm volatile("" : "+v"(lane_)); const int lane = lane_, r = lane & 15, g4 = lane >> 4, tq = t0 + r;
    LAS unsigned* hl = (LAS unsigned*)(F.lds + RING_OFF); const unsigned lp = (unsigned)lane >> 1, hinc = 1u << ((lane & 1) * 16);
    LAS u32x2* cand = (LAS u32x2*)(F.lds + RING_OFF) + r * CMAX;
    LAS unsigned short* sel = (LAS unsigned short*)(F.lds + SEL_OFF) + r * 256;
    LAS unsigned* misc = (LAS unsigned*)(F.lds + MISC_OFF);
    float elo = 0.f, ehi = 0.f; int zcut = SEQ; if (PASS == 2) { elo = __uint_as_float(misc[MW_ELO + r]); ehi = __uint_as_float(misc[MW_ELO + 16 + r]); zcut = (int)misc[MW_ZCUT + r]; }
    LAS unsigned* zh = (LAS unsigned*)(F.lds + H2_OFF) + r * 64;
    const bf16* kp = IKb + (size_t)r * 32 + 8 * g4;
    float sc, inv; { const bf16x8 at = *(const bf16x8*)kp; const f32x4 z = {0.f, 0.f, 0.f, 0.f};
        const f32x4 d0 = __builtin_amdgcn_mfma_f32_16x16x32_bf16(at, bq[0], z, 0, 0, 0), d1 = __builtin_amdgcn_mfma_f32_16x16x32_bf16(at, bq[1], z, 0, 0, 0),
                    d2 = __builtin_amdgcn_mfma_f32_16x16x32_bf16(at, bq[2], z, 0, 0, 0), d3 = __builtin_amdgcn_mfma_f32_16x16x32_bf16(at, bq[3], z, 0, 0, 0);
        float mx = -INFINITY, ma = 0.f;
#pragma unroll
        for (int i = 0; i < 4; ++i) { float s = 0.f; s = fmaf(w4[0], relu_f(d0[i]), s); s = fmaf(w4[1], relu_f(d1[i]), s); s = fmaf(w4[2], relu_f(d2[i]), s); s = fmaf(w4[3], relu_f(d3[i]), s); mx = fmaxf(mx, s); ma = fmaxf(ma, fabsf(s)); }
        mx = fmaxf(mx, __shfl_xor(mx, 16)); mx = fmaxf(mx, __shfl_xor(mx, 32)); ma = fmaxf(ma, __shfl_xor(ma, 16)); ma = fmaxf(ma, __shfl_xor(ma, 32));
        sc = mx; inv = (ma > 1e-30f && ma < 1e30f) ? 1.0f / ma : 1.0f;
        if (PASS == 1 && F.wave == 0 && g4 == 0) { misc[MW_UC + r] = __float_as_uint(sc); misc[MW_UC + 16 + r] = __float_as_uint(inv); } }
    int kt = F.wave; if (kt > tau) return;
    bf16x8 a0 = *(const bf16x8*)(kp + (size_t)kt * 512);
    bf16x8 a1 = *(const bf16x8*)(kp + (size_t)(kt + 8 <= tau ? kt + 8 : kt) * 512);
    for (; kt <= tau; kt += 8) {
        const int k2 = kt + 16 <= tau ? kt + 16 : kt; const bf16x8 a2 = *(const bf16x8*)(kp + (size_t)k2 * 512);
        if (kt < tau) idx_tile<PASS, false>(a0, bq, w4, kt, g4, r, tq, elo, ehi, hl, lp, hinc, cand, sel, misc, zh, zcut, sc, inv);
        else          idx_tile<PASS, true>(a0, bq, w4, kt, g4, r, tq, elo, ehi, hl, lp, hinc, cand, sel, misc, zh, zcut, sc, inv);
        a0 = a1; a1 = a2;
    }
}
__device__ __forceinline__ void idx_threshold(Frame& F) {
    int lane_ = F.lane; asm volatile("" : "+v"(lane_)); const int lane = lane_; LAS unsigned* misc = (LAS unsigned*)(F.lds + MISC_OFF);
    for (int qq = 0; qq < 2; ++qq) { const int q = 2 * F.wave + qq; const unsigned sh = (q & 1) * 16, qh = (unsigned)q >> 1;
        const LAS unsigned* hb = (const LAS unsigned*)(F.lds + RING_OFF);
        int cnt[16];
#pragma unroll
        for (int k = 0; k < 16; ++k) { const unsigned bin = 64u * k + lane, sw = bin & 31u; const LAS unsigned* p = hb + bin * 32u;
            cnt[k] = (int)(((p[qh ^ sw] >> sh) & 0xffffu) + ((p[(qh + 8u) ^ sw] >> sh) & 0xffffu) + ((p[(qh + 16u) ^ sw] >> sh) & 0xffffu) + ((p[(qh + 24u) ^ sw] >> sh) & 0xffffu)); }
        int a8[8], a4[4], a2[2], a1;
        { const bool h5 = lane & 32, h4 = lane & 16, h3 = lane & 8, h2 = lane & 4;
#pragma unroll
          for (int i = 0; i < 8; ++i) { const int mine = h5 ? cnt[8 + i] : cnt[i], theirs = h5 ? cnt[i] : cnt[8 + i]; a8[i] = mine + __shfl_xor(theirs, 32); }
#pragma unroll
          for (int i = 0; i < 4; ++i) { const int mine = h4 ? a8[4 + i] : a8[i], theirs = h4 ? a8[i] : a8[4 + i]; a4[i] = mine + __shfl_xor(theirs, 16); }
#pragma unroll
          for (int i = 0; i < 2; ++i) { const int mine = h3 ? a4[2 + i] : a4[i], theirs = h3 ? a4[i] : a4[2 + i]; a2[i] = mine + __shfl_xor(theirs, 8); }
          { const int mine = h2 ? a2[1] : a2[0], theirs = h2 ? a2[0] : a2[1]; a1 = mine + __shfl_xor(theirs, 4); }
          a1 += __shfl_xor(a1, 1); a1 += __shfl_xor(a1, 2); }
        int ks = 0, aseg = 0, v = cnt[0]; { int cum = 0; bool found = false;
#pragma unroll
            for (int k = 15; k >= 0; --k) { const int Tk = __builtin_amdgcn_readlane(a1, 4 * k); if (!found && cum + Tk >= 256) { found = true; ks = k; aseg = cum; v = cnt[k]; } cum += Tk; } }
        const int pre = wave_incl_scan_i(v, lane);
        int tot = pre; tot = __shfl(tot, 63);
        const int suf = tot - pre + v;
        const unsigned long long mask = __ballot(aseg + suf >= 256);
        const int Ls = mask ? 63 - (int)__builtin_clzll(mask) : 0;
        if (lane == Ls) { const int bs = 64 * ks + lane; misc[MW_BIN + q] = (unsigned)bs; misc[MW_ABOVE + q] = (unsigned)(aseg + suf - v);
                          misc[MW_ELO + q] = __float_as_uint(pedge(bs)); misc[MW_ELO + 16 + q] = __float_as_uint(pedge(bs + 1)); }
        { const int binstar = __shfl(64 * ks + lane, Ls), needz = 256 - __shfl(aseg + suf - v, Ls);
          const int zc = (int)((const LAS unsigned*)(F.lds + H2_OFF))[q * 64 + lane]; const int zi = wave_incl_scan_i(zc, lane);
          const unsigned long long zm = __ballot(zi >= needz);
          if (lane == 0) misc[MW_ZCUT + q] = (binstar == (int)pbin(0.0f, __uint_as_float(misc[MW_UC + q]), __uint_as_float(misc[MW_UC + 16 + q])) && zm) ? (unsigned)(128 * ((int)__builtin_ctzll(zm) + 1)) : (unsigned)SEQ; }
    }
}
__device__ __forceinline__ unsigned idx_digit(const u32x2 e, int lvl) { const unsigned v = 8191u - e.y;
    return lvl == 0 ? e.x >> 24 : lvl == 1 ? (e.x >> 16) & 255u : lvl == 2 ? (e.x >> 8) & 255u : lvl == 3 ? e.x & 255u : lvl == 4 ? (v >> 5) & 255u : v & 31u; }
__device__ __forceinline__ void idx_resolve(Frame& F) {
    int lane_ = F.lane; asm volatile("" : "+v"(lane_)); const int lane = lane_; LAS unsigned* misc = (LAS unsigned*)(F.lds + MISC_OFF);
    LAS unsigned* h2 = (LAS unsigned*)(F.lds + H2_OFF) + F.wave * 256;
    for (int qq = 0; qq < 2; ++qq) { const int q = 2 * F.wave + qq;
        const unsigned packed = misc[MW_NSEL + q];
        if (lane == 0) misc[MW_NSEL + q] = packed & 0xffffu;
        int c = (int)(packed >> 16); if (c > CMAX) { c = CMAX; if (lane == 0) __hip_atomic_fetch_add(F.ctl + CW_OVF, 1u, RLX_AGENT); }
        int need = 256 - (int)misc[MW_ABOVE + q];
        LAS u32x2* cq = (LAS u32x2*)(F.lds + RING_OFF) + q * CMAX;
        LAS unsigned short* sel = (LAS unsigned short*)(F.lds + SEL_OFF) + q * 256;
        if (c > need && c <= 64) {
            u32x2 e = {0u, 0u}; if (lane < c) e = cq[lane]; int rank = 0;
            for (int j = 0; j < c; ++j) { const unsigned uj = (unsigned)__builtin_amdgcn_readlane((int)e.x, j), ij = (unsigned)__builtin_amdgcn_readlane((int)e.y, j); rank += (uj > e.x || (uj == e.x && ij < e.y)) ? 1 : 0; }
            if (lane < c && rank < need) { const unsigned pos = LDS_ADD(misc + MW_NSEL + q, 1u); if (pos < 256u) sel[pos] = (unsigned short)e.y; }
            c = 0; need = 0;
        }
#pragma unroll 1
        for (int lvl = 0; lvl < 6 && c > need; ++lvl) {
            *(LAS v4u*)(h2 + 4 * lane) = (v4u){0u, 0u, 0u, 0u};
            for (int i = lane; i < c; i += 64) LDS_ADD(h2 + idx_digit(cq[i], lvl), 1u);
            const v4u hw = *(const LAS v4u*)(h2 + 252 - 4 * lane);
            const int total = (int)(hw.x + hw.y + hw.z + hw.w), incl = wave_incl_scan_i(total, lane);
            const unsigned long long mask = __ballot(incl >= need);
            const int Ls = mask ? (int)__builtin_ctzll(mask) : 63;
            int dstar_l = 0, above_l = 0; { int cum = incl - total; bool found = false;
#pragma unroll
                for (int e = 3; e >= 0; --e) { const int cc = (int)hw[e]; if (!found && cum + cc >= need) { found = true; dstar_l = 252 - 4 * lane + e; above_l = cum; } cum += cc; } }
            const unsigned dstar = (unsigned)__shfl(dstar_l, Ls); const int above = __shfl(above_l, Ls);
            int c2 = 0;
            for (int base = 0; base < c; base += 64) { const int i = base + lane; const bool valid = i < c; u32x2 e = {0u, 0u}; if (valid) e = cq[i];
                const unsigned dg = idx_digit(e, lvl); const bool tie = valid && dg == dstar;
                if (valid && dg > dstar) { const unsigned pos = LDS_ADD(misc + MW_NSEL + q, 1u); if (pos < 256u) sel[pos] = (unsigned short)e.y; }
                const unsigned long long tm = __ballot(tie);
                if (tie) cq[c2 + __popcll(tm & ((1ull << lane) - 1ull))] = e;
                c2 += __popcll(tm); }
            c = c2; need -= above;
        }
        for (int i = lane; i < c && i < need; i += 64) { const unsigned pos = LDS_ADD(misc + MW_NSEL + q, 1u); if (pos < 256u) sel[pos] = (unsigned short)cq[i].y; }
    }
}
typedef short s16x4 __attribute__((ext_vector_type(4)));
__device__ __forceinline__ void sp_glds16(const void* gsrc, unsigned lds_dst) { unsigned keep;
    asm volatile("s_mov_b32 %0, m0\n\ts_mov_b32 m0, %2\n\ts_nop 0\n\tglobal_load_lds_dwordx4 %1, off\n\ts_mov_b32 m0, %0" : "=&s"(keep) : "v"(gsrc), "s"(lds_dst) : "memory"); }
__device__ __forceinline__ void sp_glds16s(const void* sbase, unsigned voff, unsigned lds_dst) { unsigned keep;
    asm volatile("s_mov_b32 %0, m0\n\ts_mov_b32 m0, %3\n\ts_nop 0\n\tglobal_load_lds_dwordx4 %1, %2\n\ts_mov_b32 m0, %0" : "=&s"(keep) : "v"(voff), "s"(sbase), "s"(lds_dst) : "memory"); }
template <bool IS_A> __device__ __forceinline__ void sparse_pair(Frame& F, const BAParams& P, int rb, int tA, int qi0, int nv0, int nv1, bool dry) {
    constexpr int NC = IS_A ? 8 : 16, NSLOT = NC * 16, KOFF = IS_A ? 0 : M * 128, HB = IS_A ? 0 : 8, GOFF = IS_A ? 0 : 512;
    int lane_ = F.lane; asm volatile("" : "+v"(lane_)); const int lane = lane_, r = lane & 15, g4 = lane >> 4, my_a = g4 >> 1, my_j = g4 & 1;
    const bf16* Q = IS_A ? P.QA : P.QB;
    const LAS unsigned short* sel = (const LAS unsigned short*)(F.lds + SEL_OFF) + qi0 * 256;
    const LAS float* BIAS = (const LAS float*)(F.lds + BIAS_OFF);
    const LAS unsigned char* BKT = (const LAS unsigned char*)(F.lds + BKT_OFF);
    LAS unsigned short* Pimg = (LAS unsigned short*)(F.lds + RING_OFF + F.wave * 16384);
    bf16x8 q0, q1; const bf16x8 zz = {0, 0, 0, 0, 0, 0, 0, 0};
    { const int a_r = r >> 3, hd = r & 7; const bf16* qp = Q + (size_t)(rb + tA + a_r) * 512 + hd * 64 + 8 * g4; q0 = *(const bf16x8*)qp; q1 = *(const bf16x8*)(qp + 32); }
    const int my_t = tA + my_a, rcb = r >> 2;
    f32x4 x[NC];
#pragma unroll
    for (int c = 0; c < NC; ++c) x[c] = (f32x4){0.f, 0.f, 0.f, 0.f};
    constexpr int KS = NSLOT / 32, NST = 4 * KS;
    const unsigned wk = (unsigned)__builtin_amdgcn_readfirstlane((int)((unsigned)(uintptr_t)(F.lds + RING_OFF) + (unsigned)F.wave * 16384u));
    const int drow = lane >> 3, dpc = lane & 7;
#define SP_KDMA(st, bufi) do { const int cb_ = (st) / KS, ks_ = (st) % KS, a_ = cb_ >> 1, j_ = cb_ & 1; const unsigned dst_ = wk + (unsigned)((bufi) * 4096); \
        _Pragma("unroll") for (int i_ = 0; i_ < 4; ++i_) { const int slot_ = 32 * ks_ + 8 * i_ + drow; int key_; \
            if (IS_A) { key_ = tA + a_ - slot_; key_ = key_ < 0 ? 0 : key_; } else { key_ = sel[a_ * 256 + slot_]; key_ = (slot_ < (a_ ? nv1 : nv0) && key_ < SEQ) ? key_ : 0; } \
            sp_glds16s(P.KAB, (unsigned)(((rb + key_) * 128 + KOFF + j_ * 64 + ((dpc ^ (drow & 7)) * 8)) * 2), (unsigned)__builtin_amdgcn_readfirstlane((int)(dst_ + i_ * 1024))); } } while (0)
    asm volatile("s_waitcnt vmcnt(0)" ::: "memory");
    SP_KDMA(0, 0); SP_KDMA(1, 1); SP_KDMA(2, 2); if (NST > 3) SP_KDMA(3, 3);
    { const LAS unsigned char* kring = F.lds + RING_OFF + F.wave * 16384;
      int kbuf = 0;
#pragma unroll 1
      for (int st = 0; st < NST; ++st) {
        if (st + 3 < NST) asm volatile("s_waitcnt vmcnt(12)" ::: "memory"); else if (st + 2 < NST) asm volatile("s_waitcnt vmcnt(8)" ::: "memory"); else if (st + 1 < NST) asm volatile("s_waitcnt vmcnt(4)" ::: "memory"); else asm volatile("s_waitcnt vmcnt(0)" ::: "memory");
        const int cb = st / KS, ks = st % KS; const bool mine = rcb == cb; const bf16x8 a0 = mine ? q0 : zz, a1 = mine ? q1 : zz;
        const LAS unsigned char* kb = kring + kbuf * 4096;
        bf16x8 f[2][2];
#pragma unroll
        for (int cc = 0; cc < 2; ++cc)
#pragma unroll
            for (int k2 = 0; k2 < 2; ++k2) f[cc][k2] = *(const LAS bf16x8*)(kb + (16 * cc + r) * 128 + (((4 * k2 + g4) ^ (r & 7)) * 16));
        asm volatile("s_waitcnt lgkmcnt(0)" ::: "memory");
#pragma unroll
        for (int k8 = 0; k8 < KS; ++k8) if (k8 == ks) {
#pragma unroll
            for (int cc = 0; cc < 2; ++cc) { x[2 * k8 + cc] = __builtin_amdgcn_mfma_f32_16x16x32_bf16(a0, f[cc][0], x[2 * k8 + cc], 0, 0, 0); x[2 * k8 + cc] = __builtin_amdgcn_mfma_f32_16x16x32_bf16(a1, f[cc][1], x[2 * k8 + cc], 0, 0, 0); } }
        if (st + 4 < NST) SP_KDMA(st + 4, kbuf);
        kbuf = (kbuf + 1) & 3;
      } }
#undef SP_KDMA
#pragma unroll
    for (int c = 0; c < NC; ++c) { const int slot = 16 * c + r; int mk; bool mv;
        if (IS_A) { mk = my_t - slot; mv = mk >= 0; } else { mk = sel[my_a * 256 + slot]; mv = slot < (my_a ? nv1 : nv0); }
        const int delta = my_t - mk; const bool ok = mv && delta >= 0;
        const int bk = (ok && delta < 512) ? (int)BKT[delta] : 31;
        const f32x4 b4 = *(const LAS f32x4*)(BIAS + bk * 16 + HB + 4 * my_j);
#pragma unroll
        for (int i = 0; i < 4; ++i) x[c][i] = ok ? x[c][i] * 0.125f + b4[i] : -INFINITY; }
    f32x4 mx = x[0];
#pragma unroll
    for (int c = 1; c < NC; ++c)
#pragma unroll
        for (int i = 0; i < 4; ++i) mx[i] = fmaxf(mx[i], x[c][i]);
#pragma unroll
    for (int o = 1; o < 16; o <<= 1)
#pragma unroll
        for (int i = 0; i < 4; ++i) mx[i] = fmaxf(mx[i], __shfl_xor(mx[i], o));
    f32x4 sk = {0.f, 0.f, 0.f, 0.f};
    if (IS_A) { sk = *(const f32x4*)(P.sinks + 4 * my_j);
#pragma unroll
        for (int i = 0; i < 4; ++i) mx[i] = fmaxf(mx[i], sk[i]); }
    f32x4 sum = {0.f, 0.f, 0.f, 0.f};
#pragma unroll
    for (int c = 0; c < NC; ++c)
#pragma unroll
        for (int i = 0; i < 4; ++i) { x[c][i] = __expf(x[c][i] - mx[i]); sum[i] += x[c][i]; }
#pragma unroll
    for (int o = 1; o < 16; o <<= 1)
#pragma unroll
        for (int i = 0; i < 4; ++i) sum[i] += __shfl_xor(sum[i], o);
    if (IS_A) {
#pragma unroll
        for (int i = 0; i < 4; ++i) sum[i] += __expf(sk[i] - mx[i]); }
    f32x4 inv;
#pragma unroll
    for (int i = 0; i < 4; ++i) inv[i] = 1.0f / sum[i];
#define SP_PWRITE(qa) do { if (my_a == (qa)) { _Pragma("unroll") for (int c_ = 0; c_ < NC; ++c_) _Pragma("unroll") for (int i_ = 0; i_ < 4; ++i_) \
        Pimg[(4 * my_j + i_) * NSLOT + 16 * c_ + r] = (unsigned short)f2bf(x[c_][i_] * inv[i_]); } } while (0)
    SP_PWRITE(0);
    const unsigned wl = wk + 4096u;
#define SP_VDMA(st, bufi) do { const int cb_ = (st) / KS, ks_ = (st) % KS, a_ = cb_ >> 1, j_ = cb_ & 1; const unsigned dst_ = wl + (unsigned)((bufi) * 4096); \
        _Pragma("unroll") for (int i_ = 0; i_ < 4; ++i_) { const int slot_ = 32 * ks_ + 8 * i_ + drow; int key_; \
            if (IS_A) { key_ = tA + a_ - slot_; key_ = key_ < 0 ? 0 : key_; } else { key_ = sel[a_ * 256 + slot_]; key_ = (slot_ < (a_ ? nv1 : nv0) && key_ < SEQ) ? key_ : 0; } \
            sp_glds16s(P.VAB, (unsigned)(((rb + key_) * 128 + KOFF + j_ * 64 + dpc * 8) * 2), (unsigned)__builtin_amdgcn_readfirstlane((int)(dst_ + i_ * 1024))); } } while (0)
    asm volatile("s_waitcnt vmcnt(0)" ::: "memory");
    SP_VDMA(0, 0); SP_VDMA(1, 1); SP_VDMA(2, 2);
    f32x4 o[4];
#pragma unroll
    for (int db = 0; db < 4; ++db) o[db] = (f32x4){0.f, 0.f, 0.f, 0.f};
    const unsigned trb = (unsigned)((8 * g4 + ((lane & 15) >> 2)) * 128 + (lane & 3) * 8);
    int bufi = 0;
#pragma unroll 1
    for (int st = 0; st < NST; ++st) {
        if (st == NST / 2) { SP_PWRITE(1); }
        if (st + 2 < NST) asm volatile("s_waitcnt vmcnt(8)" ::: "memory"); else if (st + 1 < NST) asm volatile("s_waitcnt vmcnt(4)" ::: "memory"); else asm volatile("s_waitcnt vmcnt(0)" ::: "memory");
        const int cb = st / KS, ks = st % KS; const unsigned vb = wl + (unsigned)(bufi * 4096) + trb;
        s16x4 lo[4], hi[4];
#pragma unroll
        for (int db = 0; db < 4; ++db) {
            asm volatile("ds_read_b64_tr_b16 %0, %1 offset:%c2" : "=&v"(lo[db]) : "v"(vb), "i"(db * 32) : "memory");
            asm volatile("ds_read_b64_tr_b16 %0, %1 offset:%c2" : "=&v"(hi[db]) : "v"(vb), "i"(db * 32 + 512) : "memory"); }
        bf16x8 pb = *(const LAS bf16x8*)(Pimg + (r & 7) * NSLOT + 32 * ks + 8 * g4);
        pb = (rcb == cb) ? pb : zz;
        asm volatile("s_waitcnt lgkmcnt(0)" ::: "memory");
#pragma unroll
        for (int db = 0; db < 4; ++db) { const bf16x8 va = {lo[db][0], lo[db][1], lo[db][2], lo[db][3], hi[db][0], hi[db][1], hi[db][2], hi[db][3]};
            o[db] = __builtin_amdgcn_mfma_f32_16x16x32_bf16(va, pb, o[db], 0, 0, 0); }
        if (st + 3 < NST) SP_VDMA(st + 3, bufi);
        bufi = bufi == 2 ? 0 : bufi + 1;
    }
#undef SP_VDMA
#undef SP_PWRITE
    if (!dry) { bf16* gp = P.G + (size_t)(rb + tA + (r >> 3)) * 1536 + GOFF + (r & 7) * 64 + 4 * g4;
#pragma unroll
        for (int db = 0; db < 4; ++db) { const u32x2 gt = *(const u32x2*)(gp + 16 * db);
            const float g0 = __uint_as_float(gt.x << 16), g1 = __uint_as_float(gt.x & 0xffff0000u), g2 = __uint_as_float(gt.y << 16), g3 = __uint_as_float(gt.y & 0xffff0000u);
            u32x2 w; w.x = pk2(o[db][0] * g0, o[db][1] * g1); w.y = pk2(o[db][2] * g2, o[db][3] * g3);
            *(u32x2*)(gp + 16 * db) = w; } }
}
__device__ __forceinline__ void swa_dense(Frame& F, const BAParams& P, int rb, int t0, bool dry) {
    constexpr int NC = 10, NSLOT = 160, NST = 5;
    int lane_ = F.lane; asm volatile("" : "+v"(lane_)); const int lane = lane_, r = lane & 15, g4 = lane >> 4, j = F.wave >> 2, qg = F.wave & 3, kbase = t0 - 128;
    const LAS float* BIAS = (const LAS float*)(F.lds + BIAS_OFF);
    const LAS unsigned char* BKT = (const LAS unsigned char*)(F.lds + BKT_OFF);
    LAS unsigned short* Pimg = (LAS unsigned short*)(F.lds + RING_OFF + F.wave * 16384);
    bf16x8 qf[2]; { const bf16* qp = P.QA + (size_t)(rb + t0 + 4 * qg + (r >> 2)) * 512 + (4 * j + (r & 3)) * 64 + 8 * g4; qf[0] = *(const bf16x8*)qp; qf[1] = *(const bf16x8*)(qp + 32); }
    bf16x8 kf[NC][2];
#pragma unroll
    for (int c = 0; c < NC; ++c) { int key = kbase + 16 * c + r; key = key < 0 ? 0 : (key > SEQ - 1 ? SEQ - 1 : key);
        const bf16* kp = P.KAB + (size_t)(rb + key) * 128 + j * 64 + 8 * g4; kf[c][0] = *(const bf16x8*)kp; kf[c][1] = *(const bf16x8*)(kp + 32); }
    const int my_t = t0 + 4 * qg + g4;
    f32x4 x[NC];
#pragma unroll
    for (int c = 0; c < NC; ++c) { f32x4 d = {0.f, 0.f, 0.f, 0.f};
        d = __builtin_amdgcn_mfma_f32_16x16x32_bf16(qf[0], kf[c][0], d, 0, 0, 0); d = __builtin_amdgcn_mfma_f32_16x16x32_bf16(qf[1], kf[c][1], d, 0, 0, 0);
        const int key = kbase + 16 * c + r, delta = my_t - key; const bool ok = key >= 0 && delta >= 0 && delta < 128;
        const int bk = (int)BKT[ok ? delta : 0];
        const f32x4 b4 = *(const LAS f32x4*)(BIAS + bk * 16 + 4 * j);
#pragma unroll
        for (int i = 0; i < 4; ++i) x[c][i] = ok ? d[i] * 0.125f + b4[i] : -INFINITY; }
    f32x4 mx = *(const f32x4*)(P.sinks + 4 * j); const f32x4 sk = mx;
#pragma unroll
    for (int c = 0; c < NC; ++c)
#pragma unroll
        for (int i = 0; i < 4; ++i) mx[i] = fmaxf(mx[i], x[c][i]);
#pragma unroll
    for (int o = 1; o < 16; o <<= 1)
#pragma unroll
        for (int i = 0; i < 4; ++i) mx[i] = fmaxf(mx[i], __shfl_xor(mx[i], o));
    f32x4 sum = {0.f, 0.f, 0.f, 0.f};
#pragma unroll
    for (int c = 0; c < NC; ++c)
#pragma unroll
        for (int i = 0; i < 4; ++i) { x[c][i] = __expf(x[c][i] - mx[i]); sum[i] += x[c][i]; }
#pragma unroll
    for (int o = 1; o < 16; o <<= 1)
#pragma unroll
        for (int i = 0; i < 4; ++i) sum[i] += __shfl_xor(sum[i], o);
    f32x4 inv;
#pragma unroll
    for (int i = 0; i < 4; ++i) inv[i] = 1.0f / (sum[i] + __expf(sk[i] - mx[i]));
#pragma unroll
    for (int c = 0; c < NC; ++c)
#pragma unroll
        for (int i = 0; i < 4; ++i) Pimg[(4 * g4 + i) * NSLOT + 16 * c + r] = (unsigned short)f2bf(x[c][i] * inv[i]);
    const unsigned wl = (unsigned)__builtin_amdgcn_readfirstlane((int)((unsigned)(uintptr_t)(F.lds + RING_OFF) + (unsigned)F.wave * 16384u + 8192u));
    const int drow = lane >> 3, dpc = lane & 7;
#define SW_VDMA(st) do { const unsigned dst_ = wl + (unsigned)(((st) & 1) * 4096); \
        _Pragma("unroll") for (int i_ = 0; i_ < 4; ++i_) { int key_ = kbase + 32 * (st) + 8 * i_ + drow; key_ = key_ < 0 ? 0 : (key_ > SEQ - 1 ? SEQ - 1 : key_); \
            sp_glds16s(P.VAB, (unsigned)(((rb + key_) * 128 + j * 64 + dpc * 8) * 2), (unsigned)__builtin_amdgcn_readfirstlane((int)(dst_ + i_ * 1024))); } } while (0)
    asm volatile("s_waitcnt vmcnt(0)" ::: "memory");
    SW_VDMA(0); SW_VDMA(1);
    f32x4 o[4];
#pragma unroll
    for (int db = 0; db < 4; ++db) o[db] = (f32x4){0.f, 0.f, 0.f, 0.f};
    const unsigned trb = (unsigned)((8 * g4 + ((lane & 15) >> 2)) * 128 + (lane & 3) * 8);
#pragma unroll 1
    for (int st = 0; st < NST; ++st) {
        if (st + 1 < NST) asm volatile("s_waitcnt vmcnt(4)" ::: "memory"); else asm volatile("s_waitcnt vmcnt(0)" ::: "memory");
        const unsigned vb = wl + (unsigned)((st & 1) * 4096) + trb;
        s16x4 lo[4], hi[4];
#pragma unroll
        for (int db = 0; db < 4; ++db) {
            asm volatile("ds_read_b64_tr_b16 %0, %1 offset:%c2" : "=&v"(lo[db]) : "v"(vb), "i"(db * 32) : "memory");
            asm volatile("ds_read_b64_tr_b16 %0, %1 offset:%c2" : "=&v"(hi[db]) : "v"(vb), "i"(db * 32 + 512) : "memory"); }
        const bf16x8 pb = *(const LAS bf16x8*)(Pimg + r * NSLOT + 32 * st + 8 * g4);
        asm volatile("s_waitcnt lgkmcnt(0)" ::: "memory");
#pragma unroll
        for (int db = 0; db < 4; ++db) { const bf16x8 va = {lo[db][0], lo[db][1], lo[db][2], lo[db][3], hi[db][0], hi[db][1], hi[db][2], hi[db][3]};
            o[db] = __builtin_amdgcn_mfma_f32_16x16x32_bf16(va, pb, o[db], 0, 0, 0); }
        if (st + 2 < NST) SW_VDMA(st + 2);
    }
#undef SW_VDMA
    if (!dry) { bf16* gp = P.G + (size_t)(rb + t0 + 4 * qg + (r >> 2)) * 1536 + (4 * j + (r & 3)) * 64 + 4 * g4;
#pragma unroll
        for (int db = 0; db < 4; ++db) { const u32x2 gt = *(const u32x2*)(gp + 16 * db);
            const float g0 = __uint_as_float(gt.x << 16), g1 = __uint_as_float(gt.x & 0xffff0000u), g2 = __uint_as_float(gt.y << 16), g3 = __uint_as_float(gt.y & 0xffff0000u);
            u32x2 w; w.x = pk2(o[db][0] * g0, o[db][1] * g1); w.y = pk2(o[db][2] * g2, o[db][3] * g3);
            *(u32x2*)(gp + 16 * db) = w; } }
}
__device__ __forceinline__ void ba_unit(Frame& F, const BAParams& P, int b, int tau, bool dry) {
    { int l_ = (int)__builtin_amdgcn_mbcnt_hi(~0u, __builtin_amdgcn_mbcnt_lo(~0u, 0u)); asm volatile("" : "+v"(l_)); F.lane = l_; F.tid = F.wave * 64 + l_; }
    const int t0 = tau * 16, rb = b * SEQ, lane = F.lane;
    LAS unsigned* misc = (LAS unsigned*)(F.lds + MISC_OFF);
    for (int ri = 0; ri < REP_IDX; ++ri)
    if (tau >= 16) {
        if (ri) __syncthreads();
        { LAS v4u* hz = (LAS v4u*)(F.lds + RING_OFF); for (int i = F.tid; i < RING_BYTES / 16; i += 512) hz[i] = (v4u){0u, 0u, 0u, 0u}; }
        if (F.tid < 32) misc[F.tid] = 0u;
        for (int i = F.tid; i < 16 * 64; i += 512) ((LAS unsigned*)(F.lds + H2_OFF))[i] = 0u;
        __syncthreads();
        bf16x8 bq[4]; const int r = lane & 15, g4 = lane >> 4;
#pragma unroll
        for (int h = 0; h < 4; ++h) bq[h] = *(const bf16x8*)(P.IQ + (size_t)(rb + t0 + r) * 128 + h * 32 + 8 * g4);
        const f32x4 w4 = *(const f32x4*)(P.IW + (size_t)(rb + t0 + r) * 4);
        const bf16* IKb = P.IK + (size_t)rb * 32;
        idx_pass<1>(F, IKb, bq, w4, tau, t0);
        __syncthreads();
        idx_threshold(F);
        __syncthreads();
        idx_pass<2>(F, IKb, bq, w4, tau, t0);
        __syncthreads();
        idx_resolve(F);
    } else {
        LAS unsigned short* sel = (LAS unsigned short*)(F.lds + SEL_OFF);
        for (int i = F.tid; i < 16 * 256; i += 512) sel[i] = (unsigned short)(i & 255);
    }
    __syncthreads();
    const int tA = t0 + 2 * F.wave, nv0 = tA >= 256 ? 256 : tA + 1, nv1 = tA + 1 >= 256 ? 256 : tA + 2;
    for (int rs = 0; rs < REP_SPB; ++rs) sparse_pair<false>(F, P, rb, tA, 2 * F.wave, nv0, nv1, dry || rs + 1 < REP_SPB);
    for (int rs = 0; rs < REP_SPA; ++rs) swa_dense(F, P, rb, t0, dry || rs + 1 < REP_SPA);
}

#ifndef REP_P1A
#define REP_P1A 1
#endif
#ifndef REP_C
#define REP_C 1
#endif
#ifndef REP_BA
#define REP_BA 1
#endif
#ifndef REP_P1B
#define REP_P1B 1
#endif
#ifndef REP_P3
#define REP_P3 1
#endif
#ifndef REP_P0
#define REP_P0 1
#endif
#ifndef FOX_SKIP_LOG2
#define FOX_SKIP_LOG2 (-80.0f)
#endif
#ifndef MK_ONE_LAUNCH
#define MK_ONE_LAUNCH 1
#endif
constexpr int NPHASES = 1 + 6 * DEPTH;
struct Args { const float* in[9]; float* out; unsigned char* ws; int ph_lo, ph_hi; };
static_assert(sizeof(Args) == 9 * 8 + 8 + 8 + 4 + 4, "no padding bytes in the argument struct");

typedef const __attribute__((address_space(4))) Args* ArgP;
__device__ __forceinline__ ArgP argp() { ArgP p = (ArgP)__builtin_amdgcn_kernarg_segment_ptr(); asm volatile("" : "+s"(p)); return p; }
__global__ void __launch_bounds__(512, 2) mk_fwd(Args args) {
    extern __shared__ __attribute__((aligned(16))) unsigned char lds[];
    Frame F;
    F.lds = (LAS unsigned char*)lds;
    F.MISC = (volatile LAS unsigned*)(F.lds + MISC_OFF);
    F.tid = threadIdx.x; F.lane = F.tid & 63; F.wave = __builtin_amdgcn_readfirstlane(F.tid >> 6);
    F.G = gridDim.x; { const int bx = blockIdx.x; F.vcu = (F.G % 8 == 0) ? (bx % 8) * (F.G / 8) + bx / 8 : bx; }
    F.ctl = (gu32*)(argp()->ws + WS_CTL);
    for (int u = F.tid; u < 256; u += 512) ((LAS unsigned*)(F.lds + MISC_OFF))[u] = 0u;
    for (int u = F.tid; u < 512; u += 512) { ((LAS float*)(F.lds + BIAS_OFF))[u] = argp()->in[8][u];
        int bk; if (u < 16) bk = u; else { const float nf = (float)u; int lg = 16 + (int)(logf(nf / 16.0f) / 3.4657359027997265f * 16.0f); bk = lg < 31 ? lg : 31; }
        ((LAS unsigned char*)(F.lds + BKT_OFF))[u] = (unsigned char)bk; }
    __syncthreads();
    XcdBarrier bar; bar.bar = (unsigned*)(F.ctl + CW_BAR); bar.x = 0; bar.st = nullptr;
    if (MK_ONE_LAUNCH) bar = xcd_barrier_post((unsigned*)(F.ctl + CW_BAR), F.MISC + MW_BAR);
    const int lo = argp()->ph_lo, hi = argp()->ph_hi;
#define IN(k) (lo <= (k) && (k) < hi)
#define SEAM(k) do { if (IN(k) && IN((k) + 1)) xcd_barrier(bar); } while (0)
#define PHASE_BEGIN() do { int l_ = (int)__builtin_amdgcn_mbcnt_hi(~0u, __builtin_amdgcn_mbcnt_lo(~0u, 0u)); asm volatile("" : "+v"(l_)); F.lane = l_; F.tid = F.wave * 64 + l_; } while (0)

    if (IN(0)) { PHASE_BEGIN(); ArgP a = argp(); for (int rp = 0; rp < REP_P0; ++rp) p0_prologue(F, a->in[0], a->in[1], a->in[2], a->in[6], a->in[7], a->ws); SEAM(0); }

    for (int L = 0; L < DEPTH; ++L) {
        const int pb = 1 + 6 * L;
        if (IN(pb)) { PHASE_BEGIN();
            unsigned char* ws = argp()->ws; const pg8::bf16_t* W1T = (const pg8::bf16_t*)(ws + WS_W1T) + (size_t)L * NTILES * 256 * 1024;
            pg8::Gemm g{(const pg8::bf16_t*)(ws + WS_XB), W1T, M, NT_A * 256, 1024, 1024, 1024, 0}; pg8::StaticOrder S; S.init(M, NT_A * 256, F.G, (int)blockIdx.x);
            pg8::EpiIn E{ws, argp()->in[4] + L * 384, argp()->in[3] + L * 8};
            for (int rp = 0; rp < REP_P1A; ++rp) pg8::gemm_phase<pg8::EpiIn, pg8::StaticOrder, true, true>(F.lds + RING_OFF, g, S, E, F.wave);
            SEAM(pb);
        }
        if (IN(pb + 2)) { PHASE_BEGIN();
            unsigned char* ws = argp()->ws;
            const float* CL = (const float*)(ws + WS_CL); const float* CT = (const float*)(ws + WS_CT);
            LAS float* carry = (LAS float*)(F.lds + H2_OFF)  ; LAS unsigned* nbw = (LAS unsigned*)(F.lds + RING_OFF + NB_OFF);
            for (int rp = 0; rp < REP_C; ++rp) {
            LAS unsigned* miscw = (LAS unsigned*)(F.lds + MISC_OFF);
            for (int kg = 0; kg < 8; ++kg) { const int xg = ((F.vcu >> 5) + kg) & 7;
            gu32* const tick = F.ctl + CW_TICK + 64 * (8 * (2 * L + rp % 2) + xg);
            if (F.tid == 0) miscw[MW_TICKET] = __hip_atomic_fetch_add(tick, 1u, RLX_AGENT);
            __syncthreads();
            for (;;) {
                PHASE_BEGIN();
                const int ui = (int)miscw[MW_TICKET];
                if (ui >= 128) { __syncthreads(); break; }
                const int qb = 31 - (ui >> 2), bh = 4 * xg + (ui & 3);
                    if (F.wave == 0) { const float t0 = CT[bh * 128 + 2 * F.lane], t1 = CT[bh * 128 + 2 * F.lane + 1]; const float inc = wave_incl_scan(t0 + t1, F.lane); carry[2 * F.lane] = inc - (t0 + t1); carry[2 * F.lane + 1] = inc - t1; }
                    __syncthreads();
                    const float cref = carry[4 * qb]; int tskip;
                    { const float* gq = argp()->in[4] + L * 384 + 256; const float g1 = fabsf(gq[F.lane]), g2 = fabsf(gq[64 + F.lane]); float mq = g1, mk = g2;
#pragma unroll
                      for (int o = 1; o < 64; o <<= 1) { mq = fmaxf(mq, __shfl_xor(mq, o)); mk = fmaxf(mk, __shfl_xor(mk, o)); }
                      const float thr = FOX_SKIP_LOG2 - 2.0f * (11.8f * mq * mk + 0.5f);
                      const int NTt = 4 * (qb + 1); const int t_a = F.lane, t_b = 64 + F.lane, k_a = 64 * t_a + 63, k_b = 64 * t_b + 63;
                      const float n_a = t_a < NTt ? (cref - (carry[k_a >> 6] + CL[(size_t)bh * SEQ + k_a])) * 1.4426950408889634f : 0.f, n_b = t_b < NTt ? (cref - (carry[k_b >> 6] + CL[(size_t)bh * SEQ + k_b])) * 1.4426950408889634f : 0.f;
                      const bool s_a = t_a < NTt && n_a < thr, s_b = t_b < NTt && n_b < thr;
                      const unsigned long long f_a = __ballot(!s_a), f_b = __ballot(!s_b);
                      int cnt = f_a ? (int)__builtin_ctzll(f_a) : 64 + (f_b ? (int)__builtin_ctzll(f_b) : 64);
                      cnt &= ~1; tskip = cnt > NTt - 4 ? NTt - 4 : cnt; }
                    { const int nk = 256 * (qb + 1);
                      for (int k = 64 * tskip + F.tid; k < nk; k += 512) { const float xb = (cref - (carry[k >> 6] + CL[(size_t)bh * SEQ + k])) * 1.4426950408889634f;
                          const unsigned h = f2bf(xb), l = f2bf(xb - __uint_as_float(h << 16)); nbw[k] = h | (l << 16); } }
                    __syncthreads();
                    attn_body::attn_unit<8>(bh >> 3, bh & 7, qb, (const attn_body::bf16*)(ws + WS_QC), (const attn_body::bf16*)(ws + WS_KC), (const attn_body::bf16*)(ws + WS_VC), (attn_body::bf16*)(ws + WS_G),
                                            (char*)lds + RING_OFF, (attn_body::lds_cuptr)(F.lds + RING_OFF + NB_OFF), tskip, rp + 1 < REP_C, F.wave);
                if (F.tid == 0) miscw[MW_TICKET] = __hip_atomic_fetch_add(tick, 1u, RLX_AGENT);
                __syncthreads();
            } } }
            __syncthreads(); PHASE_BEGIN();
            const BAParams P{(const bf16*)(ws + WS_IQ), (const bf16*)(ws + WS_IK), (const float*)(ws + WS_IW), (const bf16*)(ws + WS_QA), (const bf16*)(ws + WS_QB), (const bf16*)(ws + WS_KAB), (const bf16*)(ws + WS_VAB),
                             (bf16*)(ws + WS_G), argp()->in[5] + L * 8};
            for (int rp = 0; rp < REP_BA; ++rp) {
            LAS unsigned* miscw = (LAS unsigned*)(F.lds + MISC_OFF);
            for (int kg = 0; kg < 4; ++kg) { const int bq = ((F.vcu >> 6) + kg) & 3;
            gu32* const tick = F.ctl + CW_TICK + 64 * (32 + 4 * (2 * L + rp % 2) + bq);
            if (F.tid == 0) miscw[MW_TICKET] = __hip_atomic_fetch_add(tick, 1u, RLX_AGENT);
            __syncthreads();
            for (;;) {
                PHASE_BEGIN();
                const int ui = (int)miscw[MW_TICKET];
                if (ui >= 512) { __syncthreads(); break; }
                ba_unit(F, P, bq, 511 - ui, rp + 1 < REP_BA);
                if (F.tid == 0) miscw[MW_TICKET] = __hip_atomic_fetch_add(tick, 1u, RLX_AGENT);
                __syncthreads();
            } } }
            SEAM(pb + 2);
        }
        if (IN(pb + 3)) { PHASE_BEGIN();
            unsigned char* ws = argp()->ws; const pg8::bf16_t* W1T = (const pg8::bf16_t*)(ws + WS_W1T) + (size_t)L * NTILES * 256 * 1024;
            pg8::Gemm g{(const pg8::bf16_t*)(ws + WS_XB), W1T + (size_t)NT_A * 256 * 1024, M, NT_B * 256, 1024, 1024, 1024, 0}; pg8::StaticOrder S; S.init(M, NT_B * 256, F.G, (int)blockIdx.x);
            pg8::EpiGate E{(const float*)(ws + WS_SSQ), (unsigned char*)(ws + WS_MG)};
            for (int rp = 0; rp < REP_P1B; ++rp) pg8::gemm_phase<pg8::EpiGate, pg8::StaticOrder, true, true>(F.lds + RING_OFF, g, S, E, F.wave);
            SEAM(pb + 3);
        }
        if (IN(pb + 4)) { PHASE_BEGIN();
            unsigned char* ws = argp()->ws;
            pg8::Gemm g{(const pg8::bf16_t*)(ws + WS_G), (const pg8::bf16_t*)(ws + WS_WBT) + (size_t)L * 3 * 1024 * 512, M, 1024, 512, 1536, 512, 4};
            pg8::SegOrder S; S.base.init(M, 1024, F.G, (int)blockIdx.x);
            pg8::EpiMerge E{(const unsigned char*)(ws + WS_MG), (pg8::bf16_t*)(ws + WS_MERGED)};
            for (int rp = 0; rp < REP_P3; ++rp) pg8::gemm_phase<pg8::EpiMerge, pg8::SegOrder, true, true>(F.lds + RING_OFF, g, S, E, F.wave);
            SEAM(pb + 4);
        }
        if (IN(pb + 5)) { PHASE_BEGIN();
            unsigned char* ws = argp()->ws; float* const outp = argp()->out;
            pg8::Gemm g{(const pg8::bf16_t*)(ws + WS_MERGED), (const pg8::bf16_t*)(ws + WS_WOT) + (size_t)L * 1024 * 1024, M, 1024, 1024, 1024, 1024, 0}; pg8::StaticOrder S; S.init(M, 1024, F.G, (int)blockIdx.x);
            const bool last = (L == DEPTH - 1);
            unsigned poison = 0u;
            if (last) poison = (__hip_atomic_load(F.ctl + CW_OVF, RLX_AGENT) != 0u) | (__hip_atomic_load(F.ctl + CW_BAR + XB_TMO, RLX_AGENT) != 0u);
            pg8::EpiOut E{L == 0 ? argp()->in[0] : (const float*)outp, outp, last ? nullptr : (pg8::bf16_t*)(ws + WS_XB), last ? nullptr : (float*)(ws + WS_SSQ), poison};
            pg8::gemm_phase<pg8::EpiOut, pg8::StaticOrder, true, true>(F.lds + RING_OFF, g, S, E, F.wave);
            if (!last) SEAM(pb + 5);
        }
    }
#undef IN
#undef SEAM
}

extern "C" void kernel_launch(void* const* d_in, const int* in_sizes, int n_in, void* d_out, int out_size, void* d_ws, size_t ws_size, hipStream_t stream) {
    static int grid = 0;
    if (grid == 0) {
        if (n_in != 9 || in_sizes[0] != M * DMODEL || out_size != M * DMODEL || ws_size < WS_END) { fprintf(stderr, "kernel_launch: unexpected shapes / workspace (n_in %d, in0 %d, out %d, ws %zu < %zu); nothing launched\n", n_in, n_in > 0 ? in_sizes[0] : -1, out_size, ws_size, (size_t)WS_END); grid = -1; return; }
        int dev = 0, cus = 0, per_cu = 0;
        if (hipGetDevice(&dev) != hipSuccess || hipDeviceGetAttribute(&cus, hipDeviceAttributeMultiprocessorCount, dev) != hipSuccess) { grid = -1; return; }
        if (hipFuncSetAttribute((const void*)mk_fwd, hipFuncAttributeMaxDynamicSharedMemorySize, LDS_BYTES) != hipSuccess) { fprintf(stderr, "kernel_launch: hipFuncSetAttribute failed\n"); grid = -1; return; }
        if (hipOccupancyMaxActiveBlocksPerMultiprocessor(&per_cu, (const void*)mk_fwd, 512, LDS_BYTES) != hipSuccess || per_cu < 1) fprintf(stderr, "kernel_launch: occupancy query reports %d workgroups per CU\n", per_cu);
        (void)hipGetLastError();
        grid = cus;
    }
    if (grid < 0) return;
    if (hipMemsetAsync((char*)d_ws + WS_CTL, 0, CTL_ZERO_BYTES, stream) != hipSuccess) return;
    Args a{};
    for (int i = 0; i < 9; ++i) a.in[i] = (const float*)d_in[i];
    a.out = (float*)d_out; a.ws = (unsigned char*)d_ws;
#if MK_ONE_LAUNCH
    a.ph_lo = 0; a.ph_hi = NPHASES;
    hipLaunchKernelGGL(mk_fwd, dim3(grid), dim3(512), LDS_BYTES, stream, a);
#else
    for (int p = 0; p < NPHASES; ++p) { a.ph_lo = p; a.ph_hi = p + 1; hipLaunchKernelGGL(mk_fwd, dim3(grid), dim3(512), LDS_BYTES, stream, a); }
#endif
}
```

```cpp
#include <hip/hip_runtime.h>
#include <cstdio>
#include <cstdint>
#include <cmath>
namespace pg8 {
#define PG8_LAS __attribute__((address_space(3)))
typedef unsigned short bf16_t;
typedef short bf16x8 __attribute__((ext_vector_type(8)));
typedef float f32x4 __attribute__((ext_vector_type(4)));
typedef unsigned u32x4 __attribute__((ext_vector_type(4)));
constexpr int BM = 256, BK = 64, HALF = 128, HTB = HALF * BK * 2  , STAGE_BYTES = 8 * HTB, NXCD = 8, WGM = 8;

__host__ __device__ __forceinline__ int lds_byte(int r, int c) { const int st = (r >> 4) * 2 + (c >> 5), rr = r & 15, cc = c & 31, ob = rr * 64 + cc * 2; return st * 1024 + (ob ^ (((ob >> 9) & 1) << 5)); }
__host__ __device__ __forceinline__ void stage_rc(int b, int& R, int& C) { const int st = b / 1024, sb = b % 1024, swz = sb ^ (((sb >> 9) & 1) << 5); R = (st >> 1) * 16 + swz / 64; C = (st & 1) * 32 + (swz % 64) / 2; }
__host__ __device__ __forceinline__ int perm32(int rho) { const int n = rho >> 4, i = rho & 15; return 8 * (i >> 2) + 4 * n + (i & 3); }

struct Unit { int pm, pn, seg; };
struct Gemm { const bf16_t* A; const bf16_t* Bt; int M, N, K, lda, ldb, segN; };

struct StaticOrder {
    int nM, nN, nwg, G, c;
    __host__ __device__ void init(int M, int N, int G_, int c_) { nM = M / BM; nN = N / BM; nwg = nM * nN; G = G_; c = c_; }
    __host__ __device__ bool next(int i, Unit& u) const {
        const long L = (long)i * G + c; if (L >= nwg) return false;
        int wgid = (int)L; { const int q = nwg / NXCD, r = nwg % NXCD, xcd = wgid % NXCD, off = wgid / NXCD; wgid = (xcd < r ? xcd * (q + 1) : r * (q + 1) + (xcd - r) * q) + off; }
        const int nig = WGM * nN, gid = wgid / nig, fm = gid * WGM, gsz = (nM - fm) < WGM ? (nM - fm) : WGM;
        u.pm = fm + ((wgid % nig) % gsz); u.pn = (wgid % nig) / gsz; u.seg = 0; return true;
    }
    __device__ __forceinline__ void a_ready(const Unit&) const {}
    __device__ __forceinline__ void done(const Unit&) const {}
};

__device__ __forceinline__ unsigned cvt_pk_bf16(float lo, float hi) { unsigned r; asm volatile("v_cvt_pk_bf16_f32 %0, %1, %2" : "=v"(r) : "v"(lo), "v"(hi)); return r; }
constexpr size_t EWS_MiB = 1u << 20, EWS_SSQ = 43 * EWS_MiB, EWS_CL = 45 * EWS_MiB, EWS_CT = 46 * EWS_MiB, EWS_IW = 47 * EWS_MiB, EWS_CF = 47 * EWS_MiB + 512 * 1024, EWS_IQ = 49 * EWS_MiB, EWS_IK = 57 * EWS_MiB, EWS_G = 188 * EWS_MiB,
    EWS_QA = 284 * EWS_MiB, EWS_QB = 316 * EWS_MiB, EWS_QC = 348 * EWS_MiB, EWS_KC = 380 * EWS_MiB, EWS_VC = 412 * EWS_MiB, EWS_KAB = 444 * EWS_MiB, EWS_VAB = 460 * EWS_MiB;

constexpr float C2Q = 0.125f * 1.4426950408889634f;
__device__ __forceinline__ float fast_sigmoid(float x) { return __builtin_amdgcn_rcpf(1.0f + __expf(-x)); }
__device__ __forceinline__ u32x4 pack8(const f32x4 a, const f32x4 b) { u32x4 w; w.x = cvt_pk_bf16(a[0], a[1]); w.y = cvt_pk_bf16(a[2], a[3]); w.z = cvt_pk_bf16(b[0], b[1]); w.w = cvt_pk_bf16(b[2], b[3]); return w; }
__device__ __forceinline__ void unpack8(const u32x4 w, f32x4& a, f32x4& b) {
    a[0] = __uint_as_float(w.x << 16); a[1] = __uint_as_float(w.x & 0xffff0000u); a[2] = __uint_as_float(w.y << 16); a[3] = __uint_as_float(w.y & 0xffff0000u);
    b[0] = __uint_as_float(w.z << 16); b[1] = __uint_as_float(w.z & 0xffff0000u); b[2] = __uint_as_float(w.w << 16); b[3] = __uint_as_float(w.w & 0xffff0000u); }
#define EPI_PIN() asm volatile("" ::: "memory")
__device__ __forceinline__ void rows_rstd(const float* ssq, int row0, int fq, float (&rs)[2][4]) {
    f32x4 pr[2][4];
#pragma unroll
    for (int ai = 0; ai < 2; ++ai)
#pragma unroll
        for (int m = 0; m < 4; ++m) pr[ai][m] = *(const f32x4*)(ssq + (size_t)(row0 + ai * HALF + m * 16) * 16 + 4 * fq);
    EPI_PIN();
#pragma unroll
    for (int ai = 0; ai < 2; ++ai)
#pragma unroll
        for (int m = 0; m < 4; ++m) { const f32x4 a = pr[ai][m]; float t = (a[0] + a[1]) + (a[2] + a[3]); t += __shfl_xor(t, 16); t += __shfl_xor(t, 32); rs[ai][m] = __builtin_amdgcn_rsqf(t * (1.0f / 1024.0f) + 1e-6f); }
}
struct EpiIn {
    static constexpr bool PERM = true, AFTER_DRAIN = false;
    unsigned char* ws; const float* qkg; const float* bfg;
    __device__ __forceinline__ bool keep(const Unit&) const { return false; }
    __device__ __forceinline__ void operator()(f32x4 (&acc)[2][2][4][2], const Unit& u, int wr, int wc, int fr, int fq) const {
        const int row0 = u.pm * BM + wr * 64 + fr, t = u.pn, lc0 = wc * 64 + fq * 8;
        float rs[2][4]; rows_rstd((const float*)(ws + EWS_SSQ), row0, fq, rs);
        if (t == 18) {
            bf16_t* IQ = (bf16_t*)(ws + EWS_IQ); bf16_t* IK = (bf16_t*)(ws + EWS_IK); float* IW = (float*)(ws + EWS_IW);
#pragma unroll
            for (int ai = 0; ai < 2; ++ai)
#pragma unroll
                for (int m = 0; m < 4; ++m) { const int row = row0 + ai * HALF + m * 16; const float f = rs[ai][m];
#pragma unroll
                    for (int bj = 0; bj < 2; ++bj) { const int lc = lc0 + 32 * bj; const f32x4 v0 = acc[ai][bj][m][0] * f, v1 = acc[ai][bj][m][1] * f;
                        if (lc < 128) *(u32x4*)(IQ + (size_t)row * 128 + lc) = pack8(v0, v1);
                        else if (lc < 160) *(u32x4*)(IK + (size_t)row * 32 + (lc - 128)) = pack8(v0, v1);
                        else if (lc == 160) *(f32x4*)(IW + (size_t)row * 4) = v0 * 0.08838834764831845f; } }
            int ln_ = (int)__builtin_amdgcn_mbcnt_hi(~0u, __builtin_amdgcn_mbcnt_lo(~0u, 0u)); asm volatile("" : "+v"(ln_));
            if (wc == 2 && (ln_ >> 4) < 2) { const int fql = ln_ >> 4, frl = ln_ & 15;
                float* CL = (float*)(ws + EWS_CL); float* CT = (float*)(ws + EWS_CT); const int hb = 4 * fql; const f32x4 bfv = *(const f32x4*)(bfg + hb);
#pragma unroll
                for (int ai = 0; ai < 2; ++ai) { f32x4 run = {0.f, 0.f, 0.f, 0.f};
#pragma unroll
                    for (int m = 0; m < 4; ++m) { const int row = row0 + ai * HALF + m * 16; const f32x4 z = (fql == 0 ? acc[ai][1][m][1] : acc[ai][1][m][0]) * rs[ai][m] + bfv; f32x4 lf;
#pragma unroll
                        for (int e = 0; e < 4; ++e) lf[e] = (z[e] < 0.f ? z[e] : 0.f) - __logf(1.0f + __expf(-fabsf(z[e])));
#pragma unroll
                        for (int o = 1; o < 16; o <<= 1)
#pragma unroll
                            for (int e = 0; e < 4; ++e) { const float tt = __shfl_up(lf[e], o, 16); if (frl >= o) lf[e] += tt; }
                        const f32x4 cs = lf + run;
                        const int bb = row >> 13, ss = row & 8191;
#pragma unroll
                        for (int e = 0; e < 4; ++e) CL[(size_t)(bb * 8 + hb + e) * 8192 + ss] = cs[e];
#pragma unroll
                        for (int e = 0; e < 4; ++e) run[e] += __shfl(lf[e], 15, 16); }
                    if (frl == 15) { const int row = row0 + ai * HALF, bb = row >> 13, ch = (row & 8191) >> 6;
#pragma unroll
                        for (int e = 0; e < 4; ++e) CT[(bb * 8 + hb + e) * 128 + ch] = run[e]; } } }
            return;
        }
        bf16_t* dst; int ldc, colbase; const float* gp = qkg; float csc = 1.f; bool norm = false, act = false;
        if (t < 6) { const int mx = t >> 1; dst = (bf16_t*)(ws + (mx == 0 ? EWS_QA : (mx == 1 ? EWS_QB : EWS_QC))); ldc = 512; colbase = (t & 1) * 256; norm = true; gp = qkg + (mx * 2 + 0) * 64; csc = (mx == 2) ? C2Q : 1.f; }
        else if (t == 6) { dst = (bf16_t*)(ws + EWS_KAB); ldc = 128; colbase = (wc >> 1) * (32768 * 128 - 128); norm = true;     gp = qkg + ((wc >> 1) * 2 + 1) * 64; }
        else if (t < 9) { dst = (bf16_t*)(ws + EWS_KC); ldc = 512; colbase = (t - 7) * 256; norm = true; gp = qkg + (2 * 2 + 1) * 64; }
        else if (t == 9) { dst = (bf16_t*)(ws + EWS_VAB); ldc = 128; colbase = (wc >> 1) * (32768 * 128 - 128); }
        else if (t < 12) { dst = (bf16_t*)(ws + EWS_VC); ldc = 512; colbase = (t - 10) * 256; }
        else { dst = (bf16_t*)(ws + EWS_G); ldc = 1536; colbase = (t - 12) * 256; act = true; }
        f32x4 gv[2][2];
#pragma unroll
        for (int bj = 0; bj < 2; ++bj)
#pragma unroll
            for (int n = 0; n < 2; ++n) gv[bj][n] = norm ? *(const f32x4*)(gp + 8 * fq + 32 * bj + 4 * n) * csc : (f32x4){1.f, 1.f, 1.f, 1.f};
        EPI_PIN();
#pragma unroll
        for (int ai = 0; ai < 2; ++ai)
#pragma unroll
            for (int m = 0; m < 4; ++m) { const int row = row0 + ai * HALF + m * 16; float f = rs[ai][m];
                if (norm) { float ss = 0.f;
#pragma unroll
                    for (int bj = 0; bj < 2; ++bj)
#pragma unroll
                        for (int n = 0; n < 2; ++n) { const f32x4 x = acc[ai][bj][m][n]; ss += (x[0] * x[0] + x[1] * x[1]) + (x[2] * x[2] + x[3] * x[3]); }
                    ss += __shfl_xor(ss, 16); ss += __shfl_xor(ss, 32);
                    f = f * __builtin_amdgcn_rsqf(f * f * ss * (1.0f / 64.0f) + 1e-6f); }
                bf16_t* rowp = dst + (size_t)row * ldc + colbase + lc0;
#pragma unroll
                for (int bj = 0; bj < 2; ++bj) { f32x4 v0 = acc[ai][bj][m][0] * f * gv[bj][0], v1 = acc[ai][bj][m][1] * f * gv[bj][1];
                    if (act) {
#pragma unroll
                        for (int e = 0; e < 4; ++e) { v0[e] = v0[e] * fast_sigmoid(v0[e]); v1[e] = v1[e] * fast_sigmoid(v1[e]); } }
                    *(u32x4*)(rowp + 32 * bj) = pack8(v0, v1); } }
    }
};
typedef unsigned u32x2e __attribute__((ext_vector_type(2)));
__device__ __forceinline__ unsigned gate_q4(const f32x4 v) { unsigned w = 0u;
    w = __builtin_amdgcn_cvt_pk_u8_f32(fmaxf(255.0f * fast_sigmoid(v[0]), 1.0f), 0, w); w = __builtin_amdgcn_cvt_pk_u8_f32(fmaxf(255.0f * fast_sigmoid(v[1]), 1.0f), 1, w);
    w = __builtin_amdgcn_cvt_pk_u8_f32(fmaxf(255.0f * fast_sigmoid(v[2]), 1.0f), 2, w); w = __builtin_amdgcn_cvt_pk_u8_f32(fmaxf(255.0f * fast_sigmoid(v[3]), 1.0f), 3, w); return w; }
__device__ __forceinline__ f32x4 gate_f4(const unsigned w) { return (f32x4){(float)(w & 0xffu), (float)((w >> 8) & 0xffu), (float)((w >> 16) & 0xffu), (float)(w >> 24)}; }
struct EpiGate {
    static constexpr bool PERM = true, AFTER_DRAIN = false;
    const float* ssq; unsigned char* MG;
    __device__ __forceinline__ bool keep(const Unit&) const { return false; }
    __device__ __forceinline__ void operator()(f32x4 (&acc)[2][2][4][2], const Unit& u, int wr, int wc, int fr, int fq) const {
        const int row0 = u.pm * BM + wr * 64 + fr, lc0 = wc * 64 + fq * 8;
        float rs[2][4]; rows_rstd(ssq, row0, fq, rs);
#pragma unroll
        for (int ai = 0; ai < 2; ++ai)
#pragma unroll
            for (int m = 0; m < 4; ++m) { const int row = row0 + ai * HALF + m * 16; const float f = rs[ai][m];
                unsigned char* rowp = MG + (size_t)row * 3072 + u.pn * BM + lc0;
#pragma unroll
                for (int bj = 0; bj < 2; ++bj) { u32x2e w; w.x = gate_q4(acc[ai][bj][m][0] * f); w.y = gate_q4(acc[ai][bj][m][1] * f); *(u32x2e*)(rowp + 32 * bj) = w; } }
    }
};
struct EpiMerge {
    static constexpr bool PERM = true, AFTER_DRAIN = false;
    const unsigned char* MG; bf16_t* OUT;
    __device__ __forceinline__ bool keep(const Unit& u) const { return u.seg < 2; }
    __device__ __forceinline__ void operator()(f32x4 (&acc)[2][2][4][2], const Unit& u, int wr, int wc, int fr, int fq) const {
        const int row0 = u.pm * BM + wr * 64 + fr, col0 = u.pn * BM + wc * 32 + 8 * fq, seg = u.seg;
#pragma unroll
        for (int ai = 0; ai < 2; ++ai) {
            u32x2e ga[4][2], gb[4][2];
#pragma unroll
            for (int m = 0; m < 4; ++m) { const unsigned char* gp = MG + (size_t)(row0 + ai * HALF + m * 16) * 3072 + seg * 1024 + col0;
#pragma unroll
                for (int bj = 0; bj < 2; ++bj) { ga[m][bj] = *(const u32x2e*)(gp + bj * HALF); gb[m][bj] = seg < 2 ? *(const u32x2e*)(gp + 1024 + bj * HALF) : ga[m][bj]; } }
            EPI_PIN();
#pragma unroll
            for (int m = 0; m < 4; ++m) { const int row = row0 + ai * HALF + m * 16;
#pragma unroll
                for (int bj = 0; bj < 2; ++bj) { f32x4 a0 = gate_f4(ga[m][bj].x), a1 = gate_f4(ga[m][bj].y);
                    if (seg < 2) { const f32x4 b0 = gate_f4(gb[m][bj].x), b1 = gate_f4(gb[m][bj].y);
#pragma unroll
                        for (int e = 0; e < 4; ++e) { a0[e] = a0[e] * __builtin_amdgcn_rcpf(b0[e]); a1[e] = a1[e] * __builtin_amdgcn_rcpf(b1[e]); } }
                    else { a0 = a0 * (1.0f / 255.0f); a1 = a1 * (1.0f / 255.0f); }
                    acc[ai][bj][m][0] = acc[ai][bj][m][0] * a0; acc[ai][bj][m][1] = acc[ai][bj][m][1] * a1;
                    if (seg == 2) *(u32x4*)(OUT + (size_t)row * 1024 + col0 + bj * HALF) = pack8(acc[ai][bj][m][0], acc[ai][bj][m][1]); } }
        }
    }
};
struct EpiOut {
    static constexpr bool PERM = true, AFTER_DRAIN = false;
    const float* resid; float* out; bf16_t* XB; float* ssq; unsigned poison;
    __device__ __forceinline__ bool keep(const Unit&) const { return false; }
    __device__ __forceinline__ void operator()(f32x4 (&acc)[2][2][4][2], const Unit& u, int wr, int wc, int fr, int fq) const {
        const int row0 = u.pm * BM + wr * 64 + fr, col0 = u.pn * BM + wc * 32 + 8 * fq;
#pragma unroll
        for (int ai = 0; ai < 2; ++ai) {
            f32x4 rv[4][2][2];
#pragma unroll
            for (int m = 0; m < 4; ++m)
#pragma unroll
                for (int bj = 0; bj < 2; ++bj) { const size_t o = (size_t)(row0 + ai * HALF + m * 16) * 1024 + col0 + bj * HALF; rv[m][bj][0] = *(const f32x4*)(resid + o); rv[m][bj][1] = *(const f32x4*)(resid + o + 4); }
            EPI_PIN();
#pragma unroll
            for (int m = 0; m < 4; ++m) { const int row = row0 + ai * HALF + m * 16; float ss = 0.f;
#pragma unroll
                for (int bj = 0; bj < 2; ++bj) { const size_t o = (size_t)row * 1024 + col0 + bj * HALF;
                    f32x4 v0 = rv[m][bj][0] + acc[ai][bj][m][0], v1 = rv[m][bj][1] + acc[ai][bj][m][1];
                    if (poison) { const float qn = __builtin_nanf(""); v0 = (f32x4){qn, qn, qn, qn}; v1 = v0; }
                    *(f32x4*)(out + o) = v0; *(f32x4*)(out + o + 4) = v1;
                    if (XB) { *(u32x4*)(XB + o) = pack8(v0, v1); ss += ((v0[0] * v0[0] + v0[1] * v0[1]) + (v0[2] * v0[2] + v0[3] * v0[3])) + ((v1[0] * v1[0] + v1[1] * v1[1]) + (v1[2] * v1[2] + v1[3] * v1[3])); } }
                if (XB) { ss += __shfl_xor(ss, 16); ss += __shfl_xor(ss, 32); if (fq == 0) ssq[(size_t)row * 16 + u.pn * 4 + wc] = ss; } }
            EPI_PIN();
        }
    }
};
struct SegOrder {
    StaticOrder base;
    __device__ __forceinline__ bool next(int i, Unit& u) const { if (!base.next(i / 3, u)) return false; u.seg = i % 3; return true; }
    __device__ __forceinline__ void a_ready(const Unit&) const {}
    __device__ __forceinline__ void done(const Unit&) const {}
};

template <class Epi, class Sched, bool ALIGN_EPI = false, bool SP2 = false>
__device__ __forceinline__ void gemm_phase(PG8_LAS unsigned char* lds, const Gemm g, const Sched& S, const Epi& E, int wave_id) {
    int tid_ = (int)__builtin_amdgcn_mbcnt_hi(~0u, __builtin_amdgcn_mbcnt_lo(~0u, 0u)); asm volatile("" : "+v"(tid_)); tid_ += wave_id * 64;
    const int tid = tid_, wid = __builtin_amdgcn_readfirstlane(tid >> 6), lane = tid & 63, wr = wid >> 2, wc = wid & 3, fr = lane & 15, fq = lane >> 4;
    const int K = g.K, nt = K / BK;
    unsigned voffA[2], voffB[2];
#pragma unroll
    for (int i = 0; i < 2; ++i) { int R, C; stage_rc(tid * 16 + i * 8192, R, C); const int Rb = Epi::PERM ? ((R & ~31) + perm32(R & 31)) : R;
        voffA[i] = (unsigned)(R * g.lda + C) * 2u; voffB[i] = (unsigned)(Rb * g.ldb + C) * 2u; }
    const size_t kstep = (size_t)(BK * 2);
    const size_t hstepA = (size_t)HALF * g.lda * 2, hstepB = (size_t)HALF * g.ldb * 2;
    const size_t tstepA = 2 * hstepA, tstepB = 2 * hstepB, sstepA = (size_t)K * 2;
    const unsigned ldsw = (unsigned)wid * 1024u;
    const int aoff = lds_byte(wr * 64 + fr, fq * 8), boff = lds_byte(wc * 32 + fr, fq * 8);
#define PG8_SA(b, h) (((b) * 2 + (h)) * HTB)
#define PG8_SB(b, h) ((4 + (b) * 2 + (h)) * HTB)
#define PG8_STAGE(bufoff, gbase, voff) do { _Pragma("unroll") for (int _i = 0; _i < 2; ++_i) \
        __builtin_amdgcn_global_load_lds((const unsigned*)((const char*)(gbase) + (voff)[_i]), (PG8_LAS unsigned*)(lds + (bufoff) + ldsw + _i * 8192), 16, 0, 0); } while (0)
#define PG8_LDA(dst, b, h) do { _Pragma("unroll") for (int m = 0; m < 4; ++m) _Pragma("unroll") for (int k = 0; k < 2; ++k) dst[m][k] = *(const PG8_LAS bf16x8*)(lds + PG8_SA(b, h) + aoff + m * 2048 + k * 1024); } while (0)
#define PG8_LDB(dst, b, h) do { _Pragma("unroll") for (int n = 0; n < 2; ++n) _Pragma("unroll") for (int k = 0; k < 2; ++k) dst[n][k] = *(const PG8_LAS bf16x8*)(lds + PG8_SB(b, h) + boff + n * 2048 + k * 1024); } while (0)
#define PG8_MMA(ai, bj, At, Bt) do { __builtin_amdgcn_s_setprio(1); _Pragma("unroll") for (int m = 0; m < 4; ++m) _Pragma("unroll") for (int n = 0; n < 2; ++n) _Pragma("unroll") for (int k = 0; k < 2; ++k) \
        acc[ai][bj][m][n] = __builtin_amdgcn_mfma_f32_16x16x32_bf16(Bt[n][k], At[m][k], acc[ai][bj][m][n], 0, 0, 0); __builtin_amdgcn_s_setprio(0); } while (0)
#define PG8_WAIT_V(n) asm volatile("s_waitcnt vmcnt(" #n ")" ::: "memory")
#define PG8_WAIT_L(n) asm volatile("s_waitcnt lgkmcnt(" #n ")" ::: "memory")
#define PG8_BAR __builtin_amdgcn_s_barrier()
#define PG8_SCHED __builtin_amdgcn_sched_barrier(0)
    Unit cur, nxt; int ui = 0;
    if (!S.next(0, cur)) return;
    f32x4 acc[2][2][4][2];
#pragma unroll
    for (int a = 0; a < 2; ++a)
#pragma unroll
        for (int b = 0; b < 2; ++b)
#pragma unroll
            for (int m = 0; m < 4; ++m)
#pragma unroll
                for (int n = 0; n < 2; ++n) acc[a][b][m][n] = (f32x4){0.f, 0.f, 0.f, 0.f};
    bf16x8 At[4][2], B0[2][2], B1[2][2];
    const char* cA = (const char*)g.A + (size_t)cur.pm * tstepA + (size_t)cur.seg * sstepA; const char* cB = (const char*)g.Bt + (size_t)(cur.seg * g.segN + cur.pn) * tstepB;
    S.a_ready(cur);
    if constexpr (SP2) {
        PG8_STAGE(PG8_SB(0, 0), cB, voffB); PG8_STAGE(PG8_SB(0, 1), cB + hstepB, voffB); PG8_STAGE(PG8_SA(0, 0), cA, voffA); PG8_STAGE(PG8_SA(0, 1), cA + hstepA, voffA);
        if (wr == 1) PG8_BAR;
        PG8_WAIT_V(2); PG8_BAR;
        PG8_STAGE(PG8_SB(1, 0), cB + kstep, voffB); PG8_STAGE(PG8_SA(1, 0), cA + kstep, voffA); PG8_STAGE(PG8_SB(1, 1), cB + hstepB + kstep, voffB);
        PG8_WAIT_V(6); PG8_BAR;
    } else {
        PG8_STAGE(PG8_SB(0, 0), cB, voffB); PG8_STAGE(PG8_SA(0, 0), cA, voffA); PG8_STAGE(PG8_SB(0, 1), cB + hstepB, voffB); PG8_STAGE(PG8_SA(0, 1), cA + hstepA, voffA);
        if (wr == 1) PG8_BAR;
        PG8_WAIT_V(4); PG8_BAR;
        PG8_STAGE(PG8_SB(1, 0), cB + kstep, voffB); PG8_STAGE(PG8_SA(1, 0), cA + kstep, voffA); PG8_STAGE(PG8_SB(1, 1), cB + hstepB + kstep, voffB);
        PG8_WAIT_V(6); PG8_BAR;
    }
    for (;;) {
        const bool has_next = S.next(ui + 1, nxt);
        const char* nA = has_next ? (const char*)g.A + (size_t)nxt.pm * tstepA + (size_t)nxt.seg * sstepA : cA; const char* nB = has_next ? (const char*)g.Bt + (size_t)(nxt.seg * g.segN + nxt.pn) * tstepB : cB;
        for (int t = 0; t < nt; t += 2) {
            const bool last = (t == nt - 2);
            const char* a1 = cA + (size_t)(t + 1) * kstep;
            const char* a2 = last ? nA : cA + (size_t)(t + 2) * kstep; const char* b2 = last ? nB : cB + (size_t)(t + 2) * kstep;
            const char* a3 = a2 + kstep; const char* b3 = b2 + kstep;
            if (last && has_next) S.a_ready(nxt);
            if constexpr (SP2) {
            PG8_LDB(B0, 0, 0); PG8_LDB(B1, 0, 1); PG8_SCHED; PG8_LDA(At, 0, 0); PG8_STAGE(PG8_SA(1, 1), a1 + hstepA, voffA);
            PG8_WAIT_V(8); PG8_WAIT_L(0); PG8_BAR; PG8_MMA(0, 0, At, B0); PG8_MMA(0, 1, At, B1); PG8_BAR; PG8_SCHED;
            PG8_LDA(At, 0, 1); PG8_STAGE(PG8_SB(0, 0), b2, voffB); PG8_STAGE(PG8_SB(0, 1), b2 + hstepB, voffB); PG8_STAGE(PG8_SA(0, 0), a2, voffA);
            PG8_WAIT_V(8); PG8_WAIT_L(0); PG8_BAR; PG8_MMA(1, 0, At, B0); PG8_MMA(1, 1, At, B1); PG8_BAR; PG8_SCHED;
            PG8_LDB(B0, 1, 0); PG8_LDB(B1, 1, 1); PG8_SCHED; PG8_LDA(At, 1, 0); PG8_STAGE(PG8_SA(0, 1), a2 + hstepA, voffA);
            PG8_WAIT_V(8); PG8_WAIT_L(0); PG8_BAR; PG8_MMA(0, 0, At, B0); PG8_MMA(0, 1, At, B1); PG8_BAR; PG8_SCHED;
            PG8_LDA(At, 1, 1); PG8_STAGE(PG8_SB(1, 0), b3, voffB); PG8_STAGE(PG8_SB(1, 1), b3 + hstepB, voffB); PG8_STAGE(PG8_SA(1, 0), a3, voffA);
            PG8_WAIT_V(8); PG8_WAIT_L(0); PG8_BAR; PG8_MMA(1, 0, At, B0); PG8_MMA(1, 1, At, B1); PG8_BAR; PG8_SCHED;
            } else {
            PG8_LDB(B0, 0, 0); PG8_SCHED; PG8_LDA(At, 0, 0); PG8_STAGE(PG8_SA(1, 1), a1 + hstepA, voffA);
            PG8_WAIT_L(8); PG8_BAR; PG8_WAIT_L(0); PG8_MMA(0, 0, At, B0); PG8_BAR; PG8_SCHED;
            PG8_LDB(B1, 0, 1); PG8_STAGE(PG8_SB(0, 0), b2, voffB);
            PG8_BAR; PG8_WAIT_L(0); PG8_MMA(0, 1, At, B1); PG8_BAR;
            PG8_LDA(At, 0, 1); PG8_STAGE(PG8_SA(0, 0), a2, voffA);
            PG8_BAR; PG8_WAIT_L(0); PG8_MMA(1, 0, At, B0); PG8_BAR; PG8_SCHED;
            PG8_STAGE(PG8_SB(0, 1), b2 + hstepB, voffB);
            PG8_WAIT_V(6); PG8_BAR; PG8_MMA(1, 1, At, B1); PG8_BAR;
            PG8_LDB(B0, 1, 0); PG8_SCHED; PG8_LDA(At, 1, 0); PG8_STAGE(PG8_SA(0, 1), a2 + hstepA, voffA);
            PG8_WAIT_L(8); PG8_BAR; PG8_WAIT_L(0); PG8_MMA(0, 0, At, B0); PG8_BAR; PG8_SCHED;
            PG8_LDB(B1, 1, 1); PG8_STAGE(PG8_SB(1, 0), b3, voffB);
            PG8_BAR; PG8_WAIT_L(0); PG8_MMA(0, 1, At, B1); PG8_BAR;
            PG8_LDA(At, 1, 1); PG8_STAGE(PG8_SA(1, 0), a3, voffA);
            PG8_BAR; PG8_WAIT_L(0); PG8_MMA(1, 0, At, B0); PG8_BAR; PG8_SCHED;
            PG8_STAGE(PG8_SB(1, 1), b3 + hstepB, voffB);
            PG8_WAIT_V(6); PG8_BAR; PG8_MMA(1, 1, At, B1); PG8_BAR;
            }
        }
        if constexpr (ALIGN_EPI) { if (wr == 0) PG8_BAR; }
        if constexpr (!Epi::AFTER_DRAIN) { E(acc, cur, wr, wc, fr, fq); S.done(cur); }
        if (!has_next) break;
        if (!E.keep(cur)) {
#pragma unroll
        for (int a = 0; a < 2; ++a)
#pragma unroll
            for (int b = 0; b < 2; ++b)
#pragma unroll
                for (int m = 0; m < 4; ++m)
#pragma unroll
                    for (int n = 0; n < 2; ++n) acc[a][b][m][n] = (f32x4){0.f, 0.f, 0.f, 0.f};
        }
        cur = nxt; cA = nA; cB = nB; ++ui;
        if constexpr (ALIGN_EPI) { if (wr == 1) PG8_BAR; }
    }
    PG8_WAIT_V(0);
    if constexpr (!ALIGN_EPI) { if (wr == 0) PG8_BAR; }
    PG8_BAR;
    if constexpr (Epi::AFTER_DRAIN) { E.fused(acc, cur, wr, wc, fr, fq, lds, wid, lane); S.done(cur); }
#undef PG8_SA
#undef PG8_SB
#undef PG8_STAGE
#undef PG8_LDA
#undef PG8_LDB
#undef PG8_MMA
#undef PG8_WAIT_V
#undef PG8_WAIT_L
#undef PG8_BAR
#undef PG8_SCHED
}
}
#include <hip/hip_bf16.h>
#include <cmath>
namespace attn_body {
using bf16=__hip_bfloat16;
using bf16x8=__attribute__((ext_vector_type(8)))short;
using s16x4=__attribute__((ext_vector_type(4)))short;
using f32x16=__attribute__((ext_vector_type(16)))float;
using u32x4=__attribute__((ext_vector_type(4)))unsigned;
constexpr int BATCH=4,NHEAD=8,SEQ=8192,D=64,DM=NHEAD*D;
constexpr int NW=8,QBLK=32,QB=QBLK*NW,KVBLK=64,NQB=SEQ/QB;
constexpr int ATTN_PITCH=DM, ATTN_UNIT_ROWS=QB, OPITCH=1536, OCOL0=1024;
__device__ __forceinline__ int crow(int r,int hi){return (r&3)+8*(r>>2)+4*hi;}
#define SBAR() __builtin_amdgcn_sched_barrier(0)
__device__ __forceinline__ void cmask(f32x16&p0,f32x16&p1,int jb,int qrel,int hi){
  const float NEG=-INFINITY; int kb=64*jb+4*hi;
  #pragma unroll
  for(int r=0;r<16;++r){int kv=kb+(r&3)+8*(r>>2); if(kv>qrel)p0[r]=NEG; if(kv+32>qrel)p1[r]=NEG;}
}

constexpr int NSLOT=3, SLOTB=8192;
constexpr int LDS_K=0, LDS_V=NSLOT*SLOTB, LDS_WS=2*NSLOT*SLOTB, LDS_OST=LDS_WS+NW*64*4, LDS_BYTES=LDS_OST+NW*4096;
constexpr float C2=0.125f*1.4426950408889634f;
__device__ __forceinline__ void glds16(const void*gsrc,unsigned lds_dst){unsigned keep;
  asm volatile("s_mov_b32 %0, m0\n\ts_mov_b32 m0, %2\n\ts_nop 0\n\tglobal_load_lds_dwordx4 %1, off\n\ts_mov_b32 m0, %0":"=&s"(keep):"v"(gsrc),"s"(lds_dst):"memory");}
__device__ __forceinline__ float max3f(float a,float b,float c){float r;asm("v_max3_f32 %0, %1, %2, %3":"=v"(r):"v"(a),"v"(b),"v"(c));return r;}
__device__ __forceinline__ float max2f(float a,float b){float r;asm("v_max_f32_e32 %0, %1, %2":"=v"(r):"v"(a),"v"(b));return r;}
__device__ __forceinline__ float fadd_s(float a,float b){float r;asm("v_add_f32_e32 %0, %1, %2":"=v"(r):"v"(a),"v"(b));return r;}
__device__ __forceinline__ float fsub_s(float a,float b){float r;asm("v_sub_f32_e32 %0, %1, %2":"=v"(r):"v"(a),"v"(b));return r;}
typedef float f32x2_t __attribute__((ext_vector_type(2))); typedef __bf16 bf16x2_t __attribute__((ext_vector_type(2)));
__device__ __forceinline__ unsigned cvtpk_s(float lo,float hi){f32x2_t v={lo,hi};bf16x2_t b=__builtin_convertvector(v,bf16x2_t);return __builtin_bit_cast(unsigned,b);}
#define WAIT_BAR(N) asm volatile("s_waitcnt vmcnt(" #N ") lgkmcnt(0)\n\ts_barrier":::"memory")

__device__ __forceinline__ void qkt(f32x16&p0,f32x16&p1,const char*Kslot,const bf16x8*qr,int r32,int hi){
  const char*kb=Kslot+hi*1024+r32*16;
  #pragma unroll
  for(int d0=0;d0<4;++d0){
    const bf16x8 b0=*reinterpret_cast<const bf16x8*>(kb+d0*2048);
    const bf16x8 b1=*reinterpret_cast<const bf16x8*>(kb+d0*2048+512);
    p0=__builtin_amdgcn_mfma_f32_32x32x16_bf16(b0,qr[d0],p0,0,0,0);p1=__builtin_amdgcn_mfma_f32_32x32x16_bf16(b1,qr[d0],p1,0,0,0);}
}
typedef __attribute__((address_space(3))) const unsigned* lds_cuptr;
typedef float f32x4_t __attribute__((ext_vector_type(4)));
__device__ __forceinline__ unsigned bfr(float f){ unsigned u=__builtin_bit_cast(unsigned,f); return (u+0x7fffu+((u>>16)&1u))>>16; }
__device__ __forceinline__ void biasmm(f32x16&c0,f32x16&c1,unsigned w0,unsigned w1  ,unsigned qm1,int hi){
  const unsigned one=hi?0u:0x3f803f80u; w0=hi?0u:w0; w1=hi?0u:w1;
  const u32x4 k0={w0,one,0u,0u},k1={w1,one,0u,0u},qv={one,qm1,0u,0u};
  const f32x16 z=f32x16{};
  c0=__builtin_amdgcn_mfma_f32_32x32x16_bf16(__builtin_bit_cast(bf16x8,k0),__builtin_bit_cast(bf16x8,qv),z,0,0,0);
  c1=__builtin_amdgcn_mfma_f32_32x32x16_bf16(__builtin_bit_cast(bf16x8,k1),__builtin_bit_cast(bf16x8,qv),z,0,0,0);
}
typedef __attribute__((address_space(3))) const char* lds_cptr;
typedef short v4i16_t __attribute__((ext_vector_type(4)));
__device__ __forceinline__ void kload8(bf16x8*kf,lds_cptr kp){
  kf[0]=*(const __attribute__((address_space(3))) bf16x8*)(kp);      kf[1]=*(const __attribute__((address_space(3))) bf16x8*)(kp+512);
  kf[2]=*(const __attribute__((address_space(3))) bf16x8*)(kp+2048); kf[3]=*(const __attribute__((address_space(3))) bf16x8*)(kp+2560);
  kf[4]=*(const __attribute__((address_space(3))) bf16x8*)(kp+4096); kf[5]=*(const __attribute__((address_space(3))) bf16x8*)(kp+4608);
  kf[6]=*(const __attribute__((address_space(3))) bf16x8*)(kp+6144); kf[7]=*(const __attribute__((address_space(3))) bf16x8*)(kp+6656);
}
__device__ __forceinline__ void kload2(bf16x8*kf,lds_cptr kp,int j){ kf[2*j]=*(const __attribute__((address_space(3))) bf16x8*)(kp+j*2048); kf[2*j+1]=*(const __attribute__((address_space(3))) bf16x8*)(kp+j*2048+512); }
__device__ __forceinline__ s16x4 vtr(lds_cptr p){ return __builtin_bit_cast(s16x4,__builtin_amdgcn_ds_read_tr16_b64_v4i16((__attribute__((address_space(3))) v4i16_t*)p)); }
__device__ __forceinline__ float rowmax(const f32x16&p0,const f32x16&p1){
  float a=max3f(p0[0],p0[1],p1[0]),b=max3f(p0[2],p0[3],p1[1]);a=max3f(a,p1[2],p1[3]);
  #pragma unroll
  for(int r=4;r<16;r+=4){a=max3f(a,p0[r],p0[r+1]);b=max3f(b,p0[r+2],p0[r+3]);a=max3f(a,p1[r],p1[r+1]);b=max3f(b,p1[r+2],p1[r+3]);}
  const float m=max2f(a,b);
  auto rr=__builtin_amdgcn_permlane32_swap(__float_as_uint(m),__float_as_uint(m),false,false);
  return max2f(__uint_as_float(rr[0]),__uint_as_float(rr[1]));
}
__device__ __forceinline__ void pv(f32x16*o,int vb,bf16x8 pa0,bf16x8 pa1,bf16x8 pa2,bf16x8 pa3){
  #pragma unroll
  for(int d0=0;d0<2;++d0){s16x4 lo[4],hi[4];
    #pragma unroll
    for(int ks=0;ks<4;++ks){
      asm volatile("ds_read_b64_tr_b16 %0,%1 offset:%c2":"=&v"(lo[ks]):"v"(vb),"i"(d0*4096+ks*1024):"memory");
      asm volatile("ds_read_b64_tr_b16 %0,%1 offset:%c2":"=&v"(hi[ks]):"v"(vb),"i"(d0*4096+ks*1024+512):"memory");}
    asm volatile("s_waitcnt lgkmcnt(0)":::"memory");SBAR();
    #define PK(k) (bf16x8){lo[k][0],lo[k][1],lo[k][2],lo[k][3],hi[k][0],hi[k][1],hi[k][2],hi[k][3]}
    o[d0]=__builtin_amdgcn_mfma_f32_32x32x16_bf16(pa0,PK(0),o[d0],0,0,0);
    o[d0]=__builtin_amdgcn_mfma_f32_32x32x16_bf16(pa1,PK(1),o[d0],0,0,0);
    o[d0]=__builtin_amdgcn_mfma_f32_32x32x16_bf16(pa2,PK(2),o[d0],0,0,0);
    o[d0]=__builtin_amdgcn_mfma_f32_32x32x16_bf16(pa3,PK(3),o[d0],0,0,0);
    #undef PK
  }
}

__device__ __forceinline__ u32x4 mul_bf16x8(u32x4 a,u32x4 b){ u32x4 r;
  #pragma unroll
  for(int i=0;i<4;++i){ const float al=__uint_as_float(a[i]<<16),ah=__uint_as_float(a[i]&0xffff0000u),bl=__uint_as_float(b[i]<<16),bh=__uint_as_float(b[i]&0xffff0000u); r[i]=cvtpk_s(al*bl,ah*bh); }
  return r; }
#ifndef ATTN_STORE16
#define ATTN_STORE16(p,v) (*(u32x4*)(p)=(v))
#endif
template<int THRL> __device__ __forceinline__ void attn_unit(int b,int h,int qb,const bf16*Q,const bf16*__restrict__ K,const bf16*__restrict__ V,bf16*O,char*shm,lds_cuptr nb,int tskip,bool dry,int wave_id){
  int tid_=(int)__builtin_amdgcn_mbcnt_hi(~0u,__builtin_amdgcn_mbcnt_lo(~0u,0u)); asm volatile("":"+v"(tid_)); tid_+=wave_id*64; const int tid=tid_,lane=tid&63,r32=lane&31,hi=lane>>5; const int wid=__builtin_amdgcn_readfirstlane(tid>>6);
  const long rowbase=(long)b*SEQ; const int q0=qb*QB;
  const bf16*Qw=Q+(rowbase+q0+wid*QBLK)*DM+h*D;
  const bf16*Kh=K+(rowbase+(long)tskip*KVBLK)*DM+h*D,*Vh=V+(rowbase+(long)tskip*KVBLK)*DM+h*D;
  const unsigned lds0=(unsigned)(uintptr_t)shm;
  float*wsf=(float*)(shm+LDS_WS)+wid*64;
  const bf16*ksrc=Kh+(long)lane*DM+wid*8;
  const bf16*vsrc=Vh+(long)(16*(wid&3)+(lane>>2))*DM+(wid>>2)*32+(lane&3)*8;
  const unsigned kdst=lds0+LDS_K+wid*1024, vdst=lds0+LDS_V+wid*1024;
  #define DMA_K(t,slot) glds16(ksrc+(long)(t)*KVBLK*DM,(unsigned)__builtin_amdgcn_readfirstlane(kdst+(slot)))
  #define DMA_V(t,slot) glds16(vsrc+(long)(t)*KVBLK*DM,(unsigned)__builtin_amdgcn_readfirstlane(vdst+(slot)))
  const int vb0=(int)(lds0+LDS_V)+((lane>>4)&1)*32+(lane&3)*8+(4*hi+((lane&15)>>2))*64;
  const char*Kbase=shm+LDS_K; bf16x8 kf[8];
  const lds_cptr shm3=(lds_cptr)shm; const lds_cptr kp0=shm3+LDS_K+hi*1024+r32*16; const lds_cptr vp0=shm3+LDS_V+((lane>>4)&1)*32+(lane&3)*8+(4*hi+((lane&15)>>2))*64;
  const int NT=(q0+QB)/KVBLK-tskip;
  DMA_K(0,0);DMA_V(0,0);DMA_K(1,SLOTB);
  bf16x8 qr[4];
  #pragma unroll
  for(int d0=0;d0<4;++d0)qr[d0]=*reinterpret_cast<const bf16x8*>(&Qw[(long)r32*DM+d0*16+hi*8]);
  float mhat=0.f,l_reg=0.f;f32x16 o[2];o[0]=f32x16{};o[1]=f32x16{};unsigned qm1=0u;const lds_cuptr nbl=nb+64*tskip+r32;
  #define SETM(NEWM) do{ const float nm_=-(NEWM); const unsigned h_=bfr(nm_); const float hf_=__uint_as_float(h_<<16); const unsigned l_=bfr(nm_-hf_); mhat=-(hf_+__uint_as_float(l_<<16)); qm1=hi?0u:(h_|(l_<<16)); }while(0)
  const int qrel=wid*QBLK+r32;
  #define CMASK(P0,P1,t) do{int jb_=(t)-(NT-4); if(jb_>=0)cmask(P0,P1,jb_,qrel,hi);}while(0)
  bool resc=false;
  #define START(P0,P1) do{ const float rm=rowmax(P0,P1); resc=false; \
    { const float old_=mhat; SETM(old_+rm); const float dl=mhat-old_; \
      _Pragma("unroll") for(int r=0;r<16;++r){P0[r]=fsub_s(P0[r],dl);P1[r]=fsub_s(P1[r],dl);} } \
    _Pragma("unroll") for(int r=0;r<16;++r)P0[r]=__builtin_amdgcn_exp2f(P0[r]); }while(0)
  #define RESC() do{ if(resc){ asm volatile("s_waitcnt lgkmcnt(0)":::"memory"); \
      _Pragma("unroll") for(int d_=0;d_<2;++d_) _Pragma("unroll") for(int r=0;r<16;++r)o[d_][r]*=wsf[crow(r,hi)]; } }while(0)
  f32x16 pA0,pA1,pB0,pB1;
  int sl_prev=0,sl_cur=0,sl_next=SLOTB;
  #define ROT() do{sl_prev=sl_cur;sl_cur=sl_next;sl_next=(sl_next==(NSLOT-1)*SLOTB)?0:sl_next+SLOTB;}while(0)
  DMA_K(2,2*SLOTB);
  WAIT_BAR(3);
  unsigned bw0=nbl[0],bw1=nbl[32]; biasmm(pA0,pA1,bw0,bw1,qm1,hi); bw0=nbl[64]; bw1=nbl[96]; qkt(pA0,pA1,Kbase,qr,r32,hi);    asm volatile("s_nop 15\n\ts_nop 7":"+v"(pA0),"+v"(pA1));CMASK(pA0,pA1,0);
  START(pA0,pA1);
  _Pragma("unroll") for(int r=0;r<16;++r)pA1[r]=__builtin_amdgcn_exp2f(pA1[r]);
  WAIT_BAR(0);
  DMA_K(3,0);DMA_V(1,SLOTB);
  ROT();
  kload8(kf,kp0+sl_cur);
  WAIT_BAR(2);
  s16x4 vlo[8],vhi[8]; u32x4 pw0,pw1,pw2,pw3;
  #define PKW(P,B) cvtpk_s(P[B],P[B+1])
  #define PAF(k) __builtin_bit_cast(bf16x8,pw##k)
  #define VFR(i) (bf16x8){vlo[i][0],vlo[i][1],vlo[i][2],vlo[i][3],vhi[i][0],vhi[i][1],vhi[i][2],vhi[i][3]}
  #define PIN(x) asm volatile("":"+v"(x))
  #define MX3(a,b,c) __builtin_fmaxf(__builtin_fmaxf((a),(b)),(c))
  #define GAPA(MF,A0,A1,A2,A3,W0,W1,PW) do{ MF; sacc+=A0; sacc+=A1; sacc+=A2; sacc+=A3; PIN(sacc); W0; W1; PIN(PW); SBAR(); }while(0)
  #define EX(v) __builtin_amdgcn_exp2f(v)
  #define GAPB(MF,X,B) do{ MF; X[B]=EX(X[B]); X[B+1]=EX(X[B+1]); X[B+2]=EX(X[B+2]); X[B+3]=EX(X[B+3]); PIN(X); SBAR(); }while(0)
  #define VRD(i) do{ vlo[i]=vtr(vp_+(((i)>>2)*4096+((i)&3)*1024)); vhi[i]=vtr(vp_+(((i)>>2)*4096+((i)&3)*1024+512)); }while(0)
  #define KRD(G,j) do{ if(G){ kload2(kf,kp0+sl_next,j); SBAR(); } }while(0)
  #define STEP(C0,C1,P0,P1,t,GK,GV,GL) do{ SBAR(); \
    biasmm(C0,C1,bw0,bw1,qm1,hi); bw0=nbl[64*((t)+1)]; bw1=nbl[64*((t)+1)+32]; SBAR(); \
    const lds_cptr vp_=vp0+sl_prev; \
    VRD(0); SBAR(); float sacc=(P0[0]+P0[1]); \
    GAPA(C0=__builtin_amdgcn_mfma_f32_32x32x16_bf16(kf[0],qr[0],C0,0,0,0), P0[2],P0[3],P0[4],P0[5],     pw0[0]=PKW(P0,0), pw0[1]=PKW(P0,2), pw0); \
    VRD(4); SBAR(); GAPA(C1=__builtin_amdgcn_mfma_f32_32x32x16_bf16(kf[1],qr[0],C1,0,0,0), P0[6],P0[7],P0[8],P0[9],     pw0[2]=PKW(P0,4), pw0[3]=PKW(P0,6), pw0); \
    VRD(1); SBAR(); GAPA(C0=__builtin_amdgcn_mfma_f32_32x32x16_bf16(kf[2],qr[1],C0,0,0,0),   P0[10],P0[11],P0[12],P0[13], pw1[0]=PKW(P0,8), pw1[1]=PKW(P0,10), pw1); \
    VRD(5); SBAR(); GAPA(C1=__builtin_amdgcn_mfma_f32_32x32x16_bf16(kf[3],qr[1],C1,0,0,0),   P0[14],P0[15],P1[0],P1[1],   pw1[2]=PKW(P0,12),pw1[3]=PKW(P0,14), pw1); \
    VRD(2); SBAR(); GAPA(C0=__builtin_amdgcn_mfma_f32_32x32x16_bf16(kf[4],qr[2],C0,0,0,0),   P1[2],P1[3],P1[4],P1[5],     pw2[0]=PKW(P1,0), pw2[1]=PKW(P1,2), pw2); \
    VRD(6); SBAR(); GAPA(C1=__builtin_amdgcn_mfma_f32_32x32x16_bf16(kf[5],qr[2],C1,0,0,0),   P1[6],P1[7],P1[8],P1[9],     pw2[2]=PKW(P1,4), pw2[3]=PKW(P1,6), pw2); \
    VRD(3); SBAR(); GAPA(C0=__builtin_amdgcn_mfma_f32_32x32x16_bf16(kf[6],qr[3],C0,0,0,0),   P1[10],P1[11],P1[12],P1[13], pw3[0]=PKW(P1,8), pw3[1]=PKW(P1,10), pw3); \
    VRD(7); SBAR(); GAPA(C1=__builtin_amdgcn_mfma_f32_32x32x16_bf16(kf[7],qr[3],C1,0,0,0),   P1[14],P1[15],0.f,0.f,       pw3[2]=PKW(P1,12),pw3[3]=PKW(P1,14), pw3); \
    l_reg+=sacc; \
    if(GK){DMA_K((t)+3,sl_cur);} if(GV){DMA_V((t)+1,sl_next);} \
    CMASK(C0,C1,t); \
    { float a=MX3(C0[0],C0[1],C1[0]),b=MX3(C0[2],C0[3],C1[1]); a=MX3(a,C1[2],C1[3]); \
      _Pragma("unroll") for(int r=4;r<16;r+=4){a=MX3(a,C0[r],C0[r+1]);b=MX3(b,C0[r+2],C0[r+3]);a=MX3(a,C1[r],C1[r+1]);b=MX3(b,C1[r+2],C1[r+3]);} \
      float rm=__builtin_fmaxf(a,b); { auto rr=__builtin_amdgcn_permlane32_swap(__float_as_uint(rm),__float_as_uint(rm),false,false); rm=__builtin_fmaxf(__uint_as_float(rr[0]),__uint_as_float(rr[1])); } \
      resc=false; \
      if(__builtin_expect(__any(rm>(float)THRL),0)){ const float old_=mhat; SETM(old_+__builtin_fmaxf(rm,0.f)); const float dl=mhat-old_; \
        _Pragma("unroll") for(int r=0;r<16;++r){C0[r]-=dl;C1[r]-=dl;} \
        const float f=__builtin_amdgcn_exp2f(-dl); l_reg*=f; if(hi==0)wsf[r32]=f; resc=true; } } \
    SBAR(); \
    GAPB(o[0]=__builtin_amdgcn_mfma_f32_32x32x16_bf16(PAF(0),VFR(0),o[0],0,0,0), C0,0); \
    GAPB(o[1]=__builtin_amdgcn_mfma_f32_32x32x16_bf16(PAF(0),VFR(4),o[1],0,0,0), C0,4); \
    KRD(GL,0); GAPB(o[0]=__builtin_amdgcn_mfma_f32_32x32x16_bf16(PAF(1),VFR(1),o[0],0,0,0), C0,8); \
    KRD(GL,1); GAPB(o[1]=__builtin_amdgcn_mfma_f32_32x32x16_bf16(PAF(1),VFR(5),o[1],0,0,0), C0,12); \
    KRD(GL,2); GAPB(o[0]=__builtin_amdgcn_mfma_f32_32x32x16_bf16(PAF(2),VFR(2),o[0],0,0,0), C1,0); \
    KRD(GL,3); GAPB(o[1]=__builtin_amdgcn_mfma_f32_32x32x16_bf16(PAF(2),VFR(6),o[1],0,0,0), C1,4); \
    GAPB(o[0]=__builtin_amdgcn_mfma_f32_32x32x16_bf16(PAF(3),VFR(3),o[0],0,0,0), C1,8); \
    GAPB(o[1]=__builtin_amdgcn_mfma_f32_32x32x16_bf16(PAF(3),VFR(7),o[1],0,0,0), C1,12); \
    }while(0)
  int t=1;
  #undef CMASK
  #define CMASK(P0,P1,t) do{}while(0)
  for(;t+5<NT;t+=2){
    STEP(pB0,pB1,pA0,pA1,t,true,true,true);     WAIT_BAR(2); RESC(); ROT();
    STEP(pA0,pA1,pB0,pB1,t+1,true,true,true);   WAIT_BAR(2); RESC(); ROT();
  }
  #undef CMASK
  #define CMASK(P0,P1,t) do{int jb_=(t)-(NT-4); if(jb_>=0)cmask(P0,P1,jb_,qrel,hi);}while(0)
  #define ENDW(tt) do{ if((tt)+3<NT){WAIT_BAR(2);} else if((tt)+2<NT){WAIT_BAR(1);} else {WAIT_BAR(0);} }while(0)
  for(;t+1<NT;t+=2){
    STEP(pB0,pB1,pA0,pA1,t,(t+3<NT),(t+1<NT),(t+1<NT));       ENDW(t);   RESC(); ROT();
    STEP(pA0,pA1,pB0,pB1,t+1,(t+4<NT),(t+2<NT),(t+2<NT));     ENDW(t+1); RESC(); ROT();
  }
  STEP(pB0,pB1,pA0,pA1,NT-1,false,false,false); RESC();
  { float sacc=pB0[0]+pB0[1]; _Pragma("unroll") for(int r=2;r<16;++r)sacc+=pB0[r]; _Pragma("unroll") for(int r=0;r<16;++r)sacc+=pB1[r]; l_reg+=sacc;
    pw0=(u32x4){PKW(pB0,0),PKW(pB0,2),PKW(pB0,4),PKW(pB0,6)};pw1=(u32x4){PKW(pB0,8),PKW(pB0,10),PKW(pB0,12),PKW(pB0,14)};pw2=(u32x4){PKW(pB1,0),PKW(pB1,2),PKW(pB1,4),PKW(pB1,6)};pw3=(u32x4){PKW(pB1,8),PKW(pB1,10),PKW(pB1,12),PKW(pB1,14)};
    SBAR(); pv(o,vb0+sl_cur,PAF(0),PAF(1),PAF(2),PAF(3)); }
  #undef PKW
  #undef PAF
  #undef VFR
  #undef PIN
  #undef MX3
  #undef GAPA
  #undef GAPB
  #undef EX
  #undef VRD
  #undef KRD
  #undef STEP
  #undef ENDW
  {auto rr=__builtin_amdgcn_permlane32_swap(__float_as_uint(l_reg),__float_as_uint(l_reg),false,false);l_reg=__uint_as_float(rr[0])+__uint_as_float(rr[1]);}
  if(hi==0)wsf[32+r32]=l_reg;asm volatile("s_waitcnt lgkmcnt(0)":::"memory");
  float rli[16];
  #pragma unroll
  for(int r=0;r<16;++r)rli[r]=__builtin_amdgcn_rcpf(wsf[32+crow(r,hi)]);
  bf16*Ow=O+(rowbase+q0+wid*QBLK)*(long)OPITCH+OCOL0+h*D;
  { bf16*stg=(bf16*)(shm+LDS_OST)+wid*2048;
    #pragma unroll
    for(int r=0;r<16;++r){const int orow=crow(r,hi);
      #pragma unroll
      for(int d0=0;d0<2;++d0)stg[orow*64+d0*32+r32]=__float2bfloat16(o[d0][r]*rli[r]);}
    asm volatile("s_waitcnt lgkmcnt(0)":::"memory");
    #pragma unroll
    for(int i=0;i<4;++i){const int row=i*8+(lane>>3),ch=lane&7; const u32x4 v=*(const u32x4*)(stg+row*64+ch*8); bf16*gp=Ow+(long)row*OPITCH+ch*8; const u32x4 gt=*(const u32x4*)gp; if(!dry){ATTN_STORE16(gp,mul_bf16x8(v,gt));}} }
  asm volatile("s_waitcnt lgkmcnt(0)\n\ts_barrier":::"memory");
  #undef DMA_K
  #undef DMA_V
  #undef CMASK
  #undef START
  #undef RESC
  #undef ROT
  #undef SETM
}
constexpr int ATTN_LDS_BYTES=LDS_BYTES;
#undef SBAR
#undef WAIT_BAR
}
constexpr int BATCH = 4, SEQ = 8192, DMODEL = 1024, M = BATCH * SEQ, DEPTH = 2, INC = 7852;
constexpr int NT_A = 19, NT_B = 12, NTILES = NT_A + NT_B;
constexpr int SA_Q = 0, SA_K = 512, SA_V = 640, SA_G = 768, SB_Q = 1280, SB_K = 1792, SB_V = 1920, SB_IQ = 2048, SB_IK = 2176, SB_IW = 2208, SB_G = 2212,
              SC_Q = 2724, SC_K = 3236, SC_V = 3748, SC_F = 4260, SC_G = 4268, S_MG = 4780;
static_assert(S_MG + 3072 == INC, "column partition");
__host__ __device__ __forceinline__ int src_col(int t, int lc) {
    switch (t) {
        case 0: case 1: return SA_Q + t * 256 + lc;
        case 2: case 3: return SB_Q + (t - 2) * 256 + lc;
        case 4: case 5: return SC_Q + (t - 4) * 256 + lc;
        case 6: return lc < 128 ? SA_K + lc : SB_K + lc - 128;
        case 7: case 8: return SC_K + (t - 7) * 256 + lc;
        case 9: return lc < 128 ? SA_V + lc : SB_V + lc - 128;
        case 10: case 11: return SC_V + (t - 10) * 256 + lc;
        case 12: case 13: return SA_G + (t - 12) * 256 + lc;
        case 14: case 15: return SB_G + (t - 14) * 256 + lc;
        case 16: case 17: return SC_G + (t - 16) * 256 + lc;
        case 18: return lc < 128 ? SB_IQ + lc : lc < 160 ? SB_IK + lc - 128 : lc < 164 ? SB_IW + lc - 160 : lc < 172 ? SC_F + lc - 164 : -1;
        default: return S_MG + (t - 19) * 256 + lc;
    }
}
constexpr size_t MiB = 1u << 20;
constexpr size_t WS_CTL = 0, CTL_ZERO_BYTES = 1 * MiB;
constexpr size_t WS_W1T = 2 * MiB;
constexpr size_t WS_WBT = 33 * MiB;
constexpr size_t WS_WOT = 39 * MiB;
constexpr size_t WS_SSQ = 43 * MiB;
constexpr size_t WS_CL = 45 * MiB;
constexpr size_t WS_CT = 46 * MiB;
constexpr size_t WS_IW = 47 * MiB;
constexpr size_t WS_CF = 47 * MiB + 512 * 1024;
constexpr size_t WS_IQ = 49 * MiB;
constexpr size_t WS_IK = 57 * MiB;
constexpr size_t WS_XB = 60 * MiB;
constexpr size_t WS_MERGED = 124 * MiB;
constexpr size_t WS_G = 188 * MiB;
constexpr size_t WS_QA = 284 * MiB, WS_QB = 316 * MiB, WS_QC = 348 * MiB, WS_KC = 380 * MiB, WS_VC = 412 * MiB, WS_KAB = 444 * MiB, WS_VAB = 460 * MiB;
constexpr size_t WS_MG = 284 * MiB;
constexpr size_t WS_END = 476 * MiB;
static_assert(pg8::EWS_CL == WS_CL && pg8::EWS_CT == WS_CT && pg8::EWS_SSQ == WS_SSQ && pg8::EWS_IW == WS_IW && pg8::EWS_CF == WS_CF && pg8::EWS_IQ == WS_IQ && pg8::EWS_IK == WS_IK && pg8::EWS_G == WS_G && pg8::EWS_QA == WS_QA && pg8::EWS_QB == WS_QB &&
              pg8::EWS_QC == WS_QC && pg8::EWS_KC == WS_KC && pg8::EWS_VC == WS_VC && pg8::EWS_KAB == WS_KAB && pg8::EWS_VAB == WS_VAB, "epilogue offsets");
constexpr int CW_OVF = 8;
constexpr int CW_TICK = 8192;
constexpr int CW_BAR = 4096;
constexpr int RING_OFF = 0, RING_BYTES = 131072;
constexpr int SEL_OFF = 131072;
constexpr int H2_OFF = SEL_OFF + 8192;
constexpr int BIAS_OFF = H2_OFF + 8192;
constexpr int BKT_OFF = BIAS_OFF + 2048;
constexpr int MISC_OFF = BKT_OFF + 512;
constexpr int LDS_BYTES = 155648;
static_assert(MISC_OFF + 1024 <= LDS_BYTES, "LDS map");
constexpr int NB_OFF = 86016;
static_assert(attn_body::ATTN_LDS_BYTES <= NB_OFF && NB_OFF + 32768 <= RING_BYTES, "LDS map");
constexpr int MW_NSEL = 0, MW_NCAND = 16, MW_BIN = 32, MW_ABOVE = 48, MW_CARRY = 64, MW_BAR = 96, MW_SLOW = 100, MW_TICKET = 101, MW_ZCUT = 112, MW_UC = 128, MW_ELO = 160;

#define GAS __attribute__((address_space(1)))
#define LAS __attribute__((address_space(3)))
typedef unsigned short bf16;
typedef unsigned v4u __attribute__((ext_vector_type(4)));
typedef float f32x4 __attribute__((ext_vector_type(4)));
typedef short bf16x8 __attribute__((ext_vector_type(8)));
typedef GAS unsigned gu32;
#define RLX_AGENT __ATOMIC_RELAXED, __HIP_MEMORY_SCOPE_AGENT
#define LDS_WAIT() asm volatile("s_waitcnt lgkmcnt(0)" ::: "memory")
#define VM_WAIT() asm volatile("s_waitcnt vmcnt(0)" ::: "memory")
__device__ __forceinline__ unsigned f2bf(float f) { unsigned u = __builtin_bit_cast(unsigned, f); return (u + 0x7fffu + ((u >> 16) & 1u)) >> 16; }
__device__ __forceinline__ unsigned pk2(float lo, float hi) { return f2bf(lo) | (f2bf(hi) << 16); }

#define XB_TMO      128
#define XB_XCNT(j)  (256  + 64 * (j))
#define XB_XSUB(j)  (1280 + 64 * (j))
#define XB_XGEN(j)  (2304 + 64 * (j))
#define XB_TOP      3328
#define XB_TOPGEN   3392
#define XCD_BAR_WORDS 3456
#define XB_SPIN_CAP (1u << 18)

__device__ __forceinline__ unsigned xb_ld(unsigned* p)              { return __hip_atomic_load(p, __ATOMIC_RELAXED, __HIP_MEMORY_SCOPE_AGENT); }
__device__ __forceinline__ unsigned xb_add(unsigned* p, unsigned v) { return __hip_atomic_fetch_add(p, v, __ATOMIC_RELAXED, __HIP_MEMORY_SCOPE_AGENT); }
__device__ __forceinline__ unsigned xb_xcc_id() { return (unsigned)__builtin_amdgcn_s_getreg((3 << 11) | 20) & 0xFu; }
#define XB_SPIN(cond, bar) do { unsigned _sp = 0; while (cond) { __builtin_amdgcn_s_sleep(1); \
    if ((++_sp & 255u) == 0u) { if (xb_ld(&(bar)[XB_TMO])) break; if (_sp > XB_SPIN_CAP) { atomicAdd(&(bar)[XB_TMO], 1u); break; } } } } while (0)

struct XcdBarrier {
    unsigned* bar; unsigned x;
    volatile LAS unsigned* st;
};

__device__ __forceinline__ XcdBarrier xcd_barrier_post(unsigned* bar, volatile LAS unsigned* st) {
    XcdBarrier b; b.bar = bar; b.x = xb_xcc_id(); b.st = st;
    if (threadIdx.x == 0) (void)xb_add(&bar[XB_XCNT(b.x)], 1u);
    return b;
}
__device__ __forceinline__ void xcd_barrier_complete(unsigned* bar, unsigned x, unsigned& nloc, unsigned& nx) {
    const unsigned G = gridDim.x * gridDim.y * gridDim.z;
    unsigned sum, cnt, mine, sp = 0u;
    for (;;) {
        sum = 0u; cnt = 0u; mine = 0u;
#pragma unroll
        for (unsigned j = 0; j < 16; ++j) { const unsigned c = xb_ld(&bar[XB_XCNT(j)]); sum += c; cnt += (c > 0u) ? 1u : 0u; mine = (j == x) ? c : mine; }
        if (sum == G) break;
        __builtin_amdgcn_s_sleep(1);
        if ((++sp & 255u) == 0u) { if (xb_ld(&bar[XB_TMO])) break; if (sp > XB_SPIN_CAP) { atomicAdd(&bar[XB_TMO], 1u); break; } }
    }
    nloc = mine > 0u ? mine : 1u; nx = cnt > 0u ? cnt : 1u;
}

__device__ __forceinline__ void xcd_barrier(const XcdBarrier& b) {
    asm volatile("s_waitcnt vmcnt(0)" ::: "memory");
    __syncthreads();
    if (threadIdx.x == 0) {
        unsigned* bar = b.bar;
        __builtin_amdgcn_s_waitcnt(0);
        unsigned nloc = b.st[0], nx = b.st[1];
        if (nloc == 0u) { xcd_barrier_complete(bar, b.x, nloc, nx); b.st[0] = nloc; b.st[1] = nx; }
        const unsigned old = xb_add(&bar[XB_XSUB(b.x)], 1u);
        const unsigned gen = old / nloc;
        if (old + 1u == (gen + 1u) * nloc) {
            __builtin_amdgcn_fence(__ATOMIC_RELEASE, "agent");
            asm volatile("s_waitcnt vmcnt(0)" ::: "memory");
            const unsigned og = xb_add(&bar[XB_TOP], 1u);
            const unsigned tg = og / nx;
            if (og + 1u == (tg + 1u) * nx) xb_add(&bar[XB_TOPGEN], 1u);
            else XB_SPIN(xb_ld(&bar[XB_TOPGEN]) == tg, bar);
            __builtin_amdgcn_fence(__ATOMIC_ACQUIRE, "agent");
            xb_add(&bar[XB_XGEN(b.x)], 1u);
            asm volatile("s_waitcnt vmcnt(0)" ::: "memory");
        } else {
            XB_SPIN(xb_ld(&bar[XB_XGEN(b.x)]) == gen, bar);
            __builtin_amdgcn_fence(__ATOMIC_ACQUIRE, "agent");
            asm volatile("s_waitcnt vmcnt(0)" ::: "memory");
        }
    }
    __syncthreads();
}

struct Frame {
    LAS unsigned char* lds;
    volatile LAS unsigned* MISC;
    gu32* ctl;
    int tid, lane, wave, vcu, G;
};
__device__ __forceinline__ float wave_sum(float v) {
#pragma unroll
    for (int o = 1; o < 64; o <<= 1) v += __shfl_xor(v, o);
    return v;
}
__device__ __forceinline__ float wave_incl_scan(float v, int lane) {
#pragma unroll
    for (int o = 1; o < 64; o <<= 1) { const float t = __shfl_up(v, o); if (lane >= o) v += t; }
    return v;
}
__device__ __forceinline__ int wave_incl_scan_i(int v, int lane) {
#pragma unroll
    for (int o = 1; o < 64; o <<= 1) { const int t = __shfl_up(v, o); if (lane >= o) v += t; }
    return v;
}
__device__ __forceinline__ void transpose_item(const float* W, int N, bf16* WT, int K, int n0, int k0, int scol, const float* kscale, LAS float* scr, int lane) {
#pragma unroll 8
    for (int i = 0; i < 32; ++i) { const int kk = 2 * i + (lane >> 5); float v = 0.f;
        if (scol >= 0) { v = W[(size_t)(k0 + kk) * N + scol]; if (kscale) v *= kscale[k0 + kk]; }
        scr[kk * 33 + (lane & 31)] = v; }
    LDS_WAIT(); asm volatile("" ::: "memory");
    const int c = lane & 7;
#pragma unroll
    for (int j = 0; j < 4; ++j) { const int n = (lane >> 3) + 8 * j; const LAS float* s = scr + (8 * c) * 33 + n;
        v4u o; o.x = pk2(s[0 * 33], s[1 * 33]); o.y = pk2(s[2 * 33], s[3 * 33]); o.z = pk2(s[4 * 33], s[5 * 33]); o.w = pk2(s[6 * 33], s[7 * 33]);
        *(GAS v4u*)(WT + (size_t)(n0 + n) * K + k0 + 8 * c) = o; }
    LDS_WAIT(); asm volatile("" ::: "memory");
}
__device__ __forceinline__ void p0_prologue(Frame& F, const float* x, const float* norm_gain, const float* w_in, const float* w_branch, const float* w_out, unsigned char* ws) {
    LAS float* scr = (LAS float*)(F.lds + RING_OFF + F.wave * 16384);
    const int gw = F.vcu * 8 + F.wave, NGW = F.G * 8, lane = F.lane;
    constexpr int I_W1 = 16 * (NTILES * 256 / 32), I_WB = 8 * 32, I_WO = 16 * 32;
    constexpr int NITEMS = DEPTH * I_W1 + DEPTH * 3 * I_WB + DEPTH * I_WO;
    for (int it = gw; it < NITEMS; it += NGW) {
        int r = it;
        if (r < DEPTH * I_W1) { const int L = r / I_W1; r -= L * I_W1; const int nblk = NTILES * 8, kb = r / nblk, nb = r % nblk, n0 = nb * 32, tile = n0 >> 8, p = (n0 & 255) + (lane & 31);
            const int lc = 64 * ((p >> 5) & 3) + 32 * (p >> 7) + (p & 31);
            transpose_item(w_in + (size_t)L * DMODEL * INC, INC, (bf16*)(ws + WS_W1T) + (size_t)L * NTILES * 256 * 1024, 1024, n0, kb * 64, src_col(tile, lc), norm_gain + L * DMODEL, scr, lane); continue; }
        r -= DEPTH * I_W1;
        if (r < DEPTH * 3 * I_WB) { const int mat = r / I_WB; r -= mat * I_WB; const int kb = r / 32, nb = r % 32;
            transpose_item(w_branch + (size_t)mat * 512 * 1024, 1024, (bf16*)(ws + WS_WBT) + (size_t)mat * 1024 * 512, 512, nb * 32, kb * 64, nb * 32 + (lane & 31), nullptr, scr, lane); continue; }
        r -= DEPTH * 3 * I_WB;
        { const int L = r / I_WO; r -= L * I_WO; const int kb = r / 32, nb = r % 32;
            transpose_item(w_out + (size_t)L * 1024 * 1024, 1024, (bf16*)(ws + WS_WOT) + (size_t)L * 1024 * 1024, 1024, nb * 32, kb * 64, nb * 32 + (lane & 31), nullptr, scr, lane); }
    }
    bf16* XB = (bf16*)(ws + WS_XB); float* SSQ = (float*)(ws + WS_SSQ);
    for (int m = gw; m < M; m += NGW) {
        const GAS f32x4* xr = (const GAS f32x4*)(x + (size_t)m * DMODEL) + lane; f32x4 v[4]; float s = 0.f;
#pragma unroll
        for (int j = 0; j < 4; ++j) { v[j] = xr[64 * j]; s += (v[j].x * v[j].x + v[j].y * v[j].y) + (v[j].z * v[j].z + v[j].w * v[j].w); }
        const float tot = wave_sum(s);
        GAS unsigned long long* o8 = (GAS unsigned long long*)(XB + (size_t)m * DMODEL) + lane;
#pragma unroll
        for (int j = 0; j < 4; ++j) o8[64 * j] = (unsigned long long)pk2(v[j].x, v[j].y) | ((unsigned long long)pk2(v[j].z, v[j].w) << 32);
        if (lane < 16) SSQ[(size_t)m * 16 + lane] = lane == 0 ? tot : 0.f;
    }
}
__device__ __forceinline__ void scan_phase(Frame& F, const float* CF, const float* bforget  , float* CL, float* CT) {
    const int lane = F.lane, h = F.wave;
    for (int u = blockIdx.x; u < 128; u += F.G) { const int b = u >> 5, j = u & 31; const size_t row = (size_t)b * SEQ + 256 * j + 4 * lane; const float bf = bforget[h];
        float s[4]; float run = 0.f;
#pragma unroll
        for (int e = 0; e < 4; ++e) { const float xx = CF[(row + e) * 8 + h] + bf; const float lf = (xx < 0.f ? xx : 0.f) - __logf(1.0f + __expf(-fabsf(xx))); run += lf; s[e] = run; }
        const float incl = wave_incl_scan(run, lane), excl = incl - run;
        *(f32x4*)(CL + (size_t)(b * 8 + h) * SEQ + 256 * j + 4 * lane) = (f32x4){excl + s[0], excl + s[1], excl + s[2], excl + s[3]};
        if (lane == 63) CT[(b * 8 + h) * 32 + j] = incl;
    }
}
#ifndef REP_IDX
#define REP_IDX 1
#endif
#ifndef REP_SPB
#define REP_SPB 1
#endif
#ifndef REP_SPA
#define REP_SPA 1
#endif
typedef unsigned u32x2 __attribute__((ext_vector_type(2)));
constexpr int NBIN = 1024;
__device__ __forceinline__ float pdist(float s, float sc, float inv) { return (s - sc) * inv + 0.0f; }
__device__ __forceinline__ unsigned pbin_d(float d) { const unsigned a = __float_as_uint(d) & 0x7fffffffu;
    int fx = (int)(a >> 19) - 1647; fx = fx < 0 ? 0 : (fx > 511 ? 511 : fx);
    return (__float_as_uint(d) >> 31) ? 511u - (unsigned)fx : 512u + (unsigned)fx; }
__device__ __forceinline__ unsigned pbin(float s, float sc, float inv) { return pbin_d(pdist(s, sc, inv)); }
__device__ __forceinline__ float pedge(int b) {
    if (b >= NBIN) return INFINITY; if (b <= 0) return -INFINITY;
    if (b > 512) return __uint_as_float((unsigned)(b - 512 + 1647) << 19);
    if (b == 512) return 0.0f;
    return -__uint_as_float(((unsigned)(511 - b + 1648) << 19) - 1u);
}
constexpr int CMAX = 1024;
#define LDS_ADD(p, v) __hip_atomic_fetch_add((p), (v), __ATOMIC_RELAXED, __HIP_MEMORY_SCOPE_WORKGROUP)
__device__ __forceinline__ unsigned okey(float s) { const unsigned u = __float_as_uint(s); return (u & 0x80000000u) ? ~u : (u | 0x80000000u); }
struct BAParams { const bf16 *IQ, *IK; const float* IW; const bf16 *QA, *QB, *KAB, *VAB; bf16* G; const float* sinks; };
__device__ __forceinline__ float relu_f(float x) { const int i = __float_as_int(x); return __int_as_float(i > 0 ? i : 0); }

template <int PASS, bool DIAG> __device__ __forceinline__ void idx_tile(const bf16x8 ak, const bf16x8 (&bq)[4], const f32x4 w4, int kt, int g4, int r, int tq, float elo, float ehi,
                                                                       LAS unsigned* hl, unsigned lp, unsigned hinc, LAS u32x2* cand, LAS unsigned short* sel, LAS unsigned* misc, LAS unsigned* zh, int zcut, float sc, float inv) {
    const f32x4 z = {0.f, 0.f, 0.f, 0.f};
    const f32x4 d0 = __builtin_amdgcn_mfma_f32_16x16x32_bf16(ak, bq[0], z, 0, 0, 0), d1 = __builtin_amdgcn_mfma_f32_16x16x32_bf16(ak, bq[1], z, 0, 0, 0),
                d2 = __builtin_amdgcn_mfma_f32_16x16x32_bf16(ak, bq[2], z, 0, 0, 0), d3 = __builtin_amdgcn_mfma_f32_16x16x32_bf16(ak, bq[3], z, 0, 0, 0);
    float sv[4]; bool qs[4], qc[4]; unsigned n1 = 0, n2 = 0;
#pragma unroll
    for (int i = 0; i < 4; ++i) {
        float s = 0.f; s = fmaf(w4[0], relu_f(d0[i]), s); s = fmaf(w4[1], relu_f(d1[i]), s); s = fmaf(w4[2], relu_f(d2[i]), s); s = fmaf(w4[3], relu_f(d3[i]), s);
        const int key = 16 * kt + 4 * g4 + i; sv[i] = s; const bool ok = !DIAG || key <= tq; const float d = pdist(s, sc, inv);
        if (PASS == 1) { if (ok) { const unsigned bin = pbin_d(d); LDS_ADD(hl + (bin * 32u + (lp ^ (bin & 31u))), hinc); if (s == 0.0f) LDS_ADD(zh + (key >> 7), 1u); } }
        else { qs[i] = ok && d >= ehi; qc[i] = ok && !(d >= ehi) && d >= elo && (s != 0.0f || key < zcut)  ;
               n1 += qs[i] ? 1u : 0u; n2 += qc[i] ? 1u : 0u; }
    }
    if (PASS == 2) {
        const unsigned add = n1 | (n2 << 16);
        if (add) { const unsigned pos = LDS_ADD(misc + MW_NSEL + r, add); unsigned p1 = pos & 0xffffu, p2 = pos >> 16;
#pragma unroll
            for (int i = 0; i < 4; ++i) { const int key = 16 * kt + 4 * g4 + i;
                if (qs[i]) { if (p1 < 256u) sel[p1] = (unsigned short)key; ++p1; }
                if (qc[i]) { if (p2 < (unsigned)CMAX) cand[p2] = (u32x2){okey(sv[i]), (unsigned)key}; ++p2; } } }
    }
}
template <int PASS> __device__ __forceinline__ void idx_pass(Frame& F, const bf16* IKb, const bf16x8 (&bq)[4], const f32x4 w4, int tau, int t0) {
    int lane_ = F.lane; asm volatile("" : "+v"(lane_)); const int lane = lane_, r = lane & 15, g4 = lane >> 4, tq = t0 + r;
    LAS unsigned* hl = (LAS unsigned*)(F.lds + RING_OFF); const unsigned lp = (unsigned)lane >> 1, hinc = 1u << ((lane & 1) * 16);
    LAS u32x2* cand = (LAS u32x2*)(F.lds + RING_OFF) + r * CMAX;
    LAS unsigned short* sel = (LAS unsigned short*)(F.lds + SEL_OFF) + r * 256;
    LAS unsigned* misc = (LAS unsigned*)(F.lds + MISC_OFF);
    float elo = 0.f, ehi = 0.f; int zcut = SEQ; if (PASS == 2) { elo = __uint_as_float(misc[MW_ELO + r]); ehi = __uint_as_float(misc[MW_ELO + 16 + r]); zcut = (int)misc[MW_ZCUT + r]; }
    LAS unsigned* zh = (LAS unsigned*)(F.lds + H2_OFF) + r * 64;
    const bf16* kp = IKb + (size_t)r * 32 + 8 * g4;
    float sc, inv; { const bf16x8 at = *(const bf16x8*)kp; const f32x4 z = {0.f, 0.f, 0.f, 0.f};
        const f32x4 d0 = __builtin_amdgcn_mfma_f32_16x16x32_bf16(at, bq[0], z, 0, 0, 0), d1 = __builtin_amdgcn_mfma_f32_16x16x32_bf16(at, bq[1], z, 0, 0, 0),
                    d2 = __builtin_amdgcn_mfma_f32_16x16x32_bf16(at, bq[2], z, 0, 0, 0), d3 = __builtin_amdgcn_mfma_f32_16x16x32_bf16(at, bq[3], z, 0, 0, 0);
        float mx = -INFINITY, ma = 0.f;
#pragma unroll
        for (int i = 0; i < 4; ++i) { float s = 0.f; s = fmaf(w4[0], relu_f(d0[i]), s); s = fmaf(w4[1], relu_f(d1[i]), s); s = fmaf(w4[2], relu_f(d2[i]), s); s = fmaf(w4[3], relu_f(d3[i]), s); mx = fmaxf(mx, s); ma = fmaxf(ma, fabsf(s)); }
        mx = fmaxf(mx, __shfl_xor(mx, 16)); mx = fmaxf(mx, __shfl_xor(mx, 32)); ma = fmaxf(ma, __shfl_xor(ma, 16)); ma = fmaxf(ma, __shfl_xor(ma, 32));
        sc = mx; inv = (ma > 1e-30f && ma < 1e30f) ? 1.0f / ma : 1.0f;
        if (PASS == 1 && F.wave == 0 && g4 == 0) { misc[MW_UC + r] = __float_as_uint(sc); misc[MW_UC + 16 + r] = __float_as_uint(inv); } }
    int kt = F.wave; if (kt > tau) return;
    bf16x8 a0 = *(const bf16x8*)(kp + (size_t)kt * 512);
    bf16x8 a1 = *(const bf16x8*)(kp + (size_t)(kt + 8 <= tau ? kt + 8 : kt) * 512);
    for (; kt <= tau; kt += 8) {
        const int k2 = kt + 16 <= tau ? kt + 16 : kt; const bf16x8 a2 = *(const bf16x8*)(kp + (size_t)k2 * 512);
        if (kt < tau) idx_tile<PASS, false>(a0, bq, w4, kt, g4, r, tq, elo, ehi, hl, lp, hinc, cand, sel, misc, zh, zcut, sc, inv);
        else          idx_tile<PASS, true>(a0, bq, w4, kt, g4, r, tq, elo, ehi, hl, lp, hinc, cand, sel, misc, zh, zcut, sc, inv);
        a0 = a1; a1 = a2;
    }
}
__device__ __forceinline__ void idx_threshold(Frame& F) {
    int lane_ = F.lane; asm volatile("" : "+v"(lane_)); const int lane = lane_; LAS unsigned* misc = (LAS unsigned*)(F.lds + MISC_OFF);
    for (int qq = 0; qq < 2; ++qq) { const int q = 2 * F.wave + qq; const unsigned sh = (q & 1) * 16, qh = (unsigned)q >> 1;
        const LAS unsigned* hb = (const LAS unsigned*)(F.lds + RING_OFF);
        int cnt[16];
#pragma unroll
        for (int k = 0; k < 16; ++k) { const unsigned bin = 64u * k + lane, sw = bin & 31u; const LAS unsigned* p = hb + bin * 32u;
            cnt[k] = (int)(((p[qh ^ sw] >> sh) & 0xffffu) + ((p[(qh + 8u) ^ sw] >> sh) & 0xffffu) + ((p[(qh + 16u) ^ sw] >> sh) & 0xffffu) + ((p[(qh + 24u) ^ sw] >> sh) & 0xffffu)); }
        int a8[8], a4[4], a2[2], a1;
        { const bool h5 = lane & 32, h4 = lane & 16, h3 = lane & 8, h2 = lane & 4;
#pragma unroll
          for (int i = 0; i < 8; ++i) { const int mine = h5 ? cnt[8 + i] : cnt[i], theirs = h5 ? cnt[i] : cnt[8 + i]; a8[i] = mine + __shfl_xor(theirs, 32); }
#pragma unroll
          for (int i = 0; i < 4; ++i) { const int mine = h4 ? a8[4 + i] : a8[i], theirs = h4 ? a8[i] : a8[4 + i]; a4[i] = mine + __shfl_xor(theirs, 16); }
#pragma unroll
          for (int i = 0; i < 2; ++i) { const int mine = h3 ? a4[2 + i] : a4[i], theirs = h3 ? a4[i] : a4[2 + i]; a2[i] = mine + __shfl_xor(theirs, 8); }
          { const int mine = h2 ? a2[1] : a2[0], theirs = h2 ? a2[0] : a2[1]; a1 = mine + __shfl_xor(theirs, 4); }
          a1 += __shfl_xor(a1, 1); a1 += __shfl_xor(a1, 2); }
        int ks = 0, aseg = 0, v = cnt[0]; { int cum = 0; bool found = false;
#pragma unroll
            for (int k = 15; k >= 0; --k) { const int Tk = __builtin_amdgcn_readlane(a1, 4 * k); if (!found && cum + Tk >= 256) { found = true; ks = k; aseg = cum; v = cnt[k]; } cum += Tk; } }
        const int pre = wave_incl_scan_i(v, lane);
        int tot = pre; tot = __shfl(tot, 63);
        const int suf = tot - pre + v;
        const unsigned long long mask = __ballot(aseg + suf >= 256);
        const int Ls = mask ? 63 - (int)__builtin_clzll(mask) : 0;
        if (lane == Ls) { const int bs = 64 * ks + lane; misc[MW_BIN + q] = (unsigned)bs; misc[MW_ABOVE + q] = (unsigned)(aseg + suf - v);
                          misc[MW_ELO + q] = __float_as_uint(pedge(bs)); misc[MW_ELO + 16 + q] = __float_as_uint(pedge(bs + 1)); }
        { const int binstar = __shfl(64 * ks + lane, Ls), needz = 256 - __shfl(aseg + suf - v, Ls);
          const int zc = (int)((const LAS unsigned*)(F.lds + H2_OFF))[q * 64 + lane]; const int zi = wave_incl_scan_i(zc, lane);
          const unsigned long long zm = __ballot(zi >= needz);
          if (lane == 0) misc[MW_ZCUT + q] = (binstar == (int)pbin(0.0f, __uint_as_float(misc[MW_UC + q]), __uint_as_float(misc[MW_UC + 16 + q])) && zm) ? (unsigned)(128 * ((int)__builtin_ctzll(zm) + 1)) : (unsigned)SEQ; }
    }
}
__device__ __forceinline__ unsigned idx_digit(const u32x2 e, int lvl) { const unsigned v = 8191u - e.y;
    return lvl == 0 ? e.x >> 24 : lvl == 1 ? (e.x >> 16) & 255u : lvl == 2 ? (e.x >> 8) & 255u : lvl == 3 ? e.x & 255u : lvl == 4 ? (v >> 5) & 255u : v & 31u; }
__device__ __forceinline__ void idx_resolve(Frame& F) {
    int lane_ = F.lane; asm volatile("" : "+v"(lane_)); const int lane = lane_; LAS unsigned* misc = (LAS unsigned*)(F.lds + MISC_OFF);
    LAS unsigned* h2 = (LAS unsigned*)(F.lds + H2_OFF) + F.wave * 256;
    for (int qq = 0; qq < 2; ++qq) { const int q = 2 * F.wave + qq;
        const unsigned packed = misc[MW_NSEL + q];
        if (lane == 0) misc[MW_NSEL + q] = packed & 0xffffu;
        int c = (int)(packed >> 16); if (c > CMAX) { c = CMAX; if (lane == 0) __hip_atomic_fetch_add(F.ctl + CW_OVF, 1u, RLX_AGENT); }
        int need = 256 - (int)misc[MW_ABOVE + q];
        LAS u32x2* cq = (LAS u32x2*)(F.lds + RING_OFF) + q * CMAX;
        LAS unsigned short* sel = (LAS unsigned short*)(F.lds + SEL_OFF) + q * 256;
        if (c > need && c <= 64) {
            u32x2 e = {0u, 0u}; if (lane < c) e = cq[lane]; int rank = 0;
            for (int j = 0; j < c; ++j) { const unsigned uj = (unsigned)__builtin_amdgcn_readlane((int)e.x, j), ij = (unsigned)__builtin_amdgcn_readlane((int)e.y, j); rank += (uj > e.x || (uj == e.x && ij < e.y)) ? 1 : 0; }
            if (lane < c && rank < need) { const unsigned pos = LDS_ADD(misc + MW_NSEL + q, 1u); if (pos < 256u) sel[pos] = (unsigned short)e.y; }
            c = 0; need = 0;
        }
#pragma unroll 1
        for (int lvl = 0; lvl < 6 && c > need; ++lvl) {
            *(LAS v4u*)(h2 + 4 * lane) = (v4u){0u, 0u, 0u, 0u};
            for (int i = lane; i < c; i += 64) LDS_ADD(h2 + idx_digit(cq[i], lvl), 1u);
            const v4u hw = *(const LAS v4u*)(h2 + 252 - 4 * lane);
            const int total = (int)(hw.x + hw.y + hw.z + hw.w), incl = wave_incl_scan_i(total, lane);
            const unsigned long long mask = __ballot(incl >= need);
            const int Ls = mask ? (int)__builtin_ctzll(mask) : 63;
            int dstar_l = 0, above_l = 0; { int cum = incl - total; bool found = false;
#pragma unroll
                for (int e = 3; e >= 0; --e) { const int cc = (int)hw[e]; if (!found && cum + cc >= need) { found = true; dstar_l = 252 - 4 * lane + e; above_l = cum; } cum += cc; } }
            const unsigned dstar = (unsigned)__shfl(dstar_l, Ls); const int above = __shfl(above_l, Ls);
            int c2 = 0;
            for (int base = 0; base < c; base += 64) { const int i = base + lane; const bool valid = i < c; u32x2 e = {0u, 0u}; if (valid) e = cq[i];
                const unsigned dg = idx_digit(e, lvl); const bool tie = valid && dg == dstar;
                if (valid && dg > dstar) { const unsigned pos = LDS_ADD(misc + MW_NSEL + q, 1u); if (pos < 256u) sel[pos] = (unsigned short)e.y; }
                const unsigned long long tm = __ballot(tie);
                if (tie) cq[c2 + __popcll(tm & ((1ull << lane) - 1ull))] = e;
                c2 += __popcll(tm); }
            c = c2; need -= above;
        }
        for (int i = lane; i < c && i < need; i += 64) { const unsigned pos = LDS_ADD(misc + MW_NSEL + q, 1u); if (pos < 256u) sel[pos] = (unsigned short)cq[i].y; }
    }
}
typedef short s16x4 __attribute__((ext_vector_type(4)));
__device__ __forceinline__ void sp_glds16(const void* gsrc, unsigned lds_dst) { unsigned keep;
    asm volatile("s_mov_b32 %0, m0\n\ts_mov_b32 m0, %2\n\ts_nop 0\n\tglobal_load_lds_dwordx4 %1, off\n\ts_mov_b32 m0, %0" : "=&s"(keep) : "v"(gsrc), "s"(lds_dst) : "memory"); }
__device__ __forceinline__ void sp_glds16s(const void* sbase, unsigned voff, unsigned lds_dst) { unsigned keep;
    asm volatile("s_mov_b32 %0, m0\n\ts_mov_b32 m0, %3\n\ts_nop 0\n\tglobal_load_lds_dwordx4 %1, %2\n\ts_mov_b32 m0, %0" : "=&s"(keep) : "v"(voff), "s"(sbase), "s"(lds_dst) : "memory"); }
template <bool IS_A> __device__ __forceinline__ void sparse_pair(Frame& F, const BAParams& P, int rb, int tA, int qi0, int nv0, int nv1, bool dry) {
    constexpr int NC = IS_A ? 8 : 16, NSLOT = NC * 16, KOFF = IS_A ? 0 : M * 128, HB = IS_A ? 0 : 8, GOFF = IS_A ? 0 : 512;
    int lane_ = F.lane; asm volatile("" : "+v"(lane_)); const int lane = lane_, r = lane & 15, g4 = lane >> 4, my_a = g4 >> 1, my_j = g4 & 1;
    const bf16* Q = IS_A ? P.QA : P.QB;
    const LAS unsigned short* sel = (const LAS unsigned short*)(F.lds + SEL_OFF) + qi0 * 256;
    const LAS float* BIAS = (const LAS float*)(F.lds + BIAS_OFF);
    const LAS unsigned char* BKT = (const LAS unsigned char*)(F.lds + BKT_OFF);
    LAS unsigned short* Pimg = (LAS unsigned short*)(F.lds + RING_OFF + F.wave * 16384);
    bf16x8 q0, q1; const bf16x8 zz = {0, 0, 0, 0, 0, 0, 0, 0};
    { const int a_r = r >> 3, hd = r & 7; const bf16* qp = Q + (size_t)(rb + tA + a_r) * 512 + hd * 64 + 8 * g4; q0 = *(const bf16x8*)qp; q1 = *(const bf16x8*)(qp + 32); }
    const int my_t = tA + my_a, rcb = r >> 2;
    f32x4 x[NC];
#pragma unroll
    for (int c = 0; c < NC; ++c) x[c] = (f32x4){0.f, 0.f, 0.f, 0.f};
    constexpr int KS = NSLOT / 32, NST = 4 * KS;
    const unsigned wk = (unsigned)__builtin_amdgcn_readfirstlane((int)((unsigned)(uintptr_t)(F.lds + RING_OFF) + (unsigned)F.wave * 16384u));
    const int drow = lane >> 3, dpc = lane & 7;
#define SP_KDMA(st, bufi) do { const int cb_ = (st) / KS, ks_ = (st) % KS, a_ = cb_ >> 1, j_ = cb_ & 1; const unsigned dst_ = wk + (unsigned)((bufi) * 4096); \
        _Pragma("unroll") for (int i_ = 0; i_ < 4; ++i_) { const int slot_ = 32 * ks_ + 8 * i_ + drow; int key_; \
            if (IS_A) { key_ = tA + a_ - slot_; key_ = key_ < 0 ? 0 : key_; } else { key_ = sel[a_ * 256 + slot_]; key_ = (slot_ < (a_ ? nv1 : nv0) && key_ < SEQ) ? key_ : 0; } \
            sp_glds16s(P.KAB, (unsigned)(((rb + key_) * 128 + KOFF + j_ * 64 + ((dpc ^ (drow & 7)) * 8)) * 2), (unsigned)__builtin_amdgcn_readfirstlane((int)(dst_ + i_ * 1024))); } } while (0)
    asm volatile("s_waitcnt vmcnt(0)" ::: "memory");
    SP_KDMA(0, 0); SP_KDMA(1, 1); SP_KDMA(2, 2); if (NST > 3) SP_KDMA(3, 3);
    { const LAS unsigned char* kring = F.lds + RING_OFF + F.wave * 16384;
      int kbuf = 0;
#pragma unroll 1
      for (int st = 0; st < NST; ++st) {
        if (st + 3 < NST) asm volatile("s_waitcnt vmcnt(12)" ::: "memory"); else if (st + 2 < NST) asm volatile("s_waitcnt vmcnt(8)" ::: "memory"); else if (st + 1 < NST) asm volatile("s_waitcnt vmcnt(4)" ::: "memory"); else asm volatile("s_waitcnt vmcnt(0)" ::: "memory");
        const int cb = st / KS, ks = st % KS; const bool mine = rcb == cb; const bf16x8 a0 = mine ? q0 : zz, a1 = mine ? q1 : zz;
        const LAS unsigned char* kb = kring + kbuf * 4096;
        bf16x8 f[2][2];
#pragma unroll
        for (int cc = 0; cc < 2; ++cc)
#pragma unroll
            for (int k2 = 0; k2 < 2; ++k2) f[cc][k2] = *(const LAS bf16x8*)(kb + (16 * cc + r) * 128 + (((4 * k2 + g4) ^ (r & 7)) * 16));
        asm volatile("s_waitcnt lgkmcnt(0)" ::: "memory");
#pragma unroll
        for (int k8 = 0; k8 < KS; ++k8) if (k8 == ks) {
#pragma unroll
            for (int cc = 0; cc < 2; ++cc) { x[2 * k8 + cc] = __builtin_amdgcn_mfma_f32_16x16x32_bf16(a0, f[cc][0], x[2 * k8 + cc], 0, 0, 0); x[2 * k8 + cc] = __builtin_amdgcn_mfma_f32_16x16x32_bf16(a1, f[cc][1], x[2 * k8 + cc], 0, 0, 0); } }
        if (st + 4 < NST) SP_KDMA(st + 4, kbuf);
        kbuf = (kbuf + 1) & 3;
      } }
#undef SP_KDMA
#pragma unroll
    for (int c = 0; c < NC; ++c) { const int slot = 16 * c + r; int mk; bool mv;
        if (IS_A) { mk = my_t - slot; mv = mk >= 0; } else { mk = sel[my_a * 256 + slot]; mv = slot < (my_a ? nv1 : nv0); }
        const int delta = my_t - mk; const bool ok = mv && delta >= 0;
        const int bk = (ok && delta < 512) ? (int)BKT[delta] : 31;
        const f32x4 b4 = *(const LAS f32x4*)(BIAS + bk * 16 + HB + 4 * my_j);
#pragma unroll
        for (int i = 0; i < 4; ++i) x[c][i] = ok ? x[c][i] * 0.125f + b4[i] : -INFINITY; }
    f32x4 mx = x[0];
#pragma unroll
    for (int c = 1; c < NC; ++c)
#pragma unroll
        for (int i = 0; i < 4; ++i) mx[i] = fmaxf(mx[i], x[c][i]);
#pragma unroll
    for (int o = 1; o < 16; o <<= 1)
#pragma unroll
        for (int i = 0; i < 4; ++i) mx[i] = fmaxf(mx[i], __shfl_xor(mx[i], o));
    f32x4 sk = {0.f, 0.f, 0.f, 0.f};
    if (IS_A) { sk = *(const f32x4*)(P.sinks + 4 * my_j);
#pragma unroll
        for (int i = 0; i < 4; ++i) mx[i] = fmaxf(mx[i], sk[i]); }
    f32x4 sum = {0.f, 0.f, 0.f, 0.f};
#pragma unroll
    for (int c = 0; c < NC; ++c)
#pragma unroll
        for (int i = 0; i < 4; ++i) { x[c][i] = __expf(x[c][i] - mx[i]); sum[i] += x[c][i]; }
#pragma unroll
    for (int o = 1; o < 16; o <<= 1)
#pragma unroll
        for (int i = 0; i < 4; ++i) sum[i] += __shfl_xor(sum[i], o);
    if (IS_A) {
#pragma unroll
        for (int i = 0; i < 4; ++i) sum[i] += __expf(sk[i] - mx[i]); }
    f32x4 inv;
#pragma unroll
    for (int i = 0; i < 4; ++i) inv[i] = 1.0f / sum[i];
#define SP_PWRITE(qa) do { if (my_a == (qa)) { _Pragma("unroll") for (int c_ = 0; c_ < NC; ++c_) _Pragma("unroll") for (int i_ = 0; i_ < 4; ++i_) \
        Pimg[(4 * my_j + i_) * NSLOT + 16 * c_ + r] = (unsigned short)f2bf(x[c_][i_] * inv[i_]); } } while (0)
    SP_PWRITE(0);
    const unsigned wl = wk + 4096u;
#define SP_VDMA(st, bufi) do { const int cb_ = (st) / KS, ks_ = (st) % KS, a_ = cb_ >> 1, j_ = cb_ & 1; const unsigned dst_ = wl + (unsigned)((bufi) * 4096); \
        _Pragma("unroll") for (int i_ = 0; i_ < 4; ++i_) { const int slot_ = 32 * ks_ + 8 * i_ + drow; int key_; \
            if (IS_A) { key_ = tA + a_ - slot_; key_ = key_ < 0 ? 0 : key_; } else { key_ = sel[a_ * 256 + slot_]; key_ = (slot_ < (a_ ? nv1 : nv0) && key_ < SEQ) ? key_ : 0; } \
            sp_glds16s(P.VAB, (unsigned)(((rb + key_) * 128 + KOFF + j_ * 64 + dpc * 8) * 2), (unsigned)__builtin_amdgcn_readfirstlane((int)(dst_ + i_ * 1024))); } } while (0)
    asm volatile("s_waitcnt vmcnt(0)" ::: "memory");
    SP_VDMA(0, 0); SP_VDMA(1, 1); SP_VDMA(2, 2);
    f32x4 o[4];
#pragma unroll
    for (int db = 0; db < 4; ++db) o[db] = (f32x4){0.f, 0.f, 0.f, 0.f};
    const unsigned trb = (unsigned)((8 * g4 + ((lane & 15) >> 2)) * 128 + (lane & 3) * 8);
    int bufi = 0;
#pragma unroll 1
    for (int st = 0; st < NST; ++st) {
        if (st == NST / 2) { SP_PWRITE(1); }
        if (st + 2 < NST) asm volatile("s_waitcnt vmcnt(8)" ::: "memory"); else if (st + 1 < NST) asm volatile("s_waitcnt vmcnt(4)" ::: "memory"); else asm volatile("s_waitcnt vmcnt(0)" ::: "memory");
        const int cb = st / KS, ks = st % KS; const unsigned vb = wl + (unsigned)(bufi * 4096) + trb;
        s16x4 lo[4], hi[4];
#pragma unroll
        for (int db = 0; db < 4; ++db) {
            asm volatile("ds_read_b64_tr_b16 %0, %1 offset:%c2" : "=&v"(lo[db]) : "v"(vb), "i"(db * 32) : "memory");
            asm volatile("ds_read_b64_tr_b16 %0, %1 offset:%c2" : "=&v"(hi[db]) : "v"(vb), "i"(db * 32 + 512) : "memory"); }
        bf16x8 pb = *(const LAS bf16x8*)(Pimg + (r & 7) * NSLOT + 32 * ks + 8 * g4);
        pb = (rcb == cb) ? pb : zz;
        asm volatile("s_waitcnt lgkmcnt(0)" ::: "memory");
#pragma unroll
        for (int db = 0; db < 4; ++db) { const bf16x8 va = {lo[db][0], lo[db][1], lo[db][2], lo[db][3], hi[db][0], hi[db][1], hi[db][2], hi[db][3]};
            o[db] = __builtin_amdgcn_mfma_f32_16x16x32_bf16(va, pb, o[db], 0, 0, 0); }
        if (st + 3 < NST) SP_VDMA(st + 3, bufi);
        bufi = bufi == 2 ? 0 : bufi + 1;
    }
#undef SP_VDMA
#undef SP_PWRITE
    if (!dry) { bf16* gp = P.G + (size_t)(rb + tA + (r >> 3)) * 1536 + GOFF + (r & 7) * 64 + 4 * g4;
#pragma unroll
        for (int db = 0; db < 4; ++db) { const u32x2 gt = *(const u32x2*)(gp + 16 * db);
            const float g0 = __uint_as_float(gt.x << 16), g1 = __uint_as_float(gt.x & 0xffff0000u), g2 = __uint_as_float(gt.y << 16), g3 = __uint_as_float(gt.y & 0xffff0000u);
            u32x2 w; w.x = pk2(o[db][0] * g0, o[db][1] * g1); w.y = pk2(o[db][2] * g2, o[db][3] * g3);
            *(u32x2*)(gp + 16 * db) = w; } }
}
__device__ __forceinline__ void swa_dense(Frame& F, const BAParams& P, int rb, int t0, bool dry) {
    constexpr int NC = 10, NSLOT = 160, NST = 5;
    int lane_ = F.lane; asm volatile("" : "+v"(lane_)); const int lane = lane_, r = lane & 15, g4 = lane >> 4, j = F.wave >> 2, qg = F.wave & 3, kbase = t0 - 128;
    const LAS float* BIAS = (const LAS float*)(F.lds + BIAS_OFF);
    const LAS unsigned char* BKT = (const LAS unsigned char*)(F.lds + BKT_OFF);
    LAS unsigned short* Pimg = (LAS unsigned short*)(F.lds + RING_OFF + F.wave * 16384);
    bf16x8 qf[2]; { const bf16* qp = P.QA + (size_t)(rb + t0 + 4 * qg + (r >> 2)) * 512 + (4 * j + (r & 3)) * 64 + 8 * g4; qf[0] = *(const bf16x8*)qp; qf[1] = *(const bf16x8*)(qp + 32); }
    bf16x8 kf[NC][2];
#pragma unroll
    for (int c = 0; c < NC; ++c) { int key = kbase + 16 * c + r; key = key < 0 ? 0 : (key > SEQ - 1 ? SEQ - 1 : key);
        const bf16* kp = P.KAB + (size_t)(rb + key) * 128 + j * 64 + 8 * g4; kf[c][0] = *(const bf16x8*)kp; kf[c][1] = *(const bf16x8*)(kp + 32); }
    const int my_t = t0 + 4 * qg + g4;
    f32x4 x[NC];
#pragma unroll
    for (int c = 0; c < NC; ++c) { f32x4 d = {0.f, 0.f, 0.f, 0.f};
        d = __builtin_amdgcn_mfma_f32_16x16x32_bf16(qf[0], kf[c][0], d, 0, 0, 0); d = __builtin_amdgcn_mfma_f32_16x16x32_bf16(qf[1], kf[c][1], d, 0, 0, 0);
        const int key = kbase + 16 * c + r, delta = my_t - key; const bool ok = key >= 0 && delta >= 0 && delta < 128;
        const int bk = (int)BKT[ok ? delta : 0];
        const f32x4 b4 = *(const LAS f32x4*)(BIAS + bk * 16 + 4 * j);
#pragma unroll
        for (int i = 0; i < 4; ++i) x[c][i] = ok ? d[i] * 0.125f + b4[i] : -INFINITY; }
    f32x4 mx = *(const f32x4*)(P.sinks + 4 * j); const f32x4 sk = mx;
#pragma unroll
    for (int c = 0; c < NC; ++c)
#pragma unroll
        for (int i = 0; i < 4; ++i) mx[i] = fmaxf(mx[i], x[c][i]);
#pragma unroll
    for (int o = 1; o < 16; o <<= 1)
#pragma unroll
        for (int i = 0; i < 4; ++i) mx[i] = fmaxf(mx[i], __shfl_xor(mx[i], o));
    f32x4 sum = {0.f, 0.f, 0.f, 0.f};
#pragma unroll
    for (int c = 0; c < NC; ++c)
#pragma unroll
        for (int i = 0; i < 4; ++i) { x[c][i] = __expf(x[c][i] - mx[i]); sum[i] += x[c][i]; }
#pragma unroll
    for (int o = 1; o < 16; o <<= 1)
#pragma unroll
        for (int i = 0; i < 4; ++i) sum[i] += __shfl_xor(sum[i], o);
    f32x4 inv;
#pragma unroll
    for (int i = 0; i < 4; ++i) inv[i] = 1.0f / (sum[i] + __expf(sk[i] - mx[i]));
#pragma unroll
    for (int c = 0; c < NC; ++c)
#pragma unroll
        for (int i = 0; i < 4; ++i) Pimg[(4 * g4 + i) * NSLOT + 16 * c + r] = (unsigned short)f2bf(x[c][i] * inv[i]);
    const unsigned wl = (unsigned)__builtin_amdgcn_readfirstlane((int)((unsigned)(uintptr_t)(F.lds + RING_OFF) + (unsigned)F.wave * 16384u + 8192u));
    const int drow = lane >> 3, dpc = lane & 7;
#define SW_VDMA(st) do { const unsigned dst_ = wl + (unsigned)(((st) & 1) * 4096); \
        _Pragma("unroll") for (int i_ = 0; i_ < 4; ++i_) { int key_ = kbase + 32 * (st) + 8 * i_ + drow; key_ = key_ < 0 ? 0 : (key_ > SEQ - 1 ? SEQ - 1 : key_); \
            sp_glds16s(P.VAB, (unsigned)(((rb + key_) * 128 + j * 64 + dpc * 8) * 2), (unsigned)__builtin_amdgcn_readfirstlane((int)(dst_ + i_ * 1024))); } } while (0)
    asm volatile("s_waitcnt vmcnt(0)" ::: "memory");
    SW_VDMA(0); SW_VDMA(1);
    f32x4 o[4];
#pragma unroll
    for (int db = 0; db < 4; ++db) o[db] = (f32x4){0.f, 0.f, 0.f, 0.f};
    const unsigned trb = (unsigned)((8 * g4 + ((lane & 15) >> 2)) * 128 + (lane & 3) * 8);
#pragma unroll 1
    for (int st = 0; st < NST; ++st) {
        if (st + 1 < NST) asm volatile("s_waitcnt vmcnt(4)" ::: "memory"); else asm volatile("s_waitcnt vmcnt(0)" ::: "memory");
        const unsigned vb = wl + (unsigned)((st & 1) * 4096) + trb;
        s16x4 lo[4], hi[4];
#pragma unroll
        for (int db = 0; db < 4; ++db) {
            asm volatile("ds_read_b64_tr_b16 %0, %1 offset:%c2" : "=&v"(lo[db]) : "v"(vb), "i"(db * 32) : "memory");
            asm volatile("ds_read_b64_tr_b16 %0, %1 offset:%c2" : "=&v"(hi[db]) : "v"(vb), "i"(db * 32 + 512) : "memory"); }
        const bf16x8 pb = *(const LAS bf16x8*)(Pimg + r * NSLOT + 32 * st + 8 * g4);
        asm volatile("s_waitcnt lgkmcnt(0)" ::: "memory");
#pragma unroll
        for (int db = 0; db < 4; ++db) { const bf16x8 va = {lo[db][0], lo[db][1], lo[db][2], lo[db][3], hi[db][0], hi[db][1], hi[db][2], hi[db][3]};
            o[db] = __builtin_amdgcn_mfma_f32_16x16x32_bf16(va, pb, o[db], 0, 0, 0); }
        if (st + 2 < NST) SW_VDMA(st + 2);
    }
#undef SW_VDMA
    if (!dry) { bf16* gp = P.G + (size_t)(rb + t0 + 4 * qg + (r >> 2)) * 1536 + (4 * j + (r & 3)) * 64 + 4 * g4;
#pragma unroll
        for (int db = 0; db < 4; ++db) { const u32x2 gt = *(const u32x2*)(gp + 16 * db);
            const float g0 = __uint_as_float(gt.x << 16), g1 = __uint_as_float(gt.x & 0xffff0000u), g2 = __uint_as_float(gt.y << 16), g3 = __uint_as_float(gt.y & 0xffff0000u);
            u32x2 w; w.x = pk2(o[db][0] * g0, o[db][1] * g1); w.y = pk2(o[db][2] * g2, o[db][3] * g3);
            *(u32x2*)(gp + 16 * db) = w; } }
}
__device__ __forceinline__ void ba_clear(Frame& F) {
    LAS v4u* hz = (LAS v4u*)(F.lds + RING_OFF + F.wave * 16384);
#pragma unroll
    for (int i = 0; i < 16; ++i) hz[F.lane + 64 * i] = (v4u){0u, 0u, 0u, 0u};
    if (F.tid < 32) ((LAS unsigned*)(F.lds + MISC_OFF))[F.tid] = 0u;
    for (int i = F.tid; i < 16 * 64; i += 512) ((LAS unsigned*)(F.lds + H2_OFF))[i] = 0u;
}
__device__ __forceinline__ void ba_unit(Frame& F, const BAParams& P, int b, int tau, bool dry) {
    { int l_ = (int)__builtin_amdgcn_mbcnt_hi(~0u, __builtin_amdgcn_mbcnt_lo(~0u, 0u)); asm volatile("" : "+v"(l_)); F.lane = l_; F.tid = F.wave * 64 + l_; }
    const int t0 = tau * 16, rb = b * SEQ, lane = F.lane;
    LAS unsigned* misc = (LAS unsigned*)(F.lds + MISC_OFF);
    for (int ri = 0; ri < REP_IDX; ++ri)
    if (tau >= 16) {
        if (ri) { __syncthreads(); ba_clear(F); __syncthreads(); }
        bf16x8 bq[4]; const int r = lane & 15, g4 = lane >> 4;
#pragma unroll
        for (int h = 0; h < 4; ++h) bq[h] = *(const bf16x8*)(P.IQ + (size_t)(rb + t0 + r) * 128 + h * 32 + 8 * g4);
        const f32x4 w4 = *(const f32x4*)(P.IW + (size_t)(rb + t0 + r) * 4);
        const bf16* IKb = P.IK + (size_t)rb * 32;
        idx_pass<1>(F, IKb, bq, w4, tau, t0);
        __syncthreads();
        idx_threshold(F);
        __syncthreads();
        idx_pass<2>(F, IKb, bq, w4, tau, t0);
        __syncthreads();
        idx_resolve(F);
    } else {
        LAS unsigned short* sel = (LAS unsigned short*)(F.lds + SEL_OFF);
        for (int i = F.tid; i < 16 * 256; i += 512) sel[i] = (unsigned short)(i & 255);
    }
    __syncthreads();
    const int tA = t0 + 2 * F.wave, nv0 = tA >= 256 ? 256 : tA + 1, nv1 = tA + 1 >= 256 ? 256 : tA + 2;
    for (int rs = 0; rs < REP_SPB; ++rs) sparse_pair<false>(F, P, rb, tA, 2 * F.wave, nv0, nv1, dry || rs + 1 < REP_SPB);
    for (int rs = 0; rs < REP_SPA; ++rs) swa_dense(F, P, rb, t0, dry || rs + 1 < REP_SPA);
    ba_clear(F);
}

#ifndef REP_P1A
#define REP_P1A 1
#endif
#ifndef REP_C
#define REP_C 1
#endif
#ifndef REP_BA
#define REP_BA 1
#endif
#ifndef REP_P1B
#define REP_P1B 1
#endif
#ifndef REP_P3
#define REP_P3 1
#endif
#ifndef REP_P0
#define REP_P0 1
#endif
#ifndef FOX_SKIP_LOG2
#define FOX_SKIP_LOG2 (-80.0f)
#endif
#ifndef MK_ONE_LAUNCH
#define MK_ONE_LAUNCH 1
#endif
constexpr int NPHASES = 1 + 6 * DEPTH;
struct Args { const float* in[9]; float* out; unsigned char* ws; int ph_lo, ph_hi; };
static_assert(sizeof(Args) == 9 * 8 + 8 + 8 + 4 + 4, "no padding bytes in the argument struct");

typedef const __attribute__((address_space(4))) Args* ArgP;
__device__ __forceinline__ ArgP argp() { ArgP p = (ArgP)__builtin_amdgcn_kernarg_segment_ptr(); asm volatile("" : "+s"(p)); return p; }
__global__ void __launch_bounds__(512, 2) mk_fwd(Args args) {
    extern __shared__ __attribute__((aligned(16))) unsigned char lds[];
    Frame F;
    F.lds = (LAS unsigned char*)lds;
    F.MISC = (volatile LAS unsigned*)(F.lds + MISC_OFF);
    F.tid = threadIdx.x; F.lane = F.tid & 63; F.wave = __builtin_amdgcn_readfirstlane(F.tid >> 6);
    F.G = gridDim.x; { const int bx = blockIdx.x; F.vcu = (F.G % 8 == 0) ? (bx % 8) * (F.G / 8) + bx / 8 : bx; }
    F.ctl = (gu32*)(argp()->ws + WS_CTL);
    for (int u = F.tid; u < 256; u += 512) ((LAS unsigned*)(F.lds + MISC_OFF))[u] = 0u;
    for (int u = F.tid; u < 512; u += 512) { ((LAS float*)(F.lds + BIAS_OFF))[u] = argp()->in[8][u];
        int bk; if (u < 16) bk = u; else { const float nf = (float)u; int lg = 16 + (int)(logf(nf / 16.0f) / 3.4657359027997265f * 16.0f); bk = lg < 31 ? lg : 31; }
        ((LAS unsigned char*)(F.lds + BKT_OFF))[u] = (unsigned char)bk; }
    __syncthreads();
    XcdBarrier bar; bar.bar = (unsigned*)(F.ctl + CW_BAR); bar.x = 0; bar.st = nullptr;
    if (MK_ONE_LAUNCH) bar = xcd_barrier_post((unsigned*)(F.ctl + CW_BAR), F.MISC + MW_BAR);
    const int lo = argp()->ph_lo, hi = argp()->ph_hi;
#define IN(k) (lo <= (k) && (k) < hi)
#define SEAM(k) do { if (IN(k) && IN((k) + 1)) xcd_barrier(bar); } while (0)
#define PHASE_BEGIN() do { int l_ = (int)__builtin_amdgcn_mbcnt_hi(~0u, __builtin_amdgcn_mbcnt_lo(~0u, 0u)); asm volatile("" : "+v"(l_)); F.lane = l_; F.tid = F.wave * 64 + l_; } while (0)

    if (IN(0)) { PHASE_BEGIN(); ArgP a = argp(); for (int rp = 0; rp < REP_P0; ++rp) p0_prologue(F, a->in[0], a->in[1], a->in[2], a->in[6], a->in[7], a->ws); SEAM(0); }

    for (int L = 0; L < DEPTH; ++L) {
        const int pb = 1 + 6 * L;
        if (IN(pb)) { PHASE_BEGIN();
            unsigned char* ws = argp()->ws; const pg8::bf16_t* W1T = (const pg8::bf16_t*)(ws + WS_W1T) + (size_t)L * NTILES * 256 * 1024;
            pg8::Gemm g{(const pg8::bf16_t*)(ws + WS_XB), W1T, M, NT_A * 256, 1024, 1024, 1024, 0}; pg8::StaticOrder S; S.init(M, NT_A * 256, F.G, (int)blockIdx.x);
            pg8::EpiIn E{ws, argp()->in[4] + L * 384, argp()->in[3] + L * 8};
            for (int rp = 0; rp < REP_P1A; ++rp) pg8::gemm_phase<pg8::EpiIn, pg8::StaticOrder, true, true>(F.lds + RING_OFF, g, S, E, F.wave);
            SEAM(pb);
        }
        if (IN(pb + 2)) { PHASE_BEGIN();
            unsigned char* ws = argp()->ws;
            const float* CL = (const float*)(ws + WS_CL); const float* CT = (const float*)(ws + WS_CT);
            LAS float* carry = (LAS float*)(F.lds + H2_OFF)  ; LAS unsigned* nbw = (LAS unsigned*)(F.lds + RING_OFF + NB_OFF);
            for (int rp = 0; rp < REP_C; ++rp) {
            LAS unsigned* miscw = (LAS unsigned*)(F.lds + MISC_OFF);
            for (int kg = 0; kg < 8; ++kg) { const int xg = ((F.vcu >> 5) + kg) & 7;
            gu32* const tick = F.ctl + CW_TICK + 64 * (8 * (2 * L + rp % 2) + xg);
            if (F.tid == 0) miscw[MW_TICKET] = __hip_atomic_fetch_add(tick, 1u, RLX_AGENT);
            __syncthreads();
            for (;;) {
                PHASE_BEGIN();
                const int ui = (int)miscw[MW_TICKET];
                if (ui >= 128) { __syncthreads(); break; }
                const int qb = 31 - (ui >> 2), bh = 4 * xg + (ui & 3);
                    if (F.wave == 0) { const float t0 = CT[bh * 128 + 2 * F.lane], t1 = CT[bh * 128 + 2 * F.lane + 1]; const float inc = wave_incl_scan(t0 + t1, F.lane); carry[2 * F.lane] = inc - (t0 + t1); carry[2 * F.lane + 1] = inc - t1; }
                    __syncthreads();
                    const float cref = carry[4 * qb]; int tskip;
                    { const float* gq = argp()->in[4] + L * 384 + 256; const float g1 = fabsf(gq[F.lane]), g2 = fabsf(gq[64 + F.lane]); float mq = g1, mk = g2;
#pragma unroll
                      for (int o = 1; o < 64; o <<= 1) { mq = fmaxf(mq, __shfl_xor(mq, o)); mk = fmaxf(mk, __shfl_xor(mk, o)); }
                      const float thr = FOX_SKIP_LOG2 - 2.0f * (11.8f * mq * mk + 0.5f);
                      const int NTt = 4 * (qb + 1); const int t_a = F.lane, t_b = 64 + F.lane, k_a = 64 * t_a + 63, k_b = 64 * t_b + 63;
                      const float n_a = t_a < NTt ? (cref - (carry[k_a >> 6] + CL[(size_t)bh * SEQ + k_a])) * 1.4426950408889634f : 0.f, n_b = t_b < NTt ? (cref - (carry[k_b >> 6] + CL[(size_t)bh * SEQ + k_b])) * 1.4426950408889634f : 0.f;
                      const bool s_a = t_a < NTt && n_a < thr, s_b = t_b < NTt && n_b < thr;
                      const unsigned long long f_a = __ballot(!s_a), f_b = __ballot(!s_b);
                      int cnt = f_a ? (int)__builtin_ctzll(f_a) : 64 + (f_b ? (int)__builtin_ctzll(f_b) : 64);
                      cnt &= ~1; tskip = cnt > NTt - 4 ? NTt - 4 : cnt; }
                    { const int nk = 256 * (qb + 1);
                      for (int k = 64 * tskip + F.tid; k < nk; k += 512) { const float xb = (cref - (carry[k >> 6] + CL[(size_t)bh * SEQ + k])) * 1.4426950408889634f;
                          const unsigned h = f2bf(xb), l = f2bf(xb - __uint_as_float(h << 16)); nbw[k] = h | (l << 16); } }
                    __syncthreads();
                    attn_body::attn_unit<8>(bh >> 3, bh & 7, qb, (const attn_body::bf16*)(ws + WS_QC), (const attn_body::bf16*)(ws + WS_KC), (const attn_body::bf16*)(ws + WS_VC), (attn_body::bf16*)(ws + WS_G),
                                            (char*)lds + RING_OFF, (attn_body::lds_cuptr)(F.lds + RING_OFF + NB_OFF), tskip, rp + 1 < REP_C, F.wave);
                if (F.tid == 0) miscw[MW_TICKET] = __hip_atomic_fetch_add(tick, 1u, RLX_AGENT);
                __syncthreads();
            } } }
            __syncthreads(); PHASE_BEGIN();
            const BAParams P{(const bf16*)(ws + WS_IQ), (const bf16*)(ws + WS_IK), (const float*)(ws + WS_IW), (const bf16*)(ws + WS_QA), (const bf16*)(ws + WS_QB), (const bf16*)(ws + WS_KAB), (const bf16*)(ws + WS_VAB),
                             (bf16*)(ws + WS_G), argp()->in[5] + L * 8};
            for (int rp = 0; rp < REP_BA; ++rp) {
            LAS unsigned* miscw = (LAS unsigned*)(F.lds + MISC_OFF);
            for (int kg = 0; kg < 4; ++kg) { const int bq = ((F.vcu >> 6) + kg) & 3;
            gu32* const tick = F.ctl + CW_TICK + 64 * (32 + 4 * (2 * L + rp % 2) + bq);
            ba_clear(F);
            if (F.tid == 0) miscw[MW_TICKET] = __hip_atomic_fetch_add(tick, 1u, RLX_AGENT);
            __syncthreads();
            for (;;) {
                PHASE_BEGIN();
                const int ui = (int)miscw[MW_TICKET];
                if (ui >= 512) { __syncthreads(); break; }
                ba_unit(F, P, bq, 511 - ui, rp + 1 < REP_BA);
                if (F.tid == 0) miscw[MW_TICKET] = __hip_atomic_fetch_add(tick, 1u, RLX_AGENT);
                __syncthreads();
            } } }
            SEAM(pb + 2);
        }
        if (IN(pb + 3)) { PHASE_BEGIN();
            unsigned char* ws = argp()->ws; const pg8::bf16_t* W1T = (const pg8::bf16_t*)(ws + WS_W1T) + (size_t)L * NTILES * 256 * 1024;
            pg8::Gemm g{(const pg8::bf16_t*)(ws + WS_XB), W1T + (size_t)NT_A * 256 * 1024, M, NT_B * 256, 1024, 1024, 1024, 0}; pg8::StaticOrder S; S.init(M, NT_B * 256, F.G, (int)blockIdx.x);
            pg8::EpiGate E{(const float*)(ws + WS_SSQ), (unsigned char*)(ws + WS_MG)};
            for (int rp = 0; rp < REP_P1B; ++rp) pg8::gemm_phase<pg8::EpiGate, pg8::StaticOrder, true, true>(F.lds + RING_OFF, g, S, E, F.wave);
            SEAM(pb + 3);
        }
        if (IN(pb + 4)) { PHASE_BEGIN();
            unsigned char* ws = argp()->ws;
            pg8::Gemm g{(const pg8::bf16_t*)(ws + WS_G), (const pg8::bf16_t*)(ws + WS_WBT) + (size_t)L * 3 * 1024 * 512, M, 1024, 512, 1536, 512, 4};
            pg8::SegOrder S; S.base.init(M, 1024, F.G, (int)blockIdx.x);
            pg8::EpiMerge E{(const unsigned char*)(ws + WS_MG), (pg8::bf16_t*)(ws + WS_MERGED)};
            for (int rp = 0; rp < REP_P3; ++rp) pg8::gemm_phase<pg8::EpiMerge, pg8::SegOrder, true, true>(F.lds + RING_OFF, g, S, E, F.wave);
            SEAM(pb + 4);
        }
        if (IN(pb + 5)) { PHASE_BEGIN();
            unsigned char* ws = argp()->ws; float* const outp = argp()->out;
            pg8::Gemm g{(const pg8::bf16_t*)(ws + WS_MERGED), (const pg8::bf16_t*)(ws + WS_WOT) + (size_t)L * 1024 * 1024, M, 1024, 1024, 1024, 1024, 0}; pg8::StaticOrder S; S.init(M, 1024, F.G, (int)blockIdx.x);
            const bool last = (L == DEPTH - 1);
            unsigned poison = 0u;
            if (last) poison = (__hip_atomic_load(F.ctl + CW_OVF, RLX_AGENT) != 0u) | (__hip_atomic_load(F.ctl + CW_BAR + XB_TMO, RLX_AGENT) != 0u);
            pg8::EpiOut E{L == 0 ? argp()->in[0] : (const float*)outp, outp, last ? nullptr : (pg8::bf16_t*)(ws + WS_XB), last ? nullptr : (float*)(ws + WS_SSQ), poison};
            pg8::gemm_phase<pg8::EpiOut, pg8::StaticOrder, true, true>(F.lds + RING_OFF, g, S, E, F.wave);
            if (!last) SEAM(pb + 5);
        }
    }
#undef IN
#undef SEAM
}

extern "C" void kernel_launch(void* const* d_in, const int* in_sizes, int n_in, void* d_out, int out_size, void* d_ws, size_t ws_size, hipStream_t stream) {
    static int grid = 0;
    if (grid == 0) {
        if (n_in != 9 || in_sizes[0] != M * DMODEL || out_size != M * DMODEL || ws_size < WS_END) { fprintf(stderr, "kernel_launch: unexpected shapes / workspace (n_in %d, in0 %d, out %d, ws %zu < %zu); nothing launched\n", n_in, n_in > 0 ? in_sizes[0] : -1, out_size, ws_size, (size_t)WS_END); grid = -1; return; }
        int dev = 0, cus = 0, per_cu = 0;
        if (hipGetDevice(&dev) != hipSuccess || hipDeviceGetAttribute(&cus, hipDeviceAttributeMultiprocessorCount, dev) != hipSuccess) { grid = -1; return; }
        if (hipFuncSetAttribute((const void*)mk_fwd, hipFuncAttributeMaxDynamicSharedMemorySize, LDS_BYTES) != hipSuccess) { fprintf(stderr, "kernel_launch: hipFuncSetAttribute failed\n"); grid = -1; return; }
        if (hipOccupancyMaxActiveBlocksPerMultiprocessor(&per_cu, (const void*)mk_fwd, 512, LDS_BYTES) != hipSuccess || per_cu < 1) fprintf(stderr, "kernel_launch: occupancy query reports %d workgroups per CU\n", per_cu);
        (void)hipGetLastError();
        grid = cus;
    }
    if (grid < 0) return;
    if (hipMemsetAsync((char*)d_ws + WS_CTL, 0, CTL_ZERO_BYTES, stream) != hipSuccess) return;
    Args a{};
    for (int i = 0; i < 9; ++i) a.in[i] = (const float*)d_in[i];
    a.out = (float*)d_out; a.ws = (unsigned char*)d_ws;
#if MK_ONE_LAUNCH
    a.ph_lo = 0; a.ph_hi = NPHASES;
    hipLaunchKernelGGL(mk_fwd, dim3(grid), dim3(512), LDS_BYTES, stream, a);
#else
    for (int p = 0; p < NPHASES; ++p) { a.ph_lo = p; a.ph_hi = p + 1; hipLaunchKernelGGL(mk_fwd, dim3(grid), dim3(512), LDS_BYTES, stream, a); }
#endif
}
```

```cpp
#include <hip/hip_runtime.h>
#include <cstdio>
#include <cstdint>
#include <cmath>
namespace pg8 {
#define PG8_LAS __attribute__((address_space(3)))
typedef unsigned short bf16_t;
typedef short bf16x8 __attribute__((ext_vector_type(8)));
typedef float f32x4 __attribute__((ext_vector_type(4)));
typedef unsigned u32x4 __attribute__((ext_vector_type(4)));
constexpr int BM = 256, BK = 64, HALF = 128, HTB = HALF * BK * 2  , STAGE_BYTES = 8 * HTB, NXCD = 8, WGM = 8;

__host__ __device__ __forceinline__ int lds_byte(int r, int c) { const int st = (r >> 4) * 2 + (c >> 5), rr = r & 15, cc = c & 31, ob = rr * 64 + cc * 2; return st * 1024 + (ob ^ (((ob >> 9) & 1) << 5)); }
__host__ __device__ __forceinline__ void stage_rc(int b, int& R, int& C) { const int st = b / 1024, sb = b % 1024, swz = sb ^ (((sb >> 9) & 1) << 5); R = (st >> 1) * 16 + swz / 64; C = (st & 1) * 32 + (swz % 64) / 2; }
__host__ __device__ __forceinline__ int perm32(int rho) { const int n = rho >> 4, i = rho & 15; return 8 * (i >> 2) + 4 * n + (i & 3); }

struct Unit { int pm, pn, seg; };
struct Gemm { const bf16_t* A; const bf16_t* Bt; int M, N, K, lda, ldb, segN; };

struct StaticOrder {
    int nM, nN, nwg, G, c;
    __host__ __device__ void init(int M, int N, int G_, int c_) { nM = M / BM; nN = N / BM; nwg = nM * nN; G = G_; c = c_; }
    __host__ __device__ bool next(int i, Unit& u) const {
        const long L = (long)i * G + c; if (L >= nwg) return false;
        int wgid = (int)L; { const int q = nwg / NXCD, r = nwg % NXCD, xcd = wgid % NXCD, off = wgid / NXCD; wgid = (xcd < r ? xcd * (q + 1) : r * (q + 1) + (xcd - r) * q) + off; }
        const int nig = WGM * nN, gid = wgid / nig, fm = gid * WGM, gsz = (nM - fm) < WGM ? (nM - fm) : WGM;
        u.pm = fm + ((wgid % nig) % gsz); u.pn = (wgid % nig) / gsz; u.seg = 0; return true;
    }
    __device__ __forceinline__ void a_ready(const Unit&) const {}
    __device__ __forceinline__ void done(const Unit&) const {}
};

__device__ __forceinline__ unsigned cvt_pk_bf16(float lo, float hi) { unsigned r; asm volatile("v_cvt_pk_bf16_f32 %0, %1, %2" : "=v"(r) : "v"(lo), "v"(hi)); return r; }
constexpr size_t EWS_MiB = 1u << 20, EWS_SSQ = 43 * EWS_MiB, EWS_CL = 45 * EWS_MiB, EWS_CT = 46 * EWS_MiB, EWS_IW = 47 * EWS_MiB, EWS_CF = 47 * EWS_MiB + 512 * 1024, EWS_IQ = 49 * EWS_MiB, EWS_IK = 57 * EWS_MiB, EWS_G = 188 * EWS_MiB,
    EWS_QA = 284 * EWS_MiB, EWS_QB = 316 * EWS_MiB, EWS_QC = 348 * EWS_MiB, EWS_KC = 380 * EWS_MiB, EWS_VC = 412 * EWS_MiB, EWS_KAB = 444 * EWS_MiB, EWS_VAB = 460 * EWS_MiB;

constexpr float C2Q = 0.125f * 1.4426950408889634f;
__device__ __forceinline__ float fast_sigmoid(float x) { return __builtin_amdgcn_rcpf(1.0f + __expf(-x)); }
__device__ __forceinline__ u32x4 pack8(const f32x4 a, const f32x4 b) { u32x4 w; w.x = cvt_pk_bf16(a[0], a[1]); w.y = cvt_pk_bf16(a[2], a[3]); w.z = cvt_pk_bf16(b[0], b[1]); w.w = cvt_pk_bf16(b[2], b[3]); return w; }
__device__ __forceinline__ void unpack8(const u32x4 w, f32x4& a, f32x4& b) {
    a[0] = __uint_as_float(w.x << 16); a[1] = __uint_as_float(w.x & 0xffff0000u); a[2] = __uint_as_float(w.y << 16); a[3] = __uint_as_float(w.y & 0xffff0000u);
    b[0] = __uint_as_float(w.z << 16); b[1] = __uint_as_float(w.z & 0xffff0000u); b[2] = __uint_as_float(w.w << 16); b[3] = __uint_as_float(w.w & 0xffff0000u); }
#define EPI_PIN() asm volatile("" ::: "memory")
__device__ __forceinline__ void rows_rstd(const float* ssq, int row0, int fq, float (&rs)[2][4]) {
    f32x4 pr[2][4];
#pragma unroll
    for (int ai = 0; ai < 2; ++ai)
#pragma unroll
        for (int m = 0; m < 4; ++m) pr[ai][m] = *(const f32x4*)(ssq + (size_t)(row0 + ai * HALF + m * 16) * 16 + 4 * fq);
    EPI_PIN();
#pragma unroll
    for (int ai = 0; ai < 2; ++ai)
#pragma unroll
        for (int m = 0; m < 4; ++m) { const f32x4 a = pr[ai][m]; float t = (a[0] + a[1]) + (a[2] + a[3]); t += __shfl_xor(t, 16); t += __shfl_xor(t, 32); rs[ai][m] = __builtin_amdgcn_rsqf(t * (1.0f / 1024.0f) + 1e-6f); }
}
struct EpiIn {
    static constexpr bool PERM = true, AFTER_DRAIN = false;
    unsigned char* ws; const float* qkg; const float* bfg;
    __device__ __forceinline__ bool keep(const Unit&) const { return false; }
    __device__ __forceinline__ void operator()(f32x4 (&acc)[2][2][4][2], const Unit& u, int wr, int wc, int fr, int fq) const {
        const int row0 = u.pm * BM + wr * 64 + fr, t = u.pn, lc0 = wc * 64 + fq * 8;
        float rs[2][4]; rows_rstd((const float*)(ws + EWS_SSQ), row0, fq, rs);
        if (t == 18) {
            bf16_t* IQ = (bf16_t*)(ws + EWS_IQ); bf16_t* IK = (bf16_t*)(ws + EWS_IK); float* IW = (float*)(ws + EWS_IW);
#pragma unroll
            for (int ai = 0; ai < 2; ++ai)
#pragma unroll
                for (int m = 0; m < 4; ++m) { const int row = row0 + ai * HALF + m * 16; const float f = rs[ai][m];
#pragma unroll
                    for (int bj = 0; bj < 2; ++bj) { const int lc = lc0 + 32 * bj; const f32x4 v0 = acc[ai][bj][m][0] * f, v1 = acc[ai][bj][m][1] * f;
                        if (lc < 128) *(u32x4*)(IQ + (size_t)row * 128 + lc) = pack8(v0, v1);
                        else if (lc < 160) *(u32x4*)(IK + (size_t)row * 32 + (lc - 128)) = pack8(v0, v1);
                        else if (lc == 160) *(f32x4*)(IW + (size_t)row * 4) = v0 * 0.08838834764831845f; } }
            int ln_ = (int)__builtin_amdgcn_mbcnt_hi(~0u, __builtin_amdgcn_mbcnt_lo(~0u, 0u)); asm volatile("" : "+v"(ln_));
            if (wc == 2 && (ln_ >> 4) < 2) { const int fql = ln_ >> 4, frl = ln_ & 15;
                float* CL = (float*)(ws + EWS_CL); float* CT = (float*)(ws + EWS_CT); const int hb = 4 * fql; const f32x4 bfv = *(const f32x4*)(bfg + hb);
#pragma unroll
                for (int ai = 0; ai < 2; ++ai) { f32x4 run = {0.f, 0.f, 0.f, 0.f};
#pragma unroll
                    for (int m = 0; m < 4; ++m) { const int row = row0 + ai * HALF + m * 16; const f32x4 z = (fql == 0 ? acc[ai][1][m][1] : acc[ai][1][m][0]) * rs[ai][m] + bfv; f32x4 lf;
#pragma unroll
                        for (int e = 0; e < 4; ++e) lf[e] = (z[e] < 0.f ? z[e] : 0.f) - __logf(1.0f + __expf(-fabsf(z[e])));
#pragma unroll
                        for (int o = 1; o < 16; o <<= 1)
#pragma unroll
                            for (int e = 0; e < 4; ++e) { const float tt = __shfl_up(lf[e], o, 16); if (frl >= o) lf[e] += tt; }
                        const f32x4 cs = lf + run;
                        const int bb = row >> 13, ss = row & 8191;
#pragma unroll
                        for (int e = 0; e < 4; ++e) CL[(size_t)(bb * 8 + hb + e) * 8192 + ss] = cs[e];
#pragma unroll
                        for (int e = 0; e < 4; ++e) run[e] += __shfl(lf[e], 15, 16); }
                    if (frl == 15) { const int row = row0 + ai * HALF, bb = row >> 13, ch = (row & 8191) >> 6;
#pragma unroll
                        for (int e = 0; e < 4; ++e) CT[(bb * 8 + hb + e) * 128 + ch] = run[e]; } } }
            return;
        }
        bf16_t* dst; int ldc, colbase; const float* gp = qkg; float csc = 1.f; bool norm = false, act = false;
        if (t < 6) { const int mx = t >> 1; dst = (bf16_t*)(ws + (mx == 0 ? EWS_QA : (mx == 1 ? EWS_QB : EWS_QC))); ldc = 512; colbase = (t & 1) * 256; norm = true; gp = qkg + (mx * 2 + 0) * 64; csc = (mx == 2) ? C2Q : 1.f; }
        else if (t == 6) { dst = (bf16_t*)(ws + EWS_KAB); ldc = 128; colbase = (wc >> 1) * (32768 * 128 - 128); norm = true;     gp = qkg + ((wc >> 1) * 2 + 1) * 64; }
        else if (t < 9) { dst = (bf16_t*)(ws + EWS_KC); ldc = 512; colbase = (t - 7) * 256; norm = true; gp = qkg + (2 * 2 + 1) * 64; }
        else if (t == 9) { dst = (bf16_t*)(ws + EWS_VAB); ldc = 128; colbase = (wc >> 1) * (32768 * 128 - 128); }
        else if (t < 12) { dst = (bf16_t*)(ws + EWS_VC); ldc = 512; colbase = (t - 10) * 256; }
        else { dst = (bf16_t*)(ws + EWS_G); ldc = 1536; colbase = (t - 12) * 256; act = true; }
        f32x4 gv[2][2];
#pragma unroll
        for (int bj = 0; bj < 2; ++bj)
#pragma unroll
            for (int n = 0; n < 2; ++n) gv[bj][n] = norm ? *(const f32x4*)(gp + 8 * fq + 32 * bj + 4 * n) * csc : (f32x4){1.f, 1.f, 1.f, 1.f};
        EPI_PIN();
#pragma unroll
        for (int ai = 0; ai < 2; ++ai)
#pragma unroll
            for (int m = 0; m < 4; ++m) { const int row = row0 + ai * HALF + m * 16; float f = rs[ai][m];
                if (norm) { float ss = 0.f;
#pragma unroll
                    for (int bj = 0; bj < 2; ++bj)
#pragma unroll
                        for (int n = 0; n < 2; ++n) { const f32x4 x = acc[ai][bj][m][n]; ss += (x[0] * x[0] + x[1] * x[1]) + (x[2] * x[2] + x[3] * x[3]); }
                    ss += __shfl_xor(ss, 16); ss += __shfl_xor(ss, 32);
                    f = f * __builtin_amdgcn_rsqf(f * f * ss * (1.0f / 64.0f) + 1e-6f); }
                bf16_t* rowp = dst + (size_t)row * ldc + colbase + lc0;
#pragma unroll
                for (int bj = 0; bj < 2; ++bj) { f32x4 v0 = acc[ai][bj][m][0] * f * gv[bj][0], v1 = acc[ai][bj][m][1] * f * gv[bj][1];
                    if (act) {
#pragma unroll
                        for (int e = 0; e < 4; ++e) { v0[e] = v0[e] * fast_sigmoid(v0[e]); v1[e] = v1[e] * fast_sigmoid(v1[e]); } }
                    *(u32x4*)(rowp + 32 * bj) = pack8(v0, v1); } }
    }
};
typedef unsigned u32x2e __attribute__((ext_vector_type(2)));
__device__ __forceinline__ unsigned gate_q4(const f32x4 v) { unsigned w = 0u;
    w = __builtin_amdgcn_cvt_pk_u8_f32(fmaxf(255.0f * fast_sigmoid(v[0]), 1.0f), 0, w); w = __builtin_amdgcn_cvt_pk_u8_f32(fmaxf(255.0f * fast_sigmoid(v[1]), 1.0f), 1, w);
    w = __builtin_amdgcn_cvt_pk_u8_f32(fmaxf(255.0f * fast_sigmoid(v[2]), 1.0f), 2, w); w = __builtin_amdgcn_cvt_pk_u8_f32(fmaxf(255.0f * fast_sigmoid(v[3]), 1.0f), 3, w); return w; }
__device__ __forceinline__ f32x4 gate_f4(const unsigned w) { return (f32x4){(float)(w & 0xffu), (float)((w >> 8) & 0xffu), (float)((w >> 16) & 0xffu), (float)(w >> 24)}; }
struct EpiGate {
    static constexpr bool PERM = true, AFTER_DRAIN = false;
    const float* ssq; unsigned char* MG;
    __device__ __forceinline__ bool keep(const Unit&) const { return false; }
    __device__ __forceinline__ void operator()(f32x4 (&acc)[2][2][4][2], const Unit& u, int wr, int wc, int fr, int fq) const {
        const int row0 = u.pm * BM + wr * 64 + fr, lc0 = wc * 64 + fq * 8;
        float rs[2][4]; rows_rstd(ssq, row0, fq, rs);
#pragma unroll
        for (int ai = 0; ai < 2; ++ai)
#pragma unroll
            for (int m = 0; m < 4; ++m) { const int row = row0 + ai * HALF + m * 16; const float f = rs[ai][m];
                unsigned char* rowp = MG + (size_t)row * 3072 + u.pn * BM + lc0;
#pragma unroll
                for (int bj = 0; bj < 2; ++bj) { u32x2e w; w.x = gate_q4(acc[ai][bj][m][0] * f); w.y = gate_q4(acc[ai][bj][m][1] * f); *(u32x2e*)(rowp + 32 * bj) = w; } }
    }
};
struct EpiMerge {
    static constexpr bool PERM = true, AFTER_DRAIN = false;
    const unsigned char* MG; bf16_t* OUT;
    __device__ __forceinline__ bool keep(const Unit& u) const { return u.seg < 2; }
    __device__ __forceinline__ void operator()(f32x4 (&acc)[2][2][4][2], const Unit& u, int wr, int wc, int fr, int fq) const {
        const int row0 = u.pm * BM + wr * 64 + fr, col0 = u.pn * BM + wc * 32 + 8 * fq, seg = u.seg;
#pragma unroll
        for (int ai = 0; ai < 2; ++ai) {
            u32x2e ga[4][2], gb[4][2];
#pragma unroll
            for (int m = 0; m < 4; ++m) { const unsigned char* gp = MG + (size_t)(row0 + ai * HALF + m * 16) * 3072 + seg * 1024 + col0;
#pragma unroll
                for (int bj = 0; bj < 2; ++bj) { ga[m][bj] = *(const u32x2e*)(gp + bj * HALF); gb[m][bj] = seg < 2 ? *(const u32x2e*)(gp + 1024 + bj * HALF) : ga[m][bj]; } }
            EPI_PIN();
#pragma unroll
            for (int m = 0; m < 4; ++m) { const int row = row0 + ai * HALF + m * 16;
#pragma unroll
                for (int bj = 0; bj < 2; ++bj) { f32x4 a0 = gate_f4(ga[m][bj].x), a1 = gate_f4(ga[m][bj].y);
                    if (seg < 2) { const f32x4 b0 = gate_f4(gb[m][bj].x), b1 = gate_f4(gb[m][bj].y);
#pragma unroll
                        for (int e = 0; e < 4; ++e) { a0[e] = a0[e] * __builtin_amdgcn_rcpf(b0[e]); a1[e] = a1[e] * __builtin_amdgcn_rcpf(b1[e]); } }
                    else { a0 = a0 * (1.0f / 255.0f); a1 = a1 * (1.0f / 255.0f); }
                    acc[ai][bj][m][0] = acc[ai][bj][m][0] * a0; acc[ai][bj][m][1] = acc[ai][bj][m][1] * a1;
                    if (seg == 2) *(u32x4*)(OUT + (size_t)row * 1024 + col0 + bj * HALF) = pack8(acc[ai][bj][m][0], acc[ai][bj][m][1]); } }
        }
    }
};
struct EpiOut {
    static constexpr bool PERM = true, AFTER_DRAIN = false;
    const float* resid; float* out; bf16_t* XB; float* ssq; unsigned poison;
    __device__ __forceinline__ bool keep(const Unit&) const { return false; }
    __device__ __forceinline__ void operator()(f32x4 (&acc)[2][2][4][2], const Unit& u, int wr, int wc, int fr, int fq) const {
        const int row0 = u.pm * BM + wr * 64 + fr, col0 = u.pn * BM + wc * 32 + 8 * fq;
#pragma unroll
        for (int ai = 0; ai < 2; ++ai) {
            f32x4 rv[4][2][2];
#pragma unroll
            for (int m = 0; m < 4; ++m)
#pragma unroll
                for (int bj = 0; bj < 2; ++bj) { const size_t o = (size_t)(row0 + ai * HALF + m * 16) * 1024 + col0 + bj * HALF; rv[m][bj][0] = *(const f32x4*)(resid + o); rv[m][bj][1] = *(const f32x4*)(resid + o + 4); }
            EPI_PIN();
#pragma unroll
            for (int m = 0; m < 4; ++m) { const int row = row0 + ai * HALF + m * 16; float ss = 0.f;
#pragma unroll
                for (int bj = 0; bj < 2; ++bj) { const size_t o = (size_t)row * 1024 + col0 + bj * HALF;
                    f32x4 v0 = rv[m][bj][0] + acc[ai][bj][m][0], v1 = rv[m][bj][1] + acc[ai][bj][m][1];
                    if (poison) { const float qn = __builtin_nanf(""); v0 = (f32x4){qn, qn, qn, qn}; v1 = v0; }
                    *(f32x4*)(out + o) = v0; *(f32x4*)(out + o + 4) = v1;
                    if (XB) { *(u32x4*)(XB + o) = pack8(v0, v1); ss += ((v0[0] * v0[0] + v0[1] * v0[1]) + (v0[2] * v0[2] + v0[3] * v0[3])) + ((v1[0] * v1[0] + v1[1] * v1[1]) + (v1[2] * v1[2] + v1[3] * v1[3])); } }
                if (XB) { ss += __shfl_xor(ss, 16); ss += __shfl_xor(ss, 32); if (fq == 0) ssq[(size_t)row * 16 + u.pn * 4 + wc] = ss; } }
            EPI_PIN();
        }
    }
};
struct SegOrder {
    StaticOrder base;
    __device__ __forceinline__ bool next(int i, Unit& u) const { if (!base.next(i / 3, u)) return false; u.seg = i % 3; return true; }
    __device__ __forceinline__ void a_ready(const Unit&) const {}
    __device__ __forceinline__ void done(const Unit&) const {}
};

template <class Epi, class Sched, bool ALIGN_EPI = false, bool SP2 = false>
__device__ __forceinline__ void gemm_phase(PG8_LAS unsigned char* lds, const Gemm g, const Sched& S, const Epi& E, int wave_id) {
    int tid_ = (int)__builtin_amdgcn_mbcnt_hi(~0u, __builtin_amdgcn_mbcnt_lo(~0u, 0u)); asm volatile("" : "+v"(tid_)); tid_ += wave_id * 64;
    const int tid = tid_, wid = __builtin_amdgcn_readfirstlane(tid >> 6), lane = tid & 63, wr = wid >> 2, wc = wid & 3, fr = lane & 15, fq = lane >> 4;
    const int K = g.K, nt = K / BK;
    unsigned voffA[2], voffB[2];
#pragma unroll
    for (int i = 0; i < 2; ++i) { int R, C; stage_rc(tid * 16 + i * 8192, R, C); const int Rb = Epi::PERM ? ((R & ~31) + perm32(R & 31)) : R;
        voffA[i] = (unsigned)(R * g.lda + C) * 2u; voffB[i] = (unsigned)(Rb * g.ldb + C) * 2u; }
    const size_t kstep = (size_t)(BK * 2);
    const size_t hstepA = (size_t)HALF * g.lda * 2, hstepB = (size_t)HALF * g.ldb * 2;
    const size_t tstepA = 2 * hstepA, tstepB = 2 * hstepB, sstepA = (size_t)K * 2;
    const unsigned ldsw = (unsigned)wid * 1024u;
    const int aoff = lds_byte(wr * 64 + fr, fq * 8), boff = lds_byte(wc * 32 + fr, fq * 8);
#define PG8_SA(b, h) (((b) * 2 + (h)) * HTB)
#define PG8_SB(b, h) ((4 + (b) * 2 + (h)) * HTB)
#define PG8_STAGE(bufoff, gbase, voff) do { _Pragma("unroll") for (int _i = 0; _i < 2; ++_i) \
        __builtin_amdgcn_global_load_lds((const unsigned*)((const char*)(gbase) + (voff)[_i]), (PG8_LAS unsigned*)(lds + (bufoff) + ldsw + _i * 8192), 16, 0, 0); } while (0)
#define PG8_LDA(dst, b, h) do { _Pragma("unroll") for (int m = 0; m < 4; ++m) _Pragma("unroll") for (int k = 0; k < 2; ++k) dst[m][k] = *(const PG8_LAS bf16x8*)(lds + PG8_SA(b, h) + aoff + m * 2048 + k * 1024); } while (0)
#define PG8_LDB(dst, b, h) do { _Pragma("unroll") for (int n = 0; n < 2; ++n) _Pragma("unroll") for (int k = 0; k < 2; ++k) dst[n][k] = *(const PG8_LAS bf16x8*)(lds + PG8_SB(b, h) + boff + n * 2048 + k * 1024); } while (0)
#define PG8_MMA(ai, bj, At, Bt) do { __builtin_amdgcn_s_setprio(1); _Pragma("unroll") for (int m = 0; m < 4; ++m) _Pragma("unroll") for (int n = 0; n < 2; ++n) _Pragma("unroll") for (int k = 0; k < 2; ++k) \
        acc[ai][bj][m][n] = __builtin_amdgcn_mfma_f32_16x16x32_bf16(Bt[n][k], At[m][k], acc[ai][bj][m][n], 0, 0, 0); __builtin_amdgcn_s_setprio(0); } while (0)
#define PG8_WAIT_V(n) asm volatile("s_waitcnt vmcnt(" #n ")" ::: "memory")
#define PG8_WAIT_L(n) asm volatile("s_waitcnt lgkmcnt(" #n ")" ::: "memory")
#define PG8_BAR __builtin_amdgcn_s_barrier()
#define PG8_SCHED __builtin_amdgcn_sched_barrier(0)
    Unit cur, nxt; int ui = 0;
    if (!S.next(0, cur)) return;
    f32x4 acc[2][2][4][2];
#pragma unroll
    for (int a = 0; a < 2; ++a)
#pragma unroll
        for (int b = 0; b < 2; ++b)
#pragma unroll
            for (int m = 0; m < 4; ++m)
#pragma unroll
                for (int n = 0; n < 2; ++n) acc[a][b][m][n] = (f32x4){0.f, 0.f, 0.f, 0.f};
    bf16x8 At[4][2], B0[2][2], B1[2][2];
    const char* cA = (const char*)g.A + (size_t)cur.pm * tstepA + (size_t)cur.seg * sstepA; const char* cB = (const char*)g.Bt + (size_t)(cur.seg * g.segN + cur.pn) * tstepB;
    S.a_ready(cur);
    if constexpr (SP2) {
        PG8_STAGE(PG8_SB(0, 0), cB, voffB); PG8_STAGE(PG8_SB(0, 1), cB + hstepB, voffB); PG8_STAGE(PG8_SA(0, 0), cA, voffA); PG8_STAGE(PG8_SA(0, 1), cA + hstepA, voffA);
        if (wr == 1) PG8_BAR;
        PG8_WAIT_V(2); PG8_BAR;
        PG8_STAGE(PG8_SB(1, 0), cB + kstep, voffB); PG8_STAGE(PG8_SA(1, 0), cA + kstep, voffA); PG8_STAGE(PG8_SB(1, 1), cB + hstepB + kstep, voffB);
        PG8_WAIT_V(6); PG8_BAR;
    } else {
        PG8_STAGE(PG8_SB(0, 0), cB, voffB); PG8_STAGE(PG8_SA(0, 0), cA, voffA); PG8_STAGE(PG8_SB(0, 1), cB + hstepB, voffB); PG8_STAGE(PG8_SA(0, 1), cA + hstepA, voffA);
        if (wr == 1) PG8_BAR;
        PG8_WAIT_V(4); PG8_BAR;
        PG8_STAGE(PG8_SB(1, 0), cB + kstep, voffB); PG8_STAGE(PG8_SA(1, 0), cA + kstep, voffA); PG8_STAGE(PG8_SB(1, 1), cB + hstepB + kstep, voffB);
        PG8_WAIT_V(6); PG8_BAR;
    }
    for (;;) {
        const bool has_next = S.next(ui + 1, nxt);
        const char* nA = has_next ? (const char*)g.A + (size_t)nxt.pm * tstepA + (size_t)nxt.seg * sstepA : cA; const char* nB = has_next ? (const char*)g.Bt + (size_t)(nxt.seg * g.segN + nxt.pn) * tstepB : cB;
        for (int t = 0; t < nt; t += 2) {
            const bool last = (t == nt - 2);
            const char* a1 = cA + (size_t)(t + 1) * kstep;
            const char* a2 = last ? nA : cA + (size_t)(t + 2) * kstep; const char* b2 = last ? nB : cB + (size_t)(t + 2) * kstep;
            const char* a3 = a2 + kstep; const char* b3 = b2 + kstep;
            if (last && has_next) S.a_ready(nxt);
            if constexpr (SP2) {
            PG8_LDB(B0, 0, 0); PG8_LDB(B1, 0, 1); PG8_SCHED; PG8_LDA(At, 0, 0); PG8_STAGE(PG8_SA(1, 1), a1 + hstepA, voffA);
            PG8_WAIT_V(8); PG8_WAIT_L(0); PG8_BAR; PG8_MMA(0, 0, At, B0); PG8_MMA(0, 1, At, B1); PG8_BAR; PG8_SCHED;
            PG8_LDA(At, 0, 1); PG8_STAGE(PG8_SB(0, 0), b2, voffB); PG8_STAGE(PG8_SB(0, 1), b2 + hstepB, voffB); PG8_STAGE(PG8_SA(0, 0), a2, voffA);
            PG8_WAIT_V(8); PG8_WAIT_L(0); PG8_BAR; PG8_MMA(1, 0, At, B0); PG8_MMA(1, 1, At, B1); PG8_BAR; PG8_SCHED;
            PG8_LDB(B0, 1, 0); PG8_LDB(B1, 1, 1); PG8_SCHED; PG8_LDA(At, 1, 0); PG8_STAGE(PG8_SA(0, 1), a2 + hstepA, voffA);
            PG8_WAIT_V(8); PG8_WAIT_L(0); PG8_BAR; PG8_MMA(0, 0, At, B0); PG8_MMA(0, 1, At, B1); PG8_BAR; PG8_SCHED;
            PG8_LDA(At, 1, 1); PG8_STAGE(PG8_SB(1, 0), b3, voffB); PG8_STAGE(PG8_SB(1, 1), b3 + hstepB, voffB); PG8_STAGE(PG8_SA(1, 0), a3, voffA);
            PG8_WAIT_V(8); PG8_WAIT_L(0); PG8_BAR; PG8_MMA(1, 0, At, B0); PG8_MMA(1, 1, At, B1); PG8_BAR; PG8_SCHED;
            } else {
            PG8_LDB(B0, 0, 0); PG8_SCHED; PG8_LDA(At, 0, 0); PG8_STAGE(PG8_SA(1, 1), a1 + hstepA, voffA);
            PG8_WAIT_L(8); PG8_BAR; PG8_WAIT_L(0); PG8_MMA(0, 0, At, B0); PG8_BAR; PG8_SCHED;
            PG8_LDB(B1, 0, 1); PG8_STAGE(PG8_SB(0, 0), b2, voffB);
            PG8_BAR; PG8_WAIT_L(0); PG8_MMA(0, 1, At, B1); PG8_BAR;
            PG8_LDA(At, 0, 1); PG8_STAGE(PG8_SA(0, 0), a2, voffA);
            PG8_BAR; PG8_WAIT_L(0); PG8_MMA(1, 0, At, B0); PG8_BAR; PG8_SCHED;
            PG8_STAGE(PG8_SB(0, 1), b2 + hstepB, voffB);
            PG8_WAIT_V(6); PG8_BAR; PG8_MMA(1, 1, At, B1); PG8_BAR;
            PG8_LDB(B0, 1, 0); PG8_SCHED; PG8_LDA(At, 1, 0); PG8_STAGE(PG8_SA(0, 1), a2 + hstepA, voffA);
            PG8_WAIT_L(8); PG8_BAR; PG8_WAIT_L(0); PG8_MMA(0, 0, At, B0); PG8_BAR; PG8_SCHED;
            PG8_LDB(B1, 1, 1); PG8_STAGE(PG8_SB(1, 0), b3, voffB);
            PG8_BAR; PG8_WAIT_L(0); PG8_MMA(0, 1, At, B1); PG8_BAR;
            PG8_LDA(At, 1, 1); PG8_STAGE(PG8_SA(1, 0), a3, voffA);
            PG8_BAR; PG8_WAIT_L(0); PG8_MMA(1, 0, At, B0); PG8_BAR; PG8_SCHED;
            PG8_STAGE(PG8_SB(1, 1), b3 + hstepB, voffB);
            PG8_WAIT_V(6); PG8_BAR; PG8_MMA(1, 1, At, B1); PG8_BAR;
            }
        }
        if constexpr (ALIGN_EPI) { if (wr == 0) PG8_BAR; }
        if constexpr (!Epi::AFTER_DRAIN) { E(acc, cur, wr, wc, fr, fq); S.done(cur); }
        if (!has_next) break;
        if (!E.keep(cur)) {
#pragma unroll
        for (int a = 0; a < 2; ++a)
#pragma unroll
            for (int b = 0; b < 2; ++b)
#pragma unroll
                for (int m = 0; m < 4; ++m)
#pragma unroll
                    for (int n = 0; n < 2; ++n) acc[a][b][m][n] = (f32x4){0.f, 0.f, 0.f, 0.f};
        }
        cur = nxt; cA = nA; cB = nB; ++ui;
        if constexpr (ALIGN_EPI) { if (wr == 1) PG8_BAR; }
    }
    PG8_WAIT_V(0);
    if constexpr (!ALIGN_EPI) { if (wr == 0) PG8_BAR; }
    PG8_BAR;
    if constexpr (Epi::AFTER_DRAIN) { E.fused(acc, cur, wr, wc, fr, fq, lds, wid, lane); S.done(cur); }
#undef PG8_SA
#undef PG8_SB
#undef PG8_STAGE
#undef PG8_LDA
#undef PG8_LDB
#undef PG8_MMA
#undef PG8_WAIT_V
#undef PG8_WAIT_L
#undef PG8_BAR
#undef PG8_SCHED
}
}
#include <hip/hip_bf16.h>
#include <cmath>
namespace attn_body {
using bf16=__hip_bfloat16;
using bf16x8=__attribute__((ext_vector_type(8)))short;
using s16x4=__attribute__((ext_vector_type(4)))short;
using f32x16=__attribute__((ext_vector_type(16)))float;
using u32x4=__attribute__((ext_vector_type(4)))unsigned;
constexpr int BATCH=4,NHEAD=8,SEQ=8192,D=64,DM=NHEAD*D;
constexpr int NW=8,QBLK=32,QB=QBLK*NW,KVBLK=64,NQB=SEQ/QB;
constexpr int ATTN_PITCH=DM, ATTN_UNIT_ROWS=QB, OPITCH=1536, OCOL0=1024;
__device__ __forceinline__ int crow(int r,int hi){return (r&3)+8*(r>>2)+4*hi;}
#define SBAR() __builtin_amdgcn_sched_barrier(0)
__device__ __forceinline__ void cmask(f32x16&p0,f32x16&p1,int jb,int qrel,int hi){
  const float NEG=-INFINITY; int kb=64*jb+4*hi;
  #pragma unroll
  for(int r=0;r<16;++r){int kv=kb+(r&3)+8*(r>>2); if(kv>qrel)p0[r]=NEG; if(kv+32>qrel)p1[r]=NEG;}
}

constexpr int NSLOT=3, SLOTB=8192;
constexpr int LDS_K=0, LDS_V=NSLOT*SLOTB, LDS_WS=2*NSLOT*SLOTB, LDS_OST=LDS_WS+NW*64*4, LDS_BYTES=LDS_OST+NW*4096;
constexpr float C2=0.125f*1.4426950408889634f;
__device__ __forceinline__ void glds16(const void*gsrc,unsigned lds_dst){unsigned keep;
  asm volatile("s_mov_b32 %0, m0\n\ts_mov_b32 m0, %2\n\ts_nop 0\n\tglobal_load_lds_dwordx4 %1, off\n\ts_mov_b32 m0, %0":"=&s"(keep):"v"(gsrc),"s"(lds_dst):"memory");}
__device__ __forceinline__ float max3f(float a,float b,float c){float r;asm("v_max3_f32 %0, %1, %2, %3":"=v"(r):"v"(a),"v"(b),"v"(c));return r;}
__device__ __forceinline__ float max2f(float a,float b){float r;asm("v_max_f32_e32 %0, %1, %2":"=v"(r):"v"(a),"v"(b));return r;}
__device__ __forceinline__ float fadd_s(float a,float b){float r;asm("v_add_f32_e32 %0, %1, %2":"=v"(r):"v"(a),"v"(b));return r;}
__device__ __forceinline__ float fsub_s(float a,float b){float r;asm("v_sub_f32_e32 %0, %1, %2":"=v"(r):"v"(a),"v"(b));return r;}
typedef float f32x2_t __attribute__((ext_vector_type(2))); typedef __bf16 bf16x2_t __attribute__((ext_vector_type(2)));
__device__ __forceinline__ unsigned cvtpk_s(float lo,float hi){f32x2_t v={lo,hi};bf16x2_t b=__builtin_convertvector(v,bf16x2_t);return __builtin_bit_cast(unsigned,b);}
#define WAIT_BAR(N) asm volatile("s_waitcnt vmcnt(" #N ") lgkmcnt(0)\n\ts_barrier":::"memory")

__device__ __forceinline__ void qkt(f32x16&p0,f32x16&p1,const char*Kslot,const bf16x8*qr,int r32,int hi){
  const char*kb=Kslot+hi*1024+r32*16;
  #pragma unroll
  for(int d0=0;d0<4;++d0){
    const bf16x8 b0=*reinterpret_cast<const bf16x8*>(kb+d0*2048);
    const bf16x8 b1=*reinterpret_cast<const bf16x8*>(kb+d0*2048+512);
    p0=__builtin_amdgcn_mfma_f32_32x32x16_bf16(b0,qr[d0],p0,0,0,0);p1=__builtin_amdgcn_mfma_f32_32x32x16_bf16(b1,qr[d0],p1,0,0,0);}
}
typedef __attribute__((address_space(3))) const unsigned* lds_cuptr;
typedef float f32x4_t __attribute__((ext_vector_type(4)));
__device__ __forceinline__ unsigned bfr(float f){ unsigned u=__builtin_bit_cast(unsigned,f); return (u+0x7fffu+((u>>16)&1u))>>16; }
__device__ __forceinline__ void biasmm(f32x16&c0,f32x16&c1,unsigned w0,unsigned w1  ,unsigned qm1,int hi){
  const unsigned one=hi?0u:0x3f803f80u; w0=hi?0u:w0; w1=hi?0u:w1;
  const u32x4 k0={w0,one,0u,0u},k1={w1,one,0u,0u},qv={one,qm1,0u,0u};
  const f32x16 z=f32x16{};
  c0=__builtin_amdgcn_mfma_f32_32x32x16_bf16(__builtin_bit_cast(bf16x8,k0),__builtin_bit_cast(bf16x8,qv),z,0,0,0);
  c1=__builtin_amdgcn_mfma_f32_32x32x16_bf16(__builtin_bit_cast(bf16x8,k1),__builtin_bit_cast(bf16x8,qv),z,0,0,0);
}
typedef __attribute__((address_space(3))) const char* lds_cptr;
typedef short v4i16_t __attribute__((ext_vector_type(4)));
__device__ __forceinline__ void kload8(bf16x8*kf,lds_cptr kp){
  kf[0]=*(const __attribute__((address_space(3))) bf16x8*)(kp);      kf[1]=*(const __attribute__((address_space(3))) bf16x8*)(kp+512);
  kf[2]=*(const __attribute__((address_space(3))) bf16x8*)(kp+2048); kf[3]=*(const __attribute__((address_space(3))) bf16x8*)(kp+2560);
  kf[4]=*(const __attribute__((address_space(3))) bf16x8*)(kp+4096); kf[5]=*(const __attribute__((address_space(3))) bf16x8*)(kp+4608);
  kf[6]=*(const __attribute__((address_space(3))) bf16x8*)(kp+6144); kf[7]=*(const __attribute__((address_space(3))) bf16x8*)(kp+6656);
}
__device__ __forceinline__ void kload2(bf16x8*kf,lds_cptr kp,int j){ kf[2*j]=*(const __attribute__((address_space(3))) bf16x8*)(kp+j*2048); kf[2*j+1]=*(const __attribute__((address_space(3))) bf16x8*)(kp+j*2048+512); }
__device__ __forceinline__ s16x4 vtr(lds_cptr p){ return __builtin_bit_cast(s16x4,__builtin_amdgcn_ds_read_tr16_b64_v4i16((__attribute__((address_space(3))) v4i16_t*)p)); }
__device__ __forceinline__ float rowmax(const f32x16&p0,const f32x16&p1){
  float a=max3f(p0[0],p0[1],p1[0]),b=max3f(p0[2],p0[3],p1[1]);a=max3f(a,p1[2],p1[3]);
  #pragma unroll
  for(int r=4;r<16;r+=4){a=max3f(a,p0[r],p0[r+1]);b=max3f(b,p0[r+2],p0[r+3]);a=max3f(a,p1[r],p1[r+1]);b=max3f(b,p1[r+2],p1[r+3]);}
  const float m=max2f(a,b);
  auto rr=__builtin_amdgcn_permlane32_swap(__float_as_uint(m),__float_as_uint(m),false,false);
  return max2f(__uint_as_float(rr[0]),__uint_as_float(rr[1]));
}
__device__ __forceinline__ void pv(f32x16*o,int vb,bf16x8 pa0,bf16x8 pa1,bf16x8 pa2,bf16x8 pa3){
  #pragma unroll
  for(int d0=0;d0<2;++d0){s16x4 lo[4],hi[4];
    #pragma unroll
    for(int ks=0;ks<4;++ks){
      asm volatile("ds_read_b64_tr_b16 %0,%1 offset:%c2":"=&v"(lo[ks]):"v"(vb),"i"(d0*4096+ks*1024):"memory");
      asm volatile("ds_read_b64_tr_b16 %0,%1 offset:%c2":"=&v"(hi[ks]):"v"(vb),"i"(d0*4096+ks*1024+512):"memory");}
    asm volatile("s_waitcnt lgkmcnt(0)":::"memory");SBAR();
    #define PK(k) (bf16x8){lo[k][0],lo[k][1],lo[k][2],lo[k][3],hi[k][0],hi[k][1],hi[k][2],hi[k][3]}
    o[d0]=__builtin_amdgcn_mfma_f32_32x32x16_bf16(pa0,PK(0),o[d0],0,0,0);
    o[d0]=__builtin_amdgcn_mfma_f32_32x32x16_bf16(pa1,PK(1),o[d0],0,0,0);
    o[d0]=__builtin_amdgcn_mfma_f32_32x32x16_bf16(pa2,PK(2),o[d0],0,0,0);
    o[d0]=__builtin_amdgcn_mfma_f32_32x32x16_bf16(pa3,PK(3),o[d0],0,0,0);
    #undef PK
  }
}

__device__ __forceinline__ u32x4 mul_bf16x8(u32x4 a,u32x4 b){ u32x4 r;
  #pragma unroll
  for(int i=0;i<4;++i){ const float al=__uint_as_float(a[i]<<16),ah=__uint_as_float(a[i]&0xffff0000u),bl=__uint_as_float(b[i]<<16),bh=__uint_as_float(b[i]&0xffff0000u); r[i]=cvtpk_s(al*bl,ah*bh); }
  return r; }
#ifndef ATTN_STORE16
#define ATTN_STORE16(p,v) (*(u32x4*)(p)=(v))
#endif
template<int THRL> __device__ __forceinline__ void attn_unit(int b,int h,int qb,const bf16*Q,const bf16*__restrict__ K,const bf16*__restrict__ V,bf16*O,char*shm,lds_cuptr nb,int tskip,bool dry,int wave_id){
  int tid_=(int)__builtin_amdgcn_mbcnt_hi(~0u,__builtin_amdgcn_mbcnt_lo(~0u,0u)); asm volatile("":"+v"(tid_)); tid_+=wave_id*64; const int tid=tid_,lane=tid&63,r32=lane&31,hi=lane>>5; const int wid=__builtin_amdgcn_readfirstlane(tid>>6);
  const long rowbase=(long)b*SEQ; const int q0=qb*QB;
  const bf16*Qw=Q+(rowbase+q0+wid*QBLK)*DM+h*D;
  const bf16*Kh=K+(rowbase+(long)tskip*KVBLK)*DM+h*D,*Vh=V+(rowbase+(long)tskip*KVBLK)*DM+h*D;
  const unsigned lds0=(unsigned)(uintptr_t)shm;
  float*wsf=(float*)(shm+LDS_WS)+wid*64;
  const bf16*ksrc=Kh+(long)lane*DM+wid*8;
  const bf16*vsrc=Vh+(long)(16*(wid&3)+(lane>>2))*DM+(wid>>2)*32+(lane&3)*8;
  const unsigned kdst=lds0+LDS_K+wid*1024, vdst=lds0+LDS_V+wid*1024;
  #define DMA_K(t,slot) glds16(ksrc+(long)(t)*KVBLK*DM,(unsigned)__builtin_amdgcn_readfirstlane(kdst+(slot)))
  #define DMA_V(t,slot) glds16(vsrc+(long)(t)*KVBLK*DM,(unsigned)__builtin_amdgcn_readfirstlane(vdst+(slot)))
  const int vb0=(int)(lds0+LDS_V)+((lane>>4)&1)*32+(lane&3)*8+(4*hi+((lane&15)>>2))*64;
  const char*Kbase=shm+LDS_K; bf16x8 kf[8];
  const lds_cptr shm3=(lds_cptr)shm; const lds_cptr kp0=shm3+LDS_K+hi*1024+r32*16; const lds_cptr vp0=shm3+LDS_V+((lane>>4)&1)*32+(lane&3)*8+(4*hi+((lane&15)>>2))*64;
  const int NT=(q0+QB)/KVBLK-tskip;
  DMA_K(0,0);DMA_V(0,0);DMA_K(1,SLOTB);
  bf16x8 qr[4];
  #pragma unroll
  for(int d0=0;d0<4;++d0)qr[d0]=*reinterpret_cast<const bf16x8*>(&Qw[(long)r32*DM+d0*16+hi*8]);
  float mhat=0.f,l_reg=0.f;f32x16 o[2];o[0]=f32x16{};o[1]=f32x16{};unsigned qm1=0u;const lds_cuptr nbl=nb+64*tskip+r32;
  #define SETM(NEWM) do{ const float nm_=-(NEWM); const unsigned h_=bfr(nm_); const float hf_=__uint_as_float(h_<<16); const unsigned l_=bfr(nm_-hf_); mhat=-(hf_+__uint_as_float(l_<<16)); qm1=hi?0u:(h_|(l_<<16)); }while(0)
  const int qrel=wid*QBLK+r32;
  #define CMASK(P0,P1,t) do{int jb_=(t)-(NT-4); if(jb_>=0)cmask(P0,P1,jb_,qrel,hi);}while(0)
  bool resc=false;
  #define START(P0,P1) do{ const float rm=rowmax(P0,P1); resc=false; \
    { const float old_=mhat; SETM(old_+rm); const float dl=mhat-old_; \
      _Pragma("unroll") for(int r=0;r<16;++r){P0[r]=fsub_s(P0[r],dl);P1[r]=fsub_s(P1[r],dl);} } \
    _Pragma("unroll") for(int r=0;r<16;++r)P0[r]=__builtin_amdgcn_exp2f(P0[r]); }while(0)
  #define RESC() do{ if(resc){ asm volatile("s_waitcnt lgkmcnt(0)":::"memory"); \
      _Pragma("unroll") for(int d_=0;d_<2;++d_) _Pragma("unroll") for(int r=0;r<16;++r)o[d_][r]*=wsf[crow(r,hi)]; } }while(0)
  f32x16 pA0,pA1,pB0,pB1;
  int sl_prev=0,sl_cur=0,sl_next=SLOTB;
  #define ROT() do{sl_prev=sl_cur;sl_cur=sl_next;sl_next=(sl_next==(NSLOT-1)*SLOTB)?0:sl_next+SLOTB;}while(0)
  DMA_K(2,2*SLOTB);
  WAIT_BAR(3);
  unsigned bw0=nbl[0],bw1=nbl[32]; biasmm(pA0,pA1,bw0,bw1,qm1,hi); bw0=nbl[64]; bw1=nbl[96]; qkt(pA0,pA1,Kbase,qr,r32,hi);    asm volatile("s_nop 15\n\ts_nop 7":"+v"(pA0),"+v"(pA1));CMASK(pA0,pA1,0);
  START(pA0,pA1);
  _Pragma("unroll") for(int r=0;r<16;++r)pA1[r]=__builtin_amdgcn_exp2f(pA1[r]);
  WAIT_BAR(0);
  DMA_K(3,0);DMA_V(1,SLOTB);
  ROT();
  kload8(kf,kp0+sl_cur);
  WAIT_BAR(2);
  s16x4 vlo[8],vhi[8]; u32x4 pw0,pw1,pw2,pw3;
  #define PKW(P,B) cvtpk_s(P[B],P[B+1])
  #define PAF(k) __builtin_bit_cast(bf16x8,pw##k)
  #define VFR(i) (bf16x8){vlo[i][0],vlo[i][1],vlo[i][2],vlo[i][3],vhi[i][0],vhi[i][1],vhi[i][2],vhi[i][3]}
  #define PIN(x) asm volatile("":"+v"(x))
  #define MX3(a,b,c) __builtin_fmaxf(__builtin_fmaxf((a),(b)),(c))
  #define GAPA(MF,A0,A1,A2,A3,W0,W1,PW) do{ MF; sacc+=A0; sacc+=A1; sacc+=A2; sacc+=A3; PIN(sacc); W0; W1; PIN(PW); SBAR(); }while(0)
  #define EX(v) __builtin_amdgcn_exp2f(v)
  #define GAPB(MF,X,B) do{ MF; X[B]=EX(X[B]); X[B+1]=EX(X[B+1]); X[B+2]=EX(X[B+2]); X[B+3]=EX(X[B+3]); PIN(X); SBAR(); }while(0)
  #define VRD(i) do{ vlo[i]=vtr(vp_+(((i)>>2)*4096+((i)&3)*1024)); vhi[i]=vtr(vp_+(((i)>>2)*4096+((i)&3)*1024+512)); }while(0)
  #define KRD(G,j) do{ if(G){ kload2(kf,kp0+sl_next,j); SBAR(); } }while(0)
  #define STEP(C0,C1,P0,P1,t,GK,GV,GL) do{ SBAR(); \
    biasmm(C0,C1,bw0,bw1,qm1,hi); bw0=nbl[64*((t)+1)]; bw1=nbl[64*((t)+1)+32]; SBAR(); \
    const lds_cptr vp_=vp0+sl_prev; \
    VRD(0); SBAR(); float sacc=(P0[0]+P0[1]); \
    GAPA(C0=__builtin_amdgcn_mfma_f32_32x32x16_bf16(kf[0],qr[0],C0,0,0,0), P0[2],P0[3],P0[4],P0[5],     pw0[0]=PKW(P0,0), pw0[1]=PKW(P0,2), pw0); \
    VRD(4); SBAR(); GAPA(C1=__builtin_amdgcn_mfma_f32_32x32x16_bf16(kf[1],qr[0],C1,0,0,0), P0[6],P0[7],P0[8],P0[9],     pw0[2]=PKW(P0,4), pw0[3]=PKW(P0,6), pw0); \
    VRD(1); SBAR(); GAPA(C0=__builtin_amdgcn_mfma_f32_32x32x16_bf16(kf[2],qr[1],C0,0,0,0),   P0[10],P0[11],P0[12],P0[13], pw1[0]=PKW(P0,8), pw1[1]=PKW(P0,10), pw1); \
    VRD(5); SBAR(); GAPA(C1=__builtin_amdgcn_mfma_f32_32x32x16_bf16(kf[3],qr[1],C1,0,0,0),   P0[14],P0[15],P1[0],P1[1],   pw1[2]=PKW(P0,12),pw1[3]=PKW(P0,14), pw1); \
    VRD(2); SBAR(); GAPA(C0=__builtin_amdgcn_mfma_f32_32x32x16_bf16(kf[4],qr[2],C0,0,0,0),   P1[2],P1[3],P1[4],P1[5],     pw2[0]=PKW(P1,0), pw2[1]=PKW(P1,2), pw2); \
    VRD(6); SBAR(); GAPA(C1=__builtin_amdgcn_mfma_f32_32x32x16_bf16(kf[5],qr[2],C1,0,0,0),   P1[6],P1[7],P1[8],P1[9],     pw2[2]=PKW(P1,4), pw2[3]=PKW(P1,6), pw2); \
    VRD(3); SBAR(); GAPA(C0=__builtin_amdgcn_mfma_f32_32x32x16_bf16(kf[6],qr[3],C0,0,0,0),   P1[10],P1[11],P1[12],P1[13], pw3[0]=PKW(P1,8), pw3[1]=PKW(P1,10), pw3); \
    VRD(7); SBAR(); GAPA(C1=__builtin_amdgcn_mfma_f32_32x32x16_bf16(kf[7],qr[3],C1,0,0,0),   P1[14],P1[15],0.f,0.f,       pw3[2]=PKW(P1,12),pw3[3]=PKW(P1,14), pw3); \
    l_reg+=sacc; \
    if(GK){DMA_K((t)+3,sl_cur);} if(GV){DMA_V((t)+1,sl_next);} \
    CMASK(C0,C1,t); \
    { float a=MX3(C0[0],C0[1],C1[0]),b=MX3(C0[2],C0[3],C1[1]); a=MX3(a,C1[2],C1[3]); \
      _Pragma("unroll") for(int r=4;r<16;r+=4){a=MX3(a,C0[r],C0[r+1]);b=MX3(b,C0[r+2],C0[r+3]);a=MX3(a,C1[r],C1[r+1]);b=MX3(b,C1[r+2],C1[r+3]);} \
      float rm=__builtin_fmaxf(a,b); { auto rr=__builtin_amdgcn_permlane32_swap(__float_as_uint(rm),__float_as_uint(rm),false,false); rm=__builtin_fmaxf(__uint_as_float(rr[0]),__uint_as_float(rr[1])); } \
      resc=false; \
      if(__builtin_expect(__any(rm>(float)THRL),0)){ const float old_=mhat; SETM(old_+__builtin_fmaxf(rm,0.f)); const float dl=mhat-old_; \
        _Pragma("unroll") for(int r=0;r<16;++r){C0[r]-=dl;C1[r]-=dl;} \
        const float f=__builtin_amdgcn_exp2f(-dl); l_reg*=f; if(hi==0)wsf[r32]=f; resc=true; } } \
    SBAR(); \
    GAPB(o[0]=__builtin_amdgcn_mfma_f32_32x32x16_bf16(PAF(0),VFR(0),o[0],0,0,0), C0,0); \
    GAPB(o[1]=__builtin_amdgcn_mfma_f32_32x32x16_bf16(PAF(0),VFR(4),o[1],0,0,0), C0,4); \
    KRD(GL,0); GAPB(o[0]=__builtin_amdgcn_mfma_f32_32x32x16_bf16(PAF(1),VFR(1),o[0],0,0,0), C0,8); \
    KRD(GL,1); GAPB(o[1]=__builtin_amdgcn_mfma_f32_32x32x16_bf16(PAF(1),VFR(5),o[1],0,0,0), C0,12); \
    KRD(GL,2); GAPB(o[0]=__builtin_amdgcn_mfma_f32_32x32x16_bf16(PAF(2),VFR(2),o[0],0,0,0), C1,0); \
    KRD(GL,3); GAPB(o[1]=__builtin_amdgcn_mfma_f32_32x32x16_bf16(PAF(2),VFR(6),o[1],0,0,0), C1,4); \
    GAPB(o[0]=__builtin_amdgcn_mfma_f32_32x32x16_bf16(PAF(3),VFR(3),o[0],0,0,0), C1,8); \
    GAPB(o[1]=__builtin_amdgcn_mfma_f32_32x32x16_bf16(PAF(3),VFR(7),o[1],0,0,0), C1,12); \
    }while(0)
  int t=1;
  #undef CMASK
  #define CMASK(P0,P1,t) do{}while(0)
  for(;t+5<NT;t+=2){
    STEP(pB0,pB1,pA0,pA1,t,true,true,true);     WAIT_BAR(2); RESC(); ROT();
    STEP(pA0,pA1,pB0,pB1,t+1,true,true,true);   WAIT_BAR(2); RESC(); ROT();
  }
  #undef CMASK
  #define CMASK(P0,P1,t) do{int jb_=(t)-(NT-4); if(jb_>=0)cmask(P0,P1,jb_,qrel,hi);}while(0)
  #define ENDW(tt) do{ if((tt)+3<NT){WAIT_BAR(2);} else if((tt)+2<NT){WAIT_BAR(1);} else {WAIT_BAR(0);} }while(0)
  for(;t+1<NT;t+=2){
    STEP(pB0,pB1,pA0,pA1,t,(t+3<NT),(t+1<NT),(t+1<NT));       ENDW(t);   RESC(); ROT();
    STEP(pA0,pA1,pB0,pB1,t+1,(t+4<NT),(t+2<NT),(t+2<NT));     ENDW(t+1); RESC(); ROT();
  }
  STEP(pB0,pB1,pA0,pA1,NT-1,false,false,false); RESC();
  { float sacc=pB0[0]+pB0[1]; _Pragma("unroll") for(int r=2;r<16;++r)sacc+=pB0[r]; _Pragma("unroll") for(int r=0;r<16;++r)sacc+=pB1[r]; l_reg+=sacc;
    pw0=(u32x4){PKW(pB0,0),PKW(pB0,2),PKW(pB0,4),PKW(pB0,6)};pw1=(u32x4){PKW(pB0,8),PKW(pB0,10),PKW(pB0,12),PKW(pB0,14)};pw2=(u32x4){PKW(pB1,0),PKW(pB1,2),PKW(pB1,4),PKW(pB1,6)};pw3=(u32x4){PKW(pB1,8),PKW(pB1,10),PKW(pB1,12),PKW(pB1,14)};
    SBAR(); pv(o,vb0+sl_cur,PAF(0),PAF(1),PAF(2),PAF(3)); }
  #undef PKW
  #undef PAF
  #undef VFR
  #undef PIN
  #undef MX3
  #undef GAPA
  #undef GAPB
  #undef EX
  #undef VRD
  #undef KRD
  #undef STEP
  #undef ENDW
  {auto rr=__builtin_amdgcn_permlane32_swap(__float_as_uint(l_reg),__float_as_uint(l_reg),false,false);l_reg=__uint_as_float(rr[0])+__uint_as_float(rr[1]);}
  if(hi==0)wsf[32+r32]=l_reg;asm volatile("s_waitcnt lgkmcnt(0)":::"memory");
  float rli[16];
  #pragma unroll
  for(int r=0;r<16;++r)rli[r]=__builtin_amdgcn_rcpf(wsf[32+crow(r,hi)]);
  bf16*Ow=O+(rowbase+q0+wid*QBLK)*(long)OPITCH+OCOL0+h*D;
  { bf16*stg=(bf16*)(shm+LDS_OST)+wid*2048;
    #pragma unroll
    for(int r=0;r<16;++r){const int orow=crow(r,hi);
      #pragma unroll
      for(int d0=0;d0<2;++d0)stg[orow*64+d0*32+r32]=__float2bfloat16(o[d0][r]*rli[r]);}
    asm volatile("s_waitcnt lgkmcnt(0)":::"memory");
    #pragma unroll
    for(int i=0;i<4;++i){const int row=i*8+(lane>>3),ch=lane&7; const u32x4 v=*(const u32x4*)(stg+row*64+ch*8); bf16*gp=Ow+(long)row*OPITCH+ch*8; const u32x4 gt=*(const u32x4*)gp; if(!dry){ATTN_STORE16(gp,mul_bf16x8(v,gt));}} }
  asm volatile("s_waitcnt lgkmcnt(0)\n\ts_barrier":::"memory");
  #undef DMA_K
  #undef DMA_V
  #undef CMASK
  #undef START
  #undef RESC
  #undef ROT
  #undef SETM
}
constexpr int ATTN_LDS_BYTES=LDS_BYTES;
#undef SBAR
#undef WAIT_BAR
}
constexpr int BATCH = 4, SEQ = 8192, DMODEL = 1024, M = BATCH * SEQ, DEPTH = 2, INC = 7852;
constexpr int NT_A = 19, NT_B = 12, NTILES = NT_A + NT_B;
constexpr int SA_Q = 0, SA_K = 512, SA_V = 640, SA_G = 768, SB_Q = 1280, SB_K = 1792, SB_V = 1920, SB_IQ = 2048, SB_IK = 2176, SB_IW = 2208, SB_G = 2212,
              SC_Q = 2724, SC_K = 3236, SC_V = 3748, SC_F = 4260, SC_G = 4268, S_MG = 4780;
static_assert(S_MG + 3072 == INC, "column partition");
__host__ __device__ __forceinline__ int src_col(int t, int lc) {
    switch (t) {
        case 0: case 1: return SA_Q + t * 256 + lc;
        case 2: case 3: return SB_Q + (t - 2) * 256 + lc;
        case 4: case 5: return SC_Q + (t - 4) * 256 + lc;
        case 6: return lc < 128 ? SA_K + lc : SB_K + lc - 128;
        case 7: case 8: return SC_K + (t - 7) * 256 + lc;
        case 9: return lc < 128 ? SA_V + lc : SB_V + lc - 128;
        case 10: case 11: return SC_V + (t - 10) * 256 + lc;
        case 12: case 13: return SA_G + (t - 12) * 256 + lc;
        case 14: case 15: return SB_G + (t - 14) * 256 + lc;
        case 16: case 17: return SC_G + (t - 16) * 256 + lc;
        case 18: return lc < 128 ? SB_IQ + lc : lc < 160 ? SB_IK + lc - 128 : lc < 164 ? SB_IW + lc - 160 : lc < 172 ? SC_F + lc - 164 : -1;
        default: return S_MG + (t - 19) * 256 + lc;
    }
}
constexpr size_t MiB = 1u << 20;
constexpr size_t WS_CTL = 0, CTL_ZERO_BYTES = 1 * MiB;
constexpr size_t WS_W1T = 2 * MiB;
constexpr size_t WS_WBT = 33 * MiB;
constexpr size_t WS_WOT = 39 * MiB;
constexpr size_t WS_SSQ = 43 * MiB;
constexpr size_t WS_CL = 45 * MiB;
constexpr size_t WS_CT = 46 * MiB;
constexpr size_t WS_IW = 47 * MiB;
constexpr size_t WS_CF = 47 * MiB + 512 * 1024;
constexpr size_t WS_IQ = 49 * MiB;
constexpr size_t WS_IK = 57 * MiB;
constexpr size_t WS_XB = 60 * MiB;
constexpr size_t WS_MERGED = 124 * MiB;
constexpr size_t WS_G = 188 * MiB;
constexpr size_t WS_QA = 284 * MiB, WS_QB = 316 * MiB, WS_QC = 348 * MiB, WS_KC = 380 * MiB, WS_VC = 412 * MiB, WS_KAB = 444 * MiB, WS_VAB = 460 * MiB;
constexpr size_t WS_MG = 284 * MiB;
constexpr size_t WS_END = 476 * MiB;
static_assert(pg8::EWS_CL == WS_CL && pg8::EWS_CT == WS_CT && pg8::EWS_SSQ == WS_SSQ && pg8::EWS_IW == WS_IW && pg8::EWS_CF == WS_CF && pg8::EWS_IQ == WS_IQ && pg8::EWS_IK == WS_IK && pg8::EWS_G == WS_G && pg8::EWS_QA == WS_QA && pg8::EWS_QB == WS_QB &&
              pg8::EWS_QC == WS_QC && pg8::EWS_KC == WS_KC && pg8::EWS_VC == WS_VC && pg8::EWS_KAB == WS_KAB && pg8::EWS_VAB == WS_VAB, "epilogue offsets");
constexpr int CW_OVF = 8;
constexpr int CW_TICK = 8192;
constexpr int CW_BAR = 4096;
constexpr int RING_OFF = 0, RING_BYTES = 131072;
constexpr int SEL_OFF = 131072;
constexpr int H2_OFF = SEL_OFF + 8192;
constexpr int BIAS_OFF = H2_OFF + 8192;
constexpr int BKT_OFF = BIAS_OFF + 2048;
constexpr int MISC_OFF = BKT_OFF + 512;
constexpr int LDS_BYTES = 155648;
static_assert(MISC_OFF + 1024 <= LDS_BYTES, "LDS map");
constexpr int NB_OFF = 86016;
static_assert(attn_body::ATTN_LDS_BYTES <= NB_OFF && NB_OFF + 32768 <= RING_BYTES, "LDS map");
constexpr int MW_NSEL = 0, MW_NCAND = 16, MW_BIN = 32, MW_ABOVE = 48, MW_CARRY = 64, MW_BAR = 96, MW_SLOW = 100, MW_TICKET = 101, MW_ZCUT = 112, MW_UC = 128, MW_ELO = 160;

#define GAS __attribute__((address_space(1)))
#define LAS __attribute__((address_space(3)))
typedef unsigned short bf16;
typedef unsigned v4u __attribute__((ext_vector_type(4)));
typedef float f32x4 __attribute__((ext_vector_type(4)));
typedef short bf16x8 __attribute__((ext_vector_type(8)));
typedef GAS unsigned gu32;
#define RLX_AGENT __ATOMIC_RELAXED, __HIP_MEMORY_SCOPE_AGENT
#define LDS_WAIT() asm volatile("s_waitcnt lgkmcnt(0)" ::: "memory")
#define VM_WAIT() asm volatile("s_waitcnt vmcnt(0)" ::: "memory")
__device__ __forceinline__ unsigned f2bf(float f) { unsigned u = __builtin_bit_cast(unsigned, f); return (u + 0x7fffu + ((u >> 16) & 1u)) >> 16; }
__device__ __forceinline__ unsigned pk2(float lo, float hi) { return f2bf(lo) | (f2bf(hi) << 16); }

#define XB_TMO      128
#define XB_XCNT(j)  (256  + 64 * (j))
#define XB_XSUB(j)  (1280 + 64 * (j))
#define XB_XGEN(j)  (2304 + 64 * (j))
#define XB_TOP      3328
#define XB_TOPGEN   3392
#define XCD_BAR_WORDS 3456
#define XB_SPIN_CAP (1u << 18)

__device__ __forceinline__ unsigned xb_ld(unsigned* p)              { return __hip_atomic_load(p, __ATOMIC_RELAXED, __HIP_MEMORY_SCOPE_AGENT); }
__device__ __forceinline__ unsigned xb_add(unsigned* p, unsigned v) { return __hip_atomic_fetch_add(p, v, __ATOMIC_RELAXED, __HIP_MEMORY_SCOPE_AGENT); }
__device__ __forceinline__ unsigned xb_xcc_id() { return (unsigned)__builtin_amdgcn_s_getreg((3 << 11) | 20) & 0xFu; }
#define XB_SPIN(cond, bar) do { unsigned _sp = 0; while (cond) { __builtin_amdgcn_s_sleep(1); \
    if ((++_sp & 255u) == 0u) { if (xb_ld(&(bar)[XB_TMO])) break; if (_sp > XB_SPIN_CAP) { atomicAdd(&(bar)[XB_TMO], 1u); break; } } } } while (0)

struct XcdBarrier {
    unsigned* bar; unsigned x;
    volatile LAS unsigned* st;
};

__device__ __forceinline__ XcdBarrier xcd_barrier_post(unsigned* bar, volatile LAS unsigned* st) {
    XcdBarrier b; b.bar = bar; b.x = xb_xcc_id(); b.st = st;
    if (threadIdx.x == 0) (void)xb_add(&bar[XB_XCNT(b.x)], 1u);
    return b;
}
__device__ __forceinline__ void xcd_barrier_complete(unsigned* bar, unsigned x, unsigned& nloc, unsigned& nx) {
    const unsigned G = gridDim.x * gridDim.y * gridDim.z;
    unsigned sum, cnt, mine, sp = 0u;
    for (;;) {
        sum = 0u; cnt = 0u; mine = 0u;
#pragma unroll
        for (unsigned j = 0; j < 16; ++j) { const unsigned c = xb_ld(&bar[XB_XCNT(j)]); sum += c; cnt += (c > 0u) ? 1u : 0u; mine = (j == x) ? c : mine; }
        if (sum == G) break;
        __builtin_amdgcn_s_sleep(1);
        if ((++sp & 255u) == 0u) { if (xb_ld(&bar[XB_TMO])) break; if (sp > XB_SPIN_CAP) { atomicAdd(&bar[XB_TMO], 1u); break; } }
    }
    nloc = mine > 0u ? mine : 1u; nx = cnt > 0u ? cnt : 1u;
}

__device__ __forceinline__ void xcd_barrier(const XcdBarrier& b) {
    asm volatile("s_waitcnt vmcnt(0)" ::: "memory");
    __syncthreads();
    if (threadIdx.x == 0) {
        unsigned* bar = b.bar;
        __builtin_amdgcn_s_waitcnt(0);
        unsigned nloc = b.st[0], nx = b.st[1];
        if (nloc == 0u) { xcd_barrier_complete(bar, b.x, nloc, nx); b.st[0] = nloc; b.st[1] = nx; }
        const unsigned old = xb_add(&bar[XB_XSUB(b.x)], 1u);
        const unsigned gen = old / nloc;
        if (old + 1u == (gen + 1u) * nloc) {
            __builtin_amdgcn_fence(__ATOMIC_RELEASE, "agent");
            asm volatile("s_waitcnt vmcnt(0)" ::: "memory");
            const unsigned og = xb_add(&bar[XB_TOP], 1u);
            const unsigned tg = og / nx;
            if (og + 1u == (tg + 1u) * nx) xb_add(&bar[XB_TOPGEN], 1u);
            else XB_SPIN(xb_ld(&bar[XB_TOPGEN]) == tg, bar);
            __builtin_amdgcn_fence(__ATOMIC_ACQUIRE, "agent");
            xb_add(&bar[XB_XGEN(b.x)], 1u);
            asm volatile("s_waitcnt vmcnt(0)" ::: "memory");
        } else {
            XB_SPIN(xb_ld(&bar[XB_XGEN(b.x)]) == gen, bar);
            __builtin_amdgcn_fence(__ATOMIC_ACQUIRE, "agent");
            asm volatile("s_waitcnt vmcnt(0)" ::: "memory");
        }
    }
    __syncthreads();
}

struct Frame {
    LAS unsigned char* lds;
    volatile LAS unsigned* MISC;
    gu32* ctl;
    int tid, lane, wave, vcu, G;
};
__device__ __forceinline__ float wave_sum(float v) {
#pragma unroll
    for (int o = 1; o < 64; o <<= 1) v += __shfl_xor(v, o);
    return v;
}
__device__ __forceinline__ float wave_incl_scan(float v, int lane) {
#pragma unroll
    for (int o = 1; o < 64; o <<= 1) { const float t = __shfl_up(v, o); if (lane >= o) v += t; }
    return v;
}
__device__ __forceinline__ int wave_incl_scan_i(int v, int lane) {
#pragma unroll
    for (int o = 1; o < 64; o <<= 1) { const int t = __shfl_up(v, o); if (lane >= o) v += t; }
    return v;
}
__device__ __forceinline__ void transpose_item(const float* W, int N, bf16* WT, int K, int n0, int k0, int scol, const float* kscale, LAS float* scr, int lane) {
#pragma unroll 8
    for (int i = 0; i < 32; ++i) { const int kk = 2 * i + (lane >> 5); float v = 0.f;
        if (scol >= 0) { v = W[(size_t)(k0 + kk) * N + scol]; if (kscale) v *= kscale[k0 + kk]; }
        scr[kk * 33 + (lane & 31)] = v; }
    LDS_WAIT(); asm volatile("" ::: "memory");
    const int c = lane & 7;
#pragma unroll
    for (int j = 0; j < 4; ++j) { const int n = (lane >> 3) + 8 * j; const LAS float* s = scr + (8 * c) * 33 + n;
        v4u o; o.x = pk2(s[0 * 33], s[1 * 33]); o.y = pk2(s[2 * 33], s[3 * 33]); o.z = pk2(s[4 * 33], s[5 * 33]); o.w = pk2(s[6 * 33], s[7 * 33]);
        *(GAS v4u*)(WT + (size_t)(n0 + n) * K + k0 + 8 * c) = o; }
    LDS_WAIT(); asm volatile("" ::: "memory");
}
__device__ __forceinline__ void p0_prologue(Frame& F, const float* x, const float* norm_gain, const float* w_in, const float* w_branch, const float* w_out, unsigned char* ws) {
    LAS float* scr = (LAS float*)(F.lds + RING_OFF + F.wave * 16384);
    const int gw = F.vcu * 8 + F.wave, NGW = F.G * 8, lane = F.lane;
    constexpr int I_W1 = 16 * (NTILES * 256 / 32), I_WB = 8 * 32, I_WO = 16 * 32;
    constexpr int NITEMS = DEPTH * I_W1 + DEPTH * 3 * I_WB + DEPTH * I_WO;
    for (int it = gw; it < NITEMS; it += NGW) {
        int r = it;
        if (r < DEPTH * I_W1) { const int L = r / I_W1; r -= L * I_W1; const int nblk = NTILES * 8, kb = r / nblk, nb = r % nblk, n0 = nb * 32, tile = n0 >> 8, p = (n0 & 255) + (lane & 31);
            const int lc = 64 * ((p >> 5) & 3) + 32 * (p >> 7) + (p & 31);
            transpose_item(w_in + (size_t)L * DMODEL * INC, INC, (bf16*)(ws + WS_W1T) + (size_t)L * NTILES * 256 * 1024, 1024, n0, kb * 64, src_col(tile, lc), norm_gain + L * DMODEL, scr, lane); continue; }
        r -= DEPTH * I_W1;
        if (r < DEPTH * 3 * I_WB) { const int mat = r / I_WB; r -= mat * I_WB; const int kb = r / 32, nb = r % 32;
            transpose_item(w_branch + (size_t)mat * 512 * 1024, 1024, (bf16*)(ws + WS_WBT) + (size_t)mat * 1024 * 512, 512, nb * 32, kb * 64, nb * 32 + (lane & 31), nullptr, scr, lane); continue; }
        r -= DEPTH * 3 * I_WB;
        { const int L = r / I_WO; r -= L * I_WO; const int kb = r / 32, nb = r % 32;
            transpose_item(w_out + (size_t)L * 1024 * 1024, 1024, (bf16*)(ws + WS_WOT) + (size_t)L * 1024 * 1024, 1024, nb * 32, kb * 64, nb * 32 + (lane & 31), nullptr, scr, lane); }
    }
    bf16* XB = (bf16*)(ws + WS_XB); float* SSQ = (float*)(ws + WS_SSQ);
    for (int m = gw; m < M; m += NGW) {
        const GAS f32x4* xr = (const GAS f32x4*)(x + (size_t)m * DMODEL) + lane; f32x4 v[4]; float s = 0.f;
#pragma unroll
        for (int j = 0; j < 4; ++j) { v[j] = xr[64 * j]; s += (v[j].x * v[j].x + v[j].y * v[j].y) + (v[j].z * v[j].z + v[j].w * v[j].w); }
        const float tot = wave_sum(s);
        GAS unsigned long long* o8 = (GAS unsigned long long*)(XB + (size_t)m * DMODEL) + lane;
#pragma unroll
        for (int j = 0; j < 4; ++j) o8[64 * j] = (unsigned long long)pk2(v[j].x, v[j].y) | ((unsigned long long)pk2(v[j].z, v[j].w) << 32);
        if (lane < 16) SSQ[(size_t)m * 16 + lane] = lane == 0 ? tot : 0.f;
    }
}
__device__ __forceinline__ void scan_phase(Frame& F, const float* CF, const float* bforget  , float* CL, float* CT) {
    const int lane = F.lane, h = F.wave;
    for (int u = blockIdx.x; u < 128; u += F.G) { const int b = u >> 5, j = u & 31; const size_t row = (size_t)b * SEQ + 256 * j + 4 * lane; const float bf = bforget[h];
        float s[4]; float run = 0.f;
#pragma unroll
        for (int e = 0; e < 4; ++e) { const float xx = CF[(row + e) * 8 + h] + bf; const float lf = (xx < 0.f ? xx : 0.f) - __logf(1.0f + __expf(-fabsf(xx))); run += lf; s[e] = run; }
        const float incl = wave_incl_scan(run, lane), excl = incl - run;
        *(f32x4*)(CL + (size_t)(b * 8 + h) * SEQ + 256 * j + 4 * lane) = (f32x4){excl + s[0], excl + s[1], excl + s[2], excl + s[3]};
        if (lane == 63) CT[(b * 8 + h) * 32 + j] = incl;
    }
}
#ifndef REP_IDX
#define REP_IDX 1
#endif
#ifndef REP_SPB
#define REP_SPB 1
#endif
#ifndef REP_SPA
#define REP_SPA 1
#endif
typedef unsigned u32x2 __attribute__((ext_vector_type(2)));
constexpr int NBIN = 1024;
__device__ __forceinline__ float pdist(float s, float sc, float inv) { return (s - sc) * inv + 0.0f; }
__device__ __forceinline__ unsigned pbin_d(float d) { const unsigned a = __float_as_uint(d) & 0x7fffffffu;
    int fx = (int)(a >> 19) - 1647; fx = fx < 0 ? 0 : (fx > 511 ? 511 : fx);
    return (__float_as_uint(d) >> 31) ? 511u - (unsigned)fx : 512u + (unsigned)fx; }
__device__ __forceinline__ unsigned pbin(float s, float sc, float inv) { return pbin_d(pdist(s, sc, inv)); }
__device__ __forceinline__ float pedge(int b) {
    if (b >= NBIN) return INFINITY; if (b <= 0) return -INFINITY;
    if (b > 512) return __uint_as_float((unsigned)(b - 512 + 1647) << 19);
    if (b == 512) return 0.0f;
    return -__uint_as_float(((unsigned)(511 - b + 1648) << 19) - 1u);
}
constexpr int CMAX = 1024;
#define LDS_ADD(p, v) __hip_atomic_fetch_add((p), (v), __ATOMIC_RELAXED, __HIP_MEMORY_SCOPE_WORKGROUP)
__device__ __forceinline__ unsigned okey(float s) { const unsigned u = __float_as_uint(s); return (u & 0x80000000u) ? ~u : (u | 0x80000000u); }
struct BAParams { const bf16 *IQ, *IK; const float* IW; const bf16 *QA, *QB, *KAB, *VAB; bf16* G; const float* sinks; };
__device__ __forceinline__ float relu_f(float x) { const int i = __float_as_int(x); return __int_as_float(i > 0 ? i : 0); }

template <int PASS, bool DIAG> __device__ __forceinline__ void idx_tile(const bf16x8 ak, const bf16x8 (&bq)[4], const f32x4 w4, int kt, int g4, int r, int tq, float elo, float ehi,
                                                                       LAS unsigned* hl, unsigned lp, unsigned hinc, LAS u32x2* cand, LAS unsigned short* sel, LAS unsigned* misc, LAS unsigned* zh, int zcut, float sc, float inv) {
    const f32x4 z = {0.f, 0.f, 0.f, 0.f};
    const f32x4 d0 = __builtin_amdgcn_mfma_f32_16x16x32_bf16(ak, bq[0], z, 0, 0, 0), d1 = __builtin_amdgcn_mfma_f32_16x16x32_bf16(ak, bq[1], z, 0, 0, 0),
                d2 = __builtin_amdgcn_mfma_f32_16x16x32_bf16(ak, bq[2], z, 0, 0, 0), d3 = __builtin_amdgcn_mfma_f32_16x16x32_bf16(ak, bq[3], z, 0, 0, 0);
    float sv[4]; bool qs[4], qc[4]; unsigned n1 = 0, n2 = 0;
#pragma unroll
    for (int i = 0; i < 4; ++i) {
        float s = 0.f; s = fmaf(w4[0], relu_f(d0[i]), s); s = fmaf(w4[1], relu_f(d1[i]), s); s = fmaf(w4[2], relu_f(d2[i]), s); s = fmaf(w4[3], relu_f(d3[i]), s);
        const int key = 16 * kt + 4 * g4 + i; sv[i] = s; const bool ok = !DIAG || key <= tq; const float d = pdist(s, sc, inv);
        if (PASS == 1) { if (ok) { const unsigned bin = pbin_d(d); LDS_ADD(hl + (bin * 32u + (lp ^ (bin & 31u))), hinc); if (s == 0.0f) LDS_ADD(zh + (key >> 7), 1u); } }
        else { qs[i] = ok && d >= ehi; qc[i] = ok && !(d >= ehi) && d >= elo && (s != 0.0f || key < zcut)  ;
               n1 += qs[i] ? 1u : 0u; n2 += qc[i] ? 1u : 0u; }
    }
    if (PASS == 2) {
        const unsigned add = n1 | (n2 << 16);
        if (add) { const unsigned pos = LDS_ADD(misc + MW_NSEL + r, add); unsigned p1 = pos & 0xffffu, p2 = pos >> 16;
#pragma unroll
            for (int i = 0; i < 4; ++i) { const int key = 16 * kt + 4 * g4 + i;
                if (qs[i]) { if (p1 < 256u) sel[p1] = (unsigned short)key; ++p1; }
                if (qc[i]) { if (p2 < (unsigned)CMAX) cand[p2] = (u32x2){okey(sv[i]), (unsigned)key}; ++p2; } } }
    }
}
template <int PASS> __device__ __forceinline__ void idx_pass(Frame& F, const bf16* IKb, const bf16x8 (&bq)[4], const f32x4 w4, int tau, int t0) {
    int lane_ = F.lane; asm volatile("" : "+v"(lane_)); const int lane = lane_, r = lane & 15, g4 = lane >> 4, tq = t0 + r;
    LAS unsigned* hl = (LAS unsigned*)(F.lds + RING_OFF); const unsigned lp = (unsigned)lane >> 1, hinc = 1u << ((lane & 1) * 16);
    LAS u32x2* cand = (LAS u32x2*)(F.lds + RING_OFF) + r * CMAX;
    LAS unsigned short* sel = (LAS unsigned short*)(F.lds + SEL_OFF) + r * 256;
    LAS unsigned* misc = (LAS unsigned*)(F.lds + MISC_OFF);
    float elo = 0.f, ehi = 0.f; int zcut = SEQ; if (PASS == 2) { elo = __uint_as_float(misc[MW_ELO + r]); ehi = __uint_as_float(misc[MW_ELO + 16 + r]); zcut = (int)misc[MW_ZCUT + r]; }
    LAS unsigned* zh = (LAS unsigned*)(F.lds + H2_OFF) + r * 64;
    const bf16* kp = IKb + (size_t)r * 32 + 8 * g4;
    float sc, inv; { const bf16x8 at = *(const bf16x8*)kp; const f32x4 z = {0.f, 0.f, 0.f, 0.f};
        const f32x4 d0 = __builtin_amdgcn_mfma_f32_16x16x32_bf16(at, bq[0], z, 0, 0, 0), d1 = __builtin_amdgcn_mfma_f32_16x16x32_bf16(at, bq[1], z, 0, 0, 0),
                    d2 = __builtin_amdgcn_mfma_f32_16x16x32_bf16(at, bq[2], z, 0, 0, 0), d3 = __builtin_amdgcn_mfma_f32_16x16x32_bf16(at, bq[3], z, 0, 0, 0);
        float mx = -INFINITY, ma = 0.f;
#pragma unroll
        for (int i = 0; i < 4; ++i) { float s = 0.f; s = fmaf(w4[0], relu_f(d0[i]), s); s = fmaf(w4[1], relu_f(d1[i]), s); s = fmaf(w4[2], relu_f(d2[i]), s); s = fmaf(w4[3], relu_f(d3[i]), s); mx = fmaxf(mx, s); ma = fmaxf(ma, fabsf(s)); }
        mx = fmaxf(mx, __shfl_xor(mx, 16)); mx = fmaxf(mx, __shfl_xor(mx, 32)); ma = fmaxf(ma, __shfl_xor(ma, 16)); ma = fmaxf(ma, __shfl_xor(ma, 32));
        sc = mx; inv = (ma > 1e-30f && ma < 1e30f) ? 1.0f / ma : 1.0f;
        if (PASS == 1 && F.wave == 0 && g4 == 0) { misc[MW_UC + r] = __float_as_uint(sc); misc[MW_UC + 16 + r] = __float_as_uint(inv); } }
    int kt = F.wave; if (kt > tau) return;
    bf16x8 a0 = *(const bf16x8*)(kp + (size_t)kt * 512);
    bf16x8 a1 = *(const bf16x8*)(kp + (size_t)(kt + 8 <= tau ? kt + 8 : kt) * 512);
    for (; kt <= tau; kt += 8) {
        const int k2 = kt + 16 <= tau ? kt + 16 : kt; const bf16x8 a2 = *(const bf16x8*)(kp + (size_t)k2 * 512);
        if (kt < tau) idx_tile<PASS, false>(a0, bq, w4, kt, g4, r, tq, elo, ehi, hl, lp, hinc, cand, sel, misc, zh, zcut, sc, inv);
        else          idx_tile<PASS, true>(a0, bq, w4, kt, g4, r, tq, elo, ehi, hl, lp, hinc, cand, sel, misc, zh, zcut, sc, inv);
        a0 = a1; a1 = a2;
    }
}
__device__ __forceinline__ void idx_threshold(Frame& F) {
    int lane_ = F.lane; asm volatile("" : "+v"(lane_)); const int lane = lane_; LAS unsigned* misc = (LAS unsigned*)(F.lds + MISC_OFF);
    for (int qq = 0; qq < 2; ++qq) { const int q = 2 * F.wave + qq; const unsigned sh = (q & 1) * 16, qh = (unsigned)q >> 1;
        const LAS unsigned* hb = (const LAS unsigned*)(F.lds + RING_OFF);
        int cnt[16];
#pragma unroll
        for (int k = 0; k < 16; ++k) { const unsigned bin = 64u * k + lane, sw = bin & 31u; const LAS unsigned* p = hb + bin * 32u;
            cnt[k] = (int)(((p[qh ^ sw] >> sh) & 0xffffu) + ((p[(qh + 8u) ^ sw] >> sh) & 0xffffu) + ((p[(qh + 16u) ^ sw] >> sh) & 0xffffu) + ((p[(qh + 24u) ^ sw] >> sh) & 0xffffu)); }
        int a8[8], a4[4], a2[2], a1;
        { const bool h5 = lane & 32, h4 = lane & 16, h3 = lane & 8, h2 = lane & 4;
#pragma unroll
          for (int i = 0; i < 8; ++i) { const int mine = h5 ? cnt[8 + i] : cnt[i], theirs = h5 ? cnt[i] : cnt[8 + i]; a8[i] = mine + __shfl_xor(theirs, 32); }
#pragma unroll
          for (int i = 0; i < 4; ++i) { const int mine = h4 ? a8[4 + i] : a8[i], theirs = h4 ? a8[i] : a8[4 + i]; a4[i] = mine + __shfl_xor(theirs, 16); }
#pragma unroll
          for (int i = 0; i < 2; ++i) { const int mine = h3 ? a4[2 + i] : a4[i], theirs = h3 ? a4[i] : a4[2 + i]; a2[i] = mine + __shfl_xor(theirs, 8); }
          { const int mine = h2 ? a2[1] : a2[0], theirs = h2 ? a2[0] : a2[1]; a1 = mine + __shfl_xor(theirs, 4); }
          a1 += __shfl_xor(a1, 1); a1 += __shfl_xor(a1, 2); }
        int ks = 0, aseg = 0, v = cnt[0]; { int cum = 0; bool found = false;
#pragma unroll
            for (int k = 15; k >= 0; --k) { const int Tk = __builtin_amdgcn_readlane(a1, 4 * k); if (!found && cum + Tk >= 256) { found = true; ks = k; aseg = cum; v = cnt[k]; } cum += Tk; } }
        const int pre = wave_incl_scan_i(v, lane);
        int tot = pre; tot = __shfl(tot, 63);
        const int suf = tot - pre + v;
        const unsigned long long mask = __ballot(aseg + suf >= 256);
        const int Ls = mask ? 63 - (int)__builtin_clzll(mask) : 0;
        if (lane == Ls) { const int bs = 64 * ks + lane; misc[MW_BIN + q] = (unsigned)bs; misc[MW_ABOVE + q] = (unsigned)(aseg + suf - v);
                          misc[MW_ELO + q] = __float_as_uint(pedge(bs)); misc[MW_ELO + 16 + q] = __float_as_uint(pedge(bs + 1)); }
        { const int binstar = __shfl(64 * ks + lane, Ls), needz = 256 - __shfl(aseg + suf - v, Ls);
          const int zc = (int)((const LAS unsigned*)(F.lds + H2_OFF))[q * 64 + lane]; const int zi = wave_incl_scan_i(zc, lane);
          const unsigned long long zm = __ballot(zi >= needz);
          if (lane == 0) misc[MW_ZCUT + q] = (binstar == (int)pbin(0.0f, __uint_as_float(misc[MW_UC + q]), __uint_as_float(misc[MW_UC + 16 + q])) && zm) ? (unsigned)(128 * ((int)__builtin_ctzll(zm) + 1)) : (unsigned)SEQ; }
    }
}
__device__ __forceinline__ unsigned idx_digit(const u32x2 e, int lvl) { const unsigned v = 8191u - e.y;
    return lvl == 0 ? e.x >> 24 : lvl == 1 ? (e.x >> 16) & 255u : lvl == 2 ? (e.x >> 8) & 255u : lvl == 3 ? e.x & 255u : lvl == 4 ? (v >> 5) & 255u : v & 31u; }
__device__ __forceinline__ void idx_resolve(Frame& F) {
    int lane_ = F.lane; asm volatile("" : "+v"(lane_)); const int lane = lane_; LAS unsigned* misc = (LAS unsigned*)(F.lds + MISC_OFF);
    LAS unsigned* h2 = (LAS unsigned*)(F.lds + H2_OFF) + F.wave * 256;
    for (int qq = 0; qq < 2; ++qq) { const int q = 2 * F.wave + qq;
        const unsigned packed = misc[MW_NSEL + q];
        if (lane == 0) misc[MW_NSEL + q] = packed & 0xffffu;
        int c = (int)(packed >> 16); if (c > CMAX) { c = CMAX; if (lane == 0) __hip_atomic_fetch_add(F.ctl + CW_OVF, 1u, RLX_AGENT); }
        int need = 256 - (int)misc[MW_ABOVE + q];
        LAS u32x2* cq = (LAS u32x2*)(F.lds + RING_OFF) + q * CMAX;
        LAS unsigned short* sel = (LAS unsigned short*)(F.lds + SEL_OFF) + q * 256;
        if (c > need && c <= 64) {
            u32x2 e = {0u, 0u}; if (lane < c) e = cq[lane]; int rank = 0;
            for (int j = 0; j < c; ++j) { const unsigned uj = (unsigned)__builtin_amdgcn_readlane((int)e.x, j), ij = (unsigned)__builtin_amdgcn_readlane((int)e.y, j); rank += (uj > e.x || (uj == e.x && ij < e.y)) ? 1 : 0; }
            if (lane < c && rank < need) { const unsigned pos = LDS_ADD(misc + MW_NSEL + q, 1u); if (pos < 256u) sel[pos] = (unsigned short)e.y; }
            c = 0; need = 0;
        }
#pragma unroll 1
        for (int lvl = 0; lvl < 6 && c > need; ++lvl) {
            *(LAS v4u*)(h2 + 4 * lane) = (v4u){0u, 0u, 0u, 0u};
            for (int i = lane; i < c; i += 64) LDS_ADD(h2 + idx_digit(cq[i], lvl), 1u);
            const v4u hw = *(const LAS v4u*)(h2 + 252 - 4 * lane);
            const int total = (int)(hw.x + hw.y + hw.z + hw.w), incl = wave_incl_scan_i(total, lane);
            const unsigned long long mask = __ballot(incl >= need);
            const int Ls = mask ? (int)__builtin_ctzll(mask) : 63;
            int dstar_l = 0, above_l = 0; { int cum = incl - total; bool found = false;
#pragma unroll
                for (int e = 3; e >= 0; --e) { const int cc = (int)hw[e]; if (!found && cum + cc >= need) { found = true; dstar_l = 252 - 4 * lane + e; above_l = cum; } cum += cc; } }
            const unsigned dstar = (unsigned)__shfl(dstar_l, Ls); const int above = __shfl(above_l, Ls);
            int c2 = 0;
            for (int base = 0; base < c; base += 64) { const int i = base + lane; const bool valid = i < c; u32x2 e = {0u, 0u}; if (valid) e = cq[i];
                const unsigned dg = idx_digit(e, lvl); const bool tie = valid && dg == dstar;
                if (valid && dg > dstar) { const unsigned pos = LDS_ADD(misc + MW_NSEL + q, 1u); if (pos < 256u) sel[pos] = (unsigned short)e.y; }
                const unsigned long long tm = __ballot(tie);
                if (tie) cq[c2 + __popcll(tm & ((1ull << lane) - 1ull))] = e;
                c2 += __popcll(tm); }
            c = c2; need -= above;
        }
        for (int i = lane; i < c && i < need; i += 64) { const unsigned pos = LDS_ADD(misc + MW_NSEL + q, 1u); if (pos < 256u) sel[pos] = (unsigned short)cq[i].y; }
    }
}
typedef short s16x4 __attribute__((ext_vector_type(4)));
__device__ __forceinline__ void sp_glds16(const void* gsrc, unsigned lds_dst) { unsigned keep;
    asm volatile("s_mov_b32 %0, m0\n\ts_mov_b32 m0, %2\n\ts_nop 0\n\tglobal_load_lds_dwordx4 %1, off\n\ts_mov_b32 m0, %0" : "=&s"(keep) : "v"(gsrc), "s"(lds_dst) : "memory"); }
__device__ __forceinline__ void sp_glds16s(const void* sbase, unsigned voff, unsigned lds_dst) { unsigned keep;
    asm volatile("s_mov_b32 %0, m0\n\ts_mov_b32 m0, %3\n\ts_nop 0\n\tglobal_load_lds_dwordx4 %1, %2\n\ts_mov_b32 m0, %0" : "=&s"(keep) : "v"(voff), "s"(sbase), "s"(lds_dst) : "memory"); }
template <bool IS_A> __device__ __forceinline__ void sparse_pair(Frame& F, const BAParams& P, int rb, int tA, int qi0, int nv0, int nv1, bool dry) {
    constexpr int NC = IS_A ? 8 : 16, NSLOT = NC * 16, KOFF = IS_A ? 0 : M * 128, HB = IS_A ? 0 : 8, GOFF = IS_A ? 0 : 512;
    int lane_ = F.lane; asm volatile("" : "+v"(lane_)); const int lane = lane_, r = lane & 15, g4 = lane >> 4, my_a = g4 >> 1, my_j = g4 & 1;
    const bf16* Q = IS_A ? P.QA : P.QB;
    const LAS unsigned short* sel = (const LAS unsigned short*)(F.lds + SEL_OFF) + qi0 * 256;
    const LAS float* BIAS = (const LAS float*)(F.lds + BIAS_OFF);
    const LAS unsigned char* BKT = (const LAS unsigned char*)(F.lds + BKT_OFF);
    LAS unsigned short* Pimg = (LAS unsigned short*)(F.lds + RING_OFF + F.wave * 16384);
    bf16x8 q0, q1; const bf16x8 zz = {0, 0, 0, 0, 0, 0, 0, 0};
    { const int a_r = r >> 3, hd = r & 7; const bf16* qp = Q + (size_t)(rb + tA + a_r) * 512 + hd * 64 + 8 * g4; q0 = *(const bf16x8*)qp; q1 = *(const bf16x8*)(qp + 32); }
    const int my_t = tA + my_a, rcb = r >> 2;
    f32x4 x[NC];
#pragma unroll
    for (int c = 0; c < NC; ++c) x[c] = (f32x4){0.f, 0.f, 0.f, 0.f};
    constexpr int KS = NSLOT / 32, NST = 4 * KS;
    const unsigned wk = (unsigned)__builtin_amdgcn_readfirstlane((int)((unsigned)(uintptr_t)(F.lds + RING_OFF) + (unsigned)F.wave * 16384u));
    const int drow = lane >> 3, dpc = lane & 7;
#define SP_KDMA(st, bufi) do { const int cb_ = (st) / KS, ks_ = (st) % KS, a_ = cb_ >> 1, j_ = cb_ & 1; const unsigned dst_ = wk + (unsigned)((bufi) * 4096); \
        _Pragma("unroll") for (int i_ = 0; i_ < 4; ++i_) { const int slot_ = 32 * ks_ + 8 * i_ + drow; int key_; \
            if (IS_A) { key_ = tA + a_ - slot_; key_ = key_ < 0 ? 0 : key_; } else { key_ = sel[a_ * 256 + slot_]; }   \
            sp_glds16s(P.KAB, (unsigned)(((rb + key_) * 128 + KOFF + j_ * 64 + ((dpc ^ (drow & 7)) * 8)) * 2), (unsigned)__builtin_amdgcn_readfirstlane((int)(dst_ + i_ * 1024))); } } while (0)
    asm volatile("s_waitcnt vmcnt(0)" ::: "memory");
    SP_KDMA(0, 0); SP_KDMA(1, 1); SP_KDMA(2, 2); if (NST > 3) SP_KDMA(3, 3);
    { const LAS unsigned char* kring = F.lds + RING_OFF + F.wave * 16384;
      int kbuf = 0;
#pragma unroll 1
      for (int st = 0; st < NST; ++st) {
        if (st + 3 < NST) asm volatile("s_waitcnt vmcnt(12)" ::: "memory"); else if (st + 2 < NST) asm volatile("s_waitcnt vmcnt(8)" ::: "memory"); else if (st + 1 < NST) asm volatile("s_waitcnt vmcnt(4)" ::: "memory"); else asm volatile("s_waitcnt vmcnt(0)" ::: "memory");
        const int cb = st / KS, ks = st % KS; const bool mine = rcb == cb; const bf16x8 a0 = mine ? q0 : zz, a1 = mine ? q1 : zz;
        const LAS unsigned char* kb = kring + kbuf * 4096;
        bf16x8 f[2][2];
#pragma unroll
        for (int cc = 0; cc < 2; ++cc)
#pragma unroll
            for (int k2 = 0; k2 < 2; ++k2) f[cc][k2] = *(const LAS bf16x8*)(kb + (16 * cc + r) * 128 + (((4 * k2 + g4) ^ (r & 7)) * 16));
        asm volatile("s_waitcnt lgkmcnt(0)" ::: "memory");
#pragma unroll
        for (int k8 = 0; k8 < KS; ++k8) if (k8 == ks) {
#pragma unroll
            for (int cc = 0; cc < 2; ++cc) { x[2 * k8 + cc] = __builtin_amdgcn_mfma_f32_16x16x32_bf16(a0, f[cc][0], x[2 * k8 + cc], 0, 0, 0); x[2 * k8 + cc] = __builtin_amdgcn_mfma_f32_16x16x32_bf16(a1, f[cc][1], x[2 * k8 + cc], 0, 0, 0); } }
        if (st + 4 < NST) SP_KDMA(st + 4, kbuf);
        kbuf = (kbuf + 1) & 3;
      } }
#undef SP_KDMA
#pragma unroll
    for (int c = 0; c < NC; ++c) { const int slot = 16 * c + r; int mk; bool mv;
        if (IS_A) { mk = my_t - slot; mv = mk >= 0; } else { mk = sel[my_a * 256 + slot]; mv = slot < (my_a ? nv1 : nv0); }
        const int delta = my_t - mk; const bool ok = mv && delta >= 0;
        const int bk = (ok && delta < 512) ? (int)BKT[delta] : 31;
        const f32x4 b4 = *(const LAS f32x4*)(BIAS + bk * 16 + HB + 4 * my_j);
#pragma unroll
        for (int i = 0; i < 4; ++i) x[c][i] = ok ? x[c][i] * 0.125f + b4[i] : -INFINITY; }
    f32x4 mx = x[0];
#pragma unroll
    for (int c = 1; c < NC; ++c)
#pragma unroll
        for (int i = 0; i < 4; ++i) mx[i] = fmaxf(mx[i], x[c][i]);
#pragma unroll
    for (int o = 1; o < 16; o <<= 1)
#pragma unroll
        for (int i = 0; i < 4; ++i) mx[i] = fmaxf(mx[i], __shfl_xor(mx[i], o));
    f32x4 sk = {0.f, 0.f, 0.f, 0.f};
    if (IS_A) { sk = *(const f32x4*)(P.sinks + 4 * my_j);
#pragma unroll
        for (int i = 0; i < 4; ++i) mx[i] = fmaxf(mx[i], sk[i]); }
    f32x4 sum = {0.f, 0.f, 0.f, 0.f};
#pragma unroll
    for (int c = 0; c < NC; ++c)
#pragma unroll
        for (int i = 0; i < 4; ++i) { x[c][i] = __expf(x[c][i] - mx[i]); sum[i] += x[c][i]; }
#pragma unroll
    for (int o = 1; o < 16; o <<= 1)
#pragma unroll
        for (int i = 0; i < 4; ++i) sum[i] += __shfl_xor(sum[i], o);
    if (IS_A) {
#pragma unroll
        for (int i = 0; i < 4; ++i) sum[i] += __expf(sk[i] - mx[i]); }
    f32x4 inv;
#pragma unroll
    for (int i = 0; i < 4; ++i) inv[i] = 1.0f / sum[i];
#define SP_PWRITE(qa) do { if (my_a == (qa)) { _Pragma("unroll") for (int c_ = 0; c_ < NC; ++c_) _Pragma("unroll") for (int i_ = 0; i_ < 4; ++i_) \
        Pimg[(4 * my_j + i_) * NSLOT + 16 * c_ + r] = (unsigned short)f2bf(x[c_][i_] * inv[i_]); } } while (0)
    SP_PWRITE(0);
    const unsigned wl = wk + 4096u;
#define SP_VDMA(st, bufi) do { const int cb_ = (st) / KS, ks_ = (st) % KS, a_ = cb_ >> 1, j_ = cb_ & 1; const unsigned dst_ = wl + (unsigned)((bufi) * 4096); \
        _Pragma("unroll") for (int i_ = 0; i_ < 4; ++i_) { const int slot_ = 32 * ks_ + 8 * i_ + drow; int key_; \
            if (IS_A) { key_ = tA + a_ - slot_; key_ = key_ < 0 ? 0 : key_; } else { key_ = sel[a_ * 256 + slot_]; } \
            sp_glds16s(P.VAB, (unsigned)(((rb + key_) * 128 + KOFF + j_ * 64 + dpc * 8) * 2), (unsigned)__builtin_amdgcn_readfirstlane((int)(dst_ + i_ * 1024))); } } while (0)
    asm volatile("s_waitcnt vmcnt(0)" ::: "memory");
    SP_VDMA(0, 0); SP_VDMA(1, 1); SP_VDMA(2, 2);
    f32x4 o[4];
#pragma unroll
    for (int db = 0; db < 4; ++db) o[db] = (f32x4){0.f, 0.f, 0.f, 0.f};
    const unsigned trb = (unsigned)((8 * g4 + ((lane & 15) >> 2)) * 128 + (lane & 3) * 8);
    int bufi = 0;
#pragma unroll 1
    for (int st = 0; st < NST; ++st) {
        if (st == NST / 2) { SP_PWRITE(1); }
        if (st + 2 < NST) asm volatile("s_waitcnt vmcnt(8)" ::: "memory"); else if (st + 1 < NST) asm volatile("s_waitcnt vmcnt(4)" ::: "memory"); else asm volatile("s_waitcnt vmcnt(0)" ::: "memory");
        const int cb = st / KS, ks = st % KS; const unsigned vb = wl + (unsigned)(bufi * 4096) + trb;
        s16x4 lo[4], hi[4];
#pragma unroll
        for (int db = 0; db < 4; ++db) {
            asm volatile("ds_read_b64_tr_b16 %0, %1 offset:%c2" : "=&v"(lo[db]) : "v"(vb), "i"(db * 32) : "memory");
            asm volatile("ds_read_b64_tr_b16 %0, %1 offset:%c2" : "=&v"(hi[db]) : "v"(vb), "i"(db * 32 + 512) : "memory"); }
        bf16x8 pb = *(const LAS bf16x8*)(Pimg + (r & 7) * NSLOT + 32 * ks + 8 * g4);
        pb = (rcb == cb) ? pb : zz;
        asm volatile("s_waitcnt lgkmcnt(0)" ::: "memory");
#pragma unroll
        for (int db = 0; db < 4; ++db) { const bf16x8 va = {lo[db][0], lo[db][1], lo[db][2], lo[db][3], hi[db][0], hi[db][1], hi[db][2], hi[db][3]};
            o[db] = __builtin_amdgcn_mfma_f32_16x16x32_bf16(va, pb, o[db], 0, 0, 0); }
        if (st + 3 < NST) SP_VDMA(st + 3, bufi);
        bufi = bufi == 2 ? 0 : bufi + 1;
    }
#undef SP_VDMA
#undef SP_PWRITE
    if (!dry) { bf16* gp = P.G + (size_t)(rb + tA + (r >> 3)) * 1536 + GOFF + (r & 7) * 64 + 4 * g4;
#pragma unroll
        for (int db = 0; db < 4; ++db) { const u32x2 gt = *(const u32x2*)(gp + 16 * db);
            const float g0 = __uint_as_float(gt.x << 16), g1 = __uint_as_float(gt.x & 0xffff0000u), g2 = __uint_as_float(gt.y << 16), g3 = __uint_as_float(gt.y & 0xffff0000u);
            u32x2 w; w.x = pk2(o[db][0] * g0, o[db][1] * g1); w.y = pk2(o[db][2] * g2, o[db][3] * g3);
            *(u32x2*)(gp + 16 * db) = w; } }
}
__device__ __forceinline__ void swa_dense(Frame& F, const BAParams& P, int rb, int t0, bool dry) {
    constexpr int NC = 10, NSLOT = 160, NST = 5;
    int lane_ = F.lane; asm volatile("" : "+v"(lane_)); const int lane = lane_, r = lane & 15, g4 = lane >> 4, j = F.wave >> 2, qg = F.wave & 3, kbase = t0 - 128;
    const LAS float* BIAS = (const LAS float*)(F.lds + BIAS_OFF);
    const LAS unsigned char* BKT = (const LAS unsigned char*)(F.lds + BKT_OFF);
    LAS unsigned short* Pimg = (LAS unsigned short*)(F.lds + RING_OFF + F.wave * 16384);
    bf16x8 qf[2]; { const bf16* qp = P.QA + (size_t)(rb + t0 + 4 * qg + (r >> 2)) * 512 + (4 * j + (r & 3)) * 64 + 8 * g4; qf[0] = *(const bf16x8*)qp; qf[1] = *(const bf16x8*)(qp + 32); }
    bf16x8 kf[NC][2];
#pragma unroll
    for (int c = 0; c < NC; ++c) { int key = kbase + 16 * c + r; key = key < 0 ? 0 : (key > SEQ - 1 ? SEQ - 1 : key);
        const bf16* kp = P.KAB + (size_t)(rb + key) * 128 + j * 64 + 8 * g4; kf[c][0] = *(const bf16x8*)kp; kf[c][1] = *(const bf16x8*)(kp + 32); }
    const int my_t = t0 + 4 * qg + g4;
    f32x4 x[NC];
#pragma unroll
    for (int c = 0; c < NC; ++c) { f32x4 d = {0.f, 0.f, 0.f, 0.f};
        d = __builtin_amdgcn_mfma_f32_16x16x32_bf16(qf[0], kf[c][0], d, 0, 0, 0); d = __builtin_amdgcn_mfma_f32_16x16x32_bf16(qf[1], kf[c][1], d, 0, 0, 0);
        const int key = kbase + 16 * c + r, delta = my_t - key; const bool ok = key >= 0 && delta >= 0 && delta < 128;
        const int bk = (int)BKT[ok ? delta : 0];
        const f32x4 b4 = *(const LAS f32x4*)(BIAS + bk * 16 + 4 * j);
#pragma unroll
        for (int i = 0; i < 4; ++i) x[c][i] = ok ? d[i] * 0.125f + b4[i] : -INFINITY; }
    f32x4 mx = *(const f32x4*)(P.sinks + 4 * j); const f32x4 sk = mx;
#pragma unroll
    for (int c = 0; c < NC; ++c)
#pragma unroll
        for (int i = 0; i < 4; ++i) mx[i] = fmaxf(mx[i], x[c][i]);
#pragma unroll
    for (int o = 1; o < 16; o <<= 1)
#pragma unroll
        for (int i = 0; i < 4; ++i) mx[i] = fmaxf(mx[i], __shfl_xor(mx[i], o));
    f32x4 sum = {0.f, 0.f, 0.f, 0.f};
#pragma unroll
    for (int c = 0; c < NC; ++c)
#pragma unroll
        for (int i = 0; i < 4; ++i) { x[c][i] = __expf(x[c][i] - mx[i]); sum[i] += x[c][i]; }
#pragma unroll
    for (int o = 1; o < 16; o <<= 1)
#pragma unroll
        for (int i = 0; i < 4; ++i) sum[i] += __shfl_xor(sum[i], o);
    f32x4 inv;
#pragma unroll
    for (int i = 0; i < 4; ++i) inv[i] = 1.0f / (sum[i] + __expf(sk[i] - mx[i]));
#pragma unroll
    for (int c = 0; c < NC; ++c)
#pragma unroll
        for (int i = 0; i < 4; ++i) Pimg[(4 * g4 + i) * NSLOT + 16 * c + r] = (unsigned short)f2bf(x[c][i] * inv[i]);
    const unsigned wl = (unsigned)__builtin_amdgcn_readfirstlane((int)((unsigned)(uintptr_t)(F.lds + RING_OFF) + (unsigned)F.wave * 16384u + 8192u));
    const int drow = lane >> 3, dpc = lane & 7;
#define SW_VDMA(st) do { const unsigned dst_ = wl + (unsigned)(((st) & 1) * 4096); \
        _Pragma("unroll") for (int i_ = 0; i_ < 4; ++i_) { int key_ = kbase + 32 * (st) + 8 * i_ + drow; key_ = key_ < 0 ? 0 : (key_ > SEQ - 1 ? SEQ - 1 : key_); \
            sp_glds16s(P.VAB, (unsigned)(((rb + key_) * 128 + j * 64 + dpc * 8) * 2), (unsigned)__builtin_amdgcn_readfirstlane((int)(dst_ + i_ * 1024))); } } while (0)
    asm volatile("s_waitcnt vmcnt(0)" ::: "memory");
    SW_VDMA(0); SW_VDMA(1);
    f32x4 o[4];
#pragma unroll
    for (int db = 0; db < 4; ++db) o[db] = (f32x4){0.f, 0.f, 0.f, 0.f};
    const unsigned trb = (unsigned)((8 * g4 + ((lane & 15) >> 2)) * 128 + (lane & 3) * 8);
#pragma unroll 1
    for (int st = 0; st < NST; ++st) {
        if (st + 1 < NST) asm volatile("s_waitcnt vmcnt(4)" ::: "memory"); else asm volatile("s_waitcnt vmcnt(0)" ::: "memory");
        const unsigned vb = wl + (unsigned)((st & 1) * 4096) + trb;
        s16x4 lo[4], hi[4];
#pragma unroll
        for (int db = 0; db < 4; ++db) {
            asm volatile("ds_read_b64_tr_b16 %0, %1 offset:%c2" : "=&v"(lo[db]) : "v"(vb), "i"(db * 32) : "memory");
            asm volatile("ds_read_b64_tr_b16 %0, %1 offset:%c2" : "=&v"(hi[db]) : "v"(vb), "i"(db * 32 + 512) : "memory"); }
        const bf16x8 pb = *(const LAS bf16x8*)(Pimg + r * NSLOT + 32 * st + 8 * g4);
        asm volatile("s_waitcnt lgkmcnt(0)" ::: "memory");
#pragma unroll
        for (int db = 0; db < 4; ++db) { const bf16x8 va = {lo[db][0], lo[db][1], lo[db][2], lo[db][3], hi[db][0], hi[db][1], hi[db][2], hi[db][3]};
            o[db] = __builtin_amdgcn_mfma_f32_16x16x32_bf16(va, pb, o[db], 0, 0, 0); }
        if (st + 2 < NST) SW_VDMA(st + 2);
    }
#undef SW_VDMA
    if (!dry) { bf16* gp = P.G + (size_t)(rb + t0 + 4 * qg + (r >> 2)) * 1536 + (4 * j + (r & 3)) * 64 + 4 * g4;
#pragma unroll
        for (int db = 0; db < 4; ++db) { const u32x2 gt = *(const u32x2*)(gp + 16 * db);
            const float g0 = __uint_as_float(gt.x << 16), g1 = __uint_as_float(gt.x & 0xffff0000u), g2 = __uint_as_float(gt.y << 16), g3 = __uint_as_float(gt.y & 0xffff0000u);
            u32x2 w; w.x = pk2(o[db][0] * g0, o[db][1] * g1); w.y = pk2(o[db][2] * g2, o[db][3] * g3);
            *(u32x2*)(gp + 16 * db) = w; } }
}
__device__ __forceinline__ void ba_clear(Frame& F) {
    LAS v4u* hz = (LAS v4u*)(F.lds + RING_OFF + F.wave * 16384);
#pragma unroll
    for (int i = 0; i < 16; ++i) hz[F.lane + 64 * i] = (v4u){0u, 0u, 0u, 0u};
    if (F.tid < 32) ((LAS unsigned*)(F.lds + MISC_OFF))[F.tid] = 0u;
    for (int i = F.tid; i < 16 * 64; i += 512) ((LAS unsigned*)(F.lds + H2_OFF))[i] = 0u;
}
__device__ __forceinline__ void ba_unit(Frame& F, const BAParams& P, int b, int tau, bool dry) {
    { int l_ = (int)__builtin_amdgcn_mbcnt_hi(~0u, __builtin_amdgcn_mbcnt_lo(~0u, 0u)); asm volatile("" : "+v"(l_)); F.lane = l_; F.tid = F.wave * 64 + l_; }
    const int t0 = tau * 16, rb = b * SEQ, lane = F.lane;
    LAS unsigned* misc = (LAS unsigned*)(F.lds + MISC_OFF);
    for (int ri = 0; ri < REP_IDX; ++ri)
    if (tau >= 16) {
        if (ri) { __syncthreads(); ba_clear(F); __syncthreads(); }
        bf16x8 bq[4]; const int r = lane & 15, g4 = lane >> 4;
#pragma unroll
        for (int h = 0; h < 4; ++h) bq[h] = *(const bf16x8*)(P.IQ + (size_t)(rb + t0 + r) * 128 + h * 32 + 8 * g4);
        const f32x4 w4 = *(const f32x4*)(P.IW + (size_t)(rb + t0 + r) * 4);
        const bf16* IKb = P.IK + (size_t)rb * 32;
        idx_pass<1>(F, IKb, bq, w4, tau, t0);
        __syncthreads();
        idx_threshold(F);
        __syncthreads();
        idx_pass<2>(F, IKb, bq, w4, tau, t0);
        __syncthreads();
        idx_resolve(F);
    } else {
        LAS unsigned short* sel = (LAS unsigned short*)(F.lds + SEL_OFF);
        for (int i = F.tid; i < 16 * 256; i += 512) sel[i] = (unsigned short)(i & 255);
    }
    __syncthreads();
    const int tA = t0 + 2 * F.wave, nv0 = tA >= 256 ? 256 : tA + 1, nv1 = tA + 1 >= 256 ? 256 : tA + 2;
    for (int rs = 0; rs < REP_SPB; ++rs) sparse_pair<false>(F, P, rb, tA, 2 * F.wave, nv0, nv1, dry || rs + 1 < REP_SPB);
    for (int rs = 0; rs < REP_SPA; ++rs) swa_dense(F, P, rb, t0, dry || rs + 1 < REP_SPA);
    ba_clear(F);
}

#ifndef REP_P1A
#define REP_P1A 1
#endif
#ifndef REP_C
#define REP_C 1
#endif
#ifndef REP_BA
#define REP_BA 1
#endif
#ifndef REP_P1B
#define REP_P1B 1
#endif
#ifndef REP_P3
#define REP_P3 1
#endif
#ifndef REP_P0
#define REP_P0 1
#endif
#ifndef FOX_SKIP_LOG2
#define FOX_SKIP_LOG2 (-80.0f)
#endif
#ifndef MK_ONE_LAUNCH
#define MK_ONE_LAUNCH 1
#endif
constexpr int NPHASES = 1 + 6 * DEPTH;
struct Args { const float* in[9]; float* out; unsigned char* ws; int ph_lo, ph_hi; };
static_assert(sizeof(Args) == 9 * 8 + 8 + 8 + 4 + 4, "no padding bytes in the argument struct");

typedef const __attribute__((address_space(4))) Args* ArgP;
__device__ __forceinline__ ArgP argp() { ArgP p = (ArgP)__builtin_amdgcn_kernarg_segment_ptr(); asm volatile("" : "+s"(p)); return p; }
__global__ void __launch_bounds__(512, 2) mk_fwd(Args args) {
    extern __shared__ __attribute__((aligned(16))) unsigned char lds[];
    Frame F;
    F.lds = (LAS unsigned char*)lds;
    F.MISC = (volatile LAS unsigned*)(F.lds + MISC_OFF);
    F.tid = threadIdx.x; F.lane = F.tid & 63; F.wave = __builtin_amdgcn_readfirstlane(F.tid >> 6);
    F.G = gridDim.x; { const int bx = blockIdx.x; F.vcu = (F.G % 8 == 0) ? (bx % 8) * (F.G / 8) + bx / 8 : bx; }
    F.ctl = (gu32*)(argp()->ws + WS_CTL);
    for (int u = F.tid; u < 256; u += 512) ((LAS unsigned*)(F.lds + MISC_OFF))[u] = 0u;
    for (int u = F.tid; u < 512; u += 512) { ((LAS float*)(F.lds + BIAS_OFF))[u] = argp()->in[8][u];
        int bk; if (u < 16) bk = u; else { const float nf = (float)u; int lg = 16 + (int)(logf(nf / 16.0f) / 3.4657359027997265f * 16.0f); bk = lg < 31 ? lg : 31; }
        ((LAS unsigned char*)(F.lds + BKT_OFF))[u] = (unsigned char)bk; }
    __syncthreads();
    XcdBarrier bar; bar.bar = (unsigned*)(F.ctl + CW_BAR); bar.x = 0; bar.st = nullptr;
    if (MK_ONE_LAUNCH) bar = xcd_barrier_post((unsigned*)(F.ctl + CW_BAR), F.MISC + MW_BAR);
    const int lo = argp()->ph_lo, hi = argp()->ph_hi;
#define IN(k) (lo <= (k) && (k) < hi)
#define SEAM(k) do { if (IN(k) && IN((k) + 1)) xcd_barrier(bar); } while (0)
#define PHASE_BEGIN() do { int l_ = (int)__builtin_amdgcn_mbcnt_hi(~0u, __builtin_amdgcn_mbcnt_lo(~0u, 0u)); asm volatile("" : "+v"(l_)); F.lane = l_; F.tid = F.wave * 64 + l_; } while (0)

    if (IN(0)) { PHASE_BEGIN(); ArgP a = argp(); for (int rp = 0; rp < REP_P0; ++rp) p0_prologue(F, a->in[0], a->in[1], a->in[2], a->in[6], a->in[7], a->ws); SEAM(0); }

    for (int L = 0; L < DEPTH; ++L) {
        const int pb = 1 + 6 * L;
        if (IN(pb)) { PHASE_BEGIN();
            unsigned char* ws = argp()->ws; const pg8::bf16_t* W1T = (const pg8::bf16_t*)(ws + WS_W1T) + (size_t)L * NTILES * 256 * 1024;
            pg8::Gemm g{(const pg8::bf16_t*)(ws + WS_XB), W1T, M, NT_A * 256, 1024, 1024, 1024, 0}; pg8::StaticOrder S; S.init(M, NT_A * 256, F.G, (int)blockIdx.x);
            pg8::EpiIn E{ws, argp()->in[4] + L * 384, argp()->in[3] + L * 8};
            for (int rp = 0; rp < REP_P1A; ++rp) pg8::gemm_phase<pg8::EpiIn, pg8::StaticOrder, true, true>(F.lds + RING_OFF, g, S, E, F.wave);
            SEAM(pb);
        }
        if (IN(pb + 2)) { PHASE_BEGIN();
            unsigned char* ws = argp()->ws;
            const float* CL = (const float*)(ws + WS_CL); const float* CT = (const float*)(ws + WS_CT);
            LAS float* carry = (LAS float*)(F.lds + H2_OFF)  ; LAS unsigned* nbw = (LAS unsigned*)(F.lds + RING_OFF + NB_OFF);
            for (int rp = 0; rp < REP_C; ++rp) {
            LAS unsigned* miscw = (LAS unsigned*)(F.lds + MISC_OFF);
            for (int kg = 0; kg < 8; ++kg) { const int xg = ((F.vcu >> 5) + kg) & 7;
            gu32* const tick = F.ctl + CW_TICK + 64 * (8 * (2 * L + rp % 2) + xg);
            if (F.tid == 0) miscw[MW_TICKET] = __hip_atomic_fetch_add(tick, 1u, RLX_AGENT);
            __syncthreads();
            for (;;) {
                PHASE_BEGIN();
                const int ui = (int)miscw[MW_TICKET];
                if (ui >= 128) { __syncthreads(); break; }
                const int qb = 31 - (ui >> 2), bh = 4 * xg + (ui & 3);
                    if (F.wave == 0) { const float t0 = CT[bh * 128 + 2 * F.lane], t1 = CT[bh * 128 + 2 * F.lane + 1]; const float inc = wave_incl_scan(t0 + t1, F.lane); carry[2 * F.lane] = inc - (t0 + t1); carry[2 * F.lane + 1] = inc - t1; }
                    __syncthreads();
                    const float cref = carry[4 * qb]; int tskip;
                    { const float* gq = argp()->in[4] + L * 384 + 256; const float g1 = fabsf(gq[F.lane]), g2 = fabsf(gq[64 + F.lane]); float mq = g1, mk = g2;
#pragma unroll
                      for (int o = 1; o < 64; o <<= 1) { mq = fmaxf(mq, __shfl_xor(mq, o)); mk = fmaxf(mk, __shfl_xor(mk, o)); }
                      const float thr = FOX_SKIP_LOG2 - 2.0f * (11.8f * mq * mk + 0.5f);
                      const int NTt = 4 * (qb + 1); const int t_a = F.lane, t_b = 64 + F.lane, k_a = 64 * t_a + 63, k_b = 64 * t_b + 63;
                      const float n_a = t_a < NTt ? (cref - (carry[k_a >> 6] + CL[(size_t)bh * SEQ + k_a])) * 1.4426950408889634f : 0.f, n_b = t_b < NTt ? (cref - (carry[k_b >> 6] + CL[(size_t)bh * SEQ + k_b])) * 1.4426950408889634f : 0.f;
                      const bool s_a = t_a < NTt && n_a < thr, s_b = t_b < NTt && n_b < thr;
                      const unsigned long long f_a = __ballot(!s_a), f_b = __ballot(!s_b);
                      int cnt = f_a ? (int)__builtin_ctzll(f_a) : 64 + (f_b ? (int)__builtin_ctzll(f_b) : 64);
                      cnt &= ~1; tskip = cnt > NTt - 4 ? NTt - 4 : cnt; }
                    { const int nk = 256 * (qb + 1);
                      for (int k = 64 * tskip + F.tid; k < nk; k += 512) { const float xb = (cref - (carry[k >> 6] + CL[(size_t)bh * SEQ + k])) * 1.4426950408889634f;
                          const unsigned h = f2bf(xb), l = f2bf(xb - __uint_as_float(h << 16)); nbw[k] = h | (l << 16); } }
                    __syncthreads();
                    attn_body::attn_unit<8>(bh >> 3, bh & 7, qb, (const attn_body::bf16*)(ws + WS_QC), (const attn_body::bf16*)(ws + WS_KC), (const attn_body::bf16*)(ws + WS_VC), (attn_body::bf16*)(ws + WS_G),
                                            (char*)lds + RING_OFF, (attn_body::lds_cuptr)(F.lds + RING_OFF + NB_OFF), tskip, rp + 1 < REP_C, F.wave);
                if (F.tid == 0) miscw[MW_TICKET] = __hip_atomic_fetch_add(tick, 1u, RLX_AGENT);
                __syncthreads();
            } } }
            __syncthreads(); PHASE_BEGIN();
            const BAParams P{(const bf16*)(ws + WS_IQ), (const bf16*)(ws + WS_IK), (const float*)(ws + WS_IW), (const bf16*)(ws + WS_QA), (const bf16*)(ws + WS_QB), (const bf16*)(ws + WS_KAB), (const bf16*)(ws + WS_VAB),
                             (bf16*)(ws + WS_G), argp()->in[5] + L * 8};
            for (int rp = 0; rp < REP_BA; ++rp) {
            LAS unsigned* miscw = (LAS unsigned*)(F.lds + MISC_OFF);
            for (int kg = 0; kg < 4; ++kg) { const int bq = ((F.vcu >> 6) + kg) & 3;
            gu32* const tick = F.ctl + CW_TICK + 64 * (32 + 4 * (2 * L + rp % 2) + bq);
            ba_clear(F);
            if (F.tid == 0) miscw[MW_TICKET] = __hip_atomic_fetch_add(tick, 1u, RLX_AGENT);
            __syncthreads();
            for (;;) {
                PHASE_BEGIN();
                const int ui = (int)miscw[MW_TICKET];
                if (ui >= 512) { __syncthreads(); break; }
                ba_unit(F, P, bq, 511 - ui, rp + 1 < REP_BA);
                if (F.tid == 0) miscw[MW_TICKET] = __hip_atomic_fetch_add(tick, 1u, RLX_AGENT);
                __syncthreads();
            } } }
            SEAM(pb + 2);
        }
        if (IN(pb + 3)) { PHASE_BEGIN();
            unsigned char* ws = argp()->ws; const pg8::bf16_t* W1T = (const pg8::bf16_t*)(ws + WS_W1T) + (size_t)L * NTILES * 256 * 1024;
            pg8::Gemm g{(const pg8::bf16_t*)(ws + WS_XB), W1T + (size_t)NT_A * 256 * 1024, M, NT_B * 256, 1024, 1024, 1024, 0}; pg8::StaticOrder S; S.init(M, NT_B * 256, F.G, (int)blockIdx.x);
            pg8::EpiGate E{(const float*)(ws + WS_SSQ), (unsigned char*)(ws + WS_MG)};
            for (int rp = 0; rp < REP_P1B; ++rp) pg8::gemm_phase<pg8::EpiGate, pg8::StaticOrder, true, true>(F.lds + RING_OFF, g, S, E, F.wave);
            SEAM(pb + 3);
        }
        if (IN(pb + 4)) { PHASE_BEGIN();
            unsigned char* ws = argp()->ws;
            pg8::Gemm g{(const pg8::bf16_t*)(ws + WS_G), (const pg8::bf16_t*)(ws + WS_WBT) + (size_t)L * 3 * 1024 * 512, M, 1024, 512, 1536, 512, 4};
            pg8::SegOrder S; S.base.init(M, 1024, F.G, (int)blockIdx.x);
            pg8::EpiMerge E{(const unsigned char*)(ws + WS_MG), (pg8::bf16_t*)(ws + WS_MERGED)};
            for (int rp = 0; rp < REP_P3; ++rp) pg8::gemm_phase<pg8::EpiMerge, pg8::SegOrder, true, true>(F.lds + RING_OFF, g, S, E, F.wave);
            SEAM(pb + 4);
        }
        if (IN(pb + 5)) { PHASE_BEGIN();
            unsigned char* ws = argp()->ws; float* const outp = argp()->out;
            pg8::Gemm g{(const pg8::bf16_t*)(ws + WS_MERGED), (const pg8::bf16_t*)(ws + WS_WOT) + (size_t)L * 1024 * 1024, M, 1024, 1024, 1024, 1024, 0}; pg8::StaticOrder S; S.init(M, 1024, F.G, (int)blockIdx.x);
            const bool last = (L == DEPTH - 1);
            unsigned poison = 0u;
            if (last) poison = (__hip_atomic_load(F.ctl + CW_OVF, RLX_AGENT) != 0u) | (__hip_atomic_load(F.ctl + CW_BAR + XB_TMO, RLX_AGENT) != 0u);
            pg8::EpiOut E{L == 0 ? argp()->in[0] : (const float*)outp, outp, last ? nullptr : (pg8::bf16_t*)(ws + WS_XB), last ? nullptr : (float*)(ws + WS_SSQ), poison};
            pg8::gemm_phase<pg8::EpiOut, pg8::StaticOrder, true, true>(F.lds + RING_OFF, g, S, E, F.wave);
            if (!last) SEAM(pb + 5);
        }
    }
#undef IN
#undef SEAM
}

extern "C" void kernel_launch(void* const* d_in, const int* in_sizes, int n_in, void* d_out, int out_size, void* d_ws, size_t ws_size, hipStream_t stream) {
    static int grid = 0;
    if (grid == 0) {
        if (n_in != 9 || in_sizes[0] != M * DMODEL || out_size != M * DMODEL || ws_size < WS_END) { fprintf(stderr, "kernel_launch: unexpected shapes / workspace (n_in %d, in0 %d, out %d, ws %zu < %zu); nothing launched\n", n_in, n_in > 0 ? in_sizes[0] : -1, out_size, ws_size, (size_t)WS_END); grid = -1; return; }
        int dev = 0, cus = 0, per_cu = 0;
        if (hipGetDevice(&dev) != hipSuccess || hipDeviceGetAttribute(&cus, hipDeviceAttributeMultiprocessorCount, dev) != hipSuccess) { grid = -1; return; }
        if (hipFuncSetAttribute((const void*)mk_fwd, hipFuncAttributeMaxDynamicSharedMemorySize, LDS_BYTES) != hipSuccess) { fprintf(stderr, "kernel_launch: hipFuncSetAttribute failed\n"); grid = -1; return; }
        if (hipOccupancyMaxActiveBlocksPerMultiprocessor(&per_cu, (const void*)mk_fwd, 512, LDS_BYTES) != hipSuccess || per_cu < 1) fprintf(stderr, "kernel_launch: occupancy query reports %d workgroups per CU\n", per_cu);
        (void)hipGetLastError();
        grid = cus;
    }
    if (grid < 0) return;
    if (hipMemsetAsync((char*)d_ws + WS_CTL, 0, CTL_ZERO_BYTES, stream) != hipSuccess) return;
    Args a{};
    for (int i = 0; i < 9; ++i) a.in[i] = (const float*)d_in[i];
    a.out = (float*)d_out; a.ws = (unsigned char*)d_ws;
#if MK_ONE_LAUNCH
    a.ph_lo = 0; a.ph_hi = NPHASES;
    hipLaunchKernelGGL(mk_fwd, dim3(grid), dim3(512), LDS_BYTES, stream, a);
#else
    for (int p = 0; p < NPHASES; ++p) { a.ph_lo = p; a.ph_hi = p + 1; hipLaunchKernelGGL(mk_fwd, dim3(grid), dim3(512), LDS_BYTES, stream, a); }
#endif
}
```

```cpp
#include <hip/hip_runtime.h>
#include <cstdio>
#include <cstdint>
#include <cmath>
namespace pg8 {
#define PG8_LAS __attribute__((address_space(3)))
typedef unsigned short bf16_t;
typedef short bf16x8 __attribute__((ext_vector_type(8)));
typedef float f32x4 __attribute__((ext_vector_type(4)));
typedef unsigned u32x4 __attribute__((ext_vector_type(4)));
constexpr int BM = 256, BK = 64, HALF = 128, HTB = HALF * BK * 2  , STAGE_BYTES = 8 * HTB, NXCD = 8, WGM = 8;

__host__ __device__ __forceinline__ int lds_byte(int r, int c) { const int st = (r >> 4) * 2 + (c >> 5), rr = r & 15, cc = c & 31, ob = rr * 64 + cc * 2; return st * 1024 + (ob ^ (((ob >> 9) & 1) << 5)); }
__host__ __device__ __forceinline__ void stage_rc(int b, int& R, int& C) { const int st = b / 1024, sb = b % 1024, swz = sb ^ (((sb >> 9) & 1) << 5); R = (st >> 1) * 16 + swz / 64; C = (st & 1) * 32 + (swz % 64) / 2; }
__host__ __device__ __forceinline__ int perm32(int rho) { const int n = rho >> 4, i = rho & 15; return 8 * (i >> 2) + 4 * n + (i & 3); }

struct Unit { int pm, pn, seg; };
struct Gemm { const bf16_t* A; const bf16_t* Bt; int M, N, K, lda, ldb, segN; };

struct StaticOrder {
    int nM, nN, nwg, G, c;
    __host__ __device__ void init(int M, int N, int G_, int c_) { nM = M / BM; nN = N / BM; nwg = nM * nN; G = G_; c = c_; }
    __host__ __device__ bool next(int i, Unit& u) const {
        const long L = (long)i * G + c; if (L >= nwg) return false;
        int wgid = (int)L; { const int q = nwg / NXCD, r = nwg % NXCD, xcd = wgid % NXCD, off = wgid / NXCD; wgid = (xcd < r ? xcd * (q + 1) : r * (q + 1) + (xcd - r) * q) + off; }
        const int nig = WGM * nN, gid = wgid / nig, fm = gid * WGM, gsz = (nM - fm) < WGM ? (nM - fm) : WGM;
        u.pm = fm + ((wgid % nig) % gsz); u.pn = (wgid % nig) / gsz; u.seg = 0; return true;
    }
    __device__ __forceinline__ void a_ready(const Unit&) const {}
    __device__ __forceinline__ void done(const Unit&) const {}
};

__device__ __forceinline__ unsigned cvt_pk_bf16(float lo, float hi) { unsigned r; asm volatile("v_cvt_pk_bf16_f32 %0, %1, %2" : "=v"(r) : "v"(lo), "v"(hi)); return r; }
constexpr size_t EWS_MiB = 1u << 20, EWS_SSQ = 43 * EWS_MiB, EWS_CL = 45 * EWS_MiB, EWS_CT = 46 * EWS_MiB, EWS_IW = 47 * EWS_MiB, EWS_CF = 47 * EWS_MiB + 512 * 1024, EWS_IQ = 49 * EWS_MiB, EWS_IK = 57 * EWS_MiB, EWS_G = 188 * EWS_MiB,
    EWS_QA = 284 * EWS_MiB, EWS_QB = 316 * EWS_MiB, EWS_QC = 348 * EWS_MiB, EWS_KC = 380 * EWS_MiB, EWS_VC = 412 * EWS_MiB, EWS_KAB = 444 * EWS_MiB, EWS_VAB = 460 * EWS_MiB;

constexpr float C2Q = 0.125f * 1.4426950408889634f;
__device__ __forceinline__ float fast_sigmoid(float x) { return __builtin_amdgcn_rcpf(1.0f + __expf(-x)); }
__device__ __forceinline__ u32x4 pack8(const f32x4 a, const f32x4 b) { u32x4 w; w.x = cvt_pk_bf16(a[0], a[1]); w.y = cvt_pk_bf16(a[2], a[3]); w.z = cvt_pk_bf16(b[0], b[1]); w.w = cvt_pk_bf16(b[2], b[3]); return w; }
__device__ __forceinline__ void unpack8(const u32x4 w, f32x4& a, f32x4& b) {
    a[0] = __uint_as_float(w.x << 16); a[1] = __uint_as_float(w.x & 0xffff0000u); a[2] = __uint_as_float(w.y << 16); a[3] = __uint_as_float(w.y & 0xffff0000u);
    b[0] = __uint_as_float(w.z << 16); b[1] = __uint_as_float(w.z & 0xffff0000u); b[2] = __uint_as_float(w.w << 16); b[3] = __uint_as_float(w.w & 0xffff0000u); }
#define EPI_PIN() asm volatile("" ::: "memory")
__device__ __forceinline__ void rows_rstd(const float* ssq, int row0, int fq, float (&rs)[2][4]) {
    f32x4 pr[2][4];
#pragma unroll
    for (int ai = 0; ai < 2; ++ai)
#pragma unroll
        for (int m = 0; m < 4; ++m) pr[ai][m] = *(const f32x4*)(ssq + (size_t)(row0 + ai * HALF + m * 16) * 16 + 4 * fq);
    EPI_PIN();
#pragma unroll
    for (int ai = 0; ai < 2; ++ai)
#pragma unroll
        for (int m = 0; m < 4; ++m) { const f32x4 a = pr[ai][m]; float t = (a[0] + a[1]) + (a[2] + a[3]); t += __shfl_xor(t, 16); t += __shfl_xor(t, 32); rs[ai][m] = __builtin_amdgcn_rsqf(t * (1.0f / 1024.0f) + 1e-6f); }
}
struct EpiIn {
    static constexpr bool PERM = true, AFTER_DRAIN = false;
    unsigned char* ws; const float* qkg; const float* bfg;
    __device__ __forceinline__ bool keep(const Unit&) const { return false; }
    __device__ __forceinline__ void operator()(f32x4 (&acc)[2][2][4][2], const Unit& u, int wr, int wc, int fr, int fq) const {
        const int row0 = u.pm * BM + wr * 64 + fr, t = u.pn, lc0 = wc * 64 + fq * 8;
        float rs[2][4]; rows_rstd((const float*)(ws + EWS_SSQ), row0, fq, rs);
        if (t == 18) {
            bf16_t* IQ = (bf16_t*)(ws + EWS_IQ); bf16_t* IK = (bf16_t*)(ws + EWS_IK); float* IW = (float*)(ws + EWS_IW);
#pragma unroll
            for (int ai = 0; ai < 2; ++ai)
#pragma unroll
                for (int m = 0; m < 4; ++m) { const int row = row0 + ai * HALF + m * 16; const float f = rs[ai][m];
#pragma unroll
                    for (int bj = 0; bj < 2; ++bj) { const int lc = lc0 + 32 * bj; const f32x4 v0 = acc[ai][bj][m][0] * f, v1 = acc[ai][bj][m][1] * f;
                        if (lc < 128) *(u32x4*)(IQ + (size_t)row * 128 + lc) = pack8(v0, v1);
                        else if (lc < 160) *(u32x4*)(IK + (size_t)row * 32 + (lc - 128)) = pack8(v0, v1);
                        else if (lc == 160) *(f32x4*)(IW + (size_t)row * 4) = v0 * 0.08838834764831845f; } }
            int ln_ = (int)__builtin_amdgcn_mbcnt_hi(~0u, __builtin_amdgcn_mbcnt_lo(~0u, 0u)); asm volatile("" : "+v"(ln_));
            if (wc == 2 && (ln_ >> 4) < 2) { const int fql = ln_ >> 4, frl = ln_ & 15;
                float* CL = (float*)(ws + EWS_CL); float* CT = (float*)(ws + EWS_CT); const int hb = 4 * fql; const f32x4 bfv = *(const f32x4*)(bfg + hb);
#pragma unroll
                for (int ai = 0; ai < 2; ++ai) { f32x4 run = {0.f, 0.f, 0.f, 0.f};
#pragma unroll
                    for (int m = 0; m < 4; ++m) { const int row = row0 + ai * HALF + m * 16; const f32x4 z = (fql == 0 ? acc[ai][1][m][1] : acc[ai][1][m][0]) * rs[ai][m] + bfv; f32x4 lf;
#pragma unroll
                        for (int e = 0; e < 4; ++e) lf[e] = (z[e] < 0.f ? z[e] : 0.f) - __logf(1.0f + __expf(-fabsf(z[e])));
#pragma unroll
                        for (int o = 1; o < 16; o <<= 1)
#pragma unroll
                            for (int e = 0; e < 4; ++e) { const float tt = __shfl_up(lf[e], o, 16); if (frl >= o) lf[e] += tt; }
                        const f32x4 cs = lf + run;
                        const int bb = row >> 13, ss = row & 8191;
#pragma unroll
                        for (int e = 0; e < 4; ++e) CL[(size_t)(bb * 8 + hb + e) * 8192 + ss] = cs[e];
#pragma unroll
                        for (int e = 0; e < 4; ++e) run[e] += __shfl(lf[e], 15, 16); }
                    if (frl == 15) { const int row = row0 + ai * HALF, bb = row >> 13, ch = (row & 8191) >> 6;
#pragma unroll
                        for (int e = 0; e < 4; ++e) CT[(bb * 8 + hb + e) * 128 + ch] = run[e]; } } }
            return;
        }
        bf16_t* dst; int ldc, colbase; const float* gp = qkg; float csc = 1.f; bool norm = false, act = false;
        if (t < 6) { const int mx = t >> 1; dst = (bf16_t*)(ws + (mx == 0 ? EWS_QA : (mx == 1 ? EWS_QB : EWS_QC))); ldc = 512; colbase = (t & 1) * 256; norm = true; gp = qkg + (mx * 2 + 0) * 64; csc = (mx == 2) ? C2Q : 1.f; }
        else if (t == 6) { dst = (bf16_t*)(ws + EWS_KAB); ldc = 128; colbase = (wc >> 1) * (32768 * 128 - 128); norm = true;     gp = qkg + ((wc >> 1) * 2 + 1) * 64; }
        else if (t < 9) { dst = (bf16_t*)(ws + EWS_KC); ldc = 512; colbase = (t - 7) * 256; norm = true; gp = qkg + (2 * 2 + 1) * 64; }
        else if (t == 9) { dst = (bf16_t*)(ws + EWS_VAB); ldc = 128; colbase = (wc >> 1) * (32768 * 128 - 128); }
        else if (t < 12) { dst = (bf16_t*)(ws + EWS_VC); ldc = 512; colbase = (t - 10) * 256; }
        else { dst = (bf16_t*)(ws + EWS_G); ldc = 1536; colbase = (t - 12) * 256; act = true; }
        f32x4 gv[2][2];
#pragma unroll
        for (int bj = 0; bj < 2; ++bj)
#pragma unroll
            for (int n = 0; n < 2; ++n) gv[bj][n] = norm ? *(const f32x4*)(gp + 8 * fq + 32 * bj + 4 * n) * csc : (f32x4){1.f, 1.f, 1.f, 1.f};
        EPI_PIN();
#pragma unroll
        for (int ai = 0; ai < 2; ++ai)
#pragma unroll
            for (int m = 0; m < 4; ++m) { const int row = row0 + ai * HALF + m * 16; float f = rs[ai][m];
                if (norm) { float ss = 0.f;
#pragma unroll
                    for (int bj = 0; bj < 2; ++bj)
#pragma unroll
                        for (int n = 0; n < 2; ++n) { const f32x4 x = acc[ai][bj][m][n]; ss += (x[0] * x[0] + x[1] * x[1]) + (x[2] * x[2] + x[3] * x[3]); }
                    ss += __shfl_xor(ss, 16); ss += __shfl_xor(ss, 32);
                    f = f * __builtin_amdgcn_rsqf(f * f * ss * (1.0f / 64.0f) + 1e-6f); }
                bf16_t* rowp = dst + (size_t)row * ldc + colbase + lc0;
#pragma unroll
                for (int bj = 0; bj < 2; ++bj) { f32x4 v0 = acc[ai][bj][m][0] * f * gv[bj][0], v1 = acc[ai][bj][m][1] * f * gv[bj][1];
                    if (act) {
#pragma unroll
                        for (int e = 0; e < 4; ++e) { v0[e] = v0[e] * fast_sigmoid(v0[e]); v1[e] = v1[e] * fast_sigmoid(v1[e]); } }
                    *(u32x4*)(rowp + 32 * bj) = pack8(v0, v1); } }
    }
};
typedef unsigned u32x2e __attribute__((ext_vector_type(2)));
__device__ __forceinline__ unsigned gate_q4(const f32x4 v) { unsigned w = 0u;
    w = __builtin_amdgcn_cvt_pk_u8_f32(fmaxf(255.0f * fast_sigmoid(v[0]), 1.0f), 0, w); w = __builtin_amdgcn_cvt_pk_u8_f32(fmaxf(255.0f * fast_sigmoid(v[1]), 1.0f), 1, w);
    w = __builtin_amdgcn_cvt_pk_u8_f32(fmaxf(255.0f * fast_sigmoid(v[2]), 1.0f), 2, w); w = __builtin_amdgcn_cvt_pk_u8_f32(fmaxf(255.0f * fast_sigmoid(v[3]), 1.0f), 3, w); return w; }
__device__ __forceinline__ f32x4 gate_f4(const unsigned w) { return (f32x4){(float)(w & 0xffu), (float)((w >> 8) & 0xffu), (float)((w >> 16) & 0xffu), (float)(w >> 24)}; }
struct EpiGate {
    static constexpr bool PERM = true, AFTER_DRAIN = false;
    const float* ssq; unsigned char* MG;
    __device__ __forceinline__ bool keep(const Unit&) const { return false; }
    __device__ __forceinline__ void operator()(f32x4 (&acc)[2][2][4][2], const Unit& u, int wr, int wc, int fr, int fq) const {
        const int row0 = u.pm * BM + wr * 64 + fr, lc0 = wc * 64 + fq * 8;
        float rs[2][4]; rows_rstd(ssq, row0, fq, rs);
#pragma unroll
        for (int ai = 0; ai < 2; ++ai)
#pragma unroll
            for (int m = 0; m < 4; ++m) { const int row = row0 + ai * HALF + m * 16; const float f = rs[ai][m];
                unsigned char* rowp = MG + (size_t)row * 3072 + u.pn * BM + lc0;
#pragma unroll
                for (int bj = 0; bj < 2; ++bj) { u32x2e w; w.x = gate_q4(acc[ai][bj][m][0] * f); w.y = gate_q4(acc[ai][bj][m][1] * f); *(u32x2e*)(rowp + 32 * bj) = w; } }
    }
};
struct EpiMerge {
    static constexpr bool PERM = true, AFTER_DRAIN = false;
    const unsigned char* MG; bf16_t* OUT;
    __device__ __forceinline__ bool keep(const Unit& u) const { return u.seg < 2; }
    __device__ __forceinline__ void operator()(f32x4 (&acc)[2][2][4][2], const Unit& u, int wr, int wc, int fr, int fq) const {
        const int row0 = u.pm * BM + wr * 64 + fr, col0 = u.pn * BM + wc * 32 + 8 * fq, seg = u.seg;
#pragma unroll
        for (int ai = 0; ai < 2; ++ai) {
            u32x2e ga[4][2], gb[4][2];
#pragma unroll
            for (int m = 0; m < 4; ++m) { const unsigned char* gp = MG + (size_t)(row0 + ai * HALF + m * 16) * 3072 + seg * 1024 + col0;
#pragma unroll
                for (int bj = 0; bj < 2; ++bj) { ga[m][bj] = *(const u32x2e*)(gp + bj * HALF); gb[m][bj] = seg < 2 ? *(const u32x2e*)(gp + 1024 + bj * HALF) : ga[m][bj]; } }
            EPI_PIN();
#pragma unroll
            for (int m = 0; m < 4; ++m) { const int row = row0 + ai * HALF + m * 16;
#pragma unroll
                for (int bj = 0; bj < 2; ++bj) { f32x4 a0 = gate_f4(ga[m][bj].x), a1 = gate_f4(ga[m][bj].y);
                    if (seg < 2) { const f32x4 b0 = gate_f4(gb[m][bj].x), b1 = gate_f4(gb[m][bj].y);
#pragma unroll
                        for (int e = 0; e < 4; ++e) { a0[e] = a0[e] * __builtin_amdgcn_rcpf(b0[e]); a1[e] = a1[e] * __builtin_amdgcn_rcpf(b1[e]); } }
                    else { a0 = a0 * (1.0f / 255.0f); a1 = a1 * (1.0f / 255.0f); }
                    acc[ai][bj][m][0] = acc[ai][bj][m][0] * a0; acc[ai][bj][m][1] = acc[ai][bj][m][1] * a1;
                    if (seg == 2) *(u32x4*)(OUT + (size_t)row * 1024 + col0 + bj * HALF) = pack8(acc[ai][bj][m][0], acc[ai][bj][m][1]); } }
        }
    }
};
struct EpiOut {
    static constexpr bool PERM = true, AFTER_DRAIN = false;
    const float* resid; float* out; bf16_t* XB; float* ssq; unsigned poison;
    __device__ __forceinline__ bool keep(const Unit&) const { return false; }
    __device__ __forceinline__ void operator()(f32x4 (&acc)[2][2][4][2], const Unit& u, int wr, int wc, int fr, int fq) const {
        const int row0 = u.pm * BM + wr * 64 + fr, col0 = u.pn * BM + wc * 32 + 8 * fq;
#pragma unroll
        for (int ai = 0; ai < 2; ++ai) {
            f32x4 rv[4][2][2];
#pragma unroll
            for (int m = 0; m < 4; ++m)
#pragma unroll
                for (int bj = 0; bj < 2; ++bj) { const size_t o = (size_t)(row0 + ai * HALF + m * 16) * 1024 + col0 + bj * HALF; rv[m][bj][0] = *(const f32x4*)(resid + o); rv[m][bj][1] = *(const f32x4*)(resid + o + 4); }
            EPI_PIN();
#pragma unroll
            for (int m = 0; m < 4; ++m) { const int row = row0 + ai * HALF + m * 16; float ss = 0.f;
#pragma unroll
                for (int bj = 0; bj < 2; ++bj) { const size_t o = (size_t)row * 1024 + col0 + bj * HALF;
                    f32x4 v0 = rv[m][bj][0] + acc[ai][bj][m][0], v1 = rv[m][bj][1] + acc[ai][bj][m][1];
                    if (poison) { const float qn = __builtin_nanf(""); v0 = (f32x4){qn, qn, qn, qn}; v1 = v0; }
                    *(f32x4*)(out + o) = v0; *(f32x4*)(out + o + 4) = v1;
                    if (XB) { *(u32x4*)(XB + o) = pack8(v0, v1); ss += ((v0[0] * v0[0] + v0[1] * v0[1]) + (v0[2] * v0[2] + v0[3] * v0[3])) + ((v1[0] * v1[0] + v1[1] * v1[1]) + (v1[2] * v1[2] + v1[3] * v1[3])); } }
                if (XB) { ss += __shfl_xor(ss, 16); ss += __shfl_xor(ss, 32); if (fq == 0) ssq[(size_t)row * 16 + u.pn * 4 + wc] = ss; } }
            EPI_PIN();
        }
    }
};
struct SegOrder {
    StaticOrder base;
    __device__ __forceinline__ bool next(int i, Unit& u) const { if (!base.next(i / 3, u)) return false; u.seg = i % 3; return true; }
    __device__ __forceinline__ void a_ready(const Unit&) const {}
    __device__ __forceinline__ void done(const Unit&) const {}
};

template <class Epi, class Sched, bool ALIGN_EPI = false, bool SP2 = false>
__device__ __forceinline__ void gemm_phase(PG8_LAS unsigned char* lds, const Gemm g, const Sched& S, const Epi& E, int wave_id) {
    int tid_ = (int)__builtin_amdgcn_mbcnt_hi(~0u, __builtin_amdgcn_mbcnt_lo(~0u, 0u)); asm volatile("" : "+v"(tid_)); tid_ += wave_id * 64;
    const int tid = tid_, wid = __builtin_amdgcn_readfirstlane(tid >> 6), lane = tid & 63, wr = wid >> 2, wc = wid & 3, fr = lane & 15, fq = lane >> 4;
    const int K = g.K, nt = K / BK;
    unsigned voffA[2], voffB[2];
#pragma unroll
    for (int i = 0; i < 2; ++i) { int R, C; stage_rc(tid * 16 + i * 8192, R, C); const int Rb = Epi::PERM ? ((R & ~31) + perm32(R & 31)) : R;
        voffA[i] = (unsigned)(R * g.lda + C) * 2u; voffB[i] = (unsigned)(Rb * g.ldb + C) * 2u; }
    const size_t kstep = (size_t)(BK * 2);
    const size_t hstepA = (size_t)HALF * g.lda * 2, hstepB = (size_t)HALF * g.ldb * 2;
    const size_t tstepA = 2 * hstepA, tstepB = 2 * hstepB, sstepA = (size_t)K * 2;
    const unsigned ldsw = (unsigned)wid * 1024u;
    const int aoff = lds_byte(wr * 64 + fr, fq * 8), boff = lds_byte(wc * 32 + fr, fq * 8);
#define PG8_SA(b, h) (((b) * 2 + (h)) * HTB)
#define PG8_SB(b, h) ((4 + (b) * 2 + (h)) * HTB)
#define PG8_STAGE(bufoff, gbase, voff) do { _Pragma("unroll") for (int _i = 0; _i < 2; ++_i) \
        __builtin_amdgcn_global_load_lds((const unsigned*)((const char*)(gbase) + (voff)[_i]), (PG8_LAS unsigned*)(lds + (bufoff) + ldsw + _i * 8192), 16, 0, 0); } while (0)
#define PG8_LDA(dst, b, h) do { _Pragma("unroll") for (int m = 0; m < 4; ++m) _Pragma("unroll") for (int k = 0; k < 2; ++k) dst[m][k] = *(const PG8_LAS bf16x8*)(lds + PG8_SA(b, h) + aoff + m * 2048 + k * 1024); } while (0)
#define PG8_LDB(dst, b, h) do { _Pragma("unroll") for (int n = 0; n < 2; ++n) _Pragma("unroll") for (int k = 0; k < 2; ++k) dst[n][k] = *(const PG8_LAS bf16x8*)(lds + PG8_SB(b, h) + boff + n * 2048 + k * 1024); } while (0)
#define PG8_MMA(ai, bj, At, Bt) do { __builtin_amdgcn_s_setprio(1); _Pragma("unroll") for (int m = 0; m < 4; ++m) _Pragma("unroll") for (int n = 0; n < 2; ++n) _Pragma("unroll") for (int k = 0; k < 2; ++k) \
        acc[ai][bj][m][n] = __builtin_amdgcn_mfma_f32_16x16x32_bf16(Bt[n][k], At[m][k], acc[ai][bj][m][n], 0, 0, 0); __builtin_amdgcn_s_setprio(0); } while (0)
#define PG8_WAIT_V(n) asm volatile("s_waitcnt vmcnt(" #n ")" ::: "memory")
#define PG8_WAIT_L(n) asm volatile("s_waitcnt lgkmcnt(" #n ")" ::: "memory")
#define PG8_BAR __builtin_amdgcn_s_barrier()
#define PG8_SCHED __builtin_amdgcn_sched_barrier(0)
    Unit cur, nxt; int ui = 0;
    if (!S.next(0, cur)) return;
    f32x4 acc[2][2][4][2];
#pragma unroll
    for (int a = 0; a < 2; ++a)
#pragma unroll
        for (int b = 0; b < 2; ++b)
#pragma unroll
            for (int m = 0; m < 4; ++m)
#pragma unroll
                for (int n = 0; n < 2; ++n) acc[a][b][m][n] = (f32x4){0.f, 0.f, 0.f, 0.f};
    bf16x8 At[4][2], B0[2][2], B1[2][2];
    const char* cA = (const char*)g.A + (size_t)cur.pm * tstepA + (size_t)cur.seg * sstepA; const char* cB = (const char*)g.Bt + (size_t)(cur.seg * g.segN + cur.pn) * tstepB;
    S.a_ready(cur);
    if constexpr (SP2) {
        PG8_STAGE(PG8_SB(0, 0), cB, voffB); PG8_STAGE(PG8_SB(0, 1), cB + hstepB, voffB); PG8_STAGE(PG8_SA(0, 0), cA, voffA); PG8_STAGE(PG8_SA(0, 1), cA + hstepA, voffA);
        if (wr == 1) PG8_BAR;
        PG8_WAIT_V(2); PG8_BAR;
        PG8_STAGE(PG8_SB(1, 0), cB + kstep, voffB); PG8_STAGE(PG8_SA(1, 0), cA + kstep, voffA); PG8_STAGE(PG8_SB(1, 1), cB + hstepB + kstep, voffB);
        PG8_WAIT_V(6); PG8_BAR;
    } else {
        PG8_STAGE(PG8_SB(0, 0), cB, voffB); PG8_STAGE(PG8_SA(0, 0), cA, voffA); PG8_STAGE(PG8_SB(0, 1), cB + hstepB, voffB); PG8_STAGE(PG8_SA(0, 1), cA + hstepA, voffA);
        if (wr == 1) PG8_BAR;
        PG8_WAIT_V(4); PG8_BAR;
        PG8_STAGE(PG8_SB(1, 0), cB + kstep, voffB); PG8_STAGE(PG8_SA(1, 0), cA + kstep, voffA); PG8_STAGE(PG8_SB(1, 1), cB + hstepB + kstep, voffB);
        PG8_WAIT_V(6); PG8_BAR;
    }
    for (;;) {
        const bool has_next = S.next(ui + 1, nxt);
        const char* nA = has_next ? (const char*)g.A + (size_t)nxt.pm * tstepA + (size_t)nxt.seg * sstepA : cA; const char* nB = has_next ? (const char*)g.Bt + (size_t)(nxt.seg * g.segN + nxt.pn) * tstepB : cB;
        for (int t = 0; t < nt; t += 2) {
            const bool last = (t == nt - 2);
            const char* a1 = cA + (size_t)(t + 1) * kstep;
            const char* a2 = last ? nA : cA + (size_t)(t + 2) * kstep; const char* b2 = last ? nB : cB + (size_t)(t + 2) * kstep;
            const char* a3 = a2 + kstep; const char* b3 = b2 + kstep;
            if (last && has_next) S.a_ready(nxt);
            if constexpr (SP2) {
            PG8_LDB(B0, 0, 0); PG8_LDB(B1, 0, 1); PG8_SCHED; PG8_LDA(At, 0, 0); PG8_STAGE(PG8_SA(1, 1), a1 + hstepA, voffA);
            PG8_WAIT_V(8); PG8_WAIT_L(0); PG8_BAR; PG8_MMA(0, 0, At, B0); PG8_MMA(0, 1, At, B1); PG8_BAR; PG8_SCHED;
            PG8_LDA(At, 0, 1); PG8_STAGE(PG8_SB(0, 0), b2, voffB); PG8_STAGE(PG8_SB(0, 1), b2 + hstepB, voffB); PG8_STAGE(PG8_SA(0, 0), a2, voffA);
            PG8_WAIT_V(8); PG8_WAIT_L(0); PG8_BAR; PG8_MMA(1, 0, At, B0); PG8_MMA(1, 1, At, B1); PG8_BAR; PG8_SCHED;
            PG8_LDB(B0, 1, 0); PG8_LDB(B1, 1, 1); PG8_SCHED; PG8_LDA(At, 1, 0); PG8_STAGE(PG8_SA(0, 1), a2 + hstepA, voffA);
            PG8_WAIT_V(8); PG8_WAIT_L(0); PG8_BAR; PG8_MMA(0, 0, At, B0); PG8_MMA(0, 1, At, B1); PG8_BAR; PG8_SCHED;
            PG8_LDA(At, 1, 1); PG8_STAGE(PG8_SB(1, 0), b3, voffB); PG8_STAGE(PG8_SB(1, 1), b3 + hstepB, voffB); PG8_STAGE(PG8_SA(1, 0), a3, voffA);
            PG8_WAIT_V(8); PG8_WAIT_L(0); PG8_BAR; PG8_MMA(1, 0, At, B0); PG8_MMA(1, 1, At, B1); PG8_BAR; PG8_SCHED;
            } else {
            PG8_LDB(B0, 0, 0); PG8_SCHED; PG8_LDA(At, 0, 0); PG8_STAGE(PG8_SA(1, 1), a1 + hstepA, voffA);
            PG8_WAIT_L(8); PG8_BAR; PG8_WAIT_L(0); PG8_MMA(0, 0, At, B0); PG8_BAR; PG8_SCHED;
            PG8_LDB(B1, 0, 1); PG8_STAGE(PG8_SB(0, 0), b2, voffB);
            PG8_BAR; PG8_WAIT_L(0); PG8_MMA(0, 1, At, B1); PG8_BAR;
            PG8_LDA(At, 0, 1); PG8_STAGE(PG8_SA(0, 0), a2, voffA);
            PG8_BAR; PG8_WAIT_L(0); PG8_MMA(1, 0, At, B0); PG8_BAR; PG8_SCHED;
            PG8_STAGE(PG8_SB(0, 1), b2 + hstepB, voffB);
            PG8_WAIT_V(6); PG8_BAR; PG8_MMA(1, 1, At, B1); PG8_BAR;
            PG8_LDB(B0, 1, 0); PG8_SCHED; PG8_LDA(At, 1, 0); PG8_STAGE(PG8_SA(0, 1), a2 + hstepA, voffA);
            PG8_WAIT_L(8); PG8_BAR; PG8_WAIT_L(0); PG8_MMA(0, 0, At, B0); PG8_BAR; PG8_SCHED;
            PG8_LDB(B1, 1, 1); PG8_STAGE(PG8_SB(1, 0), b3, voffB);
            PG8_BAR; PG8_WAIT_L(0); PG8_MMA(0, 1, At, B1); PG8_BAR;
            PG8_LDA(At, 1, 1); PG8_STAGE(PG8_SA(1, 0), a3, voffA);
            PG8_BAR; PG8_WAIT_L(0); PG8_MMA(1, 0, At, B0); PG8_BAR; PG8_SCHED;
            PG8_STAGE(PG8_SB(1, 1), b3 + hstepB, voffB);
            PG8_WAIT_V(6); PG8_BAR; PG8_MMA(1, 1, At, B1); PG8_BAR;
            }
        }
        if constexpr (ALIGN_EPI) { if (wr == 0) PG8_BAR; }
        if constexpr (!Epi::AFTER_DRAIN) { E(acc, cur, wr, wc, fr, fq); S.done(cur); }
        if (!has_next) break;
        if (!E.keep(cur)) {
#pragma unroll
        for (int a = 0; a < 2; ++a)
#pragma unroll
            for (int b = 0; b < 2; ++b)
#pragma unroll
                for (int m = 0; m < 4; ++m)
#pragma unroll
                    for (int n = 0; n < 2; ++n) acc[a][b][m][n] = (f32x4){0.f, 0.f, 0.f, 0.f};
        }
        cur = nxt; cA = nA; cB = nB; ++ui;
        if constexpr (ALIGN_EPI) { if (wr == 1) PG8_BAR; }
    }
    PG8_WAIT_V(0);
    if constexpr (!ALIGN_EPI) { if (wr == 0) PG8_BAR; }
    PG8_BAR;
    if constexpr (Epi::AFTER_DRAIN) { E.fused(acc, cur, wr, wc, fr, fq, lds, wid, lane); S.done(cur); }
#undef PG8_SA
#undef PG8_SB
#undef PG8_STAGE
#undef PG8_LDA
#undef PG8_LDB
#undef PG8_MMA
#undef PG8_WAIT_V
#undef PG8_WAIT_L
#undef PG8_BAR
#undef PG8_SCHED
}
}
#include <hip/hip_bf16.h>
#include <cmath>
namespace attn_body {
using bf16=__hip_bfloat16;
using bf16x8=__attribute__((ext_vector_type(8)))short;
using s16x4=__attribute__((ext_vector_type(4)))short;
using f32x16=__attribute__((ext_vector_type(16)))float;
using u32x4=__attribute__((ext_vector_type(4)))unsigned;
constexpr int BATCH=4,NHEAD=8,SEQ=8192,D=64,DM=NHEAD*D;
constexpr int NW=8,QBLK=32,QB=QBLK*NW,KVBLK=64,NQB=SEQ/QB;
constexpr int ATTN_PITCH=DM, ATTN_UNIT_ROWS=QB, OPITCH=1536, OCOL0=1024;
__device__ __forceinline__ int crow(int r,int hi){return (r&3)+8*(r>>2)+4*hi;}
#define SBAR() __builtin_amdgcn_sched_barrier(0)
__device__ __forceinline__ void cmask(f32x16&p0,f32x16&p1,int jb,int qrel,int hi){
  const float NEG=-INFINITY; int kb=64*jb+4*hi;
  #pragma unroll
  for(int r=0;r<16;++r){int kv=kb+(r&3)+8*(r>>2); if(kv>qrel)p0[r]=NEG; if(kv+32>qrel)p1[r]=NEG;}
}

constexpr int NSLOT=3, SLOTB=8192;
constexpr int LDS_K=0, LDS_V=NSLOT*SLOTB, LDS_WS=2*NSLOT*SLOTB, LDS_OST=LDS_WS+NW*64*4, LDS_BYTES=LDS_OST+NW*4096;
constexpr float C2=0.125f*1.4426950408889634f;
__device__ __forceinline__ void glds16(const void*gsrc,unsigned lds_dst){unsigned keep;
  asm volatile("s_mov_b32 %0, m0\n\ts_mov_b32 m0, %2\n\ts_nop 0\n\tglobal_load_lds_dwordx4 %1, off\n\ts_mov_b32 m0, %0":"=&s"(keep):"v"(gsrc),"s"(lds_dst):"memory");}
__device__ __forceinline__ float max3f(float a,float b,float c){float r;asm("v_max3_f32 %0, %1, %2, %3":"=v"(r):"v"(a),"v"(b),"v"(c));return r;}
__device__ __forceinline__ float max2f(float a,float b){float r;asm("v_max_f32_e32 %0, %1, %2":"=v"(r):"v"(a),"v"(b));return r;}
__device__ __forceinline__ float fadd_s(float a,float b){float r;asm("v_add_f32_e32 %0, %1, %2":"=v"(r):"v"(a),"v"(b));return r;}
__device__ __forceinline__ float fsub_s(float a,float b){float r;asm("v_sub_f32_e32 %0, %1, %2":"=v"(r):"v"(a),"v"(b));return r;}
typedef float f32x2_t __attribute__((ext_vector_type(2))); typedef __bf16 bf16x2_t __attribute__((ext_vector_type(2)));
__device__ __forceinline__ unsigned cvtpk_s(float lo,float hi){f32x2_t v={lo,hi};bf16x2_t b=__builtin_convertvector(v,bf16x2_t);return __builtin_bit_cast(unsigned,b);}
#define WAIT_BAR(N) asm volatile("s_waitcnt vmcnt(" #N ") lgkmcnt(0)\n\ts_barrier":::"memory")

__device__ __forceinline__ void qkt(f32x16&p0,f32x16&p1,const char*Kslot,const bf16x8*qr,int r32,int hi){
  const char*kb=Kslot+hi*1024+r32*16;
  #pragma unroll
  for(int d0=0;d0<4;++d0){
    const bf16x8 b0=*reinterpret_cast<const bf16x8*>(kb+d0*2048);
    const bf16x8 b1=*reinterpret_cast<const bf16x8*>(kb+d0*2048+512);
    p0=__builtin_amdgcn_mfma_f32_32x32x16_bf16(b0,qr[d0],p0,0,0,0);p1=__builtin_amdgcn_mfma_f32_32x32x16_bf16(b1,qr[d0],p1,0,0,0);}
}
typedef __attribute__((address_space(3))) const unsigned* lds_cuptr;
typedef float f32x4_t __attribute__((ext_vector_type(4)));
__device__ __forceinline__ unsigned bfr(float f){ unsigned u=__builtin_bit_cast(unsigned,f); return (u+0x7fffu+((u>>16)&1u))>>16; }
__device__ __forceinline__ void biasmm(f32x16&c0,f32x16&c1,unsigned w0,unsigned w1  ,unsigned qm1,int hi){
  const unsigned one=hi?0u:0x3f803f80u; w0=hi?0u:w0; w1=hi?0u:w1;
  const u32x4 k0={w0,one,0u,0u},k1={w1,one,0u,0u},qv={one,qm1,0u,0u};
  const f32x16 z=f32x16{};
  c0=__builtin_amdgcn_mfma_f32_32x32x16_bf16(__builtin_bit_cast(bf16x8,k0),__builtin_bit_cast(bf16x8,qv),z,0,0,0);
  c1=__builtin_amdgcn_mfma_f32_32x32x16_bf16(__builtin_bit_cast(bf16x8,k1),__builtin_bit_cast(bf16x8,qv),z,0,0,0);
}
typedef __attribute__((address_space(3))) const char* lds_cptr;
typedef short v4i16_t __attribute__((ext_vector_type(4)));
__device__ __forceinline__ void kload8(bf16x8*kf,lds_cptr kp){
  kf[0]=*(const __attribute__((address_space(3))) bf16x8*)(kp);      kf[1]=*(const __attribute__((address_space(3))) bf16x8*)(kp+512);
  kf[2]=*(const __attribute__((address_space(3))) bf16x8*)(kp+2048); kf[3]=*(const __attribute__((address_space(3))) bf16x8*)(kp+2560);
  kf[4]=*(const __attribute__((address_space(3))) bf16x8*)(kp+4096); kf[5]=*(const __attribute__((address_space(3))) bf16x8*)(kp+4608);
  kf[6]=*(const __attribute__((address_space(3))) bf16x8*)(kp+6144); kf[7]=*(const __attribute__((address_space(3))) bf16x8*)(kp+6656);
}
__device__ __forceinline__ void kload2(bf16x8*kf,lds_cptr kp,int j){ kf[2*j]=*(const __attribute__((address_space(3))) bf16x8*)(kp+j*2048); kf[2*j+1]=*(const __attribute__((address_space(3))) bf16x8*)(kp+j*2048+512); }
__device__ __forceinline__ s16x4 vtr(lds_cptr p){ return __builtin_bit_cast(s16x4,__builtin_amdgcn_ds_read_tr16_b64_v4i16((__attribute__((address_space(3))) v4i16_t*)p)); }
__device__ __forceinline__ float rowmax(const f32x16&p0,const f32x16&p1){
  float a=max3f(p0[0],p0[1],p1[0]),b=max3f(p0[2],p0[3],p1[1]);a=max3f(a,p1[2],p1[3]);
  #pragma unroll
  for(int r=4;r<16;r+=4){a=max3f(a,p0[r],p0[r+1]);b=max3f(b,p0[r+2],p0[r+3]);a=max3f(a,p1[r],p1[r+1]);b=max3f(b,p1[r+2],p1[r+3]);}
  const float m=max2f(a,b);
  auto rr=__builtin_amdgcn_permlane32_swap(__float_as_uint(m),__float_as_uint(m),false,false);
  return max2f(__uint_as_float(rr[0]),__uint_as_float(rr[1]));
}
__device__ __forceinline__ void pv(f32x16*o,int vb,bf16x8 pa0,bf16x8 pa1,bf16x8 pa2,bf16x8 pa3){
  #pragma unroll
  for(int d0=0;d0<2;++d0){s16x4 lo[4],hi[4];
    #pragma unroll
    for(int ks=0;ks<4;++ks){
      asm volatile("ds_read_b64_tr_b16 %0,%1 offset:%c2":"=&v"(lo[ks]):"v"(vb),"i"(d0*4096+ks*1024):"memory");
      asm volatile("ds_read_b64_tr_b16 %0,%1 offset:%c2":"=&v"(hi[ks]):"v"(vb),"i"(d0*4096+ks*1024+512):"memory");}
    asm volatile("s_waitcnt lgkmcnt(0)":::"memory");SBAR();
    #define PK(k) (bf16x8){lo[k][0],lo[k][1],lo[k][2],lo[k][3],hi[k][0],hi[k][1],hi[k][2],hi[k][3]}
    o[d0]=__builtin_amdgcn_mfma_f32_32x32x16_bf16(pa0,PK(0),o[d0],0,0,0);
    o[d0]=__builtin_amdgcn_mfma_f32_32x32x16_bf16(pa1,PK(1),o[d0],0,0,0);
    o[d0]=__builtin_amdgcn_mfma_f32_32x32x16_bf16(pa2,PK(2),o[d0],0,0,0);
    o[d0]=__builtin_amdgcn_mfma_f32_32x32x16_bf16(pa3,PK(3),o[d0],0,0,0);
    #undef PK
  }
}

__device__ __forceinline__ u32x4 mul_bf16x8(u32x4 a,u32x4 b){ u32x4 r;
  #pragma unroll
  for(int i=0;i<4;++i){ const float al=__uint_as_float(a[i]<<16),ah=__uint_as_float(a[i]&0xffff0000u),bl=__uint_as_float(b[i]<<16),bh=__uint_as_float(b[i]&0xffff0000u); r[i]=cvtpk_s(al*bl,ah*bh); }
  return r; }
#ifndef ATTN_STORE16
#define ATTN_STORE16(p,v) (*(u32x4*)(p)=(v))
#endif
template<int THRL> __device__ __forceinline__ void attn_unit(int b,int h,int qb,const bf16*Q,const bf16*__restrict__ K,const bf16*__restrict__ V,bf16*O,char*shm,lds_cuptr nb,int tskip,bool dry,int wave_id){
  int tid_=(int)__builtin_amdgcn_mbcnt_hi(~0u,__builtin_amdgcn_mbcnt_lo(~0u,0u)); asm volatile("":"+v"(tid_)); tid_+=wave_id*64; const int tid=tid_,lane=tid&63,r32=lane&31,hi=lane>>5; const int wid=__builtin_amdgcn_readfirstlane(tid>>6);
  const long rowbase=(long)b*SEQ; const int q0=qb*QB;
  const bf16*Qw=Q+(rowbase+q0+wid*QBLK)*DM+h*D;
  const bf16*Kh=K+(rowbase+(long)tskip*KVBLK)*DM+h*D,*Vh=V+(rowbase+(long)tskip*KVBLK)*DM+h*D;
  const unsigned lds0=(unsigned)(uintptr_t)shm;
  float*wsf=(float*)(shm+LDS_WS)+wid*64;
  const bf16*ksrc=Kh+(long)lane*DM+wid*8;
  const bf16*vsrc=Vh+(long)(16*(wid&3)+(lane>>2))*DM+(wid>>2)*32+(lane&3)*8;
  const unsigned kdst=lds0+LDS_K+wid*1024, vdst=lds0+LDS_V+wid*1024;
  #define DMA_K(t,slot) glds16(ksrc+(long)(t)*KVBLK*DM,(unsigned)__builtin_amdgcn_readfirstlane(kdst+(slot)))
  #define DMA_V(t,slot) glds16(vsrc+(long)(t)*KVBLK*DM,(unsigned)__builtin_amdgcn_readfirstlane(vdst+(slot)))
  const int vb0=(int)(lds0+LDS_V)+((lane>>4)&1)*32+(lane&3)*8+(4*hi+((lane&15)>>2))*64;
  const char*Kbase=shm+LDS_K; bf16x8 kf[8];
  const lds_cptr shm3=(lds_cptr)shm; const lds_cptr kp0=shm3+LDS_K+hi*1024+r32*16; const lds_cptr vp0=shm3+LDS_V+((lane>>4)&1)*32+(lane&3)*8+(4*hi+((lane&15)>>2))*64;
  const int NT=(q0+QB)/KVBLK-tskip;
  DMA_K(0,0);DMA_V(0,0);DMA_K(1,SLOTB);
  bf16x8 qr[4];
  #pragma unroll
  for(int d0=0;d0<4;++d0)qr[d0]=*reinterpret_cast<const bf16x8*>(&Qw[(long)r32*DM+d0*16+hi*8]);
  float mhat=0.f,l_reg=0.f;f32x16 o[2];o[0]=f32x16{};o[1]=f32x16{};unsigned qm1=0u;const lds_cuptr nbl=nb+64*tskip+r32;
  #define SETM(NEWM) do{ const float nm_=-(NEWM); const unsigned h_=bfr(nm_); const float hf_=__uint_as_float(h_<<16); const unsigned l_=bfr(nm_-hf_); mhat=-(hf_+__uint_as_float(l_<<16)); qm1=hi?0u:(h_|(l_<<16)); }while(0)
  const int qrel=wid*QBLK+r32;
  #define CMASK(P0,P1,t) do{int jb_=(t)-(NT-4); if(jb_>=0)cmask(P0,P1,jb_,qrel,hi);}while(0)
  bool resc=false;
  #define START(P0,P1) do{ const float rm=rowmax(P0,P1); resc=false; \
    { const float old_=mhat; SETM(old_+rm); const float dl=mhat-old_; \
      _Pragma("unroll") for(int r=0;r<16;++r){P0[r]=fsub_s(P0[r],dl);P1[r]=fsub_s(P1[r],dl);} } \
    _Pragma("unroll") for(int r=0;r<16;++r)P0[r]=__builtin_amdgcn_exp2f(P0[r]); }while(0)
  #define RESC() do{ if(resc){ asm volatile("s_waitcnt lgkmcnt(0)":::"memory"); \
      _Pragma("unroll") for(int d_=0;d_<2;++d_) _Pragma("unroll") for(int r=0;r<16;++r)o[d_][r]*=wsf[crow(r,hi)]; } }while(0)
  f32x16 pA0,pA1,pB0,pB1;
  int sl_prev=0,sl_cur=0,sl_next=SLOTB;
  #define ROT() do{sl_prev=sl_cur;sl_cur=sl_next;sl_next=(sl_next==(NSLOT-1)*SLOTB)?0:sl_next+SLOTB;}while(0)
  DMA_K(2,2*SLOTB);
  WAIT_BAR(3);
  unsigned bw0=nbl[0],bw1=nbl[32]; biasmm(pA0,pA1,bw0,bw1,qm1,hi); bw0=nbl[64]; bw1=nbl[96]; qkt(pA0,pA1,Kbase,qr,r32,hi);    asm volatile("s_nop 15\n\ts_nop 7":"+v"(pA0),"+v"(pA1));CMASK(pA0,pA1,0);
  START(pA0,pA1);
  _Pragma("unroll") for(int r=0;r<16;++r)pA1[r]=__builtin_amdgcn_exp2f(pA1[r]);
  WAIT_BAR(0);
  DMA_K(3,0);DMA_V(1,SLOTB);
  ROT();
  kload8(kf,kp0+sl_cur);
  WAIT_BAR(2);
  s16x4 vlo[8],vhi[8]; u32x4 pw0,pw1,pw2,pw3;
  #define PKW(P,B) cvtpk_s(P[B],P[B+1])
  #define PAF(k) __builtin_bit_cast(bf16x8,pw##k)
  #define VFR(i) (bf16x8){vlo[i][0],vlo[i][1],vlo[i][2],vlo[i][3],vhi[i][0],vhi[i][1],vhi[i][2],vhi[i][3]}
  #define PIN(x) asm volatile("":"+v"(x))
  #define MX3(a,b,c) __builtin_fmaxf(__builtin_fmaxf((a),(b)),(c))
  #define GAPA(MF,A0,A1,A2,A3,W0,W1,PW) do{ MF; sacc+=A0; sacc+=A1; sacc+=A2; sacc+=A3; PIN(sacc); W0; W1; PIN(PW); SBAR(); }while(0)
  #define EX(v) __builtin_amdgcn_exp2f(v)
  #define GAPB(MF,X,B) do{ MF; X[B]=EX(X[B]); X[B+1]=EX(X[B+1]); X[B+2]=EX(X[B+2]); X[B+3]=EX(X[B+3]); PIN(X); SBAR(); }while(0)
  #define VRD(i) do{ vlo[i]=vtr(vp_+(((i)>>2)*4096+((i)&3)*1024)); vhi[i]=vtr(vp_+(((i)>>2)*4096+((i)&3)*1024+512)); }while(0)
  #define KRD(G,j) do{ if(G){ kload2(kf,kp0+sl_next,j); SBAR(); } }while(0)
  #define STEP(C0,C1,P0,P1,t,GK,GV,GL) do{ SBAR(); \
    biasmm(C0,C1,bw0,bw1,qm1,hi); bw0=nbl[64*((t)+1)]; bw1=nbl[64*((t)+1)+32]; SBAR(); \
    const lds_cptr vp_=vp0+sl_prev; \
    VRD(0); SBAR(); float sacc=(P0[0]+P0[1]); \
    GAPA(C0=__builtin_amdgcn_mfma_f32_32x32x16_bf16(kf[0],qr[0],C0,0,0,0), P0[2],P0[3],P0[4],P0[5],     pw0[0]=PKW(P0,0), pw0[1]=PKW(P0,2), pw0); \
    VRD(4); SBAR(); GAPA(C1=__builtin_amdgcn_mfma_f32_32x32x16_bf16(kf[1],qr[0],C1,0,0,0), P0[6],P0[7],P0[8],P0[9],     pw0[2]=PKW(P0,4), pw0[3]=PKW(P0,6), pw0); \
    VRD(1); SBAR(); GAPA(C0=__builtin_amdgcn_mfma_f32_32x32x16_bf16(kf[2],qr[1],C0,0,0,0),   P0[10],P0[11],P0[12],P0[13], pw1[0]=PKW(P0,8), pw1[1]=PKW(P0,10), pw1); \
    VRD(5); SBAR(); GAPA(C1=__builtin_amdgcn_mfma_f32_32x32x16_bf16(kf[3],qr[1],C1,0,0,0),   P0[14],P0[15],P1[0],P1[1],   pw1[2]=PKW(P0,12),pw1[3]=PKW(P0,14), pw1); \
    VRD(2); SBAR(); GAPA(C0=__builtin_amdgcn_mfma_f32_32x32x16_bf16(kf[4],qr[2],C0,0,0,0),   P1[2],P1[3],P1[4],P1[5],     pw2[0]=PKW(P1,0), pw2[1]=PKW(P1,2), pw2); \
    VRD(6); SBAR(); GAPA(C1=__builtin_amdgcn_mfma_f32_32x32x16_bf16(kf[5],qr[2],C1,0,0,0),   P1[6],P1[7],P1[8],P1[9],     pw2[2]=PKW(P1,4), pw2[3]=PKW(P1,6), pw2); \
    VRD(3); SBAR(); GAPA(C0=__builtin_amdgcn_mfma_f32_32x32x16_bf16(kf[6],qr[3],C0,0,0,0),   P1[10],P1[11],P1[12],P1[13], pw3[0]=PKW(P1,8), pw3[1]=PKW(P1,10), pw3); \
    VRD(7); SBAR(); GAPA(C1=__builtin_amdgcn_mfma_f32_32x32x16_bf16(kf[7],qr[3],C1,0,0,0),   P1[14],P1[15],0.f,0.f,       pw3[2]=PKW(P1,12),pw3[3]=PKW(P1,14), pw3); \
    l_reg+=sacc; \
    if(GK){DMA_K((t)+3,sl_cur);} if(GV){DMA_V((t)+1,sl_next);} \
    CMASK(C0,C1,t); \
    { float a=MX3(C0[0],C0[1],C1[0]),b=MX3(C0[2],C0[3],C1[1]); a=MX3(a,C1[2],C1[3]); \
      _Pragma("unroll") for(int r=4;r<16;r+=4){a=MX3(a,C0[r],C0[r+1]);b=MX3(b,C0[r+2],C0[r+3]);a=MX3(a,C1[r],C1[r+1]);b=MX3(b,C1[r+2],C1[r+3]);} \
      float rm=__builtin_fmaxf(a,b); { auto rr=__builtin_amdgcn_permlane32_swap(__float_as_uint(rm),__float_as_uint(rm),false,false); rm=__builtin_fmaxf(__uint_as_float(rr[0]),__uint_as_float(rr[1])); } \
      resc=false; \
      if(__builtin_expect(__any(rm>(float)THRL),0)){ const float old_=mhat; SETM(old_+__builtin_fmaxf(rm,0.f)); const float dl=mhat-old_; \
        _Pragma("unroll") for(int r=0;r<16;++r){C0[r]-=dl;C1[r]-=dl;} \
        const float f=__builtin_amdgcn_exp2f(-dl); l_reg*=f; if(hi==0)wsf[r32]=f; resc=true; } } \
    SBAR(); \
    GAPB(o[0]=__builtin_amdgcn_mfma_f32_32x32x16_bf16(PAF(0),VFR(0),o[0],0,0,0), C0,0); \
    GAPB(o[1]=__builtin_amdgcn_mfma_f32_32x32x16_bf16(PAF(0),VFR(4),o[1],0,0,0), C0,4); \
    KRD(GL,0); GAPB(o[0]=__builtin_amdgcn_mfma_f32_32x32x16_bf16(PAF(1),VFR(1),o[0],0,0,0), C0,8); \
    KRD(GL,1); GAPB(o[1]=__builtin_amdgcn_mfma_f32_32x32x16_bf16(PAF(1),VFR(5),o[1],0,0,0), C0,12); \
    KRD(GL,2); GAPB(o[0]=__builtin_amdgcn_mfma_f32_32x32x16_bf16(PAF(2),VFR(2),o[0],0,0,0), C1,0); \
    KRD(GL,3); GAPB(o[1]=__builtin_amdgcn_mfma_f32_32x32x16_bf16(PAF(2),VFR(6),o[1],0,0,0), C1,4); \
    GAPB(o[0]=__builtin_amdgcn_mfma_f32_32x32x16_bf16(PAF(3),VFR(3),o[0],0,0,0), C1,8); \
    GAPB(o[1]=__builtin_amdgcn_mfma_f32_32x32x16_bf16(PAF(3),VFR(7),o[1],0,0,0), C1,12); \
    }while(0)
  int t=1;
  #undef CMASK
  #define CMASK(P0,P1,t) do{}while(0)
  for(;t+5<NT;t+=2){
    STEP(pB0,pB1,pA0,pA1,t,true,true,true);     WAIT_BAR(2); RESC(); ROT();
    STEP(pA0,pA1,pB0,pB1,t+1,true,true,true);   WAIT_BAR(2); RESC(); ROT();
  }
  #undef CMASK
  #define CMASK(P0,P1,t) do{int jb_=(t)-(NT-4); if(jb_>=0)cmask(P0,P1,jb_,qrel,hi);}while(0)
  #define ENDW(tt) do{ if((tt)+3<NT){WAIT_BAR(2);} else if((tt)+2<NT){WAIT_BAR(1);} else {WAIT_BAR(0);} }while(0)
  for(;t+1<NT;t+=2){
    STEP(pB0,pB1,pA0,pA1,t,(t+3<NT),(t+1<NT),(t+1<NT));       ENDW(t);   RESC(); ROT();
    STEP(pA0,pA1,pB0,pB1,t+1,(t+4<NT),(t+2<NT),(t+2<NT));     ENDW(t+1); RESC(); ROT();
  }
  STEP(pB0,pB1,pA0,pA1,NT-1,false,false,false); RESC();
  { float sacc=pB0[0]+pB0[1]; _Pragma("unroll") for(int r=2;r<16;++r)sacc+=pB0[r]; _Pragma("unroll") for(int r=0;r<16;++r)sacc+=pB1[r]; l_reg+=sacc;
    pw0=(u32x4){PKW(pB0,0),PKW(pB0,2),PKW(pB0,4),PKW(pB0,6)};pw1=(u32x4){PKW(pB0,8),PKW(pB0,10),PKW(pB0,12),PKW(pB0,14)};pw2=(u32x4){PKW(pB1,0),PKW(pB1,2),PKW(pB1,4),PKW(pB1,6)};pw3=(u32x4){PKW(pB1,8),PKW(pB1,10),PKW(pB1,12),PKW(pB1,14)};
    SBAR(); pv(o,vb0+sl_cur,PAF(0),PAF(1),PAF(2),PAF(3)); }
  #undef PKW
  #undef PAF
  #undef VFR
  #undef PIN
  #undef MX3
  #undef GAPA
  #undef GAPB
  #undef EX
  #undef VRD
  #undef KRD
  #undef STEP
  #undef ENDW
  {auto rr=__builtin_amdgcn_permlane32_swap(__float_as_uint(l_reg),__float_as_uint(l_reg),false,false);l_reg=__uint_as_float(rr[0])+__uint_as_float(rr[1]);}
  if(hi==0)wsf[32+r32]=l_reg;asm volatile("s_waitcnt lgkmcnt(0)":::"memory");
  float rli[16];
  #pragma unroll
  for(int r=0;r<16;++r)rli[r]=__builtin_amdgcn_rcpf(wsf[32+crow(r,hi)]);
  bf16*Ow=O+(rowbase+q0+wid*QBLK)*(long)OPITCH+OCOL0+h*D;
  { bf16*stg=(bf16*)(shm+LDS_OST)+wid*2048;
    #pragma unroll
    for(int r=0;r<16;++r){const int orow=crow(r,hi);
      #pragma unroll
      for(int d0=0;d0<2;++d0)stg[orow*64+d0*32+r32]=__float2bfloat16(o[d0][r]*rli[r]);}
    asm volatile("s_waitcnt lgkmcnt(0)":::"memory");
    #pragma unroll
    for(int i=0;i<4;++i){const int row=i*8+(lane>>3),ch=lane&7; const u32x4 v=*(const u32x4*)(stg+row*64+ch*8); bf16*gp=Ow+(long)row*OPITCH+ch*8; const u32x4 gt=*(const u32x4*)gp; if(!dry){ATTN_STORE16(gp,mul_bf16x8(v,gt));}} }
  asm volatile("s_waitcnt lgkmcnt(0)\n\ts_barrier":::"memory");
  #undef DMA_K
  #undef DMA_V
  #undef CMASK
  #undef START
  #undef RESC
  #undef ROT
  #undef SETM
}
constexpr int ATTN_LDS_BYTES=LDS_BYTES;
#undef SBAR
#undef WAIT_BAR
}
constexpr int BATCH = 4, SEQ = 8192, DMODEL = 1024, M = BATCH * SEQ, DEPTH = 2, INC = 7852;
constexpr int NT_A = 19, NT_B = 12, NTILES = NT_A + NT_B;
constexpr int SA_Q = 0, SA_K = 512, SA_V = 640, SA_G = 768, SB_Q = 1280, SB_K = 1792, SB_V = 1920, SB_IQ = 2048, SB_IK = 2176, SB_IW = 2208, SB_G = 2212,
              SC_Q = 2724, SC_K = 3236, SC_V = 3748, SC_F = 4260, SC_G = 4268, S_MG = 4780;
static_assert(S_MG + 3072 == INC, "column partition");
__host__ __device__ __forceinline__ int src_col(int t, int lc) {
    switch (t) {
        case 0: case 1: return SA_Q + t * 256 + lc;
        case 2: case 3: return SB_Q + (t - 2) * 256 + lc;
        case 4: case 5: return SC_Q + (t - 4) * 256 + lc;
        case 6: return lc < 128 ? SA_K + lc : SB_K + lc - 128;
        case 7: case 8: return SC_K + (t - 7) * 256 + lc;
        case 9: return lc < 128 ? SA_V + lc : SB_V + lc - 128;
        case 10: case 11: return SC_V + (t - 10) * 256 + lc;
        case 12: case 13: return SA_G + (t - 12) * 256 + lc;
        case 14: case 15: return SB_G + (t - 14) * 256 + lc;
        case 16: case 17: return SC_G + (t - 16) * 256 + lc;
        case 18: return lc < 128 ? SB_IQ + lc : lc < 160 ? SB_IK + lc - 128 : lc < 164 ? SB_IW + lc - 160 : lc < 172 ? SC_F + lc - 164 : -1;
        default: return S_MG + (t - 19) * 256 + lc;
    }
}
constexpr size_t MiB = 1u << 20;
constexpr size_t WS_CTL = 0, CTL_ZERO_BYTES = 1 * MiB;
constexpr size_t WS_W1T = 2 * MiB;
constexpr size_t WS_WBT = 33 * MiB;
constexpr size_t WS_WOT = 39 * MiB;
constexpr size_t WS_SSQ = 43 * MiB;
constexpr size_t WS_CL = 45 * MiB;
constexpr size_t WS_CT = 46 * MiB;
constexpr size_t WS_IW = 47 * MiB;
constexpr size_t WS_CF = 47 * MiB + 512 * 1024;
constexpr size_t WS_IQ = 49 * MiB;
constexpr size_t WS_IK = 57 * MiB;
constexpr size_t WS_XB = 60 * MiB;
constexpr size_t WS_MERGED = 124 * MiB;
constexpr size_t WS_G = 188 * MiB;
constexpr size_t WS_QA = 284 * MiB, WS_QB = 316 * MiB, WS_QC = 348 * MiB, WS_KC = 380 * MiB, WS_VC = 412 * MiB, WS_KAB = 444 * MiB, WS_VAB = 460 * MiB;
constexpr size_t WS_MG = 284 * MiB;
constexpr size_t WS_END = 476 * MiB;
static_assert(pg8::EWS_CL == WS_CL && pg8::EWS_CT == WS_CT && pg8::EWS_SSQ == WS_SSQ && pg8::EWS_IW == WS_IW && pg8::EWS_CF == WS_CF && pg8::EWS_IQ == WS_IQ && pg8::EWS_IK == WS_IK && pg8::EWS_G == WS_G && pg8::EWS_QA == WS_QA && pg8::EWS_QB == WS_QB &&
              pg8::EWS_QC == WS_QC && pg8::EWS_KC == WS_KC && pg8::EWS_VC == WS_VC && pg8::EWS_KAB == WS_KAB && pg8::EWS_VAB == WS_VAB, "epilogue offsets");
constexpr int CW_OVF = 8;
constexpr int CW_TICK = 8192;
constexpr int CW_BAR = 4096;
constexpr int RING_OFF = 0, RING_BYTES = 131072;
constexpr int SEL_OFF = 131072;
constexpr int H2_OFF = SEL_OFF + 8192;
constexpr int BIAS_OFF = H2_OFF + 8192;
constexpr int BKT_OFF = BIAS_OFF + 2048;
constexpr int MISC_OFF = BKT_OFF + 512;
constexpr int LDS_BYTES = 155648;
static_assert(MISC_OFF + 1024 <= LDS_BYTES, "LDS map");
constexpr int NB_OFF = 86016;
static_assert(attn_body::ATTN_LDS_BYTES <= NB_OFF && NB_OFF + 32768 <= RING_BYTES, "LDS map");
constexpr int MW_NSEL = 0, MW_NCAND = 16, MW_BIN = 32, MW_ABOVE = 48, MW_CARRY = 64, MW_BAR = 96, MW_SLOW = 100, MW_TICKET = 101, MW_ZCUT = 112, MW_UC = 128, MW_ELO = 160;

#define GAS __attribute__((address_space(1)))
#define LAS __attribute__((address_space(3)))
typedef unsigned short bf16;
typedef unsigned v4u __attribute__((ext_vector_type(4)));
typedef float f32x4 __attribute__((ext_vector_type(4)));
typedef short bf16x8 __attribute__((ext_vector_type(8)));
typedef GAS unsigned gu32;
#define RLX_AGENT __ATOMIC_RELAXED, __HIP_MEMORY_SCOPE_AGENT
#define LDS_WAIT() asm volatile("s_waitcnt lgkmcnt(0)" ::: "memory")
#define VM_WAIT() asm volatile("s_waitcnt vmcnt(0)" ::: "memory")
__device__ __forceinline__ unsigned f2bf(float f) { unsigned u = __builtin_bit_cast(unsigned, f); return (u + 0x7fffu + ((u >> 16) & 1u)) >> 16; }
__device__ __forceinline__ unsigned pk2(float lo, float hi) { return f2bf(lo) | (f2bf(hi) << 16); }

#define XB_TMO      128
#define XB_XCNT(j)  (256  + 64 * (j))
#define XB_XSUB(j)  (1280 + 64 * (j))
#define XB_XGEN(j)  (2304 + 64 * (j))
#define XB_TOP      3328
#define XB_TOPGEN   3392
#define XCD_BAR_WORDS 3456
#define XB_SPIN_CAP (1u << 18)

__device__ __forceinline__ unsigned xb_ld(unsigned* p)              { return __hip_atomic_load(p, __ATOMIC_RELAXED, __HIP_MEMORY_SCOPE_AGENT); }
__device__ __forceinline__ unsigned xb_add(unsigned* p, unsigned v) { return __hip_atomic_fetch_add(p, v, __ATOMIC_RELAXED, __HIP_MEMORY_SCOPE_AGENT); }
__device__ __forceinline__ unsigned xb_xcc_id() { return (unsigned)__builtin_amdgcn_s_getreg((3 << 11) | 20) & 0xFu; }
#define XB_SPIN(cond, bar) do { unsigned _sp = 0; while (cond) { __builtin_amdgcn_s_sleep(1); \
    if ((++_sp & 255u) == 0u) { if (xb_ld(&(bar)[XB_TMO])) break; if (_sp > XB_SPIN_CAP) { atomicAdd(&(bar)[XB_TMO], 1u); break; } } } } while (0)

struct XcdBarrier {
    unsigned* bar; unsigned x;
    volatile LAS unsigned* st;
};

__device__ __forceinline__ XcdBarrier xcd_barrier_post(unsigned* bar, volatile LAS unsigned* st) {
    XcdBarrier b; b.bar = bar; b.x = xb_xcc_id(); b.st = st;
    if (threadIdx.x == 0) (void)xb_add(&bar[XB_XCNT(b.x)], 1u);
    return b;
}
__device__ __forceinline__ void xcd_barrier_complete(unsigned* bar, unsigned x, unsigned& nloc, unsigned& nx) {
    const unsigned G = gridDim.x * gridDim.y * gridDim.z;
    unsigned sum, cnt, mine, sp = 0u;
    for (;;) {
        sum = 0u; cnt = 0u; mine = 0u;
#pragma unroll
        for (unsigned j = 0; j < 16; ++j) { const unsigned c = xb_ld(&bar[XB_XCNT(j)]); sum += c; cnt += (c > 0u) ? 1u : 0u; mine = (j == x) ? c : mine; }
        if (sum == G) break;
        __builtin_amdgcn_s_sleep(1);
        if ((++sp & 255u) == 0u) { if (xb_ld(&bar[XB_TMO])) break; if (sp > XB_SPIN_CAP) { atomicAdd(&bar[XB_TMO], 1u); break; } }
    }
    nloc = mine > 0u ? mine : 1u; nx = cnt > 0u ? cnt : 1u;
}

__device__ __forceinline__ void xcd_barrier(const XcdBarrier& b) {
    asm volatile("s_waitcnt vmcnt(0)" ::: "memory");
    __syncthreads();
    if (threadIdx.x == 0) {
        unsigned* bar = b.bar;
        __builtin_amdgcn_s_waitcnt(0);
        unsigned nloc = b.st[0], nx = b.st[1];
        if (nloc == 0u) { xcd_barrier_complete(bar, b.x, nloc, nx); b.st[0] = nloc; b.st[1] = nx; }
        const unsigned old = xb_add(&bar[XB_XSUB(b.x)], 1u);
        const unsigned gen = old / nloc;
        if (old + 1u == (gen + 1u) * nloc) {
            __builtin_amdgcn_fence(__ATOMIC_RELEASE, "agent");
            asm volatile("s_waitcnt vmcnt(0)" ::: "memory");
            const unsigned og = xb_add(&bar[XB_TOP], 1u);
            const unsigned tg = og / nx;
            if (og + 1u == (tg + 1u) * nx) xb_add(&bar[XB_TOPGEN], 1u);
            else XB_SPIN(xb_ld(&bar[XB_TOPGEN]) == tg, bar);
            __builtin_amdgcn_fence(__ATOMIC_ACQUIRE, "agent");
            xb_add(&bar[XB_XGEN(b.x)], 1u);
            asm volatile("s_waitcnt vmcnt(0)" ::: "memory");
        } else {
            XB_SPIN(xb_ld(&bar[XB_XGEN(b.x)]) == gen, bar);
            __builtin_amdgcn_fence(__ATOMIC_ACQUIRE, "agent");
            asm volatile("s_waitcnt vmcnt(0)" ::: "memory");
        }
    }
    __syncthreads();
}

struct Frame {
    LAS unsigned char* lds;
    volatile LAS unsigned* MISC;
    gu32* ctl;
    int tid, lane, wave, vcu, G;
};
__device__ __forceinline__ float wave_sum(float v) {
#pragma unroll
    for (int o = 1; o < 64; o <<= 1) v += __shfl_xor(v, o);
    return v;
}
__device__ __forceinline__ float wave_incl_scan(float v, int lane) {
#pragma unroll
    for (int o = 1; o < 64; o <<= 1) { const float t = __shfl_up(v, o); if (lane >= o) v += t; }
    return v;
}
__device__ __forceinline__ int wave_incl_scan_i(int v, int lane) {
#pragma unroll
    for (int o = 1; o < 64; o <<= 1) { const int t = __shfl_up(v, o); if (lane >= o) v += t; }
    return v;
}
__device__ __forceinline__ void transpose_item(const float* W, int N, bf16* WT, int K, int n0, int k0, int scol, const float* kscale, LAS float* scr, int lane) {
#pragma unroll 8
    for (int i = 0; i < 32; ++i) { const int kk = 2 * i + (lane >> 5); float v = 0.f;
        if (scol >= 0) { v = W[(size_t)(k0 + kk) * N + scol]; if (kscale) v *= kscale[k0 + kk]; }
        scr[kk * 33 + (lane & 31)] = v; }
    LDS_WAIT(); asm volatile("" ::: "memory");
    const int c = lane & 7;
#pragma unroll
    for (int j = 0; j < 4; ++j) { const int n = (lane >> 3) + 8 * j; const LAS float* s = scr + (8 * c) * 33 + n;
        v4u o; o.x = pk2(s[0 * 33], s[1 * 33]); o.y = pk2(s[2 * 33], s[3 * 33]); o.z = pk2(s[4 * 33], s[5 * 33]); o.w = pk2(s[6 * 33], s[7 * 33]);
        *(GAS v4u*)(WT + (size_t)(n0 + n) * K + k0 + 8 * c) = o; }
    LDS_WAIT(); asm volatile("" ::: "memory");
}
__device__ __forceinline__ void p0_prologue(Frame& F, const float* x, const float* norm_gain, const float* w_in, const float* w_branch, const float* w_out, unsigned char* ws) {
    LAS float* scr = (LAS float*)(F.lds + RING_OFF + F.wave * 16384);
    const int gw = F.vcu * 8 + F.wave, NGW = F.G * 8, lane = F.lane;
    constexpr int I_W1 = 16 * (NTILES * 256 / 32), I_WB = 8 * 32, I_WO = 16 * 32;
    constexpr int NITEMS = DEPTH * I_W1 + DEPTH * 3 * I_WB + DEPTH * I_WO;
    for (int it = gw; it < NITEMS; it += NGW) {
        int r = it;
        if (r < DEPTH * I_W1) { const int L = r / I_W1; r -= L * I_W1; const int nblk = NTILES * 8, kb = r / nblk, nb = r % nblk, n0 = nb * 32, tile = n0 >> 8, p = (n0 & 255) + (lane & 31);
            const int lc = 64 * ((p >> 5) & 3) + 32 * (p >> 7) + (p & 31);
            transpose_item(w_in + (size_t)L * DMODEL * INC, INC, (bf16*)(ws + WS_W1T) + (size_t)L * NTILES * 256 * 1024, 1024, n0, kb * 64, src_col(tile, lc), norm_gain + L * DMODEL, scr, lane); continue; }
        r -= DEPTH * I_W1;
        if (r < DEPTH * 3 * I_WB) { const int mat = r / I_WB; r -= mat * I_WB; const int kb = r / 32, nb = r % 32;
            transpose_item(w_branch + (size_t)mat * 512 * 1024, 1024, (bf16*)(ws + WS_WBT) + (size_t)mat * 1024 * 512, 512, nb * 32, kb * 64, nb * 32 + (lane & 31), nullptr, scr, lane); continue; }
        r -= DEPTH * 3 * I_WB;
        { const int L = r / I_WO; r -= L * I_WO; const int kb = r / 32, nb = r % 32;
            transpose_item(w_out + (size_t)L * 1024 * 1024, 1024, (bf16*)(ws + WS_WOT) + (size_t)L * 1024 * 1024, 1024, nb * 32, kb * 64, nb * 32 + (lane & 31), nullptr, scr, lane); }
    }
    bf16* XB = (bf16*)(ws + WS_XB); float* SSQ = (float*)(ws + WS_SSQ);
    for (int m = gw; m < M; m += NGW) {
        const GAS f32x4* xr = (const GAS f32x4*)(x + (size_t)m * DMODEL) + lane; f32x4 v[4]; float s = 0.f;
#pragma unroll
        for (int j = 0; j < 4; ++j) { v[j] = xr[64 * j]; s += (v[j].x * v[j].x + v[j].y * v[j].y) + (v[j].z * v[j].z + v[j].w * v[j].w); }
        const float tot = wave_sum(s);
        GAS unsigned long long* o8 = (GAS unsigned long long*)(XB + (size_t)m * DMODEL) + lane;
#pragma unroll
        for (int j = 0; j < 4; ++j) o8[64 * j] = (unsigned long long)pk2(v[j].x, v[j].y) | ((unsigned long long)pk2(v[j].z, v[j].w) << 32);
        if (lane < 16) SSQ[(size_t)m * 16 + lane] = lane == 0 ? tot : 0.f;
    }
}
__device__ __forceinline__ void scan_phase(Frame& F, const float* CF, const float* bforget  , float* CL, float* CT) {
    const int lane = F.lane, h = F.wave;
    for (int u = blockIdx.x; u < 128; u += F.G) { const int b = u >> 5, j = u & 31; const size_t row = (size_t)b * SEQ + 256 * j + 4 * lane; const float bf = bforget[h];
        float s[4]; float run = 0.f;
#pragma unroll
        for (int e = 0; e < 4; ++e) { const float xx = CF[(row + e) * 8 + h] + bf; const float lf = (xx < 0.f ? xx : 0.f) - __logf(1.0f + __expf(-fabsf(xx))); run += lf; s[e] = run; }
        const float incl = wave_incl_scan(run, lane), excl = incl - run;
        *(f32x4*)(CL + (size_t)(b * 8 + h) * SEQ + 256 * j + 4 * lane) = (f32x4){excl + s[0], excl + s[1], excl + s[2], excl + s[3]};
        if (lane == 63) CT[(b * 8 + h) * 32 + j] = incl;
    }
}
#ifndef REP_IDX
#define REP_IDX 1
#endif
#ifndef REP_SPB
#define REP_SPB 1
#endif
#ifndef REP_SPA
#define REP_SPA 1
#endif
typedef unsigned u32x2 __attribute__((ext_vector_type(2)));
constexpr int NBIN = 1024;
__device__ __forceinline__ float pdist(float s, float sc, float inv) { return (s - sc) * inv + 0.0f; }
__device__ __forceinline__ unsigned pbin_d(float d) { const unsigned a = __float_as_uint(d) & 0x7fffffffu;
    int fx = (int)(a >> 19) - 1647; fx = fx < 0 ? 0 : (fx > 511 ? 511 : fx);
    return (__float_as_uint(d) >> 31) ? 511u - (unsigned)fx : 512u + (unsigned)fx; }
__device__ __forceinline__ unsigned pbin(float s, float sc, float inv) { return pbin_d(pdist(s, sc, inv)); }
__device__ __forceinline__ float pedge(int b) {
    if (b >= NBIN) return INFINITY; if (b <= 0) return -INFINITY;
    if (b > 512) return __uint_as_float((unsigned)(b - 512 + 1647) << 19);
    if (b == 512) return 0.0f;
    return -__uint_as_float(((unsigned)(511 - b + 1648) << 19) - 1u);
}
constexpr int CMAX = 1024;
#define LDS_ADD(p, v) __hip_atomic_fetch_add((p), (v), __ATOMIC_RELAXED, __HIP_MEMORY_SCOPE_WORKGROUP)
__device__ __forceinline__ unsigned okey(float s) { const unsigned u = __float_as_uint(s); return (u & 0x80000000u) ? ~u : (u | 0x80000000u); }
struct BAParams { const bf16 *IQ, *IK; const float* IW; const bf16 *QA, *QB, *KAB, *VAB; bf16* G; const float* sinks; };
__device__ __forceinline__ float relu_f(float x) { const int i = __float_as_int(x); return __int_as_float(i > 0 ? i : 0); }

template <int PASS, bool DIAG> __device__ __forceinline__ void idx_tile(const bf16x8 ak, const bf16x8 (&bq)[4], const f32x4 w4, int kt, int g4, int r, int tq, float elo, float ehi,
                                                                       LAS unsigned* hl, unsigned lp, unsigned hinc, LAS u32x2* cand, LAS unsigned short* sel, LAS unsigned* misc, LAS unsigned* zh, int zcut, float sc, float inv) {
    const f32x4 z = {0.f, 0.f, 0.f, 0.f};
    const f32x4 d0 = __builtin_amdgcn_mfma_f32_16x16x32_bf16(ak, bq[0], z, 0, 0, 0), d1 = __builtin_amdgcn_mfma_f32_16x16x32_bf16(ak, bq[1], z, 0, 0, 0),
                d2 = __builtin_amdgcn_mfma_f32_16x16x32_bf16(ak, bq[2], z, 0, 0, 0), d3 = __builtin_amdgcn_mfma_f32_16x16x32_bf16(ak, bq[3], z, 0, 0, 0);
    float sv[4]; bool qs[4], qc[4]; unsigned n1 = 0, n2 = 0;
#pragma unroll
    for (int i = 0; i < 4; ++i) {
        float s = 0.f; s = fmaf(w4[0], relu_f(d0[i]), s); s = fmaf(w4[1], relu_f(d1[i]), s); s = fmaf(w4[2], relu_f(d2[i]), s); s = fmaf(w4[3], relu_f(d3[i]), s);
        const int key = 16 * kt + 4 * g4 + i; sv[i] = s; const bool ok = !DIAG || key <= tq; const float d = pdist(s, sc, inv);
        if (PASS == 1) { if (ok) { const unsigned bin = pbin_d(d); LDS_ADD(hl + (bin * 32u + (lp ^ (bin & 31u))), hinc); if (s == 0.0f) LDS_ADD(zh + (key >> 7), 1u); } }
        else { qs[i] = ok && d >= ehi; qc[i] = ok && !(d >= ehi) && d >= elo && (s != 0.0f || key < zcut)  ;
               n1 += qs[i] ? 1u : 0u; n2 += qc[i] ? 1u : 0u; }
    }
    if (PASS == 2) {
        const unsigned add = n1 | (n2 << 16);
        if (add) { const unsigned pos = LDS_ADD(misc + MW_NSEL + r, add); unsigned p1 = pos & 0xffffu, p2 = pos >> 16;
#pragma unroll
            for (int i = 0; i < 4; ++i) { const int key = 16 * kt + 4 * g4 + i;
                if (qs[i]) { if (p1 < 256u) sel[p1] = (unsigned short)key; ++p1; }
                if (qc[i]) { if (p2 < (unsigned)CMAX) cand[p2] = (u32x2){okey(sv[i]), (unsigned)key}; ++p2; } } }
    }
}
template <int PASS> __device__ __forceinline__ void idx_pass(Frame& F, const bf16* IKb, const bf16x8 (&bq)[4], const f32x4 w4, int tau, int t0) {
    int lane_ = F.lane; asm volatile("" : "+v"(lane_)); const int lane = lane_, r = lane & 15, g4 = lane >> 4, tq = t0 + r;
    LAS unsigned* hl = (LAS unsigned*)(F.lds + RING_OFF); const unsigned lp = (unsigned)lane >> 1, hinc = 1u << ((lane & 1) * 16);
    LAS u32x2* cand = (LAS u32x2*)(F.lds + RING_OFF) + r * CMAX;
    LAS unsigned short* sel = (LAS unsigned short*)(F.lds + SEL_OFF) + r * 256;
    LAS unsigned* misc = (LAS unsigned*)(F.lds + MISC_OFF);
    float elo = 0.f, ehi = 0.f; int zcut = SEQ; if (PASS == 2) { elo = __uint_as_float(misc[MW_ELO + r]); ehi = __uint_as_float(misc[MW_ELO + 16 + r]); zcut = (int)misc[MW_ZCUT + r]; }
    LAS unsigned* zh = (LAS unsigned*)(F.lds + H2_OFF) + r * 64;
    const bf16* kp = IKb + (size_t)r * 32 + 8 * g4;
    float sc, inv; { const bf16x8 at = *(const bf16x8*)kp; const f32x4 z = {0.f, 0.f, 0.f, 0.f};
        const f32x4 d0 = __builtin_amdgcn_mfma_f32_16x16x32_bf16(at, bq[0], z, 0, 0, 0), d1 = __builtin_amdgcn_mfma_f32_16x16x32_bf16(at, bq[1], z, 0, 0, 0),
                    d2 = __builtin_amdgcn_mfma_f32_16x16x32_bf16(at, bq[2], z, 0, 0, 0), d3 = __builtin_amdgcn_mfma_f32_16x16x32_bf16(at, bq[3], z, 0, 0, 0);
        float mx = -INFINITY, ma = 0.f;
#pragma unroll
        for (int i = 0; i < 4; ++i) { float s = 0.f; s = fmaf(w4[0], relu_f(d0[i]), s); s = fmaf(w4[1], relu_f(d1[i]), s); s = fmaf(w4[2], relu_f(d2[i]), s); s = fmaf(w4[3], relu_f(d3[i]), s); mx = fmaxf(mx, s); ma = fmaxf(ma, fabsf(s)); }
        mx = fmaxf(mx, __shfl_xor(mx, 16)); mx = fmaxf(mx, __shfl_xor(mx, 32)); ma = fmaxf(ma, __shfl_xor(ma, 16)); ma = fmaxf(ma, __shfl_xor(ma, 32));
        sc = mx; inv = (ma > 1e-30f && ma < 1e30f) ? 1.0f / ma : 1.0f;
        if (PASS == 1 && F.wave == 0 && g4 == 0) { misc[MW_UC + r] = __float_as_uint(sc); misc[MW_UC + 16 + r] = __float_as_uint(inv); } }
    int kt = F.wave; if (kt > tau) return;
    bf16x8 a0 = *(const bf16x8*)(kp + (size_t)kt * 512);
    bf16x8 a1 = *(const bf16x8*)(kp + (size_t)(kt + 8 <= tau ? kt + 8 : kt) * 512);
    for (; kt <= tau; kt += 8) {
        const int k2 = kt + 16 <= tau ? kt + 16 : kt; const bf16x8 a2 = *(const bf16x8*)(kp + (size_t)k2 * 512);
        if (kt < tau) idx_tile<PASS, false>(a0, bq, w4, kt, g4, r, tq, elo, ehi, hl, lp, hinc, cand, sel, misc, zh, zcut, sc, inv);
        else          idx_tile<PASS, true>(a0, bq, w4, kt, g4, r, tq, elo, ehi, hl, lp, hinc, cand, sel, misc, zh, zcut, sc, inv);
        a0 = a1; a1 = a2;
    }
}
__device__ __forceinline__ void idx_threshold(Frame& F) {
    int lane_ = F.lane; asm volatile("" : "+v"(lane_)); const int lane = lane_; LAS unsigned* misc = (LAS unsigned*)(F.lds + MISC_OFF);
    for (int qq = 0; qq < 2; ++qq) { const int q = 2 * F.wave + qq; const unsigned sh = (q & 1) * 16, qh = (unsigned)q >> 1;
        const LAS unsigned* hb = (const LAS unsigned*)(F.lds + RING_OFF);
        int cnt[16];
#pragma unroll
        for (int k = 0; k < 16; ++k) { const unsigned bin = 64u * k + lane, sw = bin & 31u; const LAS unsigned* p = hb + bin * 32u;
            cnt[k] = (int)(((p[qh ^ sw] >> sh) & 0xffffu) + ((p[(qh + 8u) ^ sw] >> sh) & 0xffffu) + ((p[(qh + 16u) ^ sw] >> sh) & 0xffffu) + ((p[(qh + 24u) ^ sw] >> sh) & 0xffffu)); }
        int a8[8], a4[4], a2[2], a1;
        { const bool h5 = lane & 32, h4 = lane & 16, h3 = lane & 8, h2 = lane & 4;
#pragma unroll
          for (int i = 0; i < 8; ++i) { const int mine = h5 ? cnt[8 + i] : cnt[i], theirs = h5 ? cnt[i] : cnt[8 + i]; a8[i] = mine + __shfl_xor(theirs, 32); }
#pragma unroll
          for (int i = 0; i < 4; ++i) { const int mine = h4 ? a8[4 + i] : a8[i], theirs = h4 ? a8[i] : a8[4 + i]; a4[i] = mine + __shfl_xor(theirs, 16); }
#pragma unroll
          for (int i = 0; i < 2; ++i) { const int mine = h3 ? a4[2 + i] : a4[i], theirs = h3 ? a4[i] : a4[2 + i]; a2[i] = mine + __shfl_xor(theirs, 8); }
          { const int mine = h2 ? a2[1] : a2[0], theirs = h2 ? a2[0] : a2[1]; a1 = mine + __shfl_xor(theirs, 4); }
          a1 += __shfl_xor(a1, 1); a1 += __shfl_xor(a1, 2); }
        int ks = 0, aseg = 0, v = cnt[0]; { int cum = 0; bool found = false;
#pragma unroll
            for (int k = 15; k >= 0; --k) { const int Tk = __builtin_amdgcn_readlane(a1, 4 * k); if (!found && cum + Tk >= 256) { found = true; ks = k; aseg = cum; v = cnt[k]; } cum += Tk; } }
        const int pre = wave_incl_scan_i(v, lane);
        int tot = pre; tot = __shfl(tot, 63);
        const int suf = tot - pre + v;
        const unsigned long long mask = __ballot(aseg + suf >= 256);
        const int Ls = mask ? 63 - (int)__builtin_clzll(mask) : 0;
        if (lane == Ls) { const int bs = 64 * ks + lane; misc[MW_BIN + q] = (unsigned)bs; misc[MW_ABOVE + q] = (unsigned)(aseg + suf - v);
                          misc[MW_ELO + q] = __float_as_uint(pedge(bs)); misc[MW_ELO + 16 + q] = __float_as_uint(pedge(bs + 1)); }
        { const int binstar = __shfl(64 * ks + lane, Ls), needz = 256 - __shfl(aseg + suf - v, Ls);
          const int zc = (int)((const LAS unsigned*)(F.lds + H2_OFF))[q * 64 + lane]; const int zi = wave_incl_scan_i(zc, lane);
          const unsigned long long zm = __ballot(zi >= needz);
          if (lane == 0) misc[MW_ZCUT + q] = (binstar == (int)pbin(0.0f, __uint_as_float(misc[MW_UC + q]), __uint_as_float(misc[MW_UC + 16 + q])) && zm) ? (unsigned)(128 * ((int)__builtin_ctzll(zm) + 1)) : (unsigned)SEQ; }
    }
}
__device__ __forceinline__ unsigned idx_digit(const u32x2 e, int lvl) { const unsigned v = 8191u - e.y;
    return lvl == 0 ? e.x >> 24 : lvl == 1 ? (e.x >> 16) & 255u : lvl == 2 ? (e.x >> 8) & 255u : lvl == 3 ? e.x & 255u : lvl == 4 ? (v >> 5) & 255u : v & 31u; }
__device__ __forceinline__ void idx_resolve(Frame& F) {
    int lane_ = F.lane; asm volatile("" : "+v"(lane_)); const int lane = lane_; LAS unsigned* misc = (LAS unsigned*)(F.lds + MISC_OFF);
    LAS unsigned* h2 = (LAS unsigned*)(F.lds + H2_OFF) + F.wave * 256;
    for (int qq = 0; qq < 2; ++qq) { const int q = 2 * F.wave + qq;
        const unsigned packed = misc[MW_NSEL + q];
        if (lane == 0) misc[MW_NSEL + q] = packed & 0xffffu;
        int c = (int)(packed >> 16); if (c > CMAX) { c = CMAX; if (lane == 0) __hip_atomic_fetch_add(F.ctl + CW_OVF, 1u, RLX_AGENT); }
        int need = 256 - (int)misc[MW_ABOVE + q];
        LAS u32x2* cq = (LAS u32x2*)(F.lds + RING_OFF) + q * CMAX;
        LAS unsigned short* sel = (LAS unsigned short*)(F.lds + SEL_OFF) + q * 256;
        if (c > need && c <= 64) {
            u32x2 e = {0u, 0u}; if (lane < c) e = cq[lane]; int rank = 0;
            for (int j = 0; j < c; ++j) { const unsigned uj = (unsigned)__builtin_amdgcn_readlane((int)e.x, j), ij = (unsigned)__builtin_amdgcn_readlane((int)e.y, j); rank += (uj > e.x || (uj == e.x && ij < e.y)) ? 1 : 0; }
            if (lane < c && rank < need) { const unsigned pos = LDS_ADD(misc + MW_NSEL + q, 1u); if (pos < 256u) sel[pos] = (unsigned short)e.y; }
            c = 0; need = 0;
        }
#pragma unroll 1
        for (int lvl = 0; lvl < 6 && c > need; ++lvl) {
            *(LAS v4u*)(h2 + 4 * lane) = (v4u){0u, 0u, 0u, 0u};
            for (int i = lane; i < c; i += 64) LDS_ADD(h2 + idx_digit(cq[i], lvl), 1u);
            const v4u hw = *(const LAS v4u*)(h2 + 252 - 4 * lane);
            const int total = (int)(hw.x + hw.y + hw.z + hw.w), incl = wave_incl_scan_i(total, lane);
            const unsigned long long mask = __ballot(incl >= need);
            const int Ls = mask ? (int)__builtin_ctzll(mask) : 63;
            int dstar_l = 0, above_l = 0; { int cum = incl - total; bool found = false;
#pragma unroll
                for (int e = 3; e >= 0; --e) { const int cc = (int)hw[e]; if (!found && cum + cc >= need) { found = true; dstar_l = 252 - 4 * lane + e; above_l = cum; } cum += cc; } }
            const unsigned dstar = (unsigned)__shfl(dstar_l, Ls); const int above = __shfl(above_l, Ls);
            int c2 = 0;
            for (int base = 0; base < c; base += 64) { const int i = base + lane; const bool valid = i < c; u32x2 e = {0u, 0u}; if (valid) e = cq[i];
                const unsigned dg = idx_digit(e, lvl); const bool tie = valid && dg == dstar;
                if (valid && dg > dstar) { const unsigned pos = LDS_ADD(misc + MW_NSEL + q, 1u); if (pos < 256u) sel[pos] = (unsigned short)e.y; }
                const unsigned long long tm = __ballot(tie);
                if (tie) cq[c2 + __popcll(tm & ((1ull << lane) - 1ull))] = e;
                c2 += __popcll(tm); }
            c = c2; need -= above;
        }
        for (int i = lane; i < c && i < need; i += 64) { const unsigned pos = LDS_ADD(misc + MW_NSEL + q, 1u); if (pos < 256u) sel[pos] = (unsigned short)cq[i].y; }
    }
}
typedef short s16x4 __attribute__((ext_vector_type(4)));
__device__ __forceinline__ void sp_glds16(const void* gsrc, unsigned lds_dst) { unsigned keep;
    asm volatile("s_mov_b32 %0, m0\n\ts_mov_b32 m0, %2\n\ts_nop 0\n\tglobal_load_lds_dwordx4 %1, off\n\ts_mov_b32 m0, %0" : "=&s"(keep) : "v"(gsrc), "s"(lds_dst) : "memory"); }
__device__ __forceinline__ void sp_glds16s(const void* sbase, unsigned voff, unsigned lds_dst) { unsigned keep;
    asm volatile("s_mov_b32 %0, m0\n\ts_mov_b32 m0, %3\n\ts_nop 0\n\tglobal_load_lds_dwordx4 %1, %2\n\ts_mov_b32 m0, %0" : "=&s"(keep) : "v"(voff), "s"(sbase), "s"(lds_dst) : "memory"); }
template <bool IS_A> __device__ __forceinline__ void sparse_pair(Frame& F, const BAParams& P, int rb, int tA, int qi0, int nv0, int nv1, bool dry) {
    constexpr int NC = IS_A ? 8 : 16, NSLOT = NC * 16, KOFF = IS_A ? 0 : M * 128, HB = IS_A ? 0 : 8, GOFF = IS_A ? 0 : 512;
    int lane_ = F.lane; asm volatile("" : "+v"(lane_)); const int lane = lane_, r = lane & 15, g4 = lane >> 4, my_a = g4 >> 1, my_j = g4 & 1;
    const bf16* Q = IS_A ? P.QA : P.QB;
    const LAS unsigned short* sel = (const LAS unsigned short*)(F.lds + SEL_OFF) + qi0 * 256;
    const LAS float* BIAS = (const LAS float*)(F.lds + BIAS_OFF);
    const LAS unsigned char* BKT = (const LAS unsigned char*)(F.lds + BKT_OFF);
    LAS unsigned short* Pimg = (LAS unsigned short*)(F.lds + RING_OFF + F.wave * 16384);
    bf16x8 q0, q1; const bf16x8 zz = {0, 0, 0, 0, 0, 0, 0, 0};
    { const int a_r = r >> 3, hd = r & 7; const bf16* qp = Q + (size_t)(rb + tA + a_r) * 512 + hd * 64 + 8 * g4; q0 = *(const bf16x8*)qp; q1 = *(const bf16x8*)(qp + 32); }
    const int my_t = tA + my_a, rcb = r >> 2;
    f32x4 x[NC];
#pragma unroll
    for (int c = 0; c < NC; ++c) x[c] = (f32x4){0.f, 0.f, 0.f, 0.f};
    constexpr int KS = NSLOT / 32, NST = 4 * KS;
    const unsigned wk = (unsigned)__builtin_amdgcn_readfirstlane((int)((unsigned)(uintptr_t)(F.lds + RING_OFF) + (unsigned)F.wave * 16384u));
    const int drow = lane >> 3, dpc = lane & 7;
#define SP_KDMA(st, bufi) do { const int cb_ = (st) / KS, ks_ = (st) % KS, a_ = cb_ >> 1, j_ = cb_ & 1; const unsigned dst_ = wk + (unsigned)((bufi) * 4096); \
        _Pragma("unroll") for (int i_ = 0; i_ < 4; ++i_) { const int slot_ = 32 * ks_ + 8 * i_ + drow; int key_; \
            if (IS_A) { key_ = tA + a_ - slot_; key_ = key_ < 0 ? 0 : key_; } else { key_ = sel[a_ * 256 + slot_]; }   \
            sp_glds16s(P.KAB, (unsigned)(((rb + key_) * 128 + KOFF + j_ * 64 + ((dpc ^ (drow & 7)) * 8)) * 2), (unsigned)__builtin_amdgcn_readfirstlane((int)(dst_ + i_ * 1024))); } } while (0)
    asm volatile("s_waitcnt vmcnt(0)" ::: "memory");
    SP_KDMA(0, 0); SP_KDMA(1, 1); SP_KDMA(2, 2); if (NST > 3) SP_KDMA(3, 3);
    { const LAS unsigned char* kring = F.lds + RING_OFF + F.wave * 16384;
      static_assert(KS % 4 == 0, "the ring position of a step is its k-step index mod 4");
#pragma unroll 1
      for (int cb = 0; cb < 4; ++cb) { const bool mine = rcb == cb; const bf16x8 a0 = mine ? q0 : zz, a1 = mine ? q1 : zz;
#pragma unroll
        for (int ks = 0; ks < KS; ++ks) { const int st = cb * KS + ks;
          if (cb < 3 || ks + 3 < KS) asm volatile("s_waitcnt vmcnt(12)" ::: "memory"); else if (ks + 2 < KS) asm volatile("s_waitcnt vmcnt(8)" ::: "memory"); else if (ks + 1 < KS) asm volatile("s_waitcnt vmcnt(4)" ::: "memory"); else asm volatile("s_waitcnt vmcnt(0)" ::: "memory");
          const LAS unsigned char* kb = kring + (ks & 3) * 4096;
          bf16x8 f[2][2];
#pragma unroll
          for (int cc = 0; cc < 2; ++cc)
#pragma unroll
              for (int k2 = 0; k2 < 2; ++k2) f[cc][k2] = *(const LAS bf16x8*)(kb + (16 * cc + r) * 128 + (((4 * k2 + g4) ^ (r & 7)) * 16));
          asm volatile("s_waitcnt lgkmcnt(0)" ::: "memory");
#pragma unroll
          for (int cc = 0; cc < 2; ++cc) { x[2 * ks + cc] = __builtin_amdgcn_mfma_f32_16x16x32_bf16(a0, f[cc][0], x[2 * ks + cc], 0, 0, 0); x[2 * ks + cc] = __builtin_amdgcn_mfma_f32_16x16x32_bf16(a1, f[cc][1], x[2 * ks + cc], 0, 0, 0); }
          if (st + 4 < NST) SP_KDMA(st + 4, ks & 3);
        } } }
#undef SP_KDMA
#pragma unroll
    for (int c = 0; c < NC; ++c) { const int slot = 16 * c + r; int mk; bool mv;
        if (IS_A) { mk = my_t - slot; mv = mk >= 0; } else { mk = sel[my_a * 256 + slot]; mv = slot < (my_a ? nv1 : nv0); }
        const int delta = my_t - mk; const bool ok = mv && delta >= 0;
        const int bk = (ok && delta < 512) ? (int)BKT[delta] : 31;
        const f32x4 b4 = *(const LAS f32x4*)(BIAS + bk * 16 + HB + 4 * my_j);
#pragma unroll
        for (int i = 0; i < 4; ++i) x[c][i] = ok ? x[c][i] * 0.125f + b4[i] : -INFINITY; }
    f32x4 mx = x[0];
#pragma unroll
    for (int c = 1; c < NC; ++c)
#pragma unroll
        for (int i = 0; i < 4; ++i) mx[i] = fmaxf(mx[i], x[c][i]);
#pragma unroll
    for (int o = 1; o < 16; o <<= 1)
#pragma unroll
        for (int i = 0; i < 4; ++i) mx[i] = fmaxf(mx[i], __shfl_xor(mx[i], o));
    f32x4 sk = {0.f, 0.f, 0.f, 0.f};
    if (IS_A) { sk = *(const f32x4*)(P.sinks + 4 * my_j);
#pragma unroll
        for (int i = 0; i < 4; ++i) mx[i] = fmaxf(mx[i], sk[i]); }
    f32x4 sum = {0.f, 0.f, 0.f, 0.f};
#pragma unroll
    for (int c = 0; c < NC; ++c)
#pragma unroll
        for (int i = 0; i < 4; ++i) { x[c][i] = __expf(x[c][i] - mx[i]); sum[i] += x[c][i]; }
#pragma unroll
    for (int o = 1; o < 16; o <<= 1)
#pragma unroll
        for (int i = 0; i < 4; ++i) sum[i] += __shfl_xor(sum[i], o);
    if (IS_A) {
#pragma unroll
        for (int i = 0; i < 4; ++i) sum[i] += __expf(sk[i] - mx[i]); }
    f32x4 inv;
#pragma unroll
    for (int i = 0; i < 4; ++i) inv[i] = 1.0f / sum[i];
#define SP_PWRITE(qa) do { if (my_a == (qa)) { _Pragma("unroll") for (int c_ = 0; c_ < NC; ++c_) _Pragma("unroll") for (int i_ = 0; i_ < 4; ++i_) \
        Pimg[(4 * my_j + i_) * NSLOT + 16 * c_ + r] = (unsigned short)f2bf(x[c_][i_] * inv[i_]); } } while (0)
    SP_PWRITE(0);
    const unsigned wl = wk + 4096u;
#define SP_VDMA(st, bufi) do { const int cb_ = (st) / KS, ks_ = (st) % KS, a_ = cb_ >> 1, j_ = cb_ & 1; const unsigned dst_ = wl + (unsigned)((bufi) * 4096); \
        _Pragma("unroll") for (int i_ = 0; i_ < 4; ++i_) { const int slot_ = 32 * ks_ + 8 * i_ + drow; int key_; \
            if (IS_A) { key_ = tA + a_ - slot_; key_ = key_ < 0 ? 0 : key_; } else { key_ = sel[a_ * 256 + slot_]; } \
            sp_glds16s(P.VAB, (unsigned)(((rb + key_) * 128 + KOFF + j_ * 64 + dpc * 8) * 2), (unsigned)__builtin_amdgcn_readfirstlane((int)(dst_ + i_ * 1024))); } } while (0)
    asm volatile("s_waitcnt vmcnt(0)" ::: "memory");
    SP_VDMA(0, 0); SP_VDMA(1, 1); SP_VDMA(2, 2);
    f32x4 o[4];
#pragma unroll
    for (int db = 0; db < 4; ++db) o[db] = (f32x4){0.f, 0.f, 0.f, 0.f};
    const unsigned trb = (unsigned)((8 * g4 + ((lane & 15) >> 2)) * 128 + (lane & 3) * 8);
    int bufi = 0;
#pragma unroll 1
    for (int cb = 0; cb < 4; ++cb) { const bool minep = rcb == cb;
        if (cb == 2) { SP_PWRITE(1); }
#pragma unroll
        for (int ks = 0; ks < KS; ++ks) { const int st = cb * KS + ks;
            if (cb < 3 || ks + 2 < KS) asm volatile("s_waitcnt vmcnt(8)" ::: "memory"); else if (ks + 1 < KS) asm volatile("s_waitcnt vmcnt(4)" ::: "memory"); else asm volatile("s_waitcnt vmcnt(0)" ::: "memory");
            const unsigned vb = wl + (unsigned)(bufi * 4096) + trb;
            s16x4 lo[4], hi[4];
#pragma unroll
            for (int db = 0; db < 4; ++db) {
                asm volatile("ds_read_b64_tr_b16 %0, %1 offset:%c2" : "=&v"(lo[db]) : "v"(vb), "i"(db * 32) : "memory");
                asm volatile("ds_read_b64_tr_b16 %0, %1 offset:%c2" : "=&v"(hi[db]) : "v"(vb), "i"(db * 32 + 512) : "memory"); }
            bf16x8 pb = *(const LAS bf16x8*)(Pimg + (r & 7) * NSLOT + 32 * ks + 8 * g4);
            pb = minep ? pb : zz;
            asm volatile("s_waitcnt lgkmcnt(0)" ::: "memory");
#pragma unroll
            for (int db = 0; db < 4; ++db) { const bf16x8 va = {lo[db][0], lo[db][1], lo[db][2], lo[db][3], hi[db][0], hi[db][1], hi[db][2], hi[db][3]};
                o[db] = __builtin_amdgcn_mfma_f32_16x16x32_bf16(va, pb, o[db], 0, 0, 0); }
            if (st + 3 < NST) SP_VDMA(st + 3, bufi);
            bufi = bufi == 2 ? 0 : bufi + 1;
        } }
#undef SP_VDMA
#undef SP_PWRITE
    if (!dry) { bf16* gp = P.G + (size_t)(rb + tA + (r >> 3)) * 1536 + GOFF + (r & 7) * 64 + 4 * g4;
#pragma unroll
        for (int db = 0; db < 4; ++db) { const u32x2 gt = *(const u32x2*)(gp + 16 * db);
            const float g0 = __uint_as_float(gt.x << 16), g1 = __uint_as_float(gt.x & 0xffff0000u), g2 = __uint_as_float(gt.y << 16), g3 = __uint_as_float(gt.y & 0xffff0000u);
            u32x2 w; w.x = pk2(o[db][0] * g0, o[db][1] * g1); w.y = pk2(o[db][2] * g2, o[db][3] * g3);
            *(u32x2*)(gp + 16 * db) = w; } }
}
__device__ __forceinline__ void swa_dense(Frame& F, const BAParams& P, int rb, int t0, bool dry) {
    constexpr int NC = 10, NSLOT = 160, NST = 5;
    int lane_ = F.lane; asm volatile("" : "+v"(lane_)); const int lane = lane_, r = lane & 15, g4 = lane >> 4, j = F.wave >> 2, qg = F.wave & 3, kbase = t0 - 128;
    const LAS float* BIAS = (const LAS float*)(F.lds + BIAS_OFF);
    const LAS unsigned char* BKT = (const LAS unsigned char*)(F.lds + BKT_OFF);
    LAS unsigned short* Pimg = (LAS unsigned short*)(F.lds + RING_OFF + F.wave * 16384);
    bf16x8 qf[2]; { const bf16* qp = P.QA + (size_t)(rb + t0 + 4 * qg + (r >> 2)) * 512 + (4 * j + (r & 3)) * 64 + 8 * g4; qf[0] = *(const bf16x8*)qp; qf[1] = *(const bf16x8*)(qp + 32); }
    bf16x8 kf[NC][2];
#pragma unroll
    for (int c = 0; c < NC; ++c) { int key = kbase + 16 * c + r; key = key < 0 ? 0 : (key > SEQ - 1 ? SEQ - 1 : key);
        const bf16* kp = P.KAB + (size_t)(rb + key) * 128 + j * 64 + 8 * g4; kf[c][0] = *(const bf16x8*)kp; kf[c][1] = *(const bf16x8*)(kp + 32); }
    const int my_t = t0 + 4 * qg + g4;
    f32x4 x[NC];
#pragma unroll
    for (int c = 0; c < NC; ++c) { f32x4 d = {0.f, 0.f, 0.f, 0.f};
        d = __builtin_amdgcn_mfma_f32_16x16x32_bf16(qf[0], kf[c][0], d, 0, 0, 0); d = __builtin_amdgcn_mfma_f32_16x16x32_bf16(qf[1], kf[c][1], d, 0, 0, 0);
        const int key = kbase + 16 * c + r, delta = my_t - key; const bool ok = key >= 0 && delta >= 0 && delta < 128;
        const int bk = (int)BKT[ok ? delta : 0];
        const f32x4 b4 = *(const LAS f32x4*)(BIAS + bk * 16 + 4 * j);
#pragma unroll
        for (int i = 0; i < 4; ++i) x[c][i] = ok ? d[i] * 0.125f + b4[i] : -INFINITY; }
    f32x4 mx = *(const f32x4*)(P.sinks + 4 * j); const f32x4 sk = mx;
#pragma unroll
    for (int c = 0; c < NC; ++c)
#pragma unroll
        for (int i = 0; i < 4; ++i) mx[i] = fmaxf(mx[i], x[c][i]);
#pragma unroll
    for (int o = 1; o < 16; o <<= 1)
#pragma unroll
        for (int i = 0; i < 4; ++i) mx[i] = fmaxf(mx[i], __shfl_xor(mx[i], o));
    f32x4 sum = {0.f, 0.f, 0.f, 0.f};
#pragma unroll
    for (int c = 0; c < NC; ++c)
#pragma unroll
        for (int i = 0; i < 4; ++i) { x[c][i] = __expf(x[c][i] - mx[i]); sum[i] += x[c][i]; }
#pragma unroll
    for (int o = 1; o < 16; o <<= 1)
#pragma unroll
        for (int i = 0; i < 4; ++i) sum[i] += __shfl_xor(sum[i], o);
    f32x4 inv;
#pragma unroll
    for (int i = 0; i < 4; ++i) inv[i] = 1.0f / (sum[i] + __expf(sk[i] - mx[i]));
#pragma unroll
    for (int c = 0; c < NC; ++c)
#pragma unroll
        for (int i = 0; i < 4; ++i) Pimg[(4 * g4 + i) * NSLOT + 16 * c + r] = (unsigned short)f2bf(x[c][i] * inv[i]);
    const unsigned wl = (unsigned)__builtin_amdgcn_readfirstlane((int)((unsigned)(uintptr_t)(F.lds + RING_OFF) + (unsigned)F.wave * 16384u + 8192u));
    const int drow = lane >> 3, dpc = lane & 7;
#define SW_VDMA(st) do { const unsigned dst_ = wl + (unsigned)(((st) & 1) * 4096); \
        _Pragma("unroll") for (int i_ = 0; i_ < 4; ++i_) { int key_ = kbase + 32 * (st) + 8 * i_ + drow; key_ = key_ < 0 ? 0 : (key_ > SEQ - 1 ? SEQ - 1 : key_); \
            sp_glds16s(P.VAB, (unsigned)(((rb + key_) * 128 + j * 64 + dpc * 8) * 2), (unsigned)__builtin_amdgcn_readfirstlane((int)(dst_ + i_ * 1024))); } } while (0)
    asm volatile("s_waitcnt vmcnt(0)" ::: "memory");
    SW_VDMA(0); SW_VDMA(1);
    f32x4 o[4];
#pragma unroll
    for (int db = 0; db < 4; ++db) o[db] = (f32x4){0.f, 0.f, 0.f, 0.f};
    const unsigned trb = (unsigned)((8 * g4 + ((lane & 15) >> 2)) * 128 + (lane & 3) * 8);
#pragma unroll 1
    for (int st = 0; st < NST; ++st) {
        if (st + 1 < NST) asm volatile("s_waitcnt vmcnt(4)" ::: "memory"); else asm volatile("s_waitcnt vmcnt(0)" ::: "memory");
        const unsigned vb = wl + (unsigned)((st & 1) * 4096) + trb;
        s16x4 lo[4], hi[4];
#pragma unroll
        for (int db = 0; db < 4; ++db) {
            asm volatile("ds_read_b64_tr_b16 %0, %1 offset:%c2" : "=&v"(lo[db]) : "v"(vb), "i"(db * 32) : "memory");
            asm volatile("ds_read_b64_tr_b16 %0, %1 offset:%c2" : "=&v"(hi[db]) : "v"(vb), "i"(db * 32 + 512) : "memory"); }
        const bf16x8 pb = *(const LAS bf16x8*)(Pimg + r * NSLOT + 32 * st + 8 * g4);
        asm volatile("s_waitcnt lgkmcnt(0)" ::: "memory");
#pragma unroll
        for (int db = 0; db < 4; ++db) { const bf16x8 va = {lo[db][0], lo[db][1], lo[db][2], lo[db][3], hi[db][0], hi[db][1], hi[db][2], hi[db][3]};
            o[db] = __builtin_amdgcn_mfma_f32_16x16x32_bf16(va, pb, o[db], 0, 0, 0); }
        if (st + 2 < NST) SW_VDMA(st + 2);
    }
#undef SW_VDMA
    if (!dry) { bf16* gp = P.G + (size_t)(rb + t0 + 4 * qg + (r >> 2)) * 1536 + (4 * j + (r & 3)) * 64 + 4 * g4;
#pragma unroll
        for (int db = 0; db < 4; ++db) { const u32x2 gt = *(const u32x2*)(gp + 16 * db);
            const float g0 = __uint_as_float(gt.x << 16), g1 = __uint_as_float(gt.x & 0xffff0000u), g2 = __uint_as_float(gt.y << 16), g3 = __uint_as_float(gt.y & 0xffff0000u);
            u32x2 w; w.x = pk2(o[db][0] * g0, o[db][1] * g1); w.y = pk2(o[db][2] * g2, o[db][3] * g3);
            *(u32x2*)(gp + 16 * db) = w; } }
}
__device__ __forceinline__ void ba_clear(Frame& F) {
    LAS v4u* hz = (LAS v4u*)(F.lds + RING_OFF + F.wave * 16384);
#pragma unroll
    for (int i = 0; i < 16; ++i) hz[F.lane + 64 * i] = (v4u){0u, 0u, 0u, 0u};
    if (F.tid < 32) ((LAS unsigned*)(F.lds + MISC_OFF))[F.tid] = 0u;
    for (int i = F.tid; i < 16 * 64; i += 512) ((LAS unsigned*)(F.lds + H2_OFF))[i] = 0u;
}
__device__ __forceinline__ void ba_unit(Frame& F, const BAParams& P, int b, int tau, bool dry) {
    { int l_ = (int)__builtin_amdgcn_mbcnt_hi(~0u, __builtin_amdgcn_mbcnt_lo(~0u, 0u)); asm volatile("" : "+v"(l_)); F.lane = l_; F.tid = F.wave * 64 + l_; }
    const int t0 = tau * 16, rb = b * SEQ, lane = F.lane;
    LAS unsigned* misc = (LAS unsigned*)(F.lds + MISC_OFF);
    for (int ri = 0; ri < REP_IDX; ++ri)
    if (tau >= 16) {
        if (ri) { __syncthreads(); ba_clear(F); __syncthreads(); }
        bf16x8 bq[4]; const int r = lane & 15, g4 = lane >> 4;
#pragma unroll
        for (int h = 0; h < 4; ++h) bq[h] = *(const bf16x8*)(P.IQ + (size_t)(rb + t0 + r) * 128 + h * 32 + 8 * g4);
        const f32x4 w4 = *(const f32x4*)(P.IW + (size_t)(rb + t0 + r) * 4);
        const bf16* IKb = P.IK + (size_t)rb * 32;
        idx_pass<1>(F, IKb, bq, w4, tau, t0);
        __syncthreads();
        idx_threshold(F);
        __syncthreads();
        idx_pass<2>(F, IKb, bq, w4, tau, t0);
        __syncthreads();
        idx_resolve(F);
    } else {
        LAS unsigned short* sel = (LAS unsigned short*)(F.lds + SEL_OFF);
        for (int i = F.tid; i < 16 * 256; i += 512) sel[i] = (unsigned short)(i & 255);
    }
    __syncthreads();
    const int tA = t0 + 2 * F.wave, nv0 = tA >= 256 ? 256 : tA + 1, nv1 = tA + 1 >= 256 ? 256 : tA + 2;
    for (int rs = 0; rs < REP_SPB; ++rs) sparse_pair<false>(F, P, rb, tA, 2 * F.wave, nv0, nv1, dry || rs + 1 < REP_SPB);
    for (int rs = 0; rs < REP_SPA; ++rs) swa_dense(F, P, rb, t0, dry || rs + 1 < REP_SPA);
    ba_clear(F);
}

#ifndef REP_P1A
#define REP_P1A 1
#endif
#ifndef REP_C
#define REP_C 1
#endif
#ifndef REP_BA
#define REP_BA 1
#endif
#ifndef REP_P1B
#define REP_P1B 1
#endif
#ifndef REP_P3
#define REP_P3 1
#endif
#ifndef REP_P0
#define REP_P0 1
#endif
#ifndef FOX_SKIP_LOG2
#define FOX_SKIP_LOG2 (-80.0f)
#endif
#ifndef MK_ONE_LAUNCH
#define MK_ONE_LAUNCH 1
#endif
constexpr int NPHASES = 1 + 6 * DEPTH;
struct Args { const float* in[9]; float* out; unsigned char* ws; int ph_lo, ph_hi; };
static_assert(sizeof(Args) == 9 * 8 + 8 + 8 + 4 + 4, "no padding bytes in the argument struct");

typedef const __attribute__((address_space(4))) Args* ArgP;
__device__ __forceinline__ ArgP argp() { ArgP p = (ArgP)__builtin_amdgcn_kernarg_segment_ptr(); asm volatile("" : "+s"(p)); return p; }
__global__ void __launch_bounds__(512, 2) mk_fwd(Args args) {
    extern __shared__ __attribute__((aligned(16))) unsigned char lds[];
    Frame F;
    F.lds = (LAS unsigned char*)lds;
    F.MISC = (volatile LAS unsigned*)(F.lds + MISC_OFF);
    F.tid = threadIdx.x; F.lane = F.tid & 63; F.wave = __builtin_amdgcn_readfirstlane(F.tid >> 6);
    F.G = gridDim.x; { const int bx = blockIdx.x; F.vcu = (F.G % 8 == 0) ? (bx % 8) * (F.G / 8) + bx / 8 : bx; }
    F.ctl = (gu32*)(argp()->ws + WS_CTL);
    for (int u = F.tid; u < 256; u += 512) ((LAS unsigned*)(F.lds + MISC_OFF))[u] = 0u;
    for (int u = F.tid; u < 512; u += 512) { ((LAS float*)(F.lds + BIAS_OFF))[u] = argp()->in[8][u];
        int bk; if (u < 16) bk = u; else { const float nf = (float)u; int lg = 16 + (int)(logf(nf / 16.0f) / 3.4657359027997265f * 16.0f); bk = lg < 31 ? lg : 31; }
        ((LAS unsigned char*)(F.lds + BKT_OFF))[u] = (unsigned char)bk; }
    __syncthreads();
    XcdBarrier bar; bar.bar = (unsigned*)(F.ctl + CW_BAR); bar.x = 0; bar.st = nullptr;
    if (MK_ONE_LAUNCH) bar = xcd_barrier_post((unsigned*)(F.ctl + CW_BAR), F.MISC + MW_BAR);
    const int lo = argp()->ph_lo, hi = argp()->ph_hi;
#define IN(k) (lo <= (k) && (k) < hi)
#define SEAM(k) do { if (IN(k) && IN((k) + 1)) xcd_barrier(bar); } while (0)
#define PHASE_BEGIN() do { int l_ = (int)__builtin_amdgcn_mbcnt_hi(~0u, __builtin_amdgcn_mbcnt_lo(~0u, 0u)); asm volatile("" : "+v"(l_)); F.lane = l_; F.tid = F.wave * 64 + l_; } while (0)

    if (IN(0)) { PHASE_BEGIN(); ArgP a = argp(); for (int rp = 0; rp < REP_P0; ++rp) p0_prologue(F, a->in[0], a->in[1], a->in[2], a->in[6], a->in[7], a->ws); SEAM(0); }

    for (int L = 0; L < DEPTH; ++L) {
        const int pb = 1 + 6 * L;
        if (IN(pb)) { PHASE_BEGIN();
            unsigned char* ws = argp()->ws; const pg8::bf16_t* W1T = (const pg8::bf16_t*)(ws + WS_W1T) + (size_t)L * NTILES * 256 * 1024;
            pg8::Gemm g{(const pg8::bf16_t*)(ws + WS_XB), W1T, M, NT_A * 256, 1024, 1024, 1024, 0}; pg8::StaticOrder S; S.init(M, NT_A * 256, F.G, (int)blockIdx.x);
            pg8::EpiIn E{ws, argp()->in[4] + L * 384, argp()->in[3] + L * 8};
            for (int rp = 0; rp < REP_P1A; ++rp) pg8::gemm_phase<pg8::EpiIn, pg8::StaticOrder, true, true>(F.lds + RING_OFF, g, S, E, F.wave);
            SEAM(pb);
        }
        if (IN(pb + 2)) { PHASE_BEGIN();
            unsigned char* ws = argp()->ws;
            const float* CL = (const float*)(ws + WS_CL); const float* CT = (const float*)(ws + WS_CT);
            LAS float* carry = (LAS float*)(F.lds + H2_OFF)  ; LAS unsigned* nbw = (LAS unsigned*)(F.lds + RING_OFF + NB_OFF);
            for (int rp = 0; rp < REP_C; ++rp) {
            LAS unsigned* miscw = (LAS unsigned*)(F.lds + MISC_OFF);
            for (int kg = 0; kg < 8; ++kg) { const int xg = ((F.vcu >> 5) + kg) & 7;
            gu32* const tick = F.ctl + CW_TICK + 64 * (8 * (2 * L + rp % 2) + xg);
            if (F.tid == 0) miscw[MW_TICKET] = __hip_atomic_fetch_add(tick, 1u, RLX_AGENT);
            __syncthreads();
            for (;;) {
                PHASE_BEGIN();
                const int ui = (int)miscw[MW_TICKET];
                if (ui >= 128) { __syncthreads(); break; }
                const int qb = 31 - (ui >> 2), bh = 4 * xg + (ui & 3);
                    if (F.wave == 0) { const float t0 = CT[bh * 128 + 2 * F.lane], t1 = CT[bh * 128 + 2 * F.lane + 1]; const float inc = wave_incl_scan(t0 + t1, F.lane); carry[2 * F.lane] = inc - (t0 + t1); carry[2 * F.lane + 1] = inc - t1; }
                    __syncthreads();
                    const float cref = carry[4 * qb]; int tskip;
                    { const float* gq = argp()->in[4] + L * 384 + 256; const float g1 = fabsf(gq[F.lane]), g2 = fabsf(gq[64 + F.lane]); float mq = g1, mk = g2;
#pragma unroll
                      for (int o = 1; o < 64; o <<= 1) { mq = fmaxf(mq, __shfl_xor(mq, o)); mk = fmaxf(mk, __shfl_xor(mk, o)); }
                      const float thr = FOX_SKIP_LOG2 - 2.0f * (11.8f * mq * mk + 0.5f);
                      const int NTt = 4 * (qb + 1); const int t_a = F.lane, t_b = 64 + F.lane, k_a = 64 * t_a + 63, k_b = 64 * t_b + 63;
                      const float n_a = t_a < NTt ? (cref - (carry[k_a >> 6] + CL[(size_t)bh * SEQ + k_a])) * 1.4426950408889634f : 0.f, n_b = t_b < NTt ? (cref - (carry[k_b >> 6] + CL[(size_t)bh * SEQ + k_b])) * 1.4426950408889634f : 0.f;
                      const bool s_a = t_a < NTt && n_a < thr, s_b = t_b < NTt && n_b < thr;
                      const unsigned long long f_a = __ballot(!s_a), f_b = __ballot(!s_b);
                      int cnt = f_a ? (int)__builtin_ctzll(f_a) : 64 + (f_b ? (int)__builtin_ctzll(f_b) : 64);
                      cnt &= ~1; tskip = cnt > NTt - 4 ? NTt - 4 : cnt; }
                    { const int nk = 256 * (qb + 1);
                      for (int k = 64 * tskip + F.tid; k < nk; k += 512) { const float xb = (cref - (carry[k >> 6] + CL[(size_t)bh * SEQ + k])) * 1.4426950408889634f;
                          const unsigned h = f2bf(xb), l = f2bf(xb - __uint_as_float(h << 16)); nbw[k] = h | (l << 16); } }
                    __syncthreads();
                    attn_body::attn_unit<8>(bh >> 3, bh & 7, qb, (const attn_body::bf16*)(ws + WS_QC), (const attn_body::bf16*)(ws + WS_KC), (const attn_body::bf16*)(ws + WS_VC), (attn_body::bf16*)(ws + WS_G),
                                            (char*)lds + RING_OFF, (attn_body::lds_cuptr)(F.lds + RING_OFF + NB_OFF), tskip, rp + 1 < REP_C, F.wave);
                if (F.tid == 0) miscw[MW_TICKET] = __hip_atomic_fetch_add(tick, 1u, RLX_AGENT);
                __syncthreads();
            } } }
            __syncthreads(); PHASE_BEGIN();
            const BAParams P{(const bf16*)(ws + WS_IQ), (const bf16*)(ws + WS_IK), (const float*)(ws + WS_IW), (const bf16*)(ws + WS_QA), (const bf16*)(ws + WS_QB), (const bf16*)(ws + WS_KAB), (const bf16*)(ws + WS_VAB),
                             (bf16*)(ws + WS_G), argp()->in[5] + L * 8};
            for (int rp = 0; rp < REP_BA; ++rp) {
            LAS unsigned* miscw = (LAS unsigned*)(F.lds + MISC_OFF);
            for (int kg = 0; kg < 4; ++kg) { const int bq = ((F.vcu >> 6) + kg) & 3;
            gu32* const tick = F.ctl + CW_TICK + 64 * (32 + 4 * (2 * L + rp % 2) + bq);
            ba_clear(F);
            if (F.tid == 0) miscw[MW_TICKET] = __hip_atomic_fetch_add(tick, 1u, RLX_AGENT);
            __syncthreads();
            for (;;) {
                PHASE_BEGIN();
                const int ui = (int)miscw[MW_TICKET];
                if (ui >= 512) { __syncthreads(); break; }
                ba_unit(F, P, bq, 511 - ui, rp + 1 < REP_BA);
                if (F.tid == 0) miscw[MW_TICKET] = __hip_atomic_fetch_add(tick, 1u, RLX_AGENT);
                __syncthreads();
            } } }
            SEAM(pb + 2);
        }
        if (IN(pb + 3)) { PHASE_BEGIN();
            unsigned char* ws = argp()->ws; const pg8::bf16_t* W1T = (const pg8::bf16_t*)(ws + WS_W1T) + (size_t)L * NTILES * 256 * 1024;
            pg8::Gemm g{(const pg8::bf16_t*)(ws + WS_XB), W1T + (size_t)NT_A * 256 * 1024, M, NT_B * 256, 1024, 1024, 1024, 0}; pg8::StaticOrder S; S.init(M, NT_B * 256, F.G, (int)blockIdx.x);
            pg8::EpiGate E{(const float*)(ws + WS_SSQ), (unsigned char*)(ws + WS_MG)};
            for (int rp = 0; rp < REP_P1B; ++rp) pg8::gemm_phase<pg8::EpiGate, pg8::StaticOrder, true, true>(F.lds + RING_OFF, g, S, E, F.wave);
            SEAM(pb + 3);
        }
        if (IN(pb + 4)) { PHASE_BEGIN();
            unsigned char* ws = argp()->ws;
            pg8::Gemm g{(const pg8::bf16_t*)(ws + WS_G), (const pg8::bf16_t*)(ws + WS_WBT) + (size_t)L * 3 * 1024 * 512, M, 1024, 512, 1536, 512, 4};
            pg8::SegOrder S; S.base.init(M, 1024, F.G, (int)blockIdx.x);
            pg8::EpiMerge E{(const unsigned char*)(ws + WS_MG), (pg8::bf16_t*)(ws + WS_MERGED)};
            for (int rp = 0; rp < REP_P3; ++rp) pg8::gemm_phase<pg8::EpiMerge, pg8::SegOrder, true, true>(F.lds + RING_OFF, g, S, E, F.wave);
            SEAM(pb + 4);
        }
        if (IN(pb + 5)) { PHASE_BEGIN();
            unsigned char* ws = argp()->ws; float* const outp = argp()->out;
            pg8::Gemm g{(const pg8::bf16_t*)(ws + WS_MERGED), (const pg8::bf16_t*)(ws + WS_WOT) + (size_t)L * 1024 * 1024, M, 1024, 1024, 1024, 1024, 0}; pg8::StaticOrder S; S.init(M, 1024, F.G, (int)blockIdx.x);
            const bool last = (L == DEPTH - 1);
            unsigned poison = 0u;
            if (last) poison = (__hip_atomic_load(F.ctl + CW_OVF, RLX_AGENT) != 0u) | (__hip_atomic_load(F.ctl + CW_BAR + XB_TMO, RLX_AGENT) != 0u);
            pg8::EpiOut E{L == 0 ? argp()->in[0] : (const float*)outp, outp, last ? nullptr : (pg8::bf16_t*)(ws + WS_XB), last ? nullptr : (float*)(ws + WS_SSQ), poison};
            pg8::gemm_phase<pg8::EpiOut, pg8::StaticOrder, true, true>(F.lds + RING_OFF, g, S, E, F.wave);
            if (!last) SEAM(pb + 5);
        }
    }
#undef IN
#undef SEAM
}

extern "C" void kernel_launch(void* const* d_in, const int* in_sizes, int n_in, void* d_out, int out_size, void* d_ws, size_t ws_size, hipStream_t stream) {
    static int grid = 0;
    if (grid == 0) {
        if (n_in != 9 || in_sizes[0] != M * DMODEL || out_size != M * DMODEL || ws_size < WS_END) { fprintf(stderr, "kernel_launch: unexpected shapes / workspace (n_in %d, in0 %d, out %d, ws %zu < %zu); nothing launched\n", n_in, n_in > 0 ? in_sizes[0] : -1, out_size, ws_size, (size_t)WS_END); grid = -1; return; }
        int dev = 0, cus = 0, per_cu = 0;
        if (hipGetDevice(&dev) != hipSuccess || hipDeviceGetAttribute(&cus, hipDeviceAttributeMultiprocessorCount, dev) != hipSuccess) { grid = -1; return; }
        if (hipFuncSetAttribute((const void*)mk_fwd, hipFuncAttributeMaxDynamicSharedMemorySize, LDS_BYTES) != hipSuccess) { fprintf(stderr, "kernel_launch: hipFuncSetAttribute failed\n"); grid = -1; return; }
        if (hipOccupancyMaxActiveBlocksPerMultiprocessor(&per_cu, (const void*)mk_fwd, 512, LDS_BYTES) != hipSuccess || per_cu < 1) fprintf(stderr, "kernel_launch: occupancy query reports %d workgroups per CU\n", per_cu);
        (void)hipGetLastError();
        grid = cus;
    }
    if (grid < 0) return;
    if (hipMemsetAsync((char*)d_ws + WS_CTL, 0, CTL_ZERO_BYTES, stream) != hipSuccess) return;
    Args a{};
    for (int i = 0; i < 9; ++i) a.in[i] = (const float*)d_in[i];
    a.out = (float*)d_out; a.ws = (unsigned char*)d_ws;
#if MK_ONE_LAUNCH
    a.ph_lo = 0; a.ph_hi = NPHASES;
    hipLaunchKernelGGL(mk_fwd, dim3(grid), dim3(512), LDS_BYTES, stream, a);
#else
    for (int p = 0; p < NPHASES; ++p) { a.ph_lo = p; a.ph_hi = p + 1; hipLaunchKernelGGL(mk_fwd, dim3(grid), dim3(512), LDS_BYTES, stream, a); }
#endif
}
```

```cpp
#include <hip/hip_runtime.h>
#include <cstdio>
#include <cstdint>
#include <cmath>
namespace pg8 {
#define PG8_LAS __attribute__((address_space(3)))
typedef unsigned short bf16_t;
typedef short bf16x8 __attribute__((ext_vector_type(8)));
typedef float f32x4 __attribute__((ext_vector_type(4)));
typedef unsigned u32x4 __attribute__((ext_vector_type(4)));
constexpr int BM = 256, BK = 64, HALF = 128, HTB = HALF * BK * 2  , STAGE_BYTES = 8 * HTB, NXCD = 8, WGM = 8;

__host__ __device__ __forceinline__ int lds_byte(int r, int c) { const int st = (r >> 4) * 2 + (c >> 5), rr = r & 15, cc = c & 31, ob = rr * 64 + cc * 2; return st * 1024 + (ob ^ (((ob >> 9) & 1) << 5)); }
__host__ __device__ __forceinline__ void stage_rc(int b, int& R, int& C) { const int st = b / 1024, sb = b % 1024, swz = sb ^ (((sb >> 9) & 1) << 5); R = (st >> 1) * 16 + swz / 64; C = (st & 1) * 32 + (swz % 64) / 2; }
__host__ __device__ __forceinline__ int perm32(int rho) { const int n = rho >> 4, i = rho & 15; return 8 * (i >> 2) + 4 * n + (i & 3); }

struct Unit { int pm, pn, seg; };
struct Gemm { const bf16_t* A; const bf16_t* Bt; int M, N, K, lda, ldb, segN; };

struct StaticOrder {
    int nM, nN, nwg, G, c;
    __host__ __device__ void init(int M, int N, int G_, int c_) { nM = M / BM; nN = N / BM; nwg = nM * nN; G = G_; c = c_; }
    __host__ __device__ bool next(int i, Unit& u) const {
        const long L = (long)i * G + c; if (L >= nwg) return false;
        int wgid = (int)L; { const int q = nwg / NXCD, r = nwg % NXCD, xcd = wgid % NXCD, off = wgid / NXCD; wgid = (xcd < r ? xcd * (q + 1) : r * (q + 1) + (xcd - r) * q) + off; }
        const int nig = WGM * nN, gid = wgid / nig, fm = gid * WGM, gsz = (nM - fm) < WGM ? (nM - fm) : WGM;
        u.pm = fm + ((wgid % nig) % gsz); u.pn = (wgid % nig) / gsz; u.seg = 0; return true;
    }
    __device__ __forceinline__ void a_ready(const Unit&) const {}
    __device__ __forceinline__ void done(const Unit&) const {}
};

__device__ __forceinline__ unsigned cvt_pk_bf16(float lo, float hi) { unsigned r; asm volatile("v_cvt_pk_bf16_f32 %0, %1, %2" : "=v"(r) : "v"(lo), "v"(hi)); return r; }
constexpr size_t EWS_MiB = 1u << 20, EWS_SSQ = 43 * EWS_MiB, EWS_CL = 45 * EWS_MiB, EWS_CT = 46 * EWS_MiB, EWS_IW = 47 * EWS_MiB, EWS_CF = 47 * EWS_MiB + 512 * 1024, EWS_IQ = 49 * EWS_MiB, EWS_IK = 57 * EWS_MiB, EWS_G = 188 * EWS_MiB,
    EWS_QA = 284 * EWS_MiB, EWS_QB = 316 * EWS_MiB, EWS_QC = 348 * EWS_MiB, EWS_KC = 380 * EWS_MiB, EWS_VC = 412 * EWS_MiB, EWS_KAB = 444 * EWS_MiB, EWS_VAB = 460 * EWS_MiB;

constexpr float C2Q = 0.125f * 1.4426950408889634f;
__device__ __forceinline__ float fast_sigmoid(float x) { return __builtin_amdgcn_rcpf(1.0f + __expf(-x)); }
__device__ __forceinline__ u32x4 pack8(const f32x4 a, const f32x4 b) { u32x4 w; w.x = cvt_pk_bf16(a[0], a[1]); w.y = cvt_pk_bf16(a[2], a[3]); w.z = cvt_pk_bf16(b[0], b[1]); w.w = cvt_pk_bf16(b[2], b[3]); return w; }
__device__ __forceinline__ void unpack8(const u32x4 w, f32x4& a, f32x4& b) {
    a[0] = __uint_as_float(w.x << 16); a[1] = __uint_as_float(w.x & 0xffff0000u); a[2] = __uint_as_float(w.y << 16); a[3] = __uint_as_float(w.y & 0xffff0000u);
    b[0] = __uint_as_float(w.z << 16); b[1] = __uint_as_float(w.z & 0xffff0000u); b[2] = __uint_as_float(w.w << 16); b[3] = __uint_as_float(w.w & 0xffff0000u); }
#define EPI_PIN() asm volatile("" ::: "memory")
__device__ __forceinline__ void rows_rstd(const float* ssq, int row0, int fq, float (&rs)[2][4]) {
    f32x4 pr[2][4];
#pragma unroll
    for (int ai = 0; ai < 2; ++ai)
#pragma unroll
        for (int m = 0; m < 4; ++m) pr[ai][m] = *(const f32x4*)(ssq + (size_t)(row0 + ai * HALF + m * 16) * 16 + 4 * fq);
    EPI_PIN();
#pragma unroll
    for (int ai = 0; ai < 2; ++ai)
#pragma unroll
        for (int m = 0; m < 4; ++m) { const f32x4 a = pr[ai][m]; float t = (a[0] + a[1]) + (a[2] + a[3]); t += __shfl_xor(t, 16); t += __shfl_xor(t, 32); rs[ai][m] = __builtin_amdgcn_rsqf(t * (1.0f / 1024.0f) + 1e-6f); }
}
struct EpiIn {
    static constexpr bool PERM = true, AFTER_DRAIN = false;
    unsigned char* ws; const float* qkg; const float* bfg;
    __device__ __forceinline__ bool keep(const Unit&) const { return false; }
    __device__ __forceinline__ void operator()(f32x4 (&acc)[2][2][4][2], const Unit& u, int wr, int wc, int fr, int fq) const {
        const int row0 = u.pm * BM + wr * 64 + fr, t = u.pn, lc0 = wc * 64 + fq * 8;
        float rs[2][4]; rows_rstd((const float*)(ws + EWS_SSQ), row0, fq, rs);
        if (t == 18) {
            bf16_t* IQ = (bf16_t*)(ws + EWS_IQ); bf16_t* IK = (bf16_t*)(ws + EWS_IK); float* IW = (float*)(ws + EWS_IW);
#pragma unroll
            for (int ai = 0; ai < 2; ++ai)
#pragma unroll
                for (int m = 0; m < 4; ++m) { const int row = row0 + ai * HALF + m * 16; const float f = rs[ai][m];
#pragma unroll
                    for (int bj = 0; bj < 2; ++bj) { const int lc = lc0 + 32 * bj; const f32x4 v0 = acc[ai][bj][m][0] * f, v1 = acc[ai][bj][m][1] * f;
                        if (lc < 128) *(u32x4*)(IQ + (size_t)row * 128 + lc) = pack8(v0, v1);
                        else if (lc < 160) *(u32x4*)(IK + (size_t)row * 32 + (lc - 128)) = pack8(v0, v1);
                        else if (lc == 160) *(f32x4*)(IW + (size_t)row * 4) = v0 * 0.08838834764831845f; } }
            int ln_ = (int)__builtin_amdgcn_mbcnt_hi(~0u, __builtin_amdgcn_mbcnt_lo(~0u, 0u)); asm volatile("" : "+v"(ln_));
            if (wc == 2 && (ln_ >> 4) < 2) { const int fql = ln_ >> 4, frl = ln_ & 15;
                float* CL = (float*)(ws + EWS_CL); float* CT = (float*)(ws + EWS_CT); const int hb = 4 * fql; const f32x4 bfv = *(const f32x4*)(bfg + hb);
#pragma unroll
                for (int ai = 0; ai < 2; ++ai) { f32x4 run = {0.f, 0.f, 0.f, 0.f};
#pragma unroll
                    for (int m = 0; m < 4; ++m) { const int row = row0 + ai * HALF + m * 16; const f32x4 z = (fql == 0 ? acc[ai][1][m][1] : acc[ai][1][m][0]) * rs[ai][m] + bfv; f32x4 lf;
#pragma unroll
                        for (int e = 0; e < 4; ++e) lf[e] = (z[e] < 0.f ? z[e] : 0.f) - __logf(1.0f + __expf(-fabsf(z[e])));
#pragma unroll
                        for (int o = 1; o < 16; o <<= 1)
#pragma unroll
                            for (int e = 0; e < 4; ++e) { const float tt = __shfl_up(lf[e], o, 16); if (frl >= o) lf[e] += tt; }
                        const f32x4 cs = lf + run;
                        const int bb = row >> 13, ss = row & 8191;
#pragma unroll
                        for (int e = 0; e < 4; ++e) CL[(size_t)(bb * 8 + hb + e) * 8192 + ss] = cs[e];
#pragma unroll
                        for (int e = 0; e < 4; ++e) run[e] += __shfl(lf[e], 15, 16); }
                    if (frl == 15) { const int row = row0 + ai * HALF, bb = row >> 13, ch = (row & 8191) >> 6;
#pragma unroll
                        for (int e = 0; e < 4; ++e) CT[(bb * 8 + hb + e) * 128 + ch] = run[e]; } } }
            return;
        }
        bf16_t* dst; int ldc, colbase; const float* gp = qkg; float csc = 1.f; bool norm = false, act = false;
        if (t < 6) { const int mx = t >> 1; dst = (bf16_t*)(ws + (mx == 0 ? EWS_QA : (mx == 1 ? EWS_QB : EWS_QC))); ldc = 512; colbase = (t & 1) * 256; norm = true; gp = qkg + (mx * 2 + 0) * 64; csc = (mx == 2) ? C2Q : 1.f; }
        else if (t == 6) { dst = (bf16_t*)(ws + EWS_KAB); ldc = 128; colbase = (wc >> 1) * (32768 * 128 - 128); norm = true;     gp = qkg + ((wc >> 1) * 2 + 1) * 64; }
        else if (t < 9) { dst = (bf16_t*)(ws + EWS_KC); ldc = 512; colbase = (t - 7) * 256; norm = true; gp = qkg + (2 * 2 + 1) * 64; }
        else if (t == 9) { dst = (bf16_t*)(ws + EWS_VAB); ldc = 128; colbase = (wc >> 1) * (32768 * 128 - 128); }
        else if (t < 12) { dst = (bf16_t*)(ws + EWS_VC); ldc = 512; colbase = (t - 10) * 256; }
        else { dst = (bf16_t*)(ws + EWS_G); ldc = 1536; colbase = (t - 12) * 256; act = true; }
        f32x4 gv[2][2];
#pragma unroll
        for (int bj = 0; bj < 2; ++bj)
#pragma unroll
            for (int n = 0; n < 2; ++n) gv[bj][n] = norm ? *(const f32x4*)(gp + 8 * fq + 32 * bj + 4 * n) * csc : (f32x4){1.f, 1.f, 1.f, 1.f};
        EPI_PIN();
#pragma unroll
        for (int ai = 0; ai < 2; ++ai)
#pragma unroll
            for (int m = 0; m < 4; ++m) { const int row = row0 + ai * HALF + m * 16; float f = rs[ai][m];
                if (norm) { float ss = 0.f;
#pragma unroll
                    for (int bj = 0; bj < 2; ++bj)
#pragma unroll
                        for (int n = 0; n < 2; ++n) { const f32x4 x = acc[ai][bj][m][n]; ss += (x[0] * x[0] + x[1] * x[1]) + (x[2] * x[2] + x[3] * x[3]); }
                    ss += __shfl_xor(ss, 16); ss += __shfl_xor(ss, 32);
                    f = f * __builtin_amdgcn_rsqf(f * f * ss * (1.0f / 64.0f) + 1e-6f); }
                bf16_t* rowp = dst + (size_t)row * ldc + colbase + lc0;
#pragma unroll
                for (int bj = 0; bj < 2; ++bj) { f32x4 v0 = acc[ai][bj][m][0] * f * gv[bj][0], v1 = acc[ai][bj][m][1] * f * gv[bj][1];
                    if (act) {
#pragma unroll
                        for (int e = 0; e < 4; ++e) { v0[e] = v0[e] * fast_sigmoid(v0[e]); v1[e] = v1[e] * fast_sigmoid(v1[e]); } }
                    *(u32x4*)(rowp + 32 * bj) = pack8(v0, v1); } }
    }
};
typedef unsigned u32x2e __attribute__((ext_vector_type(2)));
__device__ __forceinline__ unsigned gate_q4(const f32x4 v) { unsigned w = 0u;
    w = __builtin_amdgcn_cvt_pk_u8_f32(fmaxf(255.0f * fast_sigmoid(v[0]), 1.0f), 0, w); w = __builtin_amdgcn_cvt_pk_u8_f32(fmaxf(255.0f * fast_sigmoid(v[1]), 1.0f), 1, w);
    w = __builtin_amdgcn_cvt_pk_u8_f32(fmaxf(255.0f * fast_sigmoid(v[2]), 1.0f), 2, w); w = __builtin_amdgcn_cvt_pk_u8_f32(fmaxf(255.0f * fast_sigmoid(v[3]), 1.0f), 3, w); return w; }
__device__ __forceinline__ f32x4 gate_f4(const unsigned w) { return (f32x4){(float)(w & 0xffu), (float)((w >> 8) & 0xffu), (float)((w >> 16) & 0xffu), (float)(w >> 24)}; }
struct EpiGate {
    static constexpr bool PERM = true, AFTER_DRAIN = false;
    const float* ssq; unsigned char* MG;
    __device__ __forceinline__ bool keep(const Unit&) const { return false; }
    __device__ __forceinline__ void operator()(f32x4 (&acc)[2][2][4][2], const Unit& u, int wr, int wc, int fr, int fq) const {
        const int row0 = u.pm * BM + wr * 64 + fr, lc0 = wc * 64 + fq * 8;
        float rs[2][4]; rows_rstd(ssq, row0, fq, rs);
#pragma unroll
        for (int ai = 0; ai < 2; ++ai)
#pragma unroll
            for (int m = 0; m < 4; ++m) { const int row = row0 + ai * HALF + m * 16; const float f = rs[ai][m];
                unsigned char* rowp = MG + (size_t)row * 3072 + u.pn * BM + lc0;
#pragma unroll
                for (int bj = 0; bj < 2; ++bj) { u32x2e w; w.x = gate_q4(acc[ai][bj][m][0] * f); w.y = gate_q4(acc[ai][bj][m][1] * f); *(u32x2e*)(rowp + 32 * bj) = w; } }
    }
};
struct EpiMerge {
    static constexpr bool PERM = true, AFTER_DRAIN = false;
    const unsigned char* MG; bf16_t* OUT;
    __device__ __forceinline__ bool keep(const Unit& u) const { return u.seg < 2; }
    __device__ __forceinline__ void operator()(f32x4 (&acc)[2][2][4][2], const Unit& u, int wr, int wc, int fr, int fq) const {
        const int row0 = u.pm * BM + wr * 64 + fr, col0 = u.pn * BM + wc * 32 + 8 * fq, seg = u.seg;
#pragma unroll
        for (int ai = 0; ai < 2; ++ai) {
            u32x2e ga[4][2], gb[4][2];
#pragma unroll
            for (int m = 0; m < 4; ++m) { const unsigned char* gp = MG + (size_t)(row0 + ai * HALF + m * 16) * 3072 + seg * 1024 + col0;
#pragma unroll
                for (int bj = 0; bj < 2; ++bj) { ga[m][bj] = *(const u32x2e*)(gp + bj * HALF); gb[m][bj] = seg < 2 ? *(const u32x2e*)(gp + 1024 + bj * HALF) : ga[m][bj]; } }
            EPI_PIN();
#pragma unroll
            for (int m = 0; m < 4; ++m) { const int row = row0 + ai * HALF + m * 16;
#pragma unroll
                for (int bj = 0; bj < 2; ++bj) { f32x4 a0 = gate_f4(ga[m][bj].x), a1 = gate_f4(ga[m][bj].y);
                    if (seg < 2) { const f32x4 b0 = gate_f4(gb[m][bj].x), b1 = gate_f4(gb[m][bj].y);
#pragma unroll
                        for (int e = 0; e < 4; ++e) { a0[e] = a0[e] * __builtin_amdgcn_rcpf(b0[e]); a1[e] = a1[e] * __builtin_amdgcn_rcpf(b1[e]); } }
                    else { a0 = a0 * (1.0f / 255.0f); a1 = a1 * (1.0f / 255.0f); }
                    acc[ai][bj][m][0] = acc[ai][bj][m][0] * a0; acc[ai][bj][m][1] = acc[ai][bj][m][1] * a1;
                    if (seg == 2) *(u32x4*)(OUT + (size_t)row * 1024 + col0 + bj * HALF) = pack8(acc[ai][bj][m][0], acc[ai][bj][m][1]); } }
        }
    }
};
struct EpiOut {
    static constexpr bool PERM = true, AFTER_DRAIN = false;
    const float* resid; float* out; bf16_t* XB; float* ssq; unsigned poison;
    __device__ __forceinline__ bool keep(const Unit&) const { return false; }
    __device__ __forceinline__ void operator()(f32x4 (&acc)[2][2][4][2], const Unit& u, int wr, int wc, int fr, int fq) const {
        const int row0 = u.pm * BM + wr * 64 + fr, col0 = u.pn * BM + wc * 32 + 8 * fq;
#pragma unroll
        for (int ai = 0; ai < 2; ++ai) {
            f32x4 rv[4][2][2];
#pragma unroll
            for (int m = 0; m < 4; ++m)
#pragma unroll
                for (int bj = 0; bj < 2; ++bj) { const size_t o = (size_t)(row0 + ai * HALF + m * 16) * 1024 + col0 + bj * HALF; rv[m][bj][0] = *(const f32x4*)(resid + o); rv[m][bj][1] = *(const f32x4*)(resid + o + 4); }
            EPI_PIN();
#pragma unroll
            for (int m = 0; m < 4; ++m) { const int row = row0 + ai * HALF + m * 16; float ss = 0.f;
#pragma unroll
                for (int bj = 0; bj < 2; ++bj) { const size_t o = (size_t)row * 1024 + col0 + bj * HALF;
                    f32x4 v0 = rv[m][bj][0] + acc[ai][bj][m][0], v1 = rv[m][bj][1] + acc[ai][bj][m][1];
                    if (poison) { const float qn = __builtin_nanf(""); v0 = (f32x4){qn, qn, qn, qn}; v1 = v0; }
                    *(f32x4*)(out + o) = v0; *(f32x4*)(out + o + 4) = v1;
                    if (XB) { *(u32x4*)(XB + o) = pack8(v0, v1); ss += ((v0[0] * v0[0] + v0[1] * v0[1]) + (v0[2] * v0[2] + v0[3] * v0[3])) + ((v1[0] * v1[0] + v1[1] * v1[1]) + (v1[2] * v1[2] + v1[3] * v1[3])); } }
                if (XB) { ss += __shfl_xor(ss, 16); ss += __shfl_xor(ss, 32); if (fq == 0) ssq[(size_t)row * 16 + u.pn * 4 + wc] = ss; } }
            EPI_PIN();
        }
    }
};
struct SegOrder {
    StaticOrder base;
    __device__ __forceinline__ bool next(int i, Unit& u) const { if (!base.next(i / 3, u)) return false; u.seg = i % 3; return true; }
    __device__ __forceinline__ void a_ready(const Unit&) const {}
    __device__ __forceinline__ void done(const Unit&) const {}
};

template <class Epi, class Sched, bool ALIGN_EPI = false, bool SP2 = false>
__device__ __forceinline__ void gemm_phase(PG8_LAS unsigned char* lds, const Gemm g, const Sched& S, const Epi& E, int wave_id) {
    int tid_ = (int)__builtin_amdgcn_mbcnt_hi(~0u, __builtin_amdgcn_mbcnt_lo(~0u, 0u)); asm volatile("" : "+v"(tid_)); tid_ += wave_id * 64;
    const int tid = tid_, wid = __builtin_amdgcn_readfirstlane(tid >> 6), lane = tid & 63, wr = wid >> 2, wc = wid & 3, fr = lane & 15, fq = lane >> 4;
    const int K = g.K, nt = K / BK;
    unsigned voffA[2], voffB[2];
#pragma unroll
    for (int i = 0; i < 2; ++i) { int R, C; stage_rc(tid * 16 + i * 8192, R, C); const int Rb = Epi::PERM ? ((R & ~31) + perm32(R & 31)) : R;
        voffA[i] = (unsigned)(R * g.lda + C) * 2u; voffB[i] = (unsigned)(Rb * g.ldb + C) * 2u; }
    const size_t kstep = (size_t)(BK * 2);
    const size_t hstepA = (size_t)HALF * g.lda * 2, hstepB = (size_t)HALF * g.ldb * 2;
    const size_t tstepA = 2 * hstepA, tstepB = 2 * hstepB, sstepA = (size_t)K * 2;
    const unsigned ldsw = (unsigned)wid * 1024u;
    const int aoff = lds_byte(wr * 64 + fr, fq * 8), boff = lds_byte(wc * 32 + fr, fq * 8);
#define PG8_SA(b, h) (((b) * 2 + (h)) * HTB)
#define PG8_SB(b, h) ((4 + (b) * 2 + (h)) * HTB)
#define PG8_STAGE(bufoff, gbase, voff) do { _Pragma("unroll") for (int _i = 0; _i < 2; ++_i) \
        __builtin_amdgcn_global_load_lds((const unsigned*)((const char*)(gbase) + (voff)[_i]), (PG8_LAS unsigned*)(lds + (bufoff) + ldsw + _i * 8192), 16, 0, 0); } while (0)
#define PG8_LDA(dst, b, h) do { _Pragma("unroll") for (int m = 0; m < 4; ++m) _Pragma("unroll") for (int k = 0; k < 2; ++k) dst[m][k] = *(const PG8_LAS bf16x8*)(lds + PG8_SA(b, h) + aoff + m * 2048 + k * 1024); } while (0)
#define PG8_LDB(dst, b, h) do { _Pragma("unroll") for (int n = 0; n < 2; ++n) _Pragma("unroll") for (int k = 0; k < 2; ++k) dst[n][k] = *(const PG8_LAS bf16x8*)(lds + PG8_SB(b, h) + boff + n * 2048 + k * 1024); } while (0)
#define PG8_MMA(ai, bj, At, Bt) do { __builtin_amdgcn_s_setprio(1); _Pragma("unroll") for (int m = 0; m < 4; ++m) _Pragma("unroll") for (int n = 0; n < 2; ++n) _Pragma("unroll") for (int k = 0; k < 2; ++k) \
        acc[ai][bj][m][n] = __builtin_amdgcn_mfma_f32_16x16x32_bf16(Bt[n][k], At[m][k], acc[ai][bj][m][n], 0, 0, 0); __builtin_amdgcn_s_setprio(0); } while (0)
#define PG8_WAIT_V(n) asm volatile("s_waitcnt vmcnt(" #n ")" ::: "memory")
#define PG8_WAIT_L(n) asm volatile("s_waitcnt lgkmcnt(" #n ")" ::: "memory")
#define PG8_BAR __builtin_amdgcn_s_barrier()
#define PG8_SCHED __builtin_amdgcn_sched_barrier(0)
    Unit cur, nxt; int ui = 0;
    if (!S.next(0, cur)) return;
    f32x4 acc[2][2][4][2];
#pragma unroll
    for (int a = 0; a < 2; ++a)
#pragma unroll
        for (int b = 0; b < 2; ++b)
#pragma unroll
            for (int m = 0; m < 4; ++m)
#pragma unroll
                for (int n = 0; n < 2; ++n) acc[a][b][m][n] = (f32x4){0.f, 0.f, 0.f, 0.f};
    bf16x8 At[4][2], B0[2][2], B1[2][2];
    const char* cA = (const char*)g.A + (size_t)cur.pm * tstepA + (size_t)cur.seg * sstepA; const char* cB = (const char*)g.Bt + (size_t)(cur.seg * g.segN + cur.pn) * tstepB;
    S.a_ready(cur);
    if constexpr (SP2) {
        PG8_STAGE(PG8_SB(0, 0), cB, voffB); PG8_STAGE(PG8_SB(0, 1), cB + hstepB, voffB); PG8_STAGE(PG8_SA(0, 0), cA, voffA); PG8_STAGE(PG8_SA(0, 1), cA + hstepA, voffA);
        if (wr == 1) PG8_BAR;
        PG8_WAIT_V(2); PG8_BAR;
        PG8_STAGE(PG8_SB(1, 0), cB + kstep, voffB); PG8_STAGE(PG8_SA(1, 0), cA + kstep, voffA); PG8_STAGE(PG8_SB(1, 1), cB + hstepB + kstep, voffB);
        PG8_WAIT_V(6); PG8_BAR;
    } else {
        PG8_STAGE(PG8_SB(0, 0), cB, voffB); PG8_STAGE(PG8_SA(0, 0), cA, voffA); PG8_STAGE(PG8_SB(0, 1), cB + hstepB, voffB); PG8_STAGE(PG8_SA(0, 1), cA + hstepA, voffA);
        if (wr == 1) PG8_BAR;
        PG8_WAIT_V(4); PG8_BAR;
        PG8_STAGE(PG8_SB(1, 0), cB + kstep, voffB); PG8_STAGE(PG8_SA(1, 0), cA + kstep, voffA); PG8_STAGE(PG8_SB(1, 1), cB + hstepB + kstep, voffB);
        PG8_WAIT_V(6); PG8_BAR;
    }
    for (;;) {
        const bool has_next = S.next(ui + 1, nxt);
        const char* nA = has_next ? (const char*)g.A + (size_t)nxt.pm * tstepA + (size_t)nxt.seg * sstepA : cA; const char* nB = has_next ? (const char*)g.Bt + (size_t)(nxt.seg * g.segN + nxt.pn) * tstepB : cB;
        for (int t = 0; t < nt; t += 2) {
            const bool last = (t == nt - 2);
            const char* a1 = cA + (size_t)(t + 1) * kstep;
            const char* a2 = last ? nA : cA + (size_t)(t + 2) * kstep; const char* b2 = last ? nB : cB + (size_t)(t + 2) * kstep;
            const char* a3 = a2 + kstep; const char* b3 = b2 + kstep;
            if (last && has_next) S.a_ready(nxt);
            if constexpr (SP2) {
            PG8_LDB(B0, 0, 0); PG8_LDB(B1, 0, 1); PG8_SCHED; PG8_LDA(At, 0, 0); PG8_STAGE(PG8_SA(1, 1), a1 + hstepA, voffA);
            PG8_WAIT_V(8); PG8_WAIT_L(0); PG8_BAR; PG8_MMA(0, 0, At, B0); PG8_MMA(0, 1, At, B1); PG8_BAR; PG8_SCHED;
            PG8_LDA(At, 0, 1); PG8_STAGE(PG8_SB(0, 0), b2, voffB); PG8_STAGE(PG8_SB(0, 1), b2 + hstepB, voffB); PG8_STAGE(PG8_SA(0, 0), a2, voffA);
            PG8_WAIT_V(8); PG8_WAIT_L(0); PG8_BAR; PG8_MMA(1, 0, At, B0); PG8_MMA(1, 1, At, B1); PG8_BAR; PG8_SCHED;
            PG8_LDB(B0, 1, 0); PG8_LDB(B1, 1, 1); PG8_SCHED; PG8_LDA(At, 1, 0); PG8_STAGE(PG8_SA(0, 1), a2 + hstepA, voffA);
            PG8_WAIT_V(8); PG8_WAIT_L(0); PG8_BAR; PG8_MMA(0, 0, At, B0); PG8_MMA(0, 1, At, B1); PG8_BAR; PG8_SCHED;
            PG8_LDA(At, 1, 1); PG8_STAGE(PG8_SB(1, 0), b3, voffB); PG8_STAGE(PG8_SB(1, 1), b3 + hstepB, voffB); PG8_STAGE(PG8_SA(1, 0), a3, voffA);
            PG8_WAIT_V(8); PG8_WAIT_L(0); PG8_BAR; PG8_MMA(1, 0, At, B0); PG8_MMA(1, 1, At, B1); PG8_BAR; PG8_SCHED;
            } else {
            PG8_LDB(B0, 0, 0); PG8_SCHED; PG8_LDA(At, 0, 0); PG8_STAGE(PG8_SA(1, 1), a1 + hstepA, voffA);
            PG8_WAIT_L(8); PG8_BAR; PG8_WAIT_L(0); PG8_MMA(0, 0, At, B0); PG8_BAR; PG8_SCHED;
            PG8_LDB(B1, 0, 1); PG8_STAGE(PG8_SB(0, 0), b2, voffB);
            PG8_BAR; PG8_WAIT_L(0); PG8_MMA(0, 1, At, B1); PG8_BAR;
            PG8_LDA(At, 0, 1); PG8_STAGE(PG8_SA(0, 0), a2, voffA);
            PG8_BAR; PG8_WAIT_L(0); PG8_MMA(1, 0, At, B0); PG8_BAR; PG8_SCHED;
            PG8_STAGE(PG8_SB(0, 1), b2 + hstepB, voffB);
            PG8_WAIT_V(6); PG8_BAR; PG8_MMA(1, 1, At, B1); PG8_BAR;
            PG8_LDB(B0, 1, 0); PG8_SCHED; PG8_LDA(At, 1, 0); PG8_STAGE(PG8_SA(0, 1), a2 + hstepA, voffA);
            PG8_WAIT_L(8); PG8_BAR; PG8_WAIT_L(0); PG8_MMA(0, 0, At, B0); PG8_BAR; PG8_SCHED;
            PG8_LDB(B1, 1, 1); PG8_STAGE(PG8_SB(1, 0), b3, voffB);
            PG8_BAR; PG8_WAIT_L(0); PG8_MMA(0, 1, At, B1); PG8_BAR;
            PG8_LDA(At, 1, 1); PG8_STAGE(PG8_SA(1, 0), a3, voffA);
            PG8_BAR; PG8_WAIT_L(0); PG8_MMA(1, 0, At, B0); PG8_BAR; PG8_SCHED;
            PG8_STAGE(PG8_SB(1, 1), b3 + hstepB, voffB);
            PG8_WAIT_V(6); PG8_BAR; PG8_MMA(1, 1, At, B1); PG8_BAR;
            }
        }
        if constexpr (ALIGN_EPI) { if (wr == 0) PG8_BAR; }
        if constexpr (!Epi::AFTER_DRAIN) { E(acc, cur, wr, wc, fr, fq); S.done(cur); }
        if (!has_next) break;
        if (!E.keep(cur)) {
#pragma unroll
        for (int a = 0; a < 2; ++a)
#pragma unroll
            for (int b = 0; b < 2; ++b)
#pragma unroll
                for (int m = 0; m < 4; ++m)
#pragma unroll
                    for (int n = 0; n < 2; ++n) acc[a][b][m][n] = (f32x4){0.f, 0.f, 0.f, 0.f};
        }
        cur = nxt; cA = nA; cB = nB; ++ui;
        if constexpr (ALIGN_EPI) { if (wr == 1) PG8_BAR; }
    }
    PG8_WAIT_V(0);
    if constexpr (!ALIGN_EPI) { if (wr == 0) PG8_BAR; }
    PG8_BAR;
    if constexpr (Epi::AFTER_DRAIN) { E.fused(acc, cur, wr, wc, fr, fq, lds, wid, lane); S.done(cur); }
#undef PG8_SA
#undef PG8_SB
#undef PG8_STAGE
#undef PG8_LDA
#undef PG8_LDB
#undef PG8_MMA
#undef PG8_WAIT_V
#undef PG8_WAIT_L
#undef PG8_BAR
#undef PG8_SCHED
}
}
#include <hip/hip_bf16.h>
#include <cmath>
namespace attn_body {
using bf16=__hip_bfloat16;
using bf16x8=__attribute__((ext_vector_type(8)))short;
using s16x4=__attribute__((ext_vector_type(4)))short;
using f32x16=__attribute__((ext_vector_type(16)))float;
using u32x4=__attribute__((ext_vector_type(4)))unsigned;
constexpr int BATCH=4,NHEAD=8,SEQ=8192,D=64,DM=NHEAD*D;
constexpr int NW=8,QBLK=32,QB=QBLK*NW,KVBLK=64,NQB=SEQ/QB;
constexpr int ATTN_PITCH=DM, ATTN_UNIT_ROWS=QB, OPITCH=1536, OCOL0=1024;
__device__ __forceinline__ int crow(int r,int hi){return (r&3)+8*(r>>2)+4*hi;}
#define SBAR() __builtin_amdgcn_sched_barrier(0)
__device__ __forceinline__ void cmask(f32x16&p0,f32x16&p1,int jb,int qrel,int hi){
  const float NEG=-INFINITY; int kb=64*jb+4*hi;
  #pragma unroll
  for(int r=0;r<16;++r){int kv=kb+(r&3)+8*(r>>2); if(kv>qrel)p0[r]=NEG; if(kv+32>qrel)p1[r]=NEG;}
}

constexpr int NSLOT=3, SLOTB=8192;
constexpr int LDS_K=0, LDS_V=NSLOT*SLOTB, LDS_WS=2*NSLOT*SLOTB, LDS_OST=LDS_WS+NW*64*4, LDS_BYTES=LDS_OST+NW*4096;
constexpr float C2=0.125f*1.4426950408889634f;
__device__ __forceinline__ void glds16(const void*gsrc,unsigned lds_dst){unsigned keep;
  asm volatile("s_mov_b32 %0, m0\n\ts_mov_b32 m0, %2\n\ts_nop 0\n\tglobal_load_lds_dwordx4 %1, off\n\ts_mov_b32 m0, %0":"=&s"(keep):"v"(gsrc),"s"(lds_dst):"memory");}
__device__ __forceinline__ float max3f(float a,float b,float c){float r;asm("v_max3_f32 %0, %1, %2, %3":"=v"(r):"v"(a),"v"(b),"v"(c));return r;}
__device__ __forceinline__ float max2f(float a,float b){float r;asm("v_max_f32_e32 %0, %1, %2":"=v"(r):"v"(a),"v"(b));return r;}
__device__ __forceinline__ float fadd_s(float a,float b){float r;asm("v_add_f32_e32 %0, %1, %2":"=v"(r):"v"(a),"v"(b));return r;}
__device__ __forceinline__ float fsub_s(float a,float b){float r;asm("v_sub_f32_e32 %0, %1, %2":"=v"(r):"v"(a),"v"(b));return r;}
typedef float f32x2_t __attribute__((ext_vector_type(2))); typedef __bf16 bf16x2_t __attribute__((ext_vector_type(2)));
__device__ __forceinline__ unsigned cvtpk_s(float lo,float hi){f32x2_t v={lo,hi};bf16x2_t b=__builtin_convertvector(v,bf16x2_t);return __builtin_bit_cast(unsigned,b);}
#define WAIT_BAR(N) asm volatile("s_waitcnt vmcnt(" #N ") lgkmcnt(0)\n\ts_barrier":::"memory")

__device__ __forceinline__ void qkt(f32x16&p0,f32x16&p1,const char*Kslot,const bf16x8*qr,int r32,int hi){
  const char*kb=Kslot+hi*1024+r32*16;
  #pragma unroll
  for(int d0=0;d0<4;++d0){
    const bf16x8 b0=*reinterpret_cast<const bf16x8*>(kb+d0*2048);
    const bf16x8 b1=*reinterpret_cast<const bf16x8*>(kb+d0*2048+512);
    p0=__builtin_amdgcn_mfma_f32_32x32x16_bf16(b0,qr[d0],p0,0,0,0);p1=__builtin_amdgcn_mfma_f32_32x32x16_bf16(b1,qr[d0],p1,0,0,0);}
}
typedef __attribute__((address_space(3))) const unsigned* lds_cuptr;
typedef float f32x4_t __attribute__((ext_vector_type(4)));
__device__ __forceinline__ unsigned bfr(float f){ unsigned u=__builtin_bit_cast(unsigned,f); return (u+0x7fffu+((u>>16)&1u))>>16; }
__device__ __forceinline__ void biasmm(f32x16&c0,f32x16&c1,unsigned w0,unsigned w1  ,unsigned qm1,int hi){
  const unsigned one=hi?0u:0x3f803f80u; w0=hi?0u:w0; w1=hi?0u:w1;
  const u32x4 k0={w0,one,0u,0u},k1={w1,one,0u,0u},qv={one,qm1,0u,0u};
  const f32x16 z=f32x16{};
  c0=__builtin_amdgcn_mfma_f32_32x32x16_bf16(__builtin_bit_cast(bf16x8,k0),__builtin_bit_cast(bf16x8,qv),z,0,0,0);
  c1=__builtin_amdgcn_mfma_f32_32x32x16_bf16(__builtin_bit_cast(bf16x8,k1),__builtin_bit_cast(bf16x8,qv),z,0,0,0);
}
typedef __attribute__((address_space(3))) const char* lds_cptr;
typedef short v4i16_t __attribute__((ext_vector_type(4)));
__device__ __forceinline__ void kload8(bf16x8*kf,lds_cptr kp){
  kf[0]=*(const __attribute__((address_space(3))) bf16x8*)(kp);      kf[1]=*(const __attribute__((address_space(3))) bf16x8*)(kp+512);
  kf[2]=*(const __attribute__((address_space(3))) bf16x8*)(kp+2048); kf[3]=*(const __attribute__((address_space(3))) bf16x8*)(kp+2560);
  kf[4]=*(const __attribute__((address_space(3))) bf16x8*)(kp+4096); kf[5]=*(const __attribute__((address_space(3))) bf16x8*)(kp+4608);
  kf[6]=*(const __attribute__((address_space(3))) bf16x8*)(kp+6144); kf[7]=*(const __attribute__((address_space(3))) bf16x8*)(kp+6656);
}
__device__ __forceinline__ void kload2(bf16x8*kf,lds_cptr kp,int j){ kf[2*j]=*(const __attribute__((address_space(3))) bf16x8*)(kp+j*2048); kf[2*j+1]=*(const __attribute__((address_space(3))) bf16x8*)(kp+j*2048+512); }
__device__ __forceinline__ s16x4 vtr(lds_cptr p){ return __builtin_bit_cast(s16x4,__builtin_amdgcn_ds_read_tr16_b64_v4i16((__attribute__((address_space(3))) v4i16_t*)p)); }
__device__ __forceinline__ float rowmax(const f32x16&p0,const f32x16&p1){
  float a=max3f(p0[0],p0[1],p1[0]),b=max3f(p0[2],p0[3],p1[1]);a=max3f(a,p1[2],p1[3]);
  #pragma unroll
  for(int r=4;r<16;r+=4){a=max3f(a,p0[r],p0[r+1]);b=max3f(b,p0[r+2],p0[r+3]);a=max3f(a,p1[r],p1[r+1]);b=max3f(b,p1[r+2],p1[r+3]);}
  const float m=max2f(a,b);
  auto rr=__builtin_amdgcn_permlane32_swap(__float_as_uint(m),__float_as_uint(m),false,false);
  return max2f(__uint_as_float(rr[0]),__uint_as_float(rr[1]));
}
__device__ __forceinline__ void pv(f32x16*o,int vb,bf16x8 pa0,bf16x8 pa1,bf16x8 pa2,bf16x8 pa3){
  #pragma unroll
  for(int d0=0;d0<2;++d0){s16x4 lo[4],hi[4];
    #pragma unroll
    for(int ks=0;ks<4;++ks){
      asm volatile("ds_read_b64_tr_b16 %0,%1 offset:%c2":"=&v"(lo[ks]):"v"(vb),"i"(d0*4096+ks*1024):"memory");
      asm volatile("ds_read_b64_tr_b16 %0,%1 offset:%c2":"=&v"(hi[ks]):"v"(vb),"i"(d0*4096+ks*1024+512):"memory");}
    asm volatile("s_waitcnt lgkmcnt(0)":::"memory");SBAR();
    #define PK(k) (bf16x8){lo[k][0],lo[k][1],lo[k][2],lo[k][3],hi[k][0],hi[k][1],hi[k][2],hi[k][3]}
    o[d0]=__builtin_amdgcn_mfma_f32_32x32x16_bf16(pa0,PK(0),o[d0],0,0,0);
    o[d0]=__builtin_amdgcn_mfma_f32_32x32x16_bf16(pa1,PK(1),o[d0],0,0,0);
    o[d0]=__builtin_amdgcn_mfma_f32_32x32x16_bf16(pa2,PK(2),o[d0],0,0,0);
    o[d0]=__builtin_amdgcn_mfma_f32_32x32x16_bf16(pa3,PK(3),o[d0],0,0,0);
    #undef PK
  }
}

__device__ __forceinline__ u32x4 mul_bf16x8(u32x4 a,u32x4 b){ u32x4 r;
  #pragma unroll
  for(int i=0;i<4;++i){ const float al=__uint_as_float(a[i]<<16),ah=__uint_as_float(a[i]&0xffff0000u),bl=__uint_as_float(b[i]<<16),bh=__uint_as_float(b[i]&0xffff0000u); r[i]=cvtpk_s(al*bl,ah*bh); }
  return r; }
#ifndef ATTN_STORE16
#define ATTN_STORE16(p,v) (*(u32x4*)(p)=(v))
#endif
template<int THRL> __device__ __forceinline__ void attn_unit(int b,int h,int qb,const bf16*Q,const bf16*__restrict__ K,const bf16*__restrict__ V,bf16*O,char*shm,lds_cuptr nb,int tskip,bool dry,int wave_id){
  int tid_=(int)__builtin_amdgcn_mbcnt_hi(~0u,__builtin_amdgcn_mbcnt_lo(~0u,0u)); asm volatile("":"+v"(tid_)); tid_+=wave_id*64; const int tid=tid_,lane=tid&63,r32=lane&31,hi=lane>>5; const int wid=__builtin_amdgcn_readfirstlane(tid>>6);
  const long rowbase=(long)b*SEQ; const int q0=qb*QB;
  const bf16*Qw=Q+(rowbase+q0+wid*QBLK)*DM+h*D;
  const bf16*Kh=K+(rowbase+(long)tskip*KVBLK)*DM+h*D,*Vh=V+(rowbase+(long)tskip*KVBLK)*DM+h*D;
  const unsigned lds0=(unsigned)(uintptr_t)shm;
  float*wsf=(float*)(shm+LDS_WS)+wid*64;
  const bf16*ksrc=Kh+(long)lane*DM+wid*8;
  const bf16*vsrc=Vh+(long)(16*(wid&3)+(lane>>2))*DM+(wid>>2)*32+(lane&3)*8;
  const unsigned kdst=lds0+LDS_K+wid*1024, vdst=lds0+LDS_V+wid*1024;
  #define DMA_K(t,slot) glds16(ksrc+(long)(t)*KVBLK*DM,(unsigned)__builtin_amdgcn_readfirstlane(kdst+(slot)))
  #define DMA_V(t,slot) glds16(vsrc+(long)(t)*KVBLK*DM,(unsigned)__builtin_amdgcn_readfirstlane(vdst+(slot)))
  const int vb0=(int)(lds0+LDS_V)+((lane>>4)&1)*32+(lane&3)*8+(4*hi+((lane&15)>>2))*64;
  const char*Kbase=shm+LDS_K; bf16x8 kf[8];
  const lds_cptr shm3=(lds_cptr)shm; const lds_cptr kp0=shm3+LDS_K+hi*1024+r32*16; const lds_cptr vp0=shm3+LDS_V+((lane>>4)&1)*32+(lane&3)*8+(4*hi+((lane&15)>>2))*64;
  const int NT=(q0+QB)/KVBLK-tskip;
  DMA_K(0,0);DMA_V(0,0);DMA_K(1,SLOTB);
  bf16x8 qr[4];
  #pragma unroll
  for(int d0=0;d0<4;++d0)qr[d0]=*reinterpret_cast<const bf16x8*>(&Qw[(long)r32*DM+d0*16+hi*8]);
  float mhat=0.f,l_reg=0.f;f32x16 o[2];o[0]=f32x16{};o[1]=f32x16{};unsigned qm1=0u;const lds_cuptr nbl=nb+64*tskip+r32;
  #define SETM(NEWM) do{ const float nm_=-(NEWM); const unsigned h_=bfr(nm_); const float hf_=__uint_as_float(h_<<16); const unsigned l_=bfr(nm_-hf_); mhat=-(hf_+__uint_as_float(l_<<16)); qm1=hi?0u:(h_|(l_<<16)); }while(0)
  const int qrel=wid*QBLK+r32;
  #define CMASK(P0,P1,t) do{int jb_=(t)-(NT-4); if(jb_>=0)cmask(P0,P1,jb_,qrel,hi);}while(0)
  bool resc=false;
  #define START(P0,P1) do{ const float rm=rowmax(P0,P1); resc=false; \
    { const float old_=mhat; SETM(old_+rm); const float dl=mhat-old_; \
      _Pragma("unroll") for(int r=0;r<16;++r){P0[r]=fsub_s(P0[r],dl);P1[r]=fsub_s(P1[r],dl);} } \
    _Pragma("unroll") for(int r=0;r<16;++r)P0[r]=__builtin_amdgcn_exp2f(P0[r]); }while(0)
  #define RESC() do{ if(resc){ asm volatile("s_waitcnt lgkmcnt(0)":::"memory"); \
      _Pragma("unroll") for(int d_=0;d_<2;++d_) _Pragma("unroll") for(int r=0;r<16;++r)o[d_][r]*=wsf[crow(r,hi)]; } }while(0)
  f32x16 pA0,pA1,pB0,pB1;
  int sl_prev=0,sl_cur=0,sl_next=SLOTB;
  #define ROT() do{sl_prev=sl_cur;sl_cur=sl_next;sl_next=(sl_next==(NSLOT-1)*SLOTB)?0:sl_next+SLOTB;}while(0)
  DMA_K(2,2*SLOTB);
  WAIT_BAR(3);
  unsigned bw0=nbl[0],bw1=nbl[32]; biasmm(pA0,pA1,bw0,bw1,qm1,hi); bw0=nbl[64]; bw1=nbl[96]; qkt(pA0,pA1,Kbase,qr,r32,hi);    asm volatile("s_nop 15\n\ts_nop 7":"+v"(pA0),"+v"(pA1));CMASK(pA0,pA1,0);
  START(pA0,pA1);
  _Pragma("unroll") for(int r=0;r<16;++r)pA1[r]=__builtin_amdgcn_exp2f(pA1[r]);
  WAIT_BAR(0);
  DMA_K(3,0);DMA_V(1,SLOTB);
  ROT();
  kload8(kf,kp0+sl_cur);
  WAIT_BAR(2);
  s16x4 vlo[8],vhi[8]; u32x4 pw0,pw1,pw2,pw3;
  #define PKW(P,B) cvtpk_s(P[B],P[B+1])
  #define PAF(k) __builtin_bit_cast(bf16x8,pw##k)
  #define VFR(i) (bf16x8){vlo[i][0],vlo[i][1],vlo[i][2],vlo[i][3],vhi[i][0],vhi[i][1],vhi[i][2],vhi[i][3]}
  #define PIN(x) asm volatile("":"+v"(x))
  #define MX3(a,b,c) __builtin_fmaxf(__builtin_fmaxf((a),(b)),(c))
  #define GAPA(MF,A0,A1,A2,A3,W0,W1,PW) do{ MF; sacc+=A0; sacc+=A1; sacc+=A2; sacc+=A3; PIN(sacc); W0; W1; PIN(PW); SBAR(); }while(0)
  #define EX(v) __builtin_amdgcn_exp2f(v)
  #define GAPB(MF,X,B) do{ MF; X[B]=EX(X[B]); X[B+1]=EX(X[B+1]); X[B+2]=EX(X[B+2]); X[B+3]=EX(X[B+3]); PIN(X); SBAR(); }while(0)
  #define VRD(i) do{ vlo[i]=vtr(vp_+(((i)>>2)*4096+((i)&3)*1024)); vhi[i]=vtr(vp_+(((i)>>2)*4096+((i)&3)*1024+512)); }while(0)
  #define KRD(G,j) do{ if(G){ kload2(kf,kp0+sl_next,j); SBAR(); } }while(0)
  #define STEP(C0,C1,P0,P1,t,GK,GV,GL) do{ SBAR(); \
    biasmm(C0,C1,bw0,bw1,qm1,hi); bw0=nbl[64*((t)+1)]; bw1=nbl[64*((t)+1)+32]; SBAR(); \
    const lds_cptr vp_=vp0+sl_prev; \
    VRD(0); SBAR(); float sacc=(P0[0]+P0[1]); \
    GAPA(C0=__builtin_amdgcn_mfma_f32_32x32x16_bf16(kf[0],qr[0],C0,0,0,0), P0[2],P0[3],P0[4],P0[5],     pw0[0]=PKW(P0,0), pw0[1]=PKW(P0,2), pw0); \
    VRD(4); SBAR(); GAPA(C1=__builtin_amdgcn_mfma_f32_32x32x16_bf16(kf[1],qr[0],C1,0,0,0), P0[6],P0[7],P0[8],P0[9],     pw0[2]=PKW(P0,4), pw0[3]=PKW(P0,6), pw0); \
    VRD(1); SBAR(); GAPA(C0=__builtin_amdgcn_mfma_f32_32x32x16_bf16(kf[2],qr[1],C0,0,0,0),   P0[10],P0[11],P0[12],P0[13], pw1[0]=PKW(P0,8), pw1[1]=PKW(P0,10), pw1); \
    VRD(5); SBAR(); GAPA(C1=__builtin_amdgcn_mfma_f32_32x32x16_bf16(kf[3],qr[1],C1,0,0,0),   P0[14],P0[15],P1[0],P1[1],   pw1[2]=PKW(P0,12),pw1[3]=PKW(P0,14), pw1); \
    VRD(2); SBAR(); GAPA(C0=__builtin_amdgcn_mfma_f32_32x32x16_bf16(kf[4],qr[2],C0,0,0,0),   P1[2],P1[3],P1[4],P1[5],     pw2[0]=PKW(P1,0), pw2[1]=PKW(P1,2), pw2); \
    VRD(6); SBAR(); GAPA(C1=__builtin_amdgcn_mfma_f32_32x32x16_bf16(kf[5],qr[2],C1,0,0,0),   P1[6],P1[7],P1[8],P1[9],     pw2[2]=PKW(P1,4), pw2[3]=PKW(P1,6), pw2); \
    VRD(3); SBAR(); GAPA(C0=__builtin_amdgcn_mfma_f32_32x32x16_bf16(kf[6],qr[3],C0,0,0,0),   P1[10],P1[11],P1[12],P1[13], pw3[0]=PKW(P1,8), pw3[1]=PKW(P1,10), pw3); \
    VRD(7); SBAR(); GAPA(C1=__builtin_amdgcn_mfma_f32_32x32x16_bf16(kf[7],qr[3],C1,0,0,0),   P1[14],P1[15],0.f,0.f,       pw3[2]=PKW(P1,12),pw3[3]=PKW(P1,14), pw3); \
    l_reg+=sacc; \
    if(GK){DMA_K((t)+3,sl_cur);} if(GV){DMA_V((t)+1,sl_next);} \
    CMASK(C0,C1,t); \
    { float a=MX3(C0[0],C0[1],C1[0]),b=MX3(C0[2],C0[3],C1[1]); a=MX3(a,C1[2],C1[3]); \
      _Pragma("unroll") for(int r=4;r<16;r+=4){a=MX3(a,C0[r],C0[r+1]);b=MX3(b,C0[r+2],C0[r+3]);a=MX3(a,C1[r],C1[r+1]);b=MX3(b,C1[r+2],C1[r+3]);} \
      float rm=__builtin_fmaxf(a,b); { auto rr=__builtin_amdgcn_permlane32_swap(__float_as_uint(rm),__float_as_uint(rm),false,false); rm=__builtin_fmaxf(__uint_as_float(rr[0]),__uint_as_float(rr[1])); } \
      resc=false; \
      if(__builtin_expect(__any(rm>(float)THRL),0)){ const float old_=mhat; SETM(old_+__builtin_fmaxf(rm,0.f)); const float dl=mhat-old_; \
        _Pragma("unroll") for(int r=0;r<16;++r){C0[r]-=dl;C1[r]-=dl;} \
        const float f=__builtin_amdgcn_exp2f(-dl); l_reg*=f; if(hi==0)wsf[r32]=f; resc=true; } } \
    SBAR(); \
    GAPB(o[0]=__builtin_amdgcn_mfma_f32_32x32x16_bf16(PAF(0),VFR(0),o[0],0,0,0), C0,0); \
    GAPB(o[1]=__builtin_amdgcn_mfma_f32_32x32x16_bf16(PAF(0),VFR(4),o[1],0,0,0), C0,4); \
    KRD(GL,0); GAPB(o[0]=__builtin_amdgcn_mfma_f32_32x32x16_bf16(PAF(1),VFR(1),o[0],0,0,0), C0,8); \
    KRD(GL,1); GAPB(o[1]=__builtin_amdgcn_mfma_f32_32x32x16_bf16(PAF(1),VFR(5),o[1],0,0,0), C0,12); \
    KRD(GL,2); GAPB(o[0]=__builtin_amdgcn_mfma_f32_32x32x16_bf16(PAF(2),VFR(2),o[0],0,0,0), C1,0); \
    KRD(GL,3); GAPB(o[1]=__builtin_amdgcn_mfma_f32_32x32x16_bf16(PAF(2),VFR(6),o[1],0,0,0), C1,4); \
    GAPB(o[0]=__builtin_amdgcn_mfma_f32_32x32x16_bf16(PAF(3),VFR(3),o[0],0,0,0), C1,8); \
    GAPB(o[1]=__builtin_amdgcn_mfma_f32_32x32x16_bf16(PAF(3),VFR(7),o[1],0,0,0), C1,12); \
    }while(0)
  int t=1;
  #undef CMASK
  #define CMASK(P0,P1,t) do{}while(0)
  for(;t+5<NT;t+=2){
    STEP(pB0,pB1,pA0,pA1,t,true,true,true);     WAIT_BAR(2); RESC(); ROT();
    STEP(pA0,pA1,pB0,pB1,t+1,true,true,true);   WAIT_BAR(2); RESC(); ROT();
  }
  #undef CMASK
  #define CMASK(P0,P1,t) do{int jb_=(t)-(NT-4); if(jb_>=0)cmask(P0,P1,jb_,qrel,hi);}while(0)
  #define ENDW(tt) do{ if((tt)+3<NT){WAIT_BAR(2);} else if((tt)+2<NT){WAIT_BAR(1);} else {WAIT_BAR(0);} }while(0)
  for(;t+1<NT;t+=2){
    STEP(pB0,pB1,pA0,pA1,t,(t+3<NT),(t+1<NT),(t+1<NT));       ENDW(t);   RESC(); ROT();
    STEP(pA0,pA1,pB0,pB1,t+1,(t+4<NT),(t+2<NT),(t+2<NT));     ENDW(t+1); RESC(); ROT();
  }
  STEP(pB0,pB1,pA0,pA1,NT-1,false,false,false); RESC();
  { float sacc=pB0[0]+pB0[1]; _Pragma("unroll") for(int r=2;r<16;++r)sacc+=pB0[r]; _Pragma("unroll") for(int r=0;r<16;++r)sacc+=pB1[r]; l_reg+=sacc;
    pw0=(u32x4){PKW(pB0,0),PKW(pB0,2),PKW(pB0,4),PKW(pB0,6)};pw1=(u32x4){PKW(pB0,8),PKW(pB0,10),PKW(pB0,12),PKW(pB0,14)};pw2=(u32x4){PKW(pB1,0),PKW(pB1,2),PKW(pB1,4),PKW(pB1,6)};pw3=(u32x4){PKW(pB1,8),PKW(pB1,10),PKW(pB1,12),PKW(pB1,14)};
    SBAR(); pv(o,vb0+sl_cur,PAF(0),PAF(1),PAF(2),PAF(3)); }
  #undef PKW
  #undef PAF
  #undef VFR
  #undef PIN
  #undef MX3
  #undef GAPA
  #undef GAPB
  #undef EX
  #undef VRD
  #undef KRD
  #undef STEP
  #undef ENDW
  {auto rr=__builtin_amdgcn_permlane32_swap(__float_as_uint(l_reg),__float_as_uint(l_reg),false,false);l_reg=__uint_as_float(rr[0])+__uint_as_float(rr[1]);}
  if(hi==0)wsf[32+r32]=l_reg;asm volatile("s_waitcnt lgkmcnt(0)":::"memory");
  float rli[16];
  #pragma unroll
  for(int r=0;r<16;++r)rli[r]=__builtin_amdgcn_rcpf(wsf[32+crow(r,hi)]);
  bf16*Ow=O+(rowbase+q0+wid*QBLK)*(long)OPITCH+OCOL0+h*D;
  { bf16*stg=(bf16*)(shm+LDS_OST)+wid*2048;
    #pragma unroll
    for(int r=0;r<16;++r){const int orow=crow(r,hi);
      #pragma unroll
      for(int d0=0;d0<2;++d0)stg[orow*64+d0*32+r32]=__float2bfloat16(o[d0][r]*rli[r]);}
    asm volatile("s_waitcnt lgkmcnt(0)":::"memory");
    #pragma unroll
    for(int i=0;i<4;++i){const int row=i*8+(lane>>3),ch=lane&7; const u32x4 v=*(const u32x4*)(stg+row*64+ch*8); bf16*gp=Ow+(long)row*OPITCH+ch*8; const u32x4 gt=*(const u32x4*)gp; if(!dry){ATTN_STORE16(gp,mul_bf16x8(v,gt));}} }
  asm volatile("s_waitcnt lgkmcnt(0)\n\ts_barrier":::"memory");
  #undef DMA_K
  #undef DMA_V
  #undef CMASK
  #undef START
  #undef RESC
  #undef ROT
  #undef SETM
}
constexpr int ATTN_LDS_BYTES=LDS_BYTES;
#undef SBAR
#undef WAIT_BAR
}
constexpr int BATCH = 4, SEQ = 8192, DMODEL = 1024, M = BATCH * SEQ, DEPTH = 2, INC = 7852;
constexpr int NT_A = 19, NT_B = 12, NTILES = NT_A + NT_B;
constexpr int SA_Q = 0, SA_K = 512, SA_V = 640, SA_G = 768, SB_Q = 1280, SB_K = 1792, SB_V = 1920, SB_IQ = 2048, SB_IK = 2176, SB_IW = 2208, SB_G = 2212,
              SC_Q = 2724, SC_K = 3236, SC_V = 3748, SC_F = 4260, SC_G = 4268, S_MG = 4780;
static_assert(S_MG + 3072 == INC, "column partition");
__host__ __device__ __forceinline__ int src_col(int t, int lc) {
    switch (t) {
        case 0: case 1: return SA_Q + t * 256 + lc;
        case 2: case 3: return SB_Q + (t - 2) * 256 + lc;
        case 4: case 5: return SC_Q + (t - 4) * 256 + lc;
        case 6: return lc < 128 ? SA_K + lc : SB_K + lc - 128;
        case 7: case 8: return SC_K + (t - 7) * 256 + lc;
        case 9: return lc < 128 ? SA_V + lc : SB_V + lc - 128;
        case 10: case 11: return SC_V + (t - 10) * 256 + lc;
        case 12: case 13: return SA_G + (t - 12) * 256 + lc;
        case 14: case 15: return SB_G + (t - 14) * 256 + lc;
        case 16: case 17: return SC_G + (t - 16) * 256 + lc;
        case 18: return lc < 128 ? SB_IQ + lc : lc < 160 ? SB_IK + lc - 128 : lc < 164 ? SB_IW + lc - 160 : lc < 172 ? SC_F + lc - 164 : -1;
        default: return S_MG + (t - 19) * 256 + lc;
    }
}
constexpr size_t MiB = 1u << 20;
constexpr size_t WS_CTL = 0, CTL_ZERO_BYTES = 1 * MiB;
constexpr size_t WS_W1T = 2 * MiB;
constexpr size_t WS_WBT = 33 * MiB;
constexpr size_t WS_WOT = 39 * MiB;
constexpr size_t WS_SSQ = 43 * MiB;
constexpr size_t WS_CL = 45 * MiB;
constexpr size_t WS_CT = 46 * MiB;
constexpr size_t WS_IW = 47 * MiB;
constexpr size_t WS_CF = 47 * MiB + 512 * 1024;
constexpr size_t WS_IQ = 49 * MiB;
constexpr size_t WS_IK = 57 * MiB;
constexpr size_t WS_XB = 60 * MiB;
constexpr size_t WS_MERGED = 124 * MiB;
constexpr size_t WS_G = 188 * MiB;
constexpr size_t WS_QA = 284 * MiB, WS_QB = 316 * MiB, WS_QC = 348 * MiB, WS_KC = 380 * MiB, WS_VC = 412 * MiB, WS_KAB = 444 * MiB, WS_VAB = 460 * MiB;
constexpr size_t WS_MG = 284 * MiB;
constexpr size_t WS_END = 476 * MiB;
static_assert(pg8::EWS_CL == WS_CL && pg8::EWS_CT == WS_CT && pg8::EWS_SSQ == WS_SSQ && pg8::EWS_IW == WS_IW && pg8::EWS_CF == WS_CF && pg8::EWS_IQ == WS_IQ && pg8::EWS_IK == WS_IK && pg8::EWS_G == WS_G && pg8::EWS_QA == WS_QA && pg8::EWS_QB == WS_QB &&
              pg8::EWS_QC == WS_QC && pg8::EWS_KC == WS_KC && pg8::EWS_VC == WS_VC && pg8::EWS_KAB == WS_KAB && pg8::EWS_VAB == WS_VAB, "epilogue offsets");
constexpr int CW_OVF = 8;
constexpr int CW_TICK = 8192;
constexpr int CW_BAR = 4096;
constexpr int RING_OFF = 0, RING_BYTES = 131072;
constexpr int SEL_OFF = 131072;
constexpr int H2_OFF = SEL_OFF + 8192;
constexpr int BIAS_OFF = H2_OFF + 8192;
constexpr int BKT_OFF = BIAS_OFF + 2048;
constexpr int MISC_OFF = BKT_OFF + 512;
constexpr int LDS_BYTES = 155648;
static_assert(MISC_OFF + 1024 <= LDS_BYTES, "LDS map");
constexpr int NB_OFF = 86016;
static_assert(attn_body::ATTN_LDS_BYTES <= NB_OFF && NB_OFF + 32768 <= RING_BYTES, "LDS map");
constexpr int MW_NSEL = 0, MW_NCAND = 16, MW_BIN = 32, MW_ABOVE = 48, MW_CARRY = 64, MW_BAR = 96, MW_SLOW = 100, MW_TICKET = 101, MW_ZCUT = 112, MW_UC = 128, MW_ELO = 160;

#define GAS __attribute__((address_space(1)))
#define LAS __attribute__((address_space(3)))
typedef unsigned short bf16;
typedef unsigned v4u __attribute__((ext_vector_type(4)));
typedef float f32x4 __attribute__((ext_vector_type(4)));
typedef short bf16x8 __attribute__((ext_vector_type(8)));
typedef GAS unsigned gu32;
#define RLX_AGENT __ATOMIC_RELAXED, __HIP_MEMORY_SCOPE_AGENT
#define LDS_WAIT() asm volatile("s_waitcnt lgkmcnt(0)" ::: "memory")
#define VM_WAIT() asm volatile("s_waitcnt vmcnt(0)" ::: "memory")
__device__ __forceinline__ unsigned f2bf(float f) { unsigned u = __builtin_bit_cast(unsigned, f); return (u + 0x7fffu + ((u >> 16) & 1u)) >> 16; }
__device__ __forceinline__ unsigned pk2(float lo, float hi) { return f2bf(lo) | (f2bf(hi) << 16); }

#define XB_TMO      128
#define XB_XCNT(j)  (256  + 64 * (j))
#define XB_XSUB(j)  (1280 + 64 * (j))
#define XB_XGEN(j)  (2304 + 64 * (j))
#define XB_TOP      3328
#define XB_TOPGEN   3392
#define XCD_BAR_WORDS 3456
#define XB_SPIN_CAP (1u << 18)

__device__ __forceinline__ unsigned xb_ld(unsigned* p)              { return __hip_atomic_load(p, __ATOMIC_RELAXED, __HIP_MEMORY_SCOPE_AGENT); }
__device__ __forceinline__ unsigned xb_add(unsigned* p, unsigned v) { return __hip_atomic_fetch_add(p, v, __ATOMIC_RELAXED, __HIP_MEMORY_SCOPE_AGENT); }
__device__ __forceinline__ unsigned xb_xcc_id() { return (unsigned)__builtin_amdgcn_s_getreg((3 << 11) | 20) & 0xFu; }
#define XB_SPIN(cond, bar) do { unsigned _sp = 0; while (cond) { __builtin_amdgcn_s_sleep(1); \
    if ((++_sp & 255u) == 0u) { if (xb_ld(&(bar)[XB_TMO])) break; if (_sp > XB_SPIN_CAP) { atomicAdd(&(bar)[XB_TMO], 1u); break; } } } } while (0)

struct XcdBarrier {
    unsigned* bar; unsigned x;
    volatile LAS unsigned* st;
};

__device__ __forceinline__ XcdBarrier xcd_barrier_post(unsigned* bar, volatile LAS unsigned* st) {
    XcdBarrier b; b.bar = bar; b.x = xb_xcc_id(); b.st = st;
    if (threadIdx.x == 0) (void)xb_add(&bar[XB_XCNT(b.x)], 1u);
    return b;
}
__device__ __forceinline__ void xcd_barrier_complete(unsigned* bar, unsigned x, unsigned& nloc, unsigned& nx) {
    const unsigned G = gridDim.x * gridDim.y * gridDim.z;
    unsigned sum, cnt, mine, sp = 0u;
    for (;;) {
        sum = 0u; cnt = 0u; mine = 0u;
#pragma unroll
        for (unsigned j = 0; j < 16; ++j) { const unsigned c = xb_ld(&bar[XB_XCNT(j)]); sum += c; cnt += (c > 0u) ? 1u : 0u; mine = (j == x) ? c : mine; }
        if (sum == G) break;
        __builtin_amdgcn_s_sleep(1);
        if ((++sp & 255u) == 0u) { if (xb_ld(&bar[XB_TMO])) break; if (sp > XB_SPIN_CAP) { atomicAdd(&bar[XB_TMO], 1u); break; } }
    }
    nloc = mine > 0u ? mine : 1u; nx = cnt > 0u ? cnt : 1u;
}

__device__ __forceinline__ void xcd_barrier(const XcdBarrier& b) {
    asm volatile("s_waitcnt vmcnt(0)" ::: "memory");
    __syncthreads();
    if (threadIdx.x == 0) {
        unsigned* bar = b.bar;
        __builtin_amdgcn_s_waitcnt(0);
        unsigned nloc = b.st[0], nx = b.st[1];
        if (nloc == 0u) { xcd_barrier_complete(bar, b.x, nloc, nx); b.st[0] = nloc; b.st[1] = nx; }
        const unsigned old = xb_add(&bar[XB_XSUB(b.x)], 1u);
        const unsigned gen = old / nloc;
        if (old + 1u == (gen + 1u) * nloc) {
            __builtin_amdgcn_fence(__ATOMIC_RELEASE, "agent");
            asm volatile("s_waitcnt vmcnt(0)" ::: "memory");
            const unsigned og = xb_add(&bar[XB_TOP], 1u);
            const unsigned tg = og / nx;
            if (og + 1u == (tg + 1u) * nx) xb_add(&bar[XB_TOPGEN], 1u);
            else XB_SPIN(xb_ld(&bar[XB_TOPGEN]) == tg, bar);
            __builtin_amdgcn_fence(__ATOMIC_ACQUIRE, "agent");
            xb_add(&bar[XB_XGEN(b.x)], 1u);
            asm volatile("s_waitcnt vmcnt(0)" ::: "memory");
        } else {
            XB_SPIN(xb_ld(&bar[XB_XGEN(b.x)]) == gen, bar);
            __builtin_amdgcn_fence(__ATOMIC_ACQUIRE, "agent");
            asm volatile("s_waitcnt vmcnt(0)" ::: "memory");
        }
    }
    __syncthreads();
}

struct Frame {
    LAS unsigned char* lds;
    volatile LAS unsigned* MISC;
    gu32* ctl;
    int tid, lane, wave, vcu, G;
};
__device__ __forceinline__ float wave_sum(float v) {
#pragma unroll
    for (int o = 1; o < 64; o <<= 1) v += __shfl_xor(v, o);
    return v;
}
__device__ __forceinline__ float wave_incl_scan(float v, int lane) {
#pragma unroll
    for (int o = 1; o < 64; o <<= 1) { const float t = __shfl_up(v, o); if (lane >= o) v += t; }
    return v;
}
__device__ __forceinline__ int wave_incl_scan_i(int v, int lane) {
#pragma unroll
    for (int o = 1; o < 64; o <<= 1) { const int t = __shfl_up(v, o); if (lane >= o) v += t; }
    return v;
}
__device__ __forceinline__ void transpose_item(const float* W, int N, bf16* WT, int K, int n0, int k0, int scol, const float* kscale, LAS float* scr, int lane) {
#pragma unroll 8
    for (int i = 0; i < 32; ++i) { const int kk = 2 * i + (lane >> 5); float v = 0.f;
        if (scol >= 0) { v = W[(size_t)(k0 + kk) * N + scol]; if (kscale) v *= kscale[k0 + kk]; }
        scr[kk * 33 + (lane & 31)] = v; }
    LDS_WAIT(); asm volatile("" ::: "memory");
    const int c = lane & 7;
#pragma unroll
    for (int j = 0; j < 4; ++j) { const int n = (lane >> 3) + 8 * j; const LAS float* s = scr + (8 * c) * 33 + n;
        v4u o; o.x = pk2(s[0 * 33], s[1 * 33]); o.y = pk2(s[2 * 33], s[3 * 33]); o.z = pk2(s[4 * 33], s[5 * 33]); o.w = pk2(s[6 * 33], s[7 * 33]);
        *(GAS v4u*)(WT + (size_t)(n0 + n) * K + k0 + 8 * c) = o; }
    LDS_WAIT(); asm volatile("" ::: "memory");
}
__device__ __forceinline__ void p0_prologue(Frame& F, const float* x, const float* norm_gain, const float* w_in, const float* w_branch, const float* w_out, unsigned char* ws) {
    LAS float* scr = (LAS float*)(F.lds + RING_OFF + F.wave * 16384);
    const int gw = F.vcu * 8 + F.wave, NGW = F.G * 8, lane = F.lane;
    constexpr int I_W1 = 16 * (NTILES * 256 / 32), I_WB = 8 * 32, I_WO = 16 * 32;
    constexpr int NITEMS = DEPTH * I_W1 + DEPTH * 3 * I_WB + DEPTH * I_WO;
    for (int it = gw; it < NITEMS; it += NGW) {
        int r = it;
        if (r < DEPTH * I_W1) { const int L = r / I_W1; r -= L * I_W1; const int nblk = NTILES * 8, kb = r / nblk, nb = r % nblk, n0 = nb * 32, tile = n0 >> 8, p = (n0 & 255) + (lane & 31);
            const int lc = 64 * ((p >> 5) & 3) + 32 * (p >> 7) + (p & 31);
            transpose_item(w_in + (size_t)L * DMODEL * INC, INC, (bf16*)(ws + WS_W1T) + (size_t)L * NTILES * 256 * 1024, 1024, n0, kb * 64, src_col(tile, lc), norm_gain + L * DMODEL, scr, lane); continue; }
        r -= DEPTH * I_W1;
        if (r < DEPTH * 3 * I_WB) { const int mat = r / I_WB; r -= mat * I_WB; const int kb = r / 32, nb = r % 32;
            transpose_item(w_branch + (size_t)mat * 512 * 1024, 1024, (bf16*)(ws + WS_WBT) + (size_t)mat * 1024 * 512, 512, nb * 32, kb * 64, nb * 32 + (lane & 31), nullptr, scr, lane); continue; }
        r -= DEPTH * 3 * I_WB;
        { const int L = r / I_WO; r -= L * I_WO; const int kb = r / 32, nb = r % 32;
            transpose_item(w_out + (size_t)L * 1024 * 1024, 1024, (bf16*)(ws + WS_WOT) + (size_t)L * 1024 * 1024, 1024, nb * 32, kb * 64, nb * 32 + (lane & 31), nullptr, scr, lane); }
    }
    bf16* XB = (bf16*)(ws + WS_XB); float* SSQ = (float*)(ws + WS_SSQ);
    for (int m = gw; m < M; m += NGW) {
        const GAS f32x4* xr = (const GAS f32x4*)(x + (size_t)m * DMODEL) + lane; f32x4 v[4]; float s = 0.f;
#pragma unroll
        for (int j = 0; j < 4; ++j) { v[j] = xr[64 * j]; s += (v[j].x * v[j].x + v[j].y * v[j].y) + (v[j].z * v[j].z + v[j].w * v[j].w); }
        const float tot = wave_sum(s);
        GAS unsigned long long* o8 = (GAS unsigned long long*)(XB + (size_t)m * DMODEL) + lane;
#pragma unroll
        for (int j = 0; j < 4; ++j) o8[64 * j] = (unsigned long long)pk2(v[j].x, v[j].y) | ((unsigned long long)pk2(v[j].z, v[j].w) << 32);
        if (lane < 16) SSQ[(size_t)m * 16 + lane] = lane == 0 ? tot : 0.f;
    }
}
__device__ __forceinline__ void scan_phase(Frame& F, const float* CF, const float* bforget  , float* CL, float* CT) {
    const int lane = F.lane, h = F.wave;
    for (int u = blockIdx.x; u < 128; u += F.G) { const int b = u >> 5, j = u & 31; const size_t row = (size_t)b * SEQ + 256 * j + 4 * lane; const float bf = bforget[h];
        float s[4]; float run = 0.f;
#pragma unroll
        for (int e = 0; e < 4; ++e) { const float xx = CF[(row + e) * 8 + h] + bf; const float lf = (xx < 0.f ? xx : 0.f) - __logf(1.0f + __expf(-fabsf(xx))); run += lf; s[e] = run; }
        const float incl = wave_incl_scan(run, lane), excl = incl - run;
        *(f32x4*)(CL + (size_t)(b * 8 + h) * SEQ + 256 * j + 4 * lane) = (f32x4){excl + s[0], excl + s[1], excl + s[2], excl + s[3]};
        if (lane == 63) CT[(b * 8 + h) * 32 + j] = incl;
    }
}
#ifndef REP_IDX
#define REP_IDX 1
#endif
#ifndef REP_SPB
#define REP_SPB 1
#endif
#ifndef REP_SPA
#define REP_SPA 1
#endif
typedef unsigned u32x2 __attribute__((ext_vector_type(2)));
constexpr int NBIN = 1024;
__device__ __forceinline__ float pdist(float s, float c0, float inv) { return fmaf(s, inv, c0); }
__device__ __forceinline__ unsigned pbin_d(float d) { const unsigned a = __float_as_uint(d) & 0x7fffffffu;
    int fx = (int)(a >> 19) - 1647; fx = fx < 0 ? 0 : (fx > 511 ? 511 : fx);
    return (__float_as_uint(d) >> 31) ? 511u - (unsigned)fx : 512u + (unsigned)fx; }
__device__ __forceinline__ unsigned pbin(float s, float sc, float inv) { return pbin_d(pdist(s, sc, inv)); }
__device__ __forceinline__ float pedge(int b) {
    if (b >= NBIN) return INFINITY; if (b <= 0) return -INFINITY;
    if (b > 512) return __uint_as_float((unsigned)(b - 512 + 1647) << 19);
    if (b == 512) return 0.0f;
    return -__uint_as_float(((unsigned)(511 - b + 1648) << 19) - 1u);
}
constexpr int CMAX = 1024;
#define LDS_ADD(p, v) __hip_atomic_fetch_add((p), (v), __ATOMIC_RELAXED, __HIP_MEMORY_SCOPE_WORKGROUP)
__device__ __forceinline__ unsigned okey(float s) { const unsigned u = __float_as_uint(s); return (u & 0x80000000u) ? ~u : (u | 0x80000000u); }
struct BAParams { const bf16 *IQ, *IK; const float* IW; const bf16 *QA, *QB, *KAB, *VAB; bf16* G; const float* sinks; };
__device__ __forceinline__ float relu_f(float x) { const int i = __float_as_int(x); return __int_as_float(i > 0 ? i : 0); }

template <int PASS, bool DIAG> __device__ __forceinline__ void idx_tile(const bf16x8 ak, const bf16x8 (&bq)[4], const f32x4 w4, int kt, int g4, int r, int tq, float elo, float ehi,
                                                                       LAS unsigned* hl, unsigned lp, unsigned hinc, LAS u32x2* cand, LAS unsigned short* sel, LAS unsigned* misc, LAS unsigned* zh, int zcut, float sc, float inv) {
    const f32x4 z = {0.f, 0.f, 0.f, 0.f};
    const f32x4 d0 = __builtin_amdgcn_mfma_f32_16x16x32_bf16(ak, bq[0], z, 0, 0, 0), d1 = __builtin_amdgcn_mfma_f32_16x16x32_bf16(ak, bq[1], z, 0, 0, 0),
                d2 = __builtin_amdgcn_mfma_f32_16x16x32_bf16(ak, bq[2], z, 0, 0, 0), d3 = __builtin_amdgcn_mfma_f32_16x16x32_bf16(ak, bq[3], z, 0, 0, 0);
    float sv[4]; bool qs[4], qc[4]; unsigned n1 = 0, n2 = 0, nz = 0;
#pragma unroll
    for (int i = 0; i < 4; ++i) {
        float s = 0.f; s = fmaf(w4[0], relu_f(d0[i]), s); s = fmaf(w4[1], relu_f(d1[i]), s); s = fmaf(w4[2], relu_f(d2[i]), s); s = fmaf(w4[3], relu_f(d3[i]), s);
        const int key = 16 * kt + 4 * g4 + i; sv[i] = s; const bool ok = !DIAG || key <= tq; const float d = pdist(s, sc, inv);
        if (PASS == 1) { if (ok) { const unsigned bin = pbin_d(d); LDS_ADD(hl + (bin * 32u + (lp ^ (bin & 31u))), hinc); nz += (s == 0.0f) ? 1u : 0u; } }
        else { qs[i] = ok && d >= ehi; qc[i] = ok && !(d >= ehi) && d >= elo && (s != 0.0f || key < zcut)  ;
               n1 += qs[i] ? 1u : 0u; n2 += qc[i] ? 1u : 0u; }
    }
    if (PASS == 1) { if (nz) LDS_ADD(zh + (kt >> 3), nz); }
    if (PASS == 2) {
        const unsigned add = n1 | (n2 << 16);
        if (add) { const unsigned pos = LDS_ADD(misc + MW_NSEL + r, add); unsigned p1 = pos & 0xffffu, p2 = pos >> 16;
#pragma unroll
            for (int i = 0; i < 4; ++i) { const int key = 16 * kt + 4 * g4 + i;
                if (qs[i]) { if (p1 < 256u) sel[p1] = (unsigned short)key; ++p1; }
                if (qc[i]) { if (p2 < (unsigned)CMAX) cand[p2] = (u32x2){okey(sv[i]), (unsigned)key}; ++p2; } } }
    }
}
template <int PASS> __device__ __forceinline__ void idx_pass(Frame& F, const bf16* IKb, const bf16x8 (&bq)[4], const f32x4 w4, int tau, int t0) {
    int lane_ = F.lane; asm volatile("" : "+v"(lane_)); const int lane = lane_, r = lane & 15, g4 = lane >> 4, tq = t0 + r;
    LAS unsigned* hl = (LAS unsigned*)(F.lds + RING_OFF); const unsigned lp = (unsigned)lane >> 1, hinc = 1u << ((lane & 1) * 16);
    LAS u32x2* cand = (LAS u32x2*)(F.lds + RING_OFF) + r * CMAX;
    LAS unsigned short* sel = (LAS unsigned short*)(F.lds + SEL_OFF) + r * 256;
    LAS unsigned* misc = (LAS unsigned*)(F.lds + MISC_OFF);
    float elo = 0.f, ehi = 0.f; int zcut = SEQ; if (PASS == 2) { elo = __uint_as_float(misc[MW_ELO + r]); ehi = __uint_as_float(misc[MW_ELO + 16 + r]); zcut = (int)misc[MW_ZCUT + r]; }
    LAS unsigned* zh = (LAS unsigned*)(F.lds + H2_OFF) + r * 64;
    const bf16* kp = IKb + (size_t)r * 32 + 8 * g4;
    float sc, inv; { const bf16x8 at = *(const bf16x8*)kp; const f32x4 z = {0.f, 0.f, 0.f, 0.f};
        const f32x4 d0 = __builtin_amdgcn_mfma_f32_16x16x32_bf16(at, bq[0], z, 0, 0, 0), d1 = __builtin_amdgcn_mfma_f32_16x16x32_bf16(at, bq[1], z, 0, 0, 0),
                    d2 = __builtin_amdgcn_mfma_f32_16x16x32_bf16(at, bq[2], z, 0, 0, 0), d3 = __builtin_amdgcn_mfma_f32_16x16x32_bf16(at, bq[3], z, 0, 0, 0);
        float mx = -INFINITY, ma = 0.f;
#pragma unroll
        for (int i = 0; i < 4; ++i) { float s = 0.f; s = fmaf(w4[0], relu_f(d0[i]), s); s = fmaf(w4[1], relu_f(d1[i]), s); s = fmaf(w4[2], relu_f(d2[i]), s); s = fmaf(w4[3], relu_f(d3[i]), s); mx = fmaxf(mx, s); ma = fmaxf(ma, fabsf(s)); }
        mx = fmaxf(mx, __shfl_xor(mx, 16)); mx = fmaxf(mx, __shfl_xor(mx, 32)); ma = fmaxf(ma, __shfl_xor(ma, 16)); ma = fmaxf(ma, __shfl_xor(ma, 32));
        inv = (ma > 1e-30f && ma < 1e30f) ? 1.0f / ma : 1.0f; sc = -(mx * inv);
        if (PASS == 1 && F.wave == 0 && g4 == 0) { misc[MW_UC + r] = __float_as_uint(sc); misc[MW_UC + 16 + r] = __float_as_uint(inv); } }
    int kt = F.wave; if (kt > tau) return;
    bf16x8 a0 = *(const bf16x8*)(kp + (size_t)kt * 512);
    bf16x8 a1 = *(const bf16x8*)(kp + (size_t)(kt + 8 <= tau ? kt + 8 : kt) * 512);
    for (; kt <= tau; kt += 8) {
        const int k2 = kt + 16 <= tau ? kt + 16 : kt; const bf16x8 a2 = *(const bf16x8*)(kp + (size_t)k2 * 512);
        if (kt < tau) idx_tile<PASS, false>(a0, bq, w4, kt, g4, r, tq, elo, ehi, hl, lp, hinc, cand, sel, misc, zh, zcut, sc, inv);
        else          idx_tile<PASS, true>(a0, bq, w4, kt, g4, r, tq, elo, ehi, hl, lp, hinc, cand, sel, misc, zh, zcut, sc, inv);
        a0 = a1; a1 = a2;
    }
}
__device__ __forceinline__ void idx_threshold(Frame& F) {
    int lane_ = F.lane; asm volatile("" : "+v"(lane_)); const int lane = lane_; LAS unsigned* misc = (LAS unsigned*)(F.lds + MISC_OFF);
    for (int qq = 0; qq < 2; ++qq) { const int q = 2 * F.wave + qq; const unsigned sh = (q & 1) * 16, qh = (unsigned)q >> 1;
        const LAS unsigned* hb = (const LAS unsigned*)(F.lds + RING_OFF);
        int cnt[16];
#pragma unroll
        for (int k = 0; k < 16; ++k) { const unsigned bin = 64u * k + lane, sw = bin & 31u; const LAS unsigned* p = hb + bin * 32u;
            cnt[k] = (int)(((p[qh ^ sw] >> sh) & 0xffffu) + ((p[(qh + 8u) ^ sw] >> sh) & 0xffffu) + ((p[(qh + 16u) ^ sw] >> sh) & 0xffffu) + ((p[(qh + 24u) ^ sw] >> sh) & 0xffffu)); }
        int a8[8], a4[4], a2[2], a1;
        { const bool h5 = lane & 32, h4 = lane & 16, h3 = lane & 8, h2 = lane & 4;
#pragma unroll
          for (int i = 0; i < 8; ++i) { const int mine = h5 ? cnt[8 + i] : cnt[i], theirs = h5 ? cnt[i] : cnt[8 + i]; a8[i] = mine + __shfl_xor(theirs, 32); }
#pragma unroll
          for (int i = 0; i < 4; ++i) { const int mine = h4 ? a8[4 + i] : a8[i], theirs = h4 ? a8[i] : a8[4 + i]; a4[i] = mine + __shfl_xor(theirs, 16); }
#pragma unroll
          for (int i = 0; i < 2; ++i) { const int mine = h3 ? a4[2 + i] : a4[i], theirs = h3 ? a4[i] : a4[2 + i]; a2[i] = mine + __shfl_xor(theirs, 8); }
          { const int mine = h2 ? a2[1] : a2[0], theirs = h2 ? a2[0] : a2[1]; a1 = mine + __shfl_xor(theirs, 4); }
          a1 += __shfl_xor(a1, 1); a1 += __shfl_xor(a1, 2); }
        int ks = 0, aseg = 0, v = cnt[0]; { int cum = 0; bool found = false;
#pragma unroll
            for (int k = 15; k >= 0; --k) { const int Tk = __builtin_amdgcn_readlane(a1, 4 * k); if (!found && cum + Tk >= 256) { found = true; ks = k; aseg = cum; v = cnt[k]; } cum += Tk; } }
        const int pre = wave_incl_scan_i(v, lane);
        int tot = pre; tot = __shfl(tot, 63);
        const int suf = tot - pre + v;
        const unsigned long long mask = __ballot(aseg + suf >= 256);
        const int Ls = mask ? 63 - (int)__builtin_clzll(mask) : 0;
        if (lane == Ls) { const int bs = 64 * ks + lane; misc[MW_BIN + q] = (unsigned)bs; misc[MW_ABOVE + q] = (unsigned)(aseg + suf - v);
                          misc[MW_ELO + q] = __float_as_uint(pedge(bs)); misc[MW_ELO + 16 + q] = __float_as_uint(pedge(bs + 1)); }
        { const int binstar = __shfl(64 * ks + lane, Ls), needz = 256 - __shfl(aseg + suf - v, Ls);
          const int zc = (int)((const LAS unsigned*)(F.lds + H2_OFF))[q * 64 + lane]; const int zi = wave_incl_scan_i(zc, lane);
          const unsigned long long zm = __ballot(zi >= needz);
          if (lane == 0) misc[MW_ZCUT + q] = (binstar == (int)pbin(0.0f, __uint_as_float(misc[MW_UC + q]), __uint_as_float(misc[MW_UC + 16 + q])) && zm) ? (unsigned)(128 * ((int)__builtin_ctzll(zm) + 1)) : (unsigned)SEQ; }
    }
}
__device__ __forceinline__ unsigned idx_digit(const u32x2 e, int lvl) { const unsigned v = 8191u - e.y;
    return lvl == 0 ? e.x >> 24 : lvl == 1 ? (e.x >> 16) & 255u : lvl == 2 ? (e.x >> 8) & 255u : lvl == 3 ? e.x & 255u : lvl == 4 ? (v >> 5) & 255u : v & 31u; }
__device__ __forceinline__ void idx_resolve(Frame& F) {
    int lane_ = F.lane; asm volatile("" : "+v"(lane_)); const int lane = lane_; LAS unsigned* misc = (LAS unsigned*)(F.lds + MISC_OFF);
    LAS unsigned* h2 = (LAS unsigned*)(F.lds + H2_OFF) + F.wave * 256;
    for (int qq = 0; qq < 2; ++qq) { const int q = 2 * F.wave + qq;
        const unsigned packed = misc[MW_NSEL + q];
        if (lane == 0) misc[MW_NSEL + q] = packed & 0xffffu;
        int c = (int)(packed >> 16); if (c > CMAX) { c = CMAX; if (lane == 0) __hip_atomic_fetch_add(F.ctl + CW_OVF, 1u, RLX_AGENT); }
        int need = 256 - (int)misc[MW_ABOVE + q];
        LAS u32x2* cq = (LAS u32x2*)(F.lds + RING_OFF) + q * CMAX;
        LAS unsigned short* sel = (LAS unsigned short*)(F.lds + SEL_OFF) + q * 256;
        if (c > need && c <= 64) {
            u32x2 e = {0u, 0u}; if (lane < c) e = cq[lane]; int rank = 0;
            for (int j = 0; j < c; ++j) { const unsigned uj = (unsigned)__builtin_amdgcn_readlane((int)e.x, j), ij = (unsigned)__builtin_amdgcn_readlane((int)e.y, j); rank += (uj > e.x || (uj == e.x && ij < e.y)) ? 1 : 0; }
            if (lane < c && rank < need) { const unsigned pos = LDS_ADD(misc + MW_NSEL + q, 1u); if (pos < 256u) sel[pos] = (unsigned short)e.y; }
            c = 0; need = 0;
        }
#pragma unroll 1
        for (int lvl = 0; lvl < 6 && c > need; ++lvl) {
            *(LAS v4u*)(h2 + 4 * lane) = (v4u){0u, 0u, 0u, 0u};
            for (int i = lane; i < c; i += 64) LDS_ADD(h2 + idx_digit(cq[i], lvl), 1u);
            const v4u hw = *(const LAS v4u*)(h2 + 252 - 4 * lane);
            const int total = (int)(hw.x + hw.y + hw.z + hw.w), incl = wave_incl_scan_i(total, lane);
            const unsigned long long mask = __ballot(incl >= need);
            const int Ls = mask ? (int)__builtin_ctzll(mask) : 63;
            int dstar_l = 0, above_l = 0; { int cum = incl - total; bool found = false;
#pragma unroll
                for (int e = 3; e >= 0; --e) { const int cc = (int)hw[e]; if (!found && cum + cc >= need) { found = true; dstar_l = 252 - 4 * lane + e; above_l = cum; } cum += cc; } }
            const unsigned dstar = (unsigned)__shfl(dstar_l, Ls); const int above = __shfl(above_l, Ls);
            int c2 = 0;
            for (int base = 0; base < c; base += 64) { const int i = base + lane; const bool valid = i < c; u32x2 e = {0u, 0u}; if (valid) e = cq[i];
                const unsigned dg = idx_digit(e, lvl); const bool tie = valid && dg == dstar;
                if (valid && dg > dstar) { const unsigned pos = LDS_ADD(misc + MW_NSEL + q, 1u); if (pos < 256u) sel[pos] = (unsigned short)e.y; }
                const unsigned long long tm = __ballot(tie);
                if (tie) cq[c2 + __popcll(tm & ((1ull << lane) - 1ull))] = e;
                c2 += __popcll(tm); }
            c = c2; need -= above;
        }
        for (int i = lane; i < c && i < need; i += 64) { const unsigned pos = LDS_ADD(misc + MW_NSEL + q, 1u); if (pos < 256u) sel[pos] = (unsigned short)cq[i].y; }
    }
}
typedef short s16x4 __attribute__((ext_vector_type(4)));
__device__ __forceinline__ void sp_glds16(const void* gsrc, unsigned lds_dst) { unsigned keep;
    asm volatile("s_mov_b32 %0, m0\n\ts_mov_b32 m0, %2\n\ts_nop 0\n\tglobal_load_lds_dwordx4 %1, off\n\ts_mov_b32 m0, %0" : "=&s"(keep) : "v"(gsrc), "s"(lds_dst) : "memory"); }
__device__ __forceinline__ void sp_glds16s(const void* sbase, unsigned voff, unsigned lds_dst) { unsigned keep;
    asm volatile("s_mov_b32 %0, m0\n\ts_mov_b32 m0, %3\n\ts_nop 0\n\tglobal_load_lds_dwordx4 %1, %2\n\ts_mov_b32 m0, %0" : "=&s"(keep) : "v"(voff), "s"(sbase), "s"(lds_dst) : "memory"); }
__device__ __forceinline__ void sp_glds16s_x4(const void* sbase, unsigned v0, unsigned v1, unsigned v2, unsigned v3, unsigned lds_dst) { unsigned keep;
    asm volatile("s_mov_b32 %0, m0\n\ts_mov_b32 m0, %6\n\ts_nop 0\n\tglobal_load_lds_dwordx4 %1, %5\n\ts_add_u32 m0, m0, 0x400\n\ts_nop 0\n\tglobal_load_lds_dwordx4 %2, %5\n\ts_add_u32 m0, m0, 0x400\n\ts_nop 0\n\tglobal_load_lds_dwordx4 %3, %5\n\ts_add_u32 m0, m0, 0x400\n\ts_nop 0\n\tglobal_load_lds_dwordx4 %4, %5\n\ts_mov_b32 m0, %0"
                 : "=&s"(keep) : "v"(v0), "v"(v1), "v"(v2), "v"(v3), "s"(sbase), "s"(lds_dst) : "memory", "scc"); }
template <bool IS_A> __device__ __forceinline__ void sparse_pair(Frame& F, const BAParams& P, int rb, int tA, int qi0, int nv0, int nv1, bool dry) {
    constexpr int NC = IS_A ? 8 : 16, NSLOT = NC * 16, KOFF = IS_A ? 0 : M * 128, HB = IS_A ? 0 : 8, GOFF = IS_A ? 0 : 512;
    int lane_ = F.lane; asm volatile("" : "+v"(lane_)); const int lane = lane_, r = lane & 15, g4 = lane >> 4, my_a = g4 >> 1, my_j = g4 & 1;
    const bf16* Q = IS_A ? P.QA : P.QB;
    const LAS unsigned short* sel = (const LAS unsigned short*)(F.lds + SEL_OFF) + qi0 * 256;
    const LAS float* BIAS = (const LAS float*)(F.lds + BIAS_OFF);
    const LAS unsigned char* BKT = (const LAS unsigned char*)(F.lds + BKT_OFF);
    LAS unsigned short* Pimg = (LAS unsigned short*)(F.lds + RING_OFF + F.wave * 16384);
    bf16x8 q0, q1; const bf16x8 zz = {0, 0, 0, 0, 0, 0, 0, 0};
    { const int a_r = r >> 3, hd = r & 7; const bf16* qp = Q + (size_t)(rb + tA + a_r) * 512 + hd * 64 + 8 * g4; q0 = *(const bf16x8*)qp; q1 = *(const bf16x8*)(qp + 32); }
    const int my_t = tA + my_a, rcb = r >> 2;
    f32x4 x[NC];
#pragma unroll
    for (int c = 0; c < NC; ++c) x[c] = (f32x4){0.f, 0.f, 0.f, 0.f};
    constexpr int KS = NSLOT / 32, NST = 4 * KS;
    const unsigned wk = (unsigned)__builtin_amdgcn_readfirstlane((int)((unsigned)(uintptr_t)(F.lds + RING_OFF) + (unsigned)F.wave * 16384u));
    const int drow = lane >> 3, dpc = lane & 7;
#define SP_KDMA(st, bufi) do { const int cb_ = (st) / KS, ks_ = (st) % KS, a_ = cb_ >> 1, j_ = cb_ & 1; unsigned vo_[4]; \
        _Pragma("unroll") for (int i_ = 0; i_ < 4; ++i_) { const int slot_ = 32 * ks_ + 8 * i_ + drow; int key_; \
            if (IS_A) { key_ = tA + a_ - slot_; key_ = key_ < 0 ? 0 : key_; } else { key_ = sel[a_ * 256 + slot_]; }   \
            vo_[i_] = (unsigned)(((rb + key_) * 128 + KOFF + j_ * 64 + ((dpc ^ (drow & 7)) * 8)) * 2); } \
        sp_glds16s_x4(P.KAB, vo_[0], vo_[1], vo_[2], vo_[3], (unsigned)__builtin_amdgcn_readfirstlane((int)(wk + (unsigned)((bufi) * 4096)))); } while (0)
    asm volatile("s_waitcnt vmcnt(0)" ::: "memory");
    SP_KDMA(0, 0); SP_KDMA(1, 1); SP_KDMA(2, 2); if (NST > 3) SP_KDMA(3, 3);
    { const LAS unsigned char* kring = F.lds + RING_OFF + F.wave * 16384;
      static_assert(KS % 4 == 0, "the ring position of a step is its k-step index mod 4");
#pragma unroll 1
      for (int cb = 0; cb < 4; ++cb) { const bool mine = rcb == cb; const bf16x8 a0 = mine ? q0 : zz, a1 = mine ? q1 : zz;
#pragma unroll
        for (int ks = 0; ks < KS; ++ks) { const int st = cb * KS + ks;
          if (cb < 3 || ks + 3 < KS) asm volatile("s_waitcnt vmcnt(12)" ::: "memory"); else if (ks + 2 < KS) asm volatile("s_waitcnt vmcnt(8)" ::: "memory"); else if (ks + 1 < KS) asm volatile("s_waitcnt vmcnt(4)" ::: "memory"); else asm volatile("s_waitcnt vmcnt(0)" ::: "memory");
          const LAS unsigned char* kb = kring + (ks & 3) * 4096;
          bf16x8 f[2][2];
#pragma unroll
          for (int cc = 0; cc < 2; ++cc)
#pragma unroll
              for (int k2 = 0; k2 < 2; ++k2) f[cc][k2] = *(const LAS bf16x8*)(kb + (16 * cc + r) * 128 + (((4 * k2 + g4) ^ (r & 7)) * 16));
          asm volatile("s_waitcnt lgkmcnt(0)" ::: "memory");
#pragma unroll
          for (int cc = 0; cc < 2; ++cc) { x[2 * ks + cc] = __builtin_amdgcn_mfma_f32_16x16x32_bf16(a0, f[cc][0], x[2 * ks + cc], 0, 0, 0); x[2 * ks + cc] = __builtin_amdgcn_mfma_f32_16x16x32_bf16(a1, f[cc][1], x[2 * ks + cc], 0, 0, 0); }
          if (st + 4 < NST) SP_KDMA(st + 4, ks & 3);
        } } }
#undef SP_KDMA
#pragma unroll
    for (int c = 0; c < NC; ++c) { const int slot = 16 * c + r; int mk; bool mv;
        if (IS_A) { mk = my_t - slot; mv = mk >= 0; } else { mk = sel[my_a * 256 + slot]; mv = slot < (my_a ? nv1 : nv0); }
        const int delta = my_t - mk; const bool ok = mv && delta >= 0;
        const int bk = (ok && delta < 512) ? (int)BKT[delta] : 31;
        const f32x4 b4 = *(const LAS f32x4*)(BIAS + bk * 16 + HB + 4 * my_j);
#pragma unroll
        for (int i = 0; i < 4; ++i) x[c][i] = ok ? x[c][i] * 0.125f + b4[i] : -INFINITY; }
    f32x4 mx = x[0];
#pragma unroll
    for (int c = 1; c < NC; ++c)
#pragma unroll
        for (int i = 0; i < 4; ++i) mx[i] = fmaxf(mx[i], x[c][i]);
#pragma unroll
    for (int o = 1; o < 16; o <<= 1)
#pragma unroll
        for (int i = 0; i < 4; ++i) mx[i] = fmaxf(mx[i], __shfl_xor(mx[i], o));
    f32x4 sk = {0.f, 0.f, 0.f, 0.f};
    if (IS_A) { sk = *(const f32x4*)(P.sinks + 4 * my_j);
#pragma unroll
        for (int i = 0; i < 4; ++i) mx[i] = fmaxf(mx[i], sk[i]); }
    f32x4 sum = {0.f, 0.f, 0.f, 0.f};
#pragma unroll
    for (int c = 0; c < NC; ++c)
#pragma unroll
        for (int i = 0; i < 4; ++i) { x[c][i] = __expf(x[c][i] - mx[i]); sum[i] += x[c][i]; }
#pragma unroll
    for (int o = 1; o < 16; o <<= 1)
#pragma unroll
        for (int i = 0; i < 4; ++i) sum[i] += __shfl_xor(sum[i], o);
    if (IS_A) {
#pragma unroll
        for (int i = 0; i < 4; ++i) sum[i] += __expf(sk[i] - mx[i]); }
    f32x4 inv;
#pragma unroll
    for (int i = 0; i < 4; ++i) inv[i] = 1.0f / sum[i];
#define SP_PWRITE(qa) do { if (my_a == (qa)) { _Pragma("unroll") for (int c_ = 0; c_ < NC; ++c_) _Pragma("unroll") for (int i_ = 0; i_ < 4; ++i_) \
        Pimg[(4 * my_j + i_) * NSLOT + 16 * c_ + r] = (unsigned short)f2bf(x[c_][i_] * inv[i_]); } } while (0)
    SP_PWRITE(0);
    const unsigned wl = wk + 4096u;
#define SP_VDMA(st, bufi) do { const int cb_ = (st) / KS, ks_ = (st) % KS, a_ = cb_ >> 1, j_ = cb_ & 1; unsigned vo_[4]; \
        _Pragma("unroll") for (int i_ = 0; i_ < 4; ++i_) { const int slot_ = 32 * ks_ + 8 * i_ + drow; int key_; \
            if (IS_A) { key_ = tA + a_ - slot_; key_ = key_ < 0 ? 0 : key_; } else { key_ = sel[a_ * 256 + slot_]; } \
            vo_[i_] = (unsigned)(((rb + key_) * 128 + KOFF + j_ * 64 + dpc * 8) * 2); } \
        sp_glds16s_x4(P.VAB, vo_[0], vo_[1], vo_[2], vo_[3], (unsigned)__builtin_amdgcn_readfirstlane((int)(wl + (unsigned)((bufi) * 4096)))); } while (0)
    asm volatile("s_waitcnt vmcnt(0)" ::: "memory");
    SP_VDMA(0, 0); SP_VDMA(1, 1); SP_VDMA(2, 2);
    f32x4 o[4];
#pragma unroll
    for (int db = 0; db < 4; ++db) o[db] = (f32x4){0.f, 0.f, 0.f, 0.f};
    const unsigned trb = (unsigned)((8 * g4 + ((lane & 15) >> 2)) * 128 + (lane & 3) * 8);
    int bufi = 0;
#pragma unroll 1
    for (int cb = 0; cb < 4; ++cb) { const bool minep = rcb == cb;
        if (cb == 2) { SP_PWRITE(1); }
#pragma unroll
        for (int ks = 0; ks < KS; ++ks) { const int st = cb * KS + ks;
            if (cb < 3 || ks + 2 < KS) asm volatile("s_waitcnt vmcnt(8)" ::: "memory"); else if (ks + 1 < KS) asm volatile("s_waitcnt vmcnt(4)" ::: "memory"); else asm volatile("s_waitcnt vmcnt(0)" ::: "memory");
            const unsigned vb = wl + (unsigned)(bufi * 4096) + trb;
            s16x4 lo[4], hi[4];
#pragma unroll
            for (int db = 0; db < 4; ++db) {
                asm volatile("ds_read_b64_tr_b16 %0, %1 offset:%c2" : "=&v"(lo[db]) : "v"(vb), "i"(db * 32) : "memory");
                asm volatile("ds_read_b64_tr_b16 %0, %1 offset:%c2" : "=&v"(hi[db]) : "v"(vb), "i"(db * 32 + 512) : "memory"); }
            bf16x8 pb = *(const LAS bf16x8*)(Pimg + (r & 7) * NSLOT + 32 * ks + 8 * g4);
            pb = minep ? pb : zz;
            asm volatile("s_waitcnt lgkmcnt(0)" ::: "memory");
#pragma unroll
            for (int db = 0; db < 4; ++db) { const bf16x8 va = {lo[db][0], lo[db][1], lo[db][2], lo[db][3], hi[db][0], hi[db][1], hi[db][2], hi[db][3]};
                o[db] = __builtin_amdgcn_mfma_f32_16x16x32_bf16(va, pb, o[db], 0, 0, 0); }
            if (st + 3 < NST) SP_VDMA(st + 3, bufi);
            bufi = bufi == 2 ? 0 : bufi + 1;
        } }
#undef SP_VDMA
#undef SP_PWRITE
    if (!dry) { bf16* gp = P.G + (size_t)(rb + tA + (r >> 3)) * 1536 + GOFF + (r & 7) * 64 + 4 * g4;
#pragma unroll
        for (int db = 0; db < 4; ++db) { const u32x2 gt = *(const u32x2*)(gp + 16 * db);
            const float g0 = __uint_as_float(gt.x << 16), g1 = __uint_as_float(gt.x & 0xffff0000u), g2 = __uint_as_float(gt.y << 16), g3 = __uint_as_float(gt.y & 0xffff0000u);
            u32x2 w; w.x = pk2(o[db][0] * g0, o[db][1] * g1); w.y = pk2(o[db][2] * g2, o[db][3] * g3);
            *(u32x2*)(gp + 16 * db) = w; } }
}
__device__ __forceinline__ void swa_dense(Frame& F, const BAParams& P, int rb, int t0, bool dry) {
    constexpr int NC = 10, NSLOT = 160, NST = 5;
    int lane_ = F.lane; asm volatile("" : "+v"(lane_)); const int lane = lane_, r = lane & 15, g4 = lane >> 4, j = F.wave >> 2, qg = F.wave & 3, kbase = t0 - 128;
    const LAS float* BIAS = (const LAS float*)(F.lds + BIAS_OFF);
    const LAS unsigned char* BKT = (const LAS unsigned char*)(F.lds + BKT_OFF);
    LAS unsigned short* Pimg = (LAS unsigned short*)(F.lds + RING_OFF + F.wave * 16384);
    bf16x8 qf[2]; { const bf16* qp = P.QA + (size_t)(rb + t0 + 4 * qg + (r >> 2)) * 512 + (4 * j + (r & 3)) * 64 + 8 * g4; qf[0] = *(const bf16x8*)qp; qf[1] = *(const bf16x8*)(qp + 32); }
    bf16x8 kf[NC][2];
#pragma unroll
    for (int c = 0; c < NC; ++c) { int key = kbase + 16 * c + r; key = key < 0 ? 0 : (key > SEQ - 1 ? SEQ - 1 : key);
        const bf16* kp = P.KAB + (size_t)(rb + key) * 128 + j * 64 + 8 * g4; kf[c][0] = *(const bf16x8*)kp; kf[c][1] = *(const bf16x8*)(kp + 32); }
    const int my_t = t0 + 4 * qg + g4;
    f32x4 x[NC];
#pragma unroll
    for (int c = 0; c < NC; ++c) { f32x4 d = {0.f, 0.f, 0.f, 0.f};
        d = __builtin_amdgcn_mfma_f32_16x16x32_bf16(qf[0], kf[c][0], d, 0, 0, 0); d = __builtin_amdgcn_mfma_f32_16x16x32_bf16(qf[1], kf[c][1], d, 0, 0, 0);
        const int key = kbase + 16 * c + r, delta = my_t - key; const bool ok = key >= 0 && delta >= 0 && delta < 128;
        const int bk = (int)BKT[ok ? delta : 0];
        const f32x4 b4 = *(const LAS f32x4*)(BIAS + bk * 16 + 4 * j);
#pragma unroll
        for (int i = 0; i < 4; ++i) x[c][i] = ok ? d[i] * 0.125f + b4[i] : -INFINITY; }
    f32x4 mx = *(const f32x4*)(P.sinks + 4 * j); const f32x4 sk = mx;
#pragma unroll
    for (int c = 0; c < NC; ++c)
#pragma unroll
        for (int i = 0; i < 4; ++i) mx[i] = fmaxf(mx[i], x[c][i]);
#pragma unroll
    for (int o = 1; o < 16; o <<= 1)
#pragma unroll
        for (int i = 0; i < 4; ++i) mx[i] = fmaxf(mx[i], __shfl_xor(mx[i], o));
    f32x4 sum = {0.f, 0.f, 0.f, 0.f};
#pragma unroll
    for (int c = 0; c < NC; ++c)
#pragma unroll
        for (int i = 0; i < 4; ++i) { x[c][i] = __expf(x[c][i] - mx[i]); sum[i] += x[c][i]; }
#pragma unroll
    for (int o = 1; o < 16; o <<= 1)
#pragma unroll
        for (int i = 0; i < 4; ++i) sum[i] += __shfl_xor(sum[i], o);
    f32x4 inv;
#pragma unroll
    for (int i = 0; i < 4; ++i) inv[i] = 1.0f / (sum[i] + __expf(sk[i] - mx[i]));
#pragma unroll
    for (int c = 0; c < NC; ++c)
#pragma unroll
        for (int i = 0; i < 4; ++i) Pimg[(4 * g4 + i) * NSLOT + 16 * c + r] = (unsigned short)f2bf(x[c][i] * inv[i]);
    const unsigned wl = (unsigned)__builtin_amdgcn_readfirstlane((int)((unsigned)(uintptr_t)(F.lds + RING_OFF) + (unsigned)F.wave * 16384u + 8192u));
    const int drow = lane >> 3, dpc = lane & 7;
#define SW_VDMA(st) do { unsigned vo_[4]; \
        _Pragma("unroll") for (int i_ = 0; i_ < 4; ++i_) { int key_ = kbase + 32 * (st) + 8 * i_ + drow; key_ = key_ < 0 ? 0 : (key_ > SEQ - 1 ? SEQ - 1 : key_); vo_[i_] = (unsigned)(((rb + key_) * 128 + j * 64 + dpc * 8) * 2); } \
        sp_glds16s_x4(P.VAB, vo_[0], vo_[1], vo_[2], vo_[3], (unsigned)__builtin_amdgcn_readfirstlane((int)(wl + (unsigned)(((st) & 1) * 4096)))); } while (0)
    asm volatile("s_waitcnt vmcnt(0)" ::: "memory");
    SW_VDMA(0); SW_VDMA(1);
    f32x4 o[4];
#pragma unroll
    for (int db = 0; db < 4; ++db) o[db] = (f32x4){0.f, 0.f, 0.f, 0.f};
    const unsigned trb = (unsigned)((8 * g4 + ((lane & 15) >> 2)) * 128 + (lane & 3) * 8);
#pragma unroll
    for (int st = 0; st < NST; ++st) {
        if (st + 1 < NST) asm volatile("s_waitcnt vmcnt(4)" ::: "memory"); else asm volatile("s_waitcnt vmcnt(0)" ::: "memory");
        const unsigned vb = wl + (unsigned)((st & 1) * 4096) + trb;
        s16x4 lo[4], hi[4];
#pragma unroll
        for (int db = 0; db < 4; ++db) {
            asm volatile("ds_read_b64_tr_b16 %0, %1 offset:%c2" : "=&v"(lo[db]) : "v"(vb), "i"(db * 32) : "memory");
            asm volatile("ds_read_b64_tr_b16 %0, %1 offset:%c2" : "=&v"(hi[db]) : "v"(vb), "i"(db * 32 + 512) : "memory"); }
        const bf16x8 pb = *(const LAS bf16x8*)(Pimg + r * NSLOT + 32 * st + 8 * g4);
        asm volatile("s_waitcnt lgkmcnt(0)" ::: "memory");
#pragma unroll
        for (int db = 0; db < 4; ++db) { const bf16x8 va = {lo[db][0], lo[db][1], lo[db][2], lo[db][3], hi[db][0], hi[db][1], hi[db][2], hi[db][3]};
            o[db] = __builtin_amdgcn_mfma_f32_16x16x32_bf16(va, pb, o[db], 0, 0, 0); }
        if (st + 2 < NST) SW_VDMA(st + 2);
    }
#undef SW_VDMA
    if (!dry) { bf16* gp = P.G + (size_t)(rb + t0 + 4 * qg + (r >> 2)) * 1536 + (4 * j + (r & 3)) * 64 + 4 * g4;
#pragma unroll
        for (int db = 0; db < 4; ++db) { const u32x2 gt = *(const u32x2*)(gp + 16 * db);
            const float g0 = __uint_as_float(gt.x << 16), g1 = __uint_as_float(gt.x & 0xffff0000u), g2 = __uint_as_float(gt.y << 16), g3 = __uint_as_float(gt.y & 0xffff0000u);
            u32x2 w; w.x = pk2(o[db][0] * g0, o[db][1] * g1); w.y = pk2(o[db][2] * g2, o[db][3] * g3);
            *(u32x2*)(gp + 16 * db) = w; } }
}
__device__ __forceinline__ void ba_clear(Frame& F) {
    LAS v4u* hz = (LAS v4u*)(F.lds + RING_OFF + F.wave * 16384);
#pragma unroll
    for (int i = 0; i < 16; ++i) hz[F.lane + 64 * i] = (v4u){0u, 0u, 0u, 0u};
    if (F.tid < 32) ((LAS unsigned*)(F.lds + MISC_OFF))[F.tid] = 0u;
    for (int i = F.tid; i < 16 * 64; i += 512) ((LAS unsigned*)(F.lds + H2_OFF))[i] = 0u;
}
__device__ __forceinline__ void ba_unit(Frame& F, const BAParams& P, int b, int tau, bool dry) {
    { int l_ = (int)__builtin_amdgcn_mbcnt_hi(~0u, __builtin_amdgcn_mbcnt_lo(~0u, 0u)); asm volatile("" : "+v"(l_)); F.lane = l_; F.tid = F.wave * 64 + l_; }
    const int t0 = tau * 16, rb = b * SEQ, lane = F.lane;
    LAS unsigned* misc = (LAS unsigned*)(F.lds + MISC_OFF);
    for (int ri = 0; ri < REP_IDX; ++ri)
    if (tau >= 16) {
        if (ri) { __syncthreads(); ba_clear(F); __syncthreads(); }
        bf16x8 bq[4]; const int r = lane & 15, g4 = lane >> 4;
#pragma unroll
        for (int h = 0; h < 4; ++h) bq[h] = *(const bf16x8*)(P.IQ + (size_t)(rb + t0 + r) * 128 + h * 32 + 8 * g4);
        const f32x4 w4 = *(const f32x4*)(P.IW + (size_t)(rb + t0 + r) * 4);
        const bf16* IKb = P.IK + (size_t)rb * 32;
        idx_pass<1>(F, IKb, bq, w4, tau, t0);
        __syncthreads();
        idx_threshold(F);
        __syncthreads();
        idx_pass<2>(F, IKb, bq, w4, tau, t0);
        __syncthreads();
        idx_resolve(F);
    } else {
        LAS unsigned short* sel = (LAS unsigned short*)(F.lds + SEL_OFF);
        for (int i = F.tid; i < 16 * 256; i += 512) sel[i] = (unsigned short)(i & 255);
    }
    __syncthreads();
    const int tA = t0 + 2 * F.wave, nv0 = tA >= 256 ? 256 : tA + 1, nv1 = tA + 1 >= 256 ? 256 : tA + 2;
    for (int rs = 0; rs < REP_SPB; ++rs) sparse_pair<false>(F, P, rb, tA, 2 * F.wave, nv0, nv1, dry || rs + 1 < REP_SPB);
    for (int rs = 0; rs < REP_SPA; ++rs) swa_dense(F, P, rb, t0, dry || rs + 1 < REP_SPA);
    ba_clear(F);
}

#ifndef REP_P1A
#define REP_P1A 1
#endif
#ifndef REP_C
#define REP_C 1
#endif
#ifndef REP_BA
#define REP_BA 1
#endif
#ifndef REP_P1B
#define REP_P1B 1
#endif
#ifndef REP_P3
#define REP_P3 1
#endif
#ifndef REP_P0
#define REP_P0 1
#endif
#ifndef FOX_SKIP_LOG2
#define FOX_SKIP_LOG2 (-80.0f)
#endif
#ifndef MK_ONE_LAUNCH
#define MK_ONE_LAUNCH 1
#endif
constexpr int NPHASES = 1 + 6 * DEPTH;
struct Args { const float* in[9]; float* out; unsigned char* ws; int ph_lo, ph_hi; };
static_assert(sizeof(Args) == 9 * 8 + 8 + 8 + 4 + 4, "no padding bytes in the argument struct");

typedef const __attribute__((address_space(4))) Args* ArgP;
__device__ __forceinline__ ArgP argp() { ArgP p = (ArgP)__builtin_amdgcn_kernarg_segment_ptr(); asm volatile("" : "+s"(p)); return p; }
__global__ void __launch_bounds__(512, 2) mk_fwd(Args args) {
    extern __shared__ __attribute__((aligned(16))) unsigned char lds[];
    Frame F;
    F.lds = (LAS unsigned char*)lds;
    F.MISC = (volatile LAS unsigned*)(F.lds + MISC_OFF);
    F.tid = threadIdx.x; F.lane = F.tid & 63; F.wave = __builtin_amdgcn_readfirstlane(F.tid >> 6);
    F.G = gridDim.x; { const int bx = blockIdx.x; F.vcu = (F.G % 8 == 0) ? (bx % 8) * (F.G / 8) + bx / 8 : bx; }
    F.ctl = (gu32*)(argp()->ws + WS_CTL);
    for (int u = F.tid; u < 256; u += 512) ((LAS unsigned*)(F.lds + MISC_OFF))[u] = 0u;
    for (int u = F.tid; u < 512; u += 512) { ((LAS float*)(F.lds + BIAS_OFF))[u] = argp()->in[8][u];
        int bk; if (u < 16) bk = u; else { const float nf = (float)u; int lg = 16 + (int)(logf(nf / 16.0f) / 3.4657359027997265f * 16.0f); bk = lg < 31 ? lg : 31; }
        ((LAS unsigned char*)(F.lds + BKT_OFF))[u] = (unsigned char)bk; }
    __syncthreads();
    XcdBarrier bar; bar.bar = (unsigned*)(F.ctl + CW_BAR); bar.x = 0; bar.st = nullptr;
    if (MK_ONE_LAUNCH) bar = xcd_barrier_post((unsigned*)(F.ctl + CW_BAR), F.MISC + MW_BAR);
    const int lo = argp()->ph_lo, hi = argp()->ph_hi;
#define IN(k) (lo <= (k) && (k) < hi)
#define SEAM(k) do { if (IN(k) && IN((k) + 1)) xcd_barrier(bar); } while (0)
#define PHASE_BEGIN() do { int l_ = (int)__builtin_amdgcn_mbcnt_hi(~0u, __builtin_amdgcn_mbcnt_lo(~0u, 0u)); asm volatile("" : "+v"(l_)); F.lane = l_; F.tid = F.wave * 64 + l_; } while (0)

    if (IN(0)) { PHASE_BEGIN(); ArgP a = argp(); for (int rp = 0; rp < REP_P0; ++rp) p0_prologue(F, a->in[0], a->in[1], a->in[2], a->in[6], a->in[7], a->ws); SEAM(0); }

    for (int L = 0; L < DEPTH; ++L) {
        const int pb = 1 + 6 * L;
        if (IN(pb)) { PHASE_BEGIN();
            unsigned char* ws = argp()->ws; const pg8::bf16_t* W1T = (const pg8::bf16_t*)(ws + WS_W1T) + (size_t)L * NTILES * 256 * 1024;
            pg8::Gemm g{(const pg8::bf16_t*)(ws + WS_XB), W1T, M, NT_A * 256, 1024, 1024, 1024, 0}; pg8::StaticOrder S; S.init(M, NT_A * 256, F.G, (int)blockIdx.x);
            pg8::EpiIn E{ws, argp()->in[4] + L * 384, argp()->in[3] + L * 8};
            for (int rp = 0; rp < REP_P1A; ++rp) pg8::gemm_phase<pg8::EpiIn, pg8::StaticOrder, true, true>(F.lds + RING_OFF, g, S, E, F.wave);
            SEAM(pb);
        }
        if (IN(pb + 2)) { PHASE_BEGIN();
            unsigned char* ws = argp()->ws;
            const float* CL = (const float*)(ws + WS_CL); const float* CT = (const float*)(ws + WS_CT);
            LAS float* carry = (LAS float*)(F.lds + H2_OFF)  ; LAS unsigned* nbw = (LAS unsigned*)(F.lds + RING_OFF + NB_OFF);
            for (int rp = 0; rp < REP_C; ++rp) {
            LAS unsigned* miscw = (LAS unsigned*)(F.lds + MISC_OFF);
            for (int kg = 0; kg < 8; ++kg) { const int xg = ((F.vcu >> 5) + kg) & 7;
            gu32* const tick = F.ctl + CW_TICK + 64 * (8 * (2 * L + rp % 2) + xg);
            if (F.tid == 0) miscw[MW_TICKET] = __hip_atomic_fetch_add(tick, 1u, RLX_AGENT);
            __syncthreads();
            for (;;) {
                PHASE_BEGIN();
                const int ui = (int)miscw[MW_TICKET];
                if (ui >= 128) { __syncthreads(); break; }
                const int qb = 31 - (ui >> 2), bh = 4 * xg + (ui & 3);
                    if (F.wave == 0) { const float t0 = CT[bh * 128 + 2 * F.lane], t1 = CT[bh * 128 + 2 * F.lane + 1]; const float inc = wave_incl_scan(t0 + t1, F.lane); carry[2 * F.lane] = inc - (t0 + t1); carry[2 * F.lane + 1] = inc - t1; }
                    __syncthreads();
                    const float cref = carry[4 * qb]; int tskip;
                    { const float* gq = argp()->in[4] + L * 384 + 256; const float g1 = fabsf(gq[F.lane]), g2 = fabsf(gq[64 + F.lane]); float mq = g1, mk = g2;
#pragma unroll
                      for (int o = 1; o < 64; o <<= 1) { mq = fmaxf(mq, __shfl_xor(mq, o)); mk = fmaxf(mk, __shfl_xor(mk, o)); }
                      const float thr = FOX_SKIP_LOG2 - 2.0f * (11.8f * mq * mk + 0.5f);
                      const int NTt = 4 * (qb + 1); const int t_a = F.lane, t_b = 64 + F.lane, k_a = 64 * t_a + 63, k_b = 64 * t_b + 63;
                      const float n_a = t_a < NTt ? (cref - (carry[k_a >> 6] + CL[(size_t)bh * SEQ + k_a])) * 1.4426950408889634f : 0.f, n_b = t_b < NTt ? (cref - (carry[k_b >> 6] + CL[(size_t)bh * SEQ + k_b])) * 1.4426950408889634f : 0.f;
                      const bool s_a = t_a < NTt && n_a < thr, s_b = t_b < NTt && n_b < thr;
                      const unsigned long long f_a = __ballot(!s_a), f_b = __ballot(!s_b);
                      int cnt = f_a ? (int)__builtin_ctzll(f_a) : 64 + (f_b ? (int)__builtin_ctzll(f_b) : 64);
                      cnt &= ~1; tskip = cnt > NTt - 4 ? NTt - 4 : cnt; }
                    { const int nk = 256 * (qb + 1);
                      for (int k = 64 * tskip + F.tid; k < nk; k += 512) { const float xb = (cref - (carry[k >> 6] + CL[(size_t)bh * SEQ + k])) * 1.4426950408889634f;
                          const unsigned h = f2bf(xb), l = f2bf(xb - __uint_as_float(h << 16)); nbw[k] = h | (l << 16); } }
                    __syncthreads();
                    attn_body::attn_unit<8>(bh >> 3, bh & 7, qb, (const attn_body::bf16*)(ws + WS_QC), (const attn_body::bf16*)(ws + WS_KC), (const attn_body::bf16*)(ws + WS_VC), (attn_body::bf16*)(ws + WS_G),
                                            (char*)lds + RING_OFF, (attn_body::lds_cuptr)(F.lds + RING_OFF + NB_OFF), tskip, rp + 1 < REP_C, F.wave);
                if (F.tid == 0) miscw[MW_TICKET] = __hip_atomic_fetch_add(tick, 1u, RLX_AGENT);
                __syncthreads();
            } } }
            __syncthreads(); PHASE_BEGIN();
            const BAParams P{(const bf16*)(ws + WS_IQ), (const bf16*)(ws + WS_IK), (const float*)(ws + WS_IW), (const bf16*)(ws + WS_QA), (const bf16*)(ws + WS_QB), (const bf16*)(ws + WS_KAB), (const bf16*)(ws + WS_VAB),
                             (bf16*)(ws + WS_G), argp()->in[5] + L * 8};
            for (int rp = 0; rp < REP_BA; ++rp) {
            LAS unsigned* miscw = (LAS unsigned*)(F.lds + MISC_OFF);
            for (int kg = 0; kg < 4; ++kg) { const int bq = ((F.vcu >> 6) + kg) & 3;
            gu32* const tick = F.ctl + CW_TICK + 64 * (32 + 4 * (2 * L + rp % 2) + bq);
            ba_clear(F);
            if (F.tid == 0) miscw[MW_TICKET] = __hip_atomic_fetch_add(tick, 1u, RLX_AGENT);
            __syncthreads();
            for (;;) {
                PHASE_BEGIN();
                const int ui = (int)miscw[MW_TICKET];
                if (ui >= 512) { __syncthreads(); break; }
                ba_unit(F, P, bq, 511 - ui, rp + 1 < REP_BA);
                if (F.tid == 0) miscw[MW_TICKET] = __hip_atomic_fetch_add(tick, 1u, RLX_AGENT);
                __syncthreads();
            } } }
            SEAM(pb + 2);
        }
        if (IN(pb + 3)) { PHASE_BEGIN();
            unsigned char* ws = argp()->ws; const pg8::bf16_t* W1T = (const pg8::bf16_t*)(ws + WS_W1T) + (size_t)L * NTILES * 256 * 1024;
            pg8::Gemm g{(const pg8::bf16_t*)(ws + WS_XB), W1T + (size_t)NT_A * 256 * 1024, M, NT_B * 256, 1024, 1024, 1024, 0}; pg8::StaticOrder S; S.init(M, NT_B * 256, F.G, (int)blockIdx.x);
            pg8::EpiGate E{(const float*)(ws + WS_SSQ), (unsigned char*)(ws + WS_MG)};
            for (int rp = 0; rp < REP_P1B; ++rp) pg8::gemm_phase<pg8::EpiGate, pg8::StaticOrder, true, true>(F.lds + RING_OFF, g, S, E, F.wave);
            SEAM(pb + 3);
        }
        if (IN(pb + 4)) { PHASE_BEGIN();
            unsigned char* ws = argp()->ws;
            pg8::Gemm g{(const pg8::bf16_t*)(ws + WS_G), (const pg8::bf16_t*)(ws + WS_WBT) + (size_t)L * 3 * 1024 * 512, M, 1024, 512, 1536, 512, 4};
            pg8::SegOrder S; S.base.init(M, 1024, F.G, (int)blockIdx.x);
            pg8::EpiMerge E{(const unsigned char*)(ws + WS_MG), (pg8::bf16_t*)(ws + WS_MERGED)};
            for (int rp = 0; rp < REP_P3; ++rp) pg8::gemm_phase<pg8::EpiMerge, pg8::SegOrder, true, true>(F.lds + RING_OFF, g, S, E, F.wave);
            SEAM(pb + 4);
        }
        if (IN(pb + 5)) { PHASE_BEGIN();
            unsigned char* ws = argp()->ws; float* const outp = argp()->out;
            pg8::Gemm g{(const pg8::bf16_t*)(ws + WS_MERGED), (const pg8::bf16_t*)(ws + WS_WOT) + (size_t)L * 1024 * 1024, M, 1024, 1024, 1024, 1024, 0}; pg8::StaticOrder S; S.init(M, 1024, F.G, (int)blockIdx.x);
            const bool last = (L == DEPTH - 1);
            unsigned poison = 0u;
            if (last) poison = (__hip_atomic_load(F.ctl + CW_OVF, RLX_AGENT) != 0u) | (__hip_atomic_load(F.ctl + CW_BAR + XB_TMO, RLX_AGENT) != 0u);
            pg8::EpiOut E{L == 0 ? argp()->in[0] : (const float*)outp, outp, last ? nullptr : (pg8::bf16_t*)(ws + WS_XB), last ? nullptr : (float*)(ws + WS_SSQ), poison};
            pg8::gemm_phase<pg8::EpiOut, pg8::StaticOrder, true, true>(F.lds + RING_OFF, g, S, E, F.wave);
            if (!last) SEAM(pb + 5);
        }
    }
#undef IN
#undef SEAM
}

extern "C" void kernel_launch(void* const* d_in, const int* in_sizes, int n_in, void* d_out, int out_size, void* d_ws, size_t ws_size, hipStream_t stream) {
    static int grid = 0;
    if (grid == 0) {
        if (n_in != 9 || in_sizes[0] != M * DMODEL || out_size != M * DMODEL || ws_size < WS_END) { fprintf(stderr, "kernel_launch: unexpected shapes / workspace (n_in %d, in0 %d, out %d, ws %zu < %zu); nothing launched\n", n_in, n_in > 0 ? in_sizes[0] : -1, out_size, ws_size, (size_t)WS_END); grid = -1; return; }
        int dev = 0, cus = 0, per_cu = 0;
        if (hipGetDevice(&dev) != hipSuccess || hipDeviceGetAttribute(&cus, hipDeviceAttributeMultiprocessorCount, dev) != hipSuccess) { grid = -1; return; }
        if (hipFuncSetAttribute((const void*)mk_fwd, hipFuncAttributeMaxDynamicSharedMemorySize, LDS_BYTES) != hipSuccess) { fprintf(stderr, "kernel_launch: hipFuncSetAttribute failed\n"); grid = -1; return; }
        if (hipOccupancyMaxActiveBlocksPerMultiprocessor(&per_cu, (const void*)mk_fwd, 512, LDS_BYTES) != hipSuccess || per_cu < 1) fprintf(stderr, "kernel_launch: occupancy query reports %d workgroups per CU\n", per_cu);
        (void)hipGetLastError();
        grid = cus;
    }
    if (grid < 0) return;
    if (hipMemsetAsync((char*)d_ws + WS_CTL, 0, CTL_ZERO_BYTES, stream) != hipSuccess) return;
    Args a{};
    for (int i = 0; i < 9; ++i) a.in[i] = (const float*)d_in[i];
    a.out = (float*)d_out; a.ws = (unsigned char*)d_ws;
#if MK_ONE_LAUNCH
    a.ph_lo = 0; a.ph_hi = NPHASES;
    hipLaunchKernelGGL(mk_fwd, dim3(grid), dim3(512), LDS_BYTES, stream, a);
#else
    for (int p = 0; p < NPHASES; ++p) { a.ph_lo = p; a.ph_hi = p + 1; hipLaunchKernelGGL(mk_fwd, dim3(grid), dim3(512), LDS_BYTES, stream, a); }
#endif
}
```

```cpp
#include <hip/hip_runtime.h>
#include <cstdio>
#include <cstdint>
#include <cmath>
namespace pg8 {
#define PG8_LAS __attribute__((address_space(3)))
typedef unsigned short bf16_t;
typedef short bf16x8 __attribute__((ext_vector_type(8)));
typedef float f32x4 __attribute__((ext_vector_type(4)));
typedef unsigned u32x4 __attribute__((ext_vector_type(4)));
constexpr int BM = 256, BK = 64, HALF = 128, HTB = HALF * BK * 2  , STAGE_BYTES = 8 * HTB, NXCD = 8, WGM = 8;

__host__ __device__ __forceinline__ int lds_byte(int r, int c) { const int st = (r >> 4) * 2 + (c >> 5), rr = r & 15, cc = c & 31, ob = rr * 64 + cc * 2; return st * 1024 + (ob ^ (((ob >> 9) & 1) << 5)); }
__host__ __device__ __forceinline__ void stage_rc(int b, int& R, int& C) { const int st = b / 1024, sb = b % 1024, swz = sb ^ (((sb >> 9) & 1) << 5); R = (st >> 1) * 16 + swz / 64; C = (st & 1) * 32 + (swz % 64) / 2; }
__host__ __device__ __forceinline__ int perm32(int rho) { const int n = rho >> 4, i = rho & 15; return 8 * (i >> 2) + 4 * n + (i & 3); }

struct Unit { int pm, pn, seg; };
struct Gemm { const bf16_t* A; const bf16_t* Bt; int M, N, K, lda, ldb, segN; };

struct StaticOrder {
    int nM, nN, nwg, G, c;
    __host__ __device__ void init(int M, int N, int G_, int c_) { nM = M / BM; nN = N / BM; nwg = nM * nN; G = G_; c = c_; }
    __host__ __device__ bool next(int i, Unit& u) const {
        const long L = (long)i * G + c; if (L >= nwg) return false;
        int wgid = (int)L; { const int q = nwg / NXCD, r = nwg % NXCD, xcd = wgid % NXCD, off = wgid / NXCD; wgid = (xcd < r ? xcd * (q + 1) : r * (q + 1) + (xcd - r) * q) + off; }
        const int nig = WGM * nN, gid = wgid / nig, fm = gid * WGM, gsz = (nM - fm) < WGM ? (nM - fm) : WGM;
        u.pm = fm + ((wgid % nig) % gsz); u.pn = (wgid % nig) / gsz; u.seg = 0; return true;
    }
    __device__ __forceinline__ void a_ready(const Unit&) const {}
    __device__ __forceinline__ void done(const Unit&) const {}
};

__device__ __forceinline__ unsigned cvt_pk_bf16(float lo, float hi) { unsigned r; asm volatile("v_cvt_pk_bf16_f32 %0, %1, %2" : "=v"(r) : "v"(lo), "v"(hi)); return r; }
constexpr size_t EWS_MiB = 1u << 20, EWS_SSQ = 43 * EWS_MiB, EWS_CL = 45 * EWS_MiB, EWS_CT = 46 * EWS_MiB, EWS_IW = 47 * EWS_MiB, EWS_CF = 47 * EWS_MiB + 512 * 1024, EWS_IQ = 49 * EWS_MiB, EWS_IK = 57 * EWS_MiB, EWS_G = 188 * EWS_MiB,
    EWS_QA = 284 * EWS_MiB, EWS_QB = 316 * EWS_MiB, EWS_QC = 348 * EWS_MiB, EWS_KC = 380 * EWS_MiB, EWS_VC = 412 * EWS_MiB, EWS_KAB = 444 * EWS_MiB, EWS_VAB = 460 * EWS_MiB;

constexpr float C2Q = 0.125f * 1.4426950408889634f;
__device__ __forceinline__ float fast_sigmoid(float x) { return __builtin_amdgcn_rcpf(1.0f + __expf(-x)); }
__device__ __forceinline__ u32x4 pack8(const f32x4 a, const f32x4 b) { u32x4 w; w.x = cvt_pk_bf16(a[0], a[1]); w.y = cvt_pk_bf16(a[2], a[3]); w.z = cvt_pk_bf16(b[0], b[1]); w.w = cvt_pk_bf16(b[2], b[3]); return w; }
__device__ __forceinline__ void unpack8(const u32x4 w, f32x4& a, f32x4& b) {
    a[0] = __uint_as_float(w.x << 16); a[1] = __uint_as_float(w.x & 0xffff0000u); a[2] = __uint_as_float(w.y << 16); a[3] = __uint_as_float(w.y & 0xffff0000u);
    b[0] = __uint_as_float(w.z << 16); b[1] = __uint_as_float(w.z & 0xffff0000u); b[2] = __uint_as_float(w.w << 16); b[3] = __uint_as_float(w.w & 0xffff0000u); }
#define EPI_PIN() asm volatile("" ::: "memory")
__device__ __forceinline__ void rows_rstd(const float* ssq, int row0, int fq, float (&rs)[2][4]) {
    f32x4 pr[2][4];
#pragma unroll
    for (int ai = 0; ai < 2; ++ai)
#pragma unroll
        for (int m = 0; m < 4; ++m) pr[ai][m] = *(const f32x4*)(ssq + (size_t)(row0 + ai * HALF + m * 16) * 16 + 4 * fq);
    EPI_PIN();
#pragma unroll
    for (int ai = 0; ai < 2; ++ai)
#pragma unroll
        for (int m = 0; m < 4; ++m) { const f32x4 a = pr[ai][m]; float t = (a[0] + a[1]) + (a[2] + a[3]); t += __shfl_xor(t, 16); t += __shfl_xor(t, 32); rs[ai][m] = __builtin_amdgcn_rsqf(t * (1.0f / 1024.0f) + 1e-6f); }
}
struct EpiIn {
    static constexpr bool PERM = true, AFTER_DRAIN = false;
    unsigned char* ws; const float* qkg; const float* bfg;
    __device__ __forceinline__ bool keep(const Unit&) const { return false; }
    __device__ __forceinline__ void operator()(f32x4 (&acc)[2][2][4][2], const Unit& u, int wr, int wc, int fr, int fq) const {
        const int row0 = u.pm * BM + wr * 64 + fr, t = u.pn, lc0 = wc * 64 + fq * 8;
        float rs[2][4]; rows_rstd((const float*)(ws + EWS_SSQ), row0, fq, rs);
        if (t == 18) {
            bf16_t* IQ = (bf16_t*)(ws + EWS_IQ); bf16_t* IK = (bf16_t*)(ws + EWS_IK); float* IW = (float*)(ws + EWS_IW);
#pragma unroll
            for (int ai = 0; ai < 2; ++ai)
#pragma unroll
                for (int m = 0; m < 4; ++m) { const int row = row0 + ai * HALF + m * 16; const float f = rs[ai][m];
#pragma unroll
                    for (int bj = 0; bj < 2; ++bj) { const int lc = lc0 + 32 * bj; const f32x4 v0 = acc[ai][bj][m][0] * f, v1 = acc[ai][bj][m][1] * f;
                        if (lc < 128) *(u32x4*)(IQ + (size_t)row * 128 + lc) = pack8(v0, v1);
                        else if (lc < 160) *(u32x4*)(IK + (size_t)row * 32 + (lc - 128)) = pack8(v0, v1);
                        else if (lc == 160) *(f32x4*)(IW + (size_t)row * 4) = v0 * 0.08838834764831845f; } }
            int ln_ = (int)__builtin_amdgcn_mbcnt_hi(~0u, __builtin_amdgcn_mbcnt_lo(~0u, 0u)); asm volatile("" : "+v"(ln_));
            if (wc == 2 && (ln_ >> 4) < 2) { const int fql = ln_ >> 4, frl = ln_ & 15;
                float* CL = (float*)(ws + EWS_CL); float* CT = (float*)(ws + EWS_CT); const int hb = 4 * fql; const f32x4 bfv = *(const f32x4*)(bfg + hb);
#pragma unroll
                for (int ai = 0; ai < 2; ++ai) { f32x4 run = {0.f, 0.f, 0.f, 0.f};
#pragma unroll
                    for (int m = 0; m < 4; ++m) { const int row = row0 + ai * HALF + m * 16; const f32x4 z = (fql == 0 ? acc[ai][1][m][1] : acc[ai][1][m][0]) * rs[ai][m] + bfv; f32x4 lf;
#pragma unroll
                        for (int e = 0; e < 4; ++e) lf[e] = (z[e] < 0.f ? z[e] : 0.f) - __logf(1.0f + __expf(-fabsf(z[e])));
#pragma unroll
                        for (int o = 1; o < 16; o <<= 1)
#pragma unroll
                            for (int e = 0; e < 4; ++e) { const float tt = __shfl_up(lf[e], o, 16); if (frl >= o) lf[e] += tt; }
                        const f32x4 cs = lf + run;
                        const int bb = row >> 13, ss = row & 8191;
#pragma unroll
                        for (int e = 0; e < 4; ++e) CL[(size_t)(bb * 8 + hb + e) * 8192 + ss] = cs[e];
#pragma unroll
                        for (int e = 0; e < 4; ++e) run[e] += __shfl(lf[e], 15, 16); }
                    if (frl == 15) { const int row = row0 + ai * HALF, bb = row >> 13, ch = (row & 8191) >> 6;
#pragma unroll
                        for (int e = 0; e < 4; ++e) CT[(bb * 8 + hb + e) * 128 + ch] = run[e]; } } }
            return;
        }
        bf16_t* dst; int ldc, colbase; const float* gp = qkg; float csc = 1.f; bool norm = false, act = false;
        if (t < 6) { const int mx = t >> 1; dst = (bf16_t*)(ws + (mx == 0 ? EWS_QA : (mx == 1 ? EWS_QB : EWS_QC))); ldc = 512; colbase = (t & 1) * 256; norm = true; gp = qkg + (mx * 2 + 0) * 64; csc = (mx == 2) ? C2Q : 1.f; }
        else if (t == 6) { dst = (bf16_t*)(ws + EWS_KAB); ldc = 128; colbase = (wc >> 1) * (32768 * 128 - 128); norm = true;     gp = qkg + ((wc >> 1) * 2 + 1) * 64; }
        else if (t < 9) { dst = (bf16_t*)(ws + EWS_KC); ldc = 512; colbase = (t - 7) * 256; norm = true; gp = qkg + (2 * 2 + 1) * 64; }
        else if (t == 9) { dst = (bf16_t*)(ws + EWS_VAB); ldc = 128; colbase = (wc >> 1) * (32768 * 128 - 128); }
        else if (t < 12) { dst = (bf16_t*)(ws + EWS_VC); ldc = 512; colbase = (t - 10) * 256; }
        else { dst = (bf16_t*)(ws + EWS_G); ldc = 1536; colbase = (t - 12) * 256; act = true; }
        f32x4 gv[2][2];
#pragma unroll
        for (int bj = 0; bj < 2; ++bj)
#pragma unroll
            for (int n = 0; n < 2; ++n) gv[bj][n] = norm ? *(const f32x4*)(gp + 8 * fq + 32 * bj + 4 * n) * csc : (f32x4){1.f, 1.f, 1.f, 1.f};
        EPI_PIN();
#pragma unroll
        for (int ai = 0; ai < 2; ++ai)
#pragma unroll
            for (int m = 0; m < 4; ++m) { const int row = row0 + ai * HALF + m * 16; float f = rs[ai][m];
                if (norm) { float ss = 0.f;
#pragma unroll
                    for (int bj = 0; bj < 2; ++bj)
#pragma unroll
                        for (int n = 0; n < 2; ++n) { const f32x4 x = acc[ai][bj][m][n]; ss += (x[0] * x[0] + x[1] * x[1]) + (x[2] * x[2] + x[3] * x[3]); }
                    ss += __shfl_xor(ss, 16); ss += __shfl_xor(ss, 32);
                    f = f * __builtin_amdgcn_rsqf(f * f * ss * (1.0f / 64.0f) + 1e-6f); }
                bf16_t* rowp = dst + (size_t)row * ldc + colbase + lc0;
#pragma unroll
                for (int bj = 0; bj < 2; ++bj) { f32x4 v0 = acc[ai][bj][m][0] * f * gv[bj][0], v1 = acc[ai][bj][m][1] * f * gv[bj][1];
                    if (act) {
#pragma unroll
                        for (int e = 0; e < 4; ++e) { v0[e] = v0[e] * fast_sigmoid(v0[e]); v1[e] = v1[e] * fast_sigmoid(v1[e]); } }
                    *(u32x4*)(rowp + 32 * bj) = pack8(v0, v1); } }
    }
};
typedef unsigned u32x2e __attribute__((ext_vector_type(2)));
__device__ __forceinline__ unsigned gate_q4(const f32x4 v) { unsigned w = 0u;
    w = __builtin_amdgcn_cvt_pk_u8_f32(fmaxf(255.0f * fast_sigmoid(v[0]), 1.0f), 0, w); w = __builtin_amdgcn_cvt_pk_u8_f32(fmaxf(255.0f * fast_sigmoid(v[1]), 1.0f), 1, w);
    w = __builtin_amdgcn_cvt_pk_u8_f32(fmaxf(255.0f * fast_sigmoid(v[2]), 1.0f), 2, w); w = __builtin_amdgcn_cvt_pk_u8_f32(fmaxf(255.0f * fast_sigmoid(v[3]), 1.0f), 3, w); return w; }
__device__ __forceinline__ f32x4 gate_f4(const unsigned w) { return (f32x4){(float)(w & 0xffu), (float)((w >> 8) & 0xffu), (float)((w >> 16) & 0xffu), (float)(w >> 24)}; }
struct EpiGate {
    static constexpr bool PERM = true, AFTER_DRAIN = false;
    const float* ssq; unsigned char* MG;
    __device__ __forceinline__ bool keep(const Unit&) const { return false; }
    __device__ __forceinline__ void operator()(f32x4 (&acc)[2][2][4][2], const Unit& u, int wr, int wc, int fr, int fq) const {
        const int row0 = u.pm * BM + wr * 64 + fr, lc0 = wc * 64 + fq * 8;
        float rs[2][4]; rows_rstd(ssq, row0, fq, rs);
#pragma unroll
        for (int ai = 0; ai < 2; ++ai)
#pragma unroll
            for (int m = 0; m < 4; ++m) { const int row = row0 + ai * HALF + m * 16; const float f = rs[ai][m];
                unsigned char* rowp = MG + (size_t)row * 3072 + u.pn * BM + lc0;
#pragma unroll
                for (int bj = 0; bj < 2; ++bj) { u32x2e w; w.x = gate_q4(acc[ai][bj][m][0] * f); w.y = gate_q4(acc[ai][bj][m][1] * f); *(u32x2e*)(rowp + 32 * bj) = w; } }
    }
};
struct EpiMerge {
    static constexpr bool PERM = true, AFTER_DRAIN = false;
    const unsigned char* MG; bf16_t* OUT;
    __device__ __forceinline__ bool keep(const Unit& u) const { return u.seg < 2; }
    __device__ __forceinline__ void operator()(f32x4 (&acc)[2][2][4][2], const Unit& u, int wr, int wc, int fr, int fq) const {
        const int row0 = u.pm * BM + wr * 64 + fr, col0 = u.pn * BM + wc * 32 + 8 * fq, seg = u.seg;
#pragma unroll
        for (int ai = 0; ai < 2; ++ai) {
            u32x2e ga[4][2], gb[4][2];
#pragma unroll
            for (int m = 0; m < 4; ++m) { const unsigned char* gp = MG + (size_t)(row0 + ai * HALF + m * 16) * 3072 + seg * 1024 + col0;
#pragma unroll
                for (int bj = 0; bj < 2; ++bj) { ga[m][bj] = *(const u32x2e*)(gp + bj * HALF); gb[m][bj] = seg < 2 ? *(const u32x2e*)(gp + 1024 + bj * HALF) : ga[m][bj]; } }
            EPI_PIN();
#pragma unroll
            for (int m = 0; m < 4; ++m) { const int row = row0 + ai * HALF + m * 16;
#pragma unroll
                for (int bj = 0; bj < 2; ++bj) { f32x4 a0 = gate_f4(ga[m][bj].x), a1 = gate_f4(ga[m][bj].y);
                    if (seg < 2) { const f32x4 b0 = gate_f4(gb[m][bj].x), b1 = gate_f4(gb[m][bj].y);
#pragma unroll
                        for (int e = 0; e < 4; ++e) { a0[e] = a0[e] * __builtin_amdgcn_rcpf(b0[e]); a1[e] = a1[e] * __builtin_amdgcn_rcpf(b1[e]); } }
                    else { a0 = a0 * (1.0f / 255.0f); a1 = a1 * (1.0f / 255.0f); }
                    acc[ai][bj][m][0] = acc[ai][bj][m][0] * a0; acc[ai][bj][m][1] = acc[ai][bj][m][1] * a1;
                    if (seg == 2) *(u32x4*)(OUT + (size_t)row * 1024 + col0 + bj * HALF) = pack8(acc[ai][bj][m][0], acc[ai][bj][m][1]); } }
        }
    }
};
struct EpiOut {
    static constexpr bool PERM = true, AFTER_DRAIN = false;
    const float* resid; float* out; bf16_t* XB; float* ssq; unsigned poison;
    __device__ __forceinline__ bool keep(const Unit&) const { return false; }
    __device__ __forceinline__ void operator()(f32x4 (&acc)[2][2][4][2], const Unit& u, int wr, int wc, int fr, int fq) const {
        const int row0 = u.pm * BM + wr * 64 + fr, col0 = u.pn * BM + wc * 32 + 8 * fq;
#pragma unroll
        for (int ai = 0; ai < 2; ++ai) {
            f32x4 rv[4][2][2];
#pragma unroll
            for (int m = 0; m < 4; ++m)
#pragma unroll
                for (int bj = 0; bj < 2; ++bj) { const size_t o = (size_t)(row0 + ai * HALF + m * 16) * 1024 + col0 + bj * HALF; rv[m][bj][0] = *(const f32x4*)(resid + o); rv[m][bj][1] = *(const f32x4*)(resid + o + 4); }
            EPI_PIN();
#pragma unroll
            for (int m = 0; m < 4; ++m) { const int row = row0 + ai * HALF + m * 16; float ss = 0.f;
#pragma unroll
                for (int bj = 0; bj < 2; ++bj) { const size_t o = (size_t)row * 1024 + col0 + bj * HALF;
                    f32x4 v0 = rv[m][bj][0] + acc[ai][bj][m][0], v1 = rv[m][bj][1] + acc[ai][bj][m][1];
                    if (poison) { const float qn = __builtin_nanf(""); v0 = (f32x4){qn, qn, qn, qn}; v1 = v0; }
                    *(f32x4*)(out + o) = v0; *(f32x4*)(out + o + 4) = v1;
                    if (XB) { *(u32x4*)(XB + o) = pack8(v0, v1); ss += ((v0[0] * v0[0] + v0[1] * v0[1]) + (v0[2] * v0[2] + v0[3] * v0[3])) + ((v1[0] * v1[0] + v1[1] * v1[1]) + (v1[2] * v1[2] + v1[3] * v1[3])); } }
                if (XB) { ss += __shfl_xor(ss, 16); ss += __shfl_xor(ss, 32); if (fq == 0) ssq[(size_t)row * 16 + u.pn * 4 + wc] = ss; } }
            EPI_PIN();
        }
    }
};
struct SegOrder {
    StaticOrder base;
    __device__ __forceinline__ bool next(int i, Unit& u) const { if (!base.next(i / 3, u)) return false; u.seg = i % 3; return true; }
    __device__ __forceinline__ void a_ready(const Unit&) const {}
    __device__ __forceinline__ void done(const Unit&) const {}
};

template <class Epi, class Sched, bool ALIGN_EPI = false, bool SP2 = false>
__device__ __forceinline__ void gemm_phase(PG8_LAS unsigned char* lds, const Gemm g, const Sched& S, const Epi& E, int wave_id) {
    int tid_ = (int)__builtin_amdgcn_mbcnt_hi(~0u, __builtin_amdgcn_mbcnt_lo(~0u, 0u)); asm volatile("" : "+v"(tid_)); tid_ += wave_id * 64;
    const int tid = tid_, wid = __builtin_amdgcn_readfirstlane(tid >> 6), lane = tid & 63, wr = wid >> 2, wc = wid & 3, fr = lane & 15, fq = lane >> 4;
    const int K = g.K, nt = K / BK;
    unsigned voffA[2], voffB[2];
#pragma unroll
    for (int i = 0; i < 2; ++i) { int R, C; stage_rc(tid * 16 + i * 8192, R, C); const int Rb = Epi::PERM ? ((R & ~31) + perm32(R & 31)) : R;
        voffA[i] = (unsigned)(R * g.lda + C) * 2u; voffB[i] = (unsigned)(Rb * g.ldb + C) * 2u; }
    const size_t kstep = (size_t)(BK * 2);
    const size_t hstepA = (size_t)HALF * g.lda * 2, hstepB = (size_t)HALF * g.ldb * 2;
    const size_t tstepA = 2 * hstepA, tstepB = 2 * hstepB, sstepA = (size_t)K * 2;
    const unsigned ldsw = (unsigned)wid * 1024u;
    const int aoff = lds_byte(wr * 64 + fr, fq * 8), boff = lds_byte(wc * 32 + fr, fq * 8);
#define PG8_SA(b, h) (((b) * 2 + (h)) * HTB)
#define PG8_SB(b, h) ((4 + (b) * 2 + (h)) * HTB)
#define PG8_STAGE(bufoff, gbase, voff) do { _Pragma("unroll") for (int _i = 0; _i < 2; ++_i) \
        __builtin_amdgcn_global_load_lds((const unsigned*)((const char*)(gbase) + (voff)[_i]), (PG8_LAS unsigned*)(lds + (bufoff) + ldsw + _i * 8192), 16, 0, 0); } while (0)
#define PG8_LDA(dst, b, h) do { _Pragma("unroll") for (int m = 0; m < 4; ++m) _Pragma("unroll") for (int k = 0; k < 2; ++k) dst[m][k] = *(const PG8_LAS bf16x8*)(lds + PG8_SA(b, h) + aoff + m * 2048 + k * 1024); } while (0)
#define PG8_LDB(dst, b, h) do { _Pragma("unroll") for (int n = 0; n < 2; ++n) _Pragma("unroll") for (int k = 0; k < 2; ++k) dst[n][k] = *(const PG8_LAS bf16x8*)(lds + PG8_SB(b, h) + boff + n * 2048 + k * 1024); } while (0)
#define PG8_MMA(ai, bj, At, Bt) do { __builtin_amdgcn_s_setprio(1); _Pragma("unroll") for (int m = 0; m < 4; ++m) _Pragma("unroll") for (int n = 0; n < 2; ++n) _Pragma("unroll") for (int k = 0; k < 2; ++k) \
        acc[ai][bj][m][n] = __builtin_amdgcn_mfma_f32_16x16x32_bf16(Bt[n][k], At[m][k], acc[ai][bj][m][n], 0, 0, 0); __builtin_amdgcn_s_setprio(0); } while (0)
#define PG8_WAIT_V(n) asm volatile("s_waitcnt vmcnt(" #n ")" ::: "memory")
#define PG8_WAIT_L(n) asm volatile("s_waitcnt lgkmcnt(" #n ")" ::: "memory")
#define PG8_BAR __builtin_amdgcn_s_barrier()
#define PG8_SCHED __builtin_amdgcn_sched_barrier(0)
    Unit cur, nxt; int ui = 0;
    if (!S.next(0, cur)) return;
    f32x4 acc[2][2][4][2];
#pragma unroll
    for (int a = 0; a < 2; ++a)
#pragma unroll
        for (int b = 0; b < 2; ++b)
#pragma unroll
            for (int m = 0; m < 4; ++m)
#pragma unroll
                for (int n = 0; n < 2; ++n) acc[a][b][m][n] = (f32x4){0.f, 0.f, 0.f, 0.f};
    bf16x8 At[4][2], B0[2][2], B1[2][2];
    const char* cA = (const char*)g.A + (size_t)cur.pm * tstepA + (size_t)cur.seg * sstepA; const char* cB = (const char*)g.Bt + (size_t)(cur.seg * g.segN + cur.pn) * tstepB;
    S.a_ready(cur);
    if constexpr (SP2) {
        PG8_STAGE(PG8_SB(0, 0), cB, voffB); PG8_STAGE(PG8_SB(0, 1), cB + hstepB, voffB); PG8_STAGE(PG8_SA(0, 0), cA, voffA); PG8_STAGE(PG8_SA(0, 1), cA + hstepA, voffA);
        if (wr == 1) PG8_BAR;
        PG8_WAIT_V(2); PG8_BAR;
        PG8_STAGE(PG8_SB(1, 0), cB + kstep, voffB); PG8_STAGE(PG8_SA(1, 0), cA + kstep, voffA); PG8_STAGE(PG8_SB(1, 1), cB + hstepB + kstep, voffB);
        PG8_WAIT_V(6); PG8_BAR;
    } else {
        PG8_STAGE(PG8_SB(0, 0), cB, voffB); PG8_STAGE(PG8_SA(0, 0), cA, voffA); PG8_STAGE(PG8_SB(0, 1), cB + hstepB, voffB); PG8_STAGE(PG8_SA(0, 1), cA + hstepA, voffA);
        if (wr == 1) PG8_BAR;
        PG8_WAIT_V(4); PG8_BAR;
        PG8_STAGE(PG8_SB(1, 0), cB + kstep, voffB); PG8_STAGE(PG8_SA(1, 0), cA + kstep, voffA); PG8_STAGE(PG8_SB(1, 1), cB + hstepB + kstep, voffB);
        PG8_WAIT_V(6); PG8_BAR;
    }
    for (;;) {
        const bool has_next = S.next(ui + 1, nxt);
        const char* nA = has_next ? (const char*)g.A + (size_t)nxt.pm * tstepA + (size_t)nxt.seg * sstepA : cA; const char* nB = has_next ? (const char*)g.Bt + (size_t)(nxt.seg * g.segN + nxt.pn) * tstepB : cB;
        for (int t = 0; t < nt; t += 2) {
            const bool last = (t == nt - 2);
            const char* a1 = cA + (size_t)(t + 1) * kstep;
            const char* a2 = last ? nA : cA + (size_t)(t + 2) * kstep; const char* b2 = last ? nB : cB + (size_t)(t + 2) * kstep;
            const char* a3 = a2 + kstep; const char* b3 = b2 + kstep;
            if (last && has_next) S.a_ready(nxt);
            if constexpr (SP2) {
            PG8_LDB(B0, 0, 0); PG8_LDB(B1, 0, 1); PG8_SCHED; PG8_LDA(At, 0, 0); PG8_STAGE(PG8_SA(1, 1), a1 + hstepA, voffA);
            PG8_WAIT_V(8); PG8_WAIT_L(0); PG8_BAR; PG8_MMA(0, 0, At, B0); PG8_MMA(0, 1, At, B1); PG8_BAR; PG8_SCHED;
            PG8_LDA(At, 0, 1); PG8_STAGE(PG8_SB(0, 0), b2, voffB); PG8_STAGE(PG8_SB(0, 1), b2 + hstepB, voffB); PG8_STAGE(PG8_SA(0, 0), a2, voffA);
            PG8_WAIT_V(8); PG8_WAIT_L(0); PG8_BAR; PG8_MMA(1, 0, At, B0); PG8_MMA(1, 1, At, B1); PG8_BAR; PG8_SCHED;
            PG8_LDB(B0, 1, 0); PG8_LDB(B1, 1, 1); PG8_SCHED; PG8_LDA(At, 1, 0); PG8_STAGE(PG8_SA(0, 1), a2 + hstepA, voffA);
            PG8_WAIT_V(8); PG8_WAIT_L(0); PG8_BAR; PG8_MMA(0, 0, At, B0); PG8_MMA(0, 1, At, B1); PG8_BAR; PG8_SCHED;
            PG8_LDA(At, 1, 1); PG8_STAGE(PG8_SB(1, 0), b3, voffB); PG8_STAGE(PG8_SB(1, 1), b3 + hstepB, voffB); PG8_STAGE(PG8_SA(1, 0), a3, voffA);
            PG8_WAIT_V(8); PG8_WAIT_L(0); PG8_BAR; PG8_MMA(1, 0, At, B0); PG8_MMA(1, 1, At, B1); PG8_BAR; PG8_SCHED;
            } else {
            PG8_LDB(B0, 0, 0); PG8_SCHED; PG8_LDA(At, 0, 0); PG8_STAGE(PG8_SA(1, 1), a1 + hstepA, voffA);
            PG8_WAIT_L(8); PG8_BAR; PG8_WAIT_L(0); PG8_MMA(0, 0, At, B0); PG8_BAR; PG8_SCHED;
            PG8_LDB(B1, 0, 1); PG8_STAGE(PG8_SB(0, 0), b2, voffB);
            PG8_BAR; PG8_WAIT_L(0); PG8_MMA(0, 1, At, B1); PG8_BAR;
            PG8_LDA(At, 0, 1); PG8_STAGE(PG8_SA(0, 0), a2, voffA);
            PG8_BAR; PG8_WAIT_L(0); PG8_MMA(1, 0, At, B0); PG8_BAR; PG8_SCHED;
            PG8_STAGE(PG8_SB(0, 1), b2 + hstepB, voffB);
            PG8_WAIT_V(6); PG8_BAR; PG8_MMA(1, 1, At, B1); PG8_BAR;
            PG8_LDB(B0, 1, 0); PG8_SCHED; PG8_LDA(At, 1, 0); PG8_STAGE(PG8_SA(0, 1), a2 + hstepA, voffA);
            PG8_WAIT_L(8); PG8_BAR; PG8_WAIT_L(0); PG8_MMA(0, 0, At, B0); PG8_BAR; PG8_SCHED;
            PG8_LDB(B1, 1, 1); PG8_STAGE(PG8_SB(1, 0), b3, voffB);
            PG8_BAR; PG8_WAIT_L(0); PG8_MMA(0, 1, At, B1); PG8_BAR;
            PG8_LDA(At, 1, 1); PG8_STAGE(PG8_SA(1, 0), a3, voffA);
            PG8_BAR; PG8_WAIT_L(0); PG8_MMA(1, 0, At, B0); PG8_BAR; PG8_SCHED;
            PG8_STAGE(PG8_SB(1, 1), b3 + hstepB, voffB);
            PG8_WAIT_V(6); PG8_BAR; PG8_MMA(1, 1, At, B1); PG8_BAR;
            }
        }
        if constexpr (ALIGN_EPI) { if (wr == 0) PG8_BAR; }
        if constexpr (!Epi::AFTER_DRAIN) { E(acc, cur, wr, wc, fr, fq); S.done(cur); }
        if (!has_next) break;
        if (!E.keep(cur)) {
#pragma unroll
        for (int a = 0; a < 2; ++a)
#pragma unroll
            for (int b = 0; b < 2; ++b)
#pragma unroll
                for (int m = 0; m < 4; ++m)
#pragma unroll
                    for (int n = 0; n < 2; ++n) acc[a][b][m][n] = (f32x4){0.f, 0.f, 0.f, 0.f};
        }
        cur = nxt; cA = nA; cB = nB; ++ui;
        if constexpr (ALIGN_EPI) { if (wr == 1) PG8_BAR; }
    }
    PG8_WAIT_V(0);
    if constexpr (!ALIGN_EPI) { if (wr == 0) PG8_BAR; }
    PG8_BAR;
    if constexpr (Epi::AFTER_DRAIN) { E.fused(acc, cur, wr, wc, fr, fq, lds, wid, lane); S.done(cur); }
#undef PG8_SA
#undef PG8_SB
#undef PG8_STAGE
#undef PG8_LDA
#undef PG8_LDB
#undef PG8_MMA
#undef PG8_WAIT_V
#undef PG8_WAIT_L
#undef PG8_BAR
#undef PG8_SCHED
}
}
#include <hip/hip_bf16.h>
#include <cmath>
namespace attn_body {
using bf16=__hip_bfloat16;
using bf16x8=__attribute__((ext_vector_type(8)))short;
using s16x4=__attribute__((ext_vector_type(4)))short;
using f32x16=__attribute__((ext_vector_type(16)))float;
using u32x4=__attribute__((ext_vector_type(4)))unsigned;
constexpr int BATCH=4,NHEAD=8,SEQ=8192,D=64,DM=NHEAD*D;
constexpr int NW=8,QBLK=32,QB=QBLK*NW,KVBLK=64,NQB=SEQ/QB;
constexpr int ATTN_PITCH=DM, ATTN_UNIT_ROWS=QB, OPITCH=1536, OCOL0=1024;
__device__ __forceinline__ int crow(int r,int hi){return (r&3)+8*(r>>2)+4*hi;}
#define SBAR() __builtin_amdgcn_sched_barrier(0)
__device__ __forceinline__ void cmask(f32x16&p0,f32x16&p1,int jb,int qrel,int hi){
  const float NEG=-INFINITY; int kb=64*jb+4*hi;
  #pragma unroll
  for(int r=0;r<16;++r){int kv=kb+(r&3)+8*(r>>2); if(kv>qrel)p0[r]=NEG; if(kv+32>qrel)p1[r]=NEG;}
}

constexpr int NSLOT=3, SLOTB=8192;
constexpr int LDS_K=0, LDS_V=NSLOT*SLOTB, LDS_WS=2*NSLOT*SLOTB, LDS_OST=LDS_WS+NW*64*4, LDS_BYTES=LDS_OST+NW*4096;
constexpr float C2=0.125f*1.4426950408889634f;
__device__ __forceinline__ void glds16(const void*gsrc,unsigned lds_dst){unsigned keep;
  asm volatile("s_mov_b32 %0, m0\n\ts_mov_b32 m0, %2\n\ts_nop 0\n\tglobal_load_lds_dwordx4 %1, off\n\ts_mov_b32 m0, %0":"=&s"(keep):"v"(gsrc),"s"(lds_dst):"memory");}
__device__ __forceinline__ float max3f(float a,float b,float c){float r;asm("v_max3_f32 %0, %1, %2, %3":"=v"(r):"v"(a),"v"(b),"v"(c));return r;}
__device__ __forceinline__ float max2f(float a,float b){float r;asm("v_max_f32_e32 %0, %1, %2":"=v"(r):"v"(a),"v"(b));return r;}
__device__ __forceinline__ float fadd_s(float a,float b){float r;asm("v_add_f32_e32 %0, %1, %2":"=v"(r):"v"(a),"v"(b));return r;}
__device__ __forceinline__ float fsub_s(float a,float b){float r;asm("v_sub_f32_e32 %0, %1, %2":"=v"(r):"v"(a),"v"(b));return r;}
typedef float f32x2_t __attribute__((ext_vector_type(2))); typedef __bf16 bf16x2_t __attribute__((ext_vector_type(2)));
__device__ __forceinline__ unsigned cvtpk_s(float lo,float hi){f32x2_t v={lo,hi};bf16x2_t b=__builtin_convertvector(v,bf16x2_t);return __builtin_bit_cast(unsigned,b);}
#define WAIT_BAR(N) asm volatile("s_waitcnt vmcnt(" #N ") lgkmcnt(0)\n\ts_barrier":::"memory")

__device__ __forceinline__ void qkt(f32x16&p0,f32x16&p1,const char*Kslot,const bf16x8*qr,int r32,int hi){
  const char*kb=Kslot+hi*1024+r32*16;
  #pragma unroll
  for(int d0=0;d0<4;++d0){
    const bf16x8 b0=*reinterpret_cast<const bf16x8*>(kb+d0*2048);
    const bf16x8 b1=*reinterpret_cast<const bf16x8*>(kb+d0*2048+512);
    p0=__builtin_amdgcn_mfma_f32_32x32x16_bf16(b0,qr[d0],p0,0,0,0);p1=__builtin_amdgcn_mfma_f32_32x32x16_bf16(b1,qr[d0],p1,0,0,0);}
}
typedef __attribute__((address_space(3))) const unsigned* lds_cuptr;
typedef float f32x4_t __attribute__((ext_vector_type(4)));
__device__ __forceinline__ unsigned bfr(float f){ unsigned u=__builtin_bit_cast(unsigned,f); return (u+0x7fffu+((u>>16)&1u))>>16; }
__device__ __forceinline__ void biasmm(f32x16&c0,f32x16&c1,unsigned w0,unsigned w1  ,unsigned qm1,int hi){
  const unsigned one=hi?0u:0x3f803f80u; w0=hi?0u:w0; w1=hi?0u:w1;
  const u32x4 k0={w0,one,0u,0u},k1={w1,one,0u,0u},qv={one,qm1,0u,0u};
  const f32x16 z=f32x16{};
  c0=__builtin_amdgcn_mfma_f32_32x32x16_bf16(__builtin_bit_cast(bf16x8,k0),__builtin_bit_cast(bf16x8,qv),z,0,0,0);
  c1=__builtin_amdgcn_mfma_f32_32x32x16_bf16(__builtin_bit_cast(bf16x8,k1),__builtin_bit_cast(bf16x8,qv),z,0,0,0);
}
typedef __attribute__((address_space(3))) const char* lds_cptr;
typedef short v4i16_t __attribute__((ext_vector_type(4)));
__device__ __forceinline__ void kload8(bf16x8*kf,lds_cptr kp){
  kf[0]=*(const __attribute__((address_space(3))) bf16x8*)(kp);      kf[1]=*(const __attribute__((address_space(3))) bf16x8*)(kp+512);
  kf[2]=*(const __attribute__((address_space(3))) bf16x8*)(kp+2048); kf[3]=*(const __attribute__((address_space(3))) bf16x8*)(kp+2560);
  kf[4]=*(const __attribute__((address_space(3))) bf16x8*)(kp+4096); kf[5]=*(const __attribute__((address_space(3))) bf16x8*)(kp+4608);
  kf[6]=*(const __attribute__((address_space(3))) bf16x8*)(kp+6144); kf[7]=*(const __attribute__((address_space(3))) bf16x8*)(kp+6656);
}
__device__ __forceinline__ void kload2(bf16x8*kf,lds_cptr kp,int j){ kf[2*j]=*(const __attribute__((address_space(3))) bf16x8*)(kp+j*2048); kf[2*j+1]=*(const __attribute__((address_space(3))) bf16x8*)(kp+j*2048+512); }
__device__ __forceinline__ s16x4 vtr(lds_cptr p){ return __builtin_bit_cast(s16x4,__builtin_amdgcn_ds_read_tr16_b64_v4i16((__attribute__((address_space(3))) v4i16_t*)p)); }
__device__ __forceinline__ float rowmax(const f32x16&p0,const f32x16&p1){
  float a=max3f(p0[0],p0[1],p1[0]),b=max3f(p0[2],p0[3],p1[1]);a=max3f(a,p1[2],p1[3]);
  #pragma unroll
  for(int r=4;r<16;r+=4){a=max3f(a,p0[r],p0[r+1]);b=max3f(b,p0[r+2],p0[r+3]);a=max3f(a,p1[r],p1[r+1]);b=max3f(b,p1[r+2],p1[r+3]);}
  const float m=max2f(a,b);
  auto rr=__builtin_amdgcn_permlane32_swap(__float_as_uint(m),__float_as_uint(m),false,false);
  return max2f(__uint_as_float(rr[0]),__uint_as_float(rr[1]));
}
__device__ __forceinline__ void pv(f32x16*o,int vb,bf16x8 pa0,bf16x8 pa1,bf16x8 pa2,bf16x8 pa3){
  #pragma unroll
  for(int d0=0;d0<2;++d0){s16x4 lo[4],hi[4];
    #pragma unroll
    for(int ks=0;ks<4;++ks){
      asm volatile("ds_read_b64_tr_b16 %0,%1 offset:%c2":"=&v"(lo[ks]):"v"(vb),"i"(d0*4096+ks*1024):"memory");
      asm volatile("ds_read_b64_tr_b16 %0,%1 offset:%c2":"=&v"(hi[ks]):"v"(vb),"i"(d0*4096+ks*1024+512):"memory");}
    asm volatile("s_waitcnt lgkmcnt(0)":::"memory");SBAR();
    #define PK(k) (bf16x8){lo[k][0],lo[k][1],lo[k][2],lo[k][3],hi[k][0],hi[k][1],hi[k][2],hi[k][3]}
    o[d0]=__builtin_amdgcn_mfma_f32_32x32x16_bf16(pa0,PK(0),o[d0],0,0,0);
    o[d0]=__builtin_amdgcn_mfma_f32_32x32x16_bf16(pa1,PK(1),o[d0],0,0,0);
    o[d0]=__builtin_amdgcn_mfma_f32_32x32x16_bf16(pa2,PK(2),o[d0],0,0,0);
    o[d0]=__builtin_amdgcn_mfma_f32_32x32x16_bf16(pa3,PK(3),o[d0],0,0,0);
    #undef PK
  }
}

__device__ __forceinline__ u32x4 mul_bf16x8(u32x4 a,u32x4 b){ u32x4 r;
  #pragma unroll
  for(int i=0;i<4;++i){ const float al=__uint_as_float(a[i]<<16),ah=__uint_as_float(a[i]&0xffff0000u),bl=__uint_as_float(b[i]<<16),bh=__uint_as_float(b[i]&0xffff0000u); r[i]=cvtpk_s(al*bl,ah*bh); }
  return r; }
#ifndef ATTN_STORE16
#define ATTN_STORE16(p,v) (*(u32x4*)(p)=(v))
#endif
template<int THRL> __device__ __forceinline__ void attn_unit(int b,int h,int qb,const bf16*Q,const bf16*__restrict__ K,const bf16*__restrict__ V,bf16*O,char*shm,lds_cuptr nb,int tskip,bool dry,int wave_id){
  int tid_=(int)__builtin_amdgcn_mbcnt_hi(~0u,__builtin_amdgcn_mbcnt_lo(~0u,0u)); asm volatile("":"+v"(tid_)); tid_+=wave_id*64; const int tid=tid_,lane=tid&63,r32=lane&31,hi=lane>>5; const int wid=__builtin_amdgcn_readfirstlane(tid>>6);
  const long rowbase=(long)b*SEQ; const int q0=qb*QB;
  const bf16*Qw=Q+(rowbase+q0+wid*QBLK)*DM+h*D;
  const bf16*Kh=K+(rowbase+(long)tskip*KVBLK)*DM+h*D,*Vh=V+(rowbase+(long)tskip*KVBLK)*DM+h*D;
  const unsigned lds0=(unsigned)(uintptr_t)shm;
  float*wsf=(float*)(shm+LDS_WS)+wid*64;
  const bf16*ksrc=Kh+(long)lane*DM+wid*8;
  const bf16*vsrc=Vh+(long)(16*(wid&3)+(lane>>2))*DM+(wid>>2)*32+(lane&3)*8;
  const unsigned kdst=lds0+LDS_K+wid*1024, vdst=lds0+LDS_V+wid*1024;
  #define DMA_K(t,slot) glds16(ksrc+(long)(t)*KVBLK*DM,(unsigned)__builtin_amdgcn_readfirstlane(kdst+(slot)))
  #define DMA_V(t,slot) glds16(vsrc+(long)(t)*KVBLK*DM,(unsigned)__builtin_amdgcn_readfirstlane(vdst+(slot)))
  const int vb0=(int)(lds0+LDS_V)+((lane>>4)&1)*32+(lane&3)*8+(4*hi+((lane&15)>>2))*64;
  const char*Kbase=shm+LDS_K; bf16x8 kf[8];
  const lds_cptr shm3=(lds_cptr)shm; const lds_cptr kp0=shm3+LDS_K+hi*1024+r32*16; const lds_cptr vp0=shm3+LDS_V+((lane>>4)&1)*32+(lane&3)*8+(4*hi+((lane&15)>>2))*64;
  const int NT=(q0+QB)/KVBLK-tskip;
  DMA_K(0,0);DMA_V(0,0);DMA_K(1,SLOTB);
  bf16x8 qr[4];
  #pragma unroll
  for(int d0=0;d0<4;++d0)qr[d0]=*reinterpret_cast<const bf16x8*>(&Qw[(long)r32*DM+d0*16+hi*8]);
  float mhat=0.f,l_reg=0.f;f32x16 o[2];o[0]=f32x16{};o[1]=f32x16{};unsigned qm1=0u;const lds_cuptr nbl=nb+64*tskip+r32;
  #define SETM(NEWM) do{ const float nm_=-(NEWM); const unsigned h_=bfr(nm_); const float hf_=__uint_as_float(h_<<16); const unsigned l_=bfr(nm_-hf_); mhat=-(hf_+__uint_as_float(l_<<16)); qm1=hi?0u:(h_|(l_<<16)); }while(0)
  const int qrel=wid*QBLK+r32;
  #define CMASK(P0,P1,t) do{int jb_=(t)-(NT-4); if(jb_>=0)cmask(P0,P1,jb_,qrel,hi);}while(0)
  bool resc=false;
  #define START(P0,P1) do{ const float rm=rowmax(P0,P1); resc=false; \
    { const float old_=mhat; SETM(old_+rm); const float dl=mhat-old_; \
      _Pragma("unroll") for(int r=0;r<16;++r){P0[r]=fsub_s(P0[r],dl);P1[r]=fsub_s(P1[r],dl);} } \
    _Pragma("unroll") for(int r=0;r<16;++r)P0[r]=__builtin_amdgcn_exp2f(P0[r]); }while(0)
  #define RESC() do{ if(resc){ asm volatile("s_waitcnt lgkmcnt(0)":::"memory"); \
      _Pragma("unroll") for(int d_=0;d_<2;++d_) _Pragma("unroll") for(int r=0;r<16;++r)o[d_][r]*=wsf[crow(r,hi)]; } }while(0)
  f32x16 pA0,pA1,pB0,pB1;
  int sl_prev=0,sl_cur=0,sl_next=SLOTB;
  #define ROT() do{sl_prev=sl_cur;sl_cur=sl_next;sl_next=(sl_next==(NSLOT-1)*SLOTB)?0:sl_next+SLOTB;}while(0)
  DMA_K(2,2*SLOTB);
  WAIT_BAR(3);
  unsigned bw0=nbl[0],bw1=nbl[32]; biasmm(pA0,pA1,bw0,bw1,qm1,hi); bw0=nbl[64]; bw1=nbl[96]; qkt(pA0,pA1,Kbase,qr,r32,hi);    asm volatile("s_nop 15\n\ts_nop 7":"+v"(pA0),"+v"(pA1));CMASK(pA0,pA1,0);
  START(pA0,pA1);
  _Pragma("unroll") for(int r=0;r<16;++r)pA1[r]=__builtin_amdgcn_exp2f(pA1[r]);
  WAIT_BAR(0);
  DMA_K(3,0);DMA_V(1,SLOTB);
  ROT();
  kload8(kf,kp0+sl_cur);
  WAIT_BAR(2);
  s16x4 vlo[8],vhi[8]; u32x4 pw0,pw1,pw2,pw3;
  #define PKW(P,B) cvtpk_s(P[B],P[B+1])
  #define PAF(k) __builtin_bit_cast(bf16x8,pw##k)
  #define VFR(i) (bf16x8){vlo[i][0],vlo[i][1],vlo[i][2],vlo[i][3],vhi[i][0],vhi[i][1],vhi[i][2],vhi[i][3]}
  #define PIN(x) asm volatile("":"+v"(x))
  #define MX3(a,b,c) __builtin_fmaxf(__builtin_fmaxf((a),(b)),(c))
  #define GAPA(MF,A0,A1,A2,A3,W0,W1,PW) do{ MF; sacc+=A0; sacc+=A1; sacc+=A2; sacc+=A3; PIN(sacc); W0; W1; PIN(PW); SBAR(); }while(0)
  #define EX(v) __builtin_amdgcn_exp2f(v)
  #define GAPB(MF,X,B) do{ MF; X[B]=EX(X[B]); X[B+1]=EX(X[B+1]); X[B+2]=EX(X[B+2]); X[B+3]=EX(X[B+3]); PIN(X); SBAR(); }while(0)
  #define VRD(i) do{ vlo[i]=vtr(vp_+(((i)>>2)*4096+((i)&3)*1024)); vhi[i]=vtr(vp_+(((i)>>2)*4096+((i)&3)*1024+512)); }while(0)
  #define KRD(G,j) do{ if(G){ kload2(kf,kp0+sl_next,j); SBAR(); } }while(0)
  #define STEP(C0,C1,P0,P1,t,GK,GV,GL) do{ SBAR(); \
    biasmm(C0,C1,bw0,bw1,qm1,hi); bw0=nbl[64*((t)+1)]; bw1=nbl[64*((t)+1)+32]; SBAR(); \
    const lds_cptr vp_=vp0+sl_prev; \
    VRD(0); SBAR(); float sacc=(P0[0]+P0[1]); \
    GAPA(C0=__builtin_amdgcn_mfma_f32_32x32x16_bf16(kf[0],qr[0],C0,0,0,0), P0[2],P0[3],P0[4],P0[5],     pw0[0]=PKW(P0,0), pw0[1]=PKW(P0,2), pw0); \
    VRD(4); SBAR(); GAPA(C1=__builtin_amdgcn_mfma_f32_32x32x16_bf16(kf[1],qr[0],C1,0,0,0), P0[6],P0[7],P0[8],P0[9],     pw0[2]=PKW(P0,4), pw0[3]=PKW(P0,6), pw0); \
    VRD(1); SBAR(); GAPA(C0=__builtin_amdgcn_mfma_f32_32x32x16_bf16(kf[2],qr[1],C0,0,0,0),   P0[10],P0[11],P0[12],P0[13], pw1[0]=PKW(P0,8), pw1[1]=PKW(P0,10), pw1); \
    VRD(5); SBAR(); GAPA(C1=__builtin_amdgcn_mfma_f32_32x32x16_bf16(kf[3],qr[1],C1,0,0,0),   P0[14],P0[15],P1[0],P1[1],   pw1[2]=PKW(P0,12),pw1[3]=PKW(P0,14), pw1); \
    VRD(2); SBAR(); GAPA(C0=__builtin_amdgcn_mfma_f32_32x32x16_bf16(kf[4],qr[2],C0,0,0,0),   P1[2],P1[3],P1[4],P1[5],     pw2[0]=PKW(P1,0), pw2[1]=PKW(P1,2), pw2); \
    VRD(6); SBAR(); GAPA(C1=__builtin_amdgcn_mfma_f32_32x32x16_bf16(kf[5],qr[2],C1,0,0,0),   P1[6],P1[7],P1[8],P1[9],     pw2[2]=PKW(P1,4), pw2[3]=PKW(P1,6), pw2); \
    VRD(3); SBAR(); GAPA(C0=__builtin_amdgcn_mfma_f32_32x32x16_bf16(kf[6],qr[3],C0,0,0,0),   P1[10],P1[11],P1[12],P1[13], pw3[0]=PKW(P1,8), pw3[1]=PKW(P1,10), pw3); \
    VRD(7); SBAR(); GAPA(C1=__builtin_amdgcn_mfma_f32_32x32x16_bf16(kf[7],qr[3],C1,0,0,0),   P1[14],P1[15],0.f,0.f,       pw3[2]=PKW(P1,12),pw3[3]=PKW(P1,14), pw3); \
    l_reg+=sacc; \
    if(GK){DMA_K((t)+3,sl_cur);} if(GV){DMA_V((t)+1,sl_next);} \
    CMASK(C0,C1,t); \
    { float a=MX3(C0[0],C0[1],C1[0]),b=MX3(C0[2],C0[3],C1[1]); a=MX3(a,C1[2],C1[3]); \
      _Pragma("unroll") for(int r=4;r<16;r+=4){a=MX3(a,C0[r],C0[r+1]);b=MX3(b,C0[r+2],C0[r+3]);a=MX3(a,C1[r],C1[r+1]);b=MX3(b,C1[r+2],C1[r+3]);} \
      float rm=__builtin_fmaxf(a,b); { auto rr=__builtin_amdgcn_permlane32_swap(__float_as_uint(rm),__float_as_uint(rm),false,false); rm=__builtin_fmaxf(__uint_as_float(rr[0]),__uint_as_float(rr[1])); } \
      resc=false; \
      if(__builtin_expect(__any(rm>(float)THRL),0)){ const float old_=mhat; SETM(old_+__builtin_fmaxf(rm,0.f)); const float dl=mhat-old_; \
        _Pragma("unroll") for(int r=0;r<16;++r){C0[r]-=dl;C1[r]-=dl;} \
        const float f=__builtin_amdgcn_exp2f(-dl); l_reg*=f; if(hi==0)wsf[r32]=f; resc=true; } } \
    SBAR(); \
    GAPB(o[0]=__builtin_amdgcn_mfma_f32_32x32x16_bf16(PAF(0),VFR(0),o[0],0,0,0), C0,0); \
    GAPB(o[1]=__builtin_amdgcn_mfma_f32_32x32x16_bf16(PAF(0),VFR(4),o[1],0,0,0), C0,4); \
    KRD(GL,0); GAPB(o[0]=__builtin_amdgcn_mfma_f32_32x32x16_bf16(PAF(1),VFR(1),o[0],0,0,0), C0,8); \
    KRD(GL,1); GAPB(o[1]=__builtin_amdgcn_mfma_f32_32x32x16_bf16(PAF(1),VFR(5),o[1],0,0,0), C0,12); \
    KRD(GL,2); GAPB(o[0]=__builtin_amdgcn_mfma_f32_32x32x16_bf16(PAF(2),VFR(2),o[0],0,0,0), C1,0); \
    KRD(GL,3); GAPB(o[1]=__builtin_amdgcn_mfma_f32_32x32x16_bf16(PAF(2),VFR(6),o[1],0,0,0), C1,4); \
    GAPB(o[0]=__builtin_amdgcn_mfma_f32_32x32x16_bf16(PAF(3),VFR(3),o[0],0,0,0), C1,8); \
    GAPB(o[1]=__builtin_amdgcn_mfma_f32_32x32x16_bf16(PAF(3),VFR(7),o[1],0,0,0), C1,12); \
    }while(0)
  int t=1;
  #undef CMASK
  #define CMASK(P0,P1,t) do{}while(0)
  for(;t+5<NT;t+=2){
    STEP(pB0,pB1,pA0,pA1,t,true,true,true);     WAIT_BAR(2); RESC(); ROT();
    STEP(pA0,pA1,pB0,pB1,t+1,true,true,true);   WAIT_BAR(2); RESC(); ROT();
  }
  #undef CMASK
  #define CMASK(P0,P1,t) do{int jb_=(t)-(NT-4); if(jb_>=0)cmask(P0,P1,jb_,qrel,hi);}while(0)
  #define ENDW(tt) do{ if((tt)+3<NT){WAIT_BAR(2);} else if((tt)+2<NT){WAIT_BAR(1);} else {WAIT_BAR(0);} }while(0)
  for(;t+1<NT;t+=2){
    STEP(pB0,pB1,pA0,pA1,t,(t+3<NT),(t+1<NT),(t+1<NT));       ENDW(t);   RESC(); ROT();
    STEP(pA0,pA1,pB0,pB1,t+1,(t+4<NT),(t+2<NT),(t+2<NT));     ENDW(t+1); RESC(); ROT();
  }
  STEP(pB0,pB1,pA0,pA1,NT-1,false,false,false); RESC();
  { float sacc=pB0[0]+pB0[1]; _Pragma("unroll") for(int r=2;r<16;++r)sacc+=pB0[r]; _Pragma("unroll") for(int r=0;r<16;++r)sacc+=pB1[r]; l_reg+=sacc;
    pw0=(u32x4){PKW(pB0,0),PKW(pB0,2),PKW(pB0,4),PKW(pB0,6)};pw1=(u32x4){PKW(pB0,8),PKW(pB0,10),PKW(pB0,12),PKW(pB0,14)};pw2=(u32x4){PKW(pB1,0),PKW(pB1,2),PKW(pB1,4),PKW(pB1,6)};pw3=(u32x4){PKW(pB1,8),PKW(pB1,10),PKW(pB1,12),PKW(pB1,14)};
    SBAR(); pv(o,vb0+sl_cur,PAF(0),PAF(1),PAF(2),PAF(3)); }
  #undef PKW
  #undef PAF
  #undef VFR
  #undef PIN
  #undef MX3
  #undef GAPA
  #undef GAPB
  #undef EX
  #undef VRD
  #undef KRD
  #undef STEP
  #undef ENDW
  {auto rr=__builtin_amdgcn_permlane32_swap(__float_as_uint(l_reg),__float_as_uint(l_reg),false,false);l_reg=__uint_as_float(rr[0])+__uint_as_float(rr[1]);}
  if(hi==0)wsf[32+r32]=l_reg;asm volatile("s_waitcnt lgkmcnt(0)":::"memory");
  float rli[16];
  #pragma unroll
  for(int r=0;r<16;++r)rli[r]=__builtin_amdgcn_rcpf(wsf[32+crow(r,hi)]);
  bf16*Ow=O+(rowbase+q0+wid*QBLK)*(long)OPITCH+OCOL0+h*D;
  { bf16*stg=(bf16*)(shm+LDS_OST)+wid*2048;
    #pragma unroll
    for(int r=0;r<16;++r){const int orow=crow(r,hi);
      #pragma unroll
      for(int d0=0;d0<2;++d0)stg[orow*64+d0*32+r32]=__float2bfloat16(o[d0][r]*rli[r]);}
    asm volatile("s_waitcnt lgkmcnt(0)":::"memory");
    #pragma unroll
    for(int i=0;i<4;++i){const int row=i*8+(lane>>3),ch=lane&7; const u32x4 v=*(const u32x4*)(stg+row*64+ch*8); bf16*gp=Ow+(long)row*OPITCH+ch*8; const u32x4 gt=*(const u32x4*)gp; if(!dry){ATTN_STORE16(gp,mul_bf16x8(v,gt));}} }
  asm volatile("s_waitcnt lgkmcnt(0)\n\ts_barrier":::"memory");
  #undef DMA_K
  #undef DMA_V
  #undef CMASK
  #undef START
  #undef RESC
  #undef ROT
  #undef SETM
}
constexpr int ATTN_LDS_BYTES=LDS_BYTES;
#undef SBAR
#undef WAIT_BAR
}
constexpr int BATCH = 4, SEQ = 8192, DMODEL = 1024, M = BATCH * SEQ, DEPTH = 2, INC = 7852;
constexpr int NT_A = 19, NT_B = 12, NTILES = NT_A + NT_B;
constexpr int SA_Q = 0, SA_K = 512, SA_V = 640, SA_G = 768, SB_Q = 1280, SB_K = 1792, SB_V = 1920, SB_IQ = 2048, SB_IK = 2176, SB_IW = 2208, SB_G = 2212,
              SC_Q = 2724, SC_K = 3236, SC_V = 3748, SC_F = 4260, SC_G = 4268, S_MG = 4780;
static_assert(S_MG + 3072 == INC, "column partition");
__host__ __device__ __forceinline__ int src_col(int t, int lc) {
    switch (t) {
        case 0: case 1: return SA_Q + t * 256 + lc;
        case 2: case 3: return SB_Q + (t - 2) * 256 + lc;
        case 4: case 5: return SC_Q + (t - 4) * 256 + lc;
        case 6: return lc < 128 ? SA_K + lc : SB_K + lc - 128;
        case 7: case 8: return SC_K + (t - 7) * 256 + lc;
        case 9: return lc < 128 ? SA_V + lc : SB_V + lc - 128;
        case 10: case 11: return SC_V + (t - 10) * 256 + lc;
        case 12: case 13: return SA_G + (t - 12) * 256 + lc;
        case 14: case 15: return SB_G + (t - 14) * 256 + lc;
        case 16: case 17: return SC_G + (t - 16) * 256 + lc;
        case 18: return lc < 128 ? SB_IQ + lc : lc < 160 ? SB_IK + lc - 128 : lc < 164 ? SB_IW + lc - 160 : lc < 172 ? SC_F + lc - 164 : -1;
        default: return S_MG + (t - 19) * 256 + lc;
    }
}
constexpr size_t MiB = 1u << 20;
constexpr size_t WS_CTL = 0, CTL_ZERO_BYTES = 1 * MiB;
constexpr size_t WS_W1T = 2 * MiB;
constexpr size_t WS_WBT = 33 * MiB;
constexpr size_t WS_WOT = 39 * MiB;
constexpr size_t WS_SSQ = 43 * MiB;
constexpr size_t WS_CL = 45 * MiB;
constexpr size_t WS_CT = 46 * MiB;
constexpr size_t WS_IW = 47 * MiB;
constexpr size_t WS_CF = 47 * MiB + 512 * 1024;
constexpr size_t WS_IQ = 49 * MiB;
constexpr size_t WS_IK = 57 * MiB;
constexpr size_t WS_XB = 60 * MiB;
constexpr size_t WS_MERGED = 124 * MiB;
constexpr size_t WS_G = 188 * MiB;
constexpr size_t WS_QA = 284 * MiB, WS_QB = 316 * MiB, WS_QC = 348 * MiB, WS_KC = 380 * MiB, WS_VC = 412 * MiB, WS_KAB = 444 * MiB, WS_VAB = 460 * MiB;
constexpr size_t WS_MG = 284 * MiB;
constexpr size_t WS_END = 476 * MiB;
static_assert(pg8::EWS_CL == WS_CL && pg8::EWS_CT == WS_CT && pg8::EWS_SSQ == WS_SSQ && pg8::EWS_IW == WS_IW && pg8::EWS_CF == WS_CF && pg8::EWS_IQ == WS_IQ && pg8::EWS_IK == WS_IK && pg8::EWS_G == WS_G && pg8::EWS_QA == WS_QA && pg8::EWS_QB == WS_QB &&
              pg8::EWS_QC == WS_QC && pg8::EWS_KC == WS_KC && pg8::EWS_VC == WS_VC && pg8::EWS_KAB == WS_KAB && pg8::EWS_VAB == WS_VAB, "epilogue offsets");
constexpr int CW_OVF = 8;
constexpr int CW_TICK = 8192;
constexpr int CW_BAR = 4096;
constexpr int RING_OFF = 0, RING_BYTES = 131072;
constexpr int SEL_OFF = 131072;
constexpr int H2_OFF = SEL_OFF + 8192;
constexpr int BIAS_OFF = H2_OFF + 8192;
constexpr int BKT_OFF = BIAS_OFF + 2048;
constexpr int MISC_OFF = BKT_OFF + 512;
constexpr int LDS_BYTES = 155648;
static_assert(MISC_OFF + 1024 <= LDS_BYTES, "LDS map");
constexpr int NB_OFF = 86016;
static_assert(attn_body::ATTN_LDS_BYTES <= NB_OFF && NB_OFF + 32768 <= RING_BYTES, "LDS map");
constexpr int MW_NSEL = 0, MW_NCAND = 16, MW_BIN = 32, MW_ABOVE = 48, MW_CARRY = 64, MW_BAR = 96, MW_SLOW = 100, MW_TICKET = 101, MW_ZCUT = 112, MW_UC = 128, MW_ELO = 160;

#define GAS __attribute__((address_space(1)))
#define LAS __attribute__((address_space(3)))
typedef unsigned short bf16;
typedef unsigned v4u __attribute__((ext_vector_type(4)));
typedef float f32x4 __attribute__((ext_vector_type(4)));
typedef short bf16x8 __attribute__((ext_vector_type(8)));
typedef GAS unsigned gu32;
#define RLX_AGENT __ATOMIC_RELAXED, __HIP_MEMORY_SCOPE_AGENT
#define LDS_WAIT() asm volatile("s_waitcnt lgkmcnt(0)" ::: "memory")
#define VM_WAIT() asm volatile("s_waitcnt vmcnt(0)" ::: "memory")
__device__ __forceinline__ unsigned f2bf(float f) { unsigned u = __builtin_bit_cast(unsigned, f); return (u + 0x7fffu + ((u >> 16) & 1u)) >> 16; }
__device__ __forceinline__ unsigned pk2(float lo, float hi) { return f2bf(lo) | (f2bf(hi) << 16); }

#define XB_TMO      128
#define XB_XCNT(j)  (256  + 64 * (j))
#define XB_XSUB(j)  (1280 + 64 * (j))
#define XB_XGEN(j)  (2304 + 64 * (j))
#define XB_TOP      3328
#define XB_TOPGEN   3392
#define XCD_BAR_WORDS 3456
#define XB_SPIN_CAP (1u << 18)

__device__ __forceinline__ unsigned xb_ld(unsigned* p)              { return __hip_atomic_load(p, __ATOMIC_RELAXED, __HIP_MEMORY_SCOPE_AGENT); }
__device__ __forceinline__ unsigned xb_add(unsigned* p, unsigned v) { return __hip_atomic_fetch_add(p, v, __ATOMIC_RELAXED, __HIP_MEMORY_SCOPE_AGENT); }
__device__ __forceinline__ unsigned xb_xcc_id() { return (unsigned)__builtin_amdgcn_s_getreg((3 << 11) | 20) & 0xFu; }
#define XB_SPIN(cond, bar) do { unsigned _sp = 0; while (cond) { __builtin_amdgcn_s_sleep(1); \
    if ((++_sp & 255u) == 0u) { if (xb_ld(&(bar)[XB_TMO])) break; if (_sp > XB_SPIN_CAP) { atomicAdd(&(bar)[XB_TMO], 1u); break; } } } } while (0)

struct XcdBarrier {
    unsigned* bar; unsigned x;
    volatile LAS unsigned* st;
};

__device__ __forceinline__ XcdBarrier xcd_barrier_post(unsigned* bar, volatile LAS unsigned* st) {
    XcdBarrier b; b.bar = bar; b.x = xb_xcc_id(); b.st = st;
    if (threadIdx.x == 0) (void)xb_add(&bar[XB_XCNT(b.x)], 1u);
    return b;
}
__device__ __forceinline__ void xcd_barrier_complete(unsigned* bar, unsigned x, unsigned& nloc, unsigned& nx) {
    const unsigned G = gridDim.x * gridDim.y * gridDim.z;
    unsigned sum, cnt, mine, sp = 0u;
    for (;;) {
        sum = 0u; cnt = 0u; mine = 0u;
#pragma unroll
        for (unsigned j = 0; j < 16; ++j) { const unsigned c = xb_ld(&bar[XB_XCNT(j)]); sum += c; cnt += (c > 0u) ? 1u : 0u; mine = (j == x) ? c : mine; }
        if (sum == G) break;
        __builtin_amdgcn_s_sleep(1);
        if ((++sp & 255u) == 0u) { if (xb_ld(&bar[XB_TMO])) break; if (sp > XB_SPIN_CAP) { atomicAdd(&bar[XB_TMO], 1u); break; } }
    }
    nloc = mine > 0u ? mine : 1u; nx = cnt > 0u ? cnt : 1u;
}

__device__ __forceinline__ void xcd_barrier(const XcdBarrier& b) {
    asm volatile("s_waitcnt vmcnt(0)" ::: "memory");
    __syncthreads();
    if (threadIdx.x == 0) {
        unsigned* bar = b.bar;
        __builtin_amdgcn_s_waitcnt(0);
        unsigned nloc = b.st[0], nx = b.st[1];
        if (nloc == 0u) { xcd_barrier_complete(bar, b.x, nloc, nx); b.st[0] = nloc; b.st[1] = nx; }
        const unsigned old = xb_add(&bar[XB_XSUB(b.x)], 1u);
        const unsigned gen = old / nloc;
        if (old + 1u == (gen + 1u) * nloc) {
            __builtin_amdgcn_fence(__ATOMIC_RELEASE, "agent");
            asm volatile("s_waitcnt vmcnt(0)" ::: "memory");
            const unsigned og = xb_add(&bar[XB_TOP], 1u);
            const unsigned tg = og / nx;
            if (og + 1u == (tg + 1u) * nx) xb_add(&bar[XB_TOPGEN], 1u);
            else XB_SPIN(xb_ld(&bar[XB_TOPGEN]) == tg, bar);
            __builtin_amdgcn_fence(__ATOMIC_ACQUIRE, "agent");
            xb_add(&bar[XB_XGEN(b.x)], 1u);
            asm volatile("s_waitcnt vmcnt(0)" ::: "memory");
        } else {
            XB_SPIN(xb_ld(&bar[XB_XGEN(b.x)]) == gen, bar);
            __builtin_amdgcn_fence(__ATOMIC_ACQUIRE, "agent");
            asm volatile("s_waitcnt vmcnt(0)" ::: "memory");
        }
    }
    __syncthreads();
}

struct Frame {
    LAS unsigned char* lds;
    volatile LAS unsigned* MISC;
    gu32* ctl;
    int tid, lane, wave, vcu, G;
};
__device__ __forceinline__ float wave_sum(float v) {
#pragma unroll
    for (int o = 1; o < 64; o <<= 1) v += __shfl_xor(v, o);
    return v;
}
__device__ __forceinline__ float wave_incl_scan(float v, int lane) {
#pragma unroll
    for (int o = 1; o < 64; o <<= 1) { const float t = __shfl_up(v, o); if (lane >= o) v += t; }
    return v;
}
__device__ __forceinline__ int wave_incl_scan_i(int v, int lane) {
#pragma unroll
    for (int o = 1; o < 64; o <<= 1) { const int t = __shfl_up(v, o); if (lane >= o) v += t; }
    return v;
}
__device__ __forceinline__ void transpose_item(const float* W, int N, bf16* WT, int K, int n0, int k0, int scol, const float* kscale, LAS float* scr, int lane) {
#pragma unroll 8
    for (int i = 0; i < 32; ++i) { const int kk = 2 * i + (lane >> 5); float v = 0.f;
        if (scol >= 0) { v = W[(size_t)(k0 + kk) * N + scol]; if (kscale) v *= kscale[k0 + kk]; }
        scr[kk * 33 + (lane & 31)] = v; }
    LDS_WAIT(); asm volatile("" ::: "memory");
    const int c = lane & 7;
#pragma unroll
    for (int j = 0; j < 4; ++j) { const int n = (lane >> 3) + 8 * j; const LAS float* s = scr + (8 * c) * 33 + n;
        v4u o; o.x = pk2(s[0 * 33], s[1 * 33]); o.y = pk2(s[2 * 33], s[3 * 33]); o.z = pk2(s[4 * 33], s[5 * 33]); o.w = pk2(s[6 * 33], s[7 * 33]);
        *(GAS v4u*)(WT + (size_t)(n0 + n) * K + k0 + 8 * c) = o; }
    LDS_WAIT(); asm volatile("" ::: "memory");
}
__device__ __forceinline__ void p0_prologue(Frame& F, const float* x, const float* norm_gain, const float* w_in, const float* w_branch, const float* w_out, unsigned char* ws) {
    LAS float* scr = (LAS float*)(F.lds + RING_OFF + F.wave * 16384);
    const int gw = F.vcu * 8 + F.wave, NGW = F.G * 8, lane = F.lane;
    constexpr int I_W1 = 16 * (NTILES * 256 / 32), I_WB = 8 * 32, I_WO = 16 * 32;
    constexpr int NITEMS = DEPTH * I_W1 + DEPTH * 3 * I_WB + DEPTH * I_WO;
    for (int it = gw; it < NITEMS; it += NGW) {
        int r = it;
        if (r < DEPTH * I_W1) { const int L = r / I_W1; r -= L * I_W1; const int nblk = NTILES * 8, kb = r / nblk, nb = r % nblk, n0 = nb * 32, tile = n0 >> 8, p = (n0 & 255) + (lane & 31);
            const int lc = 64 * ((p >> 5) & 3) + 32 * (p >> 7) + (p & 31);
            transpose_item(w_in + (size_t)L * DMODEL * INC, INC, (bf16*)(ws + WS_W1T) + (size_t)L * NTILES * 256 * 1024, 1024, n0, kb * 64, src_col(tile, lc), norm_gain + L * DMODEL, scr, lane); continue; }
        r -= DEPTH * I_W1;
        if (r < DEPTH * 3 * I_WB) { const int mat = r / I_WB; r -= mat * I_WB; const int kb = r / 32, nb = r % 32;
            transpose_item(w_branch + (size_t)mat * 512 * 1024, 1024, (bf16*)(ws + WS_WBT) + (size_t)mat * 1024 * 512, 512, nb * 32, kb * 64, nb * 32 + (lane & 31), nullptr, scr, lane); continue; }
        r -= DEPTH * 3 * I_WB;
        { const int L = r / I_WO; r -= L * I_WO; const int kb = r / 32, nb = r % 32;
            transpose_item(w_out + (size_t)L * 1024 * 1024, 1024, (bf16*)(ws + WS_WOT) + (size_t)L * 1024 * 1024, 1024, nb * 32, kb * 64, nb * 32 + (lane & 31), nullptr, scr, lane); }
    }
    bf16* XB = (bf16*)(ws + WS_XB); float* SSQ = (float*)(ws + WS_SSQ);
    for (int m = gw; m < M; m += NGW) {
        const GAS f32x4* xr = (const GAS f32x4*)(x + (size_t)m * DMODEL) + lane; f32x4 v[4]; float s = 0.f;
#pragma unroll
        for (int j = 0; j < 4; ++j) { v[j] = xr[64 * j]; s += (v[j].x * v[j].x + v[j].y * v[j].y) + (v[j].z * v[j].z + v[j].w * v[j].w); }
        const float tot = wave_sum(s);
        GAS unsigned long long* o8 = (GAS unsigned long long*)(XB + (size_t)m * DMODEL) + lane;
#pragma unroll
        for (int j = 0; j < 4; ++j) o8[64 * j] = (unsigned long long)pk2(v[j].x, v[j].y) | ((unsigned long long)pk2(v[j].z, v[j].w) << 32);
        if (lane < 16) SSQ[(size_t)m * 16 + lane] = lane == 0 ? tot : 0.f;
    }
}
__device__ __forceinline__ void scan_phase(Frame& F, const float* CF, const float* bforget  , float* CL, float* CT) {
    const int lane = F.lane, h = F.wave;
    for (int u = blockIdx.x; u < 128; u += F.G) { const int b = u >> 5, j = u & 31; const size_t row = (size_t)b * SEQ + 256 * j + 4 * lane; const float bf = bforget[h];
        float s[4]; float run = 0.f;
#pragma unroll
        for (int e = 0; e < 4; ++e) { const float xx = CF[(row + e) * 8 + h] + bf; const float lf = (xx < 0.f ? xx : 0.f) - __logf(1.0f + __expf(-fabsf(xx))); run += lf; s[e] = run; }
        const float incl = wave_incl_scan(run, lane), excl = incl - run;
        *(f32x4*)(CL + (size_t)(b * 8 + h) * SEQ + 256 * j + 4 * lane) = (f32x4){excl + s[0], excl + s[1], excl + s[2], excl + s[3]};
        if (lane == 63) CT[(b * 8 + h) * 32 + j] = incl;
    }
}
#ifndef REP_IDX
#define REP_IDX 1
#endif
#ifndef REP_SPB
#define REP_SPB 1
#endif
#ifndef REP_SPA
#define REP_SPA 1
#endif
typedef unsigned u32x2 __attribute__((ext_vector_type(2)));
constexpr int NBIN = 1024;
__device__ __forceinline__ float pdist(float s, float c0, float inv) { return fmaf(s, inv, c0); }
__device__ __forceinline__ unsigned bitop_xa(unsigned a, unsigned mask, unsigned c) { unsigned r; asm("v_bitop3_b32 %0, %1, %2, %3 bitop3:0x48" : "=v"(r) : "v"(a), "s"(mask), "v"(c)); return r; }
__device__ __forceinline__ unsigned pbin4_d(float d) { const unsigned du = __float_as_uint(d);
    unsigned e4 = __builtin_amdgcn_ubfe(du, 17u, 14u); e4 = e4 < 6144u ? 6144u : (e4 > 8191u ? 8191u : e4);
    unsigned b4 = (e4 ^ (unsigned)((int)du >> 31)) & 4092u; asm("" : "+v"(b4)); return b4; }
__device__ __forceinline__ unsigned pbin_d(float d) { return pbin4_d(d) >> 2; }
__device__ __forceinline__ unsigned pbin(float s, float sc, float inv) { return pbin_d(pdist(s, sc, inv)); }
__device__ __forceinline__ float pedge(int b) {
    if (b >= NBIN) return INFINITY; if (b <= 0) return -INFINITY;
    if (b > 512) return __uint_as_float((unsigned)(b - 512 + 1536) << 19);
    if (b == 512) return 0.0f;
    return -__uint_as_float(((unsigned)(511 - b + 1537) << 19) - 1u);
}
constexpr int CMAX = 1024;
#define LDS_ADD(p, v) __hip_atomic_fetch_add((p), (v), __ATOMIC_RELAXED, __HIP_MEMORY_SCOPE_WORKGROUP)
__device__ __forceinline__ unsigned okey(float s) { const unsigned u = __float_as_uint(s); return (u & 0x80000000u) ? ~u : (u | 0x80000000u); }
struct BAParams { const bf16 *IQ, *IK; const float* IW; const bf16 *QA, *QB, *KAB, *VAB; bf16* G; const float* sinks; };
typedef float f32x2 __attribute__((ext_vector_type(2)));
typedef int i32x2 __attribute__((ext_vector_type(2)));
__device__ __forceinline__ f32x2 relu2(float a, float b) { i32x2 v = {__float_as_int(a), __float_as_int(b)}; v = __builtin_elementwise_max(v, (i32x2){0, 0}); return __builtin_bit_cast(f32x2, v); }
__device__ __forceinline__ float relu_f(float x) { const int i = __float_as_int(x); return __int_as_float(i > 0 ? i : 0); }

template <int PASS, bool DIAG> __device__ __forceinline__ void idx_tile(const bf16x8 ak, const bf16x8 (&bq)[4], const f32x4 w4, int kt, int g4, int r, int tq, float elo, float ehi,
                                                                       LAS unsigned* hl, unsigned lp4, unsigned hinc, LAS u32x2* cand, LAS unsigned short* sel, LAS unsigned* misc, LAS unsigned* zh, int zcut, float sc, float inv) {
    const f32x4 z = {0.f, 0.f, 0.f, 0.f};
    const f32x4 d0 = __builtin_amdgcn_mfma_f32_16x16x32_bf16(ak, bq[0], z, 0, 0, 0), d1 = __builtin_amdgcn_mfma_f32_16x16x32_bf16(ak, bq[1], z, 0, 0, 0),
                d2 = __builtin_amdgcn_mfma_f32_16x16x32_bf16(ak, bq[2], z, 0, 0, 0), d3 = __builtin_amdgcn_mfma_f32_16x16x32_bf16(ak, bq[3], z, 0, 0, 0);
    float sv[4], dv[4]; bool qs[4], qc[4]; unsigned n1 = 0, n2 = 0, nz = 0;
#pragma unroll
    for (int p2 = 0; p2 < 2; ++p2) { const f32x2 zero2 = {0.f, 0.f};
        f32x2 s2 = __builtin_elementwise_fma((f32x2){w4[0], w4[0]}, relu2(d0[2 * p2], d0[2 * p2 + 1]), zero2);
        s2 = __builtin_elementwise_fma((f32x2){w4[1], w4[1]}, relu2(d1[2 * p2], d1[2 * p2 + 1]), s2);
        s2 = __builtin_elementwise_fma((f32x2){w4[2], w4[2]}, relu2(d2[2 * p2], d2[2 * p2 + 1]), s2);
        s2 = __builtin_elementwise_fma((f32x2){w4[3], w4[3]}, relu2(d3[2 * p2], d3[2 * p2 + 1]), s2);
        const f32x2 dd = __builtin_elementwise_fma(s2, (f32x2){inv, inv}, (f32x2){sc, sc});
        sv[2 * p2] = s2[0]; sv[2 * p2 + 1] = s2[1]; dv[2 * p2] = dd[0]; dv[2 * p2 + 1] = dd[1]; }
#pragma unroll
    for (int i = 0; i < 4; ++i) {
        const float s = sv[i], d = dv[i];
        const int key = 16 * kt + 4 * g4 + i; const bool ok = !DIAG || key <= tq;
        if (PASS == 1) { if (ok) { const unsigned b4 = pbin4_d(d); LDS_ADD((LAS unsigned*)(uintptr_t)((b4 << 5) + ((b4 ^ lp4) & 124u)), hinc);
                                   if (DIAG) nz += (s == 0.0f) ? 1u : 0u; else asm volatile("v_cmp_eq_f32 vcc, 0, %1\n\tv_addc_co_u32 %0, vcc, 0, %0, vcc" : "+v"(nz) : "v"(s) : "vcc"); } }
        else { qs[i] = ok && d >= ehi; qc[i] = ok && !(d >= ehi) && d >= elo && (s != 0.0f || key < zcut)  ;
               n1 += qs[i] ? 1u : 0u; n2 += qc[i] ? 1u : 0u; }
    }
    if (PASS == 1) { if (nz) LDS_ADD(zh + (kt >> 3), nz); }
    if (PASS == 2) {
        const unsigned add = n1 | (n2 << 16);
        if (add) { const unsigned pos = LDS_ADD(misc + MW_NSEL + r, add); unsigned p1 = pos & 0xffffu, p2 = pos >> 16;
#pragma unroll
            for (int i = 0; i < 4; ++i) { const int key = 16 * kt + 4 * g4 + i;
                if (qs[i]) { if (p1 < 256u) sel[p1] = (unsigned short)key; ++p1; }
                if (qc[i]) { if (p2 < (unsigned)CMAX) cand[p2] = (u32x2){okey(sv[i]), (unsigned)key}; ++p2; } } }
    }
}
template <int PASS> __device__ __forceinline__ void idx_pass(Frame& F, const bf16* IKb, const bf16x8 (&bq)[4], const f32x4 w4, int tau, int t0) {
    int lane_ = F.lane; asm volatile("" : "+v"(lane_)); const int lane = lane_, r = lane & 15, g4 = lane >> 4, tq = t0 + r;
    LAS unsigned* hl = (LAS unsigned*)(F.lds + RING_OFF); const unsigned lp = ((unsigned)lane >> 1) * 4u, hinc = 1u << ((lane & 1) * 16);
    LAS u32x2* cand = (LAS u32x2*)(F.lds + RING_OFF) + r * CMAX;
    LAS unsigned short* sel = (LAS unsigned short*)(F.lds + SEL_OFF) + r * 256;
    LAS unsigned* misc = (LAS unsigned*)(F.lds + MISC_OFF);
    float elo = 0.f, ehi = 0.f; int zcut = SEQ; if (PASS == 2) { elo = __uint_as_float(misc[MW_ELO + r]); ehi = __uint_as_float(misc[MW_ELO + 16 + r]); zcut = (int)misc[MW_ZCUT + r]; }
    LAS unsigned* zh = (LAS unsigned*)(F.lds + H2_OFF) + r * 64;
    const bf16* kp = IKb + (size_t)r * 32 + 8 * g4;
    float sc, inv; { const bf16x8 at = *(const bf16x8*)kp; const f32x4 z = {0.f, 0.f, 0.f, 0.f};
        const f32x4 d0 = __builtin_amdgcn_mfma_f32_16x16x32_bf16(at, bq[0], z, 0, 0, 0), d1 = __builtin_amdgcn_mfma_f32_16x16x32_bf16(at, bq[1], z, 0, 0, 0),
                    d2 = __builtin_amdgcn_mfma_f32_16x16x32_bf16(at, bq[2], z, 0, 0, 0), d3 = __builtin_amdgcn_mfma_f32_16x16x32_bf16(at, bq[3], z, 0, 0, 0);
        float mx = -INFINITY, ma = 0.f;
#pragma unroll
        for (int i = 0; i < 4; ++i) { float s = 0.f; s = fmaf(w4[0], relu_f(d0[i]), s); s = fmaf(w4[1], relu_f(d1[i]), s); s = fmaf(w4[2], relu_f(d2[i]), s); s = fmaf(w4[3], relu_f(d3[i]), s); mx = fmaxf(mx, s); ma = fmaxf(ma, fabsf(s)); }
        mx = fmaxf(mx, __shfl_xor(mx, 16)); mx = fmaxf(mx, __shfl_xor(mx, 32)); ma = fmaxf(ma, __shfl_xor(ma, 16)); ma = fmaxf(ma, __shfl_xor(ma, 32));
        inv = (ma > 1e-30f && ma < 1e30f) ? __builtin_amdgcn_rcpf(ma) * 0.0078125f : 0.0078125f; sc = -(mx * inv);
        if (PASS == 1 && F.wave == 0 && g4 == 0) { misc[MW_UC + r] = __float_as_uint(sc); misc[MW_UC + 16 + r] = __float_as_uint(inv); } }
    int kt = F.wave; if (kt > tau) return;
    bf16x8 a0 = *(const bf16x8*)(kp + (size_t)kt * 512);
    bf16x8 a1 = *(const bf16x8*)(kp + (size_t)(kt + 8 <= tau ? kt + 8 : kt) * 512);
    for (; kt <= tau; kt += 8) {
        const int k2 = kt + 16 <= tau ? kt + 16 : kt; const bf16x8 a2 = *(const bf16x8*)(kp + (size_t)k2 * 512);
        if (kt < tau) idx_tile<PASS, false>(a0, bq, w4, kt, g4, r, tq, elo, ehi, hl, lp, hinc, cand, sel, misc, zh, zcut, sc, inv);
        else          idx_tile<PASS, true>(a0, bq, w4, kt, g4, r, tq, elo, ehi, hl, lp, hinc, cand, sel, misc, zh, zcut, sc, inv);
        a0 = a1; a1 = a2;
    }
}
__device__ __forceinline__ void idx_threshold(Frame& F) {
    int lane_ = F.lane; asm volatile("" : "+v"(lane_)); const int lane = lane_; LAS unsigned* misc = (LAS unsigned*)(F.lds + MISC_OFF);
    for (int qq = 0; qq < 2; ++qq) { const int q = 2 * F.wave + qq; const unsigned sh = (q & 1) * 16, qh = (unsigned)q >> 1;
        const LAS unsigned* hb = (const LAS unsigned*)(F.lds + RING_OFF);
        int cnt[16];
#pragma unroll
        for (int k = 0; k < 16; ++k) { const unsigned bin = 64u * k + lane, sw = bin & 31u; const LAS unsigned* p = hb + bin * 32u;
            cnt[k] = (int)(((p[qh ^ sw] >> sh) & 0xffffu) + ((p[(qh + 8u) ^ sw] >> sh) & 0xffffu) + ((p[(qh + 16u) ^ sw] >> sh) & 0xffffu) + ((p[(qh + 24u) ^ sw] >> sh) & 0xffffu)); }
        int a8[8], a4[4], a2[2], a1;
        { const bool h5 = lane & 32, h4 = lane & 16, h3 = lane & 8, h2 = lane & 4;
#pragma unroll
          for (int i = 0; i < 8; ++i) { const int mine = h5 ? cnt[8 + i] : cnt[i], theirs = h5 ? cnt[i] : cnt[8 + i]; a8[i] = mine + __shfl_xor(theirs, 32); }
#pragma unroll
          for (int i = 0; i < 4; ++i) { const int mine = h4 ? a8[4 + i] : a8[i], theirs = h4 ? a8[i] : a8[4 + i]; a4[i] = mine + __shfl_xor(theirs, 16); }
#pragma unroll
          for (int i = 0; i < 2; ++i) { const int mine = h3 ? a4[2 + i] : a4[i], theirs = h3 ? a4[i] : a4[2 + i]; a2[i] = mine + __shfl_xor(theirs, 8); }
          { const int mine = h2 ? a2[1] : a2[0], theirs = h2 ? a2[0] : a2[1]; a1 = mine + __shfl_xor(theirs, 4); }
          a1 += __shfl_xor(a1, 1); a1 += __shfl_xor(a1, 2); }
        int ks = 0, aseg = 0, v = cnt[0]; { int cum = 0; bool found = false;
#pragma unroll
            for (int k = 15; k >= 0; --k) { const int Tk = __builtin_amdgcn_readlane(a1, 4 * k); if (!found && cum + Tk >= 256) { found = true; ks = k; aseg = cum; v = cnt[k]; } cum += Tk; } }
        const int pre = wave_incl_scan_i(v, lane);
        int tot = pre; tot = __shfl(tot, 63);
        const int suf = tot - pre + v;
        const unsigned long long mask = __ballot(aseg + suf >= 256);
        const int Ls = mask ? 63 - (int)__builtin_clzll(mask) : 0;
        if (lane == Ls) { const int bs = 64 * ks + lane; misc[MW_BIN + q] = (unsigned)bs; misc[MW_ABOVE + q] = (unsigned)(aseg + suf - v);
                          misc[MW_ELO + q] = __float_as_uint(pedge(bs)); misc[MW_ELO + 16 + q] = __float_as_uint(pedge(bs + 1)); }
        { const int binstar = __shfl(64 * ks + lane, Ls), needz = 256 - __shfl(aseg + suf - v, Ls);
          const int zc = (int)((const LAS unsigned*)(F.lds + H2_OFF))[q * 64 + lane]; const int zi = wave_incl_scan_i(zc, lane);
          const unsigned long long zm = __ballot(zi >= needz);
          if (lane == 0) misc[MW_ZCUT + q] = (binstar == (int)pbin(0.0f, __uint_as_float(misc[MW_UC + q]), __uint_as_float(misc[MW_UC + 16 + q])) && zm) ? (unsigned)(128 * ((int)__builtin_ctzll(zm) + 1)) : (unsigned)SEQ; }
    }
}
__device__ __forceinline__ unsigned idx_digit(const u32x2 e, int lvl) { const unsigned v = 8191u - e.y;
    return lvl == 0 ? e.x >> 24 : lvl == 1 ? (e.x >> 16) & 255u : lvl == 2 ? (e.x >> 8) & 255u : lvl == 3 ? e.x & 255u : lvl == 4 ? (v >> 5) & 255u : v & 31u; }
__device__ __forceinline__ void idx_resolve(Frame& F) {
    int lane_ = F.lane; asm volatile("" : "+v"(lane_)); const int lane = lane_; LAS unsigned* misc = (LAS unsigned*)(F.lds + MISC_OFF);
    LAS unsigned* h2 = (LAS unsigned*)(F.lds + H2_OFF) + F.wave * 256;
    for (int qq = 0; qq < 2; ++qq) { const int q = 2 * F.wave + qq;
        const unsigned packed = misc[MW_NSEL + q];
        if (lane == 0) misc[MW_NSEL + q] = packed & 0xffffu;
        int c = (int)(packed >> 16); if (c > CMAX) { c = CMAX; if (lane == 0) __hip_atomic_fetch_add(F.ctl + CW_OVF, 1u, RLX_AGENT); }
        int need = 256 - (int)misc[MW_ABOVE + q];
        LAS u32x2* cq = (LAS u32x2*)(F.lds + RING_OFF) + q * CMAX;
        LAS unsigned short* sel = (LAS unsigned short*)(F.lds + SEL_OFF) + q * 256;
        if (c > need && c <= 64) {
            u32x2 e = {0u, 0u}; if (lane < c) e = cq[lane]; int rank = 0;
            for (int j = 0; j < c; ++j) { const unsigned uj = (unsigned)__builtin_amdgcn_readlane((int)e.x, j), ij = (unsigned)__builtin_amdgcn_readlane((int)e.y, j); rank += (uj > e.x || (uj == e.x && ij < e.y)) ? 1 : 0; }
            if (lane < c && rank < need) { const unsigned pos = LDS_ADD(misc + MW_NSEL + q, 1u); if (pos < 256u) sel[pos] = (unsigned short)e.y; }
            c = 0; need = 0;
        }
#pragma unroll 1
        for (int lvl = 0; lvl < 6 && c > need; ++lvl) {
            *(LAS v4u*)(h2 + 4 * lane) = (v4u){0u, 0u, 0u, 0u};
            for (int i = lane; i < c; i += 64) LDS_ADD(h2 + idx_digit(cq[i], lvl), 1u);
            const v4u hw = *(const LAS v4u*)(h2 + 252 - 4 * lane);
            const int total = (int)(hw.x + hw.y + hw.z + hw.w), incl = wave_incl_scan_i(total, lane);
            const unsigned long long mask = __ballot(incl >= need);
            const int Ls = mask ? (int)__builtin_ctzll(mask) : 63;
            int dstar_l = 0, above_l = 0; { int cum = incl - total; bool found = false;
#pragma unroll
                for (int e = 3; e >= 0; --e) { const int cc = (int)hw[e]; if (!found && cum + cc >= need) { found = true; dstar_l = 252 - 4 * lane + e; above_l = cum; } cum += cc; } }
            const unsigned dstar = (unsigned)__shfl(dstar_l, Ls); const int above = __shfl(above_l, Ls);
            int c2 = 0;
            for (int base = 0; base < c; base += 64) { const int i = base + lane; const bool valid = i < c; u32x2 e = {0u, 0u}; if (valid) e = cq[i];
                const unsigned dg = idx_digit(e, lvl); const bool tie = valid && dg == dstar;
                if (valid && dg > dstar) { const unsigned pos = LDS_ADD(misc + MW_NSEL + q, 1u); if (pos < 256u) sel[pos] = (unsigned short)e.y; }
                const unsigned long long tm = __ballot(tie);
                if (tie) cq[c2 + __popcll(tm & ((1ull << lane) - 1ull))] = e;
                c2 += __popcll(tm); }
            c = c2; need -= above;
        }
        for (int i = lane; i < c && i < need; i += 64) { const unsigned pos = LDS_ADD(misc + MW_NSEL + q, 1u); if (pos < 256u) sel[pos] = (unsigned short)cq[i].y; }
    }
}
typedef short s16x4 __attribute__((ext_vector_type(4)));
__device__ __forceinline__ void sp_glds16(const void* gsrc, unsigned lds_dst) { unsigned keep;
    asm volatile("s_mov_b32 %0, m0\n\ts_mov_b32 m0, %2\n\ts_nop 0\n\tglobal_load_lds_dwordx4 %1, off\n\ts_mov_b32 m0, %0" : "=&s"(keep) : "v"(gsrc), "s"(lds_dst) : "memory"); }
__device__ __forceinline__ void sp_glds16s(const void* sbase, unsigned voff, unsigned lds_dst) { unsigned keep;
    asm volatile("s_mov_b32 %0, m0\n\ts_mov_b32 m0, %3\n\ts_nop 0\n\tglobal_load_lds_dwordx4 %1, %2\n\ts_mov_b32 m0, %0" : "=&s"(keep) : "v"(voff), "s"(sbase), "s"(lds_dst) : "memory"); }
__device__ __forceinline__ void sp_glds16s_x4(const void* sbase, unsigned v0, unsigned v1, unsigned v2, unsigned v3, unsigned lds_dst) { unsigned keep;
    asm volatile("s_mov_b32 %0, m0\n\ts_mov_b32 m0, %6\n\ts_nop 0\n\tglobal_load_lds_dwordx4 %1, %5\n\ts_add_u32 m0, m0, 0x400\n\ts_nop 0\n\tglobal_load_lds_dwordx4 %2, %5\n\ts_add_u32 m0, m0, 0x400\n\ts_nop 0\n\tglobal_load_lds_dwordx4 %3, %5\n\ts_add_u32 m0, m0, 0x400\n\ts_nop 0\n\tglobal_load_lds_dwordx4 %4, %5\n\ts_mov_b32 m0, %0"
                 : "=&s"(keep) : "v"(v0), "v"(v1), "v"(v2), "v"(v3), "s"(sbase), "s"(lds_dst) : "memory", "scc"); }
template <bool IS_A> __device__ __forceinline__ void sparse_pair(Frame& F, const BAParams& P, int rb, int tA, int qi0, int nv0, int nv1, bool dry) {
    constexpr int NC = IS_A ? 8 : 16, NSLOT = NC * 16, KOFF = IS_A ? 0 : M * 128, HB = IS_A ? 0 : 8, GOFF = IS_A ? 0 : 512;
    int lane_ = F.lane; asm volatile("" : "+v"(lane_)); const int lane = lane_, r = lane & 15, g4 = lane >> 4, my_a = g4 >> 1, my_j = g4 & 1;
    const bf16* Q = IS_A ? P.QA : P.QB;
    const LAS unsigned short* sel = (const LAS unsigned short*)(F.lds + SEL_OFF) + qi0 * 256;
    const LAS float* BIAS = (const LAS float*)(F.lds + BIAS_OFF);
    const LAS unsigned char* BKT = (const LAS unsigned char*)(F.lds + BKT_OFF);
    LAS unsigned short* Pimg = (LAS unsigned short*)(F.lds + RING_OFF + F.wave * 16384);
    bf16x8 q0, q1; const bf16x8 zz = {0, 0, 0, 0, 0, 0, 0, 0};
    { const int a_r = r >> 3, hd = r & 7; const bf16* qp = Q + (size_t)(rb + tA + a_r) * 512 + hd * 64 + 8 * g4; q0 = *(const bf16x8*)qp; q1 = *(const bf16x8*)(qp + 32); }
    const int my_t = tA + my_a, rcb = r >> 2;
    f32x4 x[NC];
#pragma unroll
    for (int c = 0; c < NC; ++c) x[c] = (f32x4){0.f, 0.f, 0.f, 0.f};
    constexpr int KS = NSLOT / 32, NST = 4 * KS;
    const unsigned wk = (unsigned)__builtin_amdgcn_readfirstlane((int)((unsigned)(uintptr_t)(F.lds + RING_OFF) + (unsigned)F.wave * 16384u));
    const int drow = lane >> 3, dpc = lane & 7;
#define SP_KDMA(st, bufi) do { const int cb_ = (st) / KS, ks_ = (st) % KS, a_ = cb_ >> 1, j_ = cb_ & 1; unsigned vo_[4]; \
        _Pragma("unroll") for (int i_ = 0; i_ < 4; ++i_) { const int slot_ = 32 * ks_ + 8 * i_ + drow; int key_; \
            if (IS_A) { key_ = tA + a_ - slot_; key_ = key_ < 0 ? 0 : key_; } else { key_ = sel[a_ * 256 + slot_]; }   \
            vo_[i_] = (unsigned)(((rb + key_) * 128 + KOFF + j_ * 64 + ((dpc ^ (drow & 7)) * 8)) * 2); } \
        sp_glds16s_x4(P.KAB, vo_[0], vo_[1], vo_[2], vo_[3], (unsigned)__builtin_amdgcn_readfirstlane((int)(wk + (unsigned)((bufi) * 4096)))); } while (0)
    asm volatile("s_waitcnt vmcnt(0)" ::: "memory");
    SP_KDMA(0, 0); SP_KDMA(1, 1); SP_KDMA(2, 2); if (NST > 3) SP_KDMA(3, 3);
    { const LAS unsigned char* kring = F.lds + RING_OFF + F.wave * 16384;
      static_assert(KS % 4 == 0, "the ring position of a step is its k-step index mod 4");
#pragma unroll 1
      for (int cb = 0; cb < 4; ++cb) { const bool mine = rcb == cb; const bf16x8 a0 = mine ? q0 : zz, a1 = mine ? q1 : zz;
#pragma unroll
        for (int ks = 0; ks < KS; ++ks) { const int st = cb * KS + ks;
          if (cb < 3 || ks + 3 < KS) asm volatile("s_waitcnt vmcnt(12)" ::: "memory"); else if (ks + 2 < KS) asm volatile("s_waitcnt vmcnt(8)" ::: "memory"); else if (ks + 1 < KS) asm volatile("s_waitcnt vmcnt(4)" ::: "memory"); else asm volatile("s_waitcnt vmcnt(0)" ::: "memory");
          const LAS unsigned char* kb = kring + (ks & 3) * 4096;
          bf16x8 f[2][2];
#pragma unroll
          for (int cc = 0; cc < 2; ++cc)
#pragma unroll
              for (int k2 = 0; k2 < 2; ++k2) f[cc][k2] = *(const LAS bf16x8*)(kb + (16 * cc + r) * 128 + (((4 * k2 + g4) ^ (r & 7)) * 16));
          asm volatile("s_waitcnt lgkmcnt(0)" ::: "memory");
#pragma unroll
          for (int cc = 0; cc < 2; ++cc) { x[2 * ks + cc] = __builtin_amdgcn_mfma_f32_16x16x32_bf16(a0, f[cc][0], x[2 * ks + cc], 0, 0, 0); x[2 * ks + cc] = __builtin_amdgcn_mfma_f32_16x16x32_bf16(a1, f[cc][1], x[2 * ks + cc], 0, 0, 0); }
          if (st + 4 < NST) SP_KDMA(st + 4, ks & 3);
        } } }
#undef SP_KDMA
#pragma unroll
    for (int c = 0; c < NC; ++c) { const int slot = 16 * c + r; int mk; bool mv;
        if (IS_A) { mk = my_t - slot; mv = mk >= 0; } else { mk = sel[my_a * 256 + slot]; mv = slot < (my_a ? nv1 : nv0); }
        const int delta = my_t - mk; const bool ok = mv && delta >= 0;
        const int bk = (ok && delta < 512) ? (int)BKT[delta] : 31;
        const f32x4 b4 = *(const LAS f32x4*)(BIAS + bk * 16 + HB + 4 * my_j);
#pragma unroll
        for (int i = 0; i < 4; ++i) x[c][i] = ok ? x[c][i] * 0.125f + b4[i] : -INFINITY; }
    f32x4 mx = x[0];
#pragma unroll
    for (int c = 1; c < NC; ++c)
#pragma unroll
        for (int i = 0; i < 4; ++i) mx[i] = fmaxf(mx[i], x[c][i]);
#pragma unroll
    for (int o = 1; o < 16; o <<= 1)
#pragma unroll
        for (int i = 0; i < 4; ++i) mx[i] = fmaxf(mx[i], __shfl_xor(mx[i], o));
    f32x4 sk = {0.f, 0.f, 0.f, 0.f};
    if (IS_A) { sk = *(const f32x4*)(P.sinks + 4 * my_j);
#pragma unroll
        for (int i = 0; i < 4; ++i) mx[i] = fmaxf(mx[i], sk[i]); }
    f32x4 sum = {0.f, 0.f, 0.f, 0.f};
#pragma unroll
    for (int c = 0; c < NC; ++c)
#pragma unroll
        for (int i = 0; i < 4; ++i) { x[c][i] = __expf(x[c][i] - mx[i]); sum[i] += x[c][i]; }
#pragma unroll
    for (int o = 1; o < 16; o <<= 1)
#pragma unroll
        for (int i = 0; i < 4; ++i) sum[i] += __shfl_xor(sum[i], o);
    if (IS_A) {
#pragma unroll
        for (int i = 0; i < 4; ++i) sum[i] += __expf(sk[i] - mx[i]); }
    f32x4 inv;
#pragma unroll
    for (int i = 0; i < 4; ++i) inv[i] = 1.0f / sum[i];
#define SP_PWRITE(qa) do { if (my_a == (qa)) { _Pragma("unroll") for (int c_ = 0; c_ < NC; ++c_) _Pragma("unroll") for (int i_ = 0; i_ < 4; ++i_) \
        Pimg[(4 * my_j + i_) * NSLOT + 16 * c_ + r] = (unsigned short)f2bf(x[c_][i_] * inv[i_]); } } while (0)
    SP_PWRITE(0);
    const unsigned wl = wk + 4096u;
#define SP_VDMA(st, bufi) do { const int cb_ = (st) / KS, ks_ = (st) % KS, a_ = cb_ >> 1, j_ = cb_ & 1; unsigned vo_[4]; \
        _Pragma("unroll") for (int i_ = 0; i_ < 4; ++i_) { const int slot_ = 32 * ks_ + 8 * i_ + drow; int key_; \
            if (IS_A) { key_ = tA + a_ - slot_; key_ = key_ < 0 ? 0 : key_; } else { key_ = sel[a_ * 256 + slot_]; } \
            vo_[i_] = (unsigned)(((rb + key_) * 128 + KOFF + j_ * 64 + dpc * 8) * 2); } \
        sp_glds16s_x4(P.VAB, vo_[0], vo_[1], vo_[2], vo_[3], (unsigned)__builtin_amdgcn_readfirstlane((int)(wl + (unsigned)((bufi) * 4096)))); } while (0)
    asm volatile("s_waitcnt vmcnt(0)" ::: "memory");
    SP_VDMA(0, 0); SP_VDMA(1, 1); SP_VDMA(2, 2);
    f32x4 o[4];
#pragma unroll
    for (int db = 0; db < 4; ++db) o[db] = (f32x4){0.f, 0.f, 0.f, 0.f};
    const unsigned trb = (unsigned)((8 * g4 + ((lane & 15) >> 2)) * 128 + (lane & 3) * 8);
    int bufi = 0;
#pragma unroll 1
    for (int cb = 0; cb < 4; ++cb) { const bool minep = rcb == cb;
        if (cb == 2) { SP_PWRITE(1); }
#pragma unroll
        for (int ks = 0; ks < KS; ++ks) { const int st = cb * KS + ks;
            if (cb < 3 || ks + 2 < KS) asm volatile("s_waitcnt vmcnt(8)" ::: "memory"); else if (ks + 1 < KS) asm volatile("s_waitcnt vmcnt(4)" ::: "memory"); else asm volatile("s_waitcnt vmcnt(0)" ::: "memory");
            const unsigned vb = wl + (unsigned)(bufi * 4096) + trb;
            s16x4 lo[4], hi[4];
#pragma unroll
            for (int db = 0; db < 4; ++db) {
                asm volatile("ds_read_b64_tr_b16 %0, %1 offset:%c2" : "=&v"(lo[db]) : "v"(vb), "i"(db * 32) : "memory");
                asm volatile("ds_read_b64_tr_b16 %0, %1 offset:%c2" : "=&v"(hi[db]) : "v"(vb), "i"(db * 32 + 512) : "memory"); }
            bf16x8 pb = *(const LAS bf16x8*)(Pimg + (r & 7) * NSLOT + 32 * ks + 8 * g4);
            pb = minep ? pb : zz;
            asm volatile("s_waitcnt lgkmcnt(0)" ::: "memory");
#pragma unroll
            for (int db = 0; db < 4; ++db) { const bf16x8 va = {lo[db][0], lo[db][1], lo[db][2], lo[db][3], hi[db][0], hi[db][1], hi[db][2], hi[db][3]};
                o[db] = __builtin_amdgcn_mfma_f32_16x16x32_bf16(va, pb, o[db], 0, 0, 0); }
            if (st + 3 < NST) SP_VDMA(st + 3, bufi);
            bufi = bufi == 2 ? 0 : bufi + 1;
        } }
#undef SP_VDMA
#undef SP_PWRITE
    if (!dry) { bf16* gp = P.G + (size_t)(rb + tA + (r >> 3)) * 1536 + GOFF + (r & 7) * 64 + 4 * g4;
#pragma unroll
        for (int db = 0; db < 4; ++db) { const u32x2 gt = *(const u32x2*)(gp + 16 * db);
            const float g0 = __uint_as_float(gt.x << 16), g1 = __uint_as_float(gt.x & 0xffff0000u), g2 = __uint_as_float(gt.y << 16), g3 = __uint_as_float(gt.y & 0xffff0000u);
            u32x2 w; w.x = pk2(o[db][0] * g0, o[db][1] * g1); w.y = pk2(o[db][2] * g2, o[db][3] * g3);
            *(u32x2*)(gp + 16 * db) = w; } }
}
__device__ __forceinline__ void swa_dense(Frame& F, const BAParams& P, int rb, int t0, bool dry) {
    constexpr int NC = 10, NSLOT = 160, NST = 5;
    int lane_ = F.lane; asm volatile("" : "+v"(lane_)); const int lane = lane_, r = lane & 15, g4 = lane >> 4, j = F.wave >> 2, qg = F.wave & 3, kbase = t0 - 128;
    const LAS float* BIAS = (const LAS float*)(F.lds + BIAS_OFF);
    const LAS unsigned char* BKT = (const LAS unsigned char*)(F.lds + BKT_OFF);
    LAS unsigned short* Pimg = (LAS unsigned short*)(F.lds + RING_OFF + F.wave * 16384);
    bf16x8 qf[2]; { const bf16* qp = P.QA + (size_t)(rb + t0 + 4 * qg + (r >> 2)) * 512 + (4 * j + (r & 3)) * 64 + 8 * g4; qf[0] = *(const bf16x8*)qp; qf[1] = *(const bf16x8*)(qp + 32); }
    bf16x8 kf[NC][2];
#pragma unroll
    for (int c = 0; c < NC; ++c) { int key = kbase + 16 * c + r; key = key < 0 ? 0 : (key > SEQ - 1 ? SEQ - 1 : key);
        const bf16* kp = P.KAB + (size_t)(rb + key) * 128 + j * 64 + 8 * g4; kf[c][0] = *(const bf16x8*)kp; kf[c][1] = *(const bf16x8*)(kp + 32); }
    const int my_t = t0 + 4 * qg + g4;
    f32x4 x[NC];
#pragma unroll
    for (int c = 0; c < NC; ++c) { f32x4 d = {0.f, 0.f, 0.f, 0.f};
        d = __builtin_amdgcn_mfma_f32_16x16x32_bf16(qf[0], kf[c][0], d, 0, 0, 0); d = __builtin_amdgcn_mfma_f32_16x16x32_bf16(qf[1], kf[c][1], d, 0, 0, 0);
        const int key = kbase + 16 * c + r, delta = my_t - key; const bool ok = key >= 0 && delta >= 0 && delta < 128;
        const int bk = (int)BKT[ok ? delta : 0];
        const f32x4 b4 = *(const LAS f32x4*)(BIAS + bk * 16 + 4 * j);
#pragma unroll
        for (int i = 0; i < 4; ++i) x[c][i] = ok ? d[i] * 0.125f + b4[i] : -INFINITY; }
    f32x4 mx = *(const f32x4*)(P.sinks + 4 * j); const f32x4 sk = mx;
#pragma unroll
    for (int c = 0; c < NC; ++c)
#pragma unroll
        for (int i = 0; i < 4; ++i) mx[i] = fmaxf(mx[i], x[c][i]);
#pragma unroll
    for (int o = 1; o < 16; o <<= 1)
#pragma unroll
        for (int i = 0; i < 4; ++i) mx[i] = fmaxf(mx[i], __shfl_xor(mx[i], o));
    f32x4 sum = {0.f, 0.f, 0.f, 0.f};
#pragma unroll
    for (int c = 0; c < NC; ++c)
#pragma unroll
        for (int i = 0; i < 4; ++i) { x[c][i] = __expf(x[c][i] - mx[i]); sum[i] += x[c][i]; }
#pragma unroll
    for (int o = 1; o < 16; o <<= 1)
#pragma unroll
        for (int i = 0; i < 4; ++i) sum[i] += __shfl_xor(sum[i], o);
    f32x4 inv;
#pragma unroll
    for (int i = 0; i < 4; ++i) inv[i] = 1.0f / (sum[i] + __expf(sk[i] - mx[i]));
#pragma unroll
    for (int c = 0; c < NC; ++c)
#pragma unroll
        for (int i = 0; i < 4; ++i) Pimg[(4 * g4 + i) * NSLOT + 16 * c + r] = (unsigned short)f2bf(x[c][i] * inv[i]);
    const unsigned wl = (unsigned)__builtin_amdgcn_readfirstlane((int)((unsigned)(uintptr_t)(F.lds + RING_OFF) + (unsigned)F.wave * 16384u + 8192u));
    const int drow = lane >> 3, dpc = lane & 7;
#define SW_VDMA(st) do { unsigned vo_[4]; \
        _Pragma("unroll") for (int i_ = 0; i_ < 4; ++i_) { int key_ = kbase + 32 * (st) + 8 * i_ + drow; key_ = key_ < 0 ? 0 : (key_ > SEQ - 1 ? SEQ - 1 : key_); vo_[i_] = (unsigned)(((rb + key_) * 128 + j * 64 + dpc * 8) * 2); } \
        sp_glds16s_x4(P.VAB, vo_[0], vo_[1], vo_[2], vo_[3], (unsigned)__builtin_amdgcn_readfirstlane((int)(wl + (unsigned)(((st) & 1) * 4096)))); } while (0)
    asm volatile("s_waitcnt vmcnt(0)" ::: "memory");
    SW_VDMA(0); SW_VDMA(1);
    f32x4 o[4];
#pragma unroll
    for (int db = 0; db < 4; ++db) o[db] = (f32x4){0.f, 0.f, 0.f, 0.f};
    const unsigned trb = (unsigned)((8 * g4 + ((lane & 15) >> 2)) * 128 + (lane & 3) * 8);
#pragma unroll
    for (int st = 0; st < NST; ++st) {
        if (st + 1 < NST) asm volatile("s_waitcnt vmcnt(4)" ::: "memory"); else asm volatile("s_waitcnt vmcnt(0)" ::: "memory");
        const unsigned vb = wl + (unsigned)((st & 1) * 4096) + trb;
        s16x4 lo[4], hi[4];
#pragma unroll
        for (int db = 0; db < 4; ++db) {
            asm volatile("ds_read_b64_tr_b16 %0, %1 offset:%c2" : "=&v"(lo[db]) : "v"(vb), "i"(db * 32) : "memory");
            asm volatile("ds_read_b64_tr_b16 %0, %1 offset:%c2" : "=&v"(hi[db]) : "v"(vb), "i"(db * 32 + 512) : "memory"); }
        const bf16x8 pb = *(const LAS bf16x8*)(Pimg + r * NSLOT + 32 * st + 8 * g4);
        asm volatile("s_waitcnt lgkmcnt(0)" ::: "memory");
#pragma unroll
        for (int db = 0; db < 4; ++db) { const bf16x8 va = {lo[db][0], lo[db][1], lo[db][2], lo[db][3], hi[db][0], hi[db][1], hi[db][2], hi[db][3]};
            o[db] = __builtin_amdgcn_mfma_f32_16x16x32_bf16(va, pb, o[db], 0, 0, 0); }
        if (st + 2 < NST) SW_VDMA(st + 2);
    }
#undef SW_VDMA
    if (!dry) { bf16* gp = P.G + (size_t)(rb + t0 + 4 * qg + (r >> 2)) * 1536 + (4 * j + (r & 3)) * 64 + 4 * g4;
#pragma unroll
        for (int db = 0; db < 4; ++db) { const u32x2 gt = *(const u32x2*)(gp + 16 * db);
            const float g0 = __uint_as_float(gt.x << 16), g1 = __uint_as_float(gt.x & 0xffff0000u), g2 = __uint_as_float(gt.y << 16), g3 = __uint_as_float(gt.y & 0xffff0000u);
            u32x2 w; w.x = pk2(o[db][0] * g0, o[db][1] * g1); w.y = pk2(o[db][2] * g2, o[db][3] * g3);
            *(u32x2*)(gp + 16 * db) = w; } }
}
__device__ __forceinline__ void ba_clear(Frame& F) {
    LAS v4u* hz = (LAS v4u*)(F.lds + RING_OFF + F.wave * 16384);
#pragma unroll
    for (int i = 0; i < 16; ++i) hz[F.lane + 64 * i] = (v4u){0u, 0u, 0u, 0u};
    if (F.tid < 32) ((LAS unsigned*)(F.lds + MISC_OFF))[F.tid] = 0u;
    for (int i = F.tid; i < 16 * 64; i += 512) ((LAS unsigned*)(F.lds + H2_OFF))[i] = 0u;
}
__device__ __forceinline__ void ba_unit(Frame& F, const BAParams& P, int b, int tau, bool dry) {
    { int l_ = (int)__builtin_amdgcn_mbcnt_hi(~0u, __builtin_amdgcn_mbcnt_lo(~0u, 0u)); asm volatile("" : "+v"(l_)); F.lane = l_; F.tid = F.wave * 64 + l_; }
    const int t0 = tau * 16, rb = b * SEQ, lane = F.lane;
    LAS unsigned* misc = (LAS unsigned*)(F.lds + MISC_OFF);
    for (int ri = 0; ri < REP_IDX; ++ri)
    if (tau >= 16) {
        if (ri) { __syncthreads(); ba_clear(F); __syncthreads(); }
        bf16x8 bq[4]; const int r = lane & 15, g4 = lane >> 4;
#pragma unroll
        for (int h = 0; h < 4; ++h) bq[h] = *(const bf16x8*)(P.IQ + (size_t)(rb + t0 + r) * 128 + h * 32 + 8 * g4);
        const f32x4 w4 = *(const f32x4*)(P.IW + (size_t)(rb + t0 + r) * 4);
        const bf16* IKb = P.IK + (size_t)rb * 32;
        idx_pass<1>(F, IKb, bq, w4, tau, t0);
        __syncthreads();
        idx_threshold(F);
        __syncthreads();
        idx_pass<2>(F, IKb, bq, w4, tau, t0);
        __syncthreads();
        idx_resolve(F);
    } else {
        LAS unsigned short* sel = (LAS unsigned short*)(F.lds + SEL_OFF);
        for (int i = F.tid; i < 16 * 256; i += 512) sel[i] = (unsigned short)(i & 255);
    }
    __syncthreads();
    const int tA = t0 + 2 * F.wave, nv0 = tA >= 256 ? 256 : tA + 1, nv1 = tA + 1 >= 256 ? 256 : tA + 2;
    for (int rs = 0; rs < REP_SPB; ++rs) sparse_pair<false>(F, P, rb, tA, 2 * F.wave, nv0, nv1, dry || rs + 1 < REP_SPB);
    for (int rs = 0; rs < REP_SPA; ++rs) swa_dense(F, P, rb, t0, dry || rs + 1 < REP_SPA);
    ba_clear(F);
}

#ifndef REP_P1A
#define REP_P1A 1
#endif
#ifndef REP_C
#define REP_C 1
#endif
#ifndef REP_BA
#define REP_BA 1
#endif
#ifndef REP_P1B
#define REP_P1B 1
#endif
#ifndef REP_P3
#define REP_P3 1
#endif
#ifndef REP_P0
#define REP_P0 1
#endif
#ifndef FOX_SKIP_LOG2
#define FOX_SKIP_LOG2 (-80.0f)
#endif
#ifndef MK_ONE_LAUNCH
#define MK_ONE_LAUNCH 1
#endif
constexpr int NPHASES = 1 + 6 * DEPTH;
struct Args { const float* in[9]; float* out; unsigned char* ws; int ph_lo, ph_hi; };
static_assert(sizeof(Args) == 9 * 8 + 8 + 8 + 4 + 4, "no padding bytes in the argument struct");

typedef const __attribute__((address_space(4))) Args* ArgP;
__device__ __forceinline__ ArgP argp() { ArgP p = (ArgP)__builtin_amdgcn_kernarg_segment_ptr(); asm volatile("" : "+s"(p)); return p; }
__global__ void __launch_bounds__(512, 2) mk_fwd(Args args) {
    extern __shared__ __attribute__((aligned(16))) unsigned char lds[];
    Frame F;
    F.lds = (LAS unsigned char*)lds;
    if ((unsigned)(uintptr_t)F.lds != 0u) return;
    F.MISC = (volatile LAS unsigned*)(F.lds + MISC_OFF);
    F.tid = threadIdx.x; F.lane = F.tid & 63; F.wave = __builtin_amdgcn_readfirstlane(F.tid >> 6);
    F.G = gridDim.x; { const int bx = blockIdx.x; F.vcu = (F.G % 8 == 0) ? (bx % 8) * (F.G / 8) + bx / 8 : bx; }
    F.ctl = (gu32*)(argp()->ws + WS_CTL);
    for (int u = F.tid; u < 256; u += 512) ((LAS unsigned*)(F.lds + MISC_OFF))[u] = 0u;
    for (int u = F.tid; u < 512; u += 512) { ((LAS float*)(F.lds + BIAS_OFF))[u] = argp()->in[8][u];
        int bk; if (u < 16) bk = u; else { const float nf = (float)u; int lg = 16 + (int)(logf(nf / 16.0f) / 3.4657359027997265f * 16.0f); bk = lg < 31 ? lg : 31; }
        ((LAS unsigned char*)(F.lds + BKT_OFF))[u] = (unsigned char)bk; }
    __syncthreads();
    XcdBarrier bar; bar.bar = (unsigned*)(F.ctl + CW_BAR); bar.x = 0; bar.st = nullptr;
    if (MK_ONE_LAUNCH) bar = xcd_barrier_post((unsigned*)(F.ctl + CW_BAR), F.MISC + MW_BAR);
    const int lo = argp()->ph_lo, hi = argp()->ph_hi;
#define IN(k) (lo <= (k) && (k) < hi)
#define SEAM(k) do { if (IN(k) && IN((k) + 1)) xcd_barrier(bar); } while (0)
#define PHASE_BEGIN() do { int l_ = (int)__builtin_amdgcn_mbcnt_hi(~0u, __builtin_amdgcn_mbcnt_lo(~0u, 0u)); asm volatile("" : "+v"(l_)); F.lane = l_; F.tid = F.wave * 64 + l_; } while (0)

    if (IN(0)) { PHASE_BEGIN(); ArgP a = argp(); for (int rp = 0; rp < REP_P0; ++rp) p0_prologue(F, a->in[0], a->in[1], a->in[2], a->in[6], a->in[7], a->ws); SEAM(0); }

    for (int L = 0; L < DEPTH; ++L) {
        const int pb = 1 + 6 * L;
        if (IN(pb)) { PHASE_BEGIN();
            unsigned char* ws = argp()->ws; const pg8::bf16_t* W1T = (const pg8::bf16_t*)(ws + WS_W1T) + (size_t)L * NTILES * 256 * 1024;
            pg8::Gemm g{(const pg8::bf16_t*)(ws + WS_XB), W1T, M, NT_A * 256, 1024, 1024, 1024, 0}; pg8::StaticOrder S; S.init(M, NT_A * 256, F.G, (int)blockIdx.x);
            pg8::EpiIn E{ws, argp()->in[4] + L * 384, argp()->in[3] + L * 8};
            for (int rp = 0; rp < REP_P1A; ++rp) pg8::gemm_phase<pg8::EpiIn, pg8::StaticOrder, true, true>(F.lds + RING_OFF, g, S, E, F.wave);
            SEAM(pb);
        }
        if (IN(pb + 2)) { PHASE_BEGIN();
            unsigned char* ws = argp()->ws;
            const float* CL = (const float*)(ws + WS_CL); const float* CT = (const float*)(ws + WS_CT);
            LAS float* carry = (LAS float*)(F.lds + H2_OFF)  ; LAS unsigned* nbw = (LAS unsigned*)(F.lds + RING_OFF + NB_OFF);
            for (int rp = 0; rp < REP_C; ++rp) {
            LAS unsigned* miscw = (LAS unsigned*)(F.lds + MISC_OFF);
            for (int kg = 0; kg < 8; ++kg) { const int xg = ((F.vcu >> 5) + kg) & 7;
            gu32* const tick = F.ctl + CW_TICK + 64 * (8 * (2 * L + rp % 2) + xg);
            if (F.tid == 0) miscw[MW_TICKET] = __hip_atomic_fetch_add(tick, 1u, RLX_AGENT);
            __syncthreads();
            for (;;) {
                PHASE_BEGIN();
                const int ui = (int)miscw[MW_TICKET];
                if (ui >= 128) { __syncthreads(); break; }
                const int qb = 31 - (ui >> 2), bh = 4 * xg + (ui & 3);
                    if (F.wave == 0) { const float t0 = CT[bh * 128 + 2 * F.lane], t1 = CT[bh * 128 + 2 * F.lane + 1]; const float inc = wave_incl_scan(t0 + t1, F.lane); carry[2 * F.lane] = inc - (t0 + t1); carry[2 * F.lane + 1] = inc - t1; }
                    __syncthreads();
                    const float cref = carry[4 * qb]; int tskip;
                    { const float* gq = argp()->in[4] + L * 384 + 256; const float g1 = fabsf(gq[F.lane]), g2 = fabsf(gq[64 + F.lane]); float mq = g1, mk = g2;
#pragma unroll
                      for (int o = 1; o < 64; o <<= 1) { mq = fmaxf(mq, __shfl_xor(mq, o)); mk = fmaxf(mk, __shfl_xor(mk, o)); }
                      const float thr = FOX_SKIP_LOG2 - 2.0f * (11.8f * mq * mk + 0.5f);
                      const int NTt = 4 * (qb + 1); const int t_a = F.lane, t_b = 64 + F.lane, k_a = 64 * t_a + 63, k_b = 64 * t_b + 63;
                      const float n_a = t_a < NTt ? (cref - (carry[k_a >> 6] + CL[(size_t)bh * SEQ + k_a])) * 1.4426950408889634f : 0.f, n_b = t_b < NTt ? (cref - (carry[k_b >> 6] + CL[(size_t)bh * SEQ + k_b])) * 1.4426950408889634f : 0.f;
                      const bool s_a = t_a < NTt && n_a < thr, s_b = t_b < NTt && n_b < thr;
                      const unsigned long long f_a = __ballot(!s_a), f_b = __ballot(!s_b);
                      int cnt = f_a ? (int)__builtin_ctzll(f_a) : 64 + (f_b ? (int)__builtin_ctzll(f_b) : 64);
                      cnt &= ~1; tskip = cnt > NTt - 4 ? NTt - 4 : cnt; }
                    { const int nk = 256 * (qb + 1);
                      for (int k = 64 * tskip + F.tid; k < nk; k += 512) { const float xb = (cref - (carry[k >> 6] + CL[(size_t)bh * SEQ + k])) * 1.4426950408889634f;
                          const unsigned h = f2bf(xb), l = f2bf(xb - __uint_as_float(h << 16)); nbw[k] = h | (l << 16); } }
                    __syncthreads();
                    attn_body::attn_unit<8>(bh >> 3, bh & 7, qb, (const attn_body::bf16*)(ws + WS_QC), (const attn_body::bf16*)(ws + WS_KC), (const attn_body::bf16*)(ws + WS_VC), (attn_body::bf16*)(ws + WS_G),
                                            (char*)lds + RING_OFF, (attn_body::lds_cuptr)(F.lds + RING_OFF + NB_OFF), tskip, rp + 1 < REP_C, F.wave);
                if (F.tid == 0) miscw[MW_TICKET] = __hip_atomic_fetch_add(tick, 1u, RLX_AGENT);
                __syncthreads();
            } } }
            __syncthreads(); PHASE_BEGIN();
            const BAParams P{(const bf16*)(ws + WS_IQ), (const bf16*)(ws + WS_IK), (const float*)(ws + WS_IW), (const bf16*)(ws + WS_QA), (const bf16*)(ws + WS_QB), (const bf16*)(ws + WS_KAB), (const bf16*)(ws + WS_VAB),
                             (bf16*)(ws + WS_G), argp()->in[5] + L * 8};
            for (int rp = 0; rp < REP_BA; ++rp) {
            LAS unsigned* miscw = (LAS unsigned*)(F.lds + MISC_OFF);
            for (int kg = 0; kg < 4; ++kg) { const int bq = ((F.vcu >> 6) + kg) & 3;
            gu32* const tick = F.ctl + CW_TICK + 64 * (32 + 4 * (2 * L + rp % 2) + bq);
            ba_clear(F);
            if (F.tid == 0) miscw[MW_TICKET] = __hip_atomic_fetch_add(tick, 1u, RLX_AGENT);
            __syncthreads();
            for (;;) {
                PHASE_BEGIN();
                const int ui = (int)miscw[MW_TICKET];
                if (ui >= 512) { __syncthreads(); break; }
                ba_unit(F, P, bq, 511 - ui, rp + 1 < REP_BA);
                if (F.tid == 0) miscw[MW_TICKET] = __hip_atomic_fetch_add(tick, 1u, RLX_AGENT);
                __syncthreads();
            } } }
            SEAM(pb + 2);
        }
        if (IN(pb + 3)) { PHASE_BEGIN();
            unsigned char* ws = argp()->ws; const pg8::bf16_t* W1T = (const pg8::bf16_t*)(ws + WS_W1T) + (size_t)L * NTILES * 256 * 1024;
            pg8::Gemm g{(const pg8::bf16_t*)(ws + WS_XB), W1T + (size_t)NT_A * 256 * 1024, M, NT_B * 256, 1024, 1024, 1024, 0}; pg8::StaticOrder S; S.init(M, NT_B * 256, F.G, (int)blockIdx.x);
            pg8::EpiGate E{(const float*)(ws + WS_SSQ), (unsigned char*)(ws + WS_MG)};
            for (int rp = 0; rp < REP_P1B; ++rp) pg8::gemm_phase<pg8::EpiGate, pg8::StaticOrder, true, true>(F.lds + RING_OFF, g, S, E, F.wave);
            SEAM(pb + 3);
        }
        if (IN(pb + 4)) { PHASE_BEGIN();
            unsigned char* ws = argp()->ws;
            pg8::Gemm g{(const pg8::bf16_t*)(ws + WS_G), (const pg8::bf16_t*)(ws + WS_WBT) + (size_t)L * 3 * 1024 * 512, M, 1024, 512, 1536, 512, 4};
            pg8::SegOrder S; S.base.init(M, 1024, F.G, (int)blockIdx.x);
            pg8::EpiMerge E{(const unsigned char*)(ws + WS_MG), (pg8::bf16_t*)(ws + WS_MERGED)};
            for (int rp = 0; rp < REP_P3; ++rp) pg8::gemm_phase<pg8::EpiMerge, pg8::SegOrder, true, true>(F.lds + RING_OFF, g, S, E, F.wave);
            SEAM(pb + 4);
        }
        if (IN(pb + 5)) { PHASE_BEGIN();
            unsigned char* ws = argp()->ws; float* const outp = argp()->out;
            pg8::Gemm g{(const pg8::bf16_t*)(ws + WS_MERGED), (const pg8::bf16_t*)(ws + WS_WOT) + (size_t)L * 1024 * 1024, M, 1024, 1024, 1024, 1024, 0}; pg8::StaticOrder S; S.init(M, 1024, F.G, (int)blockIdx.x);
            const bool last = (L == DEPTH - 1);
            unsigned poison = 0u;
            if (last) poison = (__hip_atomic_load(F.ctl + CW_OVF, RLX_AGENT) != 0u) | (__hip_atomic_load(F.ctl + CW_BAR + XB_TMO, RLX_AGENT) != 0u);
            pg8::EpiOut E{L == 0 ? argp()->in[0] : (const float*)outp, outp, last ? nullptr : (pg8::bf16_t*)(ws + WS_XB), last ? nullptr : (float*)(ws + WS_SSQ), poison};
            pg8::gemm_phase<pg8::EpiOut, pg8::StaticOrder, true, true>(F.lds + RING_OFF, g, S, E, F.wave);
            if (!last) SEAM(pb + 5);
        }
    }
#undef IN
#undef SEAM
}

extern "C" void kernel_launch(void* const* d_in, const int* in_sizes, int n_in, void* d_out, int out_size, void* d_ws, size_t ws_size, hipStream_t stream) {
    static int grid = 0;
    if (grid == 0) {
        if (n_in != 9 || in_sizes[0] != M * DMODEL || out_size != M * DMODEL || ws_size < WS_END) { fprintf(stderr, "kernel_launch: unexpected shapes / workspace (n_in %d, in0 %d, out %d, ws %zu < %zu); nothing launched\n", n_in, n_in > 0 ? in_sizes[0] : -1, out_size, ws_size, (size_t)WS_END); grid = -1; return; }
        int dev = 0, cus = 0, per_cu = 0;
        if (hipGetDevice(&dev) != hipSuccess || hipDeviceGetAttribute(&cus, hipDeviceAttributeMultiprocessorCount, dev) != hipSuccess) { grid = -1; return; }
        if (hipFuncSetAttribute((const void*)mk_fwd, hipFuncAttributeMaxDynamicSharedMemorySize, LDS_BYTES) != hipSuccess) { fprintf(stderr, "kernel_launch: hipFuncSetAttribute failed\n"); grid = -1; return; }
        if (hipOccupancyMaxActiveBlocksPerMultiprocessor(&per_cu, (const void*)mk_fwd, 512, LDS_BYTES) != hipSuccess || per_cu < 1) fprintf(stderr, "kernel_launch: occupancy query reports %d workgroups per CU\n", per_cu);
        (void)hipGetLastError();
        grid = cus;
    }
    if (grid < 0) return;
    if (hipMemsetAsync((char*)d_ws + WS_CTL, 0, CTL_ZERO_BYTES, stream) != hipSuccess) return;
    Args a{};
    for (int i = 0; i < 9; ++i) a.in[i] = (const float*)d_in[i];
    a.out = (float*)d_out; a.ws = (unsigned char*)d_ws;
#if MK_ONE_LAUNCH
    a.ph_lo = 0; a.ph_hi = NPHASES;
    hipLaunchKernelGGL(mk_fwd, dim3(grid), dim3(512), LDS_BYTES, stream, a);
#else
    for (int p = 0; p < NPHASES; ++p) { a.ph_lo = p; a.ph_hi = p + 1; hipLaunchKernelGGL(mk_fwd, dim3(grid), dim3(512), LDS_BYTES, stream, a); }
#endif
}
```

```cpp
#include <hip/hip_runtime.h>
#include <cstdio>
#include <cstdint>
#include <cmath>
namespace pg8 {
#define PG8_LAS __attribute__((address_space(3)))
typedef unsigned short bf16_t;
typedef short bf16x8 __attribute__((ext_vector_type(8)));
typedef float f32x4 __attribute__((ext_vector_type(4)));
typedef unsigned u32x4 __attribute__((ext_vector_type(4)));
constexpr int BM = 256, BK = 64, HALF = 128, HTB = HALF * BK * 2  , STAGE_BYTES = 8 * HTB, NXCD = 8, WGM = 8;

__host__ __device__ __forceinline__ int lds_byte(int r, int c) { const int st = (r >> 4) * 2 + (c >> 5), rr = r & 15, cc = c & 31, ob = rr * 64 + cc * 2; return st * 1024 + (ob ^ (((ob >> 9) & 1) << 5)); }
__host__ __device__ __forceinline__ void stage_rc(int b, int& R, int& C) { const int st = b / 1024, sb = b % 1024, swz = sb ^ (((sb >> 9) & 1) << 5); R = (st >> 1) * 16 + swz / 64; C = (st & 1) * 32 + (swz % 64) / 2; }
__host__ __device__ __forceinline__ int perm32(int rho) { const int n = rho >> 4, i = rho & 15; return 8 * (i >> 2) + 4 * n + (i & 3); }

struct Unit { int pm, pn, seg; };
struct Gemm { const bf16_t* A; const bf16_t* Bt; int M, N, K, lda, ldb, segN; };

struct StaticOrder {
    int nM, nN, nwg, G, c;
    __host__ __device__ void init(int M, int N, int G_, int c_) { nM = M / BM; nN = N / BM; nwg = nM * nN; G = G_; c = c_; }
    __host__ __device__ bool next(int i, Unit& u) const {
        const long L = (long)i * G + c; if (L >= nwg) return false;
        int wgid = (int)L; { const int q = nwg / NXCD, r = nwg % NXCD, xcd = wgid % NXCD, off = wgid / NXCD; wgid = (xcd < r ? xcd * (q + 1) : r * (q + 1) + (xcd - r) * q) + off; }
        const int nig = WGM * nN, gid = wgid / nig, fm = gid * WGM, gsz = (nM - fm) < WGM ? (nM - fm) : WGM;
        u.pm = fm + ((wgid % nig) % gsz); u.pn = (wgid % nig) / gsz; u.seg = 0; return true;
    }
    __device__ __forceinline__ void a_ready(const Unit&) const {}
    __device__ __forceinline__ void done(const Unit&) const {}
};

__device__ __forceinline__ unsigned cvt_pk_bf16(float lo, float hi) { unsigned r; asm volatile("v_cvt_pk_bf16_f32 %0, %1, %2" : "=v"(r) : "v"(lo), "v"(hi)); return r; }
constexpr size_t EWS_MiB = 1u << 20, EWS_SSQ = 43 * EWS_MiB, EWS_CL = 45 * EWS_MiB, EWS_CT = 46 * EWS_MiB, EWS_IW = 47 * EWS_MiB, EWS_CF = 47 * EWS_MiB + 512 * 1024, EWS_IQ = 49 * EWS_MiB, EWS_IK = 57 * EWS_MiB, EWS_G = 188 * EWS_MiB,
    EWS_QA = 284 * EWS_MiB, EWS_QB = 316 * EWS_MiB, EWS_QC = 348 * EWS_MiB, EWS_KC = 380 * EWS_MiB, EWS_VC = 412 * EWS_MiB, EWS_KAB = 444 * EWS_MiB, EWS_VAB = 460 * EWS_MiB;

constexpr float C2Q = 0.125f * 1.4426950408889634f;
__device__ __forceinline__ float fast_sigmoid(float x) { return __builtin_amdgcn_rcpf(1.0f + __expf(-x)); }
__device__ __forceinline__ u32x4 pack8(const f32x4 a, const f32x4 b) { u32x4 w; w.x = cvt_pk_bf16(a[0], a[1]); w.y = cvt_pk_bf16(a[2], a[3]); w.z = cvt_pk_bf16(b[0], b[1]); w.w = cvt_pk_bf16(b[2], b[3]); return w; }
__device__ __forceinline__ void unpack8(const u32x4 w, f32x4& a, f32x4& b) {
    a[0] = __uint_as_float(w.x << 16); a[1] = __uint_as_float(w.x & 0xffff0000u); a[2] = __uint_as_float(w.y << 16); a[3] = __uint_as_float(w.y & 0xffff0000u);
    b[0] = __uint_as_float(w.z << 16); b[1] = __uint_as_float(w.z & 0xffff0000u); b[2] = __uint_as_float(w.w << 16); b[3] = __uint_as_float(w.w & 0xffff0000u); }
#define EPI_PIN() asm volatile("" ::: "memory")
__device__ __forceinline__ void rows_rstd(const float* ssq, int row0, int fq, float (&rs)[2][4]) {
    f32x4 pr[2][4];
#pragma unroll
    for (int ai = 0; ai < 2; ++ai)
#pragma unroll
        for (int m = 0; m < 4; ++m) pr[ai][m] = *(const f32x4*)(ssq + (size_t)(row0 + ai * HALF + m * 16) * 16 + 4 * fq);
    EPI_PIN();
#pragma unroll
    for (int ai = 0; ai < 2; ++ai)
#pragma unroll
        for (int m = 0; m < 4; ++m) { const f32x4 a = pr[ai][m]; float t = (a[0] + a[1]) + (a[2] + a[3]); t += __shfl_xor(t, 16); t += __shfl_xor(t, 32); rs[ai][m] = __builtin_amdgcn_rsqf(t * (1.0f / 1024.0f) + 1e-6f); }
}
struct EpiIn {
    static constexpr bool PERM = true, AFTER_DRAIN = false;
    unsigned char* ws; const float* qkg; const float* bfg;
    __device__ __forceinline__ bool keep(const Unit&) const { return false; }
    __device__ __forceinline__ void operator()(f32x4 (&acc)[2][2][4][2], const Unit& u, int wr, int wc, int fr, int fq) const {
        const int row0 = u.pm * BM + wr * 64 + fr, t = u.pn, lc0 = wc * 64 + fq * 8;
        float rs[2][4]; rows_rstd((const float*)(ws + EWS_SSQ), row0, fq, rs);
        if (t == 18) {
            bf16_t* IQ = (bf16_t*)(ws + EWS_IQ); bf16_t* IK = (bf16_t*)(ws + EWS_IK); float* IW = (float*)(ws + EWS_IW);
#pragma unroll
            for (int ai = 0; ai < 2; ++ai)
#pragma unroll
                for (int m = 0; m < 4; ++m) { const int row = row0 + ai * HALF + m * 16; const float f = rs[ai][m];
#pragma unroll
                    for (int bj = 0; bj < 2; ++bj) { const int lc = lc0 + 32 * bj; const f32x4 v0 = acc[ai][bj][m][0] * f, v1 = acc[ai][bj][m][1] * f;
                        if (lc < 128) *(u32x4*)(IQ + (size_t)row * 128 + lc) = pack8(v0, v1);
                        else if (lc < 160) *(u32x4*)(IK + (size_t)row * 32 + (lc - 128)) = pack8(v0, v1);
                        else if (lc == 160) *(f32x4*)(IW + (size_t)row * 4) = v0 * 0.08838834764831845f; } }
            int ln_ = (int)__builtin_amdgcn_mbcnt_hi(~0u, __builtin_amdgcn_mbcnt_lo(~0u, 0u)); asm volatile("" : "+v"(ln_));
            if (wc == 2 && (ln_ >> 4) < 2) { const int fql = ln_ >> 4, frl = ln_ & 15;
                float* CL = (float*)(ws + EWS_CL); float* CT = (float*)(ws + EWS_CT); const int hb = 4 * fql; const f32x4 bfv = *(const f32x4*)(bfg + hb);
#pragma unroll
                for (int ai = 0; ai < 2; ++ai) { f32x4 run = {0.f, 0.f, 0.f, 0.f};
#pragma unroll
                    for (int m = 0; m < 4; ++m) { const int row = row0 + ai * HALF + m * 16; const f32x4 z = (fql == 0 ? acc[ai][1][m][1] : acc[ai][1][m][0]) * rs[ai][m] + bfv; f32x4 lf;
#pragma unroll
                        for (int e = 0; e < 4; ++e) lf[e] = (z[e] < 0.f ? z[e] : 0.f) - __logf(1.0f + __expf(-fabsf(z[e])));
#pragma unroll
                        for (int o = 1; o < 16; o <<= 1)
#pragma unroll
                            for (int e = 0; e < 4; ++e) { const float tt = __shfl_up(lf[e], o, 16); if (frl >= o) lf[e] += tt; }
                        const f32x4 cs = lf + run;
                        const int bb = row >> 13, ss = row & 8191;
#pragma unroll
                        for (int e = 0; e < 4; ++e) CL[(size_t)(bb * 8 + hb + e) * 8192 + ss] = cs[e];
#pragma unroll
                        for (int e = 0; e < 4; ++e) run[e] += __shfl(lf[e], 15, 16); }
                    if (frl == 15) { const int row = row0 + ai * HALF, bb = row >> 13, ch = (row & 8191) >> 6;
#pragma unroll
                        for (int e = 0; e < 4; ++e) CT[(bb * 8 + hb + e) * 128 + ch] = run[e]; } } }
            return;
        }
        bf16_t* dst; int ldc, colbase; const float* gp = qkg; float csc = 1.f; bool norm = false, act = false;
        if (t < 6) { const int mx = t >> 1; dst = (bf16_t*)(ws + (mx == 0 ? EWS_QA : (mx == 1 ? EWS_QB : EWS_QC))); ldc = 512; colbase = (t & 1) * 256; norm = true; gp = qkg + (mx * 2 + 0) * 64; csc = (mx == 2) ? C2Q : 1.f; }
        else if (t == 6) { dst = (bf16_t*)(ws + EWS_KAB); ldc = 128; colbase = (wc >> 1) * (32768 * 128 - 128); norm = true;     gp = qkg + ((wc >> 1) * 2 + 1) * 64; }
        else if (t < 9) { dst = (bf16_t*)(ws + EWS_KC); ldc = 512; colbase = (t - 7) * 256; norm = true; gp = qkg + (2 * 2 + 1) * 64; }
        else if (t == 9) { dst = (bf16_t*)(ws + EWS_VAB); ldc = 128; colbase = (wc >> 1) * (32768 * 128 - 128); }
        else if (t < 12) { dst = (bf16_t*)(ws + EWS_VC); ldc = 512; colbase = (t - 10) * 256; }
        else { dst = (bf16_t*)(ws + EWS_G); ldc = 1536; colbase = (t - 12) * 256; act = true; }
        f32x4 gv[2][2];
#pragma unroll
        for (int bj = 0; bj < 2; ++bj)
#pragma unroll
            for (int n = 0; n < 2; ++n) gv[bj][n] = norm ? *(const f32x4*)(gp + 8 * fq + 32 * bj + 4 * n) * csc : (f32x4){1.f, 1.f, 1.f, 1.f};
        EPI_PIN();
#pragma unroll
        for (int ai = 0; ai < 2; ++ai)
#pragma unroll
            for (int m = 0; m < 4; ++m) { const int row = row0 + ai * HALF + m * 16; float f = rs[ai][m];
                if (norm) { float ss = 0.f;
#pragma unroll
                    for (int bj = 0; bj < 2; ++bj)
#pragma unroll
                        for (int n = 0; n < 2; ++n) { const f32x4 x = acc[ai][bj][m][n]; ss += (x[0] * x[0] + x[1] * x[1]) + (x[2] * x[2] + x[3] * x[3]); }
                    ss += __shfl_xor(ss, 16); ss += __shfl_xor(ss, 32);
                    f = f * __builtin_amdgcn_rsqf(f * f * ss * (1.0f / 64.0f) + 1e-6f); }
                bf16_t* rowp = dst + (size_t)row * ldc + colbase + lc0;
#pragma unroll
                for (int bj = 0; bj < 2; ++bj) { f32x4 v0 = acc[ai][bj][m][0] * f * gv[bj][0], v1 = acc[ai][bj][m][1] * f * gv[bj][1];
                    if (act) {
#pragma unroll
                        for (int e = 0; e < 4; ++e) { v0[e] = v0[e] * fast_sigmoid(v0[e]); v1[e] = v1[e] * fast_sigmoid(v1[e]); } }
                    *(u32x4*)(rowp + 32 * bj) = pack8(v0, v1); } }
    }
};
typedef unsigned u32x2e __attribute__((ext_vector_type(2)));
__device__ __forceinline__ unsigned gate_q4(const f32x4 v) { unsigned w = 0u;
    w = __builtin_amdgcn_cvt_pk_u8_f32(fmaxf(255.0f * fast_sigmoid(v[0]), 1.0f), 0, w); w = __builtin_amdgcn_cvt_pk_u8_f32(fmaxf(255.0f * fast_sigmoid(v[1]), 1.0f), 1, w);
    w = __builtin_amdgcn_cvt_pk_u8_f32(fmaxf(255.0f * fast_sigmoid(v[2]), 1.0f), 2, w); w = __builtin_amdgcn_cvt_pk_u8_f32(fmaxf(255.0f * fast_sigmoid(v[3]), 1.0f), 3, w); return w; }
__device__ __forceinline__ f32x4 gate_f4(const unsigned w) { return (f32x4){(float)(w & 0xffu), (float)((w >> 8) & 0xffu), (float)((w >> 16) & 0xffu), (float)(w >> 24)}; }
struct EpiGate {
    static constexpr bool PERM = true, AFTER_DRAIN = false;
    const float* ssq; unsigned char* MG;
    __device__ __forceinline__ bool keep(const Unit&) const { return false; }
    __device__ __forceinline__ void operator()(f32x4 (&acc)[2][2][4][2], const Unit& u, int wr, int wc, int fr, int fq) const {
        const int row0 = u.pm * BM + wr * 64 + fr, lc0 = wc * 64 + fq * 8;
        float rs[2][4]; rows_rstd(ssq, row0, fq, rs);
#pragma unroll
        for (int ai = 0; ai < 2; ++ai)
#pragma unroll
            for (int m = 0; m < 4; ++m) { const int row = row0 + ai * HALF + m * 16; const float f = rs[ai][m];
                unsigned char* rowp = MG + (size_t)row * 3072 + u.pn * BM + lc0;
#pragma unroll
                for (int bj = 0; bj < 2; ++bj) { u32x2e w; w.x = gate_q4(acc[ai][bj][m][0] * f); w.y = gate_q4(acc[ai][bj][m][1] * f); *(u32x2e*)(rowp + 32 * bj) = w; } }
    }
};
struct EpiMerge {
    static constexpr bool PERM = true, AFTER_DRAIN = false;
    const unsigned char* MG; bf16_t* OUT;
    __device__ __forceinline__ bool keep(const Unit& u) const { return u.seg < 2; }
    __device__ __forceinline__ void operator()(f32x4 (&acc)[2][2][4][2], const Unit& u, int wr, int wc, int fr, int fq) const {
        const int row0 = u.pm * BM + wr * 64 + fr, col0 = u.pn * BM + wc * 32 + 8 * fq, seg = u.seg;
#pragma unroll
        for (int ai = 0; ai < 2; ++ai) {
            u32x2e ga[4][2], gb[4][2];
#pragma unroll
            for (int m = 0; m < 4; ++m) { const unsigned char* gp = MG + (size_t)(row0 + ai * HALF + m * 16) * 3072 + seg * 1024 + col0;
#pragma unroll
                for (int bj = 0; bj < 2; ++bj) { ga[m][bj] = *(const u32x2e*)(gp + bj * HALF); gb[m][bj] = seg < 2 ? *(const u32x2e*)(gp + 1024 + bj * HALF) : ga[m][bj]; } }
            EPI_PIN();
#pragma unroll
            for (int m = 0; m < 4; ++m) { const int row = row0 + ai * HALF + m * 16;
#pragma unroll
                for (int bj = 0; bj < 2; ++bj) { f32x4 a0 = gate_f4(ga[m][bj].x), a1 = gate_f4(ga[m][bj].y);
                    if (seg < 2) { const f32x4 b0 = gate_f4(gb[m][bj].x), b1 = gate_f4(gb[m][bj].y);
#pragma unroll
                        for (int e = 0; e < 4; ++e) { a0[e] = a0[e] * __builtin_amdgcn_rcpf(b0[e]); a1[e] = a1[e] * __builtin_amdgcn_rcpf(b1[e]); } }
                    else { a0 = a0 * (1.0f / 255.0f); a1 = a1 * (1.0f / 255.0f); }
                    acc[ai][bj][m][0] = acc[ai][bj][m][0] * a0; acc[ai][bj][m][1] = acc[ai][bj][m][1] * a1;
                    if (seg == 2) *(u32x4*)(OUT + (size_t)row * 1024 + col0 + bj * HALF) = pack8(acc[ai][bj][m][0], acc[ai][bj][m][1]); } }
        }
    }
};
template <bool RB, bool WOUT> struct EpiOutT {
    static constexpr bool PERM = true, AFTER_DRAIN = false;
    const float* resid; const bf16_t* residb; float* out; bf16_t* XB; float* ssq; unsigned poison;
    __device__ __forceinline__ bool keep(const Unit&) const { return false; }
    __device__ __forceinline__ void operator()(f32x4 (&acc)[2][2][4][2], const Unit& u, int wr, int wc, int fr, int fq) const {
        const int row0 = u.pm * BM + wr * 64 + fr, col0 = u.pn * BM + wc * 32 + 8 * fq;
#pragma unroll
        for (int ai = 0; ai < 2; ++ai) {
            f32x4 rv[4][2][2];
#pragma unroll
            for (int m = 0; m < 4; ++m)
#pragma unroll
                for (int bj = 0; bj < 2; ++bj) { const size_t o = (size_t)(row0 + ai * HALF + m * 16) * 1024 + col0 + bj * HALF;
                    if (RB) unpack8(*(const u32x4*)(residb + o), rv[m][bj][0], rv[m][bj][1]); else { rv[m][bj][0] = *(const f32x4*)(resid + o); rv[m][bj][1] = *(const f32x4*)(resid + o + 4); } }
            EPI_PIN();
#pragma unroll
            for (int m = 0; m < 4; ++m) { const int row = row0 + ai * HALF + m * 16; float ss = 0.f;
#pragma unroll
                for (int bj = 0; bj < 2; ++bj) { const size_t o = (size_t)row * 1024 + col0 + bj * HALF;
                    f32x4 v0 = rv[m][bj][0] + acc[ai][bj][m][0], v1 = rv[m][bj][1] + acc[ai][bj][m][1];
                    if (poison) { const float qn = __builtin_nanf(""); v0 = (f32x4){qn, qn, qn, qn}; v1 = v0; }
                    if (WOUT) { *(f32x4*)(out + o) = v0; *(f32x4*)(out + o + 4) = v1; }
                    if (XB) { *(u32x4*)(XB + o) = pack8(v0, v1); ss += ((v0[0] * v0[0] + v0[1] * v0[1]) + (v0[2] * v0[2] + v0[3] * v0[3])) + ((v1[0] * v1[0] + v1[1] * v1[1]) + (v1[2] * v1[2] + v1[3] * v1[3])); } }
                if (XB) { ss += __shfl_xor(ss, 16); ss += __shfl_xor(ss, 32); if (fq == 0) ssq[(size_t)row * 16 + u.pn * 4 + wc] = ss; } }
            EPI_PIN();
        }
    }
};
struct SegOrder {
    StaticOrder base;
    __device__ __forceinline__ bool next(int i, Unit& u) const { if (!base.next(i / 3, u)) return false; u.seg = i % 3; return true; }
    __device__ __forceinline__ void a_ready(const Unit&) const {}
    __device__ __forceinline__ void done(const Unit&) const {}
};

template <class Epi, class Sched, bool ALIGN_EPI = false, bool SP2 = false>
__device__ __forceinline__ void gemm_phase(PG8_LAS unsigned char* lds, const Gemm g, const Sched& S, const Epi& E, int wave_id) {
    int tid_ = (int)__builtin_amdgcn_mbcnt_hi(~0u, __builtin_amdgcn_mbcnt_lo(~0u, 0u)); asm volatile("" : "+v"(tid_)); tid_ += wave_id * 64;
    const int tid = tid_, wid = __builtin_amdgcn_readfirstlane(tid >> 6), lane = tid & 63, wr = wid >> 2, wc = wid & 3, fr = lane & 15, fq = lane >> 4;
    const int K = g.K, nt = K / BK;
    unsigned voffA[2], voffB[2];
#pragma unroll
    for (int i = 0; i < 2; ++i) { int R, C; stage_rc(tid * 16 + i * 8192, R, C); const int Rb = Epi::PERM ? ((R & ~31) + perm32(R & 31)) : R;
        voffA[i] = (unsigned)(R * g.lda + C) * 2u; voffB[i] = (unsigned)(Rb * g.ldb + C) * 2u; }
    const size_t kstep = (size_t)(BK * 2);
    const size_t hstepA = (size_t)HALF * g.lda * 2, hstepB = (size_t)HALF * g.ldb * 2;
    const size_t tstepA = 2 * hstepA, tstepB = 2 * hstepB, sstepA = (size_t)K * 2;
    const unsigned ldsw = (unsigned)wid * 1024u;
    const int aoff = lds_byte(wr * 64 + fr, fq * 8), boff = lds_byte(wc * 32 + fr, fq * 8);
#define PG8_SA(b, h) (((b) * 2 + (h)) * HTB)
#define PG8_SB(b, h) ((4 + (b) * 2 + (h)) * HTB)
#define PG8_STAGE(bufoff, gbase, voff) do { _Pragma("unroll") for (int _i = 0; _i < 2; ++_i) \
        __builtin_amdgcn_global_load_lds((const unsigned*)((const char*)(gbase) + (voff)[_i]), (PG8_LAS unsigned*)(lds + (bufoff) + ldsw + _i * 8192), 16, 0, 0); } while (0)
#define PG8_LDA(dst, b, h) do { _Pragma("unroll") for (int m = 0; m < 4; ++m) _Pragma("unroll") for (int k = 0; k < 2; ++k) dst[m][k] = *(const PG8_LAS bf16x8*)(lds + PG8_SA(b, h) + aoff + m * 2048 + k * 1024); } while (0)
#define PG8_LDB(dst, b, h) do { _Pragma("unroll") for (int n = 0; n < 2; ++n) _Pragma("unroll") for (int k = 0; k < 2; ++k) dst[n][k] = *(const PG8_LAS bf16x8*)(lds + PG8_SB(b, h) + boff + n * 2048 + k * 1024); } while (0)
#define PG8_MMA(ai, bj, At, Bt) do { __builtin_amdgcn_s_setprio(1); _Pragma("unroll") for (int m = 0; m < 4; ++m) _Pragma("unroll") for (int n = 0; n < 2; ++n) _Pragma("unroll") for (int k = 0; k < 2; ++k) \
        acc[ai][bj][m][n] = __builtin_amdgcn_mfma_f32_16x16x32_bf16(Bt[n][k], At[m][k], acc[ai][bj][m][n], 0, 0, 0); __builtin_amdgcn_s_setprio(0); } while (0)
#define PG8_WAIT_V(n) asm volatile("s_waitcnt vmcnt(" #n ")" ::: "memory")
#define PG8_WAIT_L(n) asm volatile("s_waitcnt lgkmcnt(" #n ")" ::: "memory")
#define PG8_BAR __builtin_amdgcn_s_barrier()
#define PG8_SCHED __builtin_amdgcn_sched_barrier(0)
    Unit cur, nxt; int ui = 0;
    if (!S.next(0, cur)) return;
    f32x4 acc[2][2][4][2];
#pragma unroll
    for (int a = 0; a < 2; ++a)
#pragma unroll
        for (int b = 0; b < 2; ++b)
#pragma unroll
            for (int m = 0; m < 4; ++m)
#pragma unroll
                for (int n = 0; n < 2; ++n) acc[a][b][m][n] = (f32x4){0.f, 0.f, 0.f, 0.f};
    bf16x8 At[4][2], B0[2][2], B1[2][2];
    const char* cA = (const char*)g.A + (size_t)cur.pm * tstepA + (size_t)cur.seg * sstepA; const char* cB = (const char*)g.Bt + (size_t)(cur.seg * g.segN + cur.pn) * tstepB;
    S.a_ready(cur);
    if constexpr (SP2) {
        PG8_STAGE(PG8_SB(0, 0), cB, voffB); PG8_STAGE(PG8_SB(0, 1), cB + hstepB, voffB); PG8_STAGE(PG8_SA(0, 0), cA, voffA); PG8_STAGE(PG8_SA(0, 1), cA + hstepA, voffA);
        if (wr == 1) PG8_BAR;
        PG8_WAIT_V(2); PG8_BAR;
        PG8_STAGE(PG8_SB(1, 0), cB + kstep, voffB); PG8_STAGE(PG8_SA(1, 0), cA + kstep, voffA); PG8_STAGE(PG8_SB(1, 1), cB + hstepB + kstep, voffB);
        PG8_WAIT_V(6); PG8_BAR;
    } else {
        PG8_STAGE(PG8_SB(0, 0), cB, voffB); PG8_STAGE(PG8_SA(0, 0), cA, voffA); PG8_STAGE(PG8_SB(0, 1), cB + hstepB, voffB); PG8_STAGE(PG8_SA(0, 1), cA + hstepA, voffA);
        if (wr == 1) PG8_BAR;
        PG8_WAIT_V(4); PG8_BAR;
        PG8_STAGE(PG8_SB(1, 0), cB + kstep, voffB); PG8_STAGE(PG8_SA(1, 0), cA + kstep, voffA); PG8_STAGE(PG8_SB(1, 1), cB + hstepB + kstep, voffB);
        PG8_WAIT_V(6); PG8_BAR;
    }
    for (;;) {
        const bool has_next = S.next(ui + 1, nxt);
        const char* nA = has_next ? (const char*)g.A + (size_t)nxt.pm * tstepA + (size_t)nxt.seg * sstepA : cA; const char* nB = has_next ? (const char*)g.Bt + (size_t)(nxt.seg * g.segN + nxt.pn) * tstepB : cB;
        for (int t = 0; t < nt; t += 2) {
            const bool last = (t == nt - 2);
            const char* a1 = cA + (size_t)(t + 1) * kstep;
            const char* a2 = last ? nA : cA + (size_t)(t + 2) * kstep; const char* b2 = last ? nB : cB + (size_t)(t + 2) * kstep;
            const char* a3 = a2 + kstep; const char* b3 = b2 + kstep;
            if (last && has_next) S.a_ready(nxt);
            if constexpr (SP2) {
            PG8_LDB(B0, 0, 0); PG8_LDB(B1, 0, 1); PG8_SCHED; PG8_LDA(At, 0, 0); PG8_STAGE(PG8_SA(1, 1), a1 + hstepA, voffA);
            PG8_WAIT_V(8); PG8_WAIT_L(0); PG8_BAR; PG8_MMA(0, 0, At, B0); PG8_MMA(0, 1, At, B1); PG8_BAR; PG8_SCHED;
            PG8_LDA(At, 0, 1); PG8_STAGE(PG8_SB(0, 0), b2, voffB); PG8_STAGE(PG8_SB(0, 1), b2 + hstepB, voffB); PG8_STAGE(PG8_SA(0, 0), a2, voffA);
            PG8_WAIT_V(8); PG8_WAIT_L(0); PG8_BAR; PG8_MMA(1, 0, At, B0); PG8_MMA(1, 1, At, B1); PG8_BAR; PG8_SCHED;
            PG8_LDB(B0, 1, 0); PG8_LDB(B1, 1, 1); PG8_SCHED; PG8_LDA(At, 1, 0); PG8_STAGE(PG8_SA(0, 1), a2 + hstepA, voffA);
            PG8_WAIT_V(8); PG8_WAIT_L(0); PG8_BAR; PG8_MMA(0, 0, At, B0); PG8_MMA(0, 1, At, B1); PG8_BAR; PG8_SCHED;
            PG8_LDA(At, 1, 1); PG8_STAGE(PG8_SB(1, 0), b3, voffB); PG8_STAGE(PG8_SB(1, 1), b3 + hstepB, voffB); PG8_STAGE(PG8_SA(1, 0), a3, voffA);
            PG8_WAIT_V(8); PG8_WAIT_L(0); PG8_BAR; PG8_MMA(1, 0, At, B0); PG8_MMA(1, 1, At, B1); PG8_BAR; PG8_SCHED;
            } else {
            PG8_LDB(B0, 0, 0); PG8_SCHED; PG8_LDA(At, 0, 0); PG8_STAGE(PG8_SA(1, 1), a1 + hstepA, voffA);
            PG8_WAIT_L(8); PG8_BAR; PG8_WAIT_L(0); PG8_MMA(0, 0, At, B0); PG8_BAR; PG8_SCHED;
            PG8_LDB(B1, 0, 1); PG8_STAGE(PG8_SB(0, 0), b2, voffB);
            PG8_BAR; PG8_WAIT_L(0); PG8_MMA(0, 1, At, B1); PG8_BAR;
            PG8_LDA(At, 0, 1); PG8_STAGE(PG8_SA(0, 0), a2, voffA);
            PG8_BAR; PG8_WAIT_L(0); PG8_MMA(1, 0, At, B0); PG8_BAR; PG8_SCHED;
            PG8_STAGE(PG8_SB(0, 1), b2 + hstepB, voffB);
            PG8_WAIT_V(6); PG8_BAR; PG8_MMA(1, 1, At, B1); PG8_BAR;
            PG8_LDB(B0, 1, 0); PG8_SCHED; PG8_LDA(At, 1, 0); PG8_STAGE(PG8_SA(0, 1), a2 + hstepA, voffA);
            PG8_WAIT_L(8); PG8_BAR; PG8_WAIT_L(0); PG8_MMA(0, 0, At, B0); PG8_BAR; PG8_SCHED;
            PG8_LDB(B1, 1, 1); PG8_STAGE(PG8_SB(1, 0), b3, voffB);
            PG8_BAR; PG8_WAIT_L(0); PG8_MMA(0, 1, At, B1); PG8_BAR;
            PG8_LDA(At, 1, 1); PG8_STAGE(PG8_SA(1, 0), a3, voffA);
            PG8_BAR; PG8_WAIT_L(0); PG8_MMA(1, 0, At, B0); PG8_BAR; PG8_SCHED;
            PG8_STAGE(PG8_SB(1, 1), b3 + hstepB, voffB);
            PG8_WAIT_V(6); PG8_BAR; PG8_MMA(1, 1, At, B1); PG8_BAR;
            }
        }
        if constexpr (ALIGN_EPI) { if (wr == 0) PG8_BAR; }
        if constexpr (!Epi::AFTER_DRAIN) { E(acc, cur, wr, wc, fr, fq); S.done(cur); }
        if (!has_next) break;
        if (!E.keep(cur)) {
#pragma unroll
        for (int a = 0; a < 2; ++a)
#pragma unroll
            for (int b = 0; b < 2; ++b)
#pragma unroll
                for (int m = 0; m < 4; ++m)
#pragma unroll
                    for (int n = 0; n < 2; ++n) acc[a][b][m][n] = (f32x4){0.f, 0.f, 0.f, 0.f};
        }
        cur = nxt; cA = nA; cB = nB; ++ui;
        if constexpr (ALIGN_EPI) { if (wr == 1) PG8_BAR; }
    }
    PG8_WAIT_V(0);
    if constexpr (!ALIGN_EPI) { if (wr == 0) PG8_BAR; }
    PG8_BAR;
    if constexpr (Epi::AFTER_DRAIN) { E.fused(acc, cur, wr, wc, fr, fq, lds, wid, lane); S.done(cur); }
#undef PG8_SA
#undef PG8_SB
#undef PG8_STAGE
#undef PG8_LDA
#undef PG8_LDB
#undef PG8_MMA
#undef PG8_WAIT_V
#undef PG8_WAIT_L
#undef PG8_BAR
#undef PG8_SCHED
}
}
#include <hip/hip_bf16.h>
#include <cmath>
namespace attn_body {
using bf16=__hip_bfloat16;
using bf16x8=__attribute__((ext_vector_type(8)))short;
using s16x4=__attribute__((ext_vector_type(4)))short;
using f32x16=__attribute__((ext_vector_type(16)))float;
using u32x4=__attribute__((ext_vector_type(4)))unsigned;
constexpr int BATCH=4,NHEAD=8,SEQ=8192,D=64,DM=NHEAD*D;
constexpr int NW=8,QBLK=32,QB=QBLK*NW,KVBLK=64,NQB=SEQ/QB;
constexpr int ATTN_PITCH=DM, ATTN_UNIT_ROWS=QB, OPITCH=1536, OCOL0=1024;
__device__ __forceinline__ int crow(int r,int hi){return (r&3)+8*(r>>2)+4*hi;}
#define SBAR() __builtin_amdgcn_sched_barrier(0)
__device__ __forceinline__ void cmask(f32x16&p0,f32x16&p1,int jb,int qrel,int hi){
  const float NEG=-INFINITY; int kb=64*jb+4*hi;
  #pragma unroll
  for(int r=0;r<16;++r){int kv=kb+(r&3)+8*(r>>2); if(kv>qrel)p0[r]=NEG; if(kv+32>qrel)p1[r]=NEG;}
}

constexpr int NSLOT=3, SLOTB=8192;
constexpr int LDS_K=0, LDS_V=NSLOT*SLOTB, LDS_WS=2*NSLOT*SLOTB, LDS_OST=LDS_WS+NW*64*4, LDS_BYTES=LDS_OST+NW*4096;
constexpr float C2=0.125f*1.4426950408889634f;
__device__ __forceinline__ void glds16(const void*gsrc,unsigned lds_dst){unsigned keep;
  asm volatile("s_mov_b32 %0, m0\n\ts_mov_b32 m0, %2\n\ts_nop 0\n\tglobal_load_lds_dwordx4 %1, off\n\ts_mov_b32 m0, %0":"=&s"(keep):"v"(gsrc),"s"(lds_dst):"memory");}
__device__ __forceinline__ float max3f(float a,float b,float c){float r;asm("v_max3_f32 %0, %1, %2, %3":"=v"(r):"v"(a),"v"(b),"v"(c));return r;}
__device__ __forceinline__ float max2f(float a,float b){float r;asm("v_max_f32_e32 %0, %1, %2":"=v"(r):"v"(a),"v"(b));return r;}
__device__ __forceinline__ float fadd_s(float a,float b){float r;asm("v_add_f32_e32 %0, %1, %2":"=v"(r):"v"(a),"v"(b));return r;}
__device__ __forceinline__ float fsub_s(float a,float b){float r;asm("v_sub_f32_e32 %0, %1, %2":"=v"(r):"v"(a),"v"(b));return r;}
typedef float f32x2_t __attribute__((ext_vector_type(2))); typedef __bf16 bf16x2_t __attribute__((ext_vector_type(2)));
__device__ __forceinline__ unsigned cvtpk_s(float lo,float hi){f32x2_t v={lo,hi};bf16x2_t b=__builtin_convertvector(v,bf16x2_t);return __builtin_bit_cast(unsigned,b);}
#define WAIT_BAR(N) asm volatile("s_waitcnt vmcnt(" #N ") lgkmcnt(0)\n\ts_barrier":::"memory")

__device__ __forceinline__ void qkt(f32x16&p0,f32x16&p1,const char*Kslot,const bf16x8*qr,int r32,int hi){
  const char*kb=Kslot+hi*1024+r32*16;
  #pragma unroll
  for(int d0=0;d0<4;++d0){
    const bf16x8 b0=*reinterpret_cast<const bf16x8*>(kb+d0*2048);
    const bf16x8 b1=*reinterpret_cast<const bf16x8*>(kb+d0*2048+512);
    p0=__builtin_amdgcn_mfma_f32_32x32x16_bf16(b0,qr[d0],p0,0,0,0);p1=__builtin_amdgcn_mfma_f32_32x32x16_bf16(b1,qr[d0],p1,0,0,0);}
}
typedef __attribute__((address_space(3))) const unsigned* lds_cuptr;
typedef float f32x4_t __attribute__((ext_vector_type(4)));
__device__ __forceinline__ unsigned bfr(float f){ unsigned u=__builtin_bit_cast(unsigned,f); return (u+0x7fffu+((u>>16)&1u))>>16; }
__device__ __forceinline__ void biasmm(f32x16&c0,f32x16&c1,unsigned w0,unsigned w1  ,unsigned qm1,int hi){
  const unsigned one=hi?0u:0x3f803f80u; w0=hi?0u:w0; w1=hi?0u:w1;
  const u32x4 k0={w0,one,0u,0u},k1={w1,one,0u,0u},qv={one,qm1,0u,0u};
  const f32x16 z=f32x16{};
  c0=__builtin_amdgcn_mfma_f32_32x32x16_bf16(__builtin_bit_cast(bf16x8,k0),__builtin_bit_cast(bf16x8,qv),z,0,0,0);
  c1=__builtin_amdgcn_mfma_f32_32x32x16_bf16(__builtin_bit_cast(bf16x8,k1),__builtin_bit_cast(bf16x8,qv),z,0,0,0);
}
typedef __attribute__((address_space(3))) const char* lds_cptr;
typedef short v4i16_t __attribute__((ext_vector_type(4)));
__device__ __forceinline__ void kload8(bf16x8*kf,lds_cptr kp){
  kf[0]=*(const __attribute__((address_space(3))) bf16x8*)(kp);      kf[1]=*(const __attribute__((address_space(3))) bf16x8*)(kp+512);
  kf[2]=*(const __attribute__((address_space(3))) bf16x8*)(kp+2048); kf[3]=*(const __attribute__((address_space(3))) bf16x8*)(kp+2560);
  kf[4]=*(const __attribute__((address_space(3))) bf16x8*)(kp+4096); kf[5]=*(const __attribute__((address_space(3))) bf16x8*)(kp+4608);
  kf[6]=*(const __attribute__((address_space(3))) bf16x8*)(kp+6144); kf[7]=*(const __attribute__((address_space(3))) bf16x8*)(kp+6656);
}
__device__ __forceinline__ void kload2(bf16x8*kf,lds_cptr kp,int j){ kf[2*j]=*(const __attribute__((address_space(3))) bf16x8*)(kp+j*2048); kf[2*j+1]=*(const __attribute__((address_space(3))) bf16x8*)(kp+j*2048+512); }
__device__ __forceinline__ s16x4 vtr(lds_cptr p){ return __builtin_bit_cast(s16x4,__builtin_amdgcn_ds_read_tr16_b64_v4i16((__attribute__((address_space(3))) v4i16_t*)p)); }
__device__ __forceinline__ float rowmax(const f32x16&p0,const f32x16&p1){
  float a=max3f(p0[0],p0[1],p1[0]),b=max3f(p0[2],p0[3],p1[1]);a=max3f(a,p1[2],p1[3]);
  #pragma unroll
  for(int r=4;r<16;r+=4){a=max3f(a,p0[r],p0[r+1]);b=max3f(b,p0[r+2],p0[r+3]);a=max3f(a,p1[r],p1[r+1]);b=max3f(b,p1[r+2],p1[r+3]);}
  const float m=max2f(a,b);
  auto rr=__builtin_amdgcn_permlane32_swap(__float_as_uint(m),__float_as_uint(m),false,false);
  return max2f(__uint_as_float(rr[0]),__uint_as_float(rr[1]));
}
__device__ __forceinline__ void pv(f32x16*o,int vb,bf16x8 pa0,bf16x8 pa1,bf16x8 pa2,bf16x8 pa3){
  #pragma unroll
  for(int d0=0;d0<2;++d0){s16x4 lo[4],hi[4];
    #pragma unroll
    for(int ks=0;ks<4;++ks){
      asm volatile("ds_read_b64_tr_b16 %0,%1 offset:%c2":"=&v"(lo[ks]):"v"(vb),"i"(d0*4096+ks*1024):"memory");
      asm volatile("ds_read_b64_tr_b16 %0,%1 offset:%c2":"=&v"(hi[ks]):"v"(vb),"i"(d0*4096+ks*1024+512):"memory");}
    asm volatile("s_waitcnt lgkmcnt(0)":::"memory");SBAR();
    #define PK(k) (bf16x8){lo[k][0],lo[k][1],lo[k][2],lo[k][3],hi[k][0],hi[k][1],hi[k][2],hi[k][3]}
    o[d0]=__builtin_amdgcn_mfma_f32_32x32x16_bf16(pa0,PK(0),o[d0],0,0,0);
    o[d0]=__builtin_amdgcn_mfma_f32_32x32x16_bf16(pa1,PK(1),o[d0],0,0,0);
    o[d0]=__builtin_amdgcn_mfma_f32_32x32x16_bf16(pa2,PK(2),o[d0],0,0,0);
    o[d0]=__builtin_amdgcn_mfma_f32_32x32x16_bf16(pa3,PK(3),o[d0],0,0,0);
    #undef PK
  }
}

__device__ __forceinline__ u32x4 mul_bf16x8(u32x4 a,u32x4 b){ u32x4 r;
  #pragma unroll
  for(int i=0;i<4;++i){ const float al=__uint_as_float(a[i]<<16),ah=__uint_as_float(a[i]&0xffff0000u),bl=__uint_as_float(b[i]<<16),bh=__uint_as_float(b[i]&0xffff0000u); r[i]=cvtpk_s(al*bl,ah*bh); }
  return r; }
#ifndef ATTN_STORE16
#define ATTN_STORE16(p,v) (*(u32x4*)(p)=(v))
#endif
template<int THRL> __device__ __forceinline__ void attn_unit(int b,int h,int qb,const bf16*Q,const bf16*__restrict__ K,const bf16*__restrict__ V,bf16*O,char*shm,lds_cuptr nb,int tskip,bool dry,int wave_id){
  int tid_=(int)__builtin_amdgcn_mbcnt_hi(~0u,__builtin_amdgcn_mbcnt_lo(~0u,0u)); asm volatile("":"+v"(tid_)); tid_+=wave_id*64; const int tid=tid_,lane=tid&63,r32=lane&31,hi=lane>>5; const int wid=__builtin_amdgcn_readfirstlane(tid>>6);
  const long rowbase=(long)b*SEQ; const int q0=qb*QB;
  const bf16*Qw=Q+(rowbase+q0+wid*QBLK)*DM+h*D;
  const bf16*Kh=K+(rowbase+(long)tskip*KVBLK)*DM+h*D,*Vh=V+(rowbase+(long)tskip*KVBLK)*DM+h*D;
  const unsigned lds0=(unsigned)(uintptr_t)shm;
  float*wsf=(float*)(shm+LDS_WS)+wid*64;
  const bf16*ksrc=Kh+(long)lane*DM+wid*8;
  const bf16*vsrc=Vh+(long)(16*(wid&3)+(lane>>2))*DM+(wid>>2)*32+(lane&3)*8;
  const unsigned kdst=lds0+LDS_K+wid*1024, vdst=lds0+LDS_V+wid*1024;
  #define DMA_K(t,slot) glds16(ksrc+(long)(t)*KVBLK*DM,(unsigned)__builtin_amdgcn_readfirstlane(kdst+(slot)))
  #define DMA_V(t,slot) glds16(vsrc+(long)(t)*KVBLK*DM,(unsigned)__builtin_amdgcn_readfirstlane(vdst+(slot)))
  const int vb0=(int)(lds0+LDS_V)+((lane>>4)&1)*32+(lane&3)*8+(4*hi+((lane&15)>>2))*64;
  const char*Kbase=shm+LDS_K; bf16x8 kf[8];
  const lds_cptr shm3=(lds_cptr)shm; const lds_cptr kp0=shm3+LDS_K+hi*1024+r32*16; const lds_cptr vp0=shm3+LDS_V+((lane>>4)&1)*32+(lane&3)*8+(4*hi+((lane&15)>>2))*64;
  const int NT=(q0+QB)/KVBLK-tskip;
  DMA_K(0,0);DMA_V(0,0);DMA_K(1,SLOTB);
  bf16x8 qr[4];
  #pragma unroll
  for(int d0=0;d0<4;++d0)qr[d0]=*reinterpret_cast<const bf16x8*>(&Qw[(long)r32*DM+d0*16+hi*8]);
  float mhat=0.f,l_reg=0.f;f32x16 o[2];o[0]=f32x16{};o[1]=f32x16{};unsigned qm1=0u;const lds_cuptr nbl=nb+64*tskip+r32;
  #define SETM(NEWM) do{ const float nm_=-(NEWM); const unsigned h_=bfr(nm_); const float hf_=__uint_as_float(h_<<16); const unsigned l_=bfr(nm_-hf_); mhat=-(hf_+__uint_as_float(l_<<16)); qm1=hi?0u:(h_|(l_<<16)); }while(0)
  const int qrel=wid*QBLK+r32;
  #define CMASK(P0,P1,t) do{int jb_=(t)-(NT-4); if(jb_>=0)cmask(P0,P1,jb_,qrel,hi);}while(0)
  bool resc=false;
  #define START(P0,P1) do{ const float rm=rowmax(P0,P1); resc=false; \
    { const float old_=mhat; SETM(old_+rm); const float dl=mhat-old_; \
      _Pragma("unroll") for(int r=0;r<16;++r){P0[r]=fsub_s(P0[r],dl);P1[r]=fsub_s(P1[r],dl);} } \
    _Pragma("unroll") for(int r=0;r<16;++r)P0[r]=__builtin_amdgcn_exp2f(P0[r]); }while(0)
  #define RESC() do{ if(resc){ asm volatile("s_waitcnt lgkmcnt(0)":::"memory"); \
      _Pragma("unroll") for(int d_=0;d_<2;++d_) _Pragma("unroll") for(int r=0;r<16;++r)o[d_][r]*=wsf[crow(r,hi)]; } }while(0)
  f32x16 pA0,pA1,pB0,pB1;
  int sl_prev=0,sl_cur=0,sl_next=SLOTB;
  #define ROT() do{sl_prev=sl_cur;sl_cur=sl_next;sl_next=(sl_next==(NSLOT-1)*SLOTB)?0:sl_next+SLOTB;}while(0)
  DMA_K(2,2*SLOTB);
  WAIT_BAR(3);
  unsigned bw0=nbl[0],bw1=nbl[32]; biasmm(pA0,pA1,bw0,bw1,qm1,hi); bw0=nbl[64]; bw1=nbl[96]; qkt(pA0,pA1,Kbase,qr,r32,hi);    asm volatile("s_nop 15\n\ts_nop 7":"+v"(pA0),"+v"(pA1));CMASK(pA0,pA1,0);
  START(pA0,pA1);
  _Pragma("unroll") for(int r=0;r<16;++r)pA1[r]=__builtin_amdgcn_exp2f(pA1[r]);
  WAIT_BAR(0);
  DMA_K(3,0);DMA_V(1,SLOTB);
  ROT();
  kload8(kf,kp0+sl_cur);
  WAIT_BAR(2);
  s16x4 vlo[8],vhi[8]; u32x4 pw0,pw1,pw2,pw3;
  #define PKW(P,B) cvtpk_s(P[B],P[B+1])
  #define PAF(k) __builtin_bit_cast(bf16x8,pw##k)
  #define VFR(i) (bf16x8){vlo[i][0],vlo[i][1],vlo[i][2],vlo[i][3],vhi[i][0],vhi[i][1],vhi[i][2],vhi[i][3]}
  #define PIN(x) asm volatile("":"+v"(x))
  #define MX3(a,b,c) __builtin_fmaxf(__builtin_fmaxf((a),(b)),(c))
  #define GAPA(MF,A0,A1,A2,A3,W0,W1,PW) do{ MF; sacc+=A0; sacc+=A1; sacc+=A2; sacc+=A3; PIN(sacc); W0; W1; PIN(PW); SBAR(); }while(0)
  #define EX(v) __builtin_amdgcn_exp2f(v)
  #define GAPB(MF,X,B) do{ MF; X[B]=EX(X[B]); X[B+1]=EX(X[B+1]); X[B+2]=EX(X[B+2]); X[B+3]=EX(X[B+3]); PIN(X); SBAR(); }while(0)
  #define VRD(i) do{ vlo[i]=vtr(vp_+(((i)>>2)*4096+((i)&3)*1024)); vhi[i]=vtr(vp_+(((i)>>2)*4096+((i)&3)*1024+512)); }while(0)
  #define KRD(G,j) do{ if(G){ kload2(kf,kp0+sl_next,j); SBAR(); } }while(0)
  #define STEP(C0,C1,P0,P1,t,GK,GV,GL) do{ SBAR(); \
    biasmm(C0,C1,bw0,bw1,qm1,hi); bw0=nbl[64*((t)+1)]; bw1=nbl[64*((t)+1)+32]; SBAR(); \
    const lds_cptr vp_=vp0+sl_prev; \
    VRD(0); SBAR(); float sacc=(P0[0]+P0[1]); \
    GAPA(C0=__builtin_amdgcn_mfma_f32_32x32x16_bf16(kf[0],qr[0],C0,0,0,0), P0[2],P0[3],P0[4],P0[5],     pw0[0]=PKW(P0,0), pw0[1]=PKW(P0,2), pw0); \
    VRD(4); SBAR(); GAPA(C1=__builtin_amdgcn_mfma_f32_32x32x16_bf16(kf[1],qr[0],C1,0,0,0), P0[6],P0[7],P0[8],P0[9],     pw0[2]=PKW(P0,4), pw0[3]=PKW(P0,6), pw0); \
    VRD(1); SBAR(); GAPA(C0=__builtin_amdgcn_mfma_f32_32x32x16_bf16(kf[2],qr[1],C0,0,0,0),   P0[10],P0[11],P0[12],P0[13], pw1[0]=PKW(P0,8), pw1[1]=PKW(P0,10), pw1); \
    VRD(5); SBAR(); GAPA(C1=__builtin_amdgcn_mfma_f32_32x32x16_bf16(kf[3],qr[1],C1,0,0,0),   P0[14],P0[15],P1[0],P1[1],   pw1[2]=PKW(P0,12),pw1[3]=PKW(P0,14), pw1); \
    VRD(2); SBAR(); GAPA(C0=__builtin_amdgcn_mfma_f32_32x32x16_bf16(kf[4],qr[2],C0,0,0,0),   P1[2],P1[3],P1[4],P1[5],     pw2[0]=PKW(P1,0), pw2[1]=PKW(P1,2), pw2); \
    VRD(6); SBAR(); GAPA(C1=__builtin_amdgcn_mfma_f32_32x32x16_bf16(kf[5],qr[2],C1,0,0,0),   P1[6],P1[7],P1[8],P1[9],     pw2[2]=PKW(P1,4), pw2[3]=PKW(P1,6), pw2); \
    VRD(3); SBAR(); GAPA(C0=__builtin_amdgcn_mfma_f32_32x32x16_bf16(kf[6],qr[3],C0,0,0,0),   P1[10],P1[11],P1[12],P1[13], pw3[0]=PKW(P1,8), pw3[1]=PKW(P1,10), pw3); \
    VRD(7); SBAR(); GAPA(C1=__builtin_amdgcn_mfma_f32_32x32x16_bf16(kf[7],qr[3],C1,0,0,0),   P1[14],P1[15],0.f,0.f,       pw3[2]=PKW(P1,12),pw3[3]=PKW(P1,14), pw3); \
    l_reg+=sacc; \
    if(GK){DMA_K((t)+3,sl_cur);} if(GV){DMA_V((t)+1,sl_next);} \
    CMASK(C0,C1,t); \
    { float a=MX3(C0[0],C0[1],C1[0]),b=MX3(C0[2],C0[3],C1[1]); a=MX3(a,C1[2],C1[3]); \
      _Pragma("unroll") for(int r=4;r<16;r+=4){a=MX3(a,C0[r],C0[r+1]);b=MX3(b,C0[r+2],C0[r+3]);a=MX3(a,C1[r],C1[r+1]);b=MX3(b,C1[r+2],C1[r+3]);} \
      float rm=__builtin_fmaxf(a,b); { auto rr=__builtin_amdgcn_permlane32_swap(__float_as_uint(rm),__float_as_uint(rm),false,false); rm=__builtin_fmaxf(__uint_as_float(rr[0]),__uint_as_float(rr[1])); } \
      resc=false; \
      if(__builtin_expect(__any(rm>(float)THRL),0)){ const float old_=mhat; SETM(old_+__builtin_fmaxf(rm,0.f)); const float dl=mhat-old_; \
        _Pragma("unroll") for(int r=0;r<16;++r){C0[r]-=dl;C1[r]-=dl;} \
        const float f=__builtin_amdgcn_exp2f(-dl); l_reg*=f; if(hi==0)wsf[r32]=f; resc=true; } } \
    SBAR(); \
    GAPB(o[0]=__builtin_amdgcn_mfma_f32_32x32x16_bf16(PAF(0),VFR(0),o[0],0,0,0), C0,0); \
    GAPB(o[1]=__builtin_amdgcn_mfma_f32_32x32x16_bf16(PAF(0),VFR(4),o[1],0,0,0), C0,4); \
    KRD(GL,0); GAPB(o[0]=__builtin_amdgcn_mfma_f32_32x32x16_bf16(PAF(1),VFR(1),o[0],0,0,0), C0,8); \
    KRD(GL,1); GAPB(o[1]=__builtin_amdgcn_mfma_f32_32x32x16_bf16(PAF(1),VFR(5),o[1],0,0,0), C0,12); \
    KRD(GL,2); GAPB(o[0]=__builtin_amdgcn_mfma_f32_32x32x16_bf16(PAF(2),VFR(2),o[0],0,0,0), C1,0); \
    KRD(GL,3); GAPB(o[1]=__builtin_amdgcn_mfma_f32_32x32x16_bf16(PAF(2),VFR(6),o[1],0,0,0), C1,4); \
    GAPB(o[0]=__builtin_amdgcn_mfma_f32_32x32x16_bf16(PAF(3),VFR(3),o[0],0,0,0), C1,8); \
    GAPB(o[1]=__builtin_amdgcn_mfma_f32_32x32x16_bf16(PAF(3),VFR(7),o[1],0,0,0), C1,12); \
    }while(0)
  int t=1;
  #undef CMASK
  #define CMASK(P0,P1,t) do{}while(0)
  for(;t+5<NT;t+=2){
    STEP(pB0,pB1,pA0,pA1,t,true,true,true);     WAIT_BAR(2); RESC(); ROT();
    STEP(pA0,pA1,pB0,pB1,t+1,true,true,true);   WAIT_BAR(2); RESC(); ROT();
  }
  #undef CMASK
  #define CMASK(P0,P1,t) do{int jb_=(t)-(NT-4); if(jb_>=0)cmask(P0,P1,jb_,qrel,hi);}while(0)
  #define ENDW(tt) do{ if((tt)+3<NT){WAIT_BAR(2);} else if((tt)+2<NT){WAIT_BAR(1);} else {WAIT_BAR(0);} }while(0)
  for(;t+1<NT;t+=2){
    STEP(pB0,pB1,pA0,pA1,t,(t+3<NT),(t+1<NT),(t+1<NT));       ENDW(t);   RESC(); ROT();
    STEP(pA0,pA1,pB0,pB1,t+1,(t+4<NT),(t+2<NT),(t+2<NT));     ENDW(t+1); RESC(); ROT();
  }
  STEP(pB0,pB1,pA0,pA1,NT-1,false,false,false); RESC();
  { float sacc=pB0[0]+pB0[1]; _Pragma("unroll") for(int r=2;r<16;++r)sacc+=pB0[r]; _Pragma("unroll") for(int r=0;r<16;++r)sacc+=pB1[r]; l_reg+=sacc;
    pw0=(u32x4){PKW(pB0,0),PKW(pB0,2),PKW(pB0,4),PKW(pB0,6)};pw1=(u32x4){PKW(pB0,8),PKW(pB0,10),PKW(pB0,12),PKW(pB0,14)};pw2=(u32x4){PKW(pB1,0),PKW(pB1,2),PKW(pB1,4),PKW(pB1,6)};pw3=(u32x4){PKW(pB1,8),PKW(pB1,10),PKW(pB1,12),PKW(pB1,14)};
    SBAR(); pv(o,vb0+sl_cur,PAF(0),PAF(1),PAF(2),PAF(3)); }
  #undef PKW
  #undef PAF
  #undef VFR
  #undef PIN
  #undef MX3
  #undef GAPA
  #undef GAPB
  #undef EX
  #undef VRD
  #undef KRD
  #undef STEP
  #undef ENDW
  {auto rr=__builtin_amdgcn_permlane32_swap(__float_as_uint(l_reg),__float_as_uint(l_reg),false,false);l_reg=__uint_as_float(rr[0])+__uint_as_float(rr[1]);}
  if(hi==0)wsf[32+r32]=l_reg;asm volatile("s_waitcnt lgkmcnt(0)":::"memory");
  float rli[16];
  #pragma unroll
  for(int r=0;r<16;++r)rli[r]=__builtin_amdgcn_rcpf(wsf[32+crow(r,hi)]);
  bf16*Ow=O+(rowbase+q0+wid*QBLK)*(long)OPITCH+OCOL0+h*D;
  { bf16*stg=(bf16*)(shm+LDS_OST)+wid*2048;
    #pragma unroll
    for(int r=0;r<16;++r){const int orow=crow(r,hi);
      #pragma unroll
      for(int d0=0;d0<2;++d0)stg[orow*64+d0*32+r32]=__float2bfloat16(o[d0][r]*rli[r]);}
    asm volatile("s_waitcnt lgkmcnt(0)":::"memory");
    #pragma unroll
    for(int i=0;i<4;++i){const int row=i*8+(lane>>3),ch=lane&7; const u32x4 v=*(const u32x4*)(stg+row*64+ch*8); bf16*gp=Ow+(long)row*OPITCH+ch*8; const u32x4 gt=*(const u32x4*)gp; if(!dry){ATTN_STORE16(gp,mul_bf16x8(v,gt));}} }
  asm volatile("s_waitcnt lgkmcnt(0)\n\ts_barrier":::"memory");
  #undef DMA_K
  #undef DMA_V
  #undef CMASK
  #undef START
  #undef RESC
  #undef ROT
  #undef SETM
}
constexpr int ATTN_LDS_BYTES=LDS_BYTES;
#undef SBAR
#undef WAIT_BAR
}
constexpr int BATCH = 4, SEQ = 8192, DMODEL = 1024, M = BATCH * SEQ, DEPTH = 2, INC = 7852;
constexpr int NT_A = 19, NT_B = 12, NTILES = NT_A + NT_B;
constexpr int SA_Q = 0, SA_K = 512, SA_V = 640, SA_G = 768, SB_Q = 1280, SB_K = 1792, SB_V = 1920, SB_IQ = 2048, SB_IK = 2176, SB_IW = 2208, SB_G = 2212,
              SC_Q = 2724, SC_K = 3236, SC_V = 3748, SC_F = 4260, SC_G = 4268, S_MG = 4780;
static_assert(S_MG + 3072 == INC, "column partition");
__host__ __device__ __forceinline__ int src_col(int t, int lc) {
    switch (t) {
        case 0: case 1: return SA_Q + t * 256 + lc;
        case 2: case 3: return SB_Q + (t - 2) * 256 + lc;
        case 4: case 5: return SC_Q + (t - 4) * 256 + lc;
        case 6: return lc < 128 ? SA_K + lc : SB_K + lc - 128;
        case 7: case 8: return SC_K + (t - 7) * 256 + lc;
        case 9: return lc < 128 ? SA_V + lc : SB_V + lc - 128;
        case 10: case 11: return SC_V + (t - 10) * 256 + lc;
        case 12: case 13: return SA_G + (t - 12) * 256 + lc;
        case 14: case 15: return SB_G + (t - 14) * 256 + lc;
        case 16: case 17: return SC_G + (t - 16) * 256 + lc;
        case 18: return lc < 128 ? SB_IQ + lc : lc < 160 ? SB_IK + lc - 128 : lc < 164 ? SB_IW + lc - 160 : lc < 172 ? SC_F + lc - 164 : -1;
        default: return S_MG + (t - 19) * 256 + lc;
    }
}
constexpr size_t MiB = 1u << 20;
constexpr size_t WS_CTL = 0, CTL_ZERO_BYTES = 1 * MiB;
constexpr size_t WS_W1T = 2 * MiB;
constexpr size_t WS_WBT = 33 * MiB;
constexpr size_t WS_WOT = 39 * MiB;
constexpr size_t WS_SSQ = 43 * MiB;
constexpr size_t WS_CL = 45 * MiB;
constexpr size_t WS_CT = 46 * MiB;
constexpr size_t WS_IW = 47 * MiB;
constexpr size_t WS_CF = 47 * MiB + 512 * 1024;
constexpr size_t WS_IQ = 49 * MiB;
constexpr size_t WS_IK = 57 * MiB;
constexpr size_t WS_XB = 60 * MiB;
constexpr size_t WS_MERGED = 124 * MiB;
constexpr size_t WS_G = 188 * MiB;
constexpr size_t WS_QA = 284 * MiB, WS_QB = 316 * MiB, WS_QC = 348 * MiB, WS_KC = 380 * MiB, WS_VC = 412 * MiB, WS_KAB = 444 * MiB, WS_VAB = 460 * MiB;
constexpr size_t WS_MG = 284 * MiB;
constexpr size_t WS_END = 476 * MiB;
static_assert(pg8::EWS_CL == WS_CL && pg8::EWS_CT == WS_CT && pg8::EWS_SSQ == WS_SSQ && pg8::EWS_IW == WS_IW && pg8::EWS_CF == WS_CF && pg8::EWS_IQ == WS_IQ && pg8::EWS_IK == WS_IK && pg8::EWS_G == WS_G && pg8::EWS_QA == WS_QA && pg8::EWS_QB == WS_QB &&
              pg8::EWS_QC == WS_QC && pg8::EWS_KC == WS_KC && pg8::EWS_VC == WS_VC && pg8::EWS_KAB == WS_KAB && pg8::EWS_VAB == WS_VAB, "epilogue offsets");
constexpr int CW_OVF = 8;
constexpr int CW_TICK = 8192;
constexpr int CW_BAR = 4096;
constexpr int RING_OFF = 0, RING_BYTES = 131072;
constexpr int SEL_OFF = 131072;
constexpr int H2_OFF = SEL_OFF + 16384;
constexpr int TMISC_OFF = H2_OFF + 8192;
constexpr int BIAS_OFF = TMISC_OFF + 2048;
constexpr int BKT_OFF = BIAS_OFF + 2048;
constexpr int MISC_OFF = BKT_OFF + 512;
constexpr int LDS_BYTES = 163840;
static_assert(MISC_OFF + 1024 <= LDS_BYTES, "LDS map");
constexpr int NB_OFF = 86016;
static_assert(attn_body::ATTN_LDS_BYTES <= NB_OFF && NB_OFF + 32768 <= RING_BYTES, "LDS map");
constexpr int MW_NSEL = 0, MW_NCAND = 16, MW_BIN = 32, MW_ABOVE = 48, MW_CARRY = 64, MW_BAR = 96, MW_SLOW = 100, MW_TICKET = 101, MW_TBAR = 102, MW_ZCUT = 112, MW_UC = 128, MW_ELO = 160;

#define GAS __attribute__((address_space(1)))
#define LAS __attribute__((address_space(3)))
typedef unsigned short bf16;
typedef unsigned v4u __attribute__((ext_vector_type(4)));
typedef float f32x4 __attribute__((ext_vector_type(4)));
typedef short bf16x8 __attribute__((ext_vector_type(8)));
typedef GAS unsigned gu32;
#define RLX_AGENT __ATOMIC_RELAXED, __HIP_MEMORY_SCOPE_AGENT
#define LDS_WAIT() asm volatile("s_waitcnt lgkmcnt(0)" ::: "memory")
#define VM_WAIT() asm volatile("s_waitcnt vmcnt(0)" ::: "memory")
__device__ __forceinline__ unsigned f2bf(float f) { unsigned u = __builtin_bit_cast(unsigned, f); return (u + 0x7fffu + ((u >> 16) & 1u)) >> 16; }
__device__ __forceinline__ unsigned pk2(float lo, float hi) { return f2bf(lo) | (f2bf(hi) << 16); }

#define XB_TMO      128
#define XB_XCNT(j)  (256  + 64 * (j))
#define XB_XSUB(j)  (1280 + 64 * (j))
#define XB_XGEN(j)  (2304 + 64 * (j))
#define XB_TOP      3328
#define XB_TOPGEN   3392
#define XCD_BAR_WORDS 3456
#define XB_SPIN_CAP (1u << 18)

__device__ __forceinline__ unsigned xb_ld(unsigned* p)              { return __hip_atomic_load(p, __ATOMIC_RELAXED, __HIP_MEMORY_SCOPE_AGENT); }
__device__ __forceinline__ unsigned xb_add(unsigned* p, unsigned v) { return __hip_atomic_fetch_add(p, v, __ATOMIC_RELAXED, __HIP_MEMORY_SCOPE_AGENT); }
__device__ __forceinline__ unsigned xb_xcc_id() { return (unsigned)__builtin_amdgcn_s_getreg((3 << 11) | 20) & 0xFu; }
#define XB_SPIN(cond, bar) do { unsigned _sp = 0; while (cond) { __builtin_amdgcn_s_sleep(1); \
    if ((++_sp & 255u) == 0u) { if (xb_ld(&(bar)[XB_TMO])) break; if (_sp > XB_SPIN_CAP) { atomicAdd(&(bar)[XB_TMO], 1u); break; } } } } while (0)

struct XcdBarrier {
    unsigned* bar; unsigned x;
    volatile LAS unsigned* st;
};

__device__ __forceinline__ XcdBarrier xcd_barrier_post(unsigned* bar, volatile LAS unsigned* st) {
    XcdBarrier b; b.bar = bar; b.x = xb_xcc_id(); b.st = st;
    if (threadIdx.x == 0) (void)xb_add(&bar[XB_XCNT(b.x)], 1u);
    return b;
}
__device__ __forceinline__ void xcd_barrier_complete(unsigned* bar, unsigned x, unsigned& nloc, unsigned& nx) {
    const unsigned G = gridDim.x * gridDim.y * gridDim.z;
    unsigned sum, cnt, mine, sp = 0u;
    for (;;) {
        sum = 0u; cnt = 0u; mine = 0u;
#pragma unroll
        for (unsigned j = 0; j < 16; ++j) { const unsigned c = xb_ld(&bar[XB_XCNT(j)]); sum += c; cnt += (c > 0u) ? 1u : 0u; mine = (j == x) ? c : mine; }
        if (sum == G) break;
        __builtin_amdgcn_s_sleep(1);
        if ((++sp & 255u) == 0u) { if (xb_ld(&bar[XB_TMO])) break; if (sp > XB_SPIN_CAP) { atomicAdd(&bar[XB_TMO], 1u); break; } }
    }
    nloc = mine > 0u ? mine : 1u; nx = cnt > 0u ? cnt : 1u;
}

__device__ __forceinline__ void xcd_barrier(const XcdBarrier& b) {
    asm volatile("s_waitcnt vmcnt(0)" ::: "memory");
    __syncthreads();
    if (threadIdx.x == 0) {
        unsigned* bar = b.bar;
        __builtin_amdgcn_s_waitcnt(0);
        unsigned nloc = b.st[0], nx = b.st[1];
        if (nloc == 0u) { xcd_barrier_complete(bar, b.x, nloc, nx); b.st[0] = nloc; b.st[1] = nx; }
        const unsigned old = xb_add(&bar[XB_XSUB(b.x)], 1u);
        const unsigned gen = old / nloc;
        if (old + 1u == (gen + 1u) * nloc) {
            __builtin_amdgcn_fence(__ATOMIC_RELEASE, "agent");
            asm volatile("s_waitcnt vmcnt(0)" ::: "memory");
            const unsigned og = xb_add(&bar[XB_TOP], 1u);
            const unsigned tg = og / nx;
            if (og + 1u == (tg + 1u) * nx) xb_add(&bar[XB_TOPGEN], 1u);
            else XB_SPIN(xb_ld(&bar[XB_TOPGEN]) == tg, bar);
            __builtin_amdgcn_fence(__ATOMIC_ACQUIRE, "agent");
            xb_add(&bar[XB_XGEN(b.x)], 1u);
            asm volatile("s_waitcnt vmcnt(0)" ::: "memory");
        } else {
            XB_SPIN(xb_ld(&bar[XB_XGEN(b.x)]) == gen, bar);
            __builtin_amdgcn_fence(__ATOMIC_ACQUIRE, "agent");
            asm volatile("s_waitcnt vmcnt(0)" ::: "memory");
        }
    }
    __syncthreads();
}

struct Frame {
    LAS unsigned char* lds;
    volatile LAS unsigned* MISC;
    gu32* ctl;
    int tid, lane, wave, vcu, G;
    LAS unsigned char *ring, *selp, *h2p, *miscp; int wt; unsigned tgen;
};
__device__ __forceinline__ float wave_sum(float v) {
#pragma unroll
    for (int o = 1; o < 64; o <<= 1) v += __shfl_xor(v, o);
    return v;
}
__device__ __forceinline__ float wave_incl_scan(float v, int lane) {
#pragma unroll
    for (int o = 1; o < 64; o <<= 1) { const float t = __shfl_up(v, o); if (lane >= o) v += t; }
    return v;
}
__device__ __forceinline__ int wave_incl_scan_i(int v, int lane) {
#pragma unroll
    for (int o = 1; o < 64; o <<= 1) { const int t = __shfl_up(v, o); if (lane >= o) v += t; }
    return v;
}
__device__ __forceinline__ void transpose_item(const float* W, int N, bf16* WT, int K, int n0, int k0, int scol, const float* kscale, LAS float* scr, int lane) {
#pragma unroll 8
    for (int i = 0; i < 32; ++i) { const int kk = 2 * i + (lane >> 5); float v = 0.f;
        if (scol >= 0) { v = W[(size_t)(k0 + kk) * N + scol]; if (kscale) v *= kscale[k0 + kk]; }
        scr[kk * 33 + (lane & 31)] = v; }
    LDS_WAIT(); asm volatile("" ::: "memory");
    const int c = lane & 7;
#pragma unroll
    for (int j = 0; j < 4; ++j) { const int n = (lane >> 3) + 8 * j; const LAS float* s = scr + (8 * c) * 33 + n;
        v4u o; o.x = pk2(s[0 * 33], s[1 * 33]); o.y = pk2(s[2 * 33], s[3 * 33]); o.z = pk2(s[4 * 33], s[5 * 33]); o.w = pk2(s[6 * 33], s[7 * 33]);
        *(GAS v4u*)(WT + (size_t)(n0 + n) * K + k0 + 8 * c) = o; }
    LDS_WAIT(); asm volatile("" ::: "memory");
}
__device__ __forceinline__ void p0_prologue(Frame& F, const float* x, const float* norm_gain, const float* w_in, const float* w_branch, const float* w_out, unsigned char* ws) {
    LAS float* scr = (LAS float*)(F.lds + RING_OFF + F.wave * 16384);
    const int gw = F.vcu * 8 + F.wave, NGW = F.G * 8, lane = F.lane;
    constexpr int I_W1 = 16 * (NTILES * 256 / 32), I_WB = 8 * 32, I_WO = 16 * 32;
    constexpr int NITEMS = DEPTH * I_W1 + DEPTH * 3 * I_WB + DEPTH * I_WO;
    for (int it = gw; it < NITEMS; it += NGW) {
        int r = it;
        if (r < DEPTH * I_W1) { const int L = r / I_W1; r -= L * I_W1; const int nblk = NTILES * 8, kb = r / nblk, nb = r % nblk, n0 = nb * 32, tile = n0 >> 8, p = (n0 & 255) + (lane & 31);
            const int lc = 64 * ((p >> 5) & 3) + 32 * (p >> 7) + (p & 31);
            transpose_item(w_in + (size_t)L * DMODEL * INC, INC, (bf16*)(ws + WS_W1T) + (size_t)L * NTILES * 256 * 1024, 1024, n0, kb * 64, src_col(tile, lc), norm_gain + L * DMODEL, scr, lane); continue; }
        r -= DEPTH * I_W1;
        if (r < DEPTH * 3 * I_WB) { const int mat = r / I_WB; r -= mat * I_WB; const int kb = r / 32, nb = r % 32;
            transpose_item(w_branch + (size_t)mat * 512 * 1024, 1024, (bf16*)(ws + WS_WBT) + (size_t)mat * 1024 * 512, 512, nb * 32, kb * 64, nb * 32 + (lane & 31), nullptr, scr, lane); continue; }
        r -= DEPTH * 3 * I_WB;
        { const int L = r / I_WO; r -= L * I_WO; const int kb = r / 32, nb = r % 32;
            transpose_item(w_out + (size_t)L * 1024 * 1024, 1024, (bf16*)(ws + WS_WOT) + (size_t)L * 1024 * 1024, 1024, nb * 32, kb * 64, nb * 32 + (lane & 31), nullptr, scr, lane); }
    }
    bf16* XB = (bf16*)(ws + WS_XB); float* SSQ = (float*)(ws + WS_SSQ);
    for (int m = gw; m < M; m += NGW) {
        const GAS f32x4* xr = (const GAS f32x4*)(x + (size_t)m * DMODEL) + lane; f32x4 v[4]; float s = 0.f;
#pragma unroll
        for (int j = 0; j < 4; ++j) { v[j] = xr[64 * j]; s += (v[j].x * v[j].x + v[j].y * v[j].y) + (v[j].z * v[j].z + v[j].w * v[j].w); }
        const float tot = wave_sum(s);
        GAS unsigned long long* o8 = (GAS unsigned long long*)(XB + (size_t)m * DMODEL) + lane;
#pragma unroll
        for (int j = 0; j < 4; ++j) o8[64 * j] = (unsigned long long)pk2(v[j].x, v[j].y) | ((unsigned long long)pk2(v[j].z, v[j].w) << 32);
        if (lane < 16) SSQ[(size_t)m * 16 + lane] = lane == 0 ? tot : 0.f;
    }
}
__device__ __forceinline__ void scan_phase(Frame& F, const float* CF, const float* bforget  , float* CL, float* CT) {
    const int lane = F.lane, h = F.wave;
    for (int u = blockIdx.x; u < 128; u += F.G) { const int b = u >> 5, j = u & 31; const size_t row = (size_t)b * SEQ + 256 * j + 4 * lane; const float bf = bforget[h];
        float s[4]; float run = 0.f;
#pragma unroll
        for (int e = 0; e < 4; ++e) { const float xx = CF[(row + e) * 8 + h] + bf; const float lf = (xx < 0.f ? xx : 0.f) - __logf(1.0f + __expf(-fabsf(xx))); run += lf; s[e] = run; }
        const float incl = wave_incl_scan(run, lane), excl = incl - run;
        *(f32x4*)(CL + (size_t)(b * 8 + h) * SEQ + 256 * j + 4 * lane) = (f32x4){excl + s[0], excl + s[1], excl + s[2], excl + s[3]};
        if (lane == 63) CT[(b * 8 + h) * 32 + j] = incl;
    }
}
#ifndef SPB_IDEAL
#define SPB_IDEAL 0
#endif
#ifndef REP_P2RS
#define REP_P2RS 1
#endif
#ifndef REP_TH
#define REP_TH 1
#endif
#ifndef REP_P2
#define REP_P2 1
#endif
#ifndef REP_RS
#define REP_RS 1
#endif
#ifndef REP_IDX
#define REP_IDX 1
#endif
#ifndef REP_SPB
#define REP_SPB 1
#endif
#ifndef REP_SPA
#define REP_SPA 1
#endif
typedef unsigned u32x2 __attribute__((ext_vector_type(2)));
constexpr int NBIN = 1024;
__device__ __forceinline__ float pdist(float s, float c0, float inv) { return fmaf(s, inv, c0); }
__device__ __forceinline__ unsigned bitop_xa(unsigned a, unsigned mask, unsigned c) { unsigned r; asm("v_bitop3_b32 %0, %1, %2, %3 bitop3:0x48" : "=v"(r) : "v"(a), "s"(mask), "v"(c)); return r; }
__device__ __forceinline__ unsigned pbin4_d(float d) { const unsigned du = __float_as_uint(d);
    unsigned e4 = __builtin_amdgcn_ubfe(du, 17u, 14u); e4 = e4 < 6144u ? 6144u : (e4 > 8191u ? 8191u : e4);
    unsigned b4 = (e4 ^ (unsigned)((int)du >> 31)) & 4092u; asm("" : "+v"(b4)); return b4; }
__device__ __forceinline__ unsigned pbin_d(float d) { return pbin4_d(d) >> 2; }
__device__ __forceinline__ unsigned pbin(float s, float sc, float inv) { return pbin_d(pdist(s, sc, inv)); }
__device__ __forceinline__ float pedge(int b) {
    if (b >= NBIN) return INFINITY; if (b <= 0) return -INFINITY;
    if (b > 512) return __uint_as_float((unsigned)(b - 512 + 1536) << 19);
    if (b == 512) return 0.0f;
    return -__uint_as_float(((unsigned)(511 - b + 1537) << 19) - 1u);
}
#ifndef CFALL
#define CFALL CMAX
#endif
constexpr int NW = 4;
constexpr int QBLK = 4096, CMAX = 512;
#define LDS_ADD(p, v) __hip_atomic_fetch_add((p), (v), __ATOMIC_RELAXED, __HIP_MEMORY_SCOPE_WORKGROUP)
__device__ __forceinline__ unsigned okey(float s) { const unsigned u = __float_as_uint(s); return (u & 0x80000000u) ? ~u : (u | 0x80000000u); }
struct BAParams { const bf16 *IQ, *IK; const float* IW; const bf16 *QA, *QB, *KAB, *VAB; bf16* G; const float* sinks; };
__device__ __forceinline__ void team_barrier(Frame& F) {
    asm volatile("s_waitcnt vmcnt(0) lgkmcnt(0)" ::: "memory");
    LAS unsigned* cnt = (LAS unsigned*)F.miscp + MW_TBAR; F.tgen += (unsigned)NW;
    if (F.lane == 0) __hip_atomic_fetch_add(cnt, 1u, __ATOMIC_RELAXED, __HIP_MEMORY_SCOPE_WORKGROUP);
    for (;;) { const unsigned v = (unsigned)__builtin_amdgcn_readfirstlane((int)*(volatile LAS unsigned*)cnt); if ((int)(v - F.tgen) >= 0) break; __builtin_amdgcn_s_sleep(1); }
    asm volatile("" ::: "memory");
}
typedef float f32x2 __attribute__((ext_vector_type(2)));
typedef int i32x2 __attribute__((ext_vector_type(2)));
__device__ __forceinline__ f32x2 relu2(float a, float b) { i32x2 v = {__float_as_int(a), __float_as_int(b)}; v = __builtin_elementwise_max(v, (i32x2){0, 0}); return __builtin_bit_cast(f32x2, v); }
__device__ __forceinline__ float relu_f(float x) { const int i = __float_as_int(x); return __int_as_float(i > 0 ? i : 0); }

template <int PASS, bool DIAG> __device__ __forceinline__ void idx_tile(const bf16x8 ak, const bf16x8 (&bq)[4], const f32x4 w4, int kt, int g4, int tq, float elo, float ehi, float zsent,
                                                                       unsigned lp4, unsigned hmask, unsigned hinc, LAS unsigned* zh, float sc, float inv, unsigned& accS, unsigned& accC) {
    const f32x4 z = {0.f, 0.f, 0.f, 0.f};
    const f32x4 d0 = __builtin_amdgcn_mfma_f32_16x16x32_bf16(ak, bq[0], z, 0, 0, 0), d1 = __builtin_amdgcn_mfma_f32_16x16x32_bf16(ak, bq[1], z, 0, 0, 0),
                d2 = __builtin_amdgcn_mfma_f32_16x16x32_bf16(ak, bq[2], z, 0, 0, 0), d3 = __builtin_amdgcn_mfma_f32_16x16x32_bf16(ak, bq[3], z, 0, 0, 0);
    float sv[4], dv[4]; unsigned nz = 0;
#pragma unroll
    for (int p2 = 0; p2 < 2; ++p2) { const f32x2 zero2 = {0.f, 0.f};
        f32x2 s2 = __builtin_elementwise_fma((f32x2){w4[0], w4[0]}, relu2(d0[2 * p2], d0[2 * p2 + 1]), zero2);
        s2 = __builtin_elementwise_fma((f32x2){w4[1], w4[1]}, relu2(d1[2 * p2], d1[2 * p2 + 1]), s2);
        s2 = __builtin_elementwise_fma((f32x2){w4[2], w4[2]}, relu2(d2[2 * p2], d2[2 * p2 + 1]), s2);
        s2 = __builtin_elementwise_fma((f32x2){w4[3], w4[3]}, relu2(d3[2 * p2], d3[2 * p2 + 1]), s2);
        const f32x2 dd = __builtin_elementwise_fma(s2, (f32x2){inv, inv}, (f32x2){sc, sc});
        sv[2 * p2] = s2[0]; sv[2 * p2 + 1] = s2[1]; dv[2 * p2] = dd[0]; dv[2 * p2 + 1] = dd[1]; }
    if (PASS == 1) {
#pragma unroll
        for (int i = 0; i < 4; ++i) { const float s = sv[i], d = dv[i];
            const int key = 16 * kt + 4 * g4 + i; const bool ok = !DIAG || key <= tq;
            if (ok) { const unsigned b4 = pbin4_d(d); LDS_ADD((LAS unsigned*)(uintptr_t)((b4 << 4) + ((b4 ^ lp4) & hmask)), hinc);
                      if (DIAG) nz += (s == 0.0f) ? 1u : 0u; } }
        if (!DIAG) { unsigned long long t0_, t1_, t2_;
            asm volatile("v_cmp_eq_f32 vcc, 0, %[s0]\n\tv_cmp_eq_f32 %[t0], 0, %[s1]\n\tv_cmp_eq_f32 %[t1], 0, %[s2]\n\tv_cmp_eq_f32 %[t2], 0, %[s3]\n\t"
                         "v_addc_co_u32 %[nz], vcc, 0, %[nz], vcc\n\tv_addc_co_u32 %[nz], %[t0], 0, %[nz], %[t0]\n\tv_addc_co_u32 %[nz], %[t1], 0, %[nz], %[t1]\n\tv_addc_co_u32 %[nz], %[t2], 0, %[nz], %[t2]"
                         : [nz] "+v"(nz), [t0] "=&s"(t0_), [t1] "=&s"(t1_), [t2] "=&s"(t2_) : [s0] "v"(sv[0]), [s1] "v"(sv[1]), [s2] "v"(sv[2]), [s3] "v"(sv[3]) : "vcc"); }
        if (nz) LDS_ADD(zh + (kt >> 3), nz);
    } else if (DIAG) {
#pragma unroll
        for (int i = 3; i >= 0; --i) { const int key = 16 * kt + 4 * g4 + i; const bool ok = key <= tq;
            accS = 2u * accS + ((ok && dv[i] >= ehi) ? 1u : 0u); accC = 2u * accC + ((ok && dv[i] >= elo && sv[i] != zsent) ? 1u : 0u); }
    } else {
        unsigned long long t0_, t1_;
#define IDX_FL(D_, S_) "v_cmp_ge_f32 vcc, %[" #D_ "], %[ehi]\n\tv_cmp_ge_f32 %[t0], %[" #D_ "], %[elo]\n\tv_cmp_neq_f32 %[t1], %[" #S_ "], %[zs]\n\tv_addc_co_u32 %[as], vcc, %[as], %[as], vcc\n\ts_and_b64 %[t0], %[t0], %[t1]\n\tv_addc_co_u32 %[ac], %[t1], %[ac], %[ac], %[t0]\n\t"
        asm volatile(IDX_FL(d3, s3) IDX_FL(d2, s2) IDX_FL(d1, s1) IDX_FL(d0, s0)
                     : [as] "+v"(accS), [ac] "+v"(accC), [t0] "=&s"(t0_), [t1] "=&s"(t1_)
                     : [d0] "v"(dv[0]), [d1] "v"(dv[1]), [d2] "v"(dv[2]), [d3] "v"(dv[3]), [s0] "v"(sv[0]), [s1] "v"(sv[1]), [s2] "v"(sv[2]), [s3] "v"(sv[3]), [ehi] "v"(ehi), [elo] "v"(elo), [zs] "v"(zsent) : "vcc", "scc");
#undef IDX_FL
    }
}
template <int PASS> __device__ __forceinline__ void idx_pass(Frame& F, const bf16* IKb, const bf16x8 (&bq)[4], const f32x4 w4, int tau, int t0) {
    int lane_ = F.lane; asm volatile("" : "+v"(lane_)); const int lane = lane_, r = lane & 15, g4 = lane >> 4, tq = t0 + r;
    const unsigned hbase = (unsigned)(uintptr_t)F.ring, hmask = 60u | hbase, lp = ((((unsigned)lane >> 1) & 15u) * 4u) | hbase, hinc = 1u << ((lane & 1) * 16);
    LAS unsigned* misc = (LAS unsigned*)(F.miscp);
    float elo = 0.f, ehi = 0.f; int zcut = SEQ; if (PASS == 2) { elo = __uint_as_float(misc[MW_ELO + r]); ehi = __uint_as_float(misc[MW_ELO + 16 + r]); zcut = (int)misc[MW_ZCUT + r]; }
    LAS unsigned* zh = (LAS unsigned*)(F.h2p) + r * 64;
    LAS unsigned* bw = (LAS unsigned*)(F.ring + r * QBLK) + F.wt * 4 + g4;
    const bf16* kp = IKb + (size_t)r * 32 + 8 * g4;
    float sc, inv;
    if (PASS == 2) { sc = __uint_as_float(misc[MW_UC + r]); inv = __uint_as_float(misc[MW_UC + 16 + r]); }
    else { const bf16x8 at = *(const bf16x8*)kp; const f32x4 z = {0.f, 0.f, 0.f, 0.f};
        const f32x4 d0 = __builtin_amdgcn_mfma_f32_16x16x32_bf16(at, bq[0], z, 0, 0, 0), d1 = __builtin_amdgcn_mfma_f32_16x16x32_bf16(at, bq[1], z, 0, 0, 0),
                    d2 = __builtin_amdgcn_mfma_f32_16x16x32_bf16(at, bq[2], z, 0, 0, 0), d3 = __builtin_amdgcn_mfma_f32_16x16x32_bf16(at, bq[3], z, 0, 0, 0);
        float mx = -INFINITY, ma = 0.f;
#pragma unroll
        for (int i = 0; i < 4; ++i) { float s = 0.f; s = fmaf(w4[0], relu_f(d0[i]), s); s = fmaf(w4[1], relu_f(d1[i]), s); s = fmaf(w4[2], relu_f(d2[i]), s); s = fmaf(w4[3], relu_f(d3[i]), s); mx = fmaxf(mx, s); ma = fmaxf(ma, fabsf(s)); }
        mx = fmaxf(mx, __shfl_xor(mx, 16)); mx = fmaxf(mx, __shfl_xor(mx, 32)); ma = fmaxf(ma, __shfl_xor(ma, 16)); ma = fmaxf(ma, __shfl_xor(ma, 32));
        inv = (ma > 1e-30f && ma < 1e30f) ? __builtin_amdgcn_rcpf(ma) * 0.0078125f : 0.0078125f; sc = -(mx * inv);
        if (PASS == 1 && F.wt == 0 && g4 == 0) { misc[MW_UC + r] = __float_as_uint(sc); misc[MW_UC + 16 + r] = __float_as_uint(inv); } }
    constexpr int NPF = 8;
    unsigned accS = 0u, accC = 0u; int n = 0;
    bf16x8 A[NPF];
#pragma unroll
    for (int j = 0; j < NPF; ++j) { const int kj = F.wt + NW * j; A[j] = *(const bf16x8*)(kp + (size_t)(kj < tau ? kj : tau) * 512); }
    int kt = F.wt;
    static_assert(NPF == 8, "a full round of the loop below is one bitmap word (8 tiles) per lane");
#pragma unroll 1
    for (; kt + NW * (NPF - 1) < tau; kt += NW * NPF) {
#pragma unroll
        for (int j = 0; j < NPF; ++j) { const int kj = kt + NW * j;
            const float zsent = (PASS == 2 && 16 * kj < zcut) ? __uint_as_float(0x7fc00000u) : 0.0f;
            idx_tile<PASS, false>(A[j], bq, w4, kj, g4, tq, elo, ehi, zsent, lp, hmask, hinc, zh, sc, inv, accS, accC);
            const int kn = kj + NW * NPF; A[j] = *(const bf16x8*)(kp + (size_t)(kn < tau ? kn : tau) * 512); }
        if (PASS == 2) { LAS unsigned* wp = bw + n * (NW / 2); wp[0] = accS; wp[256] = accC; accS = 0u; accC = 0u; n += 8; }
    }
#pragma unroll 1
    for (; kt < tau; kt += NW * NPF) {
#pragma unroll
        for (int j = 0; j < NPF; ++j) { const int kj = kt + NW * j;
            if (kj < tau) {
                const float zsent = (PASS == 2 && 16 * kj < zcut) ? __uint_as_float(0x7fc00000u) : 0.0f;
                idx_tile<PASS, false>(A[j], bq, w4, kj, g4, tq, elo, ehi, zsent, lp, hmask, hinc, zh, sc, inv, accS, accC);
                if (PASS == 2) { ++n; if ((n & 7) == 0) { LAS unsigned* wp = bw + (n - 8) * (NW / 2); wp[0] = accS; wp[256] = accC; accS = 0u; accC = 0u; } }
            }
            const int kn = kj + NW * NPF; A[j] = *(const bf16x8*)(kp + (size_t)(kn < tau ? kn : tau) * 512); }
    }
    if ((tau & (NW - 1)) == F.wt) {
        const bf16x8 ad = *(const bf16x8*)(kp + (size_t)tau * 512);
        const float zsent = (PASS == 2 && 16 * tau < zcut) ? __uint_as_float(0x7fc00000u) : 0.0f;
        idx_tile<PASS, true>(ad, bq, w4, tau, g4, tq, elo, ehi, zsent, lp, hmask, hinc, zh, sc, inv, accS, accC);
        if (PASS == 2) { ++n; if ((n & 7) == 0) { LAS unsigned* wp = bw + (n - 8) * (NW / 2); wp[0] = accS; wp[256] = accC; accS = 0u; accC = 0u; } }
    }
    if (PASS == 2 && (n & 7)) { const int sh = 4 * (8 - (n & 7)); LAS unsigned* wp = bw + (n & ~7) * (NW / 2); wp[0] = accS << sh; wp[256] = accC << sh; }
}
struct ThrRes { int Ls, bs, above; unsigned zcut; };
__device__ __forceinline__ ThrRes idx_thr_one(Frame& F, int q, int lane, const LAS unsigned* misc) {
    const unsigned sh = (q & 1) * 16, qh = (unsigned)q >> 1;
    const LAS unsigned* hb = (const LAS unsigned*)(F.ring);
    int cnt[16];
#pragma unroll
    for (int k = 0; k < 16; ++k) { const unsigned bin = 64u * k + lane, sw = bin & 15u; const LAS unsigned* p = hb + bin * 16u;
        cnt[k] = (int)(((p[qh ^ sw] >> sh) & 0xffffu) + ((p[(qh + 8u) ^ sw] >> sh) & 0xffffu)); }
    int a8[8], a4[4], a2[2], a1;
    { const bool h5 = lane & 32, h4 = lane & 16, h3 = lane & 8, h2 = lane & 4;
#pragma unroll
      for (int i = 0; i < 8; ++i) { const int mine = h5 ? cnt[8 + i] : cnt[i], theirs = h5 ? cnt[i] : cnt[8 + i]; a8[i] = mine + __shfl_xor(theirs, 32); }
#pragma unroll
      for (int i = 0; i < 4; ++i) { const int mine = h4 ? a8[4 + i] : a8[i], theirs = h4 ? a8[i] : a8[4 + i]; a4[i] = mine + __shfl_xor(theirs, 16); }
#pragma unroll
      for (int i = 0; i < 2; ++i) { const int mine = h3 ? a4[2 + i] : a4[i], theirs = h3 ? a4[i] : a4[2 + i]; a2[i] = mine + __shfl_xor(theirs, 8); }
      { const int mine = h2 ? a2[1] : a2[0], theirs = h2 ? a2[0] : a2[1]; a1 = mine + __shfl_xor(theirs, 4); }
      a1 += __shfl_xor(a1, 1); a1 += __shfl_xor(a1, 2); }
    int ks = 0, aseg = 0, v = cnt[0]; { int cum = 0; bool found = false;
#pragma unroll
        for (int k = 15; k >= 0; --k) { const int Tk = __builtin_amdgcn_readlane(a1, 4 * k); if (!found && cum + Tk >= 256) { found = true; ks = k; aseg = cum; v = cnt[k]; } cum += Tk; } }
    const int pre = wave_incl_scan_i(v, lane);
    int tot = pre; tot = __shfl(tot, 63);
    const int suf = tot - pre + v;
    const unsigned long long mask = __ballot(aseg + suf >= 256);
    const int Ls = mask ? 63 - (int)__builtin_clzll(mask) : 0;
    const int binstar = __shfl(64 * ks + lane, Ls), above = __shfl(aseg + suf - v, Ls), needz = 256 - above;
    const int zc = (int)((const LAS unsigned*)(F.h2p))[q * 64 + lane]; const int zi = wave_incl_scan_i(zc, lane);
    const unsigned long long zm = __ballot(zi >= needz);
    ThrRes R; R.Ls = Ls; R.bs = binstar; R.above = above;
    R.zcut = (binstar == (int)pbin(0.0f, __uint_as_float(misc[MW_UC + q]), __uint_as_float(misc[MW_UC + 16 + q])) && zm) ? (unsigned)(128 * ((int)__builtin_ctzll(zm) + 1)) : (unsigned)SEQ;
    return R;
}
__device__ __forceinline__ void idx_threshold(Frame& F) {
    int lane_ = F.lane; asm volatile("" : "+v"(lane_)); const int lane = lane_; LAS unsigned* misc = (LAS unsigned*)(F.miscp);
    const int q0 = NW * F.wt;
    const ThrRes R0 = idx_thr_one(F, q0, lane, misc), R1 = idx_thr_one(F, q0 + 1, lane, misc), R2 = idx_thr_one(F, q0 + 2, lane, misc), R3 = idx_thr_one(F, q0 + 3, lane, misc);
    if (lane < 4) { const ThrRes R = lane == 0 ? R0 : (lane == 1 ? R1 : (lane == 2 ? R2 : R3)); const int q = q0 + lane;
        misc[MW_BIN + q] = (unsigned)R.bs; misc[MW_ABOVE + q] = (unsigned)R.above; misc[MW_ZCUT + q] = R.zcut;
        misc[MW_ELO + q] = __float_as_uint(pedge(R.bs)); misc[MW_ELO + 16 + q] = __float_as_uint(pedge(R.bs + 1)); }
}
__device__ __forceinline__ unsigned idx_digit(const u32x2 e, int lvl) { const unsigned v = 8191u - e.y;
    return lvl == 0 ? e.x >> 24 : lvl == 1 ? (e.x >> 16) & 255u : lvl == 2 ? (e.x >> 8) & 255u : lvl == 3 ? e.x & 255u : lvl == 4 ? (v >> 5) & 255u : v & 31u; }
#define IDX_EXPAND(W4_, POS_, EMIT_) do { const int kb_ = 512 * (lane >> 4) + 16 * ((lane >> 2) & 3) + 4 * (lane & 3); \
    _Pragma("unroll") for (int g_ = 0; g_ < 4; ++g_) { unsigned w_ = (W4_)[g_]; \
        while (w_) { const int b_ = (int)__builtin_ctz(w_); w_ &= w_ - 1u; const int key_ = kb_ + 2048 * g_ + 64 * (7 - (b_ >> 2)) + (b_ & 3); EMIT_(POS_, key_); ++POS_; } } } while (0)
__device__ __forceinline__ void idx_rescore(const LAS unsigned* keyp, int kstr, LAS unsigned* outp, int ostr, int n, int q, int lane, const bf16* IKb, const bf16x8 (&bq)[4], const f32x4 w4) {
    const int r = lane & 15, g4 = lane >> 4; bf16x8 ak[4];
#pragma unroll
    for (int u = 0; u < 4; ++u) { const int ci = 16 * u + r; const unsigned key = ci < n ? keyp[ci * kstr] : 0u; ak[u] = *(const bf16x8*)(IKb + (size_t)key * 32 + 8 * g4); }
#pragma unroll
    for (int u = 0; u < 4; ++u) { if (16 * u < n) { const f32x4 z = {0.f, 0.f, 0.f, 0.f};
        const f32x4 d0 = __builtin_amdgcn_mfma_f32_16x16x32_bf16(ak[u], bq[0], z, 0, 0, 0), d1 = __builtin_amdgcn_mfma_f32_16x16x32_bf16(ak[u], bq[1], z, 0, 0, 0),
                    d2 = __builtin_amdgcn_mfma_f32_16x16x32_bf16(ak[u], bq[2], z, 0, 0, 0), d3 = __builtin_amdgcn_mfma_f32_16x16x32_bf16(ak[u], bq[3], z, 0, 0, 0);
#pragma unroll
        for (int i = 0; i < 4; ++i) { float sx = 0.f; sx = fmaf(w4[0], relu_f(d0[i]), sx); sx = fmaf(w4[1], relu_f(d1[i]), sx); sx = fmaf(w4[2], relu_f(d2[i]), sx); sx = fmaf(w4[3], relu_f(d3[i]), sx);
            const int ci = 16 * u + 4 * g4 + i; if (r == q && ci < n) outp[ci * ostr] = okey(sx); } } }
}
__device__ __forceinline__ void idx_pick_digit(const LAS unsigned* h2, int need, int lane, unsigned& dstar, int& above, int& inside) {
    const v4u hw = *(const LAS v4u*)(h2 + 252 - 4 * lane);
    const int total = (int)(hw.x + hw.y + hw.z + hw.w), incl = wave_incl_scan_i(total, lane);
    const unsigned long long mask = __ballot(incl >= need);
    const int Ls = mask ? (int)__builtin_ctzll(mask) : 63;
    int dstar_l = 0, above_l = 0, in_l = 0; { int cum = incl - total; bool found = false;
#pragma unroll
        for (int e = 3; e >= 0; --e) { const int cc = (int)hw[e]; if (!found && cum + cc >= need) { found = true; dstar_l = 252 - 4 * lane + e; above_l = cum; in_l = cc; } cum += cc; } }
    dstar = (unsigned)__shfl(dstar_l, Ls); above = __shfl(above_l, Ls); inside = __shfl(in_l, Ls);
}
template <int MODE> __device__ __forceinline__ void idx_sweep(int lvl, unsigned dstar, v4u& wc, LAS unsigned* stg, LAS unsigned* h2, LAS unsigned* nselp, LAS unsigned short* sel,
                                                              int q, int lane, const bf16* IKb, const bf16x8 (&bq)[4], const f32x4 w4) {
    v4u w = wc; const int kb = 512 * (lane >> 4) + 16 * ((lane >> 2) & 3) + 4 * (lane & 3);
    while (__ballot((w.x | w.y | w.z | w.w) != 0u)) {
        const bool has = (w.x | w.y | w.z | w.w) != 0u;
        const int g = w.x ? 0 : (w.y ? 1 : (w.z ? 2 : 3));
        const unsigned cur = w.x ? w.x : (w.y ? w.y : (w.z ? w.z : w.w));
        const int b = has ? (int)__builtin_ctz(cur) : 0; const unsigned bit = has ? (1u << b) : 0u;
        const int key = has ? kb + 2048 * g + 64 * (7 - (b >> 2)) + (b & 3) : 0;
        stg[lane] = (unsigned)key;
        idx_rescore(stg, 1, stg + 64, 1, 64, q, lane, IKb, bq, w4);
        const u32x2 e = {stg[64 + lane], (unsigned)key}; const unsigned dg = idx_digit(e, lvl);
        if (has) {
            if (MODE == 0) LDS_ADD(h2 + dg, 1u);
            else { if (dg > dstar) { const unsigned pos = LDS_ADD(nselp, 1u); if (pos < 256u) sel[pos] = (unsigned short)key; }
                   if (dg != dstar) { wc.x &= g == 0 ? ~bit : ~0u; wc.y &= g == 1 ? ~bit : ~0u; wc.z &= g == 2 ? ~bit : ~0u; wc.w &= g == 3 ? ~bit : ~0u; } }
        }
        w.x &= g == 0 ? ~bit : ~0u; w.y &= g == 1 ? ~bit : ~0u; w.z &= g == 2 ? ~bit : ~0u; w.w &= g == 3 ? ~bit : ~0u;
    }
}
__device__ __forceinline__ void idx_resolve(Frame& F, const bf16* IKb, const bf16x8 (&bq)[4], const f32x4 w4, int tau) {
    int lane_ = F.lane; asm volatile("" : "+v"(lane_)); const int lane = lane_; LAS unsigned* misc = (LAS unsigned*)(F.miscp);
    LAS unsigned* h2 = (LAS unsigned*)(F.h2p) + F.wt * 256;
    for (int qq = 0; qq < NW; ++qq) { const int q = NW * F.wt + qq;
        LAS u32x2* cq = (LAS u32x2*)(F.ring + q * QBLK);
        LAS unsigned short* sel = (LAS unsigned short*)(F.selp) + q * 256;
        v4u ws, wc; { const LAS unsigned* bmp = (const LAS unsigned*)(F.ring + q * QBLK) + lane; const int wv = (lane >> 2) & 3, m0 = lane >> 4;
#pragma unroll
            for (int g = 0; g < 4; ++g) { const bool ok = wv + 32 * (m0 + 4 * g) <= tau;
                ws[g] = ok ? bmp[64 * g] : 0u; wc[g] = ok ? bmp[256 + 64 * g] : 0u; } }
        wc.x &= ~ws.x; wc.y &= ~ws.y; wc.z &= ~ws.z; wc.w &= ~ws.w;
        const int nS = (int)(__builtin_popcount(ws.x) + __builtin_popcount(ws.y) + __builtin_popcount(ws.z) + __builtin_popcount(ws.w));
        int nC = (int)(__builtin_popcount(wc.x) + __builtin_popcount(wc.y) + __builtin_popcount(wc.z) + __builtin_popcount(wc.w));
        const int iS = wave_incl_scan_i(nS, lane); int iC = wave_incl_scan_i(nC, lane);
        const int totS = __shfl(iS, 63); int c = __shfl(iC, 63);
        { int pos = iS - nS;
#define EMIT_SEL(P_, K_) do { sel[(P_) < 255 ? (P_) : 255] = (unsigned short)(K_); } while (0)
          IDX_EXPAND(ws, pos, EMIT_SEL);
#undef EMIT_SEL
        }
        if (lane == 0) misc[MW_NSEL + q] = (unsigned)(totS < 256 ? totS : 256);
        int need = 256 - totS; if (need < 0) need = 0;
        if (c > CFALL && c > need) {
#pragma unroll 1
            for (int lvl = 0; lvl < 6 && c > CFALL; ++lvl) {
                *(LAS v4u*)(h2 + 4 * lane) = (v4u){0u, 0u, 0u, 0u};
                idx_sweep<0>(lvl, 0u, wc, (LAS unsigned*)cq, h2, misc + MW_NSEL + q, sel, q, lane, IKb, bq, w4);
                unsigned dstar; int above, inside; idx_pick_digit(h2, need, lane, dstar, above, inside);
                idx_sweep<1>(lvl, dstar, wc, (LAS unsigned*)cq, h2, misc + MW_NSEL + q, sel, q, lane, IKb, bq, w4);
                c = inside; need -= above;
            }
            if (c > CMAX) { if (lane == 0) __hip_atomic_fetch_add(F.ctl + CW_OVF, 1u, RLX_AGENT); c = 0; need = 0; wc = (v4u){0u, 0u, 0u, 0u}; }
            nC = (int)(__builtin_popcount(wc.x) + __builtin_popcount(wc.y) + __builtin_popcount(wc.z) + __builtin_popcount(wc.w)); iC = wave_incl_scan_i(nC, lane);
        }
        { int pos = iC - nC;
#define EMIT_CAND(P_, K_) do { if ((P_) < CMAX) cq[(P_)] = (u32x2){0u, (unsigned)(K_)}; } while (0)
          IDX_EXPAND(wc, pos, EMIT_CAND);
#undef EMIT_CAND
        }
        if (c > need)
            for (int c0 = 0; c0 < c; c0 += 64) idx_rescore((const LAS unsigned*)cq + 2 * c0 + 1, 2, (LAS unsigned*)cq + 2 * c0, 2, c - c0 < 64 ? c - c0 : 64, q, lane, IKb, bq, w4);
        if (c > need && c <= 64) {
            u32x2 e = {0u, 0u}; if (lane < c) e = cq[lane]; int rank = 0;
            const int cu = __builtin_amdgcn_readfirstlane(c);
#pragma unroll 1
            for (int j = 0; j < cu; j += 4) {
#pragma unroll
                for (int k = 0; k < 4; ++k) { const unsigned uj = (unsigned)__builtin_amdgcn_readlane((int)e.x, (j + k) & 63), ij = (unsigned)__builtin_amdgcn_readlane((int)e.y, (j + k) & 63); rank += (uj > e.x || (uj == e.x && ij < e.y)) ? 1 : 0; } }
            if (lane < c && rank < need) { const unsigned pos = LDS_ADD(misc + MW_NSEL + q, 1u); if (pos < 256u) sel[pos] = (unsigned short)e.y; }
            c = 0; need = 0;
        }
#pragma unroll 1
        for (int lvl = 0; lvl < 6 && c > need; ++lvl) {
            *(LAS v4u*)(h2 + 4 * lane) = (v4u){0u, 0u, 0u, 0u};
            for (int i = lane; i < c; i += 64) LDS_ADD(h2 + idx_digit(cq[i], lvl), 1u);
            const v4u hw = *(const LAS v4u*)(h2 + 252 - 4 * lane);
            const int total = (int)(hw.x + hw.y + hw.z + hw.w), incl = wave_incl_scan_i(total, lane);
            const unsigned long long mask = __ballot(incl >= need);
            const int Ls = mask ? (int)__builtin_ctzll(mask) : 63;
            int dstar_l = 0, above_l = 0; { int cum = incl - total; bool found = false;
#pragma unroll
                for (int e = 3; e >= 0; --e) { const int cc = (int)hw[e]; if (!found && cum + cc >= need) { found = true; dstar_l = 252 - 4 * lane + e; above_l = cum; } cum += cc; } }
            const unsigned dstar = (unsigned)__shfl(dstar_l, Ls); const int above = __shfl(above_l, Ls);
            int c2 = 0;
            for (int base = 0; base < c; base += 64) { const int i = base + lane; const bool valid = i < c; u32x2 e = {0u, 0u}; if (valid) e = cq[i];
                const unsigned dg = idx_digit(e, lvl); const bool tie = valid && dg == dstar;
                if (valid && dg > dstar) { const unsigned pos = LDS_ADD(misc + MW_NSEL + q, 1u); if (pos < 256u) sel[pos] = (unsigned short)e.y; }
                const unsigned long long tm = __ballot(tie);
                if (tie) cq[c2 + __popcll(tm & ((1ull << lane) - 1ull))] = e;
                c2 += __popcll(tm); }
            c = c2; need -= above;
        }
        for (int i = lane; i < c && i < need; i += 64) { const unsigned pos = LDS_ADD(misc + MW_NSEL + q, 1u); if (pos < 256u) sel[pos] = (unsigned short)cq[i].y; }
    }
}
typedef short s16x4 __attribute__((ext_vector_type(4)));
__device__ __forceinline__ unsigned cvt_pk_bf16x2(float lo, float hi) { unsigned r_; asm("v_cvt_pk_bf16_f32 %0, %1, %2" : "=v"(r_) : "v"(lo), "v"(hi)); return r_; }
__device__ __forceinline__ void sp_glds16(const void* gsrc, unsigned lds_dst) { unsigned keep;
    asm volatile("s_mov_b32 %0, m0\n\ts_mov_b32 m0, %2\n\ts_nop 0\n\tglobal_load_lds_dwordx4 %1, off\n\ts_mov_b32 m0, %0" : "=&s"(keep) : "v"(gsrc), "s"(lds_dst) : "memory"); }
__device__ __forceinline__ void sp_glds16s(const void* sbase, unsigned voff, unsigned lds_dst) { unsigned keep;
    asm volatile("s_mov_b32 %0, m0\n\ts_mov_b32 m0, %3\n\ts_nop 0\n\tglobal_load_lds_dwordx4 %1, %2\n\ts_mov_b32 m0, %0" : "=&s"(keep) : "v"(voff), "s"(sbase), "s"(lds_dst) : "memory"); }
__device__ __forceinline__ void sp_glds16s_x4(const void* sbase, unsigned v0, unsigned v1, unsigned v2, unsigned v3, unsigned lds_dst) { unsigned keep;
    asm volatile("s_mov_b32 %0, m0\n\ts_mov_b32 m0, %6\n\ts_nop 0\n\tglobal_load_lds_dwordx4 %1, %5\n\ts_add_u32 m0, m0, 0x400\n\ts_nop 0\n\tglobal_load_lds_dwordx4 %2, %5\n\ts_add_u32 m0, m0, 0x400\n\ts_nop 0\n\tglobal_load_lds_dwordx4 %3, %5\n\ts_add_u32 m0, m0, 0x400\n\ts_nop 0\n\tglobal_load_lds_dwordx4 %4, %5\n\ts_mov_b32 m0, %0"
                 : "=&s"(keep) : "v"(v0), "v"(v1), "v"(v2), "v"(v3), "s"(sbase), "s"(lds_dst) : "memory", "scc"); }
template <bool IS_A> __device__ __forceinline__ void sparse_pair(Frame& F, const BAParams& P, int rb, int tA, int qi0, int nv0, int nv1, bool dry) {
    constexpr int NC = IS_A ? 8 : 16, NSLOT = NC * 16, KOFF = IS_A ? 0 : M * 128, HB = IS_A ? 0 : 8, GOFF = IS_A ? 0 : 512;
    int lane_ = F.lane; asm volatile("" : "+v"(lane_)); const int lane = lane_, r = lane & 15, g4 = lane >> 4, my_a = g4 >> 1, my_j = g4 & 1;
    const bf16* Q = IS_A ? P.QA : P.QB;
    const LAS unsigned short* sel = (const LAS unsigned short*)(F.selp) + qi0 * 256;
    const LAS float* BIAS = (const LAS float*)(F.lds + BIAS_OFF);
    const LAS unsigned char* BKT = (const LAS unsigned char*)(F.lds + BKT_OFF);
    LAS unsigned short* Pimg = (LAS unsigned short*)(F.ring + F.wt * 16384);
    bf16x8 q0, q1; const bf16x8 zz = {0, 0, 0, 0, 0, 0, 0, 0};
    { const int a_r = r >> 3, hd = r & 7; const bf16* qp = Q + (size_t)(rb + tA + a_r) * 512 + hd * 64 + 8 * g4; q0 = *(const bf16x8*)qp; q1 = *(const bf16x8*)(qp + 32); }
    const int my_t = tA + my_a, rcb = r >> 2;
    f32x4 x[NC];
#pragma unroll
    for (int c = 0; c < NC; ++c) x[c] = (f32x4){0.f, 0.f, 0.f, 0.f};
    constexpr int KS = NSLOT / 32, NST = 4 * KS;
    const unsigned wk = (unsigned)__builtin_amdgcn_readfirstlane((int)((unsigned)(uintptr_t)(F.ring) + (unsigned)F.wt * 16384u));
    const int drow = lane >> 3, dpc = lane & 7;
#define SP_KDMA(st, bufi) do { const int cb_ = (st) / KS, ks_ = (st) % KS, a_ = cb_ >> 1, j_ = cb_ & 1; unsigned vo_[4]; \
        _Pragma("unroll") for (int i_ = 0; i_ < 4; ++i_) { const int slot_ = 32 * ks_ + 8 * i_ + drow; int key_; \
            if (IS_A) { key_ = tA + a_ - slot_; key_ = key_ < 0 ? 0 : key_; } else { key_ = (SPB_IDEAL && dry) ? slot_ : (int)sel[a_ * 256 + slot_]; }   \
            vo_[i_] = (unsigned)(((rb + key_) * 128 + KOFF + j_ * 64 + ((dpc ^ (drow & 7)) * 8)) * 2); } \
        sp_glds16s_x4(P.KAB, vo_[0], vo_[1], vo_[2], vo_[3], (unsigned)__builtin_amdgcn_readfirstlane((int)(wk + (unsigned)((bufi) * 4096)))); } while (0)
    const unsigned wl = wk + 4096u;
#define SP_VDMA(st, bufi) do { const int cb_ = (st) / KS, ks_ = (st) % KS, a_ = cb_ >> 1, j_ = cb_ & 1; unsigned vo_[4]; \
        _Pragma("unroll") for (int i_ = 0; i_ < 4; ++i_) { const int slot_ = 32 * ks_ + 8 * i_ + drow; int key_; \
            if (IS_A) { key_ = tA + a_ - slot_; key_ = key_ < 0 ? 0 : key_; } else { key_ = (SPB_IDEAL && dry) ? slot_ : (int)sel[a_ * 256 + slot_]; } \
            vo_[i_] = (unsigned)(((rb + key_) * 128 + KOFF + j_ * 64 + dpc * 8) * 2); } \
        sp_glds16s_x4(P.VAB, vo_[0], vo_[1], vo_[2], vo_[3], (unsigned)__builtin_amdgcn_readfirstlane((int)(wl + (unsigned)((bufi) * 4096)))); } while (0)
    asm volatile("s_waitcnt lgkmcnt(0)" ::: "memory");
    SP_KDMA(0, 0); SP_KDMA(1, 1); SP_KDMA(2, 2); if (NST > 3) SP_KDMA(3, 3);
    { const LAS unsigned char* kring = F.ring + F.wt * 16384;
      static_assert(KS % 4 == 0, "the ring position of a step is its k-step index mod 4");
#pragma unroll 1
      for (int cb = 0; cb < 4; ++cb) { const bool mine = rcb == cb; const bf16x8 a0 = mine ? q0 : zz, a1 = mine ? q1 : zz;
#pragma unroll
        for (int ks = 0; ks < KS; ++ks) { const int st = cb * KS + ks;
          if (cb < 3 || ks + 3 < KS) asm volatile("s_waitcnt vmcnt(12)" ::: "memory"); else asm volatile("s_waitcnt vmcnt(8)" ::: "memory");
          const LAS unsigned char* kb = kring + (ks & 3) * 4096;
          bf16x8 f[2][2];
#pragma unroll
          for (int cc = 0; cc < 2; ++cc)
#pragma unroll
              for (int k2 = 0; k2 < 2; ++k2) f[cc][k2] = *(const LAS bf16x8*)(kb + (16 * cc + r) * 128 + (((4 * k2 + g4) ^ (r & 7)) * 16));
          int kn_[4] = {0, 0, 0, 0}; const int cbn_ = (st + 4) / KS, an_ = cbn_ >> 1, jn_ = cbn_ & 1;
          if (st + 4 < NST) {
#pragma unroll
              for (int i_ = 0; i_ < 4; ++i_) { const int slot_ = 32 * ((ks + 4) % KS) + 8 * i_ + drow; if (IS_A) { int k_ = tA + an_ - slot_; kn_[i_] = k_ < 0 ? 0 : k_; } else kn_[i_] = (SPB_IDEAL && dry) ? slot_ : (int)sel[an_ * 256 + slot_]; } }
          asm volatile("s_waitcnt lgkmcnt(0)" ::: "memory");
          if (st + 4 < NST) { unsigned vo_[4];
#pragma unroll
              for (int i_ = 0; i_ < 4; ++i_) vo_[i_] = (unsigned)(((rb + kn_[i_]) * 128 + KOFF + jn_ * 64 + ((dpc ^ (drow & 7)) * 8)) * 2);
              sp_glds16s_x4(P.KAB, vo_[0], vo_[1], vo_[2], vo_[3], (unsigned)__builtin_amdgcn_readfirstlane((int)(wk + (unsigned)((ks & 3) * 4096)))); }
#pragma unroll
          for (int cc = 0; cc < 2; ++cc) { x[2 * ks + cc] = __builtin_amdgcn_mfma_f32_16x16x32_bf16(a0, f[cc][0], x[2 * ks + cc], 0, 0, 0); x[2 * ks + cc] = __builtin_amdgcn_mfma_f32_16x16x32_bf16(a1, f[cc][1], x[2 * ks + cc], 0, 0, 0); }
          if (ks + 3 >= KS && cb == 3) { if (ks + 3 == KS) SP_VDMA(0, 0); else if (ks + 2 == KS) SP_VDMA(1, 1); else SP_VDMA(2, 2); }
        } } }
#undef SP_KDMA
#pragma unroll
    for (int c = 0; c < NC; ++c) { const int slot = 16 * c + r; int mk; bool mv;
        if (IS_A) { mk = my_t - slot; mv = mk >= 0; } else { mk = sel[my_a * 256 + slot]; mv = slot < (my_a ? nv1 : nv0); }
        const int delta = my_t - mk; const bool ok = mv && delta >= 0;
        const int bk = (ok && delta < 512) ? (int)BKT[delta] : 31;
        const f32x4 b4 = *(const LAS f32x4*)(BIAS + bk * 16 + HB + 4 * my_j);
#pragma unroll
        for (int i = 0; i < 4; ++i) x[c][i] = ok ? x[c][i] * 0.125f + b4[i] : -INFINITY; }
    f32x4 mx = x[0];
#pragma unroll
    for (int c = 1; c < NC; ++c)
#pragma unroll
        for (int i = 0; i < 4; ++i) mx[i] = fmaxf(mx[i], x[c][i]);
#pragma unroll
    for (int o = 1; o < 16; o <<= 1)
#pragma unroll
        for (int i = 0; i < 4; ++i) mx[i] = fmaxf(mx[i], __shfl_xor(mx[i], o));
    f32x4 sk = {0.f, 0.f, 0.f, 0.f};
    if (IS_A) { sk = *(const f32x4*)(P.sinks + 4 * my_j);
#pragma unroll
        for (int i = 0; i < 4; ++i) mx[i] = fmaxf(mx[i], sk[i]); }
    f32x4 sum = {0.f, 0.f, 0.f, 0.f};
#pragma unroll
    for (int c = 0; c < NC; ++c)
#pragma unroll
        for (int i = 0; i < 4; ++i) { x[c][i] = __expf(x[c][i] - mx[i]); sum[i] += x[c][i]; }
#pragma unroll
    for (int o = 1; o < 16; o <<= 1)
#pragma unroll
        for (int i = 0; i < 4; ++i) sum[i] += __shfl_xor(sum[i], o);
    if (IS_A) {
#pragma unroll
        for (int i = 0; i < 4; ++i) sum[i] += __expf(sk[i] - mx[i]); }
    f32x4 inv;
#pragma unroll
    for (int i = 0; i < 4; ++i) inv[i] = 1.0f / sum[i];
#define SP_PWRITE(qa) do { if (my_a == (qa)) { _Pragma("unroll") for (int c_ = 0; c_ < NC; ++c_) _Pragma("unroll") for (int i_ = 0; i_ < 4; i_ += 2) { \
        const unsigned pk_ = cvt_pk_bf16x2(x[c_][i_] * inv[i_], x[c_][i_ + 1] * inv[i_ + 1]);     \
        Pimg[(4 * my_j + i_) * NSLOT + 16 * c_ + r] = (unsigned short)pk_; Pimg[(4 * my_j + i_ + 1) * NSLOT + 16 * c_ + r] = (unsigned short)(pk_ >> 16); } } } while (0)
    SP_PWRITE(0);
    f32x4 o[4];
#pragma unroll
    for (int db = 0; db < 4; ++db) o[db] = (f32x4){0.f, 0.f, 0.f, 0.f};
    const unsigned trb = (unsigned)((8 * g4 + ((lane & 15) >> 2)) * 128 + (lane & 3) * 8);
    int bufi = 0;
#pragma unroll 1
    for (int cb = 0; cb < 4; ++cb) { const bool minep = rcb == cb;
        if (cb == 2) { SP_PWRITE(1); }
#pragma unroll
        for (int ks = 0; ks < KS; ++ks) { const int st = cb * KS + ks;
            if (cb < 3 || ks + 2 < KS) asm volatile("s_waitcnt vmcnt(8)" ::: "memory"); else if (ks + 1 < KS) asm volatile("s_waitcnt vmcnt(4)" ::: "memory"); else asm volatile("s_waitcnt vmcnt(0)" ::: "memory");
            const unsigned vb = wl + (unsigned)(bufi * 4096) + trb;
            s16x4 lo[4], hi[4];
#pragma unroll
            for (int db = 0; db < 4; ++db) {
                asm volatile("ds_read_b64_tr_b16 %0, %1 offset:%c2" : "=&v"(lo[db]) : "v"(vb), "i"(db * 32) : "memory");
                asm volatile("ds_read_b64_tr_b16 %0, %1 offset:%c2" : "=&v"(hi[db]) : "v"(vb), "i"(db * 32 + 512) : "memory"); }
            bf16x8 pb = *(const LAS bf16x8*)(Pimg + (r & 7) * NSLOT + 32 * ks + 8 * g4);
            pb = minep ? pb : zz;
            int kn_[4] = {0, 0, 0, 0}; const int cbn_ = (st + 3) / KS, an_ = cbn_ >> 1, jn_ = cbn_ & 1;
            if (st + 3 < NST) {
#pragma unroll
                for (int i_ = 0; i_ < 4; ++i_) { const int slot_ = 32 * ((ks + 3) % KS) + 8 * i_ + drow; if (IS_A) { int k_ = tA + an_ - slot_; kn_[i_] = k_ < 0 ? 0 : k_; } else kn_[i_] = (SPB_IDEAL && dry) ? slot_ : (int)sel[an_ * 256 + slot_]; } }
            asm volatile("s_waitcnt lgkmcnt(0)" ::: "memory");
            if (st + 3 < NST) { unsigned vo_[4];
#pragma unroll
                for (int i_ = 0; i_ < 4; ++i_) vo_[i_] = (unsigned)(((rb + kn_[i_]) * 128 + KOFF + jn_ * 64 + dpc * 8) * 2);
                sp_glds16s_x4(P.VAB, vo_[0], vo_[1], vo_[2], vo_[3], (unsigned)__builtin_amdgcn_readfirstlane((int)(wl + (unsigned)(bufi * 4096)))); }
#pragma unroll
            for (int db = 0; db < 4; ++db) { const bf16x8 va = {lo[db][0], lo[db][1], lo[db][2], lo[db][3], hi[db][0], hi[db][1], hi[db][2], hi[db][3]};
                o[db] = __builtin_amdgcn_mfma_f32_16x16x32_bf16(va, pb, o[db], 0, 0, 0); }
            bufi = bufi == 2 ? 0 : bufi + 1;
        } }
#undef SP_VDMA
#undef SP_PWRITE
    if (!dry) { bf16* gp = P.G + (size_t)(rb + tA + (r >> 3)) * 1536 + GOFF + (r & 7) * 64 + 4 * g4;
#pragma unroll
        for (int db = 0; db < 4; ++db) { const u32x2 gt = *(const u32x2*)(gp + 16 * db);
            const float g0 = __uint_as_float(gt.x << 16), g1 = __uint_as_float(gt.x & 0xffff0000u), g2 = __uint_as_float(gt.y << 16), g3 = __uint_as_float(gt.y & 0xffff0000u);
            u32x2 w; w.x = pk2(o[db][0] * g0, o[db][1] * g1); w.y = pk2(o[db][2] * g2, o[db][3] * g3);
            *(u32x2*)(gp + 16 * db) = w; } }
}
__device__ __forceinline__ void swa_dense(Frame& F, const BAParams& P, int rb, int t0, int combo, bool dry) {
    constexpr int NC = 10, NSLOT = 160, NST = 5;
    int lane_ = F.lane; asm volatile("" : "+v"(lane_)); const int lane = lane_, r = lane & 15, g4 = lane >> 4, j = combo >> 2, qg = combo & 3, kbase = t0 - 128;
    const LAS float* BIAS = (const LAS float*)(F.lds + BIAS_OFF);
    const LAS unsigned char* BKT = (const LAS unsigned char*)(F.lds + BKT_OFF);
    LAS unsigned short* Pimg = (LAS unsigned short*)(F.ring + F.wt * 16384);
    const unsigned wl = (unsigned)__builtin_amdgcn_readfirstlane((int)((unsigned)(uintptr_t)(F.ring) + (unsigned)F.wt * 16384u + 8192u));
    const int drow = lane >> 3, dpc = lane & 7;
#define SW_VDMA(st) do { unsigned vo_[4]; \
        _Pragma("unroll") for (int i_ = 0; i_ < 4; ++i_) { int key_ = kbase + 32 * (st) + 8 * i_ + drow; key_ = key_ < 0 ? 0 : (key_ > SEQ - 1 ? SEQ - 1 : key_); vo_[i_] = (unsigned)(((rb + key_) * 128 + j * 64 + dpc * 8) * 2); } \
        sp_glds16s_x4(P.VAB, vo_[0], vo_[1], vo_[2], vo_[3], (unsigned)__builtin_amdgcn_readfirstlane((int)(wl + (unsigned)(((st) & 1) * 4096)))); } while (0)
    asm volatile("s_waitcnt lgkmcnt(0)" ::: "memory");
    SW_VDMA(0); SW_VDMA(1);
    const unsigned wk = (unsigned)__builtin_amdgcn_readfirstlane((int)((unsigned)(uintptr_t)(F.ring) + (unsigned)F.wt * 16384u));
#define SW_KDMA(st) do { unsigned vo_[4]; \
        _Pragma("unroll") for (int i_ = 0; i_ < 4; ++i_) { int key_ = kbase + 32 * (st) + 8 * i_ + drow; key_ = key_ < 0 ? 0 : (key_ > SEQ - 1 ? SEQ - 1 : key_); vo_[i_] = (unsigned)(((rb + key_) * 128 + j * 64 + ((dpc ^ (drow & 7)) * 8)) * 2); } \
        sp_glds16s_x4(P.KAB, vo_[0], vo_[1], vo_[2], vo_[3], (unsigned)__builtin_amdgcn_readfirstlane((int)(wk + (unsigned)(((st) & 1) * 4096)))); } while (0)
    SW_KDMA(0); SW_KDMA(1);
    bf16x8 qf[2]; { const bf16* qp = P.QA + (size_t)(rb + t0 + 4 * qg + (r >> 2)) * 512 + (4 * j + (r & 3)) * 64 + 8 * g4; qf[0] = *(const bf16x8*)qp; qf[1] = *(const bf16x8*)(qp + 32); }
    const int my_t = t0 + 4 * qg + g4;
    f32x4 x[NC];
    { const LAS unsigned char* kring = F.ring + F.wt * 16384;
#pragma unroll
      for (int st = 0; st < NST; ++st) {
        if (st + 1 < NST) asm volatile("s_waitcnt vmcnt(4)" ::: "memory"); else asm volatile("s_waitcnt vmcnt(0)" ::: "memory");
        const LAS unsigned char* kb = kring + (st & 1) * 4096; bf16x8 f[2][2];
#pragma unroll
        for (int cc = 0; cc < 2; ++cc)
#pragma unroll
            for (int k2 = 0; k2 < 2; ++k2) f[cc][k2] = *(const LAS bf16x8*)(kb + (16 * cc + r) * 128 + (((4 * k2 + g4) ^ (r & 7)) * 16));
        asm volatile("s_waitcnt lgkmcnt(0)" ::: "memory");
        if (st + 2 < NST) SW_KDMA(st + 2);
#pragma unroll
        for (int cc = 0; cc < 2; ++cc) { const int c = 2 * st + cc; f32x4 d = {0.f, 0.f, 0.f, 0.f};
            d = __builtin_amdgcn_mfma_f32_16x16x32_bf16(qf[0], f[cc][0], d, 0, 0, 0); d = __builtin_amdgcn_mfma_f32_16x16x32_bf16(qf[1], f[cc][1], d, 0, 0, 0);
            const int key = kbase + 16 * c + r, delta = my_t - key; const bool ok = key >= 0 && delta >= 0 && delta < 128;
            const int bk = (int)BKT[ok ? delta : 0];
            const f32x4 b4 = *(const LAS f32x4*)(BIAS + bk * 16 + 4 * j);
#pragma unroll
            for (int i = 0; i < 4; ++i) x[c][i] = ok ? d[i] * 0.125f + b4[i] : -INFINITY; } } }
#undef SW_KDMA
    f32x4 mx = *(const f32x4*)(P.sinks + 4 * j); const f32x4 sk = mx;
#pragma unroll
    for (int c = 0; c < NC; ++c)
#pragma unroll
        for (int i = 0; i < 4; ++i) mx[i] = fmaxf(mx[i], x[c][i]);
#pragma unroll
    for (int o = 1; o < 16; o <<= 1)
#pragma unroll
        for (int i = 0; i < 4; ++i) mx[i] = fmaxf(mx[i], __shfl_xor(mx[i], o));
    f32x4 sum = {0.f, 0.f, 0.f, 0.f};
#pragma unroll
    for (int c = 0; c < NC; ++c)
#pragma unroll
        for (int i = 0; i < 4; ++i) { x[c][i] = __expf(x[c][i] - mx[i]); sum[i] += x[c][i]; }
#pragma unroll
    for (int o = 1; o < 16; o <<= 1)
#pragma unroll
        for (int i = 0; i < 4; ++i) sum[i] += __shfl_xor(sum[i], o);
    f32x4 inv;
#pragma unroll
    for (int i = 0; i < 4; ++i) inv[i] = 1.0f / (sum[i] + __expf(sk[i] - mx[i]));
#pragma unroll
    for (int c = 0; c < NC; ++c)
#pragma unroll
        for (int i = 0; i < 4; i += 2) { const unsigned pk = cvt_pk_bf16x2(x[c][i] * inv[i], x[c][i + 1] * inv[i + 1]);
            Pimg[(4 * g4 + i) * NSLOT + 16 * c + r] = (unsigned short)pk; Pimg[(4 * g4 + i + 1) * NSLOT + 16 * c + r] = (unsigned short)(pk >> 16); }
    f32x4 o[4];
#pragma unroll
    for (int db = 0; db < 4; ++db) o[db] = (f32x4){0.f, 0.f, 0.f, 0.f};
    const unsigned trb = (unsigned)((8 * g4 + ((lane & 15) >> 2)) * 128 + (lane & 3) * 8);
#pragma unroll
    for (int st = 0; st < NST; ++st) {
        if (st + 1 < NST) asm volatile("s_waitcnt vmcnt(4)" ::: "memory"); else asm volatile("s_waitcnt vmcnt(0)" ::: "memory");
        const unsigned vb = wl + (unsigned)((st & 1) * 4096) + trb;
        s16x4 lo[4], hi[4];
#pragma unroll
        for (int db = 0; db < 4; ++db) {
            asm volatile("ds_read_b64_tr_b16 %0, %1 offset:%c2" : "=&v"(lo[db]) : "v"(vb), "i"(db * 32) : "memory");
            asm volatile("ds_read_b64_tr_b16 %0, %1 offset:%c2" : "=&v"(hi[db]) : "v"(vb), "i"(db * 32 + 512) : "memory"); }
        const bf16x8 pb = *(const LAS bf16x8*)(Pimg + r * NSLOT + 32 * st + 8 * g4);
        asm volatile("s_waitcnt lgkmcnt(0)" ::: "memory");
#pragma unroll
        for (int db = 0; db < 4; ++db) { const bf16x8 va = {lo[db][0], lo[db][1], lo[db][2], lo[db][3], hi[db][0], hi[db][1], hi[db][2], hi[db][3]};
            o[db] = __builtin_amdgcn_mfma_f32_16x16x32_bf16(va, pb, o[db], 0, 0, 0); }
        if (st + 2 < NST) SW_VDMA(st + 2);
    }
#undef SW_VDMA
    if (!dry) { bf16* gp = P.G + (size_t)(rb + t0 + 4 * qg + (r >> 2)) * 1536 + (4 * j + (r & 3)) * 64 + 4 * g4;
#pragma unroll
        for (int db = 0; db < 4; ++db) { const u32x2 gt = *(const u32x2*)(gp + 16 * db);
            const float g0 = __uint_as_float(gt.x << 16), g1 = __uint_as_float(gt.x & 0xffff0000u), g2 = __uint_as_float(gt.y << 16), g3 = __uint_as_float(gt.y & 0xffff0000u);
            u32x2 w; w.x = pk2(o[db][0] * g0, o[db][1] * g1); w.y = pk2(o[db][2] * g2, o[db][3] * g3);
            *(u32x2*)(gp + 16 * db) = w; } }
}
__device__ __forceinline__ void ba_clear(Frame& F) {
    LAS v4u* hz = (LAS v4u*)(F.ring + F.wt * 16384);
#pragma unroll
    for (int i = 0; i < 16; ++i) hz[F.lane + 64 * i] = (v4u){0u, 0u, 0u, 0u};
    *(LAS v4u*)(F.h2p + F.wt * 1024 + F.lane * 16) = (v4u){0u, 0u, 0u, 0u};
}
__device__ __forceinline__ void ba_unit(Frame& F, const BAParams& P, int b, int tau, bool dry) {
    { int l_ = (int)__builtin_amdgcn_mbcnt_hi(~0u, __builtin_amdgcn_mbcnt_lo(~0u, 0u)); asm volatile("" : "+v"(l_)); F.lane = l_; F.tid = F.wt * 64 + l_; }
    const int t0 = tau * 16, rb = b * SEQ, lane = F.lane;
    LAS unsigned* misc = (LAS unsigned*)(F.miscp);
    for (int ri = 0; ri < REP_IDX; ++ri)
    if (tau >= 16) {
        if (ri) { team_barrier(F); ba_clear(F); team_barrier(F); }
        bf16x8 bq[4]; const int r = lane & 15, g4 = lane >> 4;
#pragma unroll
        for (int h = 0; h < 4; ++h) bq[h] = *(const bf16x8*)(P.IQ + (size_t)(rb + t0 + r) * 128 + h * 32 + 8 * g4);
        const f32x4 w4 = *(const f32x4*)(P.IW + (size_t)(rb + t0 + r) * 4);
        const bf16* IKb = P.IK + (size_t)rb * 32;
        idx_pass<1>(F, IKb, bq, w4, tau, t0);
        team_barrier(F);
#pragma unroll 1
        for (int k_ = 0; k_ < REP_TH; ++k_) { idx_threshold(F); team_barrier(F); }
#pragma unroll 1
        for (int k2_ = 0; k2_ < REP_P2RS; ++k2_) {
#pragma unroll 1
        for (int k_ = 0; k_ < REP_P2; ++k_) { idx_pass<2>(F, IKb, bq, w4, tau, t0); team_barrier(F); }
#pragma unroll 1
        for (int k_ = 0; k_ < REP_RS; ++k_) idx_resolve(F, IKb, bq, w4, tau);
        if (k2_ + 1 < REP_P2RS) team_barrier(F); }
    } else {
        LAS unsigned short* sel = (LAS unsigned short*)(F.selp) + NW * F.wt * 256;
        for (int i = lane; i < NW * 256; i += 64) sel[i] = (unsigned short)(i & 255);
    }
    asm volatile("s_waitcnt lgkmcnt(0)" ::: "memory");
#pragma unroll 1
    for (int pp = 0; pp < 2; ++pp) { const int pr = 2 * F.wt + pp;
        const int tA = t0 + 2 * pr, nv0 = tA >= 256 ? 256 : tA + 1, nv1 = tA + 1 >= 256 ? 256 : tA + 2;
        for (int rs = 0; rs < REP_SPB; ++rs) sparse_pair<false>(F, P, rb, tA, 2 * pr, nv0, nv1, dry || rs + 1 < REP_SPB); }
#pragma unroll 1
    for (int pp = 0; pp < 2; ++pp)
        for (int rs = 0; rs < REP_SPA; ++rs) swa_dense(F, P, rb, t0, F.wt + 4 * pp, dry || rs + 1 < REP_SPA);
    ba_clear(F);
}

#ifndef REP_P1A
#define REP_P1A 1
#endif
#ifndef REP_C
#define REP_C 1
#endif
#ifndef REP_BA
#define REP_BA 1
#endif
#ifndef REP_P1B
#define REP_P1B 1
#endif
#ifndef REP_P3
#define REP_P3 1
#endif
#ifndef REP_P0
#define REP_P0 1
#endif
#ifndef FOX_SKIP_LOG2
#define FOX_SKIP_LOG2 (-40.0f)
#endif
#ifndef MK_ONE_LAUNCH
#define MK_ONE_LAUNCH 1
#endif
constexpr int NPHASES = 1 + 6 * DEPTH;
struct Args { const float* in[9]; float* out; unsigned char* ws; int ph_lo, ph_hi; };
static_assert(sizeof(Args) == 9 * 8 + 8 + 8 + 4 + 4, "no padding bytes in the argument struct");

typedef const __attribute__((address_space(4))) Args* ArgP;
__device__ __forceinline__ ArgP argp() { ArgP p = (ArgP)__builtin_amdgcn_kernarg_segment_ptr(); asm volatile("" : "+s"(p)); return p; }
__global__ void __launch_bounds__(512, 2) mk_fwd(Args args) {
    extern __shared__ __attribute__((aligned(16))) unsigned char lds[];
    Frame F;
    F.lds = (LAS unsigned char*)lds;
    if ((unsigned)(uintptr_t)F.lds != 0u) return;
    F.MISC = (volatile LAS unsigned*)(F.lds + MISC_OFF);
    F.tid = threadIdx.x; F.lane = F.tid & 63; F.wave = __builtin_amdgcn_readfirstlane(F.tid >> 6);
    F.G = gridDim.x; { const int bx = blockIdx.x; F.vcu = (F.G % 8 == 0) ? (bx % 8) * (F.G / 8) + bx / 8 : bx; }
    F.ctl = (gu32*)(argp()->ws + WS_CTL);
    for (int u = F.tid; u < 256; u += 512) ((LAS unsigned*)(F.lds + MISC_OFF))[u] = 0u;
    for (int u = F.tid; u < 512; u += 512) { ((LAS float*)(F.lds + BIAS_OFF))[u] = argp()->in[8][u];
        int bk; if (u < 16) bk = u; else { const float nf = (float)u; int lg = 16 + (int)(logf(nf / 16.0f) / 3.4657359027997265f * 16.0f); bk = lg < 31 ? lg : 31; }
        ((LAS unsigned char*)(F.lds + BKT_OFF))[u] = (unsigned char)bk; }
    __syncthreads();
    XcdBarrier bar; bar.bar = (unsigned*)(F.ctl + CW_BAR); bar.x = 0; bar.st = nullptr;
    if (MK_ONE_LAUNCH) bar = xcd_barrier_post((unsigned*)(F.ctl + CW_BAR), F.MISC + MW_BAR);
    const int lo = argp()->ph_lo, hi = argp()->ph_hi;
#define IN(k) (lo <= (k) && (k) < hi)
#define SEAM(k) do { if (IN(k) && IN((k) + 1)) xcd_barrier(bar); } while (0)
#define PHASE_BEGIN() do { int l_ = (int)__builtin_amdgcn_mbcnt_hi(~0u, __builtin_amdgcn_mbcnt_lo(~0u, 0u)); asm volatile("" : "+v"(l_)); F.lane = l_; F.tid = F.wave * 64 + l_; } while (0)

    if (IN(0)) { PHASE_BEGIN(); ArgP a = argp(); for (int rp = 0; rp < REP_P0; ++rp) p0_prologue(F, a->in[0], a->in[1], a->in[2], a->in[6], a->in[7], a->ws); SEAM(0); }

    for (int L = 0; L < DEPTH; ++L) {
        const int pb = 1 + 6 * L;
        if (IN(pb)) { PHASE_BEGIN();
            unsigned char* ws = argp()->ws; const pg8::bf16_t* W1T = (const pg8::bf16_t*)(ws + WS_W1T) + (size_t)L * NTILES * 256 * 1024;
            pg8::Gemm g{(const pg8::bf16_t*)(ws + WS_XB), W1T, M, NT_A * 256, 1024, 1024, 1024, 0}; pg8::StaticOrder S; S.init(M, NT_A * 256, F.G, (int)blockIdx.x);
            pg8::EpiIn E{ws, argp()->in[4] + L * 384, argp()->in[3] + L * 8};
            for (int rp = 0; rp < REP_P1A; ++rp) pg8::gemm_phase<pg8::EpiIn, pg8::StaticOrder, true, true>(F.lds + RING_OFF, g, S, E, F.wave);
            SEAM(pb);
        }
        if (IN(pb + 2)) { PHASE_BEGIN();
            unsigned char* ws = argp()->ws;
            const float* CL = (const float*)(ws + WS_CL); const float* CT = (const float*)(ws + WS_CT);
            LAS float* carry = (LAS float*)(F.lds + H2_OFF)  ; LAS unsigned* nbw = (LAS unsigned*)(F.lds + RING_OFF + NB_OFF);
            for (int rp = 0; rp < REP_C; ++rp) {
            LAS unsigned* miscw = (LAS unsigned*)(F.lds + MISC_OFF);
            for (int kg = 0; kg < 8; ++kg) { const int xg = ((F.vcu >> 5) + kg) & 7;
            gu32* const tick = F.ctl + CW_TICK + 64 * (8 * (2 * L + rp % 2) + xg);
            if (F.tid == 0) miscw[MW_TICKET] = __hip_atomic_fetch_add(tick, 1u, RLX_AGENT);
            __syncthreads();
            for (;;) {
                PHASE_BEGIN();
                const int ui = (int)miscw[MW_TICKET];
                if (ui >= 128) { __syncthreads(); break; }
                const int qb = 31 - (ui >> 2), bh = 4 * xg + (ui & 3);
                    if (F.wave == 0) { const float t0 = CT[bh * 128 + 2 * F.lane], t1 = CT[bh * 128 + 2 * F.lane + 1]; const float inc = wave_incl_scan(t0 + t1, F.lane); carry[2 * F.lane] = inc - (t0 + t1); carry[2 * F.lane + 1] = inc - t1; }
                    __syncthreads();
                    const float cref = carry[4 * qb]; int tskip;
                    { const float* gq = argp()->in[4] + L * 384 + 256; const float g1 = fabsf(gq[F.lane]), g2 = fabsf(gq[64 + F.lane]); float mq = g1, mk = g2;
#pragma unroll
                      for (int o = 1; o < 64; o <<= 1) { mq = fmaxf(mq, __shfl_xor(mq, o)); mk = fmaxf(mk, __shfl_xor(mk, o)); }
                      const float thr = FOX_SKIP_LOG2 - 2.0f * (11.8f * mq * mk + 0.5f);
                      const int NTt = 4 * (qb + 1); const int t_a = F.lane, t_b = 64 + F.lane, k_a = 64 * t_a + 63, k_b = 64 * t_b + 63;
                      const float n_a = t_a < NTt ? (cref - (carry[k_a >> 6] + CL[(size_t)bh * SEQ + k_a])) * 1.4426950408889634f : 0.f, n_b = t_b < NTt ? (cref - (carry[k_b >> 6] + CL[(size_t)bh * SEQ + k_b])) * 1.4426950408889634f : 0.f;
                      const bool s_a = t_a < NTt && n_a < thr, s_b = t_b < NTt && n_b < thr;
                      const unsigned long long f_a = __ballot(!s_a), f_b = __ballot(!s_b);
                      int cnt = f_a ? (int)__builtin_ctzll(f_a) : 64 + (f_b ? (int)__builtin_ctzll(f_b) : 64);
                      cnt &= ~1; tskip = cnt > NTt - 4 ? NTt - 4 : cnt; }
                    { const int nk = 256 * (qb + 1);
                      for (int k = 64 * tskip + F.tid; k < nk; k += 512) { const float xb = (cref - (carry[k >> 6] + CL[(size_t)bh * SEQ + k])) * 1.4426950408889634f;
                          const unsigned h = f2bf(xb), l = f2bf(xb - __uint_as_float(h << 16)); nbw[k] = h | (l << 16); } }
                    __syncthreads();
                    attn_body::attn_unit<8>(bh >> 3, bh & 7, qb, (const attn_body::bf16*)(ws + WS_QC), (const attn_body::bf16*)(ws + WS_KC), (const attn_body::bf16*)(ws + WS_VC), (attn_body::bf16*)(ws + WS_G),
                                            (char*)lds + RING_OFF, (attn_body::lds_cuptr)(F.lds + RING_OFF + NB_OFF), tskip, rp + 1 < REP_C, F.wave);
                if (F.tid == 0) miscw[MW_TICKET] = __hip_atomic_fetch_add(tick, 1u, RLX_AGENT);
                __syncthreads();
            } } }
            __syncthreads(); PHASE_BEGIN();
            const BAParams P{(const bf16*)(ws + WS_IQ), (const bf16*)(ws + WS_IK), (const float*)(ws + WS_IW), (const bf16*)(ws + WS_QA), (const bf16*)(ws + WS_QB), (const bf16*)(ws + WS_KAB), (const bf16*)(ws + WS_VAB),
                             (bf16*)(ws + WS_G), argp()->in[5] + L * 8};
            { const int team = F.wave >> 2; F.wt = F.wave & 3; F.tgen = 0u;
              F.ring = F.lds + team * 65536; F.selp = F.lds + SEL_OFF + team * 8192; F.h2p = F.lds + H2_OFF + team * 4096; F.miscp = F.lds + TMISC_OFF + team * 1024; }
            for (int u = F.lane; u < 256; u += 64) if (F.wt == 0) ((LAS unsigned*)F.miscp)[u] = 0u;
            ba_clear(F);
            __syncthreads();
            for (int rp = 0; rp < REP_BA; ++rp) {
            LAS unsigned* miscw = (LAS unsigned*)F.miscp;
            for (int kg = 0; kg < 4; ++kg) { const int bq = ((F.vcu >> 6) + kg) & 3;
            gu32* const tick = F.ctl + CW_TICK + 64 * (32 + 4 * (2 * L + rp % 2) + bq);
            if (F.wt == 0 && F.lane == 0) miscw[MW_TICKET] = __hip_atomic_fetch_add(tick, 1u, RLX_AGENT);
            team_barrier(F);
            for (;;) {
                { int l_ = (int)__builtin_amdgcn_mbcnt_hi(~0u, __builtin_amdgcn_mbcnt_lo(~0u, 0u)); asm volatile("" : "+v"(l_)); F.lane = l_; }
                const int ui = (int)miscw[MW_TICKET];
                if (ui >= 512) { team_barrier(F); break; }
                ba_unit(F, P, bq, 511 - ui, rp + 1 < REP_BA);
                if (F.wt == 0 && F.lane == 0) miscw[MW_TICKET] = __hip_atomic_fetch_add(tick, 1u, RLX_AGENT);
                team_barrier(F);
            } } }
            __syncthreads(); PHASE_BEGIN();
            SEAM(pb + 2);
        }
        if (IN(pb + 3)) { PHASE_BEGIN();
            unsigned char* ws = argp()->ws; const pg8::bf16_t* W1T = (const pg8::bf16_t*)(ws + WS_W1T) + (size_t)L * NTILES * 256 * 1024;
            pg8::Gemm g{(const pg8::bf16_t*)(ws + WS_XB), W1T + (size_t)NT_A * 256 * 1024, M, NT_B * 256, 1024, 1024, 1024, 0}; pg8::StaticOrder S; S.init(M, NT_B * 256, F.G, (int)blockIdx.x);
            pg8::EpiGate E{(const float*)(ws + WS_SSQ), (unsigned char*)(ws + WS_MG)};
            for (int rp = 0; rp < REP_P1B; ++rp) pg8::gemm_phase<pg8::EpiGate, pg8::StaticOrder, true, true>(F.lds + RING_OFF, g, S, E, F.wave);
            SEAM(pb + 3);
        }
        if (IN(pb + 4)) { PHASE_BEGIN();
            unsigned char* ws = argp()->ws;
            pg8::Gemm g{(const pg8::bf16_t*)(ws + WS_G), (const pg8::bf16_t*)(ws + WS_WBT) + (size_t)L * 3 * 1024 * 512, M, 1024, 512, 1536, 512, 4};
            pg8::SegOrder S; S.base.init(M, 1024, F.G, (int)blockIdx.x);
            pg8::EpiMerge E{(const unsigned char*)(ws + WS_MG), (pg8::bf16_t*)(ws + WS_MERGED)};
            for (int rp = 0; rp < REP_P3; ++rp) pg8::gemm_phase<pg8::EpiMerge, pg8::SegOrder, true, true>(F.lds + RING_OFF, g, S, E, F.wave);
            SEAM(pb + 4);
        }
        if (IN(pb + 5)) { PHASE_BEGIN();
            unsigned char* ws = argp()->ws; float* const outp = argp()->out;
            pg8::Gemm g{(const pg8::bf16_t*)(ws + WS_MERGED), (const pg8::bf16_t*)(ws + WS_WOT) + (size_t)L * 1024 * 1024, M, 1024, 1024, 1024, 1024, 0}; pg8::StaticOrder S; S.init(M, 1024, F.G, (int)blockIdx.x);
            const bool last = (L == DEPTH - 1);
            unsigned poison = 0u;
            if (last) poison = (__hip_atomic_load(F.ctl + CW_OVF, RLX_AGENT) != 0u) | (__hip_atomic_load(F.ctl + CW_BAR + XB_TMO, RLX_AGENT) != 0u);
            static_assert(DEPTH == 2, "two instantiations: first layer (f32 residual in, bf16 stream out), last layer (bf16 stream in, f32 output)");
            if (!last) { pg8::EpiOutT<false, false> E{argp()->in[0], nullptr, nullptr, (pg8::bf16_t*)(ws + WS_XB), (float*)(ws + WS_SSQ), poison};
                         pg8::gemm_phase<pg8::EpiOutT<false, false>, pg8::StaticOrder, true, true>(F.lds + RING_OFF, g, S, E, F.wave); }
            else       { pg8::EpiOutT<true, true> E{nullptr, (const pg8::bf16_t*)(ws + WS_XB), outp, nullptr, nullptr, poison};
                         pg8::gemm_phase<pg8::EpiOutT<true, true>, pg8::StaticOrder, true, true>(F.lds + RING_OFF, g, S, E, F.wave); }
            if (!last) SEAM(pb + 5);
        }
    }
#undef IN
#undef SEAM
}

extern "C" void kernel_launch(void* const* d_in, const int* in_sizes, int n_in, void* d_out, int out_size, void* d_ws, size_t ws_size, hipStream_t stream) {
    static int grid = 0;
    if (grid == 0) {
        if (n_in != 9 || in_sizes[0] != M * DMODEL || out_size != M * DMODEL || ws_size < WS_END) { fprintf(stderr, "kernel_launch: unexpected shapes / workspace (n_in %d, in0 %d, out %d, ws %zu < %zu); nothing launched\n", n_in, n_in > 0 ? in_sizes[0] : -1, out_size, ws_size, (size_t)WS_END); grid = -1; return; }
        int dev = 0, cus = 0, per_cu = 0;
        if (hipGetDevice(&dev) != hipSuccess || hipDeviceGetAttribute(&cus, hipDeviceAttributeMultiprocessorCount, dev) != hipSuccess) { grid = -1; return; }
        if (hipFuncSetAttribute((const void*)mk_fwd, hipFuncAttributeMaxDynamicSharedMemorySize, LDS_BYTES) != hipSuccess) { fprintf(stderr, "kernel_launch: hipFuncSetAttribute failed\n"); grid = -1; return; }
        if (hipOccupancyMaxActiveBlocksPerMultiprocessor(&per_cu, (const void*)mk_fwd, 512, LDS_BYTES) != hipSuccess || per_cu < 1) fprintf(stderr, "kernel_launch: occupancy query reports %d workgroups per CU\n", per_cu);
        (void)hipGetLastError();
        grid = cus;
    }
    if (grid < 0) return;
    if (hipMemsetAsync((char*)d_ws + WS_CTL, 0, CTL_ZERO_BYTES, stream) != hipSuccess) return;
    Args a{};
    for (int i = 0; i < 9; ++i) a.in[i] = (const float*)d_in[i];
    a.out = (float*)d_out; a.ws = (unsigned char*)d_ws;
#if MK_ONE_LAUNCH
    a.ph_lo = 0; a.ph_hi = NPHASES;
    hipLaunchKernelGGL(mk_fwd, dim3(grid), dim3(512), LDS_BYTES, stream, a);
#else
    for (int p = 0; p < NPHASES; ++p) { a.ph_lo = p; a.ph_hi = p + 1; hipLaunchKernelGGL(mk_fwd, dim3(grid), dim3(512), LDS_BYTES, stream, a); }
#endif
}
```

```cpp
#include <hip/hip_runtime.h>
#include <cstdio>
#include <cstdint>
#include <cmath>
namespace pg8 {
#define PG8_LAS __attribute__((address_space(3)))
typedef unsigned short bf16_t;
typedef short bf16x8 __attribute__((ext_vector_type(8)));
typedef float f32x4 __attribute__((ext_vector_type(4)));
typedef unsigned u32x4 __attribute__((ext_vector_type(4)));
constexpr int BM = 256, BK = 64, HALF = 128, HTB = HALF * BK * 2  , STAGE_BYTES = 8 * HTB, NXCD = 8, WGM = 8;

__host__ __device__ __forceinline__ int lds_byte(int r, int c) { const int st = (r >> 4) * 2 + (c >> 5), rr = r & 15, cc = c & 31, ob = rr * 64 + cc * 2; return st * 1024 + (ob ^ (((ob >> 9) & 1) << 5)); }
__host__ __device__ __forceinline__ void stage_rc(int b, int& R, int& C) { const int st = b / 1024, sb = b % 1024, swz = sb ^ (((sb >> 9) & 1) << 5); R = (st >> 1) * 16 + swz / 64; C = (st & 1) * 32 + (swz % 64) / 2; }
__host__ __device__ __forceinline__ int perm32(int rho) { const int n = rho >> 4, i = rho & 15; return 8 * (i >> 2) + 4 * n + (i & 3); }

struct Unit { int pm, pn, seg; };
struct Gemm { const bf16_t* A; const bf16_t* Bt; int M, N, K, lda, ldb, segN; };

struct StaticOrder {
    int nM, nN, nwg, G, c;
    __host__ __device__ void init(int M, int N, int G_, int c_) { nM = M / BM; nN = N / BM; nwg = nM * nN; G = G_; c = c_; }
    __host__ __device__ bool next(int i, Unit& u) const {
        const long L = (long)i * G + c; if (L >= nwg) return false;
        int wgid = (int)L; { const int q = nwg / NXCD, r = nwg % NXCD, xcd = wgid % NXCD, off = wgid / NXCD; wgid = (xcd < r ? xcd * (q + 1) : r * (q + 1) + (xcd - r) * q) + off; }
        const int nig = WGM * nN, gid = wgid / nig, fm = gid * WGM, gsz = (nM - fm) < WGM ? (nM - fm) : WGM;
        u.pm = fm + ((wgid % nig) % gsz); u.pn = (wgid % nig) / gsz; u.seg = 0; return true;
    }
    __device__ __forceinline__ void a_ready(const Unit&) const {}
    __device__ __forceinline__ void done(const Unit&) const {}
};

__device__ __forceinline__ unsigned cvt_pk_bf16(float lo, float hi) { unsigned r; asm volatile("v_cvt_pk_bf16_f32 %0, %1, %2" : "=v"(r) : "v"(lo), "v"(hi)); return r; }
constexpr size_t EWS_MiB = 1u << 20, EWS_SSQ = 43 * EWS_MiB, EWS_CL = 45 * EWS_MiB, EWS_CT = 46 * EWS_MiB, EWS_IW = 47 * EWS_MiB, EWS_CF = 47 * EWS_MiB + 512 * 1024, EWS_IQ = 49 * EWS_MiB, EWS_IK = 57 * EWS_MiB, EWS_G = 188 * EWS_MiB,
    EWS_QA = 284 * EWS_MiB, EWS_QB = 316 * EWS_MiB, EWS_QC = 348 * EWS_MiB, EWS_KC = 380 * EWS_MiB, EWS_VC = 412 * EWS_MiB, EWS_KAB = 444 * EWS_MiB, EWS_VAB = 460 * EWS_MiB;

constexpr float C2Q = 0.125f * 1.4426950408889634f;
__device__ __forceinline__ float fast_sigmoid(float x) { return __builtin_amdgcn_rcpf(1.0f + __expf(-x)); }
__device__ __forceinline__ u32x4 pack8(const f32x4 a, const f32x4 b) { u32x4 w; w.x = cvt_pk_bf16(a[0], a[1]); w.y = cvt_pk_bf16(a[2], a[3]); w.z = cvt_pk_bf16(b[0], b[1]); w.w = cvt_pk_bf16(b[2], b[3]); return w; }
__device__ __forceinline__ void unpack8(const u32x4 w, f32x4& a, f32x4& b) {
    a[0] = __uint_as_float(w.x << 16); a[1] = __uint_as_float(w.x & 0xffff0000u); a[2] = __uint_as_float(w.y << 16); a[3] = __uint_as_float(w.y & 0xffff0000u);
    b[0] = __uint_as_float(w.z << 16); b[1] = __uint_as_float(w.z & 0xffff0000u); b[2] = __uint_as_float(w.w << 16); b[3] = __uint_as_float(w.w & 0xffff0000u); }
#define EPI_PIN() asm volatile("" ::: "memory")
__device__ __forceinline__ void rows_rstd(const float* ssq, int row0, int fq, float (&rs)[2][4]) {
    f32x4 pr[2][4];
#pragma unroll
    for (int ai = 0; ai < 2; ++ai)
#pragma unroll
        for (int m = 0; m < 4; ++m) pr[ai][m] = *(const f32x4*)(ssq + (size_t)(row0 + ai * HALF + m * 16) * 16 + 4 * fq);
    EPI_PIN();
#pragma unroll
    for (int ai = 0; ai < 2; ++ai)
#pragma unroll
        for (int m = 0; m < 4; ++m) { const f32x4 a = pr[ai][m]; float t = (a[0] + a[1]) + (a[2] + a[3]); t += __shfl_xor(t, 16); t += __shfl_xor(t, 32); rs[ai][m] = __builtin_amdgcn_rsqf(t * (1.0f / 1024.0f) + 1e-6f); }
}
struct EpiIn {
    static constexpr bool PERM = true, AFTER_DRAIN = false;
    unsigned char* ws; const float* qkg; const float* bfg;
    __device__ __forceinline__ bool keep(const Unit&) const { return false; }
    __device__ __forceinline__ void operator()(f32x4 (&acc)[2][2][4][2], const Unit& u, int wr, int wc, int fr, int fq) const {
        const int row0 = u.pm * BM + wr * 64 + fr, t = u.pn, lc0 = wc * 64 + fq * 8;
        float rs[2][4]; rows_rstd((const float*)(ws + EWS_SSQ), row0, fq, rs);
        if (t == 18) {
            bf16_t* IQ = (bf16_t*)(ws + EWS_IQ); bf16_t* IK = (bf16_t*)(ws + EWS_IK); float* IW = (float*)(ws + EWS_IW);
#pragma unroll
            for (int ai = 0; ai < 2; ++ai)
#pragma unroll
                for (int m = 0; m < 4; ++m) { const int row = row0 + ai * HALF + m * 16; const float f = rs[ai][m];
#pragma unroll
                    for (int bj = 0; bj < 2; ++bj) { const int lc = lc0 + 32 * bj; const f32x4 v0 = acc[ai][bj][m][0] * f, v1 = acc[ai][bj][m][1] * f;
                        if (lc < 128) *(u32x4*)(IQ + (size_t)row * 128 + lc) = pack8(v0, v1);
                        else if (lc < 160) *(u32x4*)(IK + (size_t)row * 32 + (lc - 128)) = pack8(v0, v1);
                        else if (lc == 160) *(f32x4*)(IW + (size_t)row * 4) = v0 * 0.08838834764831845f; } }
            int ln_ = (int)__builtin_amdgcn_mbcnt_hi(~0u, __builtin_amdgcn_mbcnt_lo(~0u, 0u)); asm volatile("" : "+v"(ln_));
            if (wc == 2 && (ln_ >> 4) < 2) { const int fql = ln_ >> 4, frl = ln_ & 15;
                float* CL = (float*)(ws + EWS_CL); float* CT = (float*)(ws + EWS_CT); const int hb = 4 * fql; const f32x4 bfv = *(const f32x4*)(bfg + hb);
#pragma unroll
                for (int ai = 0; ai < 2; ++ai) { f32x4 run = {0.f, 0.f, 0.f, 0.f};
#pragma unroll
                    for (int m = 0; m < 4; ++m) { const int row = row0 + ai * HALF + m * 16; const f32x4 z = (fql == 0 ? acc[ai][1][m][1] : acc[ai][1][m][0]) * rs[ai][m] + bfv; f32x4 lf;
#pragma unroll
                        for (int e = 0; e < 4; ++e) lf[e] = (z[e] < 0.f ? z[e] : 0.f) - __logf(1.0f + __expf(-fabsf(z[e])));
#pragma unroll
                        for (int o = 1; o < 16; o <<= 1)
#pragma unroll
                            for (int e = 0; e < 4; ++e) { const float tt = __shfl_up(lf[e], o, 16); if (frl >= o) lf[e] += tt; }
                        const f32x4 cs = lf + run;
                        const int bb = row >> 13, ss = row & 8191;
#pragma unroll
                        for (int e = 0; e < 4; ++e) CL[(size_t)(bb * 8 + hb + e) * 8192 + ss] = cs[e];
#pragma unroll
                        for (int e = 0; e < 4; ++e) run[e] += __shfl(lf[e], 15, 16); }
                    if (frl == 15) { const int row = row0 + ai * HALF, bb = row >> 13, ch = (row & 8191) >> 6;
#pragma unroll
                        for (int e = 0; e < 4; ++e) CT[(bb * 8 + hb + e) * 128 + ch] = run[e]; } } }
            return;
        }
        bf16_t* dst; int ldc, colbase; const float* gp = qkg; float csc = 1.f; bool norm = false, act = false;
        if (t < 6) { const int mx = t >> 1; dst = (bf16_t*)(ws + (mx == 0 ? EWS_QA : (mx == 1 ? EWS_QB : EWS_QC))); ldc = 512; colbase = (t & 1) * 256; norm = true; gp = qkg + (mx * 2 + 0) * 64; csc = (mx == 2) ? C2Q : 1.f; }
        else if (t == 6) { dst = (bf16_t*)(ws + EWS_KAB); ldc = 128; colbase = (wc >> 1) * (32768 * 128 - 128); norm = true;     gp = qkg + ((wc >> 1) * 2 + 1) * 64; }
        else if (t < 9) { dst = (bf16_t*)(ws + EWS_KC); ldc = 512; colbase = (t - 7) * 256; norm = true; gp = qkg + (2 * 2 + 1) * 64; }
        else if (t == 9) { dst = (bf16_t*)(ws + EWS_VAB); ldc = 128; colbase = (wc >> 1) * (32768 * 128 - 128); }
        else if (t < 12) { dst = (bf16_t*)(ws + EWS_VC); ldc = 512; colbase = (t - 10) * 256; }
        else { dst = (bf16_t*)(ws + EWS_G); ldc = 1536; colbase = (t - 12) * 256; act = true; }
        f32x4 gv[2][2];
#pragma unroll
        for (int bj = 0; bj < 2; ++bj)
#pragma unroll
            for (int n = 0; n < 2; ++n) gv[bj][n] = norm ? *(const f32x4*)(gp + 8 * fq + 32 * bj + 4 * n) * csc : (f32x4){1.f, 1.f, 1.f, 1.f};
        EPI_PIN();
#pragma unroll
        for (int ai = 0; ai < 2; ++ai)
#pragma unroll
            for (int m = 0; m < 4; ++m) { const int row = row0 + ai * HALF + m * 16; float f = rs[ai][m];
                if (norm) { float ss = 0.f;
#pragma unroll
                    for (int bj = 0; bj < 2; ++bj)
#pragma unroll
                        for (int n = 0; n < 2; ++n) { const f32x4 x = acc[ai][bj][m][n]; ss += (x[0] * x[0] + x[1] * x[1]) + (x[2] * x[2] + x[3] * x[3]); }
                    ss += __shfl_xor(ss, 16); ss += __shfl_xor(ss, 32);
                    f = f * __builtin_amdgcn_rsqf(f * f * ss * (1.0f / 64.0f) + 1e-6f); }
                bf16_t* rowp = dst + (size_t)row * ldc + colbase + lc0;
#pragma unroll
                for (int bj = 0; bj < 2; ++bj) { f32x4 v0 = acc[ai][bj][m][0] * f * gv[bj][0], v1 = acc[ai][bj][m][1] * f * gv[bj][1];
                    if (act) {
#pragma unroll
                        for (int e = 0; e < 4; ++e) { v0[e] = v0[e] * fast_sigmoid(v0[e]); v1[e] = v1[e] * fast_sigmoid(v1[e]); } }
                    *(u32x4*)(rowp + 32 * bj) = pack8(v0, v1); } }
    }
};
typedef unsigned u32x2e __attribute__((ext_vector_type(2)));
__device__ __forceinline__ unsigned gate_q4(const f32x4 v) { unsigned w = 0u;
    w = __builtin_amdgcn_cvt_pk_u8_f32(fmaxf(255.0f * fast_sigmoid(v[0]), 1.0f), 0, w); w = __builtin_amdgcn_cvt_pk_u8_f32(fmaxf(255.0f * fast_sigmoid(v[1]), 1.0f), 1, w);
    w = __builtin_amdgcn_cvt_pk_u8_f32(fmaxf(255.0f * fast_sigmoid(v[2]), 1.0f), 2, w); w = __builtin_amdgcn_cvt_pk_u8_f32(fmaxf(255.0f * fast_sigmoid(v[3]), 1.0f), 3, w); return w; }
__device__ __forceinline__ f32x4 gate_f4(const unsigned w) { return (f32x4){(float)(w & 0xffu), (float)((w >> 8) & 0xffu), (float)((w >> 16) & 0xffu), (float)(w >> 24)}; }
struct EpiGate {
    static constexpr bool PERM = true, AFTER_DRAIN = false;
    const float* ssq; unsigned char* MG;
    __device__ __forceinline__ bool keep(const Unit&) const { return false; }
    __device__ __forceinline__ void operator()(f32x4 (&acc)[2][2][4][2], const Unit& u, int wr, int wc, int fr, int fq) const {
        const int row0 = u.pm * BM + wr * 64 + fr, lc0 = wc * 64 + fq * 8;
        float rs[2][4]; rows_rstd(ssq, row0, fq, rs);
#pragma unroll
        for (int ai = 0; ai < 2; ++ai)
#pragma unroll
            for (int m = 0; m < 4; ++m) { const int row = row0 + ai * HALF + m * 16; const float f = rs[ai][m];
                unsigned char* rowp = MG + (size_t)row * 3072 + u.pn * BM + lc0;
#pragma unroll
                for (int bj = 0; bj < 2; ++bj) { u32x2e w; w.x = gate_q4(acc[ai][bj][m][0] * f); w.y = gate_q4(acc[ai][bj][m][1] * f); *(u32x2e*)(rowp + 32 * bj) = w; } }
    }
};
struct EpiMerge {
    static constexpr bool PERM = true, AFTER_DRAIN = false;
    const unsigned char* MG; bf16_t* OUT;
    __device__ __forceinline__ bool keep(const Unit& u) const { return u.seg < 2; }
    __device__ __forceinline__ void operator()(f32x4 (&acc)[2][2][4][2], const Unit& u, int wr, int wc, int fr, int fq) const {
        const int row0 = u.pm * BM + wr * 64 + fr, col0 = u.pn * BM + wc * 32 + 8 * fq, seg = u.seg;
#pragma unroll
        for (int ai = 0; ai < 2; ++ai) {
            u32x2e ga[4][2], gb[4][2];
#pragma unroll
            for (int m = 0; m < 4; ++m) { const unsigned char* gp = MG + (size_t)(row0 + ai * HALF + m * 16) * 3072 + seg * 1024 + col0;
#pragma unroll
                for (int bj = 0; bj < 2; ++bj) { ga[m][bj] = *(const u32x2e*)(gp + bj * HALF); gb[m][bj] = seg < 2 ? *(const u32x2e*)(gp + 1024 + bj * HALF) : ga[m][bj]; } }
            EPI_PIN();
#pragma unroll
            for (int m = 0; m < 4; ++m) { const int row = row0 + ai * HALF + m * 16;
#pragma unroll
                for (int bj = 0; bj < 2; ++bj) { f32x4 a0 = gate_f4(ga[m][bj].x), a1 = gate_f4(ga[m][bj].y);
                    if (seg < 2) { const f32x4 b0 = gate_f4(gb[m][bj].x), b1 = gate_f4(gb[m][bj].y);
#pragma unroll
                        for (int e = 0; e < 4; ++e) { a0[e] = a0[e] * __builtin_amdgcn_rcpf(b0[e]); a1[e] = a1[e] * __builtin_amdgcn_rcpf(b1[e]); } }
                    else { a0 = a0 * (1.0f / 255.0f); a1 = a1 * (1.0f / 255.0f); }
                    acc[ai][bj][m][0] = acc[ai][bj][m][0] * a0; acc[ai][bj][m][1] = acc[ai][bj][m][1] * a1;
                    if (seg == 2) *(u32x4*)(OUT + (size_t)row * 1024 + col0 + bj * HALF) = pack8(acc[ai][bj][m][0], acc[ai][bj][m][1]); } }
        }
    }
};
template <bool RB, bool WOUT> struct EpiOutT {
    static constexpr bool PERM = true, AFTER_DRAIN = false;
    const float* resid; const bf16_t* residb; float* out; bf16_t* XB; float* ssq; unsigned poison;
    __device__ __forceinline__ bool keep(const Unit&) const { return false; }
    __device__ __forceinline__ void operator()(f32x4 (&acc)[2][2][4][2], const Unit& u, int wr, int wc, int fr, int fq) const {
        const int row0 = u.pm * BM + wr * 64 + fr, col0 = u.pn * BM + wc * 32 + 8 * fq;
#pragma unroll
        for (int ai = 0; ai < 2; ++ai) {
            f32x4 rv[4][2][2];
#pragma unroll
            for (int m = 0; m < 4; ++m)
#pragma unroll
                for (int bj = 0; bj < 2; ++bj) { const size_t o = (size_t)(row0 + ai * HALF + m * 16) * 1024 + col0 + bj * HALF;
                    if (RB) unpack8(*(const u32x4*)(residb + o), rv[m][bj][0], rv[m][bj][1]); else { rv[m][bj][0] = *(const f32x4*)(resid + o); rv[m][bj][1] = *(const f32x4*)(resid + o + 4); } }
            EPI_PIN();
#pragma unroll
            for (int m = 0; m < 4; ++m) { const int row = row0 + ai * HALF + m * 16; float ss = 0.f;
#pragma unroll
                for (int bj = 0; bj < 2; ++bj) { const size_t o = (size_t)row * 1024 + col0 + bj * HALF;
                    f32x4 v0 = rv[m][bj][0] + acc[ai][bj][m][0], v1 = rv[m][bj][1] + acc[ai][bj][m][1];
                    if (poison) { const float qn = __builtin_nanf(""); v0 = (f32x4){qn, qn, qn, qn}; v1 = v0; }
                    if (WOUT) { *(f32x4*)(out + o) = v0; *(f32x4*)(out + o + 4) = v1; }
                    if (XB) { *(u32x4*)(XB + o) = pack8(v0, v1); ss += ((v0[0] * v0[0] + v0[1] * v0[1]) + (v0[2] * v0[2] + v0[3] * v0[3])) + ((v1[0] * v1[0] + v1[1] * v1[1]) + (v1[2] * v1[2] + v1[3] * v1[3])); } }
                if (XB) { ss += __shfl_xor(ss, 16); ss += __shfl_xor(ss, 32); if (fq == 0) ssq[(size_t)row * 16 + u.pn * 4 + wc] = ss; } }
            EPI_PIN();
        }
    }
};
struct SegOrder {
    StaticOrder base;
    __device__ __forceinline__ bool next(int i, Unit& u) const { if (!base.next(i / 3, u)) return false; u.seg = i % 3; return true; }
    __device__ __forceinline__ void a_ready(const Unit&) const {}
    __device__ __forceinline__ void done(const Unit&) const {}
};

template <class Epi, class Sched, bool ALIGN_EPI = false, bool SP2 = false>
__device__ __forceinline__ void gemm_phase(PG8_LAS unsigned char* lds, const Gemm g, const Sched& S, const Epi& E, int wave_id) {
    int tid_ = (int)__builtin_amdgcn_mbcnt_hi(~0u, __builtin_amdgcn_mbcnt_lo(~0u, 0u)); asm volatile("" : "+v"(tid_)); tid_ += wave_id * 64;
    const int tid = tid_, wid = __builtin_amdgcn_readfirstlane(tid >> 6), lane = tid & 63, wr = wid >> 2, wc = wid & 3, fr = lane & 15, fq = lane >> 4;
    const int K = g.K, nt = K / BK;
    unsigned voffA[2], voffB[2];
#pragma unroll
    for (int i = 0; i < 2; ++i) { int R, C; stage_rc(tid * 16 + i * 8192, R, C); const int Rb = Epi::PERM ? ((R & ~31) + perm32(R & 31)) : R;
        voffA[i] = (unsigned)(R * g.lda + C) * 2u; voffB[i] = (unsigned)(Rb * g.ldb + C) * 2u; }
    const size_t kstep = (size_t)(BK * 2);
    const size_t hstepA = (size_t)HALF * g.lda * 2, hstepB = (size_t)HALF * g.ldb * 2;
    const size_t tstepA = 2 * hstepA, tstepB = 2 * hstepB, sstepA = (size_t)K * 2;
    const unsigned ldsw = (unsigned)wid * 1024u;
    const int aoff = lds_byte(wr * 64 + fr, fq * 8), boff = lds_byte(wc * 32 + fr, fq * 8);
#define PG8_SA(b, h) (((b) * 2 + (h)) * HTB)
#define PG8_SB(b, h) ((4 + (b) * 2 + (h)) * HTB)
#define PG8_STAGE(bufoff, gbase, voff) do { _Pragma("unroll") for (int _i = 0; _i < 2; ++_i) \
        __builtin_amdgcn_global_load_lds((const unsigned*)((const char*)(gbase) + (voff)[_i]), (PG8_LAS unsigned*)(lds + (bufoff) + ldsw + _i * 8192), 16, 0, 0); } while (0)
#define PG8_LDA(dst, b, h) do { _Pragma("unroll") for (int m = 0; m < 4; ++m) _Pragma("unroll") for (int k = 0; k < 2; ++k) dst[m][k] = *(const PG8_LAS bf16x8*)(lds + PG8_SA(b, h) + aoff + m * 2048 + k * 1024); } while (0)
#define PG8_LDB(dst, b, h) do { _Pragma("unroll") for (int n = 0; n < 2; ++n) _Pragma("unroll") for (int k = 0; k < 2; ++k) dst[n][k] = *(const PG8_LAS bf16x8*)(lds + PG8_SB(b, h) + boff + n * 2048 + k * 1024); } while (0)
#define PG8_MMA(ai, bj, At, Bt) do { __builtin_amdgcn_s_setprio(1); _Pragma("unroll") for (int m = 0; m < 4; ++m) _Pragma("unroll") for (int n = 0; n < 2; ++n) _Pragma("unroll") for (int k = 0; k < 2; ++k) \
        acc[ai][bj][m][n] = __builtin_amdgcn_mfma_f32_16x16x32_bf16(Bt[n][k], At[m][k], acc[ai][bj][m][n], 0, 0, 0); __builtin_amdgcn_s_setprio(0); } while (0)
#define PG8_WAIT_V(n) asm volatile("s_waitcnt vmcnt(" #n ")" ::: "memory")
#define PG8_WAIT_L(n) asm volatile("s_waitcnt lgkmcnt(" #n ")" ::: "memory")
#define PG8_BAR __builtin_amdgcn_s_barrier()
#define PG8_SCHED __builtin_amdgcn_sched_barrier(0)
    Unit cur, nxt; int ui = 0;
    if (!S.next(0, cur)) return;
    f32x4 acc[2][2][4][2];
#pragma unroll
    for (int a = 0; a < 2; ++a)
#pragma unroll
        for (int b = 0; b < 2; ++b)
#pragma unroll
            for (int m = 0; m < 4; ++m)
#pragma unroll
                for (int n = 0; n < 2; ++n) acc[a][b][m][n] = (f32x4){0.f, 0.f, 0.f, 0.f};
    bf16x8 At[4][2], B0[2][2], B1[2][2];
    const char* cA = (const char*)g.A + (size_t)cur.pm * tstepA + (size_t)cur.seg * sstepA; const char* cB = (const char*)g.Bt + (size_t)(cur.seg * g.segN + cur.pn) * tstepB;
    S.a_ready(cur);
    if constexpr (SP2) {
        PG8_STAGE(PG8_SB(0, 0), cB, voffB); PG8_STAGE(PG8_SB(0, 1), cB + hstepB, voffB); PG8_STAGE(PG8_SA(0, 0), cA, voffA); PG8_STAGE(PG8_SA(0, 1), cA + hstepA, voffA);
        if (wr == 1) PG8_BAR;
        PG8_WAIT_V(2); PG8_BAR;
        PG8_STAGE(PG8_SB(1, 0), cB + kstep, voffB); PG8_STAGE(PG8_SA(1, 0), cA + kstep, voffA); PG8_STAGE(PG8_SB(1, 1), cB + hstepB + kstep, voffB);
        PG8_WAIT_V(6); PG8_BAR;
    } else {
        PG8_STAGE(PG8_SB(0, 0), cB, voffB); PG8_STAGE(PG8_SA(0, 0), cA, voffA); PG8_STAGE(PG8_SB(0, 1), cB + hstepB, voffB); PG8_STAGE(PG8_SA(0, 1), cA + hstepA, voffA);
        if (wr == 1) PG8_BAR;
        PG8_WAIT_V(4); PG8_BAR;
        PG8_STAGE(PG8_SB(1, 0), cB + kstep, voffB); PG8_STAGE(PG8_SA(1, 0), cA + kstep, voffA); PG8_STAGE(PG8_SB(1, 1), cB + hstepB + kstep, voffB);
        PG8_WAIT_V(6); PG8_BAR;
    }
    for (;;) {
        const bool has_next = S.next(ui + 1, nxt);
        const char* nA = has_next ? (const char*)g.A + (size_t)nxt.pm * tstepA + (size_t)nxt.seg * sstepA : cA; const char* nB = has_next ? (const char*)g.Bt + (size_t)(nxt.seg * g.segN + nxt.pn) * tstepB : cB;
        for (int t = 0; t < nt; t += 2) {
            const bool last = (t == nt - 2);
            const char* a1 = cA + (size_t)(t + 1) * kstep;
            const char* a2 = last ? nA : cA + (size_t)(t + 2) * kstep; const char* b2 = last ? nB : cB + (size_t)(t + 2) * kstep;
            const char* a3 = a2 + kstep; const char* b3 = b2 + kstep;
            if (last && has_next) S.a_ready(nxt);
            if constexpr (SP2) {
            PG8_LDB(B0, 0, 0); PG8_LDB(B1, 0, 1); PG8_SCHED; PG8_LDA(At, 0, 0); PG8_STAGE(PG8_SA(1, 1), a1 + hstepA, voffA);
            PG8_WAIT_V(8); PG8_WAIT_L(0); PG8_BAR; PG8_MMA(0, 0, At, B0); PG8_MMA(0, 1, At, B1); PG8_BAR; PG8_SCHED;
            PG8_LDA(At, 0, 1); PG8_STAGE(PG8_SB(0, 0), b2, voffB); PG8_STAGE(PG8_SB(0, 1), b2 + hstepB, voffB); PG8_STAGE(PG8_SA(0, 0), a2, voffA);
            PG8_WAIT_V(8); PG8_WAIT_L(0); PG8_BAR; PG8_MMA(1, 0, At, B0); PG8_MMA(1, 1, At, B1); PG8_BAR; PG8_SCHED;
            PG8_LDB(B0, 1, 0); PG8_LDB(B1, 1, 1); PG8_SCHED; PG8_LDA(At, 1, 0); PG8_STAGE(PG8_SA(0, 1), a2 + hstepA, voffA);
            PG8_WAIT_V(8); PG8_WAIT_L(0); PG8_BAR; PG8_MMA(0, 0, At, B0); PG8_MMA(0, 1, At, B1); PG8_BAR; PG8_SCHED;
            PG8_LDA(At, 1, 1); PG8_STAGE(PG8_SB(1, 0), b3, voffB); PG8_STAGE(PG8_SB(1, 1), b3 + hstepB, voffB); PG8_STAGE(PG8_SA(1, 0), a3, voffA);
            PG8_WAIT_V(8); PG8_WAIT_L(0); PG8_BAR; PG8_MMA(1, 0, At, B0); PG8_MMA(1, 1, At, B1); PG8_BAR; PG8_SCHED;
            } else {
            PG8_LDB(B0, 0, 0); PG8_SCHED; PG8_LDA(At, 0, 0); PG8_STAGE(PG8_SA(1, 1), a1 + hstepA, voffA);
            PG8_WAIT_L(8); PG8_BAR; PG8_WAIT_L(0); PG8_MMA(0, 0, At, B0); PG8_BAR; PG8_SCHED;
            PG8_LDB(B1, 0, 1); PG8_STAGE(PG8_SB(0, 0), b2, voffB);
            PG8_BAR; PG8_WAIT_L(0); PG8_MMA(0, 1, At, B1); PG8_BAR;
            PG8_LDA(At, 0, 1); PG8_STAGE(PG8_SA(0, 0), a2, voffA);
            PG8_BAR; PG8_WAIT_L(0); PG8_MMA(1, 0, At, B0); PG8_BAR; PG8_SCHED;
            PG8_STAGE(PG8_SB(0, 1), b2 + hstepB, voffB);
            PG8_WAIT_V(6); PG8_BAR; PG8_MMA(1, 1, At, B1); PG8_BAR;
            PG8_LDB(B0, 1, 0); PG8_SCHED; PG8_LDA(At, 1, 0); PG8_STAGE(PG8_SA(0, 1), a2 + hstepA, voffA);
            PG8_WAIT_L(8); PG8_BAR; PG8_WAIT_L(0); PG8_MMA(0, 0, At, B0); PG8_BAR; PG8_SCHED;
            PG8_LDB(B1, 1, 1); PG8_STAGE(PG8_SB(1, 0), b3, voffB);
            PG8_BAR; PG8_WAIT_L(0); PG8_MMA(0, 1, At, B1); PG8_BAR;
            PG8_LDA(At, 1, 1); PG8_STAGE(PG8_SA(1, 0), a3, voffA);
            PG8_BAR; PG8_WAIT_L(0); PG8_MMA(1, 0, At, B0); PG8_BAR; PG8_SCHED;
            PG8_STAGE(PG8_SB(1, 1), b3 + hstepB, voffB);
            PG8_WAIT_V(6); PG8_BAR; PG8_MMA(1, 1, At, B1); PG8_BAR;
            }
        }
        if constexpr (ALIGN_EPI) { if (wr == 0) PG8_BAR; }
        if constexpr (!Epi::AFTER_DRAIN) { E(acc, cur, wr, wc, fr, fq); S.done(cur); }
        if (!has_next) break;
        if (!E.keep(cur)) {
#pragma unroll
        for (int a = 0; a < 2; ++a)
#pragma unroll
            for (int b = 0; b < 2; ++b)
#pragma unroll
                for (int m = 0; m < 4; ++m)
#pragma unroll
                    for (int n = 0; n < 2; ++n) acc[a][b][m][n] = (f32x4){0.f, 0.f, 0.f, 0.f};
        }
        cur = nxt; cA = nA; cB = nB; ++ui;
        if constexpr (ALIGN_EPI) { if (wr == 1) PG8_BAR; }
    }
    PG8_WAIT_V(0);
    if constexpr (!ALIGN_EPI) { if (wr == 0) PG8_BAR; }
    PG8_BAR;
    if constexpr (Epi::AFTER_DRAIN) { E.fused(acc, cur, wr, wc, fr, fq, lds, wid, lane); S.done(cur); }
#undef PG8_SA
#undef PG8_SB
#undef PG8_STAGE
#undef PG8_LDA
#undef PG8_LDB
#undef PG8_MMA
#undef PG8_WAIT_V
#undef PG8_WAIT_L
#undef PG8_BAR
#undef PG8_SCHED
}
}
#include <hip/hip_bf16.h>
#include <cmath>
namespace attn_body {
using bf16=__hip_bfloat16;
using bf16x8=__attribute__((ext_vector_type(8)))short;
using s16x4=__attribute__((ext_vector_type(4)))short;
using f32x16=__attribute__((ext_vector_type(16)))float;
using u32x4=__attribute__((ext_vector_type(4)))unsigned;
constexpr int BATCH=4,NHEAD=8,SEQ=8192,D=64,DM=NHEAD*D;
constexpr int NW=8,QBLK=32,QB=QBLK*NW,KVBLK=64,NQB=SEQ/QB;
constexpr int ATTN_PITCH=DM, ATTN_UNIT_ROWS=QB, OPITCH=1536, OCOL0=1024;
__device__ __forceinline__ int crow(int r,int hi){return (r&3)+8*(r>>2)+4*hi;}
#define SBAR() __builtin_amdgcn_sched_barrier(0)
__device__ __forceinline__ void cmask(f32x16&p0,f32x16&p1,int jb,int qrel,int hi){
  const float NEG=-INFINITY; int kb=64*jb+4*hi;
  #pragma unroll
  for(int r=0;r<16;++r){int kv=kb+(r&3)+8*(r>>2); if(kv>qrel)p0[r]=NEG; if(kv+32>qrel)p1[r]=NEG;}
}

constexpr int NSLOT=3, SLOTB=8192;
constexpr int LDS_K=0, LDS_V=NSLOT*SLOTB, LDS_WS=2*NSLOT*SLOTB, LDS_OST=LDS_WS+NW*64*4, LDS_BYTES=LDS_OST+NW*4096;
constexpr float C2=0.125f*1.4426950408889634f;
__device__ __forceinline__ void glds16(const void*gsrc,unsigned lds_dst){unsigned keep;
  asm volatile("s_mov_b32 %0, m0\n\ts_mov_b32 m0, %2\n\ts_nop 0\n\tglobal_load_lds_dwordx4 %1, off\n\ts_mov_b32 m0, %0":"=&s"(keep):"v"(gsrc),"s"(lds_dst):"memory");}
__device__ __forceinline__ float max3f(float a,float b,float c){float r;asm("v_max3_f32 %0, %1, %2, %3":"=v"(r):"v"(a),"v"(b),"v"(c));return r;}
__device__ __forceinline__ float max2f(float a,float b){float r;asm("v_max_f32_e32 %0, %1, %2":"=v"(r):"v"(a),"v"(b));return r;}
__device__ __forceinline__ float fadd_s(float a,float b){float r;asm("v_add_f32_e32 %0, %1, %2":"=v"(r):"v"(a),"v"(b));return r;}
__device__ __forceinline__ float fsub_s(float a,float b){float r;asm("v_sub_f32_e32 %0, %1, %2":"=v"(r):"v"(a),"v"(b));return r;}
typedef float f32x2_t __attribute__((ext_vector_type(2))); typedef __bf16 bf16x2_t __attribute__((ext_vector_type(2)));
__device__ __forceinline__ unsigned cvtpk_s(float lo,float hi){f32x2_t v={lo,hi};bf16x2_t b=__builtin_convertvector(v,bf16x2_t);return __builtin_bit_cast(unsigned,b);}
#define WAIT_BAR(N) asm volatile("s_waitcnt vmcnt(" #N ") lgkmcnt(0)\n\ts_barrier":::"memory")

__device__ __forceinline__ void qkt(f32x16&p0,f32x16&p1,const char*Kslot,const bf16x8*qr,int r32,int hi){
  const char*kb=Kslot+hi*1024+r32*16;
  #pragma unroll
  for(int d0=0;d0<4;++d0){
    const bf16x8 b0=*reinterpret_cast<const bf16x8*>(kb+d0*2048);
    const bf16x8 b1=*reinterpret_cast<const bf16x8*>(kb+d0*2048+512);
    p0=__builtin_amdgcn_mfma_f32_32x32x16_bf16(b0,qr[d0],p0,0,0,0);p1=__builtin_amdgcn_mfma_f32_32x32x16_bf16(b1,qr[d0],p1,0,0,0);}
}
typedef __attribute__((address_space(3))) const unsigned* lds_cuptr;
typedef float f32x4_t __attribute__((ext_vector_type(4)));
__device__ __forceinline__ unsigned bfr(float f){ unsigned u=__builtin_bit_cast(unsigned,f); return (u+0x7fffu+((u>>16)&1u))>>16; }
__device__ __forceinline__ void biasmm(f32x16&c0,f32x16&c1,unsigned w0,unsigned w1  ,unsigned qm1,int hi){
  const unsigned one=hi?0u:0x3f803f80u; w0=hi?0u:w0; w1=hi?0u:w1;
  const u32x4 k0={w0,one,0u,0u},k1={w1,one,0u,0u},qv={one,qm1,0u,0u};
  const f32x16 z=f32x16{};
  c0=__builtin_amdgcn_mfma_f32_32x32x16_bf16(__builtin_bit_cast(bf16x8,k0),__builtin_bit_cast(bf16x8,qv),z,0,0,0);
  c1=__builtin_amdgcn_mfma_f32_32x32x16_bf16(__builtin_bit_cast(bf16x8,k1),__builtin_bit_cast(bf16x8,qv),z,0,0,0);
}
typedef __attribute__((address_space(3))) const char* lds_cptr;
typedef short v4i16_t __attribute__((ext_vector_type(4)));
__device__ __forceinline__ void kload8(bf16x8*kf,lds_cptr kp){
  kf[0]=*(const __attribute__((address_space(3))) bf16x8*)(kp);      kf[1]=*(const __attribute__((address_space(3))) bf16x8*)(kp+512);
  kf[2]=*(const __attribute__((address_space(3))) bf16x8*)(kp+2048); kf[3]=*(const __attribute__((address_space(3))) bf16x8*)(kp+2560);
  kf[4]=*(const __attribute__((address_space(3))) bf16x8*)(kp+4096); kf[5]=*(const __attribute__((address_space(3))) bf16x8*)(kp+4608);
  kf[6]=*(const __attribute__((address_space(3))) bf16x8*)(kp+6144); kf[7]=*(const __attribute__((address_space(3))) bf16x8*)(kp+6656);
}
__device__ __forceinline__ void kload2(bf16x8*kf,lds_cptr kp,int j){ kf[2*j]=*(const __attribute__((address_space(3))) bf16x8*)(kp+j*2048); kf[2*j+1]=*(const __attribute__((address_space(3))) bf16x8*)(kp+j*2048+512); }
__device__ __forceinline__ s16x4 vtr(lds_cptr p){ return __builtin_bit_cast(s16x4,__builtin_amdgcn_ds_read_tr16_b64_v4i16((__attribute__((address_space(3))) v4i16_t*)p)); }
__device__ __forceinline__ float rowmax(const f32x16&p0,const f32x16&p1){
  float a=max3f(p0[0],p0[1],p1[0]),b=max3f(p0[2],p0[3],p1[1]);a=max3f(a,p1[2],p1[3]);
  #pragma unroll
  for(int r=4;r<16;r+=4){a=max3f(a,p0[r],p0[r+1]);b=max3f(b,p0[r+2],p0[r+3]);a=max3f(a,p1[r],p1[r+1]);b=max3f(b,p1[r+2],p1[r+3]);}
  const float m=max2f(a,b);
  auto rr=__builtin_amdgcn_permlane32_swap(__float_as_uint(m),__float_as_uint(m),false,false);
  return max2f(__uint_as_float(rr[0]),__uint_as_float(rr[1]));
}
__device__ __forceinline__ void pv(f32x16*o,int vb,bf16x8 pa0,bf16x8 pa1,bf16x8 pa2,bf16x8 pa3){
  #pragma unroll
  for(int d0=0;d0<2;++d0){s16x4 lo[4],hi[4];
    #pragma unroll
    for(int ks=0;ks<4;++ks){
      asm volatile("ds_read_b64_tr_b16 %0,%1 offset:%c2":"=&v"(lo[ks]):"v"(vb),"i"(d0*4096+ks*1024):"memory");
      asm volatile("ds_read_b64_tr_b16 %0,%1 offset:%c2":"=&v"(hi[ks]):"v"(vb),"i"(d0*4096+ks*1024+512):"memory");}
    asm volatile("s_waitcnt lgkmcnt(0)":::"memory");SBAR();
    #define PK(k) (bf16x8){lo[k][0],lo[k][1],lo[k][2],lo[k][3],hi[k][0],hi[k][1],hi[k][2],hi[k][3]}
    o[d0]=__builtin_amdgcn_mfma_f32_32x32x16_bf16(pa0,PK(0),o[d0],0,0,0);
    o[d0]=__builtin_amdgcn_mfma_f32_32x32x16_bf16(pa1,PK(1),o[d0],0,0,0);
    o[d0]=__builtin_amdgcn_mfma_f32_32x32x16_bf16(pa2,PK(2),o[d0],0,0,0);
    o[d0]=__builtin_amdgcn_mfma_f32_32x32x16_bf16(pa3,PK(3),o[d0],0,0,0);
    #undef PK
  }
}

__device__ __forceinline__ u32x4 mul_bf16x8(u32x4 a,u32x4 b){ u32x4 r;
  #pragma unroll
  for(int i=0;i<4;++i){ const float al=__uint_as_float(a[i]<<16),ah=__uint_as_float(a[i]&0xffff0000u),bl=__uint_as_float(b[i]<<16),bh=__uint_as_float(b[i]&0xffff0000u); r[i]=cvtpk_s(al*bl,ah*bh); }
  return r; }
#ifndef ATTN_STORE16
#define ATTN_STORE16(p,v) (*(u32x4*)(p)=(v))
#endif
template<int THRL> __device__ __forceinline__ void attn_unit(int b,int h,int qb,const bf16*Q,const bf16*__restrict__ K,const bf16*__restrict__ V,bf16*O,char*shm,lds_cuptr nb,int tskip,bool dry,int wave_id){
  int tid_=(int)__builtin_amdgcn_mbcnt_hi(~0u,__builtin_amdgcn_mbcnt_lo(~0u,0u)); asm volatile("":"+v"(tid_)); tid_+=wave_id*64; const int tid=tid_,lane=tid&63,r32=lane&31,hi=lane>>5; const int wid=__builtin_amdgcn_readfirstlane(tid>>6);
  const long rowbase=(long)b*SEQ; const int q0=qb*QB;
  const bf16*Qw=Q+(rowbase+q0+wid*QBLK)*DM+h*D;
  const bf16*Kh=K+(rowbase+(long)tskip*KVBLK)*DM+h*D,*Vh=V+(rowbase+(long)tskip*KVBLK)*DM+h*D;
  const unsigned lds0=(unsigned)(uintptr_t)shm;
  float*wsf=(float*)(shm+LDS_WS)+wid*64;
  const bf16*ksrc=Kh+(long)lane*DM+wid*8;
  const bf16*vsrc=Vh+(long)(16*(wid&3)+(lane>>2))*DM+(wid>>2)*32+(lane&3)*8;
  const unsigned kdst=lds0+LDS_K+wid*1024, vdst=lds0+LDS_V+wid*1024;
  #define DMA_K(t,slot) glds16(ksrc+(long)(t)*KVBLK*DM,(unsigned)__builtin_amdgcn_readfirstlane(kdst+(slot)))
  #define DMA_V(t,slot) glds16(vsrc+(long)(t)*KVBLK*DM,(unsigned)__builtin_amdgcn_readfirstlane(vdst+(slot)))
  const int vb0=(int)(lds0+LDS_V)+((lane>>4)&1)*32+(lane&3)*8+(4*hi+((lane&15)>>2))*64;
  const char*Kbase=shm+LDS_K; bf16x8 kf[8];
  const lds_cptr shm3=(lds_cptr)shm; const lds_cptr kp0=shm3+LDS_K+hi*1024+r32*16; const lds_cptr vp0=shm3+LDS_V+((lane>>4)&1)*32+(lane&3)*8+(4*hi+((lane&15)>>2))*64;
  const int NT=(q0+QB)/KVBLK-tskip;
  DMA_K(0,0);DMA_V(0,0);DMA_K(1,SLOTB);
  bf16x8 qr[4];
  #pragma unroll
  for(int d0=0;d0<4;++d0)qr[d0]=*reinterpret_cast<const bf16x8*>(&Qw[(long)r32*DM+d0*16+hi*8]);
  float mhat=0.f,l_reg=0.f;f32x16 o[2];o[0]=f32x16{};o[1]=f32x16{};unsigned qm1=0u;const lds_cuptr nbl=nb+64*tskip+r32;
  #define SETM(NEWM) do{ const float nm_=-(NEWM); const unsigned h_=bfr(nm_); const float hf_=__uint_as_float(h_<<16); const unsigned l_=bfr(nm_-hf_); mhat=-(hf_+__uint_as_float(l_<<16)); qm1=hi?0u:(h_|(l_<<16)); }while(0)
  const int qrel=wid*QBLK+r32;
  #define CMASK(P0,P1,t) do{int jb_=(t)-(NT-4); if(jb_>=0)cmask(P0,P1,jb_,qrel,hi);}while(0)
  bool resc=false;
  #define START(P0,P1) do{ const float rm=rowmax(P0,P1); resc=false; \
    { const float old_=mhat; SETM(old_+rm); const float dl=mhat-old_; \
      _Pragma("unroll") for(int r=0;r<16;++r){P0[r]=fsub_s(P0[r],dl);P1[r]=fsub_s(P1[r],dl);} } \
    _Pragma("unroll") for(int r=0;r<16;++r)P0[r]=__builtin_amdgcn_exp2f(P0[r]); }while(0)
  #define RESC() do{ if(resc){ asm volatile("s_waitcnt lgkmcnt(0)":::"memory"); \
      _Pragma("unroll") for(int d_=0;d_<2;++d_) _Pragma("unroll") for(int r=0;r<16;++r)o[d_][r]*=wsf[crow(r,hi)]; } }while(0)
  f32x16 pA0,pA1,pB0,pB1;
  int sl_prev=0,sl_cur=0,sl_next=SLOTB;
  #define ROT() do{sl_prev=sl_cur;sl_cur=sl_next;sl_next=(sl_next==(NSLOT-1)*SLOTB)?0:sl_next+SLOTB;}while(0)
  DMA_K(2,2*SLOTB);
  WAIT_BAR(3);
  unsigned bw0=nbl[0],bw1=nbl[32]; biasmm(pA0,pA1,bw0,bw1,qm1,hi); bw0=nbl[64]; bw1=nbl[96]; qkt(pA0,pA1,Kbase,qr,r32,hi);    asm volatile("s_nop 15\n\ts_nop 7":"+v"(pA0),"+v"(pA1));CMASK(pA0,pA1,0);
  START(pA0,pA1);
  _Pragma("unroll") for(int r=0;r<16;++r)pA1[r]=__builtin_amdgcn_exp2f(pA1[r]);
  WAIT_BAR(0);
  DMA_K(3,0);DMA_V(1,SLOTB);
  ROT();
  kload8(kf,kp0+sl_cur);
  WAIT_BAR(2);
  s16x4 vlo[8],vhi[8]; u32x4 pw0,pw1,pw2,pw3;
  #define PKW(P,B) cvtpk_s(P[B],P[B+1])
  #define PAF(k) __builtin_bit_cast(bf16x8,pw##k)
  #define VFR(i) (bf16x8){vlo[i][0],vlo[i][1],vlo[i][2],vlo[i][3],vhi[i][0],vhi[i][1],vhi[i][2],vhi[i][3]}
  #define PIN(x) asm volatile("":"+v"(x))
  #define MX3(a,b,c) __builtin_fmaxf(__builtin_fmaxf((a),(b)),(c))
  #define GAPA(MF,A0,A1,A2,A3,W0,W1,PW) do{ MF; sacc+=A0; sacc+=A1; sacc+=A2; sacc+=A3; PIN(sacc); W0; W1; PIN(PW); SBAR(); }while(0)
  #define EX(v) __builtin_amdgcn_exp2f(v)
  #define GAPB(MF,X,B) do{ MF; X[B]=EX(X[B]); X[B+1]=EX(X[B+1]); X[B+2]=EX(X[B+2]); X[B+3]=EX(X[B+3]); PIN(X); SBAR(); }while(0)
  #define VRD(i) do{ vlo[i]=vtr(vp_+(((i)>>2)*4096+((i)&3)*1024)); vhi[i]=vtr(vp_+(((i)>>2)*4096+((i)&3)*1024+512)); }while(0)
  #define KRD(G,j) do{ if(G){ kload2(kf,kp0+sl_next,j); SBAR(); } }while(0)
  #define STEP(C0,C1,P0,P1,t,GK,GV,GL) do{ SBAR(); \
    biasmm(C0,C1,bw0,bw1,qm1,hi); bw0=nbl[64*((t)+1)]; bw1=nbl[64*((t)+1)+32]; SBAR(); \
    const lds_cptr vp_=vp0+sl_prev; \
    VRD(0); SBAR(); float sacc=(P0[0]+P0[1]); \
    GAPA(C0=__builtin_amdgcn_mfma_f32_32x32x16_bf16(kf[0],qr[0],C0,0,0,0), P0[2],P0[3],P0[4],P0[5],     pw0[0]=PKW(P0,0), pw0[1]=PKW(P0,2), pw0); \
    VRD(4); SBAR(); GAPA(C1=__builtin_amdgcn_mfma_f32_32x32x16_bf16(kf[1],qr[0],C1,0,0,0), P0[6],P0[7],P0[8],P0[9],     pw0[2]=PKW(P0,4), pw0[3]=PKW(P0,6), pw0); \
    VRD(1); SBAR(); GAPA(C0=__builtin_amdgcn_mfma_f32_32x32x16_bf16(kf[2],qr[1],C0,0,0,0),   P0[10],P0[11],P0[12],P0[13], pw1[0]=PKW(P0,8), pw1[1]=PKW(P0,10), pw1); \
    VRD(5); SBAR(); GAPA(C1=__builtin_amdgcn_mfma_f32_32x32x16_bf16(kf[3],qr[1],C1,0,0,0),   P0[14],P0[15],P1[0],P1[1],   pw1[2]=PKW(P0,12),pw1[3]=PKW(P0,14), pw1); \
    VRD(2); SBAR(); GAPA(C0=__builtin_amdgcn_mfma_f32_32x32x16_bf16(kf[4],qr[2],C0,0,0,0),   P1[2],P1[3],P1[4],P1[5],     pw2[0]=PKW(P1,0), pw2[1]=PKW(P1,2), pw2); \
    VRD(6); SBAR(); GAPA(C1=__builtin_amdgcn_mfma_f32_32x32x16_bf16(kf[5],qr[2],C1,0,0,0),   P1[6],P1[7],P1[8],P1[9],     pw2[2]=PKW(P1,4), pw2[3]=PKW(P1,6), pw2); \
    VRD(3); SBAR(); GAPA(C0=__builtin_amdgcn_mfma_f32_32x32x16_bf16(kf[6],qr[3],C0,0,0,0),   P1[10],P1[11],P1[12],P1[13], pw3[0]=PKW(P1,8), pw3[1]=PKW(P1,10), pw3); \
    VRD(7); SBAR(); GAPA(C1=__builtin_amdgcn_mfma_f32_32x32x16_bf16(kf[7],qr[3],C1,0,0,0),   P1[14],P1[15],0.f,0.f,       pw3[2]=PKW(P1,12),pw3[3]=PKW(P1,14), pw3); \
    l_reg+=sacc; \
    if(GK){DMA_K((t)+3,sl_cur);} if(GV){DMA_V((t)+1,sl_next);} \
    CMASK(C0,C1,t); \
    { float a=MX3(C0[0],C0[1],C1[0]),b=MX3(C0[2],C0[3],C1[1]); a=MX3(a,C1[2],C1[3]); \
      _Pragma("unroll") for(int r=4;r<16;r+=4){a=MX3(a,C0[r],C0[r+1]);b=MX3(b,C0[r+2],C0[r+3]);a=MX3(a,C1[r],C1[r+1]);b=MX3(b,C1[r+2],C1[r+3]);} \
      float rm=__builtin_fmaxf(a,b); { auto rr=__builtin_amdgcn_permlane32_swap(__float_as_uint(rm),__float_as_uint(rm),false,false); rm=__builtin_fmaxf(__uint_as_float(rr[0]),__uint_as_float(rr[1])); } \
      resc=false; \
      if(__builtin_expect(__any(rm>(float)THRL),0)){ const float old_=mhat; SETM(old_+__builtin_fmaxf(rm,0.f)); const float dl=mhat-old_; \
        _Pragma("unroll") for(int r=0;r<16;++r){C0[r]-=dl;C1[r]-=dl;} \
        const float f=__builtin_amdgcn_exp2f(-dl); l_reg*=f; if(hi==0)wsf[r32]=f; resc=true; } } \
    SBAR(); \
    GAPB(o[0]=__builtin_amdgcn_mfma_f32_32x32x16_bf16(PAF(0),VFR(0),o[0],0,0,0), C0,0); \
    GAPB(o[1]=__builtin_amdgcn_mfma_f32_32x32x16_bf16(PAF(0),VFR(4),o[1],0,0,0), C0,4); \
    KRD(GL,0); GAPB(o[0]=__builtin_amdgcn_mfma_f32_32x32x16_bf16(PAF(1),VFR(1),o[0],0,0,0), C0,8); \
    KRD(GL,1); GAPB(o[1]=__builtin_amdgcn_mfma_f32_32x32x16_bf16(PAF(1),VFR(5),o[1],0,0,0), C0,12); \
    KRD(GL,2); GAPB(o[0]=__builtin_amdgcn_mfma_f32_32x32x16_bf16(PAF(2),VFR(2),o[0],0,0,0), C1,0); \
    KRD(GL,3); GAPB(o[1]=__builtin_amdgcn_mfma_f32_32x32x16_bf16(PAF(2),VFR(6),o[1],0,0,0), C1,4); \
    GAPB(o[0]=__builtin_amdgcn_mfma_f32_32x32x16_bf16(PAF(3),VFR(3),o[0],0,0,0), C1,8); \
    GAPB(o[1]=__builtin_amdgcn_mfma_f32_32x32x16_bf16(PAF(3),VFR(7),o[1],0,0,0), C1,12); \
    }while(0)
  int t=1;
  #undef CMASK
  #define CMASK(P0,P1,t) do{}while(0)
  for(;t+5<NT;t+=2){
    STEP(pB0,pB1,pA0,pA1,t,true,true,true);     WAIT_BAR(2); RESC(); ROT();
    STEP(pA0,pA1,pB0,pB1,t+1,true,true,true);   WAIT_BAR(2); RESC(); ROT();
  }
  #undef CMASK
  #define CMASK(P0,P1,t) do{int jb_=(t)-(NT-4); if(jb_>=0)cmask(P0,P1,jb_,qrel,hi);}while(0)
  #define ENDW(tt) do{ if((tt)+3<NT){WAIT_BAR(2);} else if((tt)+2<NT){WAIT_BAR(1);} else {WAIT_BAR(0);} }while(0)
  for(;t+1<NT;t+=2){
    STEP(pB0,pB1,pA0,pA1,t,(t+3<NT),(t+1<NT),(t+1<NT));       ENDW(t);   RESC(); ROT();
    STEP(pA0,pA1,pB0,pB1,t+1,(t+4<NT),(t+2<NT),(t+2<NT));     ENDW(t+1); RESC(); ROT();
  }
  STEP(pB0,pB1,pA0,pA1,NT-1,false,false,false); RESC();
  { float sacc=pB0[0]+pB0[1]; _Pragma("unroll") for(int r=2;r<16;++r)sacc+=pB0[r]; _Pragma("unroll") for(int r=0;r<16;++r)sacc+=pB1[r]; l_reg+=sacc;
    pw0=(u32x4){PKW(pB0,0),PKW(pB0,2),PKW(pB0,4),PKW(pB0,6)};pw1=(u32x4){PKW(pB0,8),PKW(pB0,10),PKW(pB0,12),PKW(pB0,14)};pw2=(u32x4){PKW(pB1,0),PKW(pB1,2),PKW(pB1,4),PKW(pB1,6)};pw3=(u32x4){PKW(pB1,8),PKW(pB1,10),PKW(pB1,12),PKW(pB1,14)};
    SBAR(); pv(o,vb0+sl_cur,PAF(0),PAF(1),PAF(2),PAF(3)); }
  #undef PKW
  #undef PAF
  #undef VFR
  #undef PIN
  #undef MX3
  #undef GAPA
  #undef GAPB
  #undef EX
  #undef VRD
  #undef KRD
  #undef STEP
  #undef ENDW
  {auto rr=__builtin_amdgcn_permlane32_swap(__float_as_uint(l_reg),__float_as_uint(l_reg),false,false);l_reg=__uint_as_float(rr[0])+__uint_as_float(rr[1]);}
  if(hi==0)wsf[32+r32]=l_reg;asm volatile("s_waitcnt lgkmcnt(0)":::"memory");
  float rli[16];
  #pragma unroll
  for(int r=0;r<16;++r)rli[r]=__builtin_amdgcn_rcpf(wsf[32+crow(r,hi)]);
  bf16*Ow=O+(rowbase+q0+wid*QBLK)*(long)OPITCH+OCOL0+h*D;
  { bf16*stg=(bf16*)(shm+LDS_OST)+wid*2048;
    #pragma unroll
    for(int r=0;r<16;++r){const int orow=crow(r,hi);
      #pragma unroll
      for(int d0=0;d0<2;++d0)stg[orow*64+d0*32+r32]=__float2bfloat16(o[d0][r]*rli[r]);}
    asm volatile("s_waitcnt lgkmcnt(0)":::"memory");
    #pragma unroll
    for(int i=0;i<4;++i){const int row=i*8+(lane>>3),ch=lane&7; const u32x4 v=*(const u32x4*)(stg+row*64+ch*8); bf16*gp=Ow+(long)row*OPITCH+ch*8; const u32x4 gt=*(const u32x4*)gp; if(!dry){ATTN_STORE16(gp,mul_bf16x8(v,gt));}} }
  asm volatile("s_waitcnt lgkmcnt(0)\n\ts_barrier":::"memory");
  #undef DMA_K
  #undef DMA_V
  #undef CMASK
  #undef START
  #undef RESC
  #undef ROT
  #undef SETM
}
constexpr int ATTN_LDS_BYTES=LDS_BYTES;
#undef SBAR
#undef WAIT_BAR
}
constexpr int BATCH = 4, SEQ = 8192, DMODEL = 1024, M = BATCH * SEQ, DEPTH = 2, INC = 7852;
constexpr int NT_A = 19, NT_B = 12, NTILES = NT_A + NT_B;
constexpr int SA_Q = 0, SA_K = 512, SA_V = 640, SA_G = 768, SB_Q = 1280, SB_K = 1792, SB_V = 1920, SB_IQ = 2048, SB_IK = 2176, SB_IW = 2208, SB_G = 2212,
              SC_Q = 2724, SC_K = 3236, SC_V = 3748, SC_F = 4260, SC_G = 4268, S_MG = 4780;
static_assert(S_MG + 3072 == INC, "column partition");
__host__ __device__ __forceinline__ int src_col(int t, int lc) {
    switch (t) {
        case 0: case 1: return SA_Q + t * 256 + lc;
        case 2: case 3: return SB_Q + (t - 2) * 256 + lc;
        case 4: case 5: return SC_Q + (t - 4) * 256 + lc;
        case 6: return lc < 128 ? SA_K + lc : SB_K + lc - 128;
        case 7: case 8: return SC_K + (t - 7) * 256 + lc;
        case 9: return lc < 128 ? SA_V + lc : SB_V + lc - 128;
        case 10: case 11: return SC_V + (t - 10) * 256 + lc;
        case 12: case 13: return SA_G + (t - 12) * 256 + lc;
        case 14: case 15: return SB_G + (t - 14) * 256 + lc;
        case 16: case 17: return SC_G + (t - 16) * 256 + lc;
        case 18: return lc < 128 ? SB_IQ + lc : lc < 160 ? SB_IK + lc - 128 : lc < 164 ? SB_IW + lc - 160 : lc < 172 ? SC_F + lc - 164 : -1;
        default: return S_MG + (t - 19) * 256 + lc;
    }
}
constexpr size_t MiB = 1u << 20;
constexpr size_t WS_CTL = 0, CTL_ZERO_BYTES = 1 * MiB;
constexpr size_t WS_W1T = 2 * MiB;
constexpr size_t WS_WBT = 33 * MiB;
constexpr size_t WS_WOT = 39 * MiB;
constexpr size_t WS_SSQ = 43 * MiB;
constexpr size_t WS_CL = 45 * MiB;
constexpr size_t WS_CT = 46 * MiB;
constexpr size_t WS_IW = 47 * MiB;
constexpr size_t WS_CF = 47 * MiB + 512 * 1024;
constexpr size_t WS_IQ = 49 * MiB;
constexpr size_t WS_IK = 57 * MiB;
constexpr size_t WS_XB = 60 * MiB;
constexpr size_t WS_MERGED = 124 * MiB;
constexpr size_t WS_G = 188 * MiB;
constexpr size_t WS_QA = 284 * MiB, WS_QB = 316 * MiB, WS_QC = 348 * MiB, WS_KC = 380 * MiB, WS_VC = 412 * MiB, WS_KAB = 444 * MiB, WS_VAB = 460 * MiB;
constexpr size_t WS_MG = 284 * MiB;
constexpr size_t WS_END = 476 * MiB;
static_assert(pg8::EWS_CL == WS_CL && pg8::EWS_CT == WS_CT && pg8::EWS_SSQ == WS_SSQ && pg8::EWS_IW == WS_IW && pg8::EWS_CF == WS_CF && pg8::EWS_IQ == WS_IQ && pg8::EWS_IK == WS_IK && pg8::EWS_G == WS_G && pg8::EWS_QA == WS_QA && pg8::EWS_QB == WS_QB &&
              pg8::EWS_QC == WS_QC && pg8::EWS_KC == WS_KC && pg8::EWS_VC == WS_VC && pg8::EWS_KAB == WS_KAB && pg8::EWS_VAB == WS_VAB, "epilogue offsets");
constexpr int CW_OVF = 8;
constexpr int CW_TICK = 8192;
constexpr int CW_BAR = 4096;
constexpr int RING_OFF = 0, RING_BYTES = 131072;
constexpr int SEL_OFF = 131072;
constexpr int H2_OFF = SEL_OFF + 16384;
constexpr int TMISC_OFF = H2_OFF + 8192;
constexpr int BIAS_OFF = TMISC_OFF + 2048;
constexpr int BKT_OFF = BIAS_OFF + 2048;
constexpr int MISC_OFF = BKT_OFF + 512;
constexpr int LDS_BYTES = 163840;
static_assert(MISC_OFF + 1024 <= LDS_BYTES, "LDS map");
constexpr int NB_OFF = 86016;
static_assert(attn_body::ATTN_LDS_BYTES <= NB_OFF && NB_OFF + 32768 <= RING_BYTES, "LDS map");
constexpr int MW_NSEL = 0, MW_NCAND = 16, MW_BIN = 32, MW_ABOVE = 48, MW_CARRY = 64, MW_BAR = 96, MW_SLOW = 100, MW_TICKET = 101, MW_TBAR = 102, MW_ZCUT = 112, MW_UC = 128, MW_ELO = 160;

#define GAS __attribute__((address_space(1)))
#define LAS __attribute__((address_space(3)))
typedef unsigned short bf16;
typedef unsigned v4u __attribute__((ext_vector_type(4)));
typedef float f32x4 __attribute__((ext_vector_type(4)));
typedef short bf16x8 __attribute__((ext_vector_type(8)));
typedef GAS unsigned gu32;
#define RLX_AGENT __ATOMIC_RELAXED, __HIP_MEMORY_SCOPE_AGENT
#define LDS_WAIT() asm volatile("s_waitcnt lgkmcnt(0)" ::: "memory")
#define VM_WAIT() asm volatile("s_waitcnt vmcnt(0)" ::: "memory")
__device__ __forceinline__ unsigned f2bf(float f) { unsigned u = __builtin_bit_cast(unsigned, f); return (u + 0x7fffu + ((u >> 16) & 1u)) >> 16; }
__device__ __forceinline__ unsigned pk2(float lo, float hi) { return f2bf(lo) | (f2bf(hi) << 16); }

#define XB_TMO      128
#define XB_XCNT(j)  (256  + 64 * (j))
#define XB_XSUB(j)  (1280 + 64 * (j))
#define XB_XGEN(j)  (2304 + 64 * (j))
#define XB_TOP      3328
#define XB_TOPGEN   3392
#define XCD_BAR_WORDS 3456
#define XB_SPIN_CAP (1u << 18)

__device__ __forceinline__ unsigned xb_ld(unsigned* p)              { return __hip_atomic_load(p, __ATOMIC_RELAXED, __HIP_MEMORY_SCOPE_AGENT); }
__device__ __forceinline__ unsigned xb_add(unsigned* p, unsigned v) { return __hip_atomic_fetch_add(p, v, __ATOMIC_RELAXED, __HIP_MEMORY_SCOPE_AGENT); }
__device__ __forceinline__ unsigned xb_xcc_id() { return (unsigned)__builtin_amdgcn_s_getreg((3 << 11) | 20) & 0xFu; }
#define XB_SPIN(cond, bar) do { unsigned _sp = 0; while (cond) { __builtin_amdgcn_s_sleep(1); \
    if ((++_sp & 255u) == 0u) { if (xb_ld(&(bar)[XB_TMO])) break; if (_sp > XB_SPIN_CAP) { atomicAdd(&(bar)[XB_TMO], 1u); break; } } } } while (0)

struct XcdBarrier {
    unsigned* bar; unsigned x;
    volatile LAS unsigned* st;
};

__device__ __forceinline__ XcdBarrier xcd_barrier_post(unsigned* bar, volatile LAS unsigned* st) {
    XcdBarrier b; b.bar = bar; b.x = xb_xcc_id(); b.st = st;
    if (threadIdx.x == 0) (void)xb_add(&bar[XB_XCNT(b.x)], 1u);
    return b;
}
__device__ __forceinline__ void xcd_barrier_complete(unsigned* bar, unsigned x, unsigned& nloc, unsigned& nx) {
    const unsigned G = gridDim.x * gridDim.y * gridDim.z;
    unsigned sum, cnt, mine, sp = 0u;
    for (;;) {
        sum = 0u; cnt = 0u; mine = 0u;
#pragma unroll
        for (unsigned j = 0; j < 16; ++j) { const unsigned c = xb_ld(&bar[XB_XCNT(j)]); sum += c; cnt += (c > 0u) ? 1u : 0u; mine = (j == x) ? c : mine; }
        if (sum == G) break;
        __builtin_amdgcn_s_sleep(1);
        if ((++sp & 255u) == 0u) { if (xb_ld(&bar[XB_TMO])) break; if (sp > XB_SPIN_CAP) { atomicAdd(&bar[XB_TMO], 1u); break; } }
    }
    nloc = mine > 0u ? mine : 1u; nx = cnt > 0u ? cnt : 1u;
}

__device__ __forceinline__ void xcd_barrier(const XcdBarrier& b) {
    asm volatile("s_waitcnt vmcnt(0)" ::: "memory");
    __syncthreads();
    if (threadIdx.x == 0) {
        unsigned* bar = b.bar;
        __builtin_amdgcn_s_waitcnt(0);
        unsigned nloc = b.st[0], nx = b.st[1];
        if (nloc == 0u) { xcd_barrier_complete(bar, b.x, nloc, nx); b.st[0] = nloc; b.st[1] = nx; }
        const unsigned old = xb_add(&bar[XB_XSUB(b.x)], 1u);
        const unsigned gen = old / nloc;
        if (old + 1u == (gen + 1u) * nloc) {
            __builtin_amdgcn_fence(__ATOMIC_RELEASE, "agent");
            asm volatile("s_waitcnt vmcnt(0)" ::: "memory");
            const unsigned og = xb_add(&bar[XB_TOP], 1u);
            const unsigned tg = og / nx;
            if (og + 1u == (tg + 1u) * nx) xb_add(&bar[XB_TOPGEN], 1u);
            else XB_SPIN(xb_ld(&bar[XB_TOPGEN]) == tg, bar);
            __builtin_amdgcn_fence(__ATOMIC_ACQUIRE, "agent");
            xb_add(&bar[XB_XGEN(b.x)], 1u);
            asm volatile("s_waitcnt vmcnt(0)" ::: "memory");
        } else {
            XB_SPIN(xb_ld(&bar[XB_XGEN(b.x)]) == gen, bar);
            __builtin_amdgcn_fence(__ATOMIC_ACQUIRE, "agent");
            asm volatile("s_waitcnt vmcnt(0)" ::: "memory");
        }
    }
    __syncthreads();
}

struct Frame {
    LAS unsigned char* lds;
    volatile LAS unsigned* MISC;
    gu32* ctl;
    int tid, lane, wave, vcu, G;
    LAS unsigned char *ring, *selp, *h2p, *miscp; int wt; unsigned tgen;
};
__device__ __forceinline__ float wave_sum(float v) {
#pragma unroll
    for (int o = 1; o < 64; o <<= 1) v += __shfl_xor(v, o);
    return v;
}
__device__ __forceinline__ float wave_incl_scan(float v, int lane) {
#pragma unroll
    for (int o = 1; o < 64; o <<= 1) { const float t = __shfl_up(v, o); if (lane >= o) v += t; }
    return v;
}
__device__ __forceinline__ int wave_incl_scan_i(int v, int lane) {
#pragma unroll
    for (int o = 1; o < 64; o <<= 1) { const int t = __shfl_up(v, o); if (lane >= o) v += t; }
    return v;
}
__device__ __forceinline__ void transpose_item(const float* W, int N, bf16* WT, int K, int n0, int k0, int scol, const float* kscale, LAS float* scr, int lane) {
#pragma unroll 8
    for (int i = 0; i < 32; ++i) { const int kk = 2 * i + (lane >> 5); float v = 0.f;
        if (scol >= 0) { v = W[(size_t)(k0 + kk) * N + scol]; if (kscale) v *= kscale[k0 + kk]; }
        scr[kk * 33 + (lane & 31)] = v; }
    LDS_WAIT(); asm volatile("" ::: "memory");
    const int c = lane & 7;
#pragma unroll
    for (int j = 0; j < 4; ++j) { const int n = (lane >> 3) + 8 * j; const LAS float* s = scr + (8 * c) * 33 + n;
        v4u o; o.x = pk2(s[0 * 33], s[1 * 33]); o.y = pk2(s[2 * 33], s[3 * 33]); o.z = pk2(s[4 * 33], s[5 * 33]); o.w = pk2(s[6 * 33], s[7 * 33]);
        *(GAS v4u*)(WT + (size_t)(n0 + n) * K + k0 + 8 * c) = o; }
    LDS_WAIT(); asm volatile("" ::: "memory");
}
__device__ __forceinline__ void p0_prologue(Frame& F, const float* x, const float* norm_gain, const float* w_in, const float* w_branch, const float* w_out, unsigned char* ws) {
    LAS float* scr = (LAS float*)(F.lds + RING_OFF + F.wave * 16384);
    const int gw = F.vcu * 8 + F.wave, NGW = F.G * 8, lane = F.lane;
    constexpr int I_W1 = 16 * (NTILES * 256 / 32), I_WB = 8 * 32, I_WO = 16 * 32;
    constexpr int NITEMS = DEPTH * I_W1 + DEPTH * 3 * I_WB + DEPTH * I_WO;
    for (int it = gw; it < NITEMS; it += NGW) {
        int r = it;
        if (r < DEPTH * I_W1) { const int L = r / I_W1; r -= L * I_W1; const int nblk = NTILES * 8, kb = r / nblk, nb = r % nblk, n0 = nb * 32, tile = n0 >> 8, p = (n0 & 255) + (lane & 31);
            const int lc = 64 * ((p >> 5) & 3) + 32 * (p >> 7) + (p & 31);
            transpose_item(w_in + (size_t)L * DMODEL * INC, INC, (bf16*)(ws + WS_W1T) + (size_t)L * NTILES * 256 * 1024, 1024, n0, kb * 64, src_col(tile, lc), norm_gain + L * DMODEL, scr, lane); continue; }
        r -= DEPTH * I_W1;
        if (r < DEPTH * 3 * I_WB) { const int mat = r / I_WB; r -= mat * I_WB; const int kb = r / 32, nb = r % 32;
            transpose_item(w_branch + (size_t)mat * 512 * 1024, 1024, (bf16*)(ws + WS_WBT) + (size_t)mat * 1024 * 512, 512, nb * 32, kb * 64, nb * 32 + (lane & 31), nullptr, scr, lane); continue; }
        r -= DEPTH * 3 * I_WB;
        { const int L = r / I_WO; r -= L * I_WO; const int kb = r / 32, nb = r % 32;
            transpose_item(w_out + (size_t)L * 1024 * 1024, 1024, (bf16*)(ws + WS_WOT) + (size_t)L * 1024 * 1024, 1024, nb * 32, kb * 64, nb * 32 + (lane & 31), nullptr, scr, lane); }
    }
    bf16* XB = (bf16*)(ws + WS_XB); float* SSQ = (float*)(ws + WS_SSQ);
    for (int m = gw; m < M; m += NGW) {
        const GAS f32x4* xr = (const GAS f32x4*)(x + (size_t)m * DMODEL) + lane; f32x4 v[4]; float s = 0.f;
#pragma unroll
        for (int j = 0; j < 4; ++j) { v[j] = xr[64 * j]; s += (v[j].x * v[j].x + v[j].y * v[j].y) + (v[j].z * v[j].z + v[j].w * v[j].w); }
        const float tot = wave_sum(s);
        GAS unsigned long long* o8 = (GAS unsigned long long*)(XB + (size_t)m * DMODEL) + lane;
#pragma unroll
        for (int j = 0; j < 4; ++j) o8[64 * j] = (unsigned long long)pk2(v[j].x, v[j].y) | ((unsigned long long)pk2(v[j].z, v[j].w) << 32);
        if (lane < 16) SSQ[(size_t)m * 16 + lane] = lane == 0 ? tot : 0.f;
    }
}
__device__ __forceinline__ void scan_phase(Frame& F, const float* CF, const float* bforget  , float* CL, float* CT) {
    const int lane = F.lane, h = F.wave;
    for (int u = blockIdx.x; u < 128; u += F.G) { const int b = u >> 5, j = u & 31; const size_t row = (size_t)b * SEQ + 256 * j + 4 * lane; const float bf = bforget[h];
        float s[4]; float run = 0.f;
#pragma unroll
        for (int e = 0; e < 4; ++e) { const float xx = CF[(row + e) * 8 + h] + bf; const float lf = (xx < 0.f ? xx : 0.f) - __logf(1.0f + __expf(-fabsf(xx))); run += lf; s[e] = run; }
        const float incl = wave_incl_scan(run, lane), excl = incl - run;
        *(f32x4*)(CL + (size_t)(b * 8 + h) * SEQ + 256 * j + 4 * lane) = (f32x4){excl + s[0], excl + s[1], excl + s[2], excl + s[3]};
        if (lane == 63) CT[(b * 8 + h) * 32 + j] = incl;
    }
}
#ifndef SPB_IDEAL
#define SPB_IDEAL 0
#endif
#ifndef REP_P2RS
#define REP_P2RS 1
#endif
#ifndef REP_TH
#define REP_TH 1
#endif
#ifndef REP_P2
#define REP_P2 1
#endif
#ifndef REP_RS
#define REP_RS 1
#endif
#ifndef REP_IDX
#define REP_IDX 1
#endif
#ifndef REP_SPB
#define REP_SPB 1
#endif
#ifndef REP_SPA
#define REP_SPA 1
#endif
typedef unsigned u32x2 __attribute__((ext_vector_type(2)));
constexpr int NBIN = 1024;
__device__ __forceinline__ float pdist(float s, float c0, float inv) { return fmaf(s, inv, c0); }
__device__ __forceinline__ unsigned bitop_xa(unsigned a, unsigned mask, unsigned c) { unsigned r; asm("v_bitop3_b32 %0, %1, %2, %3 bitop3:0x48" : "=v"(r) : "v"(a), "s"(mask), "v"(c)); return r; }
__device__ __forceinline__ unsigned pbin4_d(float d) { const unsigned du = __float_as_uint(d);
    unsigned e4 = __builtin_amdgcn_ubfe(du, 17u, 14u); e4 = e4 < 6144u ? 6144u : (e4 > 8191u ? 8191u : e4);
    unsigned b4 = (e4 ^ (unsigned)((int)du >> 31)) & 4092u; asm("" : "+v"(b4)); return b4; }
__device__ __forceinline__ unsigned pbin_d(float d) { return pbin4_d(d) >> 2; }
__device__ __forceinline__ unsigned pbin(float s, float sc, float inv) { return pbin_d(pdist(s, sc, inv)); }
__device__ __forceinline__ float pedge(int b) {
    if (b >= NBIN) return INFINITY; if (b <= 0) return -INFINITY;
    if (b > 512) return __uint_as_float((unsigned)(b - 512 + 1536) << 19);
    if (b == 512) return 0.0f;
    return -__uint_as_float(((unsigned)(511 - b + 1537) << 19) - 1u);
}
#ifndef CFALL
#define CFALL CMAX
#endif
constexpr int NW = 4;
constexpr int QBLK = 4096, CMAX = 512;
#define LDS_ADD(p, v) __hip_atomic_fetch_add((p), (v), __ATOMIC_RELAXED, __HIP_MEMORY_SCOPE_WORKGROUP)
__device__ __forceinline__ unsigned okey(float s) { const unsigned u = __float_as_uint(s); return (u & 0x80000000u) ? ~u : (u | 0x80000000u); }
struct BAParams { const bf16 *IQ, *IK; const float* IW; const bf16 *QA, *QB, *KAB, *VAB; bf16* G; const float* sinks; };
__device__ __forceinline__ void team_barrier(Frame& F) {
    asm volatile("s_waitcnt vmcnt(0) lgkmcnt(0)" ::: "memory");
    LAS unsigned* cnt = (LAS unsigned*)F.miscp + MW_TBAR; F.tgen += (unsigned)NW;
    if (F.lane == 0) __hip_atomic_fetch_add(cnt, 1u, __ATOMIC_RELAXED, __HIP_MEMORY_SCOPE_WORKGROUP);
    for (;;) { const unsigned v = (unsigned)__builtin_amdgcn_readfirstlane((int)*(volatile LAS unsigned*)cnt); if ((int)(v - F.tgen) >= 0) break; __builtin_amdgcn_s_sleep(1); }
    asm volatile("" ::: "memory");
}
typedef float f32x2 __attribute__((ext_vector_type(2)));
typedef int i32x2 __attribute__((ext_vector_type(2)));
__device__ __forceinline__ f32x2 relu2(float a, float b) { i32x2 v = {__float_as_int(a), __float_as_int(b)}; v = __builtin_elementwise_max(v, (i32x2){0, 0}); return __builtin_bit_cast(f32x2, v); }
__device__ __forceinline__ float relu_f(float x) { const int i = __float_as_int(x); return __int_as_float(i > 0 ? i : 0); }

template <int PASS, bool DIAG> __device__ __forceinline__ void idx_tile(const bf16x8 ak, const bf16x8 (&bq)[4], const f32x4 w4, int kt, int g4, int tq, float elo, float ehi, float zsent,
                                                                       unsigned lp4, unsigned hmask, unsigned hinc, LAS unsigned* zh, float sc, float inv, unsigned& accS, unsigned& accC) {
    const f32x4 z = {0.f, 0.f, 0.f, 0.f};
    const f32x4 d0 = __builtin_amdgcn_mfma_f32_16x16x32_bf16(ak, bq[0], z, 0, 0, 0), d1 = __builtin_amdgcn_mfma_f32_16x16x32_bf16(ak, bq[1], z, 0, 0, 0),
                d2 = __builtin_amdgcn_mfma_f32_16x16x32_bf16(ak, bq[2], z, 0, 0, 0), d3 = __builtin_amdgcn_mfma_f32_16x16x32_bf16(ak, bq[3], z, 0, 0, 0);
    float sv[4], dv[4]; unsigned nz = 0;
#pragma unroll
    for (int p2 = 0; p2 < 2; ++p2) { const f32x2 zero2 = {0.f, 0.f};
        f32x2 s2 = __builtin_elementwise_fma((f32x2){w4[0], w4[0]}, relu2(d0[2 * p2], d0[2 * p2 + 1]), zero2);
        s2 = __builtin_elementwise_fma((f32x2){w4[1], w4[1]}, relu2(d1[2 * p2], d1[2 * p2 + 1]), s2);
        s2 = __builtin_elementwise_fma((f32x2){w4[2], w4[2]}, relu2(d2[2 * p2], d2[2 * p2 + 1]), s2);
        s2 = __builtin_elementwise_fma((f32x2){w4[3], w4[3]}, relu2(d3[2 * p2], d3[2 * p2 + 1]), s2);
        const f32x2 dd = __builtin_elementwise_fma(s2, (f32x2){inv, inv}, (f32x2){sc, sc});
        sv[2 * p2] = s2[0]; sv[2 * p2 + 1] = s2[1]; dv[2 * p2] = dd[0]; dv[2 * p2 + 1] = dd[1]; }
    if (PASS == 1) {
#pragma unroll
        for (int i = 0; i < 4; ++i) { const float s = sv[i], d = dv[i];
            const int key = 16 * kt + 4 * g4 + i; const bool ok = !DIAG || key <= tq;
            if (ok) { const unsigned b4 = pbin4_d(d); LDS_ADD((LAS unsigned*)(uintptr_t)((b4 << 4) + ((b4 ^ lp4) & hmask)), hinc);
                      if (DIAG) nz += (s == 0.0f) ? 1u : 0u; } }
        if (!DIAG) { unsigned long long t0_, t1_, t2_;
            asm volatile("v_cmp_eq_f32 vcc, 0, %[s0]\n\tv_cmp_eq_f32 %[t0], 0, %[s1]\n\tv_cmp_eq_f32 %[t1], 0, %[s2]\n\tv_cmp_eq_f32 %[t2], 0, %[s3]\n\t"
                         "v_addc_co_u32 %[nz], vcc, 0, %[nz], vcc\n\tv_addc_co_u32 %[nz], %[t0], 0, %[nz], %[t0]\n\tv_addc_co_u32 %[nz], %[t1], 0, %[nz], %[t1]\n\tv_addc_co_u32 %[nz], %[t2], 0, %[nz], %[t2]"
                         : [nz] "+v"(nz), [t0] "=&s"(t0_), [t1] "=&s"(t1_), [t2] "=&s"(t2_) : [s0] "v"(sv[0]), [s1] "v"(sv[1]), [s2] "v"(sv[2]), [s3] "v"(sv[3]) : "vcc"); }
        if (nz) LDS_ADD(zh + (kt >> 3), nz);
    } else if (DIAG) {
#pragma unroll
        for (int i = 3; i >= 0; --i) { const int key = 16 * kt + 4 * g4 + i; const bool ok = key <= tq;
            accS = 2u * accS + ((ok && dv[i] >= ehi) ? 1u : 0u); accC = 2u * accC + ((ok && dv[i] >= elo && sv[i] != zsent) ? 1u : 0u); }
    } else {
        unsigned long long t0_, t1_;
#define IDX_FL(D_, S_) "v_cmp_ge_f32 vcc, %[" #D_ "], %[ehi]\n\tv_cmp_ge_f32 %[t0], %[" #D_ "], %[elo]\n\tv_cmp_neq_f32 %[t1], %[" #S_ "], %[zs]\n\tv_addc_co_u32 %[as], vcc, %[as], %[as], vcc\n\ts_and_b64 %[t0], %[t0], %[t1]\n\tv_addc_co_u32 %[ac], %[t1], %[ac], %[ac], %[t0]\n\t"
        asm volatile(IDX_FL(d3, s3) IDX_FL(d2, s2) IDX_FL(d1, s1) IDX_FL(d0, s0)
                     : [as] "+v"(accS), [ac] "+v"(accC), [t0] "=&s"(t0_), [t1] "=&s"(t1_)
                     : [d0] "v"(dv[0]), [d1] "v"(dv[1]), [d2] "v"(dv[2]), [d3] "v"(dv[3]), [s0] "v"(sv[0]), [s1] "v"(sv[1]), [s2] "v"(sv[2]), [s3] "v"(sv[3]), [ehi] "v"(ehi), [elo] "v"(elo), [zs] "v"(zsent) : "vcc", "scc");
#undef IDX_FL
    }
}
template <int PASS> __device__ __forceinline__ void idx_pass(Frame& F, const bf16* IKb, const bf16x8 (&bq)[4], const f32x4 w4, int tau, int t0) {
    int lane_ = F.lane; asm volatile("" : "+v"(lane_)); const int lane = lane_, r = lane & 15, g4 = lane >> 4, tq = t0 + r;
    const unsigned hbase = (unsigned)(uintptr_t)F.ring, hmask = 60u | hbase, lp = ((((unsigned)lane >> 1) & 15u) * 4u) | hbase, hinc = 1u << ((lane & 1) * 16);
    LAS unsigned* misc = (LAS unsigned*)(F.miscp);
    float elo = 0.f, ehi = 0.f; int zcut = SEQ; if (PASS == 2) { elo = __uint_as_float(misc[MW_ELO + r]); ehi = __uint_as_float(misc[MW_ELO + 16 + r]); zcut = (int)misc[MW_ZCUT + r]; }
    LAS unsigned* zh = (LAS unsigned*)(F.h2p) + r * 64;
    LAS unsigned* bw = (LAS unsigned*)(F.ring + r * QBLK) + F.wt * 4 + g4;
    const bf16* kp = IKb + (size_t)r * 32 + 8 * g4;
    float sc, inv;
    if (PASS == 2) { sc = __uint_as_float(misc[MW_UC + r]); inv = __uint_as_float(misc[MW_UC + 16 + r]); }
    else { const bf16x8 at = *(const bf16x8*)kp; const f32x4 z = {0.f, 0.f, 0.f, 0.f};
        const f32x4 d0 = __builtin_amdgcn_mfma_f32_16x16x32_bf16(at, bq[0], z, 0, 0, 0), d1 = __builtin_amdgcn_mfma_f32_16x16x32_bf16(at, bq[1], z, 0, 0, 0),
                    d2 = __builtin_amdgcn_mfma_f32_16x16x32_bf16(at, bq[2], z, 0, 0, 0), d3 = __builtin_amdgcn_mfma_f32_16x16x32_bf16(at, bq[3], z, 0, 0, 0);
        float mx = -INFINITY, ma = 0.f;
#pragma unroll
        for (int i = 0; i < 4; ++i) { float s = 0.f; s = fmaf(w4[0], relu_f(d0[i]), s); s = fmaf(w4[1], relu_f(d1[i]), s); s = fmaf(w4[2], relu_f(d2[i]), s); s = fmaf(w4[3], relu_f(d3[i]), s); mx = fmaxf(mx, s); ma = fmaxf(ma, fabsf(s)); }
        mx = fmaxf(mx, __shfl_xor(mx, 16)); mx = fmaxf(mx, __shfl_xor(mx, 32)); ma = fmaxf(ma, __shfl_xor(ma, 16)); ma = fmaxf(ma, __shfl_xor(ma, 32));
        inv = (ma > 1e-30f && ma < 1e30f) ? __builtin_amdgcn_rcpf(ma) * 0.0078125f : 0.0078125f; sc = -(mx * inv);
        if (PASS == 1 && F.wt == 0 && g4 == 0) { misc[MW_UC + r] = __float_as_uint(sc); misc[MW_UC + 16 + r] = __float_as_uint(inv); } }
    constexpr int NPF = 8;
    unsigned accS = 0u, accC = 0u; int n = 0;
    bf16x8 A[NPF];
#pragma unroll
    for (int j = 0; j < NPF; ++j) { const int kj = F.wt + NW * j; A[j] = *(const bf16x8*)(kp + (size_t)(kj < tau ? kj : tau) * 512); }
    int kt = F.wt;
    static_assert(NPF == 8, "a full round of the loop below is one bitmap word (8 tiles) per lane");
#pragma unroll 1
    for (; kt + NW * (NPF - 1) < tau; kt += NW * NPF) {
#pragma unroll
        for (int j = 0; j < NPF; ++j) { const int kj = kt + NW * j;
            const float zsent = (PASS == 2 && 16 * kj < zcut) ? __uint_as_float(0x7fc00000u) : 0.0f;
            idx_tile<PASS, false>(A[j], bq, w4, kj, g4, tq, elo, ehi, zsent, lp, hmask, hinc, zh, sc, inv, accS, accC);
            const int kn = kj + NW * NPF; A[j] = *(const bf16x8*)(kp + (size_t)(kn < tau ? kn : tau) * 512); }
        if (PASS == 2) { LAS unsigned* wp = bw + n * (NW / 2); wp[0] = accS; wp[256] = accC; accS = 0u; accC = 0u; n += 8; }
    }
#pragma unroll 1
    for (; kt < tau; kt += NW * NPF) {
#pragma unroll
        for (int j = 0; j < NPF; ++j) { const int kj = kt + NW * j;
            if (kj < tau) {
                const float zsent = (PASS == 2 && 16 * kj < zcut) ? __uint_as_float(0x7fc00000u) : 0.0f;
                idx_tile<PASS, false>(A[j], bq, w4, kj, g4, tq, elo, ehi, zsent, lp, hmask, hinc, zh, sc, inv, accS, accC);
                if (PASS == 2) { ++n; if ((n & 7) == 0) { LAS unsigned* wp = bw + (n - 8) * (NW / 2); wp[0] = accS; wp[256] = accC; accS = 0u; accC = 0u; } }
            }
            const int kn = kj + NW * NPF; A[j] = *(const bf16x8*)(kp + (size_t)(kn < tau ? kn : tau) * 512); }
    }
    if ((tau & (NW - 1)) == F.wt) {
        const bf16x8 ad = *(const bf16x8*)(kp + (size_t)tau * 512);
        const float zsent = (PASS == 2 && 16 * tau < zcut) ? __uint_as_float(0x7fc00000u) : 0.0f;
        idx_tile<PASS, true>(ad, bq, w4, tau, g4, tq, elo, ehi, zsent, lp, hmask, hinc, zh, sc, inv, accS, accC);
        if (PASS == 2) { ++n; if ((n & 7) == 0) { LAS unsigned* wp = bw + (n - 8) * (NW / 2); wp[0] = accS; wp[256] = accC; accS = 0u; accC = 0u; } }
    }
    if (PASS == 2 && (n & 7)) { const int sh = 4 * (8 - (n & 7)); LAS unsigned* wp = bw + (n & ~7) * (NW / 2); wp[0] = accS << sh; wp[256] = accC << sh; }
}
struct ThrRes { int Ls, bs, above; unsigned zcut; };
__device__ __forceinline__ ThrRes idx_thr_one(Frame& F, int q, int lane, const LAS unsigned* misc) {
    const unsigned sh = (q & 1) * 16, qh = (unsigned)q >> 1;
    const LAS unsigned* hb = (const LAS unsigned*)(F.ring);
    int cnt[16];
#pragma unroll
    for (int k = 0; k < 16; ++k) { const unsigned bin = 64u * k + lane, sw = bin & 15u; const LAS unsigned* p = hb + bin * 16u;
        cnt[k] = (int)(((p[qh ^ sw] >> sh) & 0xffffu) + ((p[(qh + 8u) ^ sw] >> sh) & 0xffffu)); }
    int a8[8], a4[4], a2[2], a1;
    { const bool h5 = lane & 32, h4 = lane & 16, h3 = lane & 8, h2 = lane & 4;
#pragma unroll
      for (int i = 0; i < 8; ++i) { const int mine = h5 ? cnt[8 + i] : cnt[i], theirs = h5 ? cnt[i] : cnt[8 + i]; a8[i] = mine + __shfl_xor(theirs, 32); }
#pragma unroll
      for (int i = 0; i < 4; ++i) { const int mine = h4 ? a8[4 + i] : a8[i], theirs = h4 ? a8[i] : a8[4 + i]; a4[i] = mine + __shfl_xor(theirs, 16); }
#pragma unroll
      for (int i = 0; i < 2; ++i) { const int mine = h3 ? a4[2 + i] : a4[i], theirs = h3 ? a4[i] : a4[2 + i]; a2[i] = mine + __shfl_xor(theirs, 8); }
      { const int mine = h2 ? a2[1] : a2[0], theirs = h2 ? a2[0] : a2[1]; a1 = mine + __shfl_xor(theirs, 4); }
      a1 += __shfl_xor(a1, 1); a1 += __shfl_xor(a1, 2); }
    int ks = 0, aseg = 0, v = cnt[0]; { int cum = 0; bool found = false;
#pragma unroll
        for (int k = 15; k >= 0; --k) { const int Tk = __builtin_amdgcn_readlane(a1, 4 * k); if (!found && cum + Tk >= 256) { found = true; ks = k; aseg = cum; v = cnt[k]; } cum += Tk; } }
    const int pre = wave_incl_scan_i(v, lane);
    int tot = pre; tot = __shfl(tot, 63);
    const int suf = tot - pre + v;
    const unsigned long long mask = __ballot(aseg + suf >= 256);
    const int Ls = mask ? 63 - (int)__builtin_clzll(mask) : 0;
    const int binstar = __shfl(64 * ks + lane, Ls), above = __shfl(aseg + suf - v, Ls), needz = 256 - above;
    const int zc = (int)((const LAS unsigned*)(F.h2p))[q * 64 + lane]; const int zi = wave_incl_scan_i(zc, lane);
    const unsigned long long zm = __ballot(zi >= needz);
    ThrRes R; R.Ls = Ls; R.bs = binstar; R.above = above;
    R.zcut = (binstar == (int)pbin(0.0f, __uint_as_float(misc[MW_UC + q]), __uint_as_float(misc[MW_UC + 16 + q])) && zm) ? (unsigned)(128 * ((int)__builtin_ctzll(zm) + 1)) : (unsigned)SEQ;
    return R;
}
__device__ __forceinline__ void idx_threshold(Frame& F) {
    int lane_ = F.lane; asm volatile("" : "+v"(lane_)); const int lane = lane_; LAS unsigned* misc = (LAS unsigned*)(F.miscp);
    const int q0 = NW * F.wt;
    const ThrRes R0 = idx_thr_one(F, q0, lane, misc), R1 = idx_thr_one(F, q0 + 1, lane, misc), R2 = idx_thr_one(F, q0 + 2, lane, misc), R3 = idx_thr_one(F, q0 + 3, lane, misc);
    if (lane < 4) { const ThrRes R = lane == 0 ? R0 : (lane == 1 ? R1 : (lane == 2 ? R2 : R3)); const int q = q0 + lane;
        misc[MW_BIN + q] = (unsigned)R.bs; misc[MW_ABOVE + q] = (unsigned)R.above; misc[MW_ZCUT + q] = R.zcut;
        misc[MW_ELO + q] = __float_as_uint(pedge(R.bs)); misc[MW_ELO + 16 + q] = __float_as_uint(pedge(R.bs + 1)); }
}
__device__ __forceinline__ unsigned idx_digit(const u32x2 e, int lvl) { const unsigned v = 8191u - e.y;
    return lvl == 0 ? e.x >> 24 : lvl == 1 ? (e.x >> 16) & 255u : lvl == 2 ? (e.x >> 8) & 255u : lvl == 3 ? e.x & 255u : lvl == 4 ? (v >> 5) & 255u : v & 31u; }
#define IDX_EXPAND(W4_, POS_, EMIT_) do { const int kb_ = 512 * (lane >> 4) + 16 * ((lane >> 2) & 3) + 4 * (lane & 3); \
    _Pragma("unroll") for (int g_ = 0; g_ < 4; ++g_) { unsigned w_ = (W4_)[g_]; \
        while (w_) { const int b_ = (int)__builtin_ctz(w_); w_ &= w_ - 1u; const int key_ = kb_ + 2048 * g_ + 64 * (7 - (b_ >> 2)) + (b_ & 3); EMIT_(POS_, key_); ++POS_; } } } while (0)
__device__ __forceinline__ void idx_rescore(const LAS unsigned* keyp, int kstr, LAS unsigned* outp, int ostr, int n, int q, int lane, const bf16* IKb, const bf16x8 (&bq)[4], const f32x4 w4) {
    const int r = lane & 15, g4 = lane >> 4; bf16x8 ak[4];
#pragma unroll
    for (int u = 0; u < 4; ++u) { const int ci = 16 * u + r; const unsigned key = ci < n ? keyp[ci * kstr] : 0u; ak[u] = *(const bf16x8*)(IKb + (size_t)key * 32 + 8 * g4); }
#pragma unroll
    for (int u = 0; u < 4; ++u) { if (16 * u < n) { const f32x4 z = {0.f, 0.f, 0.f, 0.f};
        const f32x4 d0 = __builtin_amdgcn_mfma_f32_16x16x32_bf16(ak[u], bq[0], z, 0, 0, 0), d1 = __builtin_amdgcn_mfma_f32_16x16x32_bf16(ak[u], bq[1], z, 0, 0, 0),
                    d2 = __builtin_amdgcn_mfma_f32_16x16x32_bf16(ak[u], bq[2], z, 0, 0, 0), d3 = __builtin_amdgcn_mfma_f32_16x16x32_bf16(ak[u], bq[3], z, 0, 0, 0);
#pragma unroll
        for (int i = 0; i < 4; ++i) { float sx = 0.f; sx = fmaf(w4[0], relu_f(d0[i]), sx); sx = fmaf(w4[1], relu_f(d1[i]), sx); sx = fmaf(w4[2], relu_f(d2[i]), sx); sx = fmaf(w4[3], relu_f(d3[i]), sx);
            const int ci = 16 * u + 4 * g4 + i; if (r == q && ci < n) outp[ci * ostr] = okey(sx); } } }
}
__device__ __forceinline__ void idx_pick_digit(const LAS unsigned* h2, int need, int lane, unsigned& dstar, int& above, int& inside) {
    const v4u hw = *(const LAS v4u*)(h2 + 252 - 4 * lane);
    const int total = (int)(hw.x + hw.y + hw.z + hw.w), incl = wave_incl_scan_i(total, lane);
    const unsigned long long mask = __ballot(incl >= need);
    const int Ls = mask ? (int)__builtin_ctzll(mask) : 63;
    int dstar_l = 0, above_l = 0, in_l = 0; { int cum = incl - total; bool found = false;
#pragma unroll
        for (int e = 3; e >= 0; --e) { const int cc = (int)hw[e]; if (!found && cum + cc >= need) { found = true; dstar_l = 252 - 4 * lane + e; above_l = cum; in_l = cc; } cum += cc; } }
    dstar = (unsigned)__shfl(dstar_l, Ls); above = __shfl(above_l, Ls); inside = __shfl(in_l, Ls);
}
template <int MODE> __device__ __forceinline__ void idx_sweep(int lvl, unsigned dstar, v4u& wc, LAS unsigned* stg, LAS unsigned* h2, LAS unsigned* nselp, LAS unsigned short* sel,
                                                              int q, int lane, const bf16* IKb, const bf16x8 (&bq)[4], const f32x4 w4) {
    v4u w = wc; const int kb = 512 * (lane >> 4) + 16 * ((lane >> 2) & 3) + 4 * (lane & 3);
    while (__ballot((w.x | w.y | w.z | w.w) != 0u)) {
        const bool has = (w.x | w.y | w.z | w.w) != 0u;
        const int g = w.x ? 0 : (w.y ? 1 : (w.z ? 2 : 3));
        const unsigned cur = w.x ? w.x : (w.y ? w.y : (w.z ? w.z : w.w));
        const int b = has ? (int)__builtin_ctz(cur) : 0; const unsigned bit = has ? (1u << b) : 0u;
        const int key = has ? kb + 2048 * g + 64 * (7 - (b >> 2)) + (b & 3) : 0;
        stg[lane] = (unsigned)key;
        idx_rescore(stg, 1, stg + 64, 1, 64, q, lane, IKb, bq, w4);
        const u32x2 e = {stg[64 + lane], (unsigned)key}; const unsigned dg = idx_digit(e, lvl);
        if (has) {
            if (MODE == 0) LDS_ADD(h2 + dg, 1u);
            else { if (dg > dstar) { const unsigned pos = LDS_ADD(nselp, 1u); if (pos < 256u) sel[pos] = (unsigned short)key; }
                   if (dg != dstar) { wc.x &= g == 0 ? ~bit : ~0u; wc.y &= g == 1 ? ~bit : ~0u; wc.z &= g == 2 ? ~bit : ~0u; wc.w &= g == 3 ? ~bit : ~0u; } }
        }
        w.x &= g == 0 ? ~bit : ~0u; w.y &= g == 1 ? ~bit : ~0u; w.z &= g == 2 ? ~bit : ~0u; w.w &= g == 3 ? ~bit : ~0u;
    }
}
__device__ __forceinline__ void idx_resolve(Frame& F, const bf16* IKb, const bf16x8 (&bq)[4], const f32x4 w4, int tau) {
    int lane_ = F.lane; asm volatile("" : "+v"(lane_)); const int lane = lane_; LAS unsigned* misc = (LAS unsigned*)(F.miscp);
    LAS unsigned* h2 = (LAS unsigned*)(F.h2p) + F.wt * 256;
    for (int qq = 0; qq < NW; ++qq) { const int q = NW * F.wt + qq;
        LAS u32x2* cq = (LAS u32x2*)(F.ring + q * QBLK);
        LAS unsigned short* sel = (LAS unsigned short*)(F.selp) + q * 256;
        v4u ws, wc; { const LAS unsigned* bmp = (const LAS unsigned*)(F.ring + q * QBLK) + lane; const int wv = (lane >> 2) & 3, m0 = lane >> 4;
#pragma unroll
            for (int g = 0; g < 4; ++g) { const bool ok = wv + 32 * (m0 + 4 * g) <= tau;
                ws[g] = ok ? bmp[64 * g] : 0u; wc[g] = ok ? bmp[256 + 64 * g] : 0u; } }
        wc.x &= ~ws.x; wc.y &= ~ws.y; wc.z &= ~ws.z; wc.w &= ~ws.w;
        const int nS = (int)(__builtin_popcount(ws.x) + __builtin_popcount(ws.y) + __builtin_popcount(ws.z) + __builtin_popcount(ws.w));
        int nC = (int)(__builtin_popcount(wc.x) + __builtin_popcount(wc.y) + __builtin_popcount(wc.z) + __builtin_popcount(wc.w));
        const int iS = wave_incl_scan_i(nS, lane); int iC = wave_incl_scan_i(nC, lane);
        const int totS = __shfl(iS, 63); int c = __shfl(iC, 63);
        { int pos = iS - nS;
#define EMIT_SEL(P_, K_) do { sel[(P_) < 255 ? (P_) : 255] = (unsigned short)(K_); } while (0)
          IDX_EXPAND(ws, pos, EMIT_SEL);
#undef EMIT_SEL
        }
        if (lane == 0) misc[MW_NSEL + q] = (unsigned)(totS < 256 ? totS : 256);
        int need = 256 - totS; if (need < 0) need = 0;
        if (c > CFALL && c > need) {
#pragma unroll 1
            for (int lvl = 0; lvl < 6 && c > CFALL; ++lvl) {
                *(LAS v4u*)(h2 + 4 * lane) = (v4u){0u, 0u, 0u, 0u};
                idx_sweep<0>(lvl, 0u, wc, (LAS unsigned*)cq, h2, misc + MW_NSEL + q, sel, q, lane, IKb, bq, w4);
                unsigned dstar; int above, inside; idx_pick_digit(h2, need, lane, dstar, above, inside);
                idx_sweep<1>(lvl, dstar, wc, (LAS unsigned*)cq, h2, misc + MW_NSEL + q, sel, q, lane, IKb, bq, w4);
                c = inside; need -= above;
            }
            if (c > CMAX) { if (lane == 0) __hip_atomic_fetch_add(F.ctl + CW_OVF, 1u, RLX_AGENT); c = 0; need = 0; wc = (v4u){0u, 0u, 0u, 0u}; }
            nC = (int)(__builtin_popcount(wc.x) + __builtin_popcount(wc.y) + __builtin_popcount(wc.z) + __builtin_popcount(wc.w)); iC = wave_incl_scan_i(nC, lane);
        }
        { int pos = iC - nC;
#define EMIT_CAND(P_, K_) do { if ((P_) < CMAX) cq[(P_)] = (u32x2){0u, (unsigned)(K_)}; } while (0)
          IDX_EXPAND(wc, pos, EMIT_CAND);
#undef EMIT_CAND
        }
        if (c > need)
            for (int c0 = 0; c0 < c; c0 += 64) idx_rescore((const LAS unsigned*)cq + 2 * c0 + 1, 2, (LAS unsigned*)cq + 2 * c0, 2, c - c0 < 64 ? c - c0 : 64, q, lane, IKb, bq, w4);
        if (c > need && c <= 64) {
            u32x2 e = {0u, 0u}; if (lane < c) e = cq[lane]; int rank = 0;
            const int cu = __builtin_amdgcn_readfirstlane(c);
#pragma unroll 1
            for (int j = 0; j < cu; j += 4) {
#pragma unroll
                for (int k = 0; k < 4; ++k) { const unsigned uj = (unsigned)__builtin_amdgcn_readlane((int)e.x, (j + k) & 63), ij = (unsigned)__builtin_amdgcn_readlane((int)e.y, (j + k) & 63); rank += (uj > e.x || (uj == e.x && ij < e.y)) ? 1 : 0; } }
            if (lane < c && rank < need) { const unsigned pos = LDS_ADD(misc + MW_NSEL + q, 1u); if (pos < 256u) sel[pos] = (unsigned short)e.y; }
            c = 0; need = 0;
        }
#pragma unroll 1
        for (int lvl = 0; lvl < 6 && c > need; ++lvl) {
            *(LAS v4u*)(h2 + 4 * lane) = (v4u){0u, 0u, 0u, 0u};
            for (int i = lane; i < c; i += 64) LDS_ADD(h2 + idx_digit(cq[i], lvl), 1u);
            const v4u hw = *(const LAS v4u*)(h2 + 252 - 4 * lane);
            const int total = (int)(hw.x + hw.y + hw.z + hw.w), incl = wave_incl_scan_i(total, lane);
            const unsigned long long mask = __ballot(incl >= need);
            const int Ls = mask ? (int)__builtin_ctzll(mask) : 63;
            int dstar_l = 0, above_l = 0; { int cum = incl - total; bool found = false;
#pragma unroll
                for (int e = 3; e >= 0; --e) { const int cc = (int)hw[e]; if (!found && cum + cc >= need) { found = true; dstar_l = 252 - 4 * lane + e; above_l = cum; } cum += cc; } }
            const unsigned dstar = (unsigned)__shfl(dstar_l, Ls); const int above = __shfl(above_l, Ls);
            int c2 = 0;
            for (int base = 0; base < c; base += 64) { const int i = base + lane; const bool valid = i < c; u32x2 e = {0u, 0u}; if (valid) e = cq[i];
                const unsigned dg = idx_digit(e, lvl); const bool tie = valid && dg == dstar;
                if (valid && dg > dstar) { const unsigned pos = LDS_ADD(misc + MW_NSEL + q, 1u); if (pos < 256u) sel[pos] = (unsigned short)e.y; }
                const unsigned long long tm = __ballot(tie);
                if (tie) cq[c2 + __popcll(tm & ((1ull << lane) - 1ull))] = e;
                c2 += __popcll(tm); }
            c = c2; need -= above;
        }
        for (int i = lane; i < c && i < need; i += 64) { const unsigned pos = LDS_ADD(misc + MW_NSEL + q, 1u); if (pos < 256u) sel[pos] = (unsigned short)cq[i].y; }
    }
}
typedef short s16x4 __attribute__((ext_vector_type(4)));
__device__ __forceinline__ unsigned cvt_pk_bf16x2(float lo, float hi) { unsigned r_; asm("v_cvt_pk_bf16_f32 %0, %1, %2" : "=v"(r_) : "v"(lo), "v"(hi)); return r_; }
__device__ __forceinline__ void sp_glds16(const void* gsrc, unsigned lds_dst) { unsigned keep;
    asm volatile("s_mov_b32 %0, m0\n\ts_mov_b32 m0, %2\n\ts_nop 0\n\tglobal_load_lds_dwordx4 %1, off\n\ts_mov_b32 m0, %0" : "=&s"(keep) : "v"(gsrc), "s"(lds_dst) : "memory"); }
__device__ __forceinline__ void sp_glds16s(const void* sbase, unsigned voff, unsigned lds_dst) { unsigned keep;
    asm volatile("s_mov_b32 %0, m0\n\ts_mov_b32 m0, %3\n\ts_nop 0\n\tglobal_load_lds_dwordx4 %1, %2\n\ts_mov_b32 m0, %0" : "=&s"(keep) : "v"(voff), "s"(sbase), "s"(lds_dst) : "memory"); }
__device__ __forceinline__ void sp_glds16s_x4(const void* sbase, unsigned v0, unsigned v1, unsigned v2, unsigned v3, unsigned lds_dst) { unsigned keep;
    asm volatile("s_mov_b32 %0, m0\n\ts_mov_b32 m0, %6\n\ts_nop 0\n\tglobal_load_lds_dwordx4 %1, %5\n\ts_add_u32 m0, m0, 0x400\n\ts_nop 0\n\tglobal_load_lds_dwordx4 %2, %5\n\ts_add_u32 m0, m0, 0x400\n\ts_nop 0\n\tglobal_load_lds_dwordx4 %3, %5\n\ts_add_u32 m0, m0, 0x400\n\ts_nop 0\n\tglobal_load_lds_dwordx4 %4, %5\n\ts_mov_b32 m0, %0"
                 : "=&s"(keep) : "v"(v0), "v"(v1), "v"(v2), "v"(v3), "s"(sbase), "s"(lds_dst) : "memory", "scc"); }
__device__ __forceinline__ void sp_prologue(Frame& F, const BAParams& P, int rb, int qi0, bool dry) {
    const int lane = F.lane, drow = lane >> 3, dpc = lane & 7; constexpr int KOFF = M * 128;
    const LAS unsigned short* sel = (const LAS unsigned short*)(F.selp) + qi0 * 256;
    const unsigned wk = (unsigned)__builtin_amdgcn_readfirstlane((int)((unsigned)(uintptr_t)(F.ring) + (unsigned)F.wt * 16384u));
    asm volatile("s_waitcnt lgkmcnt(0)" ::: "memory");
#pragma unroll
    for (int st = 0; st < 4; ++st) { unsigned vo_[4];
#pragma unroll
        for (int i_ = 0; i_ < 4; ++i_) { const int slot_ = 32 * st + 8 * i_ + drow; const int key_ = (SPB_IDEAL && dry) ? slot_ : (int)sel[slot_];
            vo_[i_] = (unsigned)(((rb + key_) * 128 + KOFF + ((dpc ^ (drow & 7)) * 8)) * 2); }
        sp_glds16s_x4(P.KAB, vo_[0], vo_[1], vo_[2], vo_[3], (unsigned)__builtin_amdgcn_readfirstlane((int)(wk + (unsigned)(st * 4096)))); }
}
__device__ __forceinline__ void sw_prologue(Frame& F, const BAParams& P, int rb, int t0, int combo) {
    const int lane = F.lane, drow = lane >> 3, dpc = lane & 7, j = combo >> 2, kbase = t0 - 128;
    const unsigned wk = (unsigned)__builtin_amdgcn_readfirstlane((int)((unsigned)(uintptr_t)(F.ring) + (unsigned)F.wt * 16384u)), wl = wk + 8192u;
    asm volatile("s_waitcnt lgkmcnt(0)" ::: "memory");
#pragma unroll
    for (int st = 0; st < 2; ++st) { unsigned vo_[4];
#pragma unroll
        for (int i_ = 0; i_ < 4; ++i_) { int key_ = kbase + 32 * st + 8 * i_ + drow; key_ = key_ < 0 ? 0 : (key_ > SEQ - 1 ? SEQ - 1 : key_); vo_[i_] = (unsigned)(((rb + key_) * 128 + j * 64 + dpc * 8) * 2); }
        sp_glds16s_x4(P.VAB, vo_[0], vo_[1], vo_[2], vo_[3], (unsigned)__builtin_amdgcn_readfirstlane((int)(wl + (unsigned)(st * 4096)))); }
#pragma unroll
    for (int st = 0; st < 2; ++st) { unsigned vo_[4];
#pragma unroll
        for (int i_ = 0; i_ < 4; ++i_) { int key_ = kbase + 32 * st + 8 * i_ + drow; key_ = key_ < 0 ? 0 : (key_ > SEQ - 1 ? SEQ - 1 : key_); vo_[i_] = (unsigned)(((rb + key_) * 128 + j * 64 + ((dpc ^ (drow & 7)) * 8)) * 2); }
        sp_glds16s_x4(P.KAB, vo_[0], vo_[1], vo_[2], vo_[3], (unsigned)__builtin_amdgcn_readfirstlane((int)(wk + (unsigned)(st * 4096)))); }
}
template <bool IS_A> __device__ __forceinline__ void sparse_pair(Frame& F, const BAParams& P, int rb, int tA, int qi0, int nv0, int nv1, bool dry, bool pre, int nxt, int nxa, int t0u) {
    constexpr int NC = IS_A ? 8 : 16, NSLOT = NC * 16, KOFF = IS_A ? 0 : M * 128, HB = IS_A ? 0 : 8, GOFF = IS_A ? 0 : 512;
    int lane_ = F.lane; asm volatile("" : "+v"(lane_)); const int lane = lane_, r = lane & 15, g4 = lane >> 4, my_a = g4 >> 1, my_j = g4 & 1;
    const bf16* Q = IS_A ? P.QA : P.QB;
    const LAS unsigned short* sel = (const LAS unsigned short*)(F.selp) + qi0 * 256;
    const LAS float* BIAS = (const LAS float*)(F.lds + BIAS_OFF);
    const LAS unsigned char* BKT = (const LAS unsigned char*)(F.lds + BKT_OFF);
    LAS unsigned short* Pimg = (LAS unsigned short*)(F.ring + F.wt * 16384);
    bf16x8 q0, q1; const bf16x8 zz = {0, 0, 0, 0, 0, 0, 0, 0};
    { const int a_r = r >> 3, hd = r & 7; const bf16* qp = Q + (size_t)(rb + tA + a_r) * 512 + hd * 64 + 8 * g4; q0 = *(const bf16x8*)qp; q1 = *(const bf16x8*)(qp + 32); }
    const int my_t = tA + my_a, rcb = r >> 2;
    f32x4 x[NC];
#pragma unroll
    for (int c = 0; c < NC; ++c) x[c] = (f32x4){0.f, 0.f, 0.f, 0.f};
    constexpr int KS = NSLOT / 32, NST = 4 * KS;
    const unsigned wk = (unsigned)__builtin_amdgcn_readfirstlane((int)((unsigned)(uintptr_t)(F.ring) + (unsigned)F.wt * 16384u));
    const int drow = lane >> 3, dpc = lane & 7;
#define SP_KDMA(st, bufi) do { const int cb_ = (st) / KS, ks_ = (st) % KS, a_ = cb_ >> 1, j_ = cb_ & 1; unsigned vo_[4]; \
        _Pragma("unroll") for (int i_ = 0; i_ < 4; ++i_) { const int slot_ = 32 * ks_ + 8 * i_ + drow; int key_; \
            if (IS_A) { key_ = tA + a_ - slot_; key_ = key_ < 0 ? 0 : key_; } else { key_ = (SPB_IDEAL && dry) ? slot_ : (int)sel[a_ * 256 + slot_]; }   \
            vo_[i_] = (unsigned)(((rb + key_) * 128 + KOFF + j_ * 64 + ((dpc ^ (drow & 7)) * 8)) * 2); } \
        sp_glds16s_x4(P.KAB, vo_[0], vo_[1], vo_[2], vo_[3], (unsigned)__builtin_amdgcn_readfirstlane((int)(wk + (unsigned)((bufi) * 4096)))); } while (0)
    const unsigned wl = wk + 4096u;
#define SP_VDMA(st, bufi) do { const int cb_ = (st) / KS, ks_ = (st) % KS, a_ = cb_ >> 1, j_ = cb_ & 1; unsigned vo_[4]; \
        _Pragma("unroll") for (int i_ = 0; i_ < 4; ++i_) { const int slot_ = 32 * ks_ + 8 * i_ + drow; int key_; \
            if (IS_A) { key_ = tA + a_ - slot_; key_ = key_ < 0 ? 0 : key_; } else { key_ = (SPB_IDEAL && dry) ? slot_ : (int)sel[a_ * 256 + slot_]; } \
            vo_[i_] = (unsigned)(((rb + key_) * 128 + KOFF + j_ * 64 + dpc * 8) * 2); } \
        sp_glds16s_x4(P.VAB, vo_[0], vo_[1], vo_[2], vo_[3], (unsigned)__builtin_amdgcn_readfirstlane((int)(wl + (unsigned)((bufi) * 4096)))); } while (0)
    asm volatile("s_waitcnt lgkmcnt(0)" ::: "memory");
    if (!pre) { SP_KDMA(0, 0); SP_KDMA(1, 1); SP_KDMA(2, 2); if (NST > 3) SP_KDMA(3, 3); }
    { const LAS unsigned char* kring = F.ring + F.wt * 16384;
      static_assert(KS % 4 == 0, "the ring position of a step is its k-step index mod 4");
#pragma unroll 1
      for (int cb = 0; cb < 4; ++cb) { const bool mine = rcb == cb; const bf16x8 a0 = mine ? q0 : zz, a1 = mine ? q1 : zz;
#pragma unroll
        for (int ks = 0; ks < KS; ++ks) { const int st = cb * KS + ks;
          if (cb < 3 || ks + 3 < KS) asm volatile("s_waitcnt vmcnt(12)" ::: "memory"); else asm volatile("s_waitcnt vmcnt(8)" ::: "memory");
          const LAS unsigned char* kb = kring + (ks & 3) * 4096;
          bf16x8 f[2][2];
#pragma unroll
          for (int cc = 0; cc < 2; ++cc)
#pragma unroll
              for (int k2 = 0; k2 < 2; ++k2) f[cc][k2] = *(const LAS bf16x8*)(kb + (16 * cc + r) * 128 + (((4 * k2 + g4) ^ (r & 7)) * 16));
          int kn_[4] = {0, 0, 0, 0}; const int cbn_ = (st + 4) / KS, an_ = cbn_ >> 1, jn_ = cbn_ & 1;
          if (st + 4 < NST) {
#pragma unroll
              for (int i_ = 0; i_ < 4; ++i_) { const int slot_ = 32 * ((ks + 4) % KS) + 8 * i_ + drow; if (IS_A) { int k_ = tA + an_ - slot_; kn_[i_] = k_ < 0 ? 0 : k_; } else kn_[i_] = (SPB_IDEAL && dry) ? slot_ : (int)sel[an_ * 256 + slot_]; } }
          asm volatile("s_waitcnt lgkmcnt(0)" ::: "memory");
          if (st + 4 < NST) { unsigned vo_[4];
#pragma unroll
              for (int i_ = 0; i_ < 4; ++i_) vo_[i_] = (unsigned)(((rb + kn_[i_]) * 128 + KOFF + jn_ * 64 + ((dpc ^ (drow & 7)) * 8)) * 2);
              sp_glds16s_x4(P.KAB, vo_[0], vo_[1], vo_[2], vo_[3], (unsigned)__builtin_amdgcn_readfirstlane((int)(wk + (unsigned)((ks & 3) * 4096)))); }
#pragma unroll
          for (int cc = 0; cc < 2; ++cc) { x[2 * ks + cc] = __builtin_amdgcn_mfma_f32_16x16x32_bf16(a0, f[cc][0], x[2 * ks + cc], 0, 0, 0); x[2 * ks + cc] = __builtin_amdgcn_mfma_f32_16x16x32_bf16(a1, f[cc][1], x[2 * ks + cc], 0, 0, 0); }
          if (ks + 3 >= KS && cb == 3) { if (ks + 3 == KS) SP_VDMA(0, 0); else if (ks + 2 == KS) SP_VDMA(1, 1); else SP_VDMA(2, 2); }
        } } }
#undef SP_KDMA
#pragma unroll
    for (int c = 0; c < NC; ++c) { const int slot = 16 * c + r; int mk; bool mv;
        if (IS_A) { mk = my_t - slot; mv = mk >= 0; } else { mk = sel[my_a * 256 + slot]; mv = slot < (my_a ? nv1 : nv0); }
        const int delta = my_t - mk; const bool ok = mv && delta >= 0;
        const int bk = (ok && delta < 512) ? (int)BKT[delta] : 31;
        const f32x4 b4 = *(const LAS f32x4*)(BIAS + bk * 16 + HB + 4 * my_j);
#pragma unroll
        for (int i = 0; i < 4; ++i) x[c][i] = ok ? x[c][i] * 0.125f + b4[i] : -INFINITY; }
    f32x4 mx = x[0];
#pragma unroll
    for (int c = 1; c < NC; ++c)
#pragma unroll
        for (int i = 0; i < 4; ++i) mx[i] = fmaxf(mx[i], x[c][i]);
#pragma unroll
    for (int o = 1; o < 16; o <<= 1)
#pragma unroll
        for (int i = 0; i < 4; ++i) mx[i] = fmaxf(mx[i], __shfl_xor(mx[i], o));
    f32x4 sk = {0.f, 0.f, 0.f, 0.f};
    if (IS_A) { sk = *(const f32x4*)(P.sinks + 4 * my_j);
#pragma unroll
        for (int i = 0; i < 4; ++i) mx[i] = fmaxf(mx[i], sk[i]); }
    f32x4 sum = {0.f, 0.f, 0.f, 0.f};
#pragma unroll
    for (int c = 0; c < NC; ++c)
#pragma unroll
        for (int i = 0; i < 4; ++i) { x[c][i] = __expf(x[c][i] - mx[i]); sum[i] += x[c][i]; }
#pragma unroll
    for (int o = 1; o < 16; o <<= 1)
#pragma unroll
        for (int i = 0; i < 4; ++i) sum[i] += __shfl_xor(sum[i], o);
    if (IS_A) {
#pragma unroll
        for (int i = 0; i < 4; ++i) sum[i] += __expf(sk[i] - mx[i]); }
    f32x4 inv;
#pragma unroll
    for (int i = 0; i < 4; ++i) inv[i] = 1.0f / sum[i];
#define SP_PWRITE(qa) do { if (my_a == (qa)) { _Pragma("unroll") for (int c_ = 0; c_ < NC; ++c_) _Pragma("unroll") for (int i_ = 0; i_ < 4; i_ += 2) { \
        const unsigned pk_ = cvt_pk_bf16x2(x[c_][i_] * inv[i_], x[c_][i_ + 1] * inv[i_ + 1]);     \
        Pimg[(4 * my_j + i_) * NSLOT + 16 * c_ + r] = (unsigned short)pk_; Pimg[(4 * my_j + i_ + 1) * NSLOT + 16 * c_ + r] = (unsigned short)(pk_ >> 16); } } } while (0)
    SP_PWRITE(0);
    f32x4 o[4];
#pragma unroll
    for (int db = 0; db < 4; ++db) o[db] = (f32x4){0.f, 0.f, 0.f, 0.f};
    const unsigned trb = (unsigned)((8 * g4 + ((lane & 15) >> 2)) * 128 + (lane & 3) * 8);
    int bufi = 0;
#pragma unroll 1
    for (int cb = 0; cb < 4; ++cb) { const bool minep = rcb == cb;
        if (cb == 2) { SP_PWRITE(1); }
#pragma unroll
        for (int ks = 0; ks < KS; ++ks) { const int st = cb * KS + ks;
            if (cb < 3 || ks + 2 < KS) asm volatile("s_waitcnt vmcnt(8)" ::: "memory"); else if (ks + 1 < KS) asm volatile("s_waitcnt vmcnt(4)" ::: "memory"); else asm volatile("s_waitcnt vmcnt(0)" ::: "memory");
            const unsigned vb = wl + (unsigned)(bufi * 4096) + trb;
            s16x4 lo[4], hi[4];
#pragma unroll
            for (int db = 0; db < 4; ++db) {
                asm volatile("ds_read_b64_tr_b16 %0, %1 offset:%c2" : "=&v"(lo[db]) : "v"(vb), "i"(db * 32) : "memory");
                asm volatile("ds_read_b64_tr_b16 %0, %1 offset:%c2" : "=&v"(hi[db]) : "v"(vb), "i"(db * 32 + 512) : "memory"); }
            bf16x8 pb = *(const LAS bf16x8*)(Pimg + (r & 7) * NSLOT + 32 * ks + 8 * g4);
            pb = minep ? pb : zz;
            int kn_[4] = {0, 0, 0, 0}; const int cbn_ = (st + 3) / KS, an_ = cbn_ >> 1, jn_ = cbn_ & 1;
            if (st + 3 < NST) {
#pragma unroll
                for (int i_ = 0; i_ < 4; ++i_) { const int slot_ = 32 * ((ks + 3) % KS) + 8 * i_ + drow; if (IS_A) { int k_ = tA + an_ - slot_; kn_[i_] = k_ < 0 ? 0 : k_; } else kn_[i_] = (SPB_IDEAL && dry) ? slot_ : (int)sel[an_ * 256 + slot_]; } }
            asm volatile("s_waitcnt lgkmcnt(0)" ::: "memory");
            if (st + 3 < NST) { unsigned vo_[4];
#pragma unroll
                for (int i_ = 0; i_ < 4; ++i_) vo_[i_] = (unsigned)(((rb + kn_[i_]) * 128 + KOFF + jn_ * 64 + dpc * 8) * 2);
                sp_glds16s_x4(P.VAB, vo_[0], vo_[1], vo_[2], vo_[3], (unsigned)__builtin_amdgcn_readfirstlane((int)(wl + (unsigned)(bufi * 4096)))); }
#pragma unroll
            for (int db = 0; db < 4; ++db) { const bf16x8 va = {lo[db][0], lo[db][1], lo[db][2], lo[db][3], hi[db][0], hi[db][1], hi[db][2], hi[db][3]};
                o[db] = __builtin_amdgcn_mfma_f32_16x16x32_bf16(va, pb, o[db], 0, 0, 0); }
            bufi = bufi == 2 ? 0 : bufi + 1;
        } }
#undef SP_VDMA
    if (nxt == 1) sp_prologue(F, P, rb, nxa, dry); else if (nxt == 2) sw_prologue(F, P, rb, t0u, nxa);
#undef SP_PWRITE
    if (!dry) { bf16* gp = P.G + (size_t)(rb + tA + (r >> 3)) * 1536 + GOFF + (r & 7) * 64 + 4 * g4;
#pragma unroll
        for (int db = 0; db < 4; ++db) { const u32x2 gt = *(const u32x2*)(gp + 16 * db);
            const float g0 = __uint_as_float(gt.x << 16), g1 = __uint_as_float(gt.x & 0xffff0000u), g2 = __uint_as_float(gt.y << 16), g3 = __uint_as_float(gt.y & 0xffff0000u);
            u32x2 w; w.x = pk2(o[db][0] * g0, o[db][1] * g1); w.y = pk2(o[db][2] * g2, o[db][3] * g3);
            *(u32x2*)(gp + 16 * db) = w; } }
}
__device__ __forceinline__ void swa_dense(Frame& F, const BAParams& P, int rb, int t0, int combo, bool dry, bool pre, int nxa) {
    constexpr int NC = 10, NSLOT = 160, NST = 5;
    int lane_ = F.lane; asm volatile("" : "+v"(lane_)); const int lane = lane_, r = lane & 15, g4 = lane >> 4, j = combo >> 2, qg = combo & 3, kbase = t0 - 128;
    const LAS float* BIAS = (const LAS float*)(F.lds + BIAS_OFF);
    const LAS unsigned char* BKT = (const LAS unsigned char*)(F.lds + BKT_OFF);
    LAS unsigned short* Pimg = (LAS unsigned short*)(F.ring + F.wt * 16384);
    const unsigned wl = (unsigned)__builtin_amdgcn_readfirstlane((int)((unsigned)(uintptr_t)(F.ring) + (unsigned)F.wt * 16384u + 8192u));
    const int drow = lane >> 3, dpc = lane & 7;
#define SW_VDMA(st) do { unsigned vo_[4]; \
        _Pragma("unroll") for (int i_ = 0; i_ < 4; ++i_) { int key_ = kbase + 32 * (st) + 8 * i_ + drow; key_ = key_ < 0 ? 0 : (key_ > SEQ - 1 ? SEQ - 1 : key_); vo_[i_] = (unsigned)(((rb + key_) * 128 + j * 64 + dpc * 8) * 2); } \
        sp_glds16s_x4(P.VAB, vo_[0], vo_[1], vo_[2], vo_[3], (unsigned)__builtin_amdgcn_readfirstlane((int)(wl + (unsigned)(((st) & 1) * 4096)))); } while (0)
    asm volatile("s_waitcnt lgkmcnt(0)" ::: "memory");
    if (!pre) { SW_VDMA(0); SW_VDMA(1); }
    const unsigned wk = (unsigned)__builtin_amdgcn_readfirstlane((int)((unsigned)(uintptr_t)(F.ring) + (unsigned)F.wt * 16384u));
#define SW_KDMA(st) do { unsigned vo_[4]; \
        _Pragma("unroll") for (int i_ = 0; i_ < 4; ++i_) { int key_ = kbase + 32 * (st) + 8 * i_ + drow; key_ = key_ < 0 ? 0 : (key_ > SEQ - 1 ? SEQ - 1 : key_); vo_[i_] = (unsigned)(((rb + key_) * 128 + j * 64 + ((dpc ^ (drow & 7)) * 8)) * 2); } \
        sp_glds16s_x4(P.KAB, vo_[0], vo_[1], vo_[2], vo_[3], (unsigned)__builtin_amdgcn_readfirstlane((int)(wk + (unsigned)(((st) & 1) * 4096)))); } while (0)
    if (!pre) { SW_KDMA(0); SW_KDMA(1); }
    bf16x8 qf[2]; { const bf16* qp = P.QA + (size_t)(rb + t0 + 4 * qg + (r >> 2)) * 512 + (4 * j + (r & 3)) * 64 + 8 * g4; qf[0] = *(const bf16x8*)qp; qf[1] = *(const bf16x8*)(qp + 32); }
    const int my_t = t0 + 4 * qg + g4;
    f32x4 x[NC];
    { const LAS unsigned char* kring = F.ring + F.wt * 16384;
#pragma unroll
      for (int st = 0; st < NST; ++st) {
        if (st + 1 < NST) asm volatile("s_waitcnt vmcnt(4)" ::: "memory"); else asm volatile("s_waitcnt vmcnt(0)" ::: "memory");
        const LAS unsigned char* kb = kring + (st & 1) * 4096; bf16x8 f[2][2];
#pragma unroll
        for (int cc = 0; cc < 2; ++cc)
#pragma unroll
            for (int k2 = 0; k2 < 2; ++k2) f[cc][k2] = *(const LAS bf16x8*)(kb + (16 * cc + r) * 128 + (((4 * k2 + g4) ^ (r & 7)) * 16));
        asm volatile("s_waitcnt lgkmcnt(0)" ::: "memory");
        if (st + 2 < NST) SW_KDMA(st + 2);
#pragma unroll
        for (int cc = 0; cc < 2; ++cc) { const int c = 2 * st + cc; f32x4 d = {0.f, 0.f, 0.f, 0.f};
            d = __builtin_amdgcn_mfma_f32_16x16x32_bf16(qf[0], f[cc][0], d, 0, 0, 0); d = __builtin_amdgcn_mfma_f32_16x16x32_bf16(qf[1], f[cc][1], d, 0, 0, 0);
            const int key = kbase + 16 * c + r, delta = my_t - key; const bool ok = key >= 0 && delta >= 0 && delta < 128;
            const int bk = (int)BKT[ok ? delta : 0];
            const f32x4 b4 = *(const LAS f32x4*)(BIAS + bk * 16 + 4 * j);
#pragma unroll
            for (int i = 0; i < 4; ++i) x[c][i] = ok ? d[i] * 0.125f + b4[i] : -INFINITY; } } }
#undef SW_KDMA
    f32x4 mx = *(const f32x4*)(P.sinks + 4 * j); const f32x4 sk = mx;
#pragma unroll
    for (int c = 0; c < NC; ++c)
#pragma unroll
        for (int i = 0; i < 4; ++i) mx[i] = fmaxf(mx[i], x[c][i]);
#pragma unroll
    for (int o = 1; o < 16; o <<= 1)
#pragma unroll
        for (int i = 0; i < 4; ++i) mx[i] = fmaxf(mx[i], __shfl_xor(mx[i], o));
    f32x4 sum = {0.f, 0.f, 0.f, 0.f};
#pragma unroll
    for (int c = 0; c < NC; ++c)
#pragma unroll
        for (int i = 0; i < 4; ++i) { x[c][i] = __expf(x[c][i] - mx[i]); sum[i] += x[c][i]; }
#pragma unroll
    for (int o = 1; o < 16; o <<= 1)
#pragma unroll
        for (int i = 0; i < 4; ++i) sum[i] += __shfl_xor(sum[i], o);
    f32x4 inv;
#pragma unroll
    for (int i = 0; i < 4; ++i) inv[i] = 1.0f / (sum[i] + __expf(sk[i] - mx[i]));
#pragma unroll
    for (int c = 0; c < NC; ++c)
#pragma unroll
        for (int i = 0; i < 4; i += 2) { const unsigned pk = cvt_pk_bf16x2(x[c][i] * inv[i], x[c][i + 1] * inv[i + 1]);
            Pimg[(4 * g4 + i) * NSLOT + 16 * c + r] = (unsigned short)pk; Pimg[(4 * g4 + i + 1) * NSLOT + 16 * c + r] = (unsigned short)(pk >> 16); }
    f32x4 o[4];
#pragma unroll
    for (int db = 0; db < 4; ++db) o[db] = (f32x4){0.f, 0.f, 0.f, 0.f};
    const unsigned trb = (unsigned)((8 * g4 + ((lane & 15) >> 2)) * 128 + (lane & 3) * 8);
#pragma unroll
    for (int st = 0; st < NST; ++st) {
        if (st + 1 < NST) asm volatile("s_waitcnt vmcnt(4)" ::: "memory"); else asm volatile("s_waitcnt vmcnt(0)" ::: "memory");
        const unsigned vb = wl + (unsigned)((st & 1) * 4096) + trb;
        s16x4 lo[4], hi[4];
#pragma unroll
        for (int db = 0; db < 4; ++db) {
            asm volatile("ds_read_b64_tr_b16 %0, %1 offset:%c2" : "=&v"(lo[db]) : "v"(vb), "i"(db * 32) : "memory");
            asm volatile("ds_read_b64_tr_b16 %0, %1 offset:%c2" : "=&v"(hi[db]) : "v"(vb), "i"(db * 32 + 512) : "memory"); }
        const bf16x8 pb = *(const LAS bf16x8*)(Pimg + r * NSLOT + 32 * st + 8 * g4);
        asm volatile("s_waitcnt lgkmcnt(0)" ::: "memory");
#pragma unroll
        for (int db = 0; db < 4; ++db) { const bf16x8 va = {lo[db][0], lo[db][1], lo[db][2], lo[db][3], hi[db][0], hi[db][1], hi[db][2], hi[db][3]};
            o[db] = __builtin_amdgcn_mfma_f32_16x16x32_bf16(va, pb, o[db], 0, 0, 0); }
        if (st + 2 < NST) SW_VDMA(st + 2);
    }
#undef SW_VDMA
    if (nxa >= 0) sw_prologue(F, P, rb, t0, nxa);
    if (!dry) { bf16* gp = P.G + (size_t)(rb + t0 + 4 * qg + (r >> 2)) * 1536 + (4 * j + (r & 3)) * 64 + 4 * g4;
#pragma unroll
        for (int db = 0; db < 4; ++db) { const u32x2 gt = *(const u32x2*)(gp + 16 * db);
            const float g0 = __uint_as_float(gt.x << 16), g1 = __uint_as_float(gt.x & 0xffff0000u), g2 = __uint_as_float(gt.y << 16), g3 = __uint_as_float(gt.y & 0xffff0000u);
            u32x2 w; w.x = pk2(o[db][0] * g0, o[db][1] * g1); w.y = pk2(o[db][2] * g2, o[db][3] * g3);
            *(u32x2*)(gp + 16 * db) = w; } }
}
__device__ __forceinline__ void ba_clear(Frame& F) {
    LAS v4u* hz = (LAS v4u*)(F.ring + F.wt * 16384);
#pragma unroll
    for (int i = 0; i < 16; ++i) hz[F.lane + 64 * i] = (v4u){0u, 0u, 0u, 0u};
    *(LAS v4u*)(F.h2p + F.wt * 1024 + F.lane * 16) = (v4u){0u, 0u, 0u, 0u};
}
__device__ __forceinline__ void ba_unit(Frame& F, const BAParams& P, int b, int tau, bool dry) {
    { int l_ = (int)__builtin_amdgcn_mbcnt_hi(~0u, __builtin_amdgcn_mbcnt_lo(~0u, 0u)); asm volatile("" : "+v"(l_)); F.lane = l_; F.tid = F.wt * 64 + l_; }
    const int t0 = tau * 16, rb = b * SEQ, lane = F.lane;
    LAS unsigned* misc = (LAS unsigned*)(F.miscp);
    for (int ri = 0; ri < REP_IDX; ++ri)
    if (tau >= 16) {
        if (ri) { team_barrier(F); ba_clear(F); team_barrier(F); }
        bf16x8 bq[4]; const int r = lane & 15, g4 = lane >> 4;
#pragma unroll
        for (int h = 0; h < 4; ++h) bq[h] = *(const bf16x8*)(P.IQ + (size_t)(rb + t0 + r) * 128 + h * 32 + 8 * g4);
        const f32x4 w4 = *(const f32x4*)(P.IW + (size_t)(rb + t0 + r) * 4);
        const bf16* IKb = P.IK + (size_t)rb * 32;
        idx_pass<1>(F, IKb, bq, w4, tau, t0);
        team_barrier(F);
#pragma unroll 1
        for (int k_ = 0; k_ < REP_TH; ++k_) { idx_threshold(F); team_barrier(F); }
#pragma unroll 1
        for (int k2_ = 0; k2_ < REP_P2RS; ++k2_) {
#pragma unroll 1
        for (int k_ = 0; k_ < REP_P2; ++k_) { idx_pass<2>(F, IKb, bq, w4, tau, t0); team_barrier(F); }
#pragma unroll 1
        for (int k_ = 0; k_ < REP_RS; ++k_) idx_resolve(F, IKb, bq, w4, tau);
        if (k2_ + 1 < REP_P2RS) team_barrier(F); }
    } else {
        LAS unsigned short* sel = (LAS unsigned short*)(F.selp) + NW * F.wt * 256;
        for (int i = lane; i < NW * 256; i += 64) sel[i] = (unsigned short)(i & 255);
    }
    asm volatile("s_waitcnt lgkmcnt(0)" ::: "memory");
    static_assert(REP_SPB == 1 && REP_SPA == 1, "the bodies hand their first DMA pieces on to each other: no repeats");
#pragma unroll 1
    for (int pp = 0; pp < 2; ++pp) { const int pr = 2 * F.wt + pp;
        const int tA = t0 + 2 * pr, nv0 = tA >= 256 ? 256 : tA + 1, nv1 = tA + 1 >= 256 ? 256 : tA + 2;
        sparse_pair<false>(F, P, rb, tA, 2 * pr, nv0, nv1, dry, pp > 0, pp == 0 ? 1 : 2, pp == 0 ? 2 * pr + 2 : F.wt, t0); }
#pragma unroll 1
    for (int pp = 0; pp < 2; ++pp) swa_dense(F, P, rb, t0, F.wt + 4 * pp, dry, true, pp == 0 ? F.wt + 4 : -1);
    ba_clear(F);
}

#ifndef REP_P1A
#define REP_P1A 1
#endif
#ifndef REP_C
#define REP_C 1
#endif
#ifndef REP_BA
#define REP_BA 1
#endif
#ifndef REP_P1B
#define REP_P1B 1
#endif
#ifndef REP_P3
#define REP_P3 1
#endif
#ifndef REP_P0
#define REP_P0 1
#endif
#ifndef FOX_SKIP_LOG2
#define FOX_SKIP_LOG2 (-40.0f)
#endif
#ifndef MK_ONE_LAUNCH
#define MK_ONE_LAUNCH 1
#endif
constexpr int NPHASES = 1 + 6 * DEPTH;
struct Args { const float* in[9]; float* out; unsigned char* ws; int ph_lo, ph_hi; };
static_assert(sizeof(Args) == 9 * 8 + 8 + 8 + 4 + 4, "no padding bytes in the argument struct");

typedef const __attribute__((address_space(4))) Args* ArgP;
__device__ __forceinline__ ArgP argp() { ArgP p = (ArgP)__builtin_amdgcn_kernarg_segment_ptr(); asm volatile("" : "+s"(p)); return p; }
__global__ void __launch_bounds__(512, 2) mk_fwd(Args args) {
    extern __shared__ __attribute__((aligned(16))) unsigned char lds[];
    Frame F;
    F.lds = (LAS unsigned char*)lds;
    if ((unsigned)(uintptr_t)F.lds != 0u) return;
    F.MISC = (volatile LAS unsigned*)(F.lds + MISC_OFF);
    F.tid = threadIdx.x; F.lane = F.tid & 63; F.wave = __builtin_amdgcn_readfirstlane(F.tid >> 6);
    F.G = gridDim.x; { const int bx = blockIdx.x; F.vcu = (F.G % 8 == 0) ? (bx % 8) * (F.G / 8) + bx / 8 : bx; }
    F.ctl = (gu32*)(argp()->ws + WS_CTL);
    for (int u = F.tid; u < 256; u += 512) ((LAS unsigned*)(F.lds + MISC_OFF))[u] = 0u;
    for (int u = F.tid; u < 512; u += 512) { ((LAS float*)(F.lds + BIAS_OFF))[u] = argp()->in[8][u];
        int bk; if (u < 16) bk = u; else { const float nf = (float)u; int lg = 16 + (int)(logf(nf / 16.0f) / 3.4657359027997265f * 16.0f); bk = lg < 31 ? lg : 31; }
        ((LAS unsigned char*)(F.lds + BKT_OFF))[u] = (unsigned char)bk; }
    __syncthreads();
    XcdBarrier bar; bar.bar = (unsigned*)(F.ctl + CW_BAR); bar.x = 0; bar.st = nullptr;
    if (MK_ONE_LAUNCH) bar = xcd_barrier_post((unsigned*)(F.ctl + CW_BAR), F.MISC + MW_BAR);
    const int lo = argp()->ph_lo, hi = argp()->ph_hi;
#define IN(k) (lo <= (k) && (k) < hi)
#define SEAM(k) do { if (IN(k) && IN((k) + 1)) xcd_barrier(bar); } while (0)
#define PHASE_BEGIN() do { int l_ = (int)__builtin_amdgcn_mbcnt_hi(~0u, __builtin_amdgcn_mbcnt_lo(~0u, 0u)); asm volatile("" : "+v"(l_)); F.lane = l_; F.tid = F.wave * 64 + l_; } while (0)

    if (IN(0)) { PHASE_BEGIN(); ArgP a = argp(); for (int rp = 0; rp < REP_P0; ++rp) p0_prologue(F, a->in[0], a->in[1], a->in[2], a->in[6], a->in[7], a->ws); SEAM(0); }

    for (int L = 0; L < DEPTH; ++L) {
        const int pb = 1 + 6 * L;
        if (IN(pb)) { PHASE_BEGIN();
            unsigned char* ws = argp()->ws; const pg8::bf16_t* W1T = (const pg8::bf16_t*)(ws + WS_W1T) + (size_t)L * NTILES * 256 * 1024;
            pg8::Gemm g{(const pg8::bf16_t*)(ws + WS_XB), W1T, M, NT_A * 256, 1024, 1024, 1024, 0}; pg8::StaticOrder S; S.init(M, NT_A * 256, F.G, (int)blockIdx.x);
            pg8::EpiIn E{ws, argp()->in[4] + L * 384, argp()->in[3] + L * 8};
            for (int rp = 0; rp < REP_P1A; ++rp) pg8::gemm_phase<pg8::EpiIn, pg8::StaticOrder, true, true>(F.lds + RING_OFF, g, S, E, F.wave);
            SEAM(pb);
        }
        if (IN(pb + 2)) { PHASE_BEGIN();
            unsigned char* ws = argp()->ws;
            const float* CL = (const float*)(ws + WS_CL); const float* CT = (const float*)(ws + WS_CT);
            LAS float* carry = (LAS float*)(F.lds + H2_OFF)  ; LAS unsigned* nbw = (LAS unsigned*)(F.lds + RING_OFF + NB_OFF);
            for (int rp = 0; rp < REP_C; ++rp) {
            LAS unsigned* miscw = (LAS unsigned*)(F.lds + MISC_OFF);
            for (int kg = 0; kg < 8; ++kg) { const int xg = ((F.vcu >> 5) + kg) & 7;
            gu32* const tick = F.ctl + CW_TICK + 64 * (8 * (2 * L + rp % 2) + xg);
            if (F.tid == 0) miscw[MW_TICKET] = __hip_atomic_fetch_add(tick, 1u, RLX_AGENT);
            __syncthreads();
            for (;;) {
                PHASE_BEGIN();
                const int ui = (int)miscw[MW_TICKET];
                if (ui >= 128) { __syncthreads(); break; }
                const int qb = 31 - (ui >> 2), bh = 4 * xg + (ui & 3);
                    if (F.wave == 0) { const float t0 = CT[bh * 128 + 2 * F.lane], t1 = CT[bh * 128 + 2 * F.lane + 1]; const float inc = wave_incl_scan(t0 + t1, F.lane); carry[2 * F.lane] = inc - (t0 + t1); carry[2 * F.lane + 1] = inc - t1; }
                    __syncthreads();
                    const float cref = carry[4 * qb]; int tskip;
                    { const float* gq = argp()->in[4] + L * 384 + 256; const float g1 = fabsf(gq[F.lane]), g2 = fabsf(gq[64 + F.lane]); float mq = g1, mk = g2;
#pragma unroll
                      for (int o = 1; o < 64; o <<= 1) { mq = fmaxf(mq, __shfl_xor(mq, o)); mk = fmaxf(mk, __shfl_xor(mk, o)); }
                      const float thr = FOX_SKIP_LOG2 - 2.0f * (11.8f * mq * mk + 0.5f);
                      const int NTt = 4 * (qb + 1); const int t_a = F.lane, t_b = 64 + F.lane, k_a = 64 * t_a + 63, k_b = 64 * t_b + 63;
                      const float n_a = t_a < NTt ? (cref - (carry[k_a >> 6] + CL[(size_t)bh * SEQ + k_a])) * 1.4426950408889634f : 0.f, n_b = t_b < NTt ? (cref - (carry[k_b >> 6] + CL[(size_t)bh * SEQ + k_b])) * 1.4426950408889634f : 0.f;
                      const bool s_a = t_a < NTt && n_a < thr, s_b = t_b < NTt && n_b < thr;
                      const unsigned long long f_a = __ballot(!s_a), f_b = __ballot(!s_b);
                      int cnt = f_a ? (int)__builtin_ctzll(f_a) : 64 + (f_b ? (int)__builtin_ctzll(f_b) : 64);
                      cnt &= ~1; tskip = cnt > NTt - 4 ? NTt - 4 : cnt; }
                    { const int nk = 256 * (qb + 1);
                      for (int k = 64 * tskip + F.tid; k < nk; k += 512) { const float xb = (cref - (carry[k >> 6] + CL[(size_t)bh * SEQ + k])) * 1.4426950408889634f;
                          const unsigned h = f2bf(xb), l = f2bf(xb - __uint_as_float(h << 16)); nbw[k] = h | (l << 16); } }
                    __syncthreads();
                    attn_body::attn_unit<8>(bh >> 3, bh & 7, qb, (const attn_body::bf16*)(ws + WS_QC), (const attn_body::bf16*)(ws + WS_KC), (const attn_body::bf16*)(ws + WS_VC), (attn_body::bf16*)(ws + WS_G),
                                            (char*)lds + RING_OFF, (attn_body::lds_cuptr)(F.lds + RING_OFF + NB_OFF), tskip, rp + 1 < REP_C, F.wave);
                if (F.tid == 0) miscw[MW_TICKET] = __hip_atomic_fetch_add(tick, 1u, RLX_AGENT);
                __syncthreads();
            } } }
            __syncthreads(); PHASE_BEGIN();
            const BAParams P{(const bf16*)(ws + WS_IQ), (const bf16*)(ws + WS_IK), (const float*)(ws + WS_IW), (const bf16*)(ws + WS_QA), (const bf16*)(ws + WS_QB), (const bf16*)(ws + WS_KAB), (const bf16*)(ws + WS_VAB),
                             (bf16*)(ws + WS_G), argp()->in[5] + L * 8};
            { const int team = F.wave >> 2; F.wt = F.wave & 3; F.tgen = 0u;
              F.ring = F.lds + team * 65536; F.selp = F.lds + SEL_OFF + team * 8192; F.h2p = F.lds + H2_OFF + team * 4096; F.miscp = F.lds + TMISC_OFF + team * 1024; }
            for (int u = F.lane; u < 256; u += 64) if (F.wt == 0) ((LAS unsigned*)F.miscp)[u] = 0u;
            ba_clear(F);
            __syncthreads();
            for (int rp = 0; rp < REP_BA; ++rp) {
            LAS unsigned* miscw = (LAS unsigned*)F.miscp;
            for (int kg = 0; kg < 4; ++kg) { const int bq = ((F.vcu >> 6) + kg) & 3;
            gu32* const tick = F.ctl + CW_TICK + 64 * (32 + 4 * (2 * L + rp % 2) + bq);
            if (F.wt == 0 && F.lane == 0) miscw[MW_TICKET] = __hip_atomic_fetch_add(tick, 1u, RLX_AGENT);
            team_barrier(F);
            for (;;) {
                { int l_ = (int)__builtin_amdgcn_mbcnt_hi(~0u, __builtin_amdgcn_mbcnt_lo(~0u, 0u)); asm volatile("" : "+v"(l_)); F.lane = l_; }
                const int ui = (int)miscw[MW_TICKET];
                if (ui >= 512) { team_barrier(F); break; }
                ba_unit(F, P, bq, 511 - ui, rp + 1 < REP_BA);
                if (F.wt == 0 && F.lane == 0) miscw[MW_TICKET] = __hip_atomic_fetch_add(tick, 1u, RLX_AGENT);
                team_barrier(F);
            } } }
            __syncthreads(); PHASE_BEGIN();
            SEAM(pb + 2);
        }
        if (IN(pb + 3)) { PHASE_BEGIN();
            unsigned char* ws = argp()->ws; const pg8::bf16_t* W1T = (const pg8::bf16_t*)(ws + WS_W1T) + (size_t)L * NTILES * 256 * 1024;
            pg8::Gemm g{(const pg8::bf16_t*)(ws + WS_XB), W1T + (size_t)NT_A * 256 * 1024, M, NT_B * 256, 1024, 1024, 1024, 0}; pg8::StaticOrder S; S.init(M, NT_B * 256, F.G, (int)blockIdx.x);
            pg8::EpiGate E{(const float*)(ws + WS_SSQ), (unsigned char*)(ws + WS_MG)};
            for (int rp = 0; rp < REP_P1B; ++rp) pg8::gemm_phase<pg8::EpiGate, pg8::StaticOrder, true, true>(F.lds + RING_OFF, g, S, E, F.wave);
            SEAM(pb + 3);
        }
        if (IN(pb + 4)) { PHASE_BEGIN();
            unsigned char* ws = argp()->ws;
            pg8::Gemm g{(const pg8::bf16_t*)(ws + WS_G), (const pg8::bf16_t*)(ws + WS_WBT) + (size_t)L * 3 * 1024 * 512, M, 1024, 512, 1536, 512, 4};
            pg8::SegOrder S; S.base.init(M, 1024, F.G, (int)blockIdx.x);
            pg8::EpiMerge E{(const unsigned char*)(ws + WS_MG), (pg8::bf16_t*)(ws + WS_MERGED)};
            for (int rp = 0; rp < REP_P3; ++rp) pg8::gemm_phase<pg8::EpiMerge, pg8::SegOrder, true, true>(F.lds + RING_OFF, g, S, E, F.wave);
            SEAM(pb + 4);
        }
        if (IN(pb + 5)) { PHASE_BEGIN();
            unsigned char* ws = argp()->ws; float* const outp = argp()->out;
            pg8::Gemm g{(const pg8::bf16_t*)(ws + WS_MERGED), (const pg8::bf16_t*)(ws + WS_WOT) + (size_t)L * 1024 * 1024, M, 1024, 1024, 1024, 1024, 0}; pg8::StaticOrder S; S.init(M, 1024, F.G, (int)blockIdx.x);
            const bool last = (L == DEPTH - 1);
            unsigned poison = 0u;
            if (last) poison = (__hip_atomic_load(F.ctl + CW_OVF, RLX_AGENT) != 0u) | (__hip_atomic_load(F.ctl + CW_BAR + XB_TMO, RLX_AGENT) != 0u);
            static_assert(DEPTH == 2, "two instantiations: first layer (f32 residual in, bf16 stream out), last layer (bf16 stream in, f32 output)");
            if (!last) { pg8::EpiOutT<false, false> E{argp()->in[0], nullptr, nullptr, (pg8::bf16_t*)(ws + WS_XB), (float*)(ws + WS_SSQ), poison};
                         pg8::gemm_phase<pg8::EpiOutT<false, false>, pg8::StaticOrder, true, true>(F.lds + RING_OFF, g, S, E, F.wave); }
            else       { pg8::EpiOutT<true, true> E{nullptr, (const pg8::bf16_t*)(ws + WS_XB), outp, nullptr, nullptr, poison};
                         pg8::gemm_phase<pg8::EpiOutT<true, true>, pg8::StaticOrder, true, true>(F.lds + RING_OFF, g, S, E, F.wave); }
            if (!last) SEAM(pb + 5);
        }
    }
#undef IN
#undef SEAM
}

extern "C" void kernel_launch(void* const* d_in, const int* in_sizes, int n_in, void* d_out, int out_size, void* d_ws, size_t ws_size, hipStream_t stream) {
    static int grid = 0;
    if (grid == 0) {
        if (n_in != 9 || in_sizes[0] != M * DMODEL || out_size != M * DMODEL || ws_size < WS_END) { fprintf(stderr, "kernel_launch: unexpected shapes / workspace (n_in %d, in0 %d, out %d, ws %zu < %zu); nothing launched\n", n_in, n_in > 0 ? in_sizes[0] : -1, out_size, ws_size, (size_t)WS_END); grid = -1; return; }
        int dev = 0, cus = 0, per_cu = 0;
        if (hipGetDevice(&dev) != hipSuccess || hipDeviceGetAttribute(&cus, hipDeviceAttributeMultiprocessorCount, dev) != hipSuccess) { grid = -1; return; }
        if (hipFuncSetAttribute((const void*)mk_fwd, hipFuncAttributeMaxDynamicSharedMemorySize, LDS_BYTES) != hipSuccess) { fprintf(stderr, "kernel_launch: hipFuncSetAttribute failed\n"); grid = -1; return; }
        if (hipOccupancyMaxActiveBlocksPerMultiprocessor(&per_cu, (const void*)mk_fwd, 512, LDS_BYTES) != hipSuccess || per_cu < 1) fprintf(stderr, "kernel_launch: occupancy query reports %d workgroups per CU\n", per_cu);
        (void)hipGetLastError();
        grid = cus;
    }
    if (grid < 0) return;
    if (hipMemsetAsync((char*)d_ws + WS_CTL, 0, CTL_ZERO_BYTES, stream) != hipSuccess) return;
    Args a{};
    for (int i = 0; i < 9; ++i) a.in[i] = (const float*)d_in[i];
    a.out = (float*)d_out; a.ws = (unsigned char*)d_ws;
#if MK_ONE_LAUNCH
    a.ph_lo = 0; a.ph_hi = NPHASES;
    hipLaunchKernelGGL(mk_fwd, dim3(grid), dim3(512), LDS_BYTES, stream, a);
#else
    for (int p = 0; p < NPHASES; ++p) { a.ph_lo = p; a.ph_hi = p + 1; hipLaunchKernelGGL(mk_fwd, dim3(grid), dim3(512), LDS_BYTES, stream, a); }
#endif
}
```

```cpp
#include <hip/hip_runtime.h>
#include <cstdio>
#include <cstdint>
#include <cmath>
namespace pg8 {
#define PG8_LAS __attribute__((address_space(3)))
typedef unsigned short bf16_t;
typedef short bf16x8 __attribute__((ext_vector_type(8)));
typedef float f32x4 __attribute__((ext_vector_type(4)));
typedef unsigned u32x4 __attribute__((ext_vector_type(4)));
constexpr int BM = 256, BK = 64, HALF = 128, HTB = HALF * BK * 2  , STAGE_BYTES = 8 * HTB, NXCD = 8, WGM = 8;

__host__ __device__ __forceinline__ int lds_byte(int r, int c) { const int st = (r >> 4) * 2 + (c >> 5), rr = r & 15, cc = c & 31, ob = rr * 64 + cc * 2; return st * 1024 + (ob ^ (((ob >> 9) & 1) << 5)); }
__host__ __device__ __forceinline__ void stage_rc(int b, int& R, int& C) { const int st = b / 1024, sb = b % 1024, swz = sb ^ (((sb >> 9) & 1) << 5); R = (st >> 1) * 16 + swz / 64; C = (st & 1) * 32 + (swz % 64) / 2; }
__host__ __device__ __forceinline__ int perm32(int rho) { const int n = rho >> 4, i = rho & 15; return 8 * (i >> 2) + 4 * n + (i & 3); }

struct Unit { int pm, pn, seg; };
struct Gemm { const bf16_t* A; const bf16_t* Bt; int M, N, K, lda, ldb, segN; };

struct StaticOrder {
    int nM, nN, nwg, G, c;
    __host__ __device__ void init(int M, int N, int G_, int c_) { nM = M / BM; nN = N / BM; nwg = nM * nN; G = G_; c = c_; }
    __host__ __device__ bool next(int i, Unit& u) const {
        const long L = (long)i * G + c; if (L >= nwg) return false;
        int wgid = (int)L; { const int q = nwg / NXCD, r = nwg % NXCD, xcd = wgid % NXCD, off = wgid / NXCD; wgid = (xcd < r ? xcd * (q + 1) : r * (q + 1) + (xcd - r) * q) + off; }
        const int nig = WGM * nN, gid = wgid / nig, fm = gid * WGM, gsz = (nM - fm) < WGM ? (nM - fm) : WGM;
        u.pm = fm + ((wgid % nig) % gsz); u.pn = (wgid % nig) / gsz; u.seg = 0; return true;
    }
    __device__ __forceinline__ void a_ready(const Unit&) const {}
    __device__ __forceinline__ void done(const Unit&) const {}
};

__device__ __forceinline__ unsigned cvt_pk_bf16(float lo, float hi) { unsigned r; asm volatile("v_cvt_pk_bf16_f32 %0, %1, %2" : "=v"(r) : "v"(lo), "v"(hi)); return r; }
constexpr size_t EWS_MiB = 1u << 20, EWS_SSQ = 43 * EWS_MiB, EWS_CL = 45 * EWS_MiB, EWS_CT = 46 * EWS_MiB, EWS_IW = 47 * EWS_MiB, EWS_CF = 47 * EWS_MiB + 512 * 1024, EWS_IQ = 49 * EWS_MiB, EWS_IK = 57 * EWS_MiB, EWS_G = 188 * EWS_MiB,
    EWS_QA = 284 * EWS_MiB, EWS_QB = 316 * EWS_MiB, EWS_QC = 348 * EWS_MiB, EWS_KC = 380 * EWS_MiB, EWS_VC = 412 * EWS_MiB, EWS_KAB = 444 * EWS_MiB, EWS_VAB = 460 * EWS_MiB;

constexpr float C2Q = 0.125f * 1.4426950408889634f;
__device__ __forceinline__ float fast_sigmoid(float x) { return __builtin_amdgcn_rcpf(1.0f + __expf(-x)); }
__device__ __forceinline__ u32x4 pack8(const f32x4 a, const f32x4 b) { u32x4 w; w.x = cvt_pk_bf16(a[0], a[1]); w.y = cvt_pk_bf16(a[2], a[3]); w.z = cvt_pk_bf16(b[0], b[1]); w.w = cvt_pk_bf16(b[2], b[3]); return w; }
__device__ __forceinline__ void unpack8(const u32x4 w, f32x4& a, f32x4& b) {
    a[0] = __uint_as_float(w.x << 16); a[1] = __uint_as_float(w.x & 0xffff0000u); a[2] = __uint_as_float(w.y << 16); a[3] = __uint_as_float(w.y & 0xffff0000u);
    b[0] = __uint_as_float(w.z << 16); b[1] = __uint_as_float(w.z & 0xffff0000u); b[2] = __uint_as_float(w.w << 16); b[3] = __uint_as_float(w.w & 0xffff0000u); }
#define EPI_PIN() asm volatile("" ::: "memory")
__device__ __forceinline__ void rows_rstd(const float* ssq, int row0, int fq, float (&rs)[2][4]) {
    f32x4 pr[2][4];
#pragma unroll
    for (int ai = 0; ai < 2; ++ai)
#pragma unroll
        for (int m = 0; m < 4; ++m) pr[ai][m] = *(const f32x4*)(ssq + (size_t)(row0 + ai * HALF + m * 16) * 16 + 4 * fq);
    EPI_PIN();
#pragma unroll
    for (int ai = 0; ai < 2; ++ai)
#pragma unroll
        for (int m = 0; m < 4; ++m) { const f32x4 a = pr[ai][m]; float t = (a[0] + a[1]) + (a[2] + a[3]); t += __shfl_xor(t, 16); t += __shfl_xor(t, 32); rs[ai][m] = __builtin_amdgcn_rsqf(t * (1.0f / 1024.0f) + 1e-6f); }
}
struct EpiIn {
    static constexpr bool PERM = true, AFTER_DRAIN = false;
    unsigned char* ws; const float* qkg; const float* bfg;
    __device__ __forceinline__ bool keep(const Unit&) const { return false; }
    __device__ __forceinline__ void operator()(f32x4 (&acc)[2][2][4][2], const Unit& u, int wr, int wc, int fr, int fq) const {
        const int row0 = u.pm * BM + wr * 64 + fr, t = u.pn, lc0 = wc * 64 + fq * 8;
        float rs[2][4]; rows_rstd((const float*)(ws + EWS_SSQ), row0, fq, rs);
        if (t == 18) {
            bf16_t* IQ = (bf16_t*)(ws + EWS_IQ); bf16_t* IK = (bf16_t*)(ws + EWS_IK); float* IW = (float*)(ws + EWS_IW);
#pragma unroll
            for (int ai = 0; ai < 2; ++ai)
#pragma unroll
                for (int m = 0; m < 4; ++m) { const int row = row0 + ai * HALF + m * 16; const float f = rs[ai][m];
#pragma unroll
                    for (int bj = 0; bj < 2; ++bj) { const int lc = lc0 + 32 * bj; const f32x4 v0 = acc[ai][bj][m][0] * f, v1 = acc[ai][bj][m][1] * f;
                        if (lc < 128) *(u32x4*)(IQ + (size_t)row * 128 + lc) = pack8(v0, v1);
                        else if (lc < 160) *(u32x4*)(IK + (size_t)row * 32 + (lc - 128)) = pack8(v0, v1);
                        else if (lc == 160) *(f32x4*)(IW + (size_t)row * 4) = v0 * 0.08838834764831845f; } }
            int ln_ = (int)__builtin_amdgcn_mbcnt_hi(~0u, __builtin_amdgcn_mbcnt_lo(~0u, 0u)); asm volatile("" : "+v"(ln_));
            if (wc == 2 && (ln_ >> 4) < 2) { const int fql = ln_ >> 4, frl = ln_ & 15;
                float* CL = (float*)(ws + EWS_CL); float* CT = (float*)(ws + EWS_CT); const int hb = 4 * fql; const f32x4 bfv = *(const f32x4*)(bfg + hb);
#pragma unroll
                for (int ai = 0; ai < 2; ++ai) { f32x4 run = {0.f, 0.f, 0.f, 0.f};
#pragma unroll
                    for (int m = 0; m < 4; ++m) { const int row = row0 + ai * HALF + m * 16; const f32x4 z = (fql == 0 ? acc[ai][1][m][1] : acc[ai][1][m][0]) * rs[ai][m] + bfv; f32x4 lf;
#pragma unroll
                        for (int e = 0; e < 4; ++e) lf[e] = (z[e] < 0.f ? z[e] : 0.f) - __logf(1.0f + __expf(-fabsf(z[e])));
#pragma unroll
                        for (int o = 1; o < 16; o <<= 1)
#pragma unroll
                            for (int e = 0; e < 4; ++e) { const float tt = __shfl_up(lf[e], o, 16); if (frl >= o) lf[e] += tt; }
                        const f32x4 cs = lf + run;
                        const int bb = row >> 13, ss = row & 8191;
#pragma unroll
                        for (int e = 0; e < 4; ++e) CL[(size_t)(bb * 8 + hb + e) * 8192 + ss] = cs[e];
#pragma unroll
                        for (int e = 0; e < 4; ++e) run[e] += __shfl(lf[e], 15, 16); }
                    if (frl == 15) { const int row = row0 + ai * HALF, bb = row >> 13, ch = (row & 8191) >> 6;
#pragma unroll
                        for (int e = 0; e < 4; ++e) CT[(bb * 8 + hb + e) * 128 + ch] = run[e]; } } }
            return;
        }
        bf16_t* dst; int ldc, colbase; const float* gp = qkg; float csc = 1.f; bool norm = false, act = false;
        if (t < 6) { const int mx = t >> 1; dst = (bf16_t*)(ws + (mx == 0 ? EWS_QA : (mx == 1 ? EWS_QB : EWS_QC))); ldc = 512; colbase = (t & 1) * 256; norm = true; gp = qkg + (mx * 2 + 0) * 64; csc = (mx == 2) ? C2Q : 1.f; }
        else if (t == 6) { dst = (bf16_t*)(ws + EWS_KAB); ldc = 128; colbase = (wc >> 1) * (32768 * 128 - 128); norm = true;     gp = qkg + ((wc >> 1) * 2 + 1) * 64; }
        else if (t < 9) { dst = (bf16_t*)(ws + EWS_KC); ldc = 512; colbase = (t - 7) * 256; norm = true; gp = qkg + (2 * 2 + 1) * 64; }
        else if (t == 9) { dst = (bf16_t*)(ws + EWS_VAB); ldc = 128; colbase = (wc >> 1) * (32768 * 128 - 128); }
        else if (t < 12) { dst = (bf16_t*)(ws + EWS_VC); ldc = 512; colbase = (t - 10) * 256; }
        else { dst = (bf16_t*)(ws + EWS_G); ldc = 1536; colbase = (t - 12) * 256; act = true; }
        f32x4 gv[2][2];
#pragma unroll
        for (int bj = 0; bj < 2; ++bj)
#pragma unroll
            for (int n = 0; n < 2; ++n) gv[bj][n] = norm ? *(const f32x4*)(gp + 8 * fq + 32 * bj + 4 * n) * csc : (f32x4){1.f, 1.f, 1.f, 1.f};
        EPI_PIN();
#pragma unroll
        for (int ai = 0; ai < 2; ++ai)
#pragma unroll
            for (int m = 0; m < 4; ++m) { const int row = row0 + ai * HALF + m * 16; float f = rs[ai][m];
                if (norm) { float ss = 0.f;
#pragma unroll
                    for (int bj = 0; bj < 2; ++bj)
#pragma unroll
                        for (int n = 0; n < 2; ++n) { const f32x4 x = acc[ai][bj][m][n]; ss += (x[0] * x[0] + x[1] * x[1]) + (x[2] * x[2] + x[3] * x[3]); }
                    ss += __shfl_xor(ss, 16); ss += __shfl_xor(ss, 32);
                    f = f * __builtin_amdgcn_rsqf(f * f * ss * (1.0f / 64.0f) + 1e-6f); }
                bf16_t* rowp = dst + (size_t)row * ldc + colbase + lc0;
#pragma unroll
                for (int bj = 0; bj < 2; ++bj) { f32x4 v0 = acc[ai][bj][m][0] * f * gv[bj][0], v1 = acc[ai][bj][m][1] * f * gv[bj][1];
                    if (act) {
#pragma unroll
                        for (int e = 0; e < 4; ++e) { v0[e] = v0[e] * fast_sigmoid(v0[e]); v1[e] = v1[e] * fast_sigmoid(v1[e]); } }
                    *(u32x4*)(rowp + 32 * bj) = pack8(v0, v1); } }
    }
};
typedef unsigned u32x2e __attribute__((ext_vector_type(2)));
__device__ __forceinline__ unsigned gate_q4s(const f32x4 a, const float fe) { unsigned w = 0u;
#define GQ1_(E_) fmaxf(__builtin_amdgcn_rcpf(fmaf(__builtin_amdgcn_exp2f(a[E_] * fe), 1.0f / 255.0f, 1.0f / 255.0f)), 1.0f)
    w = __builtin_amdgcn_cvt_pk_u8_f32(GQ1_(0), 0, w); w = __builtin_amdgcn_cvt_pk_u8_f32(GQ1_(1), 1, w); w = __builtin_amdgcn_cvt_pk_u8_f32(GQ1_(2), 2, w); w = __builtin_amdgcn_cvt_pk_u8_f32(GQ1_(3), 3, w); return w;
#undef GQ1_
}
__device__ __forceinline__ f32x4 gate_f4(const unsigned w) { return (f32x4){(float)(w & 0xffu), (float)((w >> 8) & 0xffu), (float)((w >> 16) & 0xffu), (float)(w >> 24)}; }
struct EpiGate {
    static constexpr bool PERM = true, AFTER_DRAIN = false;
    const float* ssq; unsigned char* MG;
    __device__ __forceinline__ bool keep(const Unit&) const { return false; }
    __device__ __forceinline__ void operator()(f32x4 (&acc)[2][2][4][2], const Unit& u, int wr, int wc, int fr, int fq) const {
        const int row0 = u.pm * BM + wr * 64 + fr, lc0 = wc * 64 + fq * 8;
        float rs[2][4]; rows_rstd(ssq, row0, fq, rs);
#pragma unroll
        for (int ai = 0; ai < 2; ++ai)
#pragma unroll
            for (int m = 0; m < 4; ++m) { const float fe = -rs[ai][m] * 1.4426950408889634f;
                unsigned char* tp = MG + ((size_t)u.pm * 12 + u.pn) * 65536 + (size_t)(ai * 4 + m) * 8192 + (size_t)(fq * 16 + fr) * 16 + (size_t)wr * 4096;
#pragma unroll
                for (int bj = 0; bj < 2; ++bj) { const int cb2 = wc * 2 + bj, wcp = cb2 & 3, bjp = cb2 >> 2; u32x2e w; w.x = gate_q4s(acc[ai][bj][m][0], fe); w.y = gate_q4s(acc[ai][bj][m][1], fe);
                    *(u32x2e*)(tp + wcp * 1024 + bjp * 8) = w; } }
    }
};
struct EpiInAll {
    static constexpr bool PERM = true, AFTER_DRAIN = false;
    EpiIn a; EpiGate b; int nta;
    __device__ __forceinline__ bool keep(const Unit&) const { return false; }
    __device__ __forceinline__ void operator()(f32x4 (&acc)[2][2][4][2], const Unit& u, int wr, int wc, int fr, int fq) const {
        if (u.pn < nta) a(acc, u, wr, wc, fr, fq);
        else { Unit v = u; v.pn = u.pn - nta; b(acc, v, wr, wc, fr, fq); }
    }
};
struct EpiMerge {
    static constexpr bool PERM = true, AFTER_DRAIN = false;
    const unsigned char* MG; bf16_t* OUT;
    __device__ __forceinline__ bool keep(const Unit& u) const { return u.seg < 2; }
    __device__ __forceinline__ void operator()(f32x4 (&acc)[2][2][4][2], const Unit& u, int wr, int wc, int fr, int fq) const {
        const int row0 = u.pm * BM + wr * 64 + fr, col0 = u.pn * BM + wc * 32 + 8 * fq, seg = u.seg;
#pragma unroll
        for (int ai = 0; ai < 2; ++ai) {
            u32x2e ga[4][2], gb[4][2];
#pragma unroll
            for (int m = 0; m < 4; ++m) { const unsigned char* gp = MG + ((size_t)u.pm * 12 + seg * 4 + u.pn) * 65536 + (size_t)(ai * 4 + m) * 8192 + (size_t)((wr * 4 + wc) * 64 + fq * 16 + fr) * 16;
                const u32x4 a4 = *(const u32x4*)gp, b4 = seg < 2 ? *(const u32x4*)(gp + 4 * 65536) : a4;
                ga[m][0] = (u32x2e){a4.x, a4.y}; ga[m][1] = (u32x2e){a4.z, a4.w}; gb[m][0] = (u32x2e){b4.x, b4.y}; gb[m][1] = (u32x2e){b4.z, b4.w}; }
            EPI_PIN();
#pragma unroll
            for (int m = 0; m < 4; ++m) { const int row = row0 + ai * HALF + m * 16;
#pragma unroll
                for (int bj = 0; bj < 2; ++bj) { f32x4 a0 = gate_f4(ga[m][bj].x), a1 = gate_f4(ga[m][bj].y);
                    if (seg < 2) { const f32x4 b0 = gate_f4(gb[m][bj].x), b1 = gate_f4(gb[m][bj].y);
#pragma unroll
                        for (int e = 0; e < 4; ++e) { a0[e] = a0[e] * __builtin_amdgcn_rcpf(b0[e]); a1[e] = a1[e] * __builtin_amdgcn_rcpf(b1[e]); } }
                    else { a0 = a0 * (1.0f / 255.0f); a1 = a1 * (1.0f / 255.0f); }
                    acc[ai][bj][m][0] = acc[ai][bj][m][0] * a0; acc[ai][bj][m][1] = acc[ai][bj][m][1] * a1;
                    if (seg == 2) *(u32x4*)(OUT + (size_t)row * 1024 + col0 + bj * HALF) = pack8(acc[ai][bj][m][0], acc[ai][bj][m][1]); } }
        }
    }
};
template <bool RB, bool WOUT> struct EpiOutT {
    static constexpr bool PERM = true, AFTER_DRAIN = false;
    const float* resid; const bf16_t* residb; float* out; bf16_t* XB; float* ssq; unsigned poison;
    __device__ __forceinline__ bool keep(const Unit&) const { return false; }
    __device__ __forceinline__ void operator()(f32x4 (&acc)[2][2][4][2], const Unit& u, int wr, int wc, int fr, int fq) const {
        const int row0 = u.pm * BM + wr * 64 + fr, col0 = u.pn * BM + wc * 32 + 8 * fq;
#pragma unroll
        for (int ai = 0; ai < 2; ++ai) {
            f32x4 rv[4][2][2];
#pragma unroll
            for (int m = 0; m < 4; ++m)
#pragma unroll
                for (int bj = 0; bj < 2; ++bj) { const size_t o = (size_t)(row0 + ai * HALF + m * 16) * 1024 + col0 + bj * HALF;
                    if (RB) unpack8(*(const u32x4*)(residb + o), rv[m][bj][0], rv[m][bj][1]); else { rv[m][bj][0] = *(const f32x4*)(resid + o); rv[m][bj][1] = *(const f32x4*)(resid + o + 4); } }
            EPI_PIN();
#pragma unroll
            for (int m = 0; m < 4; ++m) { const int row = row0 + ai * HALF + m * 16; float ss = 0.f;
#pragma unroll
                for (int bj = 0; bj < 2; ++bj) { const size_t o = (size_t)row * 1024 + col0 + bj * HALF;
                    f32x4 v0 = rv[m][bj][0] + acc[ai][bj][m][0], v1 = rv[m][bj][1] + acc[ai][bj][m][1];
                    if (poison) { const float qn = __builtin_nanf(""); v0 = (f32x4){qn, qn, qn, qn}; v1 = v0; }
                    if (WOUT) { *(f32x4*)(out + o) = v0; *(f32x4*)(out + o + 4) = v1; }
                    if (XB) { *(u32x4*)(XB + o) = pack8(v0, v1); ss += ((v0[0] * v0[0] + v0[1] * v0[1]) + (v0[2] * v0[2] + v0[3] * v0[3])) + ((v1[0] * v1[0] + v1[1] * v1[1]) + (v1[2] * v1[2] + v1[3] * v1[3])); } }
                if (XB) { ss += __shfl_xor(ss, 16); ss += __shfl_xor(ss, 32); if (fq == 0) ssq[(size_t)row * 16 + u.pn * 4 + wc] = ss; } }
            EPI_PIN();
        }
    }
};
struct SegOrder {
    StaticOrder base;
    __device__ __forceinline__ bool next(int i, Unit& u) const { if (!base.next(i / 3, u)) return false; u.seg = i % 3; return true; }
    __device__ __forceinline__ void a_ready(const Unit&) const {}
    __device__ __forceinline__ void done(const Unit&) const {}
};

template <class Epi, class Sched, bool ALIGN_EPI = false, bool SP2 = false>
__device__ __forceinline__ void gemm_phase(PG8_LAS unsigned char* lds, const Gemm g, const Sched& S, const Epi& E, int wave_id) {
    int tid_ = (int)__builtin_amdgcn_mbcnt_hi(~0u, __builtin_amdgcn_mbcnt_lo(~0u, 0u)); asm volatile("" : "+v"(tid_)); tid_ += wave_id * 64;
    const int tid = tid_, wid = __builtin_amdgcn_readfirstlane(tid >> 6), lane = tid & 63, wr = wid >> 2, wc = wid & 3, fr = lane & 15, fq = lane >> 4;
    const int K = g.K, nt = K / BK;
    unsigned voffA[2], voffB[2];
#pragma unroll
    for (int i = 0; i < 2; ++i) { int R, C; stage_rc(tid * 16 + i * 8192, R, C); const int Rb = Epi::PERM ? ((R & ~31) + perm32(R & 31)) : R;
        voffA[i] = (unsigned)(R * g.lda + C) * 2u; voffB[i] = (unsigned)(Rb * g.ldb + C) * 2u; }
    const size_t kstep = (size_t)(BK * 2);
    const size_t hstepA = (size_t)HALF * g.lda * 2, hstepB = (size_t)HALF * g.ldb * 2;
    const size_t tstepA = 2 * hstepA, tstepB = 2 * hstepB, sstepA = (size_t)K * 2;
    const unsigned ldsw = (unsigned)wid * 1024u;
    const int aoff = lds_byte(wr * 64 + fr, fq * 8), boff = lds_byte(wc * 32 + fr, fq * 8);
#define PG8_SA(b, h) (((b) * 2 + (h)) * HTB)
#define PG8_SB(b, h) ((4 + (b) * 2 + (h)) * HTB)
#define PG8_STAGE(bufoff, gbase, voff) do { _Pragma("unroll") for (int _i = 0; _i < 2; ++_i) \
        __builtin_amdgcn_global_load_lds((const unsigned*)((const char*)(gbase) + (voff)[_i]), (PG8_LAS unsigned*)(lds + (bufoff) + ldsw + _i * 8192), 16, 0, 0); } while (0)
#define PG8_LDA(dst, b, h) do { _Pragma("unroll") for (int m = 0; m < 4; ++m) _Pragma("unroll") for (int k = 0; k < 2; ++k) dst[m][k] = *(const PG8_LAS bf16x8*)(lds + PG8_SA(b, h) + aoff + m * 2048 + k * 1024); } while (0)
#define PG8_LDB(dst, b, h) do { _Pragma("unroll") for (int n = 0; n < 2; ++n) _Pragma("unroll") for (int k = 0; k < 2; ++k) dst[n][k] = *(const PG8_LAS bf16x8*)(lds + PG8_SB(b, h) + boff + n * 2048 + k * 1024); } while (0)
#define PG8_MMA(ai, bj, At, Bt) do { __builtin_amdgcn_s_setprio(1); _Pragma("unroll") for (int m = 0; m < 4; ++m) _Pragma("unroll") for (int n = 0; n < 2; ++n) _Pragma("unroll") for (int k = 0; k < 2; ++k) \
        acc[ai][bj][m][n] = __builtin_amdgcn_mfma_f32_16x16x32_bf16(Bt[n][k], At[m][k], acc[ai][bj][m][n], 0, 0, 0); __builtin_amdgcn_s_setprio(0); } while (0)
#define PG8_WAIT_V(n) asm volatile("s_waitcnt vmcnt(" #n ")" ::: "memory")
#define PG8_WAIT_L(n) asm volatile("s_waitcnt lgkmcnt(" #n ")" ::: "memory")
#define PG8_BAR __builtin_amdgcn_s_barrier()
#define PG8_SCHED __builtin_amdgcn_sched_barrier(0)
    Unit cur, nxt; int ui = 0;
    if (!S.next(0, cur)) return;
    f32x4 acc[2][2][4][2];
#pragma unroll
    for (int a = 0; a < 2; ++a)
#pragma unroll
        for (int b = 0; b < 2; ++b)
#pragma unroll
            for (int m = 0; m < 4; ++m)
#pragma unroll
                for (int n = 0; n < 2; ++n) acc[a][b][m][n] = (f32x4){0.f, 0.f, 0.f, 0.f};
    bf16x8 At[4][2], B0[2][2], B1[2][2];
    const char* cA = (const char*)g.A + (size_t)cur.pm * tstepA + (size_t)cur.seg * sstepA; const char* cB = (const char*)g.Bt + (size_t)(cur.seg * g.segN + cur.pn) * tstepB;
    S.a_ready(cur);
    if constexpr (SP2) {
        PG8_STAGE(PG8_SB(0, 0), cB, voffB); PG8_STAGE(PG8_SB(0, 1), cB + hstepB, voffB); PG8_STAGE(PG8_SA(0, 0), cA, voffA); PG8_STAGE(PG8_SA(0, 1), cA + hstepA, voffA);
        if (wr == 1) PG8_BAR;
        PG8_WAIT_V(2); PG8_BAR;
        PG8_STAGE(PG8_SB(1, 0), cB + kstep, voffB); PG8_STAGE(PG8_SA(1, 0), cA + kstep, voffA); PG8_STAGE(PG8_SB(1, 1), cB + hstepB + kstep, voffB);
        PG8_WAIT_V(6); PG8_BAR;
    } else {
        PG8_STAGE(PG8_SB(0, 0), cB, voffB); PG8_STAGE(PG8_SA(0, 0), cA, voffA); PG8_STAGE(PG8_SB(0, 1), cB + hstepB, voffB); PG8_STAGE(PG8_SA(0, 1), cA + hstepA, voffA);
        if (wr == 1) PG8_BAR;
        PG8_WAIT_V(4); PG8_BAR;
        PG8_STAGE(PG8_SB(1, 0), cB + kstep, voffB); PG8_STAGE(PG8_SA(1, 0), cA + kstep, voffA); PG8_STAGE(PG8_SB(1, 1), cB + hstepB + kstep, voffB);
        PG8_WAIT_V(6); PG8_BAR;
    }
    for (;;) {
        const bool has_next = S.next(ui + 1, nxt);
        const char* nA = has_next ? (const char*)g.A + (size_t)nxt.pm * tstepA + (size_t)nxt.seg * sstepA : cA; const char* nB = has_next ? (const char*)g.Bt + (size_t)(nxt.seg * g.segN + nxt.pn) * tstepB : cB;
        for (int t = 0; t < nt; t += 2) {
            const bool last = (t == nt - 2);
            const char* a1 = cA + (size_t)(t + 1) * kstep;
            const char* a2 = last ? nA : cA + (size_t)(t + 2) * kstep; const char* b2 = last ? nB : cB + (size_t)(t + 2) * kstep;
            const char* a3 = a2 + kstep; const char* b3 = b2 + kstep;
            if (last && has_next) S.a_ready(nxt);
            if constexpr (SP2) {
            PG8_LDB(B0, 0, 0); PG8_LDB(B1, 0, 1); PG8_SCHED; PG8_LDA(At, 0, 0); PG8_STAGE(PG8_SA(1, 1), a1 + hstepA, voffA);
            PG8_WAIT_V(8); PG8_WAIT_L(0); PG8_BAR; PG8_MMA(0, 0, At, B0); PG8_MMA(0, 1, At, B1); PG8_BAR; PG8_SCHED;
            PG8_LDA(At, 0, 1); PG8_STAGE(PG8_SB(0, 0), b2, voffB); PG8_STAGE(PG8_SB(0, 1), b2 + hstepB, voffB); PG8_STAGE(PG8_SA(0, 0), a2, voffA);
            PG8_WAIT_V(8); PG8_WAIT_L(0); PG8_BAR; PG8_MMA(1, 0, At, B0); PG8_MMA(1, 1, At, B1); PG8_BAR; PG8_SCHED;
            PG8_LDB(B0, 1, 0); PG8_LDB(B1, 1, 1); PG8_SCHED; PG8_LDA(At, 1, 0); PG8_STAGE(PG8_SA(0, 1), a2 + hstepA, voffA);
            PG8_WAIT_V(8); PG8_WAIT_L(0); PG8_BAR; PG8_MMA(0, 0, At, B0); PG8_MMA(0, 1, At, B1); PG8_BAR; PG8_SCHED;
            PG8_LDA(At, 1, 1); PG8_STAGE(PG8_SB(1, 0), b3, voffB); PG8_STAGE(PG8_SB(1, 1), b3 + hstepB, voffB); PG8_STAGE(PG8_SA(1, 0), a3, voffA);
            PG8_WAIT_V(8); PG8_WAIT_L(0); PG8_BAR; PG8_MMA(1, 0, At, B0); PG8_MMA(1, 1, At, B1); PG8_BAR; PG8_SCHED;
            } else {
            PG8_LDB(B0, 0, 0); PG8_SCHED; PG8_LDA(At, 0, 0); PG8_STAGE(PG8_SA(1, 1), a1 + hstepA, voffA);
            PG8_WAIT_L(8); PG8_BAR; PG8_WAIT_L(0); PG8_MMA(0, 0, At, B0); PG8_BAR; PG8_SCHED;
            PG8_LDB(B1, 0, 1); PG8_STAGE(PG8_SB(0, 0), b2, voffB);
            PG8_BAR; PG8_WAIT_L(0); PG8_MMA(0, 1, At, B1); PG8_BAR;
            PG8_LDA(At, 0, 1); PG8_STAGE(PG8_SA(0, 0), a2, voffA);
            PG8_BAR; PG8_WAIT_L(0); PG8_MMA(1, 0, At, B0); PG8_BAR; PG8_SCHED;
            PG8_STAGE(PG8_SB(0, 1), b2 + hstepB, voffB);
            PG8_WAIT_V(6); PG8_BAR; PG8_MMA(1, 1, At, B1); PG8_BAR;
            PG8_LDB(B0, 1, 0); PG8_SCHED; PG8_LDA(At, 1, 0); PG8_STAGE(PG8_SA(0, 1), a2 + hstepA, voffA);
            PG8_WAIT_L(8); PG8_BAR; PG8_WAIT_L(0); PG8_MMA(0, 0, At, B0); PG8_BAR; PG8_SCHED;
            PG8_LDB(B1, 1, 1); PG8_STAGE(PG8_SB(1, 0), b3, voffB);
            PG8_BAR; PG8_WAIT_L(0); PG8_MMA(0, 1, At, B1); PG8_BAR;
            PG8_LDA(At, 1, 1); PG8_STAGE(PG8_SA(1, 0), a3, voffA);
            PG8_BAR; PG8_WAIT_L(0); PG8_MMA(1, 0, At, B0); PG8_BAR; PG8_SCHED;
            PG8_STAGE(PG8_SB(1, 1), b3 + hstepB, voffB);
            PG8_WAIT_V(6); PG8_BAR; PG8_MMA(1, 1, At, B1); PG8_BAR;
            }
        }
        if constexpr (ALIGN_EPI) { if (wr == 0) PG8_BAR; }
        if constexpr (!Epi::AFTER_DRAIN) { E(acc, cur, wr, wc, fr, fq); S.done(cur); }
        if (!has_next) break;
        if (!E.keep(cur)) {
#pragma unroll
        for (int a = 0; a < 2; ++a)
#pragma unroll
            for (int b = 0; b < 2; ++b)
#pragma unroll
                for (int m = 0; m < 4; ++m)
#pragma unroll
                    for (int n = 0; n < 2; ++n) acc[a][b][m][n] = (f32x4){0.f, 0.f, 0.f, 0.f};
        }
        cur = nxt; cA = nA; cB = nB; ++ui;
        if constexpr (ALIGN_EPI) { if (wr == 1) PG8_BAR; }
    }
    PG8_WAIT_V(0);
    if constexpr (!ALIGN_EPI) { if (wr == 0) PG8_BAR; }
    PG8_BAR;
    if constexpr (Epi::AFTER_DRAIN) { E.fused(acc, cur, wr, wc, fr, fq, lds, wid, lane); S.done(cur); }
#undef PG8_SA
#undef PG8_SB
#undef PG8_STAGE
#undef PG8_LDA
#undef PG8_LDB
#undef PG8_MMA
#undef PG8_WAIT_V
#undef PG8_WAIT_L
#undef PG8_BAR
#undef PG8_SCHED
}
}
#include <hip/hip_bf16.h>
#include <cmath>
namespace attn_body {
using bf16=__hip_bfloat16;
using bf16x8=__attribute__((ext_vector_type(8)))short;
using s16x4=__attribute__((ext_vector_type(4)))short;
using f32x16=__attribute__((ext_vector_type(16)))float;
using u32x4=__attribute__((ext_vector_type(4)))unsigned;
constexpr int BATCH=4,NHEAD=8,SEQ=8192,D=64,DM=NHEAD*D;
constexpr int NW=8,QBLK=32,QB=QBLK*NW,KVBLK=64,NQB=SEQ/QB;
constexpr int ATTN_PITCH=DM, ATTN_UNIT_ROWS=QB, OPITCH=1536, OCOL0=1024;
__device__ __forceinline__ int crow(int r,int hi){return (r&3)+8*(r>>2)+4*hi;}
#define SBAR() __builtin_amdgcn_sched_barrier(0)
__device__ __forceinline__ void cmask(f32x16&p0,f32x16&p1,int jb,int qrel,int hi){
  const float NEG=-INFINITY; int kb=64*jb+4*hi;
  #pragma unroll
  for(int r=0;r<16;++r){int kv=kb+(r&3)+8*(r>>2); if(kv>qrel)p0[r]=NEG; if(kv+32>qrel)p1[r]=NEG;}
}

constexpr int NSLOT=3, SLOTB=8192;
constexpr int LDS_K=0, LDS_V=NSLOT*SLOTB, LDS_WS=2*NSLOT*SLOTB, LDS_OST=LDS_WS+NW*64*4, LDS_BYTES=LDS_OST+NW*4096;
constexpr float C2=0.125f*1.4426950408889634f;
__device__ __forceinline__ void glds16(const void*gsrc,unsigned lds_dst){unsigned keep;
  asm volatile("s_mov_b32 %0, m0\n\ts_mov_b32 m0, %2\n\ts_nop 0\n\tglobal_load_lds_dwordx4 %1, off\n\ts_mov_b32 m0, %0":"=&s"(keep):"v"(gsrc),"s"(lds_dst):"memory");}
__device__ __forceinline__ float max3f(float a,float b,float c){float r;asm("v_max3_f32 %0, %1, %2, %3":"=v"(r):"v"(a),"v"(b),"v"(c));return r;}
__device__ __forceinline__ float max2f(float a,float b){float r;asm("v_max_f32_e32 %0, %1, %2":"=v"(r):"v"(a),"v"(b));return r;}
__device__ __forceinline__ float fadd_s(float a,float b){float r;asm("v_add_f32_e32 %0, %1, %2":"=v"(r):"v"(a),"v"(b));return r;}
__device__ __forceinline__ float fsub_s(float a,float b){float r;asm("v_sub_f32_e32 %0, %1, %2":"=v"(r):"v"(a),"v"(b));return r;}
typedef float f32x2_t __attribute__((ext_vector_type(2))); typedef __bf16 bf16x2_t __attribute__((ext_vector_type(2)));
__device__ __forceinline__ unsigned cvtpk_s(float lo,float hi){f32x2_t v={lo,hi};bf16x2_t b=__builtin_convertvector(v,bf16x2_t);return __builtin_bit_cast(unsigned,b);}
#define WAIT_BAR(N) asm volatile("s_waitcnt vmcnt(" #N ") lgkmcnt(0)\n\ts_barrier":::"memory")

__device__ __forceinline__ void qkt(f32x16&p0,f32x16&p1,const char*Kslot,const bf16x8*qr,int r32,int hi){
  const char*kb=Kslot+hi*1024+r32*16;
  #pragma unroll
  for(int d0=0;d0<4;++d0){
    const bf16x8 b0=*reinterpret_cast<const bf16x8*>(kb+d0*2048);
    const bf16x8 b1=*reinterpret_cast<const bf16x8*>(kb+d0*2048+512);
    p0=__builtin_amdgcn_mfma_f32_32x32x16_bf16(b0,qr[d0],p0,0,0,0);p1=__builtin_amdgcn_mfma_f32_32x32x16_bf16(b1,qr[d0],p1,0,0,0);}
}
typedef __attribute__((address_space(3))) const unsigned* lds_cuptr;
typedef float f32x4_t __attribute__((ext_vector_type(4)));
__device__ __forceinline__ unsigned bfr(float f){ unsigned u=__builtin_bit_cast(unsigned,f); return (u+0x7fffu+((u>>16)&1u))>>16; }
__device__ __forceinline__ void biasmm(f32x16&c0,f32x16&c1,unsigned w0,unsigned w1  ,unsigned qm1,int hi){
  const unsigned one=hi?0u:0x3f803f80u; w0=hi?0u:w0; w1=hi?0u:w1;
  const u32x4 k0={w0,one,0u,0u},k1={w1,one,0u,0u},qv={one,qm1,0u,0u};
  const f32x16 z=f32x16{};
  c0=__builtin_amdgcn_mfma_f32_32x32x16_bf16(__builtin_bit_cast(bf16x8,k0),__builtin_bit_cast(bf16x8,qv),z,0,0,0);
  c1=__builtin_amdgcn_mfma_f32_32x32x16_bf16(__builtin_bit_cast(bf16x8,k1),__builtin_bit_cast(bf16x8,qv),z,0,0,0);
}
typedef __attribute__((address_space(3))) const char* lds_cptr;
typedef short v4i16_t __attribute__((ext_vector_type(4)));
__device__ __forceinline__ void kload8(bf16x8*kf,lds_cptr kp){
  kf[0]=*(const __attribute__((address_space(3))) bf16x8*)(kp);      kf[1]=*(const __attribute__((address_space(3))) bf16x8*)(kp+512);
  kf[2]=*(const __attribute__((address_space(3))) bf16x8*)(kp+2048); kf[3]=*(const __attribute__((address_space(3))) bf16x8*)(kp+2560);
  kf[4]=*(const __attribute__((address_space(3))) bf16x8*)(kp+4096); kf[5]=*(const __attribute__((address_space(3))) bf16x8*)(kp+4608);
  kf[6]=*(const __attribute__((address_space(3))) bf16x8*)(kp+6144); kf[7]=*(const __attribute__((address_space(3))) bf16x8*)(kp+6656);
}
__device__ __forceinline__ void kload2(bf16x8*kf,lds_cptr kp,int j){ kf[2*j]=*(const __attribute__((address_space(3))) bf16x8*)(kp+j*2048); kf[2*j+1]=*(const __attribute__((address_space(3))) bf16x8*)(kp+j*2048+512); }
__device__ __forceinline__ s16x4 vtr(lds_cptr p){ return __builtin_bit_cast(s16x4,__builtin_amdgcn_ds_read_tr16_b64_v4i16((__attribute__((address_space(3))) v4i16_t*)p)); }
__device__ __forceinline__ float rowmax(const f32x16&p0,const f32x16&p1){
  float a=max3f(p0[0],p0[1],p1[0]),b=max3f(p0[2],p0[3],p1[1]);a=max3f(a,p1[2],p1[3]);
  #pragma unroll
  for(int r=4;r<16;r+=4){a=max3f(a,p0[r],p0[r+1]);b=max3f(b,p0[r+2],p0[r+3]);a=max3f(a,p1[r],p1[r+1]);b=max3f(b,p1[r+2],p1[r+3]);}
  const float m=max2f(a,b);
  auto rr=__builtin_amdgcn_permlane32_swap(__float_as_uint(m),__float_as_uint(m),false,false);
  return max2f(__uint_as_float(rr[0]),__uint_as_float(rr[1]));
}
__device__ __forceinline__ void pv(f32x16*o,int vb,bf16x8 pa0,bf16x8 pa1,bf16x8 pa2,bf16x8 pa3){
  #pragma unroll
  for(int d0=0;d0<2;++d0){s16x4 lo[4],hi[4];
    #pragma unroll
    for(int ks=0;ks<4;++ks){
      asm volatile("ds_read_b64_tr_b16 %0,%1 offset:%c2":"=&v"(lo[ks]):"v"(vb),"i"(d0*4096+ks*1024):"memory");
      asm volatile("ds_read_b64_tr_b16 %0,%1 offset:%c2":"=&v"(hi[ks]):"v"(vb),"i"(d0*4096+ks*1024+512):"memory");}
    asm volatile("s_waitcnt lgkmcnt(0)":::"memory");SBAR();
    #define PK(k) (bf16x8){lo[k][0],lo[k][1],lo[k][2],lo[k][3],hi[k][0],hi[k][1],hi[k][2],hi[k][3]}
    o[d0]=__builtin_amdgcn_mfma_f32_32x32x16_bf16(pa0,PK(0),o[d0],0,0,0);
    o[d0]=__builtin_amdgcn_mfma_f32_32x32x16_bf16(pa1,PK(1),o[d0],0,0,0);
    o[d0]=__builtin_amdgcn_mfma_f32_32x32x16_bf16(pa2,PK(2),o[d0],0,0,0);
    o[d0]=__builtin_amdgcn_mfma_f32_32x32x16_bf16(pa3,PK(3),o[d0],0,0,0);
    #undef PK
  }
}

__device__ __forceinline__ u32x4 mul_bf16x8(u32x4 a,u32x4 b){ u32x4 r;
  #pragma unroll
  for(int i=0;i<4;++i){ const float al=__uint_as_float(a[i]<<16),ah=__uint_as_float(a[i]&0xffff0000u),bl=__uint_as_float(b[i]<<16),bh=__uint_as_float(b[i]&0xffff0000u); r[i]=cvtpk_s(al*bl,ah*bh); }
  return r; }
#ifndef ATTN_STORE16
#define ATTN_STORE16(p,v) (*(u32x4*)(p)=(v))
#endif
__device__ __forceinline__ void attn_prologue(int b,int h,const bf16*__restrict__ K,const bf16*__restrict__ V,char*shm,int tskip,int wave_id){
  int tid_=(int)__builtin_amdgcn_mbcnt_hi(~0u,__builtin_amdgcn_mbcnt_lo(~0u,0u)); asm volatile("":"+v"(tid_)); const int lane=tid_&63; const int wid=wave_id;
  const long rowbase=(long)b*SEQ; const bf16*Kh=K+(rowbase+(long)tskip*KVBLK)*DM+h*D,*Vh=V+(rowbase+(long)tskip*KVBLK)*DM+h*D;
  const unsigned lds0=(unsigned)(uintptr_t)shm;
  const bf16*ksrc=Kh+(long)lane*DM+wid*8; const bf16*vsrc=Vh+(long)(16*(wid&3)+(lane>>2))*DM+(wid>>2)*32+(lane&3)*8;
  const unsigned kdst=lds0+LDS_K+wid*1024, vdst=lds0+LDS_V+wid*1024;
  glds16(ksrc,(unsigned)__builtin_amdgcn_readfirstlane(kdst)); glds16(vsrc,(unsigned)__builtin_amdgcn_readfirstlane(vdst)); glds16(ksrc+(long)KVBLK*DM,(unsigned)__builtin_amdgcn_readfirstlane(kdst+SLOTB));
}
template<int THRL> __device__ __forceinline__ void attn_unit(int b,int h,int qb,const bf16*Q,const bf16*__restrict__ K,const bf16*__restrict__ V,bf16*O,char*shm,lds_cuptr nb,int tskip,bool dry,int wave_id,bool pre){
  int tid_=(int)__builtin_amdgcn_mbcnt_hi(~0u,__builtin_amdgcn_mbcnt_lo(~0u,0u)); asm volatile("":"+v"(tid_)); tid_+=wave_id*64; const int tid=tid_,lane=tid&63,r32=lane&31,hi=lane>>5; const int wid=__builtin_amdgcn_readfirstlane(tid>>6);
  const long rowbase=(long)b*SEQ; const int q0=qb*QB;
  const bf16*Qw=Q+(rowbase+q0+wid*QBLK)*DM+h*D;
  const bf16*Kh=K+(rowbase+(long)tskip*KVBLK)*DM+h*D,*Vh=V+(rowbase+(long)tskip*KVBLK)*DM+h*D;
  const unsigned lds0=(unsigned)(uintptr_t)shm;
  float*wsf=(float*)(shm+LDS_WS)+wid*64;
  const bf16*ksrc=Kh+(long)lane*DM+wid*8;
  const bf16*vsrc=Vh+(long)(16*(wid&3)+(lane>>2))*DM+(wid>>2)*32+(lane&3)*8;
  const unsigned kdst=lds0+LDS_K+wid*1024, vdst=lds0+LDS_V+wid*1024;
  #define DMA_K(t,slot) glds16(ksrc+(long)(t)*KVBLK*DM,(unsigned)__builtin_amdgcn_readfirstlane(kdst+(slot)))
  #define DMA_V(t,slot) glds16(vsrc+(long)(t)*KVBLK*DM,(unsigned)__builtin_amdgcn_readfirstlane(vdst+(slot)))
  const int vb0=(int)(lds0+LDS_V)+((lane>>4)&1)*32+(lane&3)*8+(4*hi+((lane&15)>>2))*64;
  const char*Kbase=shm+LDS_K; bf16x8 kf[8];
  const lds_cptr shm3=(lds_cptr)shm; const lds_cptr kp0=shm3+LDS_K+hi*1024+r32*16; const lds_cptr vp0=shm3+LDS_V+((lane>>4)&1)*32+(lane&3)*8+(4*hi+((lane&15)>>2))*64;
  const int NT=(q0+QB)/KVBLK-tskip;
  if(!pre){DMA_K(0,0);DMA_V(0,0);DMA_K(1,SLOTB);}
  bf16x8 qr[4];
  #pragma unroll
  for(int d0=0;d0<4;++d0)qr[d0]=*reinterpret_cast<const bf16x8*>(&Qw[(long)r32*DM+d0*16+hi*8]);
  float mhat=0.f,l_reg=0.f;f32x16 o[2];o[0]=f32x16{};o[1]=f32x16{};unsigned qm1=0u;const lds_cuptr nbl=nb+64*tskip+r32;
  #define SETM(NEWM) do{ const float nm_=-(NEWM); const unsigned h_=bfr(nm_); const float hf_=__uint_as_float(h_<<16); const unsigned l_=bfr(nm_-hf_); mhat=-(hf_+__uint_as_float(l_<<16)); qm1=hi?0u:(h_|(l_<<16)); }while(0)
  const int qrel=wid*QBLK+r32;
  #define CMASK(P0,P1,t) do{int jb_=(t)-(NT-4); if(jb_>=0)cmask(P0,P1,jb_,qrel,hi);}while(0)
  bool resc=false;
  #define START(P0,P1) do{ const float rm=rowmax(P0,P1); resc=false; \
    { const float old_=mhat; SETM(old_+rm); const float dl=mhat-old_; \
      _Pragma("unroll") for(int r=0;r<16;++r){P0[r]=fsub_s(P0[r],dl);P1[r]=fsub_s(P1[r],dl);} } \
    _Pragma("unroll") for(int r=0;r<16;++r)P0[r]=__builtin_amdgcn_exp2f(P0[r]); }while(0)
  #define RESC() do{ if(resc){ asm volatile("s_waitcnt lgkmcnt(0)":::"memory"); \
      _Pragma("unroll") for(int d_=0;d_<2;++d_) _Pragma("unroll") for(int r=0;r<16;++r)o[d_][r]*=wsf[crow(r,hi)]; } }while(0)
  f32x16 pA0,pA1,pB0,pB1;
  int sl_prev=0,sl_cur=0,sl_next=SLOTB;
  #define ROT() do{sl_prev=sl_cur;sl_cur=sl_next;sl_next=(sl_next==(NSLOT-1)*SLOTB)?0:sl_next+SLOTB;}while(0)
  DMA_K(2,2*SLOTB);
  WAIT_BAR(3);
  unsigned bw0=nbl[0],bw1=nbl[32]; biasmm(pA0,pA1,bw0,bw1,qm1,hi); bw0=nbl[64]; bw1=nbl[96]; qkt(pA0,pA1,Kbase,qr,r32,hi);    asm volatile("s_nop 15\n\ts_nop 7":"+v"(pA0),"+v"(pA1));CMASK(pA0,pA1,0);
  START(pA0,pA1);
  _Pragma("unroll") for(int r=0;r<16;++r)pA1[r]=__builtin_amdgcn_exp2f(pA1[r]);
  WAIT_BAR(0);
  DMA_K(3,0);DMA_V(1,SLOTB);
  ROT();
  kload8(kf,kp0+sl_cur);
  WAIT_BAR(2);
  s16x4 vlo[8],vhi[8]; u32x4 pw0,pw1,pw2,pw3;
  #define PKW(P,B) cvtpk_s(P[B],P[B+1])
  #define PAF(k) __builtin_bit_cast(bf16x8,pw##k)
  #define VFR(i) (bf16x8){vlo[i][0],vlo[i][1],vlo[i][2],vlo[i][3],vhi[i][0],vhi[i][1],vhi[i][2],vhi[i][3]}
  #define PIN(x) asm volatile("":"+v"(x))
  #define MX3(a,b,c) __builtin_fmaxf(__builtin_fmaxf((a),(b)),(c))
  #define GAPA(MF,A0,A1,A2,A3,W0,W1,PW) do{ MF; sacc+=A0; sacc+=A1; sacc+=A2; sacc+=A3; PIN(sacc); W0; W1; PIN(PW); SBAR(); }while(0)
  #define EX(v) __builtin_amdgcn_exp2f(v)
  #define GAPB(MF,X,B) do{ MF; X[B]=EX(X[B]); X[B+1]=EX(X[B+1]); X[B+2]=EX(X[B+2]); X[B+3]=EX(X[B+3]); PIN(X); SBAR(); }while(0)
  #define VRD(i) do{ vlo[i]=vtr(vp_+(((i)>>2)*4096+((i)&3)*1024)); vhi[i]=vtr(vp_+(((i)>>2)*4096+((i)&3)*1024+512)); }while(0)
  #define KRD(G,j) do{ if(G){ kload2(kf,kp0+sl_next,j); SBAR(); } }while(0)
  #define STEP(C0,C1,P0,P1,t,GK,GV,GL) do{ SBAR(); \
    biasmm(C0,C1,bw0,bw1,qm1,hi); bw0=nbl[64*((t)+1)]; bw1=nbl[64*((t)+1)+32]; SBAR(); \
    const lds_cptr vp_=vp0+sl_prev; \
    VRD(0); SBAR(); float sacc=(P0[0]+P0[1]); \
    GAPA(C0=__builtin_amdgcn_mfma_f32_32x32x16_bf16(kf[0],qr[0],C0,0,0,0), P0[2],P0[3],P0[4],P0[5],     pw0[0]=PKW(P0,0), pw0[1]=PKW(P0,2), pw0); \
    VRD(4); SBAR(); GAPA(C1=__builtin_amdgcn_mfma_f32_32x32x16_bf16(kf[1],qr[0],C1,0,0,0), P0[6],P0[7],P0[8],P0[9],     pw0[2]=PKW(P0,4), pw0[3]=PKW(P0,6), pw0); \
    VRD(1); SBAR(); GAPA(C0=__builtin_amdgcn_mfma_f32_32x32x16_bf16(kf[2],qr[1],C0,0,0,0),   P0[10],P0[11],P0[12],P0[13], pw1[0]=PKW(P0,8), pw1[1]=PKW(P0,10), pw1); \
    VRD(5); SBAR(); GAPA(C1=__builtin_amdgcn_mfma_f32_32x32x16_bf16(kf[3],qr[1],C1,0,0,0),   P0[14],P0[15],P1[0],P1[1],   pw1[2]=PKW(P0,12),pw1[3]=PKW(P0,14), pw1); \
    VRD(2); SBAR(); GAPA(C0=__builtin_amdgcn_mfma_f32_32x32x16_bf16(kf[4],qr[2],C0,0,0,0),   P1[2],P1[3],P1[4],P1[5],     pw2[0]=PKW(P1,0), pw2[1]=PKW(P1,2), pw2); \
    VRD(6); SBAR(); GAPA(C1=__builtin_amdgcn_mfma_f32_32x32x16_bf16(kf[5],qr[2],C1,0,0,0),   P1[6],P1[7],P1[8],P1[9],     pw2[2]=PKW(P1,4), pw2[3]=PKW(P1,6), pw2); \
    VRD(3); SBAR(); GAPA(C0=__builtin_amdgcn_mfma_f32_32x32x16_bf16(kf[6],qr[3],C0,0,0,0),   P1[10],P1[11],P1[12],P1[13], pw3[0]=PKW(P1,8), pw3[1]=PKW(P1,10), pw3); \
    VRD(7); SBAR(); GAPA(C1=__builtin_amdgcn_mfma_f32_32x32x16_bf16(kf[7],qr[3],C1,0,0,0),   P1[14],P1[15],0.f,0.f,       pw3[2]=PKW(P1,12),pw3[3]=PKW(P1,14), pw3); \
    l_reg+=sacc; \
    if(GK){DMA_K((t)+3,sl_cur);} if(GV){DMA_V((t)+1,sl_next);} \
    CMASK(C0,C1,t); \
    { float a=MX3(C0[0],C0[1],C1[0]),b=MX3(C0[2],C0[3],C1[1]); a=MX3(a,C1[2],C1[3]); \
      _Pragma("unroll") for(int r=4;r<16;r+=4){a=MX3(a,C0[r],C0[r+1]);b=MX3(b,C0[r+2],C0[r+3]);a=MX3(a,C1[r],C1[r+1]);b=MX3(b,C1[r+2],C1[r+3]);} \
      float rm=__builtin_fmaxf(a,b); { auto rr=__builtin_amdgcn_permlane32_swap(__float_as_uint(rm),__float_as_uint(rm),false,false); rm=__builtin_fmaxf(__uint_as_float(rr[0]),__uint_as_float(rr[1])); } \
      resc=false; \
      if(__builtin_expect(__any(rm>(float)THRL),0)){ const float old_=mhat; SETM(old_+__builtin_fmaxf(rm,0.f)); const float dl=mhat-old_; \
        _Pragma("unroll") for(int r=0;r<16;++r){C0[r]-=dl;C1[r]-=dl;} \
        const float f=__builtin_amdgcn_exp2f(-dl); l_reg*=f; if(hi==0)wsf[r32]=f; resc=true; } } \
    SBAR(); \
    GAPB(o[0]=__builtin_amdgcn_mfma_f32_32x32x16_bf16(PAF(0),VFR(0),o[0],0,0,0), C0,0); \
    GAPB(o[1]=__builtin_amdgcn_mfma_f32_32x32x16_bf16(PAF(0),VFR(4),o[1],0,0,0), C0,4); \
    KRD(GL,0); GAPB(o[0]=__builtin_amdgcn_mfma_f32_32x32x16_bf16(PAF(1),VFR(1),o[0],0,0,0), C0,8); \
    KRD(GL,1); GAPB(o[1]=__builtin_amdgcn_mfma_f32_32x32x16_bf16(PAF(1),VFR(5),o[1],0,0,0), C0,12); \
    KRD(GL,2); GAPB(o[0]=__builtin_amdgcn_mfma_f32_32x32x16_bf16(PAF(2),VFR(2),o[0],0,0,0), C1,0); \
    KRD(GL,3); GAPB(o[1]=__builtin_amdgcn_mfma_f32_32x32x16_bf16(PAF(2),VFR(6),o[1],0,0,0), C1,4); \
    GAPB(o[0]=__builtin_amdgcn_mfma_f32_32x32x16_bf16(PAF(3),VFR(3),o[0],0,0,0), C1,8); \
    GAPB(o[1]=__builtin_amdgcn_mfma_f32_32x32x16_bf16(PAF(3),VFR(7),o[1],0,0,0), C1,12); \
    }while(0)
  int t=1;
  #undef CMASK
  #define CMASK(P0,P1,t) do{}while(0)
  for(;t+5<NT;t+=2){
    STEP(pB0,pB1,pA0,pA1,t,true,true,true);     WAIT_BAR(2); RESC(); ROT();
    STEP(pA0,pA1,pB0,pB1,t+1,true,true,true);   WAIT_BAR(2); RESC(); ROT();
  }
  #undef CMASK
  #define CMASK(P0,P1,t) do{int jb_=(t)-(NT-4); if(jb_>=0)cmask(P0,P1,jb_,qrel,hi);}while(0)
  #define ENDW(tt) do{ if((tt)+3<NT){WAIT_BAR(2);} else if((tt)+2<NT){WAIT_BAR(1);} else {WAIT_BAR(0);} }while(0)
  for(;t+1<NT;t+=2){
    STEP(pB0,pB1,pA0,pA1,t,(t+3<NT),(t+1<NT),(t+1<NT));       ENDW(t);   RESC(); ROT();
    STEP(pA0,pA1,pB0,pB1,t+1,(t+4<NT),(t+2<NT),(t+2<NT));     ENDW(t+1); RESC(); ROT();
  }
  STEP(pB0,pB1,pA0,pA1,NT-1,false,false,false); RESC();
  { float sacc=pB0[0]+pB0[1]; _Pragma("unroll") for(int r=2;r<16;++r)sacc+=pB0[r]; _Pragma("unroll") for(int r=0;r<16;++r)sacc+=pB1[r]; l_reg+=sacc;
    pw0=(u32x4){PKW(pB0,0),PKW(pB0,2),PKW(pB0,4),PKW(pB0,6)};pw1=(u32x4){PKW(pB0,8),PKW(pB0,10),PKW(pB0,12),PKW(pB0,14)};pw2=(u32x4){PKW(pB1,0),PKW(pB1,2),PKW(pB1,4),PKW(pB1,6)};pw3=(u32x4){PKW(pB1,8),PKW(pB1,10),PKW(pB1,12),PKW(pB1,14)};
    SBAR(); pv(o,vb0+sl_cur,PAF(0),PAF(1),PAF(2),PAF(3)); }
  #undef PKW
  #undef PAF
  #undef VFR
  #undef PIN
  #undef MX3
  #undef GAPA
  #undef GAPB
  #undef EX
  #undef VRD
  #undef KRD
  #undef STEP
  #undef ENDW
  {auto rr=__builtin_amdgcn_permlane32_swap(__float_as_uint(l_reg),__float_as_uint(l_reg),false,false);l_reg=__uint_as_float(rr[0])+__uint_as_float(rr[1]);}
  if(hi==0)wsf[32+r32]=l_reg;asm volatile("s_waitcnt lgkmcnt(0)":::"memory");
  float rli[16];
  #pragma unroll
  for(int r=0;r<16;++r)rli[r]=__builtin_amdgcn_rcpf(wsf[32+crow(r,hi)]);
  bf16*Ow=O+(rowbase+q0+wid*QBLK)*(long)OPITCH+OCOL0+h*D;
  { bf16*stg=(bf16*)(shm+LDS_OST)+wid*2048;
    #pragma unroll
    for(int r=0;r<16;++r){const int orow=crow(r,hi);
      #pragma unroll
      for(int d0=0;d0<2;++d0)stg[orow*64+d0*32+r32]=__float2bfloat16(o[d0][r]*rli[r]);}
    asm volatile("s_waitcnt lgkmcnt(0)":::"memory");
    #pragma unroll
    for(int i=0;i<4;++i){const int row=i*8+(lane>>3),ch=lane&7; const u32x4 v=*(const u32x4*)(stg+row*64+ch*8); bf16*gp=Ow+(long)row*OPITCH+ch*8; const u32x4 gt=*(const u32x4*)gp; if(!dry){ATTN_STORE16(gp,mul_bf16x8(v,gt));}} }
  asm volatile("s_waitcnt lgkmcnt(0)\n\ts_barrier":::"memory");
  #undef DMA_K
  #undef DMA_V
  #undef CMASK
  #undef START
  #undef RESC
  #undef ROT
  #undef SETM
}
constexpr int ATTN_LDS_BYTES=LDS_BYTES;
#undef SBAR
#undef WAIT_BAR
}
constexpr int BATCH = 4, SEQ = 8192, DMODEL = 1024, M = BATCH * SEQ, DEPTH = 2, INC = 7852;
constexpr int NT_A = 19, NT_B = 12, NTILES = NT_A + NT_B;
constexpr int SA_Q = 0, SA_K = 512, SA_V = 640, SA_G = 768, SB_Q = 1280, SB_K = 1792, SB_V = 1920, SB_IQ = 2048, SB_IK = 2176, SB_IW = 2208, SB_G = 2212,
              SC_Q = 2724, SC_K = 3236, SC_V = 3748, SC_F = 4260, SC_G = 4268, S_MG = 4780;
static_assert(S_MG + 3072 == INC, "column partition");
__host__ __device__ __forceinline__ int src_col(int t, int lc) {
    switch (t) {
        case 0: case 1: return SA_Q + t * 256 + lc;
        case 2: case 3: return SB_Q + (t - 2) * 256 + lc;
        case 4: case 5: return SC_Q + (t - 4) * 256 + lc;
        case 6: return lc < 128 ? SA_K + lc : SB_K + lc - 128;
        case 7: case 8: return SC_K + (t - 7) * 256 + lc;
        case 9: return lc < 128 ? SA_V + lc : SB_V + lc - 128;
        case 10: case 11: return SC_V + (t - 10) * 256 + lc;
        case 12: case 13: return SA_G + (t - 12) * 256 + lc;
        case 14: case 15: return SB_G + (t - 14) * 256 + lc;
        case 16: case 17: return SC_G + (t - 16) * 256 + lc;
        case 18: return lc < 128 ? SB_IQ + lc : lc < 160 ? SB_IK + lc - 128 : lc < 164 ? SB_IW + lc - 160 : lc < 172 ? SC_F + lc - 164 : -1;
        default: return S_MG + (t - 19) * 256 + lc;
    }
}
constexpr size_t MiB = 1u << 20;
constexpr size_t WS_CTL = 0, CTL_ZERO_BYTES = 1 * MiB;
constexpr size_t WS_W1T = 2 * MiB;
constexpr size_t WS_WBT = 33 * MiB;
constexpr size_t WS_WOT = 39 * MiB;
constexpr size_t WS_SSQ = 43 * MiB;
constexpr size_t WS_CL = 45 * MiB;
constexpr size_t WS_CT = 46 * MiB;
constexpr size_t WS_IW = 47 * MiB;
constexpr size_t WS_CF = 47 * MiB + 512 * 1024;
constexpr size_t WS_IQ = 49 * MiB;
constexpr size_t WS_IK = 57 * MiB;
constexpr size_t WS_XB = 60 * MiB;
constexpr size_t WS_MERGED = 124 * MiB;
constexpr size_t WS_G = 188 * MiB;
constexpr size_t WS_QA = 284 * MiB, WS_QB = 316 * MiB, WS_QC = 348 * MiB, WS_KC = 380 * MiB, WS_VC = 412 * MiB, WS_KAB = 444 * MiB, WS_VAB = 460 * MiB;
constexpr size_t WS_END = 476 * MiB;
static_assert(pg8::EWS_CL == WS_CL && pg8::EWS_CT == WS_CT && pg8::EWS_SSQ == WS_SSQ && pg8::EWS_IW == WS_IW && pg8::EWS_CF == WS_CF && pg8::EWS_IQ == WS_IQ && pg8::EWS_IK == WS_IK && pg8::EWS_G == WS_G && pg8::EWS_QA == WS_QA && pg8::EWS_QB == WS_QB &&
              pg8::EWS_QC == WS_QC && pg8::EWS_KC == WS_KC && pg8::EWS_VC == WS_VC && pg8::EWS_KAB == WS_KAB && pg8::EWS_VAB == WS_VAB, "epilogue offsets");
constexpr int CW_OVF = 8;
constexpr int CW_TICK = 8192;
constexpr int CW_BAR = 4096;
constexpr int RING_OFF = 0, RING_BYTES = 131072;
constexpr int SEL_OFF = 131072;
constexpr int H2_OFF = SEL_OFF + 16384;
constexpr int TMISC_OFF = H2_OFF + 8192;
constexpr int BIAS_OFF = TMISC_OFF + 2048;
constexpr int BKT_OFF = BIAS_OFF + 2048;
constexpr int MISC_OFF = BKT_OFF + 512;
constexpr int LDS_BYTES = 163840;
static_assert(MISC_OFF + 1024 <= LDS_BYTES, "LDS map");
constexpr int NB_OFF = 86016;
static_assert(attn_body::ATTN_LDS_BYTES <= NB_OFF && NB_OFF + 32768 <= RING_BYTES, "LDS map");
constexpr int MW_NSEL = 0, MW_NCAND = 16, MW_BIN = 32, MW_ABOVE = 48, MW_CARRY = 64, MW_BAR = 96, MW_SLOW = 100, MW_TICKET = 101, MW_TBAR = 102, MW_LIVE = 104, MW_ZCUT = 112, MW_UC = 128, MW_ELO = 160;

#define GAS __attribute__((address_space(1)))
#define LAS __attribute__((address_space(3)))
typedef unsigned short bf16;
typedef unsigned v4u __attribute__((ext_vector_type(4)));
typedef float f32x4 __attribute__((ext_vector_type(4)));
typedef short bf16x8 __attribute__((ext_vector_type(8)));
typedef GAS unsigned gu32;
#define RLX_AGENT __ATOMIC_RELAXED, __HIP_MEMORY_SCOPE_AGENT
#define LDS_WAIT() asm volatile("s_waitcnt lgkmcnt(0)" ::: "memory")
#define VM_WAIT() asm volatile("s_waitcnt vmcnt(0)" ::: "memory")
__device__ __forceinline__ unsigned f2bf(float f) { unsigned u = __builtin_bit_cast(unsigned, f); return (u + 0x7fffu + ((u >> 16) & 1u)) >> 16; }
__device__ __forceinline__ unsigned pk2(float lo, float hi) { return f2bf(lo) | (f2bf(hi) << 16); }

#define XB_TMO      128
#define XB_XCNT(j)  (256  + 64 * (j))
#define XB_XSUB(j)  (1280 + 64 * (j))
#define XB_XGEN(j)  (2304 + 64 * (j))
#define XB_TOP      3328
#define XB_TOPGEN   3392
#define XCD_BAR_WORDS 3456
#define XB_SPIN_CAP (1u << 18)

__device__ __forceinline__ unsigned xb_ld(unsigned* p)              { return __hip_atomic_load(p, __ATOMIC_RELAXED, __HIP_MEMORY_SCOPE_AGENT); }
__device__ __forceinline__ unsigned xb_add(unsigned* p, unsigned v) { return __hip_atomic_fetch_add(p, v, __ATOMIC_RELAXED, __HIP_MEMORY_SCOPE_AGENT); }
__device__ __forceinline__ unsigned xb_xcc_id() { return (unsigned)__builtin_amdgcn_s_getreg((3 << 11) | 20) & 0xFu; }
#define XB_SPIN(cond, bar) do { unsigned _sp = 0; while (cond) { __builtin_amdgcn_s_sleep(1); \
    if ((++_sp & 255u) == 0u) { if (xb_ld(&(bar)[XB_TMO])) break; if (_sp > XB_SPIN_CAP) { atomicAdd(&(bar)[XB_TMO], 1u); break; } } } } while (0)

struct XcdBarrier {
    unsigned* bar; unsigned x;
    volatile LAS unsigned* st;
};

__device__ __forceinline__ XcdBarrier xcd_barrier_post(unsigned* bar, volatile LAS unsigned* st) {
    XcdBarrier b; b.bar = bar; b.x = xb_xcc_id(); b.st = st;
    if (threadIdx.x == 0) (void)xb_add(&bar[XB_XCNT(b.x)], 1u);
    return b;
}
__device__ __forceinline__ void xcd_barrier_complete(unsigned* bar, unsigned x, unsigned& nloc, unsigned& nx) {
    const unsigned G = gridDim.x * gridDim.y * gridDim.z;
    unsigned sum, cnt, mine, sp = 0u;
    for (;;) {
        sum = 0u; cnt = 0u; mine = 0u;
#pragma unroll
        for (unsigned j = 0; j < 16; ++j) { const unsigned c = xb_ld(&bar[XB_XCNT(j)]); sum += c; cnt += (c > 0u) ? 1u : 0u; mine = (j == x) ? c : mine; }
        if (sum == G) break;
        __builtin_amdgcn_s_sleep(1);
        if ((++sp & 255u) == 0u) { if (xb_ld(&bar[XB_TMO])) break; if (sp > XB_SPIN_CAP) { atomicAdd(&bar[XB_TMO], 1u); break; } }
    }
    nloc = mine > 0u ? mine : 1u; nx = cnt > 0u ? cnt : 1u;
}

__device__ __forceinline__ void xcd_barrier(const XcdBarrier& b) {
    asm volatile("s_waitcnt vmcnt(0)" ::: "memory");
    __syncthreads();
    if (threadIdx.x == 0) {
        unsigned* bar = b.bar;
        __builtin_amdgcn_s_waitcnt(0);
        unsigned nloc = b.st[0], nx = b.st[1];
        if (nloc == 0u) { xcd_barrier_complete(bar, b.x, nloc, nx); b.st[0] = nloc; b.st[1] = nx; }
        const unsigned old = xb_add(&bar[XB_XSUB(b.x)], 1u);
        const unsigned gen = old / nloc;
        if (old + 1u == (gen + 1u) * nloc) {
            __builtin_amdgcn_fence(__ATOMIC_RELEASE, "agent");
            asm volatile("s_waitcnt vmcnt(0)" ::: "memory");
            const unsigned og = xb_add(&bar[XB_TOP], 1u);
            const unsigned tg = og / nx;
            if (og + 1u == (tg + 1u) * nx) xb_add(&bar[XB_TOPGEN], 1u);
            else XB_SPIN(xb_ld(&bar[XB_TOPGEN]) == tg, bar);
            __builtin_amdgcn_fence(__ATOMIC_ACQUIRE, "agent");
            xb_add(&bar[XB_XGEN(b.x)], 1u);
            asm volatile("s_waitcnt vmcnt(0)" ::: "memory");
        } else {
            XB_SPIN(xb_ld(&bar[XB_XGEN(b.x)]) == gen, bar);
            __builtin_amdgcn_fence(__ATOMIC_ACQUIRE, "agent");
            asm volatile("s_waitcnt vmcnt(0)" ::: "memory");
        }
    }
    __syncthreads();
}

struct Frame {
    LAS unsigned char* lds;
    volatile LAS unsigned* MISC;
    gu32* ctl;
    int tid, lane, wave, vcu, G;
    LAS unsigned char *ring, *selp, *h2p, *miscp; int wt; unsigned tgen;
};
__device__ __forceinline__ float wave_sum(float v) {
#pragma unroll
    for (int o = 1; o < 64; o <<= 1) v += __shfl_xor(v, o);
    return v;
}
__device__ __forceinline__ float wave_incl_scan(float v, int lane) {
#pragma unroll
    for (int o = 1; o < 64; o <<= 1) { const float t = __shfl_up(v, o); if (lane >= o) v += t; }
    return v;
}
__device__ __forceinline__ int wave_incl_scan_i(int v, int lane) {
#pragma unroll
    for (int o = 1; o < 64; o <<= 1) { const int t = __shfl_up(v, o); if (lane >= o) v += t; }
    return v;
}
__device__ __forceinline__ void transpose_item(const float* W, int N, bf16* WT, int K, int n0, int k0, int scol, const float* kscale, LAS float* scr, int lane) {
    float tv[32];
#pragma unroll
    for (int i = 0; i < 32; ++i) { const int kk = 2 * i + (lane >> 5); tv[i] = scol >= 0 ? W[(size_t)(k0 + kk) * N + scol] : 0.f; }
#pragma unroll
    for (int i = 0; i < 32; ++i) { const int kk = 2 * i + (lane >> 5); float v = tv[i]; if (scol >= 0 && kscale) v *= kscale[k0 + kk];
        scr[kk * 33 + (lane & 31)] = v; }
    LDS_WAIT(); asm volatile("" ::: "memory");
    const int c = lane & 7;
#pragma unroll
    for (int j = 0; j < 4; ++j) { const int n = (lane >> 3) + 8 * j; const LAS float* s = scr + (8 * c) * 33 + n;
        v4u o; o.x = pk2(s[0 * 33], s[1 * 33]); o.y = pk2(s[2 * 33], s[3 * 33]); o.z = pk2(s[4 * 33], s[5 * 33]); o.w = pk2(s[6 * 33], s[7 * 33]);
        *(GAS v4u*)(WT + (size_t)(n0 + n) * K + k0 + 8 * c) = o; }
    LDS_WAIT(); asm volatile("" ::: "memory");
}
__device__ __forceinline__ void p0_weights(Frame& F, int L, int part, int gw, int NGW, const float* norm_gain, const float* w_in, const float* w_branch, const float* w_out, unsigned char* ws) {
    LAS float* scr = (LAS float*)(F.lds + RING_OFF + F.wave * 16384);
    const int lane = F.lane;
    constexpr int I_W1 = 16 * (NTILES * 256 / 32), I_WB = 8 * 32, I_WO = 16 * 32;
    constexpr int NITEMS = I_W1 + 3 * I_WB + I_WO;
    const int it_lo = part == 1 ? I_W1 : 0, it_hi = part == 0 ? I_W1 : NITEMS;
    for (int it = it_lo + gw; it < it_hi; it += NGW) {
        int r = it;
        if (r < I_W1) { const int nblk = NTILES * 8, kb = r / nblk, nb = r % nblk, n0 = nb * 32, tile = n0 >> 8, p = (n0 & 255) + (lane & 31);
            const int lc = 64 * ((p >> 5) & 3) + 32 * (p >> 7) + (p & 31);
            transpose_item(w_in + (size_t)L * DMODEL * INC, INC, (bf16*)(ws + WS_W1T) + (size_t)L * NTILES * 256 * 1024, 1024, n0, kb * 64, src_col(tile, lc), norm_gain + L * DMODEL, scr, lane); continue; }
        r -= I_W1;
        if (r < 3 * I_WB) { const int mat = 3 * L + r / I_WB; r %= I_WB; const int kb = r / 32, nb = r % 32;
            transpose_item(w_branch + (size_t)mat * 512 * 1024, 1024, (bf16*)(ws + WS_WBT) + (size_t)mat * 1024 * 512, 512, nb * 32, kb * 64, nb * 32 + (lane & 31), nullptr, scr, lane); continue; }
        r -= 3 * I_WB;
        { const int kb = r / 32, nb = r % 32;
            transpose_item(w_out + (size_t)L * 1024 * 1024, 1024, (bf16*)(ws + WS_WOT) + (size_t)L * 1024 * 1024, 1024, nb * 32, kb * 64, nb * 32 + (lane & 31), nullptr, scr, lane); }
    }
}
__device__ __forceinline__ void p0_prologue(Frame& F, const float* x, const float* norm_gain, const float* w_in, const float* w_branch, const float* w_out, unsigned char* ws) {
    const int gw = F.vcu * 8 + F.wave, NGW = F.G * 8, lane = F.lane;
#pragma unroll 1
    for (int half = 0; half < 2; ++half) {
    if ((half == 0) == ((F.wave & 1) == 0)) { p0_weights(F, 0, 2, gw, NGW, norm_gain, w_in, w_branch, w_out, ws); continue; }
    bf16* XB = (bf16*)(ws + WS_XB); float* SSQ = (float*)(ws + WS_SSQ);
    for (int m0 = gw; m0 < M; m0 += 4 * NGW) {
        f32x4 v[4][4]; float s[4];
#pragma unroll
        for (int q = 0; q < 4; ++q) { const int m = m0 + q * NGW < M ? m0 + q * NGW : m0; const GAS f32x4* xr = (const GAS f32x4*)(x + (size_t)m * DMODEL) + lane;
#pragma unroll
            for (int j = 0; j < 4; ++j) v[q][j] = xr[64 * j]; }
#pragma unroll
        for (int q = 0; q < 4; ++q) { s[q] = 0.f;
#pragma unroll
            for (int j = 0; j < 4; ++j) s[q] += (v[q][j].x * v[q][j].x + v[q][j].y * v[q][j].y) + (v[q][j].z * v[q][j].z + v[q][j].w * v[q][j].w); }
#pragma unroll
        for (int o = 1; o < 64; o <<= 1)
#pragma unroll
            for (int q = 0; q < 4; ++q) s[q] += __shfl_xor(s[q], o);
#pragma unroll
        for (int q = 0; q < 4; ++q) { const int m = m0 + q * NGW; if (m < M) {
            GAS unsigned long long* o8 = (GAS unsigned long long*)(XB + (size_t)m * DMODEL) + lane;
#pragma unroll
            for (int j = 0; j < 4; ++j) o8[64 * j] = (unsigned long long)pk2(v[q][j].x, v[q][j].y) | ((unsigned long long)pk2(v[q][j].z, v[q][j].w) << 32);
            if (lane < 16) SSQ[(size_t)m * 16 + lane] = lane == 0 ? s[q] : 0.f; } }
    }
    }
}
__device__ __forceinline__ void scan_phase(Frame& F, const float* CF, const float* bforget  , float* CL, float* CT) {
    const int lane = F.lane, h = F.wave;
    for (int u = blockIdx.x; u < 128; u += F.G) { const int b = u >> 5, j = u & 31; const size_t row = (size_t)b * SEQ + 256 * j + 4 * lane; const float bf = bforget[h];
        float s[4]; float run = 0.f;
#pragma unroll
        for (int e = 0; e < 4; ++e) { const float xx = CF[(row + e) * 8 + h] + bf; const float lf = (xx < 0.f ? xx : 0.f) - __logf(1.0f + __expf(-fabsf(xx))); run += lf; s[e] = run; }
        const float incl = wave_incl_scan(run, lane), excl = incl - run;
        *(f32x4*)(CL + (size_t)(b * 8 + h) * SEQ + 256 * j + 4 * lane) = (f32x4){excl + s[0], excl + s[1], excl + s[2], excl + s[3]};
        if (lane == 63) CT[(b * 8 + h) * 32 + j] = incl;
    }
}
#ifndef SPB_IDEAL
#define SPB_IDEAL 0
#endif
#ifndef REP_P2RS
#define REP_P2RS 1
#endif
#ifndef REP_TH
#define REP_TH 1
#endif
#ifndef REP_P2
#define REP_P2 1
#endif
#ifndef REP_RS
#define REP_RS 1
#endif
#ifndef REP_IDX
#define REP_IDX 1
#endif
#ifndef REP_SPB
#define REP_SPB 1
#endif
#ifndef REP_SPA
#define REP_SPA 1
#endif
typedef unsigned u32x2 __attribute__((ext_vector_type(2)));
constexpr int NBIN = 1024;
__device__ __forceinline__ float pdist(float s, float c0, float inv) { return fmaf(s, inv, c0); }
__device__ __forceinline__ unsigned bitop_xa(unsigned a, unsigned mask, unsigned c) { unsigned r; asm("v_bitop3_b32 %0, %1, %2, %3 bitop3:0x48" : "=v"(r) : "v"(a), "s"(mask), "v"(c)); return r; }
__device__ __forceinline__ unsigned pbin4_d(float d) { const unsigned du = __float_as_uint(d);
    unsigned e4 = __builtin_amdgcn_ubfe(du, 17u, 14u); e4 = e4 < 6144u ? 6144u : (e4 > 8191u ? 8191u : e4);
    unsigned b4 = (e4 ^ (unsigned)((int)du >> 31)) & 4092u; asm("" : "+v"(b4)); return b4; }
__device__ __forceinline__ unsigned pbin_d(float d) { return pbin4_d(d) >> 2; }
__device__ __forceinline__ unsigned pbin(float s, float sc, float inv) { return pbin_d(pdist(s, sc, inv)); }
__device__ __forceinline__ float pedge(int b) {
    if (b >= NBIN) return INFINITY; if (b <= 0) return -INFINITY;
    if (b > 512) return __uint_as_float((unsigned)(b - 512 + 1536) << 19);
    if (b == 512) return 0.0f;
    return -__uint_as_float(((unsigned)(511 - b + 1537) << 19) - 1u);
}
#ifndef CFALL
#define CFALL CMAX
#endif
constexpr int NW = 4;
constexpr int QBLK = 4096, CMAX = 512;
#define LDS_ADD(p, v) __hip_atomic_fetch_add((p), (v), __ATOMIC_RELAXED, __HIP_MEMORY_SCOPE_WORKGROUP)
__device__ __forceinline__ unsigned okey(float s) { const unsigned u = __float_as_uint(s); return (u & 0x80000000u) ? ~u : (u | 0x80000000u); }
struct BAParams { const bf16 *IQ, *IK; const float* IW; const bf16 *QA, *QB, *KAB, *VAB; bf16* G; const float* sinks; };
__device__ __forceinline__ void team_barrier(Frame& F) {
    asm volatile("s_waitcnt lgkmcnt(0)" ::: "memory");
    LAS unsigned* cnt = (LAS unsigned*)F.miscp + MW_TBAR; F.tgen += (unsigned)NW;
    if (F.lane == 0) __hip_atomic_fetch_add(cnt, 1u, __ATOMIC_RELAXED, __HIP_MEMORY_SCOPE_WORKGROUP);
    for (;;) { const unsigned v = (unsigned)__builtin_amdgcn_readfirstlane((int)*(volatile LAS unsigned*)cnt); if ((int)(v - F.tgen) >= 0) break; __builtin_amdgcn_s_sleep(1); }
    asm volatile("" ::: "memory");
}
typedef float f32x2 __attribute__((ext_vector_type(2)));
typedef int i32x2 __attribute__((ext_vector_type(2)));
__device__ __forceinline__ f32x2 relu2(float a, float b) { i32x2 v = {__float_as_int(a), __float_as_int(b)}; v = __builtin_elementwise_max(v, (i32x2){0, 0}); return __builtin_bit_cast(f32x2, v); }
__device__ __forceinline__ float relu_f(float x) { const int i = __float_as_int(x); return __int_as_float(i > 0 ? i : 0); }

template <int PASS, bool DIAG> __device__ __forceinline__ void idx_tile(const bf16x8 ak, const bf16x8 (&bq)[4], const f32x4 w4, int kt, int g4, int tq, float elo, float ehi, float zsent,
                                                                       unsigned lp4, unsigned hmask, unsigned hinc, LAS unsigned* zh, float sc, float inv, unsigned& accS, unsigned& accC) {
    const f32x4 z = {0.f, 0.f, 0.f, 0.f};
    const f32x4 d0 = __builtin_amdgcn_mfma_f32_16x16x32_bf16(ak, bq[0], z, 0, 0, 0), d1 = __builtin_amdgcn_mfma_f32_16x16x32_bf16(ak, bq[1], z, 0, 0, 0),
                d2 = __builtin_amdgcn_mfma_f32_16x16x32_bf16(ak, bq[2], z, 0, 0, 0), d3 = __builtin_amdgcn_mfma_f32_16x16x32_bf16(ak, bq[3], z, 0, 0, 0);
    float sv[4], dv[4]; unsigned nz = 0;
#pragma unroll
    for (int p2 = 0; p2 < 2; ++p2) { const f32x2 zero2 = {0.f, 0.f};
        f32x2 s2 = __builtin_elementwise_fma((f32x2){w4[0], w4[0]}, relu2(d0[2 * p2], d0[2 * p2 + 1]), zero2);
        s2 = __builtin_elementwise_fma((f32x2){w4[1], w4[1]}, relu2(d1[2 * p2], d1[2 * p2 + 1]), s2);
        s2 = __builtin_elementwise_fma((f32x2){w4[2], w4[2]}, relu2(d2[2 * p2], d2[2 * p2 + 1]), s2);
        s2 = __builtin_elementwise_fma((f32x2){w4[3], w4[3]}, relu2(d3[2 * p2], d3[2 * p2 + 1]), s2);
        const f32x2 dd = __builtin_elementwise_fma(s2, (f32x2){inv, inv}, (f32x2){sc, sc});
        sv[2 * p2] = s2[0]; sv[2 * p2 + 1] = s2[1]; dv[2 * p2] = dd[0]; dv[2 * p2 + 1] = dd[1]; }
    if (PASS == 1) {
#pragma unroll
        for (int i = 0; i < 4; ++i) { const float s = sv[i], d = dv[i];
            const int key = 16 * kt + 4 * g4 + i; const bool ok = !DIAG || key <= tq;
            if (ok) { const unsigned b4 = pbin4_d(d); LDS_ADD((LAS unsigned*)(uintptr_t)((b4 << 4) + ((b4 ^ lp4) & hmask)), hinc);
                      if (DIAG) nz += (s == 0.0f) ? 1u : 0u; } }
        if (!DIAG) { unsigned long long t0_, t1_, t2_;
            asm volatile("v_cmp_eq_f32 vcc, 0, %[s0]\n\tv_cmp_eq_f32 %[t0], 0, %[s1]\n\tv_cmp_eq_f32 %[t1], 0, %[s2]\n\tv_cmp_eq_f32 %[t2], 0, %[s3]\n\t"
                         "v_addc_co_u32 %[nz], vcc, 0, %[nz], vcc\n\tv_addc_co_u32 %[nz], %[t0], 0, %[nz], %[t0]\n\tv_addc_co_u32 %[nz], %[t1], 0, %[nz], %[t1]\n\tv_addc_co_u32 %[nz], %[t2], 0, %[nz], %[t2]"
                         : [nz] "+v"(nz), [t0] "=&s"(t0_), [t1] "=&s"(t1_), [t2] "=&s"(t2_) : [s0] "v"(sv[0]), [s1] "v"(sv[1]), [s2] "v"(sv[2]), [s3] "v"(sv[3]) : "vcc"); }
        if (nz) LDS_ADD(zh + (kt >> 3), nz);
    } else if (DIAG) {
#pragma unroll
        for (int i = 3; i >= 0; --i) { const int key = 16 * kt + 4 * g4 + i; const bool ok = key <= tq;
            accS = 2u * accS + ((ok && dv[i] >= ehi) ? 1u : 0u); accC = 2u * accC + ((ok && dv[i] >= elo && sv[i] != zsent) ? 1u : 0u); }
    } else {
        unsigned long long t0_, t1_;
#define IDX_FL(D_, S_) "v_cmp_ge_f32 vcc, %[" #D_ "], %[ehi]\n\tv_cmp_ge_f32 %[t0], %[" #D_ "], %[elo]\n\tv_cmp_neq_f32 %[t1], %[" #S_ "], %[zs]\n\tv_addc_co_u32 %[as], vcc, %[as], %[as], vcc\n\ts_and_b64 %[t0], %[t0], %[t1]\n\tv_addc_co_u32 %[ac], %[t1], %[ac], %[ac], %[t0]\n\t"
        asm volatile(IDX_FL(d3, s3) IDX_FL(d2, s2) IDX_FL(d1, s1) IDX_FL(d0, s0)
                     : [as] "+v"(accS), [ac] "+v"(accC), [t0] "=&s"(t0_), [t1] "=&s"(t1_)
                     : [d0] "v"(dv[0]), [d1] "v"(dv[1]), [d2] "v"(dv[2]), [d3] "v"(dv[3]), [s0] "v"(sv[0]), [s1] "v"(sv[1]), [s2] "v"(sv[2]), [s3] "v"(sv[3]), [ehi] "v"(ehi), [elo] "v"(elo), [zs] "v"(zsent) : "vcc", "scc");
#undef IDX_FL
    }
}
template <int PASS> __device__ __forceinline__ void idx_pass(Frame& F, const bf16* IKb, const bf16x8 (&bq)[4], const f32x4 w4, int tau, int t0) {
    int lane_ = F.lane; asm volatile("" : "+v"(lane_)); const int lane = lane_, r = lane & 15, g4 = lane >> 4, tq = t0 + r;
    const unsigned hbase = (unsigned)(uintptr_t)F.ring, hmask = 60u | hbase, lp = ((((unsigned)lane >> 1) & 15u) * 4u) | hbase, hinc = 1u << ((lane & 1) * 16);
    LAS unsigned* misc = (LAS unsigned*)(F.miscp);
    float elo = 0.f, ehi = 0.f; int zcut = SEQ; if (PASS == 2) { elo = __uint_as_float(misc[MW_ELO + r]); ehi = __uint_as_float(misc[MW_ELO + 16 + r]); zcut = (int)misc[MW_ZCUT + r]; }
    LAS unsigned* zh = (LAS unsigned*)(F.h2p) + r * 64;
    LAS unsigned* bw = (LAS unsigned*)(F.ring + r * QBLK) + F.wt * 4 + g4;
    const bf16* kp = IKb + (size_t)r * 32 + 8 * g4;
    constexpr int NPF = 8;
    bf16x8 at0 = {0, 0, 0, 0, 0, 0, 0, 0}; if (PASS == 1) at0 = *(const bf16x8*)kp;
    bf16x8 A[NPF];
#pragma unroll
    for (int j = 0; j < NPF; ++j) { const int kj = F.wt + NW * j; A[j] = *(const bf16x8*)(kp + (size_t)(kj < tau ? kj : tau) * 512); }
    asm volatile("" ::: "memory");
    float sc, inv;
    if (PASS == 2) { sc = __uint_as_float(misc[MW_UC + r]); inv = __uint_as_float(misc[MW_UC + 16 + r]); }
    else { const bf16x8 at = at0; const f32x4 z = {0.f, 0.f, 0.f, 0.f};
        const f32x4 d0 = __builtin_amdgcn_mfma_f32_16x16x32_bf16(at, bq[0], z, 0, 0, 0), d1 = __builtin_amdgcn_mfma_f32_16x16x32_bf16(at, bq[1], z, 0, 0, 0),
                    d2 = __builtin_amdgcn_mfma_f32_16x16x32_bf16(at, bq[2], z, 0, 0, 0), d3 = __builtin_amdgcn_mfma_f32_16x16x32_bf16(at, bq[3], z, 0, 0, 0);
        float mx = -INFINITY, ma = 0.f;
#pragma unroll
        for (int i = 0; i < 4; ++i) { float s = 0.f; s = fmaf(w4[0], relu_f(d0[i]), s); s = fmaf(w4[1], relu_f(d1[i]), s); s = fmaf(w4[2], relu_f(d2[i]), s); s = fmaf(w4[3], relu_f(d3[i]), s); mx = fmaxf(mx, s); ma = fmaxf(ma, fabsf(s)); }
        mx = fmaxf(mx, __shfl_xor(mx, 16)); mx = fmaxf(mx, __shfl_xor(mx, 32)); ma = fmaxf(ma, __shfl_xor(ma, 16)); ma = fmaxf(ma, __shfl_xor(ma, 32));
        inv = (ma > 1e-30f && ma < 1e30f) ? __builtin_amdgcn_rcpf(ma) * 0.0078125f : 0.0078125f; sc = -(mx * inv);
        if (PASS == 1 && F.wt == 0 && g4 == 0) { misc[MW_UC + r] = __float_as_uint(sc); misc[MW_UC + 16 + r] = __float_as_uint(inv); } }
    unsigned accS = 0u, accC = 0u; int n = 0;
    int kt = F.wt;
    static_assert(NPF == 8, "a full round of the loop below is one bitmap word (8 tiles) per lane");
#pragma unroll 1
    for (; kt + NW * (NPF - 1) < tau; kt += NW * NPF) {
#pragma unroll
        for (int j = 0; j < NPF; ++j) { const int kj = kt + NW * j;
            const float zsent = (PASS == 2 && 16 * kj < zcut) ? __uint_as_float(0x7fc00000u) : 0.0f;
            idx_tile<PASS, false>(A[j], bq, w4, kj, g4, tq, elo, ehi, zsent, lp, hmask, hinc, zh, sc, inv, accS, accC);
            const int kn = kj + NW * NPF; A[j] = *(const bf16x8*)(kp + (size_t)(kn < tau ? kn : tau) * 512); }
        if (PASS == 2) { LAS unsigned* wp = bw + n * (NW / 2); wp[0] = accS; wp[256] = accC; accS = 0u; accC = 0u; n += 8; }
    }
#pragma unroll 1
    for (; kt < tau; kt += NW * NPF) {
#pragma unroll
        for (int j = 0; j < NPF; ++j) { const int kj = kt + NW * j;
            if (kj < tau) {
                const float zsent = (PASS == 2 && 16 * kj < zcut) ? __uint_as_float(0x7fc00000u) : 0.0f;
                idx_tile<PASS, false>(A[j], bq, w4, kj, g4, tq, elo, ehi, zsent, lp, hmask, hinc, zh, sc, inv, accS, accC);
                if (PASS == 2) { ++n; if ((n & 7) == 0) { LAS unsigned* wp = bw + (n - 8) * (NW / 2); wp[0] = accS; wp[256] = accC; accS = 0u; accC = 0u; } }
            }
            const int kn = kj + NW * NPF; A[j] = *(const bf16x8*)(kp + (size_t)(kn < tau ? kn : tau) * 512); }
    }
    if ((tau & (NW - 1)) == F.wt) {
        const bf16x8 ad = *(const bf16x8*)(kp + (size_t)tau * 512);
        const float zsent = (PASS == 2 && 16 * tau < zcut) ? __uint_as_float(0x7fc00000u) : 0.0f;
        idx_tile<PASS, true>(ad, bq, w4, tau, g4, tq, elo, ehi, zsent, lp, hmask, hinc, zh, sc, inv, accS, accC);
        if (PASS == 2) { ++n; if ((n & 7) == 0) { LAS unsigned* wp = bw + (n - 8) * (NW / 2); wp[0] = accS; wp[256] = accC; accS = 0u; accC = 0u; } }
    }
    if (PASS == 2 && (n & 7)) { const int sh = 4 * (8 - (n & 7)); LAS unsigned* wp = bw + (n & ~7) * (NW / 2); wp[0] = accS << sh; wp[256] = accC << sh; }
}
struct ThrRes { int Ls, bs, above; unsigned zcut; };
__device__ __forceinline__ ThrRes idx_thr_one(Frame& F, int q, int lane, const LAS unsigned* misc) {
    const unsigned sh = (q & 1) * 16, qh = (unsigned)q >> 1;
    const LAS unsigned* hb = (const LAS unsigned*)(F.ring);
    int cnt[16];
#pragma unroll
    for (int k = 0; k < 16; ++k) { const unsigned bin = 64u * k + lane, sw = bin & 15u; const LAS unsigned* p = hb + bin * 16u;
        cnt[k] = (int)(((p[qh ^ sw] >> sh) & 0xffffu) + ((p[(qh + 8u) ^ sw] >> sh) & 0xffffu)); }
    int a8[8], a4[4], a2[2], a1;
    { const bool h5 = lane & 32, h4 = lane & 16, h3 = lane & 8, h2 = lane & 4;
#pragma unroll
      for (int i = 0; i < 8; ++i) { const int mine = h5 ? cnt[8 + i] : cnt[i], theirs = h5 ? cnt[i] : cnt[8 + i]; a8[i] = mine + __shfl_xor(theirs, 32); }
#pragma unroll
      for (int i = 0; i < 4; ++i) { const int mine = h4 ? a8[4 + i] : a8[i], theirs = h4 ? a8[i] : a8[4 + i]; a4[i] = mine + __shfl_xor(theirs, 16); }
#pragma unroll
      for (int i = 0; i < 2; ++i) { const int mine = h3 ? a4[2 + i] : a4[i], theirs = h3 ? a4[i] : a4[2 + i]; a2[i] = mine + __shfl_xor(theirs, 8); }
      { const int mine = h2 ? a2[1] : a2[0], theirs = h2 ? a2[0] : a2[1]; a1 = mine + __shfl_xor(theirs, 4); }
      a1 += __shfl_xor(a1, 1); a1 += __shfl_xor(a1, 2); }
    int ks = 0, aseg = 0, v = cnt[0]; { int cum = 0; bool found = false;
#pragma unroll
        for (int k = 15; k >= 0; --k) { const int Tk = __builtin_amdgcn_readlane(a1, 4 * k); if (!found && cum + Tk >= 256) { found = true; ks = k; aseg = cum; v = cnt[k]; } cum += Tk; } }
    const int pre = wave_incl_scan_i(v, lane);
    int tot = pre; tot = __shfl(tot, 63);
    const int suf = tot - pre + v;
    const unsigned long long mask = __ballot(aseg + suf >= 256);
    const int Ls = mask ? 63 - (int)__builtin_clzll(mask) : 0;
    const int binstar = __shfl(64 * ks + lane, Ls), above = __shfl(aseg + suf - v, Ls), needz = 256 - above;
    const int zc = (int)((const LAS unsigned*)(F.h2p))[q * 64 + lane]; const int zi = wave_incl_scan_i(zc, lane);
    const unsigned long long zm = __ballot(zi >= needz);
    ThrRes R; R.Ls = Ls; R.bs = binstar; R.above = above;
    R.zcut = (binstar == (int)pbin(0.0f, __uint_as_float(misc[MW_UC + q]), __uint_as_float(misc[MW_UC + 16 + q])) && zm) ? (unsigned)(128 * ((int)__builtin_ctzll(zm) + 1)) : (unsigned)SEQ;
    return R;
}
__device__ __forceinline__ void idx_threshold(Frame& F) {
    int lane_ = F.lane; asm volatile("" : "+v"(lane_)); const int lane = lane_; LAS unsigned* misc = (LAS unsigned*)(F.miscp);
    const int q0 = NW * F.wt;
    const ThrRes R0 = idx_thr_one(F, q0, lane, misc), R1 = idx_thr_one(F, q0 + 1, lane, misc), R2 = idx_thr_one(F, q0 + 2, lane, misc), R3 = idx_thr_one(F, q0 + 3, lane, misc);
    if (lane < 4) { const ThrRes R = lane == 0 ? R0 : (lane == 1 ? R1 : (lane == 2 ? R2 : R3)); const int q = q0 + lane;
        misc[MW_BIN + q] = (unsigned)R.bs; misc[MW_ABOVE + q] = (unsigned)R.above; misc[MW_ZCUT + q] = R.zcut;
        misc[MW_ELO + q] = __float_as_uint(pedge(R.bs)); misc[MW_ELO + 16 + q] = __float_as_uint(pedge(R.bs + 1)); }
}
__device__ __forceinline__ unsigned idx_digit(const u32x2 e, int lvl) { const unsigned v = 8191u - e.y;
    return lvl == 0 ? e.x >> 24 : lvl == 1 ? (e.x >> 16) & 255u : lvl == 2 ? (e.x >> 8) & 255u : lvl == 3 ? e.x & 255u : lvl == 4 ? (v >> 5) & 255u : v & 31u; }
#define IDX_EXPAND(W4_, POS_, EMIT_) do { const int kb_ = 512 * (lane >> 4) + 16 * ((lane >> 2) & 3) + 4 * (lane & 3); \
    _Pragma("unroll") for (int g_ = 0; g_ < 4; ++g_) { unsigned w_ = (W4_)[g_]; \
        while (w_) { const int b_ = (int)__builtin_ctz(w_); w_ &= w_ - 1u; const int key_ = kb_ + 2048 * g_ + 64 * (7 - (b_ >> 2)) + (b_ & 3); EMIT_(POS_, key_); ++POS_; } } } while (0)
__device__ __forceinline__ void idx_rescore(const LAS unsigned* keyp, int kstr, LAS unsigned* outp, int ostr, int n, int q, int lane, const bf16* IKb, const bf16x8 (&bq)[4], const f32x4 w4) {
    const int r = lane & 15, g4 = lane >> 4; bf16x8 ak[4];
#pragma unroll
    for (int u = 0; u < 4; ++u) { const int ci = 16 * u + r; const unsigned key = ci < n ? keyp[ci * kstr] : 0u; ak[u] = *(const bf16x8*)(IKb + (size_t)key * 32 + 8 * g4); }
#pragma unroll
    for (int u = 0; u < 4; ++u) { if (16 * u < n) { const f32x4 z = {0.f, 0.f, 0.f, 0.f};
        const f32x4 d0 = __builtin_amdgcn_mfma_f32_16x16x32_bf16(ak[u], bq[0], z, 0, 0, 0), d1 = __builtin_amdgcn_mfma_f32_16x16x32_bf16(ak[u], bq[1], z, 0, 0, 0),
                    d2 = __builtin_amdgcn_mfma_f32_16x16x32_bf16(ak[u], bq[2], z, 0, 0, 0), d3 = __builtin_amdgcn_mfma_f32_16x16x32_bf16(ak[u], bq[3], z, 0, 0, 0);
#pragma unroll
        for (int i = 0; i < 4; ++i) { float sx = 0.f; sx = fmaf(w4[0], relu_f(d0[i]), sx); sx = fmaf(w4[1], relu_f(d1[i]), sx); sx = fmaf(w4[2], relu_f(d2[i]), sx); sx = fmaf(w4[3], relu_f(d3[i]), sx);
            const int ci = 16 * u + 4 * g4 + i; if (r == q && ci < n) outp[ci * ostr] = okey(sx); } } }
}
__device__ __forceinline__ void idx_pick_digit(const LAS unsigned* h2, int need, int lane, unsigned& dstar, int& above, int& inside) {
    const v4u hw = *(const LAS v4u*)(h2 + 252 - 4 * lane);
    const int total = (int)(hw.x + hw.y + hw.z + hw.w), incl = wave_incl_scan_i(total, lane);
    const unsigned long long mask = __ballot(incl >= need);
    const int Ls = mask ? (int)__builtin_ctzll(mask) : 63;
    int dstar_l = 0, above_l = 0, in_l = 0; { int cum = incl - total; bool found = false;
#pragma unroll
        for (int e = 3; e >= 0; --e) { const int cc = (int)hw[e]; if (!found && cum + cc >= need) { found = true; dstar_l = 252 - 4 * lane + e; above_l = cum; in_l = cc; } cum += cc; } }
    dstar = (unsigned)__shfl(dstar_l, Ls); above = __shfl(above_l, Ls); inside = __shfl(in_l, Ls);
}
template <int MODE> __device__ __forceinline__ void idx_sweep(int lvl, unsigned dstar, v4u& wc, LAS unsigned* stg, LAS unsigned* h2, LAS unsigned* nselp, LAS unsigned short* sel,
                                                              int q, int lane, const bf16* IKb, const bf16x8 (&bq)[4], const f32x4 w4) {
    v4u w = wc; const int kb = 512 * (lane >> 4) + 16 * ((lane >> 2) & 3) + 4 * (lane & 3);
    while (__ballot((w.x | w.y | w.z | w.w) != 0u)) {
        const bool has = (w.x | w.y | w.z | w.w) != 0u;
        const int g = w.x ? 0 : (w.y ? 1 : (w.z ? 2 : 3));
        const unsigned cur = w.x ? w.x : (w.y ? w.y : (w.z ? w.z : w.w));
        const int b = has ? (int)__builtin_ctz(cur) : 0; const unsigned bit = has ? (1u << b) : 0u;
        const int key = has ? kb + 2048 * g + 64 * (7 - (b >> 2)) + (b & 3) : 0;
        stg[lane] = (unsigned)key;
        idx_rescore(stg, 1, stg + 64, 1, 64, q, lane, IKb, bq, w4);
        const u32x2 e = {stg[64 + lane], (unsigned)key}; const unsigned dg = idx_digit(e, lvl);
        if (has) {
            if (MODE == 0) LDS_ADD(h2 + dg, 1u);
            else { if (dg > dstar) { const unsigned pos = LDS_ADD(nselp, 1u); if (pos < 256u) sel[pos] = (unsigned short)key; }
                   if (dg != dstar) { wc.x &= g == 0 ? ~bit : ~0u; wc.y &= g == 1 ? ~bit : ~0u; wc.z &= g == 2 ? ~bit : ~0u; wc.w &= g == 3 ? ~bit : ~0u; } }
        }
        w.x &= g == 0 ? ~bit : ~0u; w.y &= g == 1 ? ~bit : ~0u; w.z &= g == 2 ? ~bit : ~0u; w.w &= g == 3 ? ~bit : ~0u;
    }
}
__device__ __forceinline__ void idx_resolve(Frame& F, const bf16* IKb, const bf16x8 (&bq)[4], const f32x4 w4, int tau) {
    int lane_ = F.lane; asm volatile("" : "+v"(lane_)); const int lane = lane_; LAS unsigned* misc = (LAS unsigned*)(F.miscp);
    LAS unsigned* h2 = (LAS unsigned*)(F.h2p) + F.wt * 256;
    for (int qq = 0; qq < NW; ++qq) { const int q = NW * F.wt + qq;
        LAS u32x2* cq = (LAS u32x2*)(F.ring + q * QBLK);
        LAS unsigned short* sel = (LAS unsigned short*)(F.selp) + q * 256;
        v4u ws, wc; { const LAS unsigned* bmp = (const LAS unsigned*)(F.ring + q * QBLK) + lane; const int wv = (lane >> 2) & 3, m0 = lane >> 4;
#pragma unroll
            for (int g = 0; g < 4; ++g) { const bool ok = wv + 32 * (m0 + 4 * g) <= tau;
                ws[g] = ok ? bmp[64 * g] : 0u; wc[g] = ok ? bmp[256 + 64 * g] : 0u; } }
        wc.x &= ~ws.x; wc.y &= ~ws.y; wc.z &= ~ws.z; wc.w &= ~ws.w;
        const int nS = (int)(__builtin_popcount(ws.x) + __builtin_popcount(ws.y) + __builtin_popcount(ws.z) + __builtin_popcount(ws.w));
        int nC = (int)(__builtin_popcount(wc.x) + __builtin_popcount(wc.y) + __builtin_popcount(wc.z) + __builtin_popcount(wc.w));
        const int iS = wave_incl_scan_i(nS, lane); int iC = wave_incl_scan_i(nC, lane);
        const int totS = __shfl(iS, 63); int c = __shfl(iC, 63);
        { int pos = iS - nS;
#define EMIT_SEL(P_, K_) do { sel[(P_) < 255 ? (P_) : 255] = (unsigned short)(K_); } while (0)
          IDX_EXPAND(ws, pos, EMIT_SEL);
#undef EMIT_SEL
        }
        if (lane == 0) misc[MW_NSEL + q] = (unsigned)(totS < 256 ? totS : 256);
        int need = 256 - totS; if (need < 0) need = 0;
        if (c > CFALL && c > need) {
#pragma unroll 1
            for (int lvl = 0; lvl < 6 && c > CFALL; ++lvl) {
                *(LAS v4u*)(h2 + 4 * lane) = (v4u){0u, 0u, 0u, 0u};
                idx_sweep<0>(lvl, 0u, wc, (LAS unsigned*)cq, h2, misc + MW_NSEL + q, sel, q, lane, IKb, bq, w4);
                unsigned dstar; int above, inside; idx_pick_digit(h2, need, lane, dstar, above, inside);
                idx_sweep<1>(lvl, dstar, wc, (LAS unsigned*)cq, h2, misc + MW_NSEL + q, sel, q, lane, IKb, bq, w4);
                c = inside; need -= above;
            }
            if (c > CMAX) { if (lane == 0) __hip_atomic_fetch_add(F.ctl + CW_OVF, 1u, RLX_AGENT); c = 0; need = 0; wc = (v4u){0u, 0u, 0u, 0u}; }
            nC = (int)(__builtin_popcount(wc.x) + __builtin_popcount(wc.y) + __builtin_popcount(wc.z) + __builtin_popcount(wc.w)); iC = wave_incl_scan_i(nC, lane);
        }
        { int pos = iC - nC;
#define EMIT_CAND(P_, K_) do { if ((P_) < CMAX) cq[(P_)] = (u32x2){0u, (unsigned)(K_)}; } while (0)
          IDX_EXPAND(wc, pos, EMIT_CAND);
#undef EMIT_CAND
        }
        if (c > need)
            for (int c0 = 0; c0 < c; c0 += 64) idx_rescore((const LAS unsigned*)cq + 2 * c0 + 1, 2, (LAS unsigned*)cq + 2 * c0, 2, c - c0 < 64 ? c - c0 : 64, q, lane, IKb, bq, w4);
        if (c > need && c <= 64) {
            u32x2 e = {0u, 0u}; if (lane < c) e = cq[lane]; int rank = 0;
            const int cu = __builtin_amdgcn_readfirstlane(c);
#pragma unroll 1
            for (int j = 0; j < cu; j += 4) {
#pragma unroll
                for (int k = 0; k < 4; ++k) { const unsigned uj = (unsigned)__builtin_amdgcn_readlane((int)e.x, (j + k) & 63), ij = (unsigned)__builtin_amdgcn_readlane((int)e.y, (j + k) & 63); rank += (uj > e.x || (uj == e.x && ij < e.y)) ? 1 : 0; } }
            if (lane < c && rank < need) { const unsigned pos = LDS_ADD(misc + MW_NSEL + q, 1u); if (pos < 256u) sel[pos] = (unsigned short)e.y; }
            c = 0; need = 0;
        }
#pragma unroll 1
        for (int lvl = 0; lvl < 6 && c > need; ++lvl) {
            *(LAS v4u*)(h2 + 4 * lane) = (v4u){0u, 0u, 0u, 0u};
            for (int i = lane; i < c; i += 64) LDS_ADD(h2 + idx_digit(cq[i], lvl), 1u);
            const v4u hw = *(const LAS v4u*)(h2 + 252 - 4 * lane);
            const int total = (int)(hw.x + hw.y + hw.z + hw.w), incl = wave_incl_scan_i(total, lane);
            const unsigned long long mask = __ballot(incl >= need);
            const int Ls = mask ? (int)__builtin_ctzll(mask) : 63;
            int dstar_l = 0, above_l = 0; { int cum = incl - total; bool found = false;
#pragma unroll
                for (int e = 3; e >= 0; --e) { const int cc = (int)hw[e]; if (!found && cum + cc >= need) { found = true; dstar_l = 252 - 4 * lane + e; above_l = cum; } cum += cc; } }
            const unsigned dstar = (unsigned)__shfl(dstar_l, Ls); const int above = __shfl(above_l, Ls);
            int c2 = 0;
            for (int base = 0; base < c; base += 64) { const int i = base + lane; const bool valid = i < c; u32x2 e = {0u, 0u}; if (valid) e = cq[i];
                const unsigned dg = idx_digit(e, lvl); const bool tie = valid && dg == dstar;
                if (valid && dg > dstar) { const unsigned pos = LDS_ADD(misc + MW_NSEL + q, 1u); if (pos < 256u) sel[pos] = (unsigned short)e.y; }
                const unsigned long long tm = __ballot(tie);
                if (tie) cq[c2 + __popcll(tm & ((1ull << lane) - 1ull))] = e;
                c2 += __popcll(tm); }
            c = c2; need -= above;
        }
        for (int i = lane; i < c && i < need; i += 64) { const unsigned pos = LDS_ADD(misc + MW_NSEL + q, 1u); if (pos < 256u) sel[pos] = (unsigned short)cq[i].y; }
    }
}
typedef short s16x4 __attribute__((ext_vector_type(4)));
__device__ __forceinline__ unsigned cvt_pk_bf16x2(float lo, float hi) { unsigned r_; asm("v_cvt_pk_bf16_f32 %0, %1, %2" : "=v"(r_) : "v"(lo), "v"(hi)); return r_; }
__device__ __forceinline__ void sp_glds16(const void* gsrc, unsigned lds_dst) { unsigned keep;
    asm volatile("s_mov_b32 %0, m0\n\ts_mov_b32 m0, %2\n\ts_nop 0\n\tglobal_load_lds_dwordx4 %1, off\n\ts_mov_b32 m0, %0" : "=&s"(keep) : "v"(gsrc), "s"(lds_dst) : "memory"); }
__device__ __forceinline__ void sp_glds16s(const void* sbase, unsigned voff, unsigned lds_dst) { unsigned keep;
    asm volatile("s_mov_b32 %0, m0\n\ts_mov_b32 m0, %3\n\ts_nop 0\n\tglobal_load_lds_dwordx4 %1, %2\n\ts_mov_b32 m0, %0" : "=&s"(keep) : "v"(voff), "s"(sbase), "s"(lds_dst) : "memory"); }
__device__ __forceinline__ void sp_glds16s_x4(const void* sbase, unsigned v0, unsigned v1, unsigned v2, unsigned v3, unsigned lds_dst) { unsigned keep;
    asm volatile("s_mov_b32 %0, m0\n\ts_mov_b32 m0, %6\n\ts_nop 0\n\tglobal_load_lds_dwordx4 %1, %5\n\ts_add_u32 m0, m0, 0x400\n\ts_nop 0\n\tglobal_load_lds_dwordx4 %2, %5\n\ts_add_u32 m0, m0, 0x400\n\ts_nop 0\n\tglobal_load_lds_dwordx4 %3, %5\n\ts_add_u32 m0, m0, 0x400\n\ts_nop 0\n\tglobal_load_lds_dwordx4 %4, %5\n\ts_mov_b32 m0, %0"
                 : "=&s"(keep) : "v"(v0), "v"(v1), "v"(v2), "v"(v3), "s"(sbase), "s"(lds_dst) : "memory", "scc"); }
__device__ __forceinline__ void sp_prologue(Frame& F, const BAParams& P, int rb, int qi0, bool dry) {
    const int lane = F.lane, drow = lane >> 3, dpc = lane & 7; constexpr int KOFF = M * 128;
    const LAS unsigned short* sel = (const LAS unsigned short*)(F.selp) + qi0 * 256;
    const unsigned wk = (unsigned)__builtin_amdgcn_readfirstlane((int)((unsigned)(uintptr_t)(F.ring) + (unsigned)F.wt * 16384u));
    asm volatile("s_waitcnt lgkmcnt(0)" ::: "memory");
#pragma unroll
    for (int st = 0; st < 4; ++st) { unsigned vo_[4];
#pragma unroll
        for (int i_ = 0; i_ < 4; ++i_) { const int slot_ = 32 * st + 8 * i_ + drow; const int key_ = (SPB_IDEAL && dry) ? slot_ : (int)sel[slot_];
            vo_[i_] = (unsigned)(((rb + key_) * 128 + KOFF + ((dpc ^ (drow & 7)) * 8)) * 2); }
        sp_glds16s_x4(P.KAB, vo_[0], vo_[1], vo_[2], vo_[3], (unsigned)__builtin_amdgcn_readfirstlane((int)(wk + (unsigned)(st * 4096)))); }
}
__device__ __forceinline__ void sw_prologue(Frame& F, const BAParams& P, int rb, int t0, int combo) {
    const int lane = F.lane, drow = lane >> 3, dpc = lane & 7, j = combo >> 2, kbase = t0 - 128;
    const unsigned wk = (unsigned)__builtin_amdgcn_readfirstlane((int)((unsigned)(uintptr_t)(F.ring) + (unsigned)F.wt * 16384u)), wl = wk + 8192u;
    asm volatile("s_waitcnt lgkmcnt(0)" ::: "memory");
#pragma unroll
    for (int st = 0; st < 2; ++st) { unsigned vo_[4];
#pragma unroll
        for (int i_ = 0; i_ < 4; ++i_) { int key_ = kbase + 32 * st + 8 * i_ + drow; key_ = key_ < 0 ? 0 : (key_ > SEQ - 1 ? SEQ - 1 : key_); vo_[i_] = (unsigned)(((rb + key_) * 128 + j * 64 + dpc * 8) * 2); }
        sp_glds16s_x4(P.VAB, vo_[0], vo_[1], vo_[2], vo_[3], (unsigned)__builtin_amdgcn_readfirstlane((int)(wl + (unsigned)(st * 4096)))); }
#pragma unroll
    for (int st = 0; st < 2; ++st) { unsigned vo_[4];
#pragma unroll
        for (int i_ = 0; i_ < 4; ++i_) { int key_ = kbase + 32 * st + 8 * i_ + drow; key_ = key_ < 0 ? 0 : (key_ > SEQ - 1 ? SEQ - 1 : key_); vo_[i_] = (unsigned)(((rb + key_) * 128 + j * 64 + ((dpc ^ (drow & 7)) * 8)) * 2); }
        sp_glds16s_x4(P.KAB, vo_[0], vo_[1], vo_[2], vo_[3], (unsigned)__builtin_amdgcn_readfirstlane((int)(wk + (unsigned)(st * 4096)))); }
}
template <bool IS_A> __device__ __forceinline__ void sparse_pair(Frame& F, const BAParams& P, int rb, int tA, int qi0, int nv0, int nv1, bool dry, bool pre, int nxt, int nxa, int t0u) {
    constexpr int NC = IS_A ? 8 : 16, NSLOT = NC * 16, KOFF = IS_A ? 0 : M * 128, HB = IS_A ? 0 : 8, GOFF = IS_A ? 0 : 512;
    int lane_ = F.lane; asm volatile("" : "+v"(lane_)); const int lane = lane_, r = lane & 15, g4 = lane >> 4, my_a = g4 >> 1, my_j = g4 & 1;
    const bf16* Q = IS_A ? P.QA : P.QB;
    const LAS unsigned short* sel = (const LAS unsigned short*)(F.selp) + qi0 * 256;
    const LAS float* BIAS = (const LAS float*)(F.lds + BIAS_OFF);
    const LAS unsigned char* BKT = (const LAS unsigned char*)(F.lds + BKT_OFF);
    LAS unsigned short* Pimg = (LAS unsigned short*)(F.ring + F.wt * 16384);
    bf16x8 q0, q1; const bf16x8 zz = {0, 0, 0, 0, 0, 0, 0, 0};
    { const int a_r = r >> 3, hd = r & 7; const bf16* qp = Q + (size_t)(rb + tA + a_r) * 512 + hd * 64 + 8 * g4; q0 = *(const bf16x8*)qp; q1 = *(const bf16x8*)(qp + 32); }
    const int my_t = tA + my_a, rcb = r >> 2;
    bf16* const gp = P.G + (size_t)(rb + tA + (r >> 3)) * 1536 + GOFF + (r & 7) * 64 + 4 * g4; u32x2 gt[4];
#pragma unroll
    for (int db = 0; db < 4; ++db) gt[db] = dry ? (u32x2){0u, 0u} : *(const u32x2*)(gp + 16 * db);
    f32x4 x[NC];
#pragma unroll
    for (int c = 0; c < NC; ++c) x[c] = (f32x4){0.f, 0.f, 0.f, 0.f};
    constexpr int KS = NSLOT / 32, NST = 4 * KS;
    const unsigned wk = (unsigned)__builtin_amdgcn_readfirstlane((int)((unsigned)(uintptr_t)(F.ring) + (unsigned)F.wt * 16384u));
    const int drow = lane >> 3, dpc = lane & 7;
#define SP_KDMA(st, bufi) do { const int cb_ = (st) / KS, ks_ = (st) % KS, a_ = cb_ >> 1, j_ = cb_ & 1; unsigned vo_[4]; \
        _Pragma("unroll") for (int i_ = 0; i_ < 4; ++i_) { const int slot_ = 32 * ks_ + 8 * i_ + drow; int key_; \
            if (IS_A) { key_ = tA + a_ - slot_; key_ = key_ < 0 ? 0 : key_; } else { key_ = (SPB_IDEAL && dry) ? slot_ : (int)sel[a_ * 256 + slot_]; }   \
            vo_[i_] = (unsigned)(((rb + key_) * 128 + KOFF + j_ * 64 + ((dpc ^ (drow & 7)) * 8)) * 2); } \
        sp_glds16s_x4(P.KAB, vo_[0], vo_[1], vo_[2], vo_[3], (unsigned)__builtin_amdgcn_readfirstlane((int)(wk + (unsigned)((bufi) * 4096)))); } while (0)
    const unsigned wl = wk + 4096u;
#define SP_VDMA(st, bufi) do { const int cb_ = (st) / KS, ks_ = (st) % KS, a_ = cb_ >> 1, j_ = cb_ & 1; unsigned vo_[4]; \
        _Pragma("unroll") for (int i_ = 0; i_ < 4; ++i_) { const int slot_ = 32 * ks_ + 8 * i_ + drow; int key_; \
            if (IS_A) { key_ = tA + a_ - slot_; key_ = key_ < 0 ? 0 : key_; } else { key_ = (SPB_IDEAL && dry) ? slot_ : (int)sel[a_ * 256 + slot_]; } \
            vo_[i_] = (unsigned)(((rb + key_) * 128 + KOFF + j_ * 64 + dpc * 8) * 2); } \
        sp_glds16s_x4(P.VAB, vo_[0], vo_[1], vo_[2], vo_[3], (unsigned)__builtin_amdgcn_readfirstlane((int)(wl + (unsigned)((bufi) * 4096)))); } while (0)
    asm volatile("s_waitcnt lgkmcnt(0)" ::: "memory");
    if (!pre) { SP_KDMA(0, 0); SP_KDMA(1, 1); SP_KDMA(2, 2); if (NST > 3) SP_KDMA(3, 3); }
    { const LAS unsigned char* kring = F.ring + F.wt * 16384;
      static_assert(KS % 4 == 0, "the ring position of a step is its k-step index mod 4");
#pragma unroll 1
      for (int cb = 0; cb < 4; ++cb) { const bool mine = rcb == cb; const bf16x8 a0 = mine ? q0 : zz, a1 = mine ? q1 : zz;
#pragma unroll
        for (int ks = 0; ks < KS; ++ks) { const int st = cb * KS + ks;
          if (cb < 3 || ks + 3 < KS) asm volatile("s_waitcnt vmcnt(12)" ::: "memory"); else asm volatile("s_waitcnt vmcnt(8)" ::: "memory");
          const LAS unsigned char* kb = kring + (ks & 3) * 4096;
          bf16x8 f[2][2];
#pragma unroll
          for (int cc = 0; cc < 2; ++cc)
#pragma unroll
              for (int k2 = 0; k2 < 2; ++k2) f[cc][k2] = *(const LAS bf16x8*)(kb + (16 * cc + r) * 128 + (((4 * k2 + g4) ^ (r & 7)) * 16));
          int kn_[4] = {0, 0, 0, 0}; const int cbn_ = (st + 4) / KS, an_ = cbn_ >> 1, jn_ = cbn_ & 1;
          if (st + 4 < NST) {
#pragma unroll
              for (int i_ = 0; i_ < 4; ++i_) { const int slot_ = 32 * ((ks + 4) % KS) + 8 * i_ + drow; if (IS_A) { int k_ = tA + an_ - slot_; kn_[i_] = k_ < 0 ? 0 : k_; } else kn_[i_] = (SPB_IDEAL && dry) ? slot_ : (int)sel[an_ * 256 + slot_]; } }
          asm volatile("s_waitcnt lgkmcnt(0)" ::: "memory");
          if (st + 4 < NST) { unsigned vo_[4];
#pragma unroll
              for (int i_ = 0; i_ < 4; ++i_) vo_[i_] = (unsigned)(((rb + kn_[i_]) * 128 + KOFF + jn_ * 64 + ((dpc ^ (drow & 7)) * 8)) * 2);
              sp_glds16s_x4(P.KAB, vo_[0], vo_[1], vo_[2], vo_[3], (unsigned)__builtin_amdgcn_readfirstlane((int)(wk + (unsigned)((ks & 3) * 4096)))); }
#pragma unroll
          for (int cc = 0; cc < 2; ++cc) { x[2 * ks + cc] = __builtin_amdgcn_mfma_f32_16x16x32_bf16(a0, f[cc][0], x[2 * ks + cc], 0, 0, 0); x[2 * ks + cc] = __builtin_amdgcn_mfma_f32_16x16x32_bf16(a1, f[cc][1], x[2 * ks + cc], 0, 0, 0); }
          if (ks + 3 >= KS && cb == 3) { if (ks + 3 == KS) SP_VDMA(0, 0); else if (ks + 2 == KS) SP_VDMA(1, 1); else SP_VDMA(2, 2); }
        } } }
#undef SP_KDMA
#pragma unroll
    for (int c = 0; c < NC; ++c) { const int slot = 16 * c + r; int mk; bool mv;
        if (IS_A) { mk = my_t - slot; mv = mk >= 0; } else { mk = sel[my_a * 256 + slot]; mv = slot < (my_a ? nv1 : nv0); }
        const int delta = my_t - mk; const bool ok = mv && delta >= 0;
        const int bk = (ok && delta < 512) ? (int)BKT[delta] : 31;
        const f32x4 b4 = *(const LAS f32x4*)(BIAS + bk * 16 + HB + 4 * my_j);
#pragma unroll
        for (int i = 0; i < 4; ++i) x[c][i] = ok ? x[c][i] * 0.125f + b4[i] : -INFINITY; }
    f32x4 mx = x[0];
#pragma unroll
    for (int c = 1; c < NC; ++c)
#pragma unroll
        for (int i = 0; i < 4; ++i) mx[i] = fmaxf(mx[i], x[c][i]);
#pragma unroll
    for (int o = 1; o < 16; o <<= 1)
#pragma unroll
        for (int i = 0; i < 4; ++i) mx[i] = fmaxf(mx[i], __shfl_xor(mx[i], o));
    f32x4 sk = {0.f, 0.f, 0.f, 0.f};
    if (IS_A) { sk = *(const f32x4*)(P.sinks + 4 * my_j);
#pragma unroll
        for (int i = 0; i < 4; ++i) mx[i] = fmaxf(mx[i], sk[i]); }
    f32x4 sum = {0.f, 0.f, 0.f, 0.f};
#pragma unroll
    for (int c = 0; c < NC; ++c)
#pragma unroll
        for (int i = 0; i < 4; ++i) { x[c][i] = __expf(x[c][i] - mx[i]); sum[i] += x[c][i]; }
#pragma unroll
    for (int o = 1; o < 16; o <<= 1)
#pragma unroll
        for (int i = 0; i < 4; ++i) sum[i] += __shfl_xor(sum[i], o);
    if (IS_A) {
#pragma unroll
        for (int i = 0; i < 4; ++i) sum[i] += __expf(sk[i] - mx[i]); }
    f32x4 inv;
#pragma unroll
    for (int i = 0; i < 4; ++i) inv[i] = 1.0f / sum[i];
#define SP_PWRITE(qa) do { if (my_a == (qa)) { _Pragma("unroll") for (int c_ = 0; c_ < NC; ++c_) _Pragma("unroll") for (int i_ = 0; i_ < 4; i_ += 2) { \
        const unsigned pk_ = cvt_pk_bf16x2(x[c_][i_] * inv[i_], x[c_][i_ + 1] * inv[i_ + 1]);     \
        Pimg[(4 * my_j + i_) * NSLOT + 16 * c_ + r] = (unsigned short)pk_; Pimg[(4 * my_j + i_ + 1) * NSLOT + 16 * c_ + r] = (unsigned short)(pk_ >> 16); } } } while (0)
    SP_PWRITE(0);
    f32x4 o[4];
#pragma unroll
    for (int db = 0; db < 4; ++db) o[db] = (f32x4){0.f, 0.f, 0.f, 0.f};
    const unsigned trb = (unsigned)((8 * g4 + ((lane & 15) >> 2)) * 128 + (lane & 3) * 8);
    int bufi = 0;
#pragma unroll 1
    for (int cb = 0; cb < 4; ++cb) { const bool minep = rcb == cb;
        if (cb == 2) { SP_PWRITE(1); }
#pragma unroll
        for (int ks = 0; ks < KS; ++ks) { const int st = cb * KS + ks;
            if (cb < 3 || ks + 2 < KS) asm volatile("s_waitcnt vmcnt(8)" ::: "memory"); else if (ks + 1 < KS) asm volatile("s_waitcnt vmcnt(4)" ::: "memory"); else asm volatile("s_waitcnt vmcnt(0)" ::: "memory");
            const unsigned vb = wl + (unsigned)(bufi * 4096) + trb;
            s16x4 lo[4], hi[4];
#pragma unroll
            for (int db = 0; db < 4; ++db) {
                asm volatile("ds_read_b64_tr_b16 %0, %1 offset:%c2" : "=&v"(lo[db]) : "v"(vb), "i"(db * 32) : "memory");
                asm volatile("ds_read_b64_tr_b16 %0, %1 offset:%c2" : "=&v"(hi[db]) : "v"(vb), "i"(db * 32 + 512) : "memory"); }
            bf16x8 pb = *(const LAS bf16x8*)(Pimg + (r & 7) * NSLOT + 32 * ks + 8 * g4);
            pb = minep ? pb : zz;
            int kn_[4] = {0, 0, 0, 0}; const int cbn_ = (st + 3) / KS, an_ = cbn_ >> 1, jn_ = cbn_ & 1;
            if (st + 3 < NST) {
#pragma unroll
                for (int i_ = 0; i_ < 4; ++i_) { const int slot_ = 32 * ((ks + 3) % KS) + 8 * i_ + drow; if (IS_A) { int k_ = tA + an_ - slot_; kn_[i_] = k_ < 0 ? 0 : k_; } else kn_[i_] = (SPB_IDEAL && dry) ? slot_ : (int)sel[an_ * 256 + slot_]; } }
            asm volatile("s_waitcnt lgkmcnt(0)" ::: "memory");
            if (st + 3 < NST) { unsigned vo_[4];
#pragma unroll
                for (int i_ = 0; i_ < 4; ++i_) vo_[i_] = (unsigned)(((rb + kn_[i_]) * 128 + KOFF + jn_ * 64 + dpc * 8) * 2);
                sp_glds16s_x4(P.VAB, vo_[0], vo_[1], vo_[2], vo_[3], (unsigned)__builtin_amdgcn_readfirstlane((int)(wl + (unsigned)(bufi * 4096)))); }
#pragma unroll
            for (int db = 0; db < 4; ++db) { const bf16x8 va = {lo[db][0], lo[db][1], lo[db][2], lo[db][3], hi[db][0], hi[db][1], hi[db][2], hi[db][3]};
                o[db] = __builtin_amdgcn_mfma_f32_16x16x32_bf16(va, pb, o[db], 0, 0, 0); }
            bufi = bufi == 2 ? 0 : bufi + 1;
        } }
#undef SP_VDMA
    if (nxt == 1) sp_prologue(F, P, rb, nxa, dry); else if (nxt == 2) sw_prologue(F, P, rb, t0u, nxa);
#undef SP_PWRITE
    if (!dry) {
#pragma unroll
        for (int db = 0; db < 4; ++db) {
            const float g0 = __uint_as_float(gt[db].x << 16), g1 = __uint_as_float(gt[db].x & 0xffff0000u), g2 = __uint_as_float(gt[db].y << 16), g3 = __uint_as_float(gt[db].y & 0xffff0000u);
            u32x2 w; w.x = cvt_pk_bf16x2(o[db][0] * g0, o[db][1] * g1); w.y = cvt_pk_bf16x2(o[db][2] * g2, o[db][3] * g3);
            *(u32x2*)(gp + 16 * db) = w; } }
}
__device__ __forceinline__ void swa_dense(Frame& F, const BAParams& P, int rb, int t0, int combo, bool dry, bool pre, int nxa) {
    constexpr int NC = 10, NSLOT = 160, NST = 5;
    int lane_ = F.lane; asm volatile("" : "+v"(lane_)); const int lane = lane_, r = lane & 15, g4 = lane >> 4, j = combo >> 2, qg = combo & 3, kbase = t0 - 128;
    const LAS float* BIAS = (const LAS float*)(F.lds + BIAS_OFF);
    const LAS unsigned char* BKT = (const LAS unsigned char*)(F.lds + BKT_OFF);
    LAS unsigned short* Pimg = (LAS unsigned short*)(F.ring + F.wt * 16384);
    bf16* const gp = P.G + (size_t)(rb + t0 + 4 * qg + (r >> 2)) * 1536 + (4 * j + (r & 3)) * 64 + 4 * g4; u32x2 gt[4];
#pragma unroll
    for (int db = 0; db < 4; ++db) gt[db] = dry ? (u32x2){0u, 0u} : *(const u32x2*)(gp + 16 * db);
    const unsigned wl = (unsigned)__builtin_amdgcn_readfirstlane((int)((unsigned)(uintptr_t)(F.ring) + (unsigned)F.wt * 16384u + 8192u));
    const int drow = lane >> 3, dpc = lane & 7;
#define SW_VDMA(st) do { unsigned vo_[4]; \
        _Pragma("unroll") for (int i_ = 0; i_ < 4; ++i_) { int key_ = kbase + 32 * (st) + 8 * i_ + drow; key_ = key_ < 0 ? 0 : (key_ > SEQ - 1 ? SEQ - 1 : key_); vo_[i_] = (unsigned)(((rb + key_) * 128 + j * 64 + dpc * 8) * 2); } \
        sp_glds16s_x4(P.VAB, vo_[0], vo_[1], vo_[2], vo_[3], (unsigned)__builtin_amdgcn_readfirstlane((int)(wl + (unsigned)(((st) & 1) * 4096)))); } while (0)
    asm volatile("s_waitcnt lgkmcnt(0)" ::: "memory");
    if (!pre) { SW_VDMA(0); SW_VDMA(1); }
    const unsigned wk = (unsigned)__builtin_amdgcn_readfirstlane((int)((unsigned)(uintptr_t)(F.ring) + (unsigned)F.wt * 16384u));
#define SW_KDMA(st) do { unsigned vo_[4]; \
        _Pragma("unroll") for (int i_ = 0; i_ < 4; ++i_) { int key_ = kbase + 32 * (st) + 8 * i_ + drow; key_ = key_ < 0 ? 0 : (key_ > SEQ - 1 ? SEQ - 1 : key_); vo_[i_] = (unsigned)(((rb + key_) * 128 + j * 64 + ((dpc ^ (drow & 7)) * 8)) * 2); } \
        sp_glds16s_x4(P.KAB, vo_[0], vo_[1], vo_[2], vo_[3], (unsigned)__builtin_amdgcn_readfirstlane((int)(wk + (unsigned)(((st) & 1) * 4096)))); } while (0)
    if (!pre) { SW_KDMA(0); SW_KDMA(1); }
    bf16x8 qf[2]; { const bf16* qp = P.QA + (size_t)(rb + t0 + 4 * qg + (r >> 2)) * 512 + (4 * j + (r & 3)) * 64 + 8 * g4; qf[0] = *(const bf16x8*)qp; qf[1] = *(const bf16x8*)(qp + 32); }
    const int my_t = t0 + 4 * qg + g4;
    f32x4 x[NC];
    { const LAS unsigned char* kring = F.ring + F.wt * 16384;
#pragma unroll
      for (int st = 0; st < NST; ++st) {
        if (st + 1 < NST) asm volatile("s_waitcnt vmcnt(4)" ::: "memory"); else asm volatile("s_waitcnt vmcnt(0)" ::: "memory");
        const LAS unsigned char* kb = kring + (st & 1) * 4096; bf16x8 f[2][2];
#pragma unroll
        for (int cc = 0; cc < 2; ++cc)
#pragma unroll
            for (int k2 = 0; k2 < 2; ++k2) f[cc][k2] = *(const LAS bf16x8*)(kb + (16 * cc + r) * 128 + (((4 * k2 + g4) ^ (r & 7)) * 16));
        asm volatile("s_waitcnt lgkmcnt(0)" ::: "memory");
        if (st + 2 < NST) SW_KDMA(st + 2);
#pragma unroll
        for (int cc = 0; cc < 2; ++cc) { const int c = 2 * st + cc; f32x4 d = {0.f, 0.f, 0.f, 0.f};
            d = __builtin_amdgcn_mfma_f32_16x16x32_bf16(qf[0], f[cc][0], d, 0, 0, 0); d = __builtin_amdgcn_mfma_f32_16x16x32_bf16(qf[1], f[cc][1], d, 0, 0, 0);
            const int key = kbase + 16 * c + r, delta = my_t - key; const bool ok = key >= 0 && delta >= 0 && delta < 128;
            const int bk = (int)BKT[ok ? delta : 0];
            const f32x4 b4 = *(const LAS f32x4*)(BIAS + bk * 16 + 4 * j);
#pragma unroll
            for (int i = 0; i < 4; ++i) x[c][i] = ok ? d[i] * 0.125f + b4[i] : -INFINITY; } } }
#undef SW_KDMA
    f32x4 mx = *(const f32x4*)(P.sinks + 4 * j); const f32x4 sk = mx;
#pragma unroll
    for (int c = 0; c < NC; ++c)
#pragma unroll
        for (int i = 0; i < 4; ++i) mx[i] = fmaxf(mx[i], x[c][i]);
#pragma unroll
    for (int o = 1; o < 16; o <<= 1)
#pragma unroll
        for (int i = 0; i < 4; ++i) mx[i] = fmaxf(mx[i], __shfl_xor(mx[i], o));
    f32x4 sum = {0.f, 0.f, 0.f, 0.f};
#pragma unroll
    for (int c = 0; c < NC; ++c)
#pragma unroll
        for (int i = 0; i < 4; ++i) { x[c][i] = __expf(x[c][i] - mx[i]); sum[i] += x[c][i]; }
#pragma unroll
    for (int o = 1; o < 16; o <<= 1)
#pragma unroll
        for (int i = 0; i < 4; ++i) sum[i] += __shfl_xor(sum[i], o);
    f32x4 inv;
#pragma unroll
    for (int i = 0; i < 4; ++i) inv[i] = 1.0f / (sum[i] + __expf(sk[i] - mx[i]));
#pragma unroll
    for (int c = 0; c < NC; ++c)
#pragma unroll
        for (int i = 0; i < 4; i += 2) { const unsigned pk = cvt_pk_bf16x2(x[c][i] * inv[i], x[c][i + 1] * inv[i + 1]);
            Pimg[(4 * g4 + i) * NSLOT + 16 * c + r] = (unsigned short)pk; Pimg[(4 * g4 + i + 1) * NSLOT + 16 * c + r] = (unsigned short)(pk >> 16); }
    f32x4 o[4];
#pragma unroll
    for (int db = 0; db < 4; ++db) o[db] = (f32x4){0.f, 0.f, 0.f, 0.f};
    const unsigned trb = (unsigned)((8 * g4 + ((lane & 15) >> 2)) * 128 + (lane & 3) * 8);
#pragma unroll
    for (int st = 0; st < NST; ++st) {
        if (st + 1 < NST) asm volatile("s_waitcnt vmcnt(4)" ::: "memory"); else asm volatile("s_waitcnt vmcnt(0)" ::: "memory");
        const unsigned vb = wl + (unsigned)((st & 1) * 4096) + trb;
        s16x4 lo[4], hi[4];
#pragma unroll
        for (int db = 0; db < 4; ++db) {
            asm volatile("ds_read_b64_tr_b16 %0, %1 offset:%c2" : "=&v"(lo[db]) : "v"(vb), "i"(db * 32) : "memory");
            asm volatile("ds_read_b64_tr_b16 %0, %1 offset:%c2" : "=&v"(hi[db]) : "v"(vb), "i"(db * 32 + 512) : "memory"); }
        const bf16x8 pb = *(const LAS bf16x8*)(Pimg + r * NSLOT + 32 * st + 8 * g4);
        asm volatile("s_waitcnt lgkmcnt(0)" ::: "memory");
#pragma unroll
        for (int db = 0; db < 4; ++db) { const bf16x8 va = {lo[db][0], lo[db][1], lo[db][2], lo[db][3], hi[db][0], hi[db][1], hi[db][2], hi[db][3]};
            o[db] = __builtin_amdgcn_mfma_f32_16x16x32_bf16(va, pb, o[db], 0, 0, 0); }
        if (st + 2 < NST) SW_VDMA(st + 2);
    }
#undef SW_VDMA
    if (nxa >= 0) sw_prologue(F, P, rb, t0, nxa);
    if (!dry) {
#pragma unroll
        for (int db = 0; db < 4; ++db) {
            const float g0 = __uint_as_float(gt[db].x << 16), g1 = __uint_as_float(gt[db].x & 0xffff0000u), g2 = __uint_as_float(gt[db].y << 16), g3 = __uint_as_float(gt[db].y & 0xffff0000u);
            u32x2 w; w.x = cvt_pk_bf16x2(o[db][0] * g0, o[db][1] * g1); w.y = cvt_pk_bf16x2(o[db][2] * g2, o[db][3] * g3);
            *(u32x2*)(gp + 16 * db) = w; } }
}
__device__ __forceinline__ void ba_clear(Frame& F) {
    LAS v4u* hz = (LAS v4u*)(F.ring + F.wt * 16384);
#pragma unroll
    for (int i = 0; i < 16; ++i) hz[F.lane + 64 * i] = (v4u){0u, 0u, 0u, 0u};
    *(LAS v4u*)(F.h2p + F.wt * 1024 + F.lane * 16) = (v4u){0u, 0u, 0u, 0u};
}
__device__ __forceinline__ void ba_unit(Frame& F, const BAParams& P, int b, int tau, bool dry) {
    { int l_ = (int)__builtin_amdgcn_mbcnt_hi(~0u, __builtin_amdgcn_mbcnt_lo(~0u, 0u)); asm volatile("" : "+v"(l_)); F.lane = l_; F.tid = F.wt * 64 + l_; }
    const int t0 = tau * 16, rb = b * SEQ, lane = F.lane;
    LAS unsigned* misc = (LAS unsigned*)(F.miscp);
    for (int ri = 0; ri < REP_IDX; ++ri)
    if (tau >= 16) {
        if (ri) { team_barrier(F); ba_clear(F); team_barrier(F); }
        bf16x8 bq[4]; const int r = lane & 15, g4 = lane >> 4;
#pragma unroll
        for (int h = 0; h < 4; ++h) bq[h] = *(const bf16x8*)(P.IQ + (size_t)(rb + t0 + r) * 128 + h * 32 + 8 * g4);
        const f32x4 w4 = *(const f32x4*)(P.IW + (size_t)(rb + t0 + r) * 4);
        const bf16* IKb = P.IK + (size_t)rb * 32;
        idx_pass<1>(F, IKb, bq, w4, tau, t0);
        team_barrier(F);
#pragma unroll 1
        for (int k_ = 0; k_ < REP_TH; ++k_) { idx_threshold(F); team_barrier(F); }
#pragma unroll 1
        for (int k2_ = 0; k2_ < REP_P2RS; ++k2_) {
#pragma unroll 1
        for (int k_ = 0; k_ < REP_P2; ++k_) { idx_pass<2>(F, IKb, bq, w4, tau, t0); team_barrier(F); }
#pragma unroll 1
        for (int k_ = 0; k_ < REP_RS; ++k_) idx_resolve(F, IKb, bq, w4, tau);
        if (k2_ + 1 < REP_P2RS) team_barrier(F); }
    } else {
        LAS unsigned short* sel = (LAS unsigned short*)(F.selp) + NW * F.wt * 256;
        for (int i = lane; i < NW * 256; i += 64) sel[i] = (unsigned short)(i & 255);
    }
    asm volatile("s_waitcnt lgkmcnt(0)" ::: "memory");
    static_assert(REP_SPB == 1 && REP_SPA == 1, "the bodies hand their first DMA pieces on to each other: no repeats");
#pragma unroll 1
    for (int pp = 0; pp < 2; ++pp) { const int pr = 2 * F.wt + pp;
        const int tA = t0 + 2 * pr, nv0 = tA >= 256 ? 256 : tA + 1, nv1 = tA + 1 >= 256 ? 256 : tA + 2;
        sparse_pair<false>(F, P, rb, tA, 2 * pr, nv0, nv1, dry, pp > 0, pp == 0 ? 1 : 2, pp == 0 ? 2 * pr + 2 : F.wt, t0); }
#pragma unroll 1
    for (int pp = 0; pp < 2; ++pp) swa_dense(F, P, rb, t0, F.wt + 4 * pp, dry, true, pp == 0 ? F.wt + 4 : -1);
    ba_clear(F);
}

#ifndef REP_P1A
#define REP_P1A 1
#endif
#ifndef REP_C
#define REP_C 1
#endif
#ifndef REP_BA
#define REP_BA 1
#endif
#ifndef REP_P1B
#define REP_P1B 1
#endif
#ifndef REP_P3
#define REP_P3 1
#endif
#ifndef REP_P0
#define REP_P0 1
#endif
#ifndef FOX_SKIP_LOG2
#define FOX_SKIP_LOG2 (-30.0f)
#endif
#ifndef MK_ONE_LAUNCH
#define MK_ONE_LAUNCH 1
#endif
constexpr int NPHASES = 1 + 6 * DEPTH;
struct Args { const float* in[9]; float* out; unsigned char* ws; int ph_lo, ph_hi; };
static_assert(sizeof(Args) == 9 * 8 + 8 + 8 + 4 + 4, "no padding bytes in the argument struct");

typedef const __attribute__((address_space(4))) Args* ArgP;
__device__ __forceinline__ ArgP argp() { ArgP p = (ArgP)__builtin_amdgcn_kernarg_segment_ptr(); asm volatile("" : "+s"(p)); return p; }
__global__ void __launch_bounds__(512, 2) mk_fwd(Args args) {
    extern __shared__ __attribute__((aligned(16))) unsigned char lds[];
    Frame F;
    F.lds = (LAS unsigned char*)lds;
    if ((unsigned)(uintptr_t)F.lds != 0u) return;
    F.MISC = (volatile LAS unsigned*)(F.lds + MISC_OFF);
    F.tid = threadIdx.x; F.lane = F.tid & 63; F.wave = __builtin_amdgcn_readfirstlane(F.tid >> 6);
    F.G = gridDim.x; { const int bx = blockIdx.x; F.vcu = (F.G % 8 == 0) ? (bx % 8) * (F.G / 8) + bx / 8 : bx; }
    F.ctl = (gu32*)(argp()->ws + WS_CTL);
    for (int u = F.tid; u < 256; u += 512) ((LAS unsigned*)(F.lds + MISC_OFF))[u] = 0u;
    for (int u = F.tid; u < 512; u += 512) { ((LAS float*)(F.lds + BIAS_OFF))[u] = argp()->in[8][u];
        int bk; if (u < 16) bk = u; else { const float nf = (float)u; int lg = 16 + (int)(logf(nf / 16.0f) / 3.4657359027997265f * 16.0f); bk = lg < 31 ? lg : 31; }
        ((LAS unsigned char*)(F.lds + BKT_OFF))[u] = (unsigned char)bk; }
    __syncthreads();
    XcdBarrier bar; bar.bar = (unsigned*)(F.ctl + CW_BAR); bar.x = 0; bar.st = nullptr;
    if (MK_ONE_LAUNCH) bar = xcd_barrier_post((unsigned*)(F.ctl + CW_BAR), F.MISC + MW_BAR);
    const int lo = argp()->ph_lo, hi = argp()->ph_hi;
#define IN(k) (lo <= (k) && (k) < hi)
#define SEAM(k) do { if (IN(k) && IN((k) + 1)) xcd_barrier(bar); } while (0)
#define PHASE_BEGIN() do { int l_ = (int)__builtin_amdgcn_mbcnt_hi(~0u, __builtin_amdgcn_mbcnt_lo(~0u, 0u)); asm volatile("" : "+v"(l_)); F.lane = l_; F.tid = F.wave * 64 + l_; } while (0)

    if (IN(0)) { PHASE_BEGIN(); ArgP a = argp(); for (int rp = 0; rp < REP_P0; ++rp) p0_prologue(F, a->in[0], a->in[1], a->in[2], a->in[6], a->in[7], a->ws); SEAM(0); }

    for (int L = 0; L < DEPTH; ++L) {
        const int pb = 1 + 6 * L;
        if (IN(pb)) { PHASE_BEGIN();
            unsigned char* ws = argp()->ws; const pg8::bf16_t* W1T = (const pg8::bf16_t*)(ws + WS_W1T) + (size_t)L * NTILES * 256 * 1024;
            pg8::Gemm g{(const pg8::bf16_t*)(ws + WS_XB), W1T, M, NTILES * 256, 1024, 1024, 1024, 0}; pg8::StaticOrder S; S.init(M, NTILES * 256, F.G, (int)blockIdx.x);
            pg8::EpiInAll E{pg8::EpiIn{ws, argp()->in[4] + L * 384, argp()->in[3] + L * 8}, pg8::EpiGate{(const float*)(ws + WS_SSQ), (unsigned char*)argp()->out}, NT_A};
            for (int rp = 0; rp < REP_P1A; ++rp) pg8::gemm_phase<pg8::EpiInAll, pg8::StaticOrder, true, true>(F.lds + RING_OFF, g, S, E, F.wave);
            {
                const int rem = S.nwg % F.G, c = (int)blockIdx.x;
                if (c >= rem && (L + 1 < DEPTH || L > 0)) { VM_WAIT(); LDS_WAIT(); __syncthreads(); PHASE_BEGIN(); ArgP a = argp(); const int dgw = (c - rem) * 8 + F.wave, dng = (F.G - rem) * 8;
                    if (L + 1 < DEPTH) p0_weights(F, L + 1, 0, dgw, dng, a->in[1], a->in[2], a->in[6], a->in[7], a->ws);
                    if (L > 0) p0_weights(F, L, 1, dgw, dng, a->in[1], a->in[2], a->in[6], a->in[7], a->ws); } }
            SEAM(pb);
        }
        if (IN(pb + 2)) { PHASE_BEGIN();
            unsigned char* ws = argp()->ws;
            const float* CL = (const float*)(ws + WS_CL); const float* CT = (const float*)(ws + WS_CT);
            LAS float* carry = (LAS float*)(F.lds + H2_OFF)  ; LAS unsigned* nbw = (LAS unsigned*)(F.lds + RING_OFF + NB_OFF);
            float fox_mq, fox_mk;
            { const float* gq = argp()->in[4] + L * 384 + 256; float mq = fabsf(gq[F.lane]), mk = fabsf(gq[64 + F.lane]);
#pragma unroll
              for (int o = 1; o < 64; o <<= 1) { mq = fmaxf(mq, __shfl_xor(mq, o)); mk = fmaxf(mk, __shfl_xor(mk, o)); }
              fox_mq = mq; fox_mk = mk; }
            for (int rp = 0; rp < REP_C; ++rp) {
            LAS unsigned* miscw = (LAS unsigned*)(F.lds + MISC_OFF);
            unsigned live = 0xffu;
            for (int kg = 0; kg < 8; ++kg) { const int xg = ((F.vcu >> 5) + kg) & 7;
            if (kg == 1) {
                if (F.wave == 0) { unsigned v = 0xffffffffu; if (F.lane < 8) v = __hip_atomic_load(F.ctl + CW_TICK + 64 * (8 * (2 * L + rp % 2) + (((F.vcu >> 5) + F.lane) & 7)), RLX_AGENT);
                    const unsigned long long m = __ballot(v < 128u); if (F.lane == 0) miscw[MW_LIVE] = (unsigned)m; }
                __syncthreads(); live = (unsigned)__builtin_amdgcn_readfirstlane((int)miscw[MW_LIVE]); }
            if (!((live >> kg) & 1u)) continue;
            gu32* const tick = F.ctl + CW_TICK + 64 * (8 * (2 * L + rp % 2) + xg);
            if (F.tid == 0) miscw[MW_TICKET] = __hip_atomic_fetch_add(tick, 1u, RLX_AGENT);
            __syncthreads();
            for (;;) {
                PHASE_BEGIN();
                const int ui = (int)miscw[MW_TICKET];
                if (ui >= 128) { __syncthreads(); break; }
                unsigned nxt_c = 0u; if (F.tid == 0) nxt_c = __hip_atomic_fetch_add(tick, 1u, RLX_AGENT);
                const int qb = 31 - (ui >> 2), bh = 4 * xg + (ui & 3);
                    const int NTt = 4 * (qb + 1); const int t_a = F.lane, t_b = 64 + F.lane, k_a = 64 * t_a + 63, k_b = 64 * t_b + 63;
                    const float cl_a = t_a < NTt ? CL[(size_t)bh * SEQ + k_a] : 0.f, cl_b = t_b < NTt ? CL[(size_t)bh * SEQ + k_b] : 0.f;
                    { const size_t off = ((size_t)(bh >> 3) * SEQ + 256 * qb + (F.tid >> 1)) * 512 + (bh & 7) * 64 + 32 * (F.tid & 1);
                      const pg8::u32x4* qp = (const pg8::u32x4*)((const bf16*)(ws + WS_QC) + off); const pg8::u32x4* kp = (const pg8::u32x4*)((const bf16*)(ws + WS_KC) + off);
                      pg8::u32x4 qv[4], kv[4];
#pragma unroll
                      for (int j = 0; j < 4; ++j) { qv[j] = qp[j]; kv[j] = kp[j]; }
                      float dg = 0.f;
#pragma unroll
                      for (int j = 0; j < 4; ++j)
#pragma unroll
                          for (int e = 0; e < 4; ++e) { dg = fmaf(__uint_as_float(qv[j][e] << 16), __uint_as_float(kv[j][e] << 16), dg); dg = fmaf(__uint_as_float(qv[j][e] & 0xffff0000u), __uint_as_float(kv[j][e] & 0xffff0000u), dg); }
                      dg += __shfl_xor(dg, 1);
#pragma unroll
                      for (int o = 2; o < 64; o <<= 1) dg = fminf(dg, __shfl_xor(dg, o));
                      if (F.lane == 0) carry[128 + F.wave] = dg; }
                    if (F.wave == 0) { const float t0 = CT[bh * 128 + 2 * F.lane], t1 = CT[bh * 128 + 2 * F.lane + 1]; const float inc = wave_incl_scan(t0 + t1, F.lane); carry[2 * F.lane] = inc - (t0 + t1); carry[2 * F.lane + 1] = inc - t1; }
                    __syncthreads();
                    const float cref = carry[4 * qb]; int tskip;
                    { const float mq = fox_mq, mk = fox_mk;
                      const float qkb = 11.8f * mq * mk + 0.5f;
                      const pg8::f32x4 dA = *(const LAS pg8::f32x4*)(carry + 128), dB = *(const LAS pg8::f32x4*)(carry + 132);
                      const float dmin = fminf(fminf(fminf(dA[0], dA[1]), fminf(dA[2], dA[3])), fminf(fminf(dB[0], dB[1]), fminf(dB[2], dB[3])));
                      const float dlb = fmaxf(dmin - 0.25f, -qkb);
                      const float thr = FOX_SKIP_LOG2 - qkb + dlb;
                      const float n_a = t_a < NTt ? (cref - (carry[k_a >> 6] + cl_a)) * 1.4426950408889634f : 0.f, n_b = t_b < NTt ? (cref - (carry[k_b >> 6] + cl_b)) * 1.4426950408889634f : 0.f;
                      const bool s_a = t_a < NTt && n_a < thr, s_b = t_b < NTt && n_b < thr;
                      const unsigned long long f_a = __ballot(!s_a), f_b = __ballot(!s_b);
                      int cnt = f_a ? (int)__builtin_ctzll(f_a) : 64 + (f_b ? (int)__builtin_ctzll(f_b) : 64);
                      cnt &= ~1; tskip = cnt > NTt - 4 ? NTt - 4 : cnt; }
                    attn_body::attn_prologue(bh >> 3, bh & 7, (const attn_body::bf16*)(ws + WS_KC), (const attn_body::bf16*)(ws + WS_VC), (char*)lds + RING_OFF, tskip, F.wave);
                    { const int nk = 256 * (qb + 1);
                      const float* CLr = CL + (size_t)bh * SEQ;
#pragma unroll 1
                      for (int k0 = 64 * tskip + F.tid; k0 < nk; k0 += 2048) {
                          float cl4[4];
#pragma unroll
                          for (int j = 0; j < 4; ++j) { const int k = k0 + 512 * j; cl4[j] = CLr[k < nk ? k : k0]; }
                          asm volatile("" ::: "memory");
#pragma unroll
                          for (int j = 0; j < 4; ++j) { const int k = k0 + 512 * j; if (k < nk) { const float xb = (cref - (carry[k >> 6] + cl4[j])) * 1.4426950408889634f;
                              const unsigned h = f2bf(xb), l = f2bf(xb - __uint_as_float(h << 16)); nbw[k] = h | (l << 16); } } } }
                    __syncthreads();
                    attn_body::attn_unit<64>(bh >> 3, bh & 7, qb, (const attn_body::bf16*)(ws + WS_QC), (const attn_body::bf16*)(ws + WS_KC), (const attn_body::bf16*)(ws + WS_VC), (attn_body::bf16*)(ws + WS_G),
                                            (char*)lds + RING_OFF, (attn_body::lds_cuptr)(F.lds + RING_OFF + NB_OFF), tskip, rp + 1 < REP_C, F.wave, true);
                if (F.tid == 0) miscw[MW_TICKET] = nxt_c;
                __syncthreads();
            } } }
            __syncthreads(); PHASE_BEGIN();
            const BAParams P{(const bf16*)(ws + WS_IQ), (const bf16*)(ws + WS_IK), (const float*)(ws + WS_IW), (const bf16*)(ws + WS_QA), (const bf16*)(ws + WS_QB), (const bf16*)(ws + WS_KAB), (const bf16*)(ws + WS_VAB),
                             (bf16*)(ws + WS_G), argp()->in[5] + L * 8};
            { const int team = F.wave >> 2; F.wt = F.wave & 3; F.tgen = 0u;
              F.ring = F.lds + team * 65536; F.selp = F.lds + SEL_OFF + team * 8192; F.h2p = F.lds + H2_OFF + team * 4096; F.miscp = F.lds + TMISC_OFF + team * 1024; }
            for (int u = F.lane; u < 256; u += 64) if (F.wt == 0) ((LAS unsigned*)F.miscp)[u] = 0u;
            ba_clear(F);
            __syncthreads();
            for (int rp = 0; rp < REP_BA; ++rp) {
            LAS unsigned* miscw = (LAS unsigned*)F.miscp;
            unsigned live = 0xfu;
            for (int kg = 0; kg < 4; ++kg) { const int bq = ((F.vcu >> 6) + kg) & 3;
            if (kg == 1) {
                if (F.wt == 0) { unsigned v = 0xffffffffu; if (F.lane < 4) v = __hip_atomic_load(F.ctl + CW_TICK + 64 * (32 + 4 * (2 * L + rp % 2) + (((F.vcu >> 6) + F.lane) & 3)), RLX_AGENT);
                    const unsigned long long m = __ballot(v < 512u); if (F.lane == 0) miscw[MW_LIVE] = (unsigned)m; }
                team_barrier(F); live = (unsigned)__builtin_amdgcn_readfirstlane((int)miscw[MW_LIVE]); }
            if (!((live >> kg) & 1u)) continue;
            gu32* const tick = F.ctl + CW_TICK + 64 * (32 + 4 * (2 * L + rp % 2) + bq);
            if (F.wt == 0 && F.lane == 0) miscw[MW_TICKET] = __hip_atomic_fetch_add(tick, 1u, RLX_AGENT);
            team_barrier(F);
            for (;;) {
                { int l_ = (int)__builtin_amdgcn_mbcnt_hi(~0u, __builtin_amdgcn_mbcnt_lo(~0u, 0u)); asm volatile("" : "+v"(l_)); F.lane = l_; }
                const int ui = (int)miscw[MW_TICKET];
                if (ui >= 512) { team_barrier(F); break; }
                ba_unit(F, P, bq, 511 - ui, rp + 1 < REP_BA);
                if (F.wt == 0 && F.lane == 0) miscw[MW_TICKET] = __hip_atomic_fetch_add(tick, 1u, RLX_AGENT);
                team_barrier(F);
            } } }
            __syncthreads(); PHASE_BEGIN();
            SEAM(pb + 2);
        }
        if (IN(pb + 4)) { PHASE_BEGIN();
            unsigned char* ws = argp()->ws;
            pg8::Gemm g{(const pg8::bf16_t*)(ws + WS_G), (const pg8::bf16_t*)(ws + WS_WBT) + (size_t)L * 3 * 1024 * 512, M, 1024, 512, 1536, 512, 4};
            pg8::SegOrder S; S.base.init(M, 1024, F.G, (int)blockIdx.x);
            pg8::EpiMerge E{(const unsigned char*)argp()->out, (pg8::bf16_t*)(ws + WS_MERGED)};
            for (int rp = 0; rp < REP_P3; ++rp) pg8::gemm_phase<pg8::EpiMerge, pg8::SegOrder, true, true>(F.lds + RING_OFF, g, S, E, F.wave);
            SEAM(pb + 4);
        }
        if (IN(pb + 5)) { PHASE_BEGIN();
            unsigned char* ws = argp()->ws; float* const outp = argp()->out;
            pg8::Gemm g{(const pg8::bf16_t*)(ws + WS_MERGED), (const pg8::bf16_t*)(ws + WS_WOT) + (size_t)L * 1024 * 1024, M, 1024, 1024, 1024, 1024, 0}; pg8::StaticOrder S; S.init(M, 1024, F.G, (int)blockIdx.x);
            const bool last = (L == DEPTH - 1);
            unsigned poison = 0u;
            if (last) poison = (__hip_atomic_load(F.ctl + CW_OVF, RLX_AGENT) != 0u) | (__hip_atomic_load(F.ctl + CW_BAR + XB_TMO, RLX_AGENT) != 0u);
            static_assert(DEPTH == 2, "two instantiations: first layer (f32 residual in, bf16 stream out), last layer (bf16 stream in, f32 output)");
            if (!last) { pg8::EpiOutT<false, false> E{argp()->in[0], nullptr, nullptr, (pg8::bf16_t*)(ws + WS_XB), (float*)(ws + WS_SSQ), poison};
                         pg8::gemm_phase<pg8::EpiOutT<false, false>, pg8::StaticOrder, true, true>(F.lds + RING_OFF, g, S, E, F.wave); }
            else       { pg8::EpiOutT<true, true> E{nullptr, (const pg8::bf16_t*)(ws + WS_XB), outp, nullptr, nullptr, poison};
                         pg8::gemm_phase<pg8::EpiOutT<true, true>, pg8::StaticOrder, true, true>(F.lds + RING_OFF, g, S, E, F.wave); }
            if (!last) SEAM(pb + 5);
        }
    }
#undef IN
#undef SEAM
}

extern "C" void kernel_launch(void* const* d_in, const int* in_sizes, int n_in, void* d_out, int out_size, void* d_ws, size_t ws_size, hipStream_t stream) {
    static int grid = 0;
    if (grid == 0) {
        if (n_in != 9 || in_sizes[0] != M * DMODEL || out_size != M * DMODEL || ws_size < WS_END) { fprintf(stderr, "kernel_launch: unexpected shapes / workspace (n_in %d, in0 %d, out %d, ws %zu < %zu); nothing launched\n", n_in, n_in > 0 ? in_sizes[0] : -1, out_size, ws_size, (size_t)WS_END); grid = -1; return; }
        int dev = 0, cus = 0, per_cu = 0;
        if (hipGetDevice(&dev) != hipSuccess || hipDeviceGetAttribute(&cus, hipDeviceAttributeMultiprocessorCount, dev) != hipSuccess) { grid = -1; return; }
        if (hipFuncSetAttribute((const void*)mk_fwd, hipFuncAttributeMaxDynamicSharedMemorySize, LDS_BYTES) != hipSuccess) { fprintf(stderr, "kernel_launch: hipFuncSetAttribute failed\n"); grid = -1; return; }
        if (hipOccupancyMaxActiveBlocksPerMultiprocessor(&per_cu, (const void*)mk_fwd, 512, LDS_BYTES) != hipSuccess || per_cu < 1) fprintf(stderr, "kernel_launch: occupancy query reports %d workgroups per CU\n", per_cu);
        (void)hipGetLastError();
        grid = cus;
    }
    if (grid < 0) return;
    if (hipMemsetAsync((char*)d_ws + WS_CTL, 0, CTL_ZERO_BYTES, stream) != hipSuccess) return;
    Args a{};
    for (int i = 0; i < 9; ++i) a.in[i] = (const float*)d_in[i];
    a.out = (float*)d_out; a.ws = (unsigned char*)d_ws;
#if MK_ONE_LAUNCH
    a.ph_lo = 0; a.ph_hi = NPHASES;
    hipLaunchKernelGGL(mk_fwd, dim3(grid), dim3(512), LDS_BYTES, stream, a);
#else
    for (int p = 0; p < NPHASES; ++p) { a.ph_lo = p; a.ph_hi = p + 1; hipLaunchKernelGGL(mk_fwd, dim3(grid), dim3(512), LDS_BYTES, stream, a); }
#endif
}
```
